# Optimizing an MI355X kernel written in HIP

```python
import jax, jax.numpy as jnp
from jax import lax
import numpy as np


D_MODEL = 1024
BATCH = 2
SEQ = 16384
DEPTH = 2

N_Q_HEADS = 8
N_KV_HEADS = 2
GQA_GROUP = N_Q_HEADS // N_KV_HEADS
HEAD_DIM = 64
WINDOW = 128
WIN_BLOCK = 128
ROPE_THETA = 10000.0
MASK_VALUE = -1e30
HGRN_HEADS = 4
HGRN_KEY_DIM = 128
HGRN_VAL_DIM = 128
HGRN_CHUNK = 16
LOGF_MIN = -4.0
LB_FLOOR = 1e-30
N_GROUPS = 4
EXPERTS_PER_GROUP = 8
N_EXPERTS = N_GROUPS * EXPERTS_PER_GROUP
TOP_K = 2
D_EXPERT = 512
MOE_BLOCK = 128
NORM_EPS = 1e-6

ATTN_Q_W = N_Q_HEADS * HEAD_DIM
ATTN_KV_W = N_KV_HEADS * HEAD_DIM
HGRN_F_W = HGRN_HEADS * HGRN_KEY_DIM
HGRN_V_W = HGRN_HEADS * HGRN_VAL_DIM
SPLIT_SIZES = (ATTN_Q_W, ATTN_KV_W, ATTN_KV_W,
               HGRN_F_W, HGRN_F_W, HGRN_F_W, HGRN_V_W, HGRN_V_W,
               D_MODEL, D_MODEL)
IN_WIDTH = sum(SPLIT_SIZES)

kernel_name = "hybrid_swa_hgrn2_hmoe_encoder"


def _rmsnorm(x, g):
    x32 = x.astype(jnp.float32)
    y = x32 * lax.rsqrt(jnp.mean(x32 * x32, axis=-1, keepdims=True) + NORM_EPS)
    return (y * g.astype(jnp.float32)).astype(x.dtype)


def _rope(t, pos):
    half = t.shape[-1] // 2
    inv = ROPE_THETA ** (-jnp.arange(half, dtype=jnp.float32) / half)
    ang = pos.astype(jnp.float32)[:, None] * inv[None, :]
    cos = jnp.cos(ang)[None, :, None, :]
    sin = jnp.sin(ang)[None, :, None, :]
    t1, t2 = t[..., :half], t[..., half:]
    return jnp.concatenate([t1 * cos - t2 * sin, t2 * cos + t1 * sin], axis=-1)


def _window_attention(q, k, v, sink):
    B, L = q.shape[0], q.shape[1]
    nb = L // WIN_BLOCK
    q = q.reshape(B, nb, WIN_BLOCK, N_KV_HEADS, GQA_GROUP, HEAD_DIM)

    def band(t):
        tp = jnp.pad(t, ((0, 0), (WIN_BLOCK, WIN_BLOCK), (0, 0), (0, 0)))
        tb = tp.reshape(B, nb + 2, WIN_BLOCK, N_KV_HEADS, HEAD_DIM)
        return jnp.concatenate([tb[:, :-2], tb[:, 1:-1], tb[:, 2:]], axis=2)

    kw, vw = band(k), band(v)
    s = jnp.einsum('bnqkgd,bnskd->bnkgqs', q, kw) * (HEAD_DIM ** -0.5)
    blk = jnp.arange(nb)
    qpos = blk[:, None] * WIN_BLOCK + jnp.arange(WIN_BLOCK)[None, :]
    kpos = (blk[:, None] - 1) * WIN_BLOCK + jnp.arange(3 * WIN_BLOCK)[None, :]
    valid = ((jnp.abs(qpos[:, :, None] - kpos[:, None, :]) <= WINDOW)
             & (kpos >= 0)[:, None, :] & (kpos < L)[:, None, :])
    s = jnp.where(valid[None, :, None, None], s, MASK_VALUE)
    sink_b = sink.reshape(N_KV_HEADS, GQA_GROUP)[None, None, :, :, None, None]
    m = jnp.maximum(jnp.max(s, axis=-1, keepdims=True), sink_b)
    p = jnp.exp(s - m)
    denom = jnp.sum(p, axis=-1, keepdims=True) + jnp.exp(sink_b - m)
    o = jnp.einsum('bnkgqs,bnskd->bnqkgd', p / denom, vw)
    return o.reshape(B, L, ATTN_Q_W)


def _gla_chunkwise(q, k, v, logf):
    B, H, L, DK = q.shape
    DV = v.shape[-1]
    n = L // HGRN_CHUNK
    q, k, logf = [t.reshape(B, H, n, HGRN_CHUNK, DK) for t in (q, k, logf)]
    v = v.reshape(B, H, n, HGRN_CHUNK, DV)
    b = jnp.cumsum(logf, axis=3)
    b_last = b[:, :, :, -1:, :]
    qe = q * jnp.exp(b)
    a = jnp.einsum('bhncd,bhnsd->bhncs', qe, k * jnp.exp(-b))
    tril = jnp.tril(jnp.ones((HGRN_CHUNK, HGRN_CHUNK), dtype=bool))
    a = jnp.where(tril, a, 0.0)
    o = jnp.einsum('bhncs,bhnse->bhnce', a, v)
    kv = jnp.einsum('bhncd,bhnce->bhnde', k * jnp.exp(b_last - b), v)
    decay = jnp.exp(b_last[:, :, :, 0, :])

    def step(S, inp):
        d, u = inp
        return d[..., None] * S + u, S

    _, s_prev = lax.scan(step, jnp.zeros((B, H, DK, DV), jnp.float32),
                         (jnp.moveaxis(decay, 2, 0), jnp.moveaxis(kv, 2, 0)))
    o = o + jnp.einsum('bhncd,nbhde->bhnce', qe, s_prev)
    return o.reshape(B, H, L, DV)


def _hgrn2(qb, zf, zb, ib, ogb, lb, norm_g):
    B, L = qb.shape[0], qb.shape[1]

    def heads(t):
        return t.astype(jnp.float32).reshape(B, L, HGRN_HEADS, -1).transpose(0, 2, 1, 3)

    q = jax.nn.silu(heads(qb))
    v = heads(ib)

    def direction(z, lbd, reverse):
        lbd = lbd.astype(jnp.float32).reshape(1, HGRN_HEADS, 1, HGRN_KEY_DIM)
        logf = jnp.logaddexp(jnp.log(jnp.maximum(lbd, LB_FLOOR)),
                             jnp.log1p(-lbd) + jax.nn.log_sigmoid(heads(z)))
        logf = jnp.maximum(logf, LOGF_MIN)
        k = -jnp.expm1(logf)
        if reverse:
            fl = lambda t: jnp.flip(t, axis=2)
            return fl(_gla_chunkwise(fl(q), fl(k), fl(v), fl(logf)))
        return _gla_chunkwise(q, k, v, logf)

    o = direction(zf, lb[0], False) + direction(zb, lb[1], True)
    o = o.transpose(0, 2, 1, 3).reshape(B, L, HGRN_V_W)
    o = o * lax.rsqrt(jnp.mean(o * o, axis=-1, keepdims=True) + NORM_EPS) * norm_g.astype(jnp.float32)
    return o * jax.nn.silu(ogb.astype(jnp.float32))


def _mixer(h, w_in, sink, lb, hgrn_g, w_up_attn, w_up_hgrn, w_out):
    B, L, _ = h.shape
    proj = h @ w_in
    points = np.cumsum(SPLIT_SIZES)[:-1].tolist()
    qa, ka, va, qb, zf, zb, ib, ogb, ga, gb = jnp.split(proj, points, axis=-1)
    pos = jnp.arange(L)
    qa = _rope(qa.reshape(B, L, N_Q_HEADS, HEAD_DIM).astype(jnp.float32), pos)
    ka = _rope(ka.reshape(B, L, N_KV_HEADS, HEAD_DIM).astype(jnp.float32), pos)
    va = va.reshape(B, L, N_KV_HEADS, HEAD_DIM).astype(jnp.float32)
    y_attn = _window_attention(qa, ka, va, sink.astype(jnp.float32)).astype(h.dtype)
    y_hgrn = _hgrn2(qb, zf, zb, ib, ogb, lb, hgrn_g).astype(h.dtype)
    merged = (jax.nn.sigmoid(ga) * (y_attn @ w_up_attn)
              + jax.nn.sigmoid(gb) * (y_hgrn @ w_up_hgrn))
    return merged @ w_out


def _hier_moe(xf, w_rg, b_rg, w_re, b_re, w_gate, w_up, w_down):
    T, D = xf.shape
    p_g = jax.nn.softmax((xf @ w_rg).astype(jnp.float32) + b_rg.astype(jnp.float32), axis=-1)
    p_top, g_top = lax.top_k(p_g, 1)
    logits_e = jnp.einsum('td,gde->tge', xf, w_re).astype(jnp.float32) + b_re.astype(jnp.float32)
    logits_e = jnp.take_along_axis(logits_e, g_top[:, :, None], axis=1)[:, 0]
    w_top, e_top = lax.top_k(jax.nn.softmax(logits_e, axis=-1), TOP_K)
    w_top = w_top / jnp.sum(w_top, axis=-1, keepdims=True)
    weights = (p_top * w_top).reshape(-1)
    experts = (g_top * EXPERTS_PER_GROUP + e_top).reshape(-1).astype(jnp.int32)
    tokens = jnp.repeat(jnp.arange(T, dtype=jnp.int32), TOP_K)

    n_slots = T * TOP_K
    order = jnp.argsort(experts)
    e_s, t_s, w_s = experts[order], tokens[order], weights[order]
    counts = jnp.bincount(experts, length=N_EXPERTS)
    start = jnp.cumsum(counts) - counts
    padded = (counts + MOE_BLOCK - 1) // MOE_BLOCK * MOE_BLOCK
    pend = jnp.cumsum(padded)
    pstart = pend - padded
    dest = pstart[e_s] + (jnp.arange(n_slots) - start[e_s])
    n_pad = n_slots + N_EXPERTS * MOE_BLOCK
    n_blocks = n_pad // MOE_BLOCK
    slot_token = jnp.full((n_pad,), T, jnp.int32).at[dest].set(t_s)
    slot_weight = jnp.zeros((n_pad,), xf.dtype).at[dest].set(w_s.astype(xf.dtype))
    block_expert = jnp.minimum(
        jnp.searchsorted(pend, jnp.arange(n_blocks) * MOE_BLOCK, side='right'), N_EXPERTS - 1)
    x_pad = jnp.concatenate([xf, jnp.zeros((1, D), xf.dtype)], axis=0)

    def block_fn(args):
        e, idx = args
        hb = x_pad[idx]
        return (jax.nn.silu(hb @ w_gate[e]) * (hb @ w_up[e])) @ w_down[e]

    y = lax.map(block_fn, (block_expert, slot_token.reshape(n_blocks, MOE_BLOCK)))
    y = y.reshape(n_pad, D) * slot_weight[:, None]
    return jax.ops.segment_sum(y, slot_token, num_segments=T + 1)[:T]


def setup_inputs(seed: int = 0) -> dict:
    key = jax.random.key(seed)
    ks = jax.random.split(key, 18)
    f32 = jnp.float32
    nrm = lambda k, shape, scale: jax.random.normal(k, shape, f32) * scale
    return {
        "x": nrm(ks[0], (BATCH, SEQ, D_MODEL), 1.0),
        "attn_norm_g": 1.0 + nrm(ks[1], (DEPTH, D_MODEL), 0.02),
        "w_in": nrm(ks[2], (DEPTH, D_MODEL, IN_WIDTH), D_MODEL ** -0.5),
        "sink_logits": nrm(ks[3], (DEPTH, N_Q_HEADS), 0.5),
        "hgrn_lb_table": nrm(ks[4], (DEPTH, 2, HGRN_F_W), 0.5),
        "hgrn_norm_g": 1.0 + nrm(ks[5], (DEPTH, HGRN_V_W), 0.02),
        "w_up_attn": nrm(ks[6], (DEPTH, ATTN_Q_W, D_MODEL), ATTN_Q_W ** -0.5),
        "w_up_hgrn": nrm(ks[7], (DEPTH, HGRN_V_W, D_MODEL), HGRN_V_W ** -0.5),
        "w_out": nrm(ks[8], (DEPTH, D_MODEL, D_MODEL), D_MODEL ** -0.5),
        "ffn_norm_g": 1.0 + nrm(ks[9], (DEPTH, D_MODEL), 0.02),
        "w_router_group": nrm(ks[10], (DEPTH, D_MODEL, N_GROUPS), D_MODEL ** -0.5),
        "b_router_group": nrm(ks[11], (DEPTH, N_GROUPS), 0.01),
        "w_router_expert": nrm(ks[12], (DEPTH, N_GROUPS, D_MODEL, EXPERTS_PER_GROUP), D_MODEL ** -0.5),
        "b_router_expert": nrm(ks[13], (DEPTH, N_GROUPS, EXPERTS_PER_GROUP), 0.01),
        "w_expert_gate": nrm(ks[14], (DEPTH, N_EXPERTS, D_MODEL, D_EXPERT), D_MODEL ** -0.5),
        "w_expert_up": nrm(ks[15], (DEPTH, N_EXPERTS, D_MODEL, D_EXPERT), D_MODEL ** -0.5),
        "w_expert_down": nrm(ks[16], (DEPTH, N_EXPERTS, D_EXPERT, D_MODEL), D_EXPERT ** -0.5),
        "final_norm_g": 1.0 + nrm(ks[17], (D_MODEL,), 0.02),
    }


def reference(x, attn_norm_g, w_in, sink_logits, hgrn_lb_table, hgrn_norm_g, w_up_attn,
              w_up_hgrn, w_out, ffn_norm_g, w_router_group, b_router_group, w_router_expert,
              b_router_expert, w_expert_gate, w_expert_up, w_expert_down, final_norm_g):
    B, L, D = x.shape
    sm = jax.nn.softmax(hgrn_lb_table.astype(jnp.float32), axis=0)
    lower_bounds = jnp.cumsum(sm, axis=0) - sm[:1]
    for l in range(DEPTH):
        h = _rmsnorm(x, attn_norm_g[l])
        x = x + _mixer(h, w_in[l], sink_logits[l], lower_bounds[l], hgrn_norm_g[l],
                       w_up_attn[l], w_up_hgrn[l], w_out[l])
        h = _rmsnorm(x, ffn_norm_g[l])
        y = _hier_moe(h.reshape(B * L, D), w_router_group[l], b_router_group[l],
                      w_router_expert[l], b_router_expert[l], w_expert_gate[l],
                      w_expert_up[l], w_expert_down[l])
        x = x + y.reshape(B, L, D).astype(x.dtype)
    return _rmsnorm(x, final_norm_g)
```

```cpp
#define ORACLE 1
#include <hip/hip_runtime.h>
#include <cstdio>
#include <cstdint>
namespace pg8 {
#define PG8_LAS __attribute__((address_space(3)))
typedef unsigned short bf16_t;
typedef short bf16x8 __attribute__((ext_vector_type(8)));
typedef float f32x4 __attribute__((ext_vector_type(4)));
typedef unsigned u32x4 __attribute__((ext_vector_type(4)));
typedef unsigned u32x2 __attribute__((ext_vector_type(2)));
constexpr int BM = 256, BK = 64, HALF = 128, HTB = HALF * BK * 2  , STAGE_BYTES = 8 * HTB, NXCD = 8, WGM = 8;

__host__ __device__ __forceinline__ int lds_byte(int r, int c) { const int st = (r >> 4) * 2 + (c >> 5), rr = r & 15, cc = c & 31, ob = rr * 64 + cc * 2; return st * 1024 + (ob ^ (((ob >> 9) & 1) << 5)); }
__host__ __device__ __forceinline__ void stage_rc(int b, int& R, int& C) { const int st = b / 1024, sb = b % 1024, swz = sb ^ (((sb >> 9) & 1) << 5); R = (st >> 1) * 16 + swz / 64; C = (st & 1) * 32 + (swz % 64) / 2; }
__host__ __device__ __forceinline__ int perm32(int rho) { const int n = rho >> 4, i = rho & 15; return 8 * (i >> 2) + 4 * n + (i & 3); }

struct Unit { int pm, pn, pb; };
struct Gemm { const bf16_t* A; const bf16_t* Bt; int M, N, K; };

struct StaticOrder {
    int nM, nN, nwg, G, c;
    __host__ __device__ void init(int M, int N, int G_, int c_) { nM = M / BM; nN = N / BM; nwg = nM * nN; G = G_; c = c_; }
    __host__ __device__ bool next(int i, Unit& u) const {
        const long L = (long)i * G + c; if (L >= nwg) return false;
        int wgid = (int)L; { const int q = nwg / NXCD, r = nwg % NXCD, xcd = wgid % NXCD, off = wgid / NXCD; wgid = (xcd < r ? xcd * (q + 1) : r * (q + 1) + (xcd - r) * q) + off; }
        const int nig = WGM * nN, gid = wgid / nig, fm = gid * WGM, gsz = (nM - fm) < WGM ? (nM - fm) : WGM;
        u.pm = fm + ((wgid % nig) % gsz); u.pn = (wgid % nig) / gsz; u.pb = u.pn; return true;
    }
    __device__ __forceinline__ void a_ready(const Unit&) const {}
    __device__ __forceinline__ void done(const Unit&) const {}
};
struct GroupedOrder {
    const int* meta; int nM, nN, nwg, G, c;
    __device__ void init(const int* meta_, int N, int G_, int c_) { meta = meta_; nM = __builtin_amdgcn_readfirstlane(meta_[0]); nN = N / BM; nwg = nM * nN; G = G_; c = c_; }
    __device__ bool next(int i, Unit& u) const {
        const long L = (long)i * G + c; if (L >= nwg) return false;
        int wgid = (int)L; { const int q = nwg / NXCD, r = nwg % NXCD, xcd = wgid % NXCD, off = wgid / NXCD; wgid = (xcd < r ? xcd * (q + 1) : r * (q + 1) + (xcd - r) * q) + off; }
        const int nig = WGM * nN, gid = wgid / nig, fm = gid * WGM, gsz = (nM - fm) < WGM ? (nM - fm) : WGM;
        u.pm = fm + ((wgid % nig) % gsz); u.pn = (wgid % nig) / gsz;
        u.pb = __builtin_amdgcn_readfirstlane(meta[1 + u.pm]) * nN + u.pn; return true;
    }
    __device__ __forceinline__ void a_ready(const Unit&) const {}
    __device__ __forceinline__ void done(const Unit&) const {}
};
typedef float f32x2_t __attribute__((ext_vector_type(2))); typedef __bf16 bf16x2_t __attribute__((ext_vector_type(2)));
__device__ __forceinline__ unsigned cvt_pk_bf16(float lo, float hi) { f32x2_t v = {lo, hi}; bf16x2_t b = __builtin_convertvector(v, bf16x2_t); return __builtin_bit_cast(unsigned, b); }
template <class Epi, class Sched, bool ALIGN_EPI = false, bool SP2 = false>
__device__ __forceinline__ void gemm_phase(PG8_LAS unsigned char* lds, const Gemm g, const Sched& S, const Epi& E) {
    int tid_ = threadIdx.x; asm volatile("" : "+v"(tid_));
    const int tid = tid_, wid = __builtin_amdgcn_readfirstlane(tid >> 6), lane = tid & 63, wr = wid >> 2, wc = wid & 3, fr = lane & 15, fq = lane >> 4;
    const int K = g.K, nt = K / BK;
    unsigned voffA[2], voffB[2];
#pragma unroll
    for (int i = 0; i < 2; ++i) { int R, C; stage_rc(tid * 16 + i * 8192, R, C); const int Rb = Epi::PERM ? ((R & ~31) + perm32(R & 31)) : R;
        voffA[i] = (unsigned)(R * K + C) * 2u; voffB[i] = (unsigned)(Rb * K + C) * 2u; }
    const size_t kstep = (size_t)(BK * 2);
    const size_t hstep = (size_t)HALF * K * 2;
    const size_t tstep = 2 * hstep;
    const unsigned ldsw = (unsigned)wid * 1024u;
    const int aoff = lds_byte(wr * 64 + fr, fq * 8), boff = lds_byte(wc * 32 + fr, fq * 8);
#define PG8_SA(b, h) (((b) * 2 + (h)) * HTB)
#define PG8_SB(b, h) ((4 + (b) * 2 + (h)) * HTB)
#define PG8_STAGE(bufoff, gbase, voff) do { _Pragma("unroll") for (int _i = 0; _i < 2; ++_i) \
        __builtin_amdgcn_global_load_lds((const unsigned*)((const char*)(gbase) + (voff)[_i]), (PG8_LAS unsigned*)(lds + (bufoff) + ldsw + _i * 8192), 16, 0, 0); } while (0)
#define PG8_LDA(dst, b, h) do { _Pragma("unroll") for (int m = 0; m < 4; ++m) _Pragma("unroll") for (int k = 0; k < 2; ++k) dst[m][k] = *(const PG8_LAS bf16x8*)(lds + PG8_SA(b, h) + aoff + m * 2048 + k * 1024); } while (0)
#define PG8_LDB(dst, b, h) do { _Pragma("unroll") for (int n = 0; n < 2; ++n) _Pragma("unroll") for (int k = 0; k < 2; ++k) dst[n][k] = *(const PG8_LAS bf16x8*)(lds + PG8_SB(b, h) + boff + n * 2048 + k * 1024); } while (0)
#define PG8_MMA(ai, bj, At, Bt) do { __builtin_amdgcn_s_setprio(1); _Pragma("unroll") for (int m = 0; m < 4; ++m) _Pragma("unroll") for (int n = 0; n < 2; ++n) _Pragma("unroll") for (int k = 0; k < 2; ++k) \
        acc[ai][bj][m][n] = __builtin_amdgcn_mfma_f32_16x16x32_bf16(Bt[n][k], At[m][k], acc[ai][bj][m][n], 0, 0, 0); __builtin_amdgcn_s_setprio(0); } while (0)
#define PG8_WAIT_V(n) asm volatile("s_waitcnt vmcnt(" #n ")" ::: "memory")
#define PG8_WAIT_L(n) asm volatile("s_waitcnt lgkmcnt(" #n ")" ::: "memory")
#define PG8_BAR __builtin_amdgcn_s_barrier()
#define PG8_SCHED __builtin_amdgcn_sched_barrier(0)
    Unit cur, nxt; int ui = 0;
    if (!S.next(0, cur)) return;
    f32x4 acc[2][2][4][2];
#pragma unroll
    for (int a = 0; a < 2; ++a)
#pragma unroll
        for (int b = 0; b < 2; ++b)
#pragma unroll
            for (int m = 0; m < 4; ++m)
#pragma unroll
                for (int n = 0; n < 2; ++n) acc[a][b][m][n] = (f32x4){0.f, 0.f, 0.f, 0.f};
    bf16x8 At[4][2], B0[2][2], B1[2][2];
    const char* cA = (const char*)g.A + (size_t)cur.pm * tstep; const char* cB = (const char*)g.Bt + (size_t)cur.pb * tstep;
    S.a_ready(cur);
    if constexpr (SP2) {
        PG8_STAGE(PG8_SB(0, 0), cB, voffB); PG8_STAGE(PG8_SB(0, 1), cB + hstep, voffB); PG8_STAGE(PG8_SA(0, 0), cA, voffA); PG8_STAGE(PG8_SA(0, 1), cA + hstep, voffA);
        if (wr == 1) PG8_BAR;
        PG8_WAIT_V(2); PG8_BAR;
        PG8_STAGE(PG8_SB(1, 0), cB + kstep, voffB); PG8_STAGE(PG8_SA(1, 0), cA + kstep, voffA); PG8_STAGE(PG8_SB(1, 1), cB + hstep + kstep, voffB);
        PG8_WAIT_V(6); PG8_BAR;
    } else {
        PG8_STAGE(PG8_SB(0, 0), cB, voffB); PG8_STAGE(PG8_SA(0, 0), cA, voffA); PG8_STAGE(PG8_SB(0, 1), cB + hstep, voffB); PG8_STAGE(PG8_SA(0, 1), cA + hstep, voffA);
        if (wr == 1) PG8_BAR;
        PG8_WAIT_V(4); PG8_BAR;
        PG8_STAGE(PG8_SB(1, 0), cB + kstep, voffB); PG8_STAGE(PG8_SA(1, 0), cA + kstep, voffA); PG8_STAGE(PG8_SB(1, 1), cB + hstep + kstep, voffB);
        PG8_WAIT_V(6); PG8_BAR;
    }
    for (;;) {
        const bool has_next = S.next(ui + 1, nxt);
        const char* nA = has_next ? (const char*)g.A + (size_t)nxt.pm * tstep : cA; const char* nB = has_next ? (const char*)g.Bt + (size_t)nxt.pb * tstep : cB;
        for (int t = 0; t < nt; t += 2) {
            const bool last = (t == nt - 2);
            const char* a1 = cA + (size_t)(t + 1) * kstep;
            const char* a2 = last ? nA : cA + (size_t)(t + 2) * kstep; const char* b2 = last ? nB : cB + (size_t)(t + 2) * kstep;
            const char* a3 = a2 + kstep; const char* b3 = b2 + kstep;
            if (last && has_next) S.a_ready(nxt);
            if constexpr (SP2) {
            PG8_LDB(B0, 0, 0); PG8_LDB(B1, 0, 1); PG8_SCHED; PG8_LDA(At, 0, 0); PG8_STAGE(PG8_SA(1, 1), a1 + hstep, voffA);
            PG8_WAIT_V(8); PG8_WAIT_L(0); PG8_BAR; PG8_MMA(0, 0, At, B0); PG8_MMA(0, 1, At, B1); PG8_BAR; PG8_SCHED;
            PG8_LDA(At, 0, 1); PG8_STAGE(PG8_SB(0, 0), b2, voffB); PG8_STAGE(PG8_SB(0, 1), b2 + hstep, voffB); PG8_STAGE(PG8_SA(0, 0), a2, voffA);
            PG8_WAIT_V(8); PG8_WAIT_L(0); PG8_BAR; PG8_MMA(1, 0, At, B0); PG8_MMA(1, 1, At, B1); PG8_BAR; PG8_SCHED;
            PG8_LDB(B0, 1, 0); PG8_LDB(B1, 1, 1); PG8_SCHED; PG8_LDA(At, 1, 0); PG8_STAGE(PG8_SA(0, 1), a2 + hstep, voffA);
            PG8_WAIT_V(8); PG8_WAIT_L(0); PG8_BAR; PG8_MMA(0, 0, At, B0); PG8_MMA(0, 1, At, B1); PG8_BAR; PG8_SCHED;
            PG8_LDA(At, 1, 1); PG8_STAGE(PG8_SB(1, 0), b3, voffB); PG8_STAGE(PG8_SB(1, 1), b3 + hstep, voffB); PG8_STAGE(PG8_SA(1, 0), a3, voffA);
            PG8_WAIT_V(8); PG8_WAIT_L(0); PG8_BAR; PG8_MMA(1, 0, At, B0); PG8_MMA(1, 1, At, B1); PG8_BAR; PG8_SCHED;
            } else {
            PG8_LDB(B0, 0, 0); PG8_SCHED; PG8_LDA(At, 0, 0); PG8_STAGE(PG8_SA(1, 1), a1 + hstep, voffA);
            PG8_WAIT_L(8); PG8_BAR; PG8_WAIT_L(0); PG8_MMA(0, 0, At, B0); PG8_BAR; PG8_SCHED;
            PG8_LDB(B1, 0, 1); PG8_STAGE(PG8_SB(0, 0), b2, voffB);
            PG8_BAR; PG8_WAIT_L(0); PG8_MMA(0, 1, At, B1); PG8_BAR;
            PG8_LDA(At, 0, 1); PG8_STAGE(PG8_SA(0, 0), a2, voffA);
            PG8_BAR; PG8_WAIT_L(0); PG8_MMA(1, 0, At, B0); PG8_BAR; PG8_SCHED;
            PG8_STAGE(PG8_SB(0, 1), b2 + hstep, voffB);
            PG8_WAIT_V(6); PG8_BAR; PG8_MMA(1, 1, At, B1); PG8_BAR;
            PG8_LDB(B0, 1, 0); PG8_SCHED; PG8_LDA(At, 1, 0); PG8_STAGE(PG8_SA(0, 1), a2 + hstep, voffA);
            PG8_WAIT_L(8); PG8_BAR; PG8_WAIT_L(0); PG8_MMA(0, 0, At, B0); PG8_BAR; PG8_SCHED;
            PG8_LDB(B1, 1, 1); PG8_STAGE(PG8_SB(1, 0), b3, voffB);
            PG8_BAR; PG8_WAIT_L(0); PG8_MMA(0, 1, At, B1); PG8_BAR;
            PG8_LDA(At, 1, 1); PG8_STAGE(PG8_SA(1, 0), a3, voffA);
            PG8_BAR; PG8_WAIT_L(0); PG8_MMA(1, 0, At, B0); PG8_BAR; PG8_SCHED;
            PG8_STAGE(PG8_SB(1, 1), b3 + hstep, voffB);
            PG8_WAIT_V(6); PG8_BAR; PG8_MMA(1, 1, At, B1); PG8_BAR;
            }
        }
        if constexpr (ALIGN_EPI) { if (wr == 0) PG8_BAR; }
        if constexpr (!Epi::AFTER_DRAIN) { E(acc, cur, wr, wc, fr, fq); S.done(cur); }
        if (!has_next) break;
#pragma unroll
        for (int a = 0; a < 2; ++a)
#pragma unroll
            for (int b = 0; b < 2; ++b)
#pragma unroll
                for (int m = 0; m < 4; ++m)
#pragma unroll
                    for (int n = 0; n < 2; ++n) acc[a][b][m][n] = (f32x4){0.f, 0.f, 0.f, 0.f};
        cur = nxt; cA = nA; cB = nB; ++ui;
        if constexpr (ALIGN_EPI) { if (wr == 1) PG8_BAR; }
    }
    PG8_WAIT_V(0);
    if constexpr (!ALIGN_EPI) { if (wr == 0) PG8_BAR; }
    PG8_BAR;
    if constexpr (Epi::AFTER_DRAIN) { E.fused(acc, cur, wr, wc, fr, fq, lds, wid, lane); S.done(cur); }
#undef PG8_SA
#undef PG8_SB
#undef PG8_STAGE
#undef PG8_LDA
#undef PG8_LDB
#undef PG8_MMA
#undef PG8_WAIT_V
#undef PG8_WAIT_L
#undef PG8_BAR
#undef PG8_SCHED
}
}


constexpr int NWAVES = 8;
constexpr int BATCH = 2, SEQ = 16384, D = 1024, T = BATCH * SEQ, DEPTH = 2;
constexpr int NQH = 8, NKVH = 2, HD = 64, WINDOW = 128;
constexpr int HH = 4, HDK = 128;
constexpr int NGRP = 4, EPG = 8, NEXP = 32, DEXP = 512;
constexpr int INW = 5376, NPA = 3328, NGATE = 2048;
constexpr int C_QA = 0, C_KA = 512, C_VA = 640, C_QH = 768, C_LF = 1280, C_LB = 1792, C_VH = 2304, C_SG = 2816;
constexpr float NORM_EPS = 1e-6f, LOGF_MIN = -4.0f;
constexpr float LOG2E = 1.4426950408889634f;
constexpr float QSCALE = 0.125f * LOG2E;
constexpr int CH = 128, NCH = SEQ / CH;
constexpr int SLOT_ROWS = 73728;

constexpr size_t MiB = 1u << 20;
constexpr size_t WS_CTL = 0, CTL_ZERO_BYTES = 1 * MiB;
constexpr size_t WS_COS = 1 * MiB, WS_SIN = 3 * MiB, WS_LBT = 5 * MiB;
constexpr size_t WS_WIN = 6 * MiB, WS_WUA = 17 * MiB, WS_WUH = 18 * MiB, WS_WOUT = 19 * MiB, WS_W1 = 22 * MiB, WS_W2 = 86 * MiB;
constexpr size_t WS_XN = 118 * MiB;
constexpr size_t WS_PA = 182 * MiB;
constexpr size_t WS_US = 390 * MiB;
constexpr size_t WS_Y = 454 * MiB;
constexpr size_t WS_YH = 486 * MiB;
constexpr size_t WS_HD = 518 * MiB;
constexpr size_t WS_SSQ = 519 * MiB;
constexpr size_t WS_TOKE = 520 * MiB, WS_TOKW = 521 * MiB, WS_TOKR = 522 * MiB, WS_TOKP = 523 * MiB;
constexpr size_t WS_WGCNT = 524 * MiB;
constexpr size_t WS_META = 524 * MiB + 512 * 1024;
constexpr size_t WS_END = 526 * MiB;
constexpr size_t WS_XP = WS_PA;
constexpr size_t WS_ACT = WS_PA + (size_t)SLOT_ROWS * D * 2;
static_assert(WS_ACT + (size_t)SLOT_ROWS * DEXP * 2 <= WS_Y, "MoE overlay");
static_assert(WS_PA + (size_t)T * NPA * 2 <= WS_US && WS_W2 + (size_t)NEXP * D * DEXP * 2 <= WS_XN && WS_WIN + (size_t)INW * D * 2 <= WS_WUA, "ws map");
constexpr int CW_TMO = 0, CW_CODE = 1;
constexpr int CW_BAR = 4096;
constexpr int MAX_LAUNCH = 16;

constexpr int RING_OFF = 0, RING_BYTES = 131072;
constexpr int LDSCTL_OFF = RING_BYTES, MISC_OFF = LDSCTL_OFF + 320;
constexpr int LDS_BYTES = 147456;

#define GAS __attribute__((address_space(1)))
#define LAS __attribute__((address_space(3)))
typedef unsigned short bf16;
typedef unsigned v4u __attribute__((ext_vector_type(4)));
typedef unsigned v2u __attribute__((ext_vector_type(2)));
typedef float f32x4 __attribute__((ext_vector_type(4)));
typedef short bf16x8 __attribute__((ext_vector_type(8)));
typedef short s16x4 __attribute__((ext_vector_type(4)));
typedef _Float16 h16x4 __attribute__((ext_vector_type(4)));
typedef _Float16 h16x8 __attribute__((ext_vector_type(8)));
typedef GAS unsigned gu32;
typedef GAS unsigned long long gu64;
#define RLX_AGENT __ATOMIC_RELAXED, __HIP_MEMORY_SCOPE_AGENT
#define LDS_WAIT() asm volatile("s_waitcnt lgkmcnt(0)" ::: "memory")
#define VM_WAIT() asm volatile("s_waitcnt vmcnt(0)" ::: "memory")
__device__ __forceinline__ unsigned f2bf(float f) { unsigned u = __builtin_bit_cast(unsigned, f); return (u + 0x7fffu + ((u >> 16) & 1u)) >> 16; }
__device__ __forceinline__ unsigned pk2(float lo, float hi) { return f2bf(lo) | (f2bf(hi) << 16); }
__device__ __forceinline__ float bf2f(unsigned short b) { return __builtin_bit_cast(float, ((unsigned)b) << 16); }
__device__ __forceinline__ float bflo(unsigned w) { return __builtin_bit_cast(float, w << 16); }
__device__ __forceinline__ float bfhi(unsigned w) { return __builtin_bit_cast(float, w & 0xffff0000u); }
__device__ __forceinline__ float fast_rcp(float x) { return __builtin_amdgcn_rcpf(x); }
__device__ __forceinline__ float sigmoidf_(float x) { return fast_rcp(1.0f + __expf(-x)); }
__device__ __forceinline__ float siluf_(float x) { return x * fast_rcp(1.0f + __expf(-x)); }

#define XB_TMO      128
#define XB_XCNT(j)  (256  + 64 * (j))
#define XB_XSUB(j)  (1280 + 64 * (j))
#define XB_XGEN(j)  (2304 + 64 * (j))
#define XB_TOP      3328
#define XB_TOPGEN   3392
#define XCD_BAR_WORDS 3456
#define XB_SPIN_CAP (1u << 18)

__device__ __forceinline__ unsigned xb_ld(unsigned* p)              { return __hip_atomic_load(p, __ATOMIC_RELAXED, __HIP_MEMORY_SCOPE_AGENT); }
__device__ __forceinline__ unsigned xb_add(unsigned* p, unsigned v) { return __hip_atomic_fetch_add(p, v, __ATOMIC_RELAXED, __HIP_MEMORY_SCOPE_AGENT); }
__device__ __forceinline__ unsigned xb_xcc_id() { return (unsigned)__builtin_amdgcn_s_getreg((3 << 11) | 20) & 0xFu; }
#define XB_SPIN(cond, bar) do { unsigned _sp = 0; while (cond) { __builtin_amdgcn_s_sleep(1); \
    if ((++_sp & 255u) == 0u) { if (xb_ld(&(bar)[XB_TMO])) break; if (_sp > XB_SPIN_CAP) { atomicAdd(&(bar)[XB_TMO], 1u); break; } } } } while (0)

struct XcdBarrier {
    unsigned* bar; unsigned x;
    volatile LAS unsigned* st;
};

__device__ __forceinline__ XcdBarrier xcd_barrier_post(unsigned* bar, volatile LAS unsigned* st) {
    XcdBarrier b; b.bar = bar; b.x = xb_xcc_id(); b.st = st;
    if (threadIdx.x == 0) (void)xb_add(&bar[XB_XCNT(b.x)], 1u);
    return b;
}
__device__ __forceinline__ void xcd_barrier_complete(unsigned* bar, unsigned x, unsigned& nloc, unsigned& nx) {
    const unsigned G = gridDim.x * gridDim.y * gridDim.z;
    unsigned sum, cnt, mine, sp = 0u;
    for (;;) {
        sum = 0u; cnt = 0u; mine = 0u;
#pragma unroll
        for (unsigned j = 0; j < 16; ++j) { const unsigned c = xb_ld(&bar[XB_XCNT(j)]); sum += c; cnt += (c > 0u) ? 1u : 0u; mine = (j == x) ? c : mine; }
        if (sum == G) break;
        __builtin_amdgcn_s_sleep(1);
        if ((++sp & 255u) == 0u) { if (xb_ld(&bar[XB_TMO])) break; if (sp > XB_SPIN_CAP) { atomicAdd(&bar[XB_TMO], 1u); break; } }
    }
    nloc = mine > 0u ? mine : 1u; nx = cnt > 0u ? cnt : 1u;
}

__device__ __forceinline__ void xcd_barrier(const XcdBarrier& b) {
    asm volatile("s_waitcnt vmcnt(0)" ::: "memory");
    __syncthreads();
    if (threadIdx.x == 0) {
        unsigned* bar = b.bar;
        __builtin_amdgcn_s_waitcnt(0);
        unsigned nloc = b.st[0], nx = b.st[1];
        if (nloc == 0u) { xcd_barrier_complete(bar, b.x, nloc, nx); b.st[0] = nloc; b.st[1] = nx; }
        const unsigned old = xb_add(&bar[XB_XSUB(b.x)], 1u);
        const unsigned gen = old / nloc;
        if (old + 1u == (gen + 1u) * nloc) {
            __builtin_amdgcn_fence(__ATOMIC_RELEASE, "agent");
            asm volatile("s_waitcnt vmcnt(0)" ::: "memory");
            const unsigned og = xb_add(&bar[XB_TOP], 1u);
            const unsigned tg = og / nx;
            if (og + 1u == (tg + 1u) * nx) xb_add(&bar[XB_TOPGEN], 1u);
            else XB_SPIN(xb_ld(&bar[XB_TOPGEN]) == tg, bar);
            __builtin_amdgcn_fence(__ATOMIC_ACQUIRE, "agent");
            xb_add(&bar[XB_XGEN(b.x)], 1u);
            asm volatile("s_waitcnt vmcnt(0)" ::: "memory");
        } else {
            XB_SPIN(xb_ld(&bar[XB_XGEN(b.x)]) == gen, bar);
            __builtin_amdgcn_fence(__ATOMIC_ACQUIRE, "agent");
            asm volatile("s_waitcnt vmcnt(0)" ::: "memory");
        }
    }
    __syncthreads();
}

struct Frame {
    LAS unsigned char* lds;
    volatile LAS unsigned* MISC;
    gu32* ctl;
    int tid, lane, wave, vcu, G;
    unsigned char* ws;
    float* out;
};
struct Args { const float* in[18]; float* out; unsigned char* ws; int ph_lo, ph_hi, li, pad; };
enum { I_X = 0, I_ANG, I_WIN, I_SINK, I_LBT, I_HNG, I_WUA, I_WUH, I_WOUT, I_FNG, I_WRG, I_BRG, I_WRE, I_BRE, I_WEG, I_WEU, I_WED, I_FING };

__device__ __forceinline__ float wave_sum(float v) {
#pragma unroll
    for (int o = 1; o < 64; o <<= 1) v += __shfl_xor(v, o);
    return v;
}

struct CmPerm { const float* W; int N; __device__ __forceinline__ const float* col(int p, int& ld) const { ld = N; return W + ((p & ~31) + pg8::perm32(p & 31)); } };
struct CmIn { const float* W; __device__ __forceinline__ const float* col(int p, int& ld) const { ld = INW;
    const int lc = (p < C_VA) ? ((p & ~63) + 32 * ((p >> 4) & 1) + 16 * ((p >> 5) & 1) + (p & 15)) : ((p & ~31) + pg8::perm32(p & 31)); return W + lc; } };
struct CmGU { const float* Wg; const float* Wu; __device__ __forceinline__ const float* col(int p, int& ld) const { ld = DEXP; const int j = 16 * (p >> 5) + (p & 15); const size_t dlt = ((p >> 4) & 1) ? (size_t)((const char*)Wu - (const char*)Wg) : (size_t)0; return (const float*)((const char*)Wg + dlt) + j; } };
template <class CM> __device__ __forceinline__ void transpose_item(const CM& cm, int K, bf16* WT, LAS float* scr, int kb, int nb, int lane) {
    const int k0 = 64 * kb, n0 = 32 * nb;
    int ld; const float* src = cm.col(n0 + (lane & 31), ld);
#pragma unroll 8
    for (int i = 0; i < 32; ++i) { const int kk = 2 * i + (lane >> 5); scr[kk * 33 + (lane & 31)] = src[(size_t)(k0 + kk) * ld]; }
    LDS_WAIT(); asm volatile("" ::: "memory");
    const int c = lane & 7;
#pragma unroll
    for (int j = 0; j < 4; ++j) { const int n = (lane >> 3) + 8 * j; const LAS float* s = scr + (8 * c) * 33 + n;
        v4u o; o.x = pk2(s[0 * 33], s[1 * 33]); o.y = pk2(s[2 * 33], s[3 * 33]); o.z = pk2(s[4 * 33], s[5 * 33]); o.w = pk2(s[6 * 33], s[7 * 33]);
        *(GAS v4u*)(WT + (size_t)(n0 + n) * K + k0 + 8 * c) = o; }
    LDS_WAIT(); asm volatile("" ::: "memory");
}
__device__ __forceinline__ void conv_weights(Frame& F, const Args& A, int l) {
    LAS float* scr = (LAS float*)(F.lds + RING_OFF + F.wave * 16384);
    const int gw = F.vcu * NWAVES + F.wave, NGW = F.G * NWAVES;
    unsigned char* ws = F.ws;
    const float* w_in = A.in[I_WIN] + (size_t)l * D * INW;
    const float* w_ua = A.in[I_WUA] + (size_t)l * 512 * D;
    const float* w_uh = A.in[I_WUH] + (size_t)l * 512 * D;
    const float* w_out = A.in[I_WOUT] + (size_t)l * D * D;
    const float* w_eg = A.in[I_WEG] + (size_t)l * NEXP * D * DEXP;
    const float* w_eu = A.in[I_WEU] + (size_t)l * NEXP * D * DEXP;
    const float* w_ed = A.in[I_WED] + (size_t)l * NEXP * DEXP * D;
    constexpr int I_A = 16 * (INW / 32), I_B = 8 * 32, I_D = 16 * 32, I_E1 = 16 * 32, I_E = NEXP * I_E1, I_F1 = 8 * 32, I_F = NEXP * I_F1;
    constexpr int NITEMS = I_A + 2 * I_B + I_D + I_E + I_F;
    for (int it = gw; it < NITEMS; it += NGW) {
        int r = it;
        if (r < I_A) { CmIn cm{w_in}; transpose_item(cm, D, (bf16*)(ws + WS_WIN), scr, r / (INW / 32), r % (INW / 32), F.lane); continue; } r -= I_A;
        if (r < I_B) { CmPerm cm{w_ua, D}; transpose_item(cm, 512, (bf16*)(ws + WS_WUA), scr, r / 32, r % 32, F.lane); continue; } r -= I_B;
        if (r < I_B) { CmPerm cm{w_uh, D}; transpose_item(cm, 512, (bf16*)(ws + WS_WUH), scr, r / 32, r % 32, F.lane); continue; } r -= I_B;
        if (r < I_D) { CmPerm cm{w_out, D}; transpose_item(cm, D, (bf16*)(ws + WS_WOUT), scr, r / 32, r % 32, F.lane); continue; } r -= I_D;
        if (r < I_E) { const int e = r / I_E1, q = r % I_E1; CmGU cm{w_eg + (size_t)e * D * DEXP, w_eu + (size_t)e * D * DEXP};
            transpose_item(cm, D, (bf16*)(ws + WS_W1) + (size_t)e * 1024 * D, scr, q / 32, q % 32, F.lane); continue; } r -= I_E;
        { const int e = r / I_F1, q = r % I_F1; CmPerm cm{w_ed + (size_t)e * DEXP * D, D};
            transpose_item(cm, DEXP, (bf16*)(ws + WS_W2) + (size_t)e * D * DEXP, scr, q / 32, q % 32, F.lane); }
    }
}
__device__ __forceinline__ void make_tables(Frame& F, const Args& A) {
    const int gt = F.vcu * (NWAVES * 64) + F.tid, NT = F.G * NWAVES * 64;
    float* cosT = (float*)(F.ws + WS_COS); float* sinT = (float*)(F.ws + WS_SIN); float* lbt = (float*)(F.ws + WS_LBT);
    for (int idx = gt; idx < SEQ * 32; idx += NT) { const int pos = idx >> 5, i = idx & 31;
        const double inv = exp2(-(double)i * (13.287712379549449 / 32.0));
        const double ang = (double)pos * inv; double s, c; sincos(ang, &s, &c); cosT[idx] = (float)c; sinT[idx] = (float)s; }
    for (int idx = gt; idx < 2 * 512; idx += NT) { const int dir = idx >> 9, col = idx & 511;
        float tv[DEPTH]; float mx = -3.0e38f;
#pragma unroll
        for (int l = 0; l < DEPTH; ++l) { tv[l] = A.in[I_LBT][(size_t)(l * 2 + dir) * 512 + col]; mx = fmaxf(mx, tv[l]); }
        float den = 0.f;
#pragma unroll
        for (int l = 0; l < DEPTH; ++l) { tv[l] = expf(tv[l] - mx); den += tv[l]; }
        float cum = 0.f;
#pragma unroll
        for (int l = 0; l < DEPTH; ++l) { if (l > 0) cum += tv[l] / den; const float lb = cum;
            lbt[((l * 2 + dir) * 2 + 0) * 512 + col] = logf(fmaxf(lb, 1e-30f)); lbt[((l * 2 + dir) * 2 + 1) * 512 + col] = log1pf(-lb); } }
}
__device__ __forceinline__ void norm_rows(Frame& F, const float* xin, float* xcopy, const float* g, bf16* xn) {
    const int gw = F.vcu * NWAVES + F.wave, NGW = F.G * NWAVES;
    f32x4 gv[4];
#pragma unroll
    for (int j = 0; j < 4; ++j) gv[j] = *(const f32x4*)(g + 4 * F.lane + 256 * j);
    for (int m = gw; m < T; m += NGW) {
        const GAS f32x4* xr = (const GAS f32x4*)(xin + (size_t)m * D) + F.lane;
        f32x4 v[4]; float s = 0.f;
#pragma unroll
        for (int j = 0; j < 4; ++j) { v[j] = xr[64 * j]; s += (v[j].x * v[j].x + v[j].y * v[j].y) + (v[j].z * v[j].z + v[j].w * v[j].w); }
        const float rstd = 1.0f / sqrtf(wave_sum(s) * (1.f / D) + NORM_EPS);
        if (xcopy) { GAS f32x4* xo = (GAS f32x4*)(xcopy + (size_t)m * D) + F.lane;
#pragma unroll
            for (int j = 0; j < 4; ++j) xo[64 * j] = v[j]; }
        GAS v2u* o8 = (GAS v2u*)(xn + (size_t)m * D) + F.lane;
#pragma unroll
        for (int j = 0; j < 4; ++j) { const f32x4 y = v[j] * rstd * gv[j]; v2u w; w.x = pk2(y.x, y.y); w.y = pk2(y.z, y.w); o8[64 * j] = w; }
    }
}

using pg8::Unit; using pg8::cvt_pk_bf16;
__device__ __forceinline__ v4u pack8(const f32x4& a, const f32x4& b) { v4u w; w.x = cvt_pk_bf16(a[0], a[1]); w.y = cvt_pk_bf16(a[2], a[3]); w.z = cvt_pk_bf16(b[0], b[1]); w.w = cvt_pk_bf16(b[2], b[3]); return w; }
__device__ __forceinline__ void unpack8(const v4u& w, f32x4& a, f32x4& b) { a = (f32x4){bflo(w.x), bfhi(w.x), bflo(w.y), bfhi(w.y)}; b = (f32x4){bflo(w.z), bfhi(w.z), bflo(w.w), bfhi(w.w)}; }
__device__ __forceinline__ float logf_gate(float z, float la, float lc) {
    const float ls = fminf(z, 0.f) - __logf(1.0f + __expf(-fabsf(z)));
    const float b = lc + ls, mx = fmaxf(la, b), r = mx + __logf(1.0f + __expf(-fabsf(la - b)));
    return fmaxf(r, LOGF_MIN);
}
struct EpiInA {
    static constexpr bool PERM = false, AFTER_DRAIN = false;
    bf16* PA; const float* cosT; const float* sinT; const float* lbt;
    __device__ __forceinline__ void operator()(const f32x4 (&acc)[2][2][4][2], const Unit& u, int wr, int wc, int fr, int fq) const {
        const int pn = u.pn, row0 = u.pm * 256 + wr * 64 + fr;
#pragma unroll
        for (int bj = 0; bj < 2; ++bj) {
            int mode = 0; float sc = 1.f; int lbo = 0;
            if (pn < 2) { mode = 1; sc = QSCALE; } else if (pn == 2) { mode = (bj == 0) ? 1 : 0; } else if (pn < 5) mode = 2;
            else if (pn < 7) { mode = 3; lbo = (pn - 5) * 256; } else if (pn < 9) { mode = 3; lbo = 1024 + (pn - 7) * 256; } else if (pn < 11) mode = 0; else mode = 2;
            if (mode == 1) {
                const int hb = 256 * pn + 128 * bj + 64 * (wc >> 1), d0 = 16 * (wc & 1) + 4 * fq;
#pragma unroll
                for (int ai = 0; ai < 2; ++ai)
#pragma unroll
                    for (int m = 0; m < 4; ++m) { const int r = row0 + 128 * ai + 16 * m, pos = r & (SEQ - 1);
                        const f32x4 cs = *(const f32x4*)(cosT + pos * 32 + d0), sn = *(const f32x4*)(sinT + pos * 32 + d0);
                        const f32x4 x1 = acc[ai][bj][m][0], x2 = acc[ai][bj][m][1];
                        const f32x4 o1 = (x1 * cs - x2 * sn) * sc, o2 = (x2 * cs + x1 * sn) * sc;
                        bf16* rp = PA + (size_t)r * NPA + hb + d0;
                        v2u w1; w1.x = cvt_pk_bf16(o1[0], o1[1]); w1.y = cvt_pk_bf16(o1[2], o1[3]); *(v2u*)rp = w1;
                        v2u w2; w2.x = cvt_pk_bf16(o2[0], o2[1]); w2.y = cvt_pk_bf16(o2[2], o2[3]); *(v2u*)(rp + 32) = w2; asm volatile("" ::: "memory"); }
            } else {
                const int c0 = 256 * pn + 128 * bj + 32 * wc + 8 * fq;
                if (mode == 3) {
                    const float* lp = lbt + lbo + 128 * bj + 32 * wc + 8 * fq;
#pragma unroll
                    for (int n = 0; n < 2; ++n) { const f32x4 la = *(const f32x4*)(lp + 4 * n), lc = *(const f32x4*)(lp + 512 + 4 * n);
#pragma unroll
                        for (int ai = 0; ai < 2; ++ai)
#pragma unroll
                            for (int m = 0; m < 4; ++m) { const int r = row0 + 128 * ai + 16 * m; bf16* rp = PA + (size_t)r * NPA + c0 + 4 * n;
                                const f32x4 v = acc[ai][bj][m][n]; h16x4 hv;
#pragma unroll
                                for (int j = 0; j < 4; ++j) hv[j] = (_Float16)logf_gate(v[j], la[j], lc[j]);
                                *(h16x4*)rp = hv; asm volatile("" ::: "memory"); } }
                } else {
#pragma unroll
                    for (int ai = 0; ai < 2; ++ai)
#pragma unroll
                        for (int m = 0; m < 4; ++m) { const int r = row0 + 128 * ai + 16 * m; bf16* rp = PA + (size_t)r * NPA + c0;
                            f32x4 v0 = acc[ai][bj][m][0], v1 = acc[ai][bj][m][1];
                            if (mode == 2) {
#pragma unroll
                                for (int j = 0; j < 4; ++j) { v0[j] = siluf_(v0[j]); v1[j] = siluf_(v1[j]); } }
                            *(v4u*)rp = pack8(v0, v1); asm volatile("" ::: "memory"); }
                }
            }
        }
    }
};
struct EpiGate {
    static constexpr bool PERM = false, AFTER_DRAIN = false;
    bf16* O;
    __device__ __forceinline__ void operator()(const f32x4 (&acc)[2][2][4][2], const Unit& u, int wr, int wc, int fr, int fq) const {
        const int row0 = u.pm * 256 + wr * 64 + fr, c0 = 256 * u.pn + 32 * wc + 8 * fq;
#pragma unroll
        for (int ai = 0; ai < 2; ++ai)
#pragma unroll
            for (int m = 0; m < 4; ++m) { bf16* rp = O + (size_t)(row0 + 128 * ai + 16 * m) * NGATE + c0;
#pragma unroll
                for (int bj = 0; bj < 2; ++bj) { f32x4 v0 = acc[ai][bj][m][0], v1 = acc[ai][bj][m][1];
#if !defined(CK_PLAIN)
#pragma unroll
                    for (int j = 0; j < 4; ++j) { v0[j] = sigmoidf_(v0[j]); v1[j] = sigmoidf_(v1[j]); }
#endif
                    *(v4u*)(rp + 128 * bj) = pack8(v0, v1); } }
    }
};
struct EpiUpA {
    static constexpr bool PERM = false, AFTER_DRAIN = false;
    bf16* MG; const bf16* GT;
    __device__ __forceinline__ void operator()(const f32x4 (&acc)[2][2][4][2], const Unit& u, int wr, int wc, int fr, int fq) const {
        const int row0 = u.pm * 256 + wr * 64 + fr, c0 = 256 * u.pn + 32 * wc + 8 * fq;
#pragma unroll
        for (int ai = 0; ai < 2; ++ai)
#pragma unroll
            for (int m = 0; m < 4; ++m) { const int r = row0 + 128 * ai + 16 * m; bf16* rp = MG + (size_t)r * D + c0; const bf16* gp = GT + (size_t)r * NGATE + c0;
#pragma unroll
                for (int bj = 0; bj < 2; ++bj) { f32x4 g0, g1; unpack8(*(const v4u*)(gp + 128 * bj), g0, g1);
                    *(v4u*)(rp + 128 * bj) = pack8(acc[ai][bj][m][0] * g0, acc[ai][bj][m][1] * g1); } asm volatile("" ::: "memory"); }
    }
};
struct EpiUpB {
    static constexpr bool PERM = false, AFTER_DRAIN = false;
    bf16* MG; const bf16* GT; const float* ssq;
    __device__ __forceinline__ void operator()(const f32x4 (&acc)[2][2][4][2], const Unit& u, int wr, int wc, int fr, int fq) const {
        const int row0 = u.pm * 256 + wr * 64 + fr, c0 = 256 * u.pn + 32 * wc + 8 * fq;
#pragma unroll
        for (int ai = 0; ai < 2; ++ai)
#pragma unroll
            for (int m = 0; m < 4; ++m) { const int r = row0 + 128 * ai + 16 * m; bf16* rp = MG + (size_t)r * D + c0; const bf16* gp = GT + (size_t)r * NGATE + 1024 + c0;
                const f32x4 sq = *(const f32x4*)(ssq + (size_t)r * 4); const float rstd = 1.0f / sqrtf(((sq[0] + sq[1]) + (sq[2] + sq[3])) * (1.f / 512.f) + NORM_EPS);
#pragma unroll
                for (int bj = 0; bj < 2; ++bj) { f32x4 g0, g1, p0, p1; unpack8(*(const v4u*)(gp + 128 * bj), g0, g1); unpack8(*(const v4u*)(rp + 128 * bj), p0, p1);
                    *(v4u*)(rp + 128 * bj) = pack8(p0 + acc[ai][bj][m][0] * g0 * rstd, p1 + acc[ai][bj][m][1] * g1 * rstd); } asm volatile("" ::: "memory"); }
    }
};
struct EpiOut {
    static constexpr bool PERM = false, AFTER_DRAIN = false;
    float* X;
    __device__ __forceinline__ void operator()(const f32x4 (&acc)[2][2][4][2], const Unit& u, int wr, int wc, int fr, int fq) const {
        const int row0 = u.pm * 256 + wr * 64 + fr, c0 = 256 * u.pn + 32 * wc + 8 * fq;
#pragma unroll
        for (int ai = 0; ai < 2; ++ai)
#pragma unroll
            for (int m = 0; m < 4; ++m) { float* rp = X + (size_t)(row0 + 128 * ai + 16 * m) * D + c0;
#pragma unroll
                for (int bj = 0; bj < 2; ++bj) { f32x4* p = (f32x4*)(rp + 128 * bj); const f32x4 a = p[0], b = p[1]; p[0] = a + acc[ai][bj][m][0]; p[1] = b + acc[ai][bj][m][1]; } asm volatile("" ::: "memory"); }
    }
};
struct EpiAct {
    static constexpr bool PERM = false, AFTER_DRAIN = false;
    bf16* ACT;
    __device__ __forceinline__ void operator()(const f32x4 (&acc)[2][2][4][2], const Unit& u, int wr, int wc, int fr, int fq) const {
        const int row0 = u.pm * 256 + wr * 64 + fr, c0 = 128 * u.pn + 16 * wc + 4 * fq;
#pragma unroll
        for (int ai = 0; ai < 2; ++ai)
#pragma unroll
            for (int m = 0; m < 4; ++m) { bf16* rp = ACT + (size_t)(row0 + 128 * ai + 16 * m) * DEXP + c0;
#pragma unroll
                for (int bj = 0; bj < 2; ++bj) { const f32x4 g = acc[ai][bj][m][0], up = acc[ai][bj][m][1]; f32x4 a;
#pragma unroll
                    for (int j = 0; j < 4; ++j) a[j] = siluf_(g[j]) * up[j];
                    v2u w; w.x = cvt_pk_bf16(a[0], a[1]); w.y = cvt_pk_bf16(a[2], a[3]); *(v2u*)(rp + 64 * bj) = w; } }
    }
};
struct EpiY {
    static constexpr bool PERM = false, AFTER_DRAIN = false;
    bf16* Y;
    __device__ __forceinline__ void operator()(const f32x4 (&acc)[2][2][4][2], const Unit& u, int wr, int wc, int fr, int fq) const {
        const int row0 = u.pm * 256 + wr * 64 + fr, c0 = 256 * u.pn + 32 * wc + 8 * fq;
#pragma unroll
        for (int ai = 0; ai < 2; ++ai)
#pragma unroll
            for (int m = 0; m < 4; ++m) { bf16* rp = Y + (size_t)(row0 + 128 * ai + 16 * m) * D + c0;
#pragma unroll
                for (int bj = 0; bj < 2; ++bj) *(v4u*)(rp + 128 * bj) = pack8(acc[ai][bj][m][0], acc[ai][bj][m][1]); }
    }
};

constexpr int HIST_OFF = MISC_OFF + 256;
constexpr int SBASE_OFF = HIST_OFF + 128;
constexpr int STOT_OFF = SBASE_OFF + 128;
static_assert(STOT_OFF + 128 <= LDS_BYTES, "LDS misc");

__device__ __forceinline__ void phase_norm_route(Frame& F, const Args& A, int l) {
    const int gw = F.vcu * NWAVES + F.wave, NGW = F.G * NWAVES, lane = F.lane;
    LAS f32x4* Wre = (LAS f32x4*)(F.lds + RING_OFF);
    volatile LAS int* hist = (volatile LAS int*)(F.lds + HIST_OFF);
    const float* w_re = A.in[I_WRE] + (size_t)l * NGRP * D * EPG;
    const float* w_rg = A.in[I_WRG] + (size_t)l * D * NGRP;
    const float* b_rg = A.in[I_BRG] + l * NGRP;
    const float* b_re = A.in[I_BRE] + l * NGRP * EPG;
    const float* gf = A.in[I_FNG] + (size_t)l * D;
    for (int idx = F.tid; idx < NGRP * D; idx += NWAVES * 64) { const int g = idx >> 10, i = idx & 1023, li = (i & 255) >> 2, jj = 4 * (i >> 8) + (i & 3);
        const f32x4 a = *(const f32x4*)(w_re + (size_t)idx * 8), b = *(const f32x4*)(w_re + (size_t)idx * 8 + 4);
        Wre[((g * 2 + 0) * 16 + jj) * 64 + li] = a; Wre[((g * 2 + 1) * 16 + jj) * 64 + li] = b; }
    if (F.tid < 32) hist[F.tid] = 0;
    f32x4 wgr[16], gv[4];
#pragma unroll
    for (int j = 0; j < 4; ++j) { gv[j] = *(const f32x4*)(gf + 4 * lane + 256 * j);
#pragma unroll
        for (int c = 0; c < 4; ++c) wgr[4 * j + c] = *(const f32x4*)(w_rg + (size_t)(4 * lane + 256 * j + c) * 4); }
    f32x4 brg = *(const f32x4*)b_rg;
    __syncthreads();
    float* X = F.out; bf16* XN = (bf16*)(F.ws + WS_XN);
    int* tok_e = (int*)(F.ws + WS_TOKE); float* tok_w = (float*)(F.ws + WS_TOKW); int* tok_r = (int*)(F.ws + WS_TOKR);
    for (int m = gw; m < T; m += NGW) {
        const GAS f32x4* xr = (const GAS f32x4*)(X + (size_t)m * D) + lane;
        f32x4 v[4]; float s = 0.f;
#pragma unroll
        for (int j = 0; j < 4; ++j) { v[j] = xr[64 * j]; s += (v[j].x * v[j].x + v[j].y * v[j].y) + (v[j].z * v[j].z + v[j].w * v[j].w); }
        const float rstd = 1.0f / sqrtf(wave_sum(s) * (1.f / D) + NORM_EPS);
        GAS v2u* o8 = (GAS v2u*)(XN + (size_t)m * D) + lane;
        f32x4 ga = (f32x4){0.f, 0.f, 0.f, 0.f};
#pragma unroll
        for (int j = 0; j < 4; ++j) { v[j] = v[j] * rstd * gv[j]; v2u w; w.x = pk2(v[j].x, v[j].y); w.y = pk2(v[j].z, v[j].w); o8[64 * j] = w;
            ga += wgr[4 * j + 0] * v[j].x; ga += wgr[4 * j + 1] * v[j].y; ga += wgr[4 * j + 2] * v[j].z; ga += wgr[4 * j + 3] * v[j].w; }
        float gl[4];
#pragma unroll
        for (int k = 0; k < 4; ++k) gl[k] = wave_sum(ga[k]) + brg[k];
        int gt = 0; float gm = gl[0];
#pragma unroll
        for (int k = 1; k < 4; ++k) if (gl[k] > gm) { gm = gl[k]; gt = k; }
        float gden = 0.f;
#pragma unroll
        for (int k = 0; k < 4; ++k) gden += expf(gl[k] - gm);
        const float p_top = 1.0f / gden;
        gt = __builtin_amdgcn_readfirstlane(gt);
        f32x4 a0 = (f32x4){0.f, 0.f, 0.f, 0.f}, a1 = a0;
        const LAS f32x4* w0 = Wre + ((gt * 2 + 0) * 16) * 64 + lane; const LAS f32x4* w1 = Wre + ((gt * 2 + 1) * 16) * 64 + lane;
#pragma unroll
        for (int j = 0; j < 4; ++j) {
            a0 += w0[(4 * j + 0) * 64] * v[j].x; a1 += w1[(4 * j + 0) * 64] * v[j].x;
            a0 += w0[(4 * j + 1) * 64] * v[j].y; a1 += w1[(4 * j + 1) * 64] * v[j].y;
            a0 += w0[(4 * j + 2) * 64] * v[j].z; a1 += w1[(4 * j + 2) * 64] * v[j].z;
            a0 += w0[(4 * j + 3) * 64] * v[j].w; a1 += w1[(4 * j + 3) * 64] * v[j].w; }
        float el[8];
#pragma unroll
        for (int k = 0; k < 4; ++k) { el[k] = wave_sum(a0[k]) + b_re[gt * 8 + k]; el[4 + k] = wave_sum(a1[k]) + b_re[gt * 8 + 4 + k]; }
        int i1 = 0; float m1 = el[0];
#pragma unroll
        for (int k = 1; k < 8; ++k) if (el[k] > m1) { m1 = el[k]; i1 = k; }
        int i2 = -1; float m2 = -3.0e38f;
#pragma unroll
        for (int k = 0; k < 8; ++k) if (k != i1 && el[k] > m2) { m2 = el[k]; i2 = k; }
        const float q1 = 1.0f, q2 = expf(m2 - m1);
        const float wn1 = p_top * q1 / (q1 + q2), wn2 = p_top * q2 / (q1 + q2);
        if (lane == 0) {
            const int e1 = gt * 8 + i1, e2 = gt * 8 + i2;
            const int r1 = __hip_atomic_fetch_add((LAS int*)hist + e1, 1, __ATOMIC_RELAXED, __HIP_MEMORY_SCOPE_WORKGROUP);
            const int r2 = __hip_atomic_fetch_add((LAS int*)hist + e2, 1, __ATOMIC_RELAXED, __HIP_MEMORY_SCOPE_WORKGROUP);
            tok_e[2 * m] = e1; tok_e[2 * m + 1] = e2; tok_w[2 * m] = wn1; tok_w[2 * m + 1] = wn2; tok_r[2 * m] = r1; tok_r[2 * m + 1] = r2;
        }
    }
    __syncthreads();
    if (F.tid < 32) ((int*)(F.ws + WS_WGCNT))[blockIdx.x * 32 + F.tid] = hist[F.tid];
}
__device__ __forceinline__ void phase_dispatch(Frame& F) {
    const int gw = F.vcu * NWAVES + F.wave, NGW = F.G * NWAVES, lane = F.lane;
    volatile LAS int* sbase = (volatile LAS int*)(F.lds + SBASE_OFF); volatile LAS int* stot = (volatile LAS int*)(F.lds + STOT_OFF);
    const int* wgcnt = (const int*)(F.ws + WS_WGCNT); int* meta = (int*)(F.ws + WS_META);
    if (F.tid < 32) { int tot = 0, base = 0; for (int w = 0; w < F.G; ++w) { const int c = wgcnt[w * 32 + F.tid]; tot += c; if (w < (int)blockIdx.x) base += c; } stot[F.tid] = tot; sbase[F.tid] = base; }
    __syncthreads();
    if (F.tid == 0) { int run = 0, nrt = 0;
        for (int e = 0; e < NEXP; ++e) { const int nt = (stot[e] + 255) >> 8; sbase[e] = sbase[e] + run;
            if (blockIdx.x == 0) for (int k = 0; k < nt; ++k) meta[1 + nrt + k] = e;
            nrt += nt; run += nt * 256; }
        if (blockIdx.x == 0) meta[0] = nrt; }
    __syncthreads();
    const int* tok_e = (const int*)(F.ws + WS_TOKE); const int* tok_r = (const int*)(F.ws + WS_TOKR); int* tok_p = (int*)(F.ws + WS_TOKP);
    const bf16* XN = (const bf16*)(F.ws + WS_XN); bf16* XP = (bf16*)(F.ws + WS_XP);
    for (int m = gw; m < T; m += NGW) {
        const int e1 = tok_e[2 * m], e2 = tok_e[2 * m + 1];
        const int p1 = sbase[e1] + tok_r[2 * m], p2 = sbase[e2] + tok_r[2 * m + 1];
        if (lane == 0) { tok_p[2 * m] = p1; tok_p[2 * m + 1] = p2; }
        const GAS v4u* src = (const GAS v4u*)(XN + (size_t)m * D) + lane; const v4u a = src[0], b = src[64];
        GAS v4u* d1 = (GAS v4u*)(XP + (size_t)p1 * D) + lane; d1[0] = a; d1[64] = b;
        GAS v4u* d2 = (GAS v4u*)(XP + (size_t)p2 * D) + lane; d2[0] = a; d2[64] = b;
    }
}
__device__ __forceinline__ void phase_combine(Frame& F, const float* g, bool last) {
    const int gw = F.vcu * NWAVES + F.wave, NGW = F.G * NWAVES, lane = F.lane;
    const int* tok_p = (const int*)(F.ws + WS_TOKP); const float* tok_w = (const float*)(F.ws + WS_TOKW);
    const bf16* Y = (const bf16*)(F.ws + WS_XP); bf16* XN = (bf16*)(F.ws + WS_XN); float* X = F.out;
    f32x4 gv[4];
#pragma unroll
    for (int j = 0; j < 4; ++j) gv[j] = *(const f32x4*)(g + 4 * lane + 256 * j);
    for (int m = gw; m < T; m += NGW) {
        const int p1 = tok_p[2 * m], p2 = tok_p[2 * m + 1]; const float w1 = tok_w[2 * m], w2 = tok_w[2 * m + 1];
        GAS f32x4* xr = (GAS f32x4*)(X + (size_t)m * D) + lane;
        const GAS v2u* y1 = (const GAS v2u*)(Y + (size_t)p1 * D) + lane; const GAS v2u* y2 = (const GAS v2u*)(Y + (size_t)p2 * D) + lane;
        f32x4 v[4]; float s = 0.f;
#pragma unroll
        for (int j = 0; j < 4; ++j) { const v2u a = y1[64 * j], b = y2[64 * j];
            const f32x4 ya = (f32x4){bflo(a.x), bfhi(a.x), bflo(a.y), bfhi(a.y)}, yb = (f32x4){bflo(b.x), bfhi(b.x), bflo(b.y), bfhi(b.y)};
#if defined(ABL_NOMOE)
            v[j] = xr[64 * j] + (ya * w1 + yb * w2) * 0.0f;
#else
            v[j] = xr[64 * j] + (ya * w1 + yb * w2);
#endif
            s += (v[j].x * v[j].x + v[j].y * v[j].y) + (v[j].z * v[j].z + v[j].w * v[j].w); }
        const float rstd = 1.0f / sqrtf(wave_sum(s) * (1.f / D) + NORM_EPS);
        if (last) {
#pragma unroll
            for (int j = 0; j < 4; ++j) xr[64 * j] = v[j] * rstd * gv[j];
        } else {
            GAS v2u* o8 = (GAS v2u*)(XN + (size_t)m * D) + lane;
#pragma unroll
            for (int j = 0; j < 4; ++j) { xr[64 * j] = v[j]; const f32x4 y = v[j] * rstd * gv[j]; v2u w; w.x = pk2(y.x, y.y); w.y = pk2(y.z, y.w); o8[64 * j] = w; }
        }
    }
}

#if defined(ORACLE)
__global__ void __launch_bounds__(256) simple_attn(const bf16* PA, const float* sink, bf16* YA) {
    const int lane = threadIdx.x & 63, task = blockIdx.x * 4 + (threadIdx.x >> 6);
    const int m = task >> 3, qh = task & 7, kvh = qh >> 2, b = m / SEQ, t = m % SEQ;
    float q[64];
    { const bf16* qp = PA + (size_t)m * NPA + C_QA + 64 * qh;
#pragma unroll
      for (int d = 0; d < 64; ++d) q[d] = bf2f(qp[d]); }
    float s[5]; float mx = sink[qh] * LOG2E;
#pragma unroll
    for (int r = 0; r < 5; ++r) { const int j = t - WINDOW + 64 * r + lane; const bool ok = (j >= 0) && (j < SEQ) && (j <= t + WINDOW);
        float a = -3.0e38f;
        if (ok) { const bf16* kp = PA + (size_t)(b * SEQ + j) * NPA + C_KA + 64 * kvh; a = 0.f;
#pragma unroll
            for (int d = 0; d < 64; ++d) a += q[d] * bf2f(kp[d]); }
        s[r] = a; mx = fmaxf(mx, a); }
#pragma unroll
    for (int o = 1; o < 64; o <<= 1) mx = fmaxf(mx, __shfl_xor(mx, o));
    float den = 0.f;
#pragma unroll
    for (int r = 0; r < 5; ++r) { s[r] = (s[r] > -1.0e38f) ? exp2f(s[r] - mx) : 0.f; den += s[r]; }
    den = wave_sum(den) + exp2f(sink[qh] * LOG2E - mx);
    float o = 0.f;
    for (int r = 0; r < 5; ++r) for (int jj = 0; jj < 64; ++jj) { const int j = t - WINDOW + 64 * r + jj; const float p = __shfl(s[r], jj);
        if (j >= 0 && j < SEQ && j <= t + WINDOW) o += p * bf2f(PA[(size_t)(b * SEQ + j) * NPA + C_VA + 64 * kvh + lane]); }
#if defined(ABL_NOATTN)
    YA[(size_t)m * 512 + 64 * qh + lane] = 0;
#else
    YA[(size_t)m * 512 + 64 * qh + lane] = (bf16)f2bf(o / den);
#endif
}
__global__ void __launch_bounds__(512) simple_hgrn(const bf16* PA, const float* hng, float* obuf, bf16* YH, float* ssq) {
    __shared__ float part[32][4][128];
    const int tid = threadIdx.x, e = tid & 127, dq = tid >> 7, b = blockIdx.x >> 2, h = blockIdx.x & 3;
    for (int dir = 0; dir < 2; ++dir) {
        float S[32];
#pragma unroll
        for (int d = 0; d < 32; ++d) S[d] = 0.f;
        for (int t0 = 0; t0 < SEQ; t0 += 32) {
            for (int tt = 0; tt < 32; ++tt) { const int t = dir ? (SEQ - 1 - (t0 + tt)) : (t0 + tt); const bf16* row = PA + (size_t)(b * SEQ + t) * NPA;
                const float v = bf2f(row[C_VH + 128 * h + e]); const _Float16* lf = (const _Float16*)(row + (dir ? C_LB : C_LF) + 128 * h + 32 * dq); const bf16* qp = row + C_QH + 128 * h + 32 * dq;
                float o = 0.f;
#pragma unroll
                for (int d = 0; d < 32; ++d) { const float l = (float)lf[d], f = expf(l), k = -expm1f(l); S[d] = f * S[d] + k * v; o += S[d] * bf2f(qp[d]); }
                part[tt][dq][e] = o; }
            __syncthreads();
            for (int idx = tid; idx < 32 * 128; idx += 512) { const int tt = idx >> 7, ee = idx & 127; const int t = dir ? (SEQ - 1 - (t0 + tt)) : (t0 + tt); const size_t m = (size_t)b * SEQ + t;
                float o = (part[tt][0][ee] + part[tt][1][ee]) + (part[tt][2][ee] + part[tt][3][ee]);
                if (dir == 0) obuf[m * 512 + 128 * h + ee] = o;
                else { o += obuf[m * 512 + 128 * h + ee];
                    const float sg = bf2f(PA[m * NPA + C_SG + 128 * h + ee]);
#if defined(ABL_NOHGRN)
                    YH[m * 512 + 128 * h + ee] = 0;
#else
                    YH[m * 512 + 128 * h + ee] = (bf16)f2bf(o * hng[128 * h + ee] * sg);
#endif

                    const float q = wave_sum(o * o);
                    if ((tid & 63) == 0) atomicAdd(&ssq[m * 4 + h], q); } }
            __syncthreads();
        }
    }
}
__global__ void zero_f32(float* p, int n) { const int i = blockIdx.x * blockDim.x + threadIdx.x; if (i < n) p[i] = 0.f; }
#endif

#if defined(CHECK)
#define CK_NS 48
__device__ __forceinline__ int ck_row(int s) { return (int)(((long)s * 10007 + 77) % T); }
__device__ __forceinline__ bool ck_cmp(float got, float ref, float rtol, float atol, unsigned* cnt) { const float d = fabsf(got - ref); if (!(d <= rtol * fabsf(ref) + atol)) { atomicAdd(cnt, 1u); return true; } return false; }
__global__ void ck_norm(const float* x, const float* g, const bf16* XN, unsigned* cnt) {
    const int m = ck_row(blockIdx.x); __shared__ float red[256];
    float s = 0.f; for (int c = threadIdx.x; c < D; c += 256) { const float v = x[(size_t)m * D + c]; s += v * v; }
    red[threadIdx.x] = s; __syncthreads(); for (int o = 128; o > 0; o >>= 1) { if (threadIdx.x < o) red[threadIdx.x] += red[threadIdx.x + o]; __syncthreads(); }
    const float rstd = 1.0f / sqrtf(red[0] / D + NORM_EPS);
    for (int c = threadIdx.x; c < D; c += 256) ck_cmp(bf2f(XN[(size_t)m * D + c]), x[(size_t)m * D + c] * rstd * g[c], 0.01f, 0.01f, cnt);
}
__global__ void ck_pa(const bf16* XN, const float* w_in, const float* lb_tab  , int l, const bf16* PA, unsigned* cnt) {
    const int m = ck_row(blockIdx.x), pos = m % SEQ; __shared__ float z[NPA]; __shared__ float xr[D];
    for (int c = threadIdx.x; c < D; c += 256) xr[c] = bf2f(XN[(size_t)m * D + c]);
    __syncthreads();
    for (int c = threadIdx.x; c < NPA; c += 256) { float a = 0.f; for (int k = 0; k < D; ++k) a += xr[k] * w_in[(size_t)k * INW + c]; z[c] = a; }
    __syncthreads();
    for (int c = threadIdx.x; c < NPA; c += 256) {
        const float got_b = bf2f(PA[(size_t)m * NPA + c]); const float got_h = (float)((const _Float16*)PA)[(size_t)m * NPA + c];
        if (c < C_VA) { const int d = c & 63, i = d & 31; const double inv = exp2(-(double)i * (13.287712379549449 / 32.0)); const float cs = (float)cos((double)pos * inv), sn = (float)sin((double)pos * inv);
            const float x1 = z[(c & ~63) + i], x2 = z[(c & ~63) + i + 32]; float r = (d < 32) ? (x1 * cs - x2 * sn) : (x2 * cs + x1 * sn); if (c < C_KA) r *= QSCALE;
            ck_cmp(got_b, r, 0.02f, 0.03f, cnt + 0);
        } else if (c < C_QH) ck_cmp(got_b, z[c], 0.02f, 0.02f, cnt + 1);
        else if (c < C_LF) ck_cmp(got_b, z[c] / (1.f + expf(-z[c])), 0.02f, 0.02f, cnt + 2);
        else if (c < C_VH) { const int dir = (c >= C_LB), col = c - (dir ? C_LB : C_LF);
            float t0 = lb_tab[(0 * 2 + dir) * 512 + col], t1 = lb_tab[(1 * 2 + dir) * 512 + col]; const float mx = fmaxf(t0, t1); t0 = expf(t0 - mx); t1 = expf(t1 - mx);
            const float lb = (l == 0) ? 0.f : t1 / (t0 + t1); const float sg = 1.f / (1.f + expf(-z[c])); const float r = fmaxf(logf(lb + (1.f - lb) * sg), LOGF_MIN);
            ck_cmp(got_h, r, 0.01f, 0.02f, cnt + 3);
        } else if (c < C_SG) ck_cmp(got_b, z[c], 0.02f, 0.02f, cnt + 4);
        else ck_cmp(got_b, z[c] / (1.f + expf(-z[c])), 0.02f, 0.02f, cnt + 5);
    }
}
__global__ void ck_mix(const bf16* XN, const float* w_in, const bf16* YA, const bf16* YH, const float* ssq, const float* wua, const float* wuh, const bf16* GT, const bf16* MG, int which, unsigned* cnt) {
#ifndef CK_SHIFT
#define CK_SHIFT 0
#endif
    const int m = ck_row((blockIdx.x + CK_SHIFT) % CK_NS); __shared__ float xr[D]; __shared__ float ya[512]; __shared__ float yh[512];
    for (int c = threadIdx.x; c < D; c += 256) xr[c] = bf2f(XN[(size_t)m * D + c]);
    for (int c = threadIdx.x; c < 512; c += 256) { ya[c] = bf2f(YA[(size_t)m * 512 + c]); yh[c] = bf2f(YH[(size_t)m * 512 + c]); }
    __syncthreads();
    const float rstd = 1.0f / sqrtf((ssq[m * 4] + ssq[m * 4 + 1] + ssq[m * 4 + 2] + ssq[m * 4 + 3]) / 512.f + NORM_EPS);
    for (int c = threadIdx.x; c < D; c += 256) { float a = 0.f, b = 0.f, p = 0.f, q = 0.f;
        for (int k = 0; k < D; ++k) { a += xr[k] * w_in[(size_t)k * INW + NPA + c]; b += xr[k] * w_in[(size_t)k * INW + NPA + 1024 + c]; }
        for (int k = 0; k < 512; ++k) { p += ya[k] * wua[(size_t)k * D + c]; q += yh[k] * wuh[(size_t)k * D + c]; }
        float ga = 1.f / (1.f + expf(-a)), gb = 1.f / (1.f + expf(-b));
        if (which != 0) { ga = bf2f(GT[(size_t)m * NGATE + c]); gb = bf2f(GT[(size_t)m * NGATE + 1024 + c]); }
        if (which == 0) { unsigned* dbg = cnt + 100; if (blockIdx.x == 27) { const float e0 = fabsf(bf2f(GT[(size_t)m * NGATE + c]) - ga), e1 = fabsf(bf2f(GT[(size_t)m * NGATE + 1024 + c]) - gb); atomicMax(dbg + 200, __float_as_uint(e0)); atomicMax(dbg + 200, __float_as_uint(e1)); atomicMax(dbg + 201, __float_as_uint(fabsf(a))); atomicMax(dbg + 201, __float_as_uint(fabsf(b))); if (GT[(size_t)m * NGATE + c] == 0xFFFFu) atomicAdd(dbg + 203, 1u); if (GT[(size_t)m * NGATE + 1024 + c] == 0xFFFFu) atomicAdd(dbg + 203, 1u); if (e0 > 0.2f) { atomicAdd(dbg + 202, 1u); atomicOr(dbg + 210 + (c >> 11), 0u); atomicAdd(dbg + 300 + (c >> 6), 1u); } if (e1 > 0.2f) { atomicAdd(dbg + 202, 1u); atomicAdd(dbg + 300 + 16 + (c >> 6), 1u); } } if (ck_cmp(bf2f(GT[(size_t)m * NGATE + c]), ga, 0.01f, 0.01f, cnt + 0)) { atomicAdd(dbg + blockIdx.x, 1u); atomicAdd(dbg + 64 + (c >> 5), 1u); } if (ck_cmp(bf2f(GT[(size_t)m * NGATE + 1024 + c]), gb, 0.01f, 0.01f, cnt + 0)) { atomicAdd(dbg + blockIdx.x, 1u); atomicAdd(dbg + 64 + 32 + (c >> 5), 1u); } }
        else if (which == 1) ck_cmp(bf2f(MG[(size_t)m * D + c]), ga * p, 0.03f, 0.01f, cnt + 1);
        else ck_cmp(bf2f(MG[(size_t)m * D + c]), ga * p + gb * rstd * q, 0.03f, 0.02f, cnt + 2); }
}
__global__ void ck_out(const float* xprev, const bf16* MG, const float* wout, const float* X, unsigned* cnt) {
    const int m = ck_row(blockIdx.x); __shared__ float mg[D];
    for (int c = threadIdx.x; c < D; c += 256) mg[c] = bf2f(MG[(size_t)m * D + c]);
    __syncthreads();
    for (int c = threadIdx.x; c < D; c += 256) { float a = 0.f; for (int k = 0; k < D; ++k) a += mg[k] * wout[(size_t)k * D + c]; ck_cmp(X[(size_t)m * D + c], xprev[(size_t)m * D + c] + a, 0.01f, 0.02f, cnt); }
}
__global__ void ck_moe(const float* X, const float* g, const float* wrg, const float* brg, const float* wre, const float* bre, const float* weg, const float* weu, const float* wed,
                       const bf16* XN, const int* tok_e, const float* tok_w, const int* tok_p, const int* meta, const bf16* XP, const bf16* ACT, const bf16* Y, int stage, unsigned* cnt) {
    const int m = ck_row(blockIdx.x); __shared__ float h[D]; __shared__ float red[256]; __shared__ float lg[36]; __shared__ float act[DEXP];
    float s = 0.f; for (int c = threadIdx.x; c < D; c += 256) { const float v = X[(size_t)m * D + c]; s += v * v; }
    red[threadIdx.x] = s; __syncthreads(); for (int o = 128; o > 0; o >>= 1) { if (threadIdx.x < o) red[threadIdx.x] += red[threadIdx.x + o]; __syncthreads(); }
    const float rstd = 1.0f / sqrtf(red[0] / D + NORM_EPS);
    for (int c = threadIdx.x; c < D; c += 256) h[c] = X[(size_t)m * D + c] * rstd * g[c];
    __syncthreads();
    if (threadIdx.x < 36) { const int t = threadIdx.x; float a = 0.f;
        if (t < 4) { for (int k = 0; k < D; ++k) a += h[k] * wrg[k * 4 + t]; a += brg[t]; } else { const int gg = (t - 4) >> 3, e = (t - 4) & 7; for (int k = 0; k < D; ++k) a += h[k] * wre[((size_t)gg * D + k) * 8 + e]; a += bre[gg * 8 + e]; }
        lg[t] = a; }
    __syncthreads();
    int gt = 0; for (int k = 1; k < 4; ++k) if (lg[k] > lg[gt]) gt = k;
    float gden = 0.f; for (int k = 0; k < 4; ++k) gden += expf(lg[k] - lg[gt]);
    const float* el = lg + 4 + gt * 8; int i1 = 0; for (int k = 1; k < 8; ++k) if (el[k] > el[i1]) i1 = k; int i2 = (i1 == 0) ? 1 : 0; for (int k = 0; k < 8; ++k) if (k != i1 && el[k] > el[i2]) i2 = k;
    const float q2 = expf(el[i2] - el[i1]); const float w1 = (1.f / gden) / (1.f + q2), w2 = (1.f / gden) * q2 / (1.f + q2);
    const int e1 = gt * 8 + i1, e2 = gt * 8 + i2;
    if (stage == 0) { if (threadIdx.x == 0) { if (tok_e[2 * m] != e1 || tok_e[2 * m + 1] != e2) atomicAdd(cnt + 0, 1u); ck_cmp(tok_w[2 * m], w1, 0.01f, 1e-3f, cnt + 1); ck_cmp(tok_w[2 * m + 1], w2, 0.01f, 1e-3f, cnt + 1); } return; }
    for (int kk = 0; kk < 2; ++kk) { const int e = tok_e[2 * m + kk], p = tok_p[2 * m + kk];
        if (stage == 1) { if (threadIdx.x == 0) { const int rt = p >> 8; if (rt >= meta[0] || meta[1 + rt] != e) atomicAdd(cnt + 2, 1u); }
            for (int c = threadIdx.x; c < D; c += 256) if (XP[(size_t)p * D + c] != XN[(size_t)m * D + c]) atomicAdd(cnt + 3, 1u); continue; }
        const float* wg = weg + (size_t)e * D * DEXP; const float* wu = weu + (size_t)e * D * DEXP; const float* wd = wed + (size_t)e * DEXP * D;
        __syncthreads();
        for (int j = threadIdx.x; j < DEXP; j += 256) { float a = 0.f, b = 0.f; for (int k = 0; k < D; ++k) { const float hv = bf2f(XN[(size_t)m * D + k]); a += hv * wg[(size_t)k * DEXP + j]; b += hv * wu[(size_t)k * DEXP + j]; }
            const float r = a / (1.f + expf(-a)) * b; act[j] = r; if (stage == 2) ck_cmp(bf2f(ACT[(size_t)p * DEXP + j]), r, 0.03f, 0.02f, cnt + 4); }
        __syncthreads();
        if (stage == 3) for (int c = threadIdx.x; c < D; c += 256) { float a = 0.f; for (int j = 0; j < DEXP; ++j) a += act[j] * wd[(size_t)j * D + c]; ck_cmp(bf2f(Y[(size_t)p * D + c]), a, 0.03f, 0.03f, cnt + 5); }
    }
}

__global__ void ck_attn(const bf16* PA, const float* sink, const bf16* YA, unsigned* cnt) {
    const int m = ck_row(blockIdx.x), b = m / SEQ, t = m % SEQ; __shared__ float sc[512]; __shared__ float red[256];
    for (int qh = 0; qh < NQH; ++qh) { const int kvh = qh / 4;
        const bf16* qp = PA + (size_t)m * NPA + C_QA + 64 * qh;
        for (int jj = threadIdx.x; jj < 2 * WINDOW + 1; jj += 256) { const int j = t - WINDOW + jj; float a = -1e30f;
            if (j >= 0 && j < SEQ) { a = 0.f; const bf16* kp = PA + (size_t)(b * SEQ + j) * NPA + C_KA + 64 * kvh; for (int d = 0; d < 64; ++d) a += bf2f(qp[d]) * bf2f(kp[d]); a *= 0.6931471805599453f; }
            sc[jj] = a; }
        __syncthreads();
        float mx = sink[qh]; for (int jj = 0; jj < 2 * WINDOW + 1; ++jj) mx = fmaxf(mx, sc[jj]);
        float den = expf(sink[qh] - mx); for (int jj = 0; jj < 2 * WINDOW + 1; ++jj) den += expf(sc[jj] - mx);
        if (threadIdx.x < 64) { const int d = threadIdx.x; float o = 0.f; for (int jj = 0; jj < 2 * WINDOW + 1; ++jj) { const int j = t - WINDOW + jj; if (j >= 0 && j < SEQ) o += expf(sc[jj] - mx) * bf2f(PA[(size_t)(b * SEQ + j) * NPA + C_VA + 64 * kvh + d]); }
            ck_cmp(bf2f(YA[(size_t)m * 512 + 64 * qh + d]), o / den, 0.03f, 0.005f, cnt); }
        __syncthreads(); }
}
__global__ void ck_hgrn(const bf16* PA, const float* hng, const bf16* YH, const float* ssq, unsigned* cnt) {
    const int m = ck_row(blockIdx.x), b = m / SEQ, t = m % SEQ, h = blockIdx.y; __shared__ float wgt[128]; __shared__ float osum[128]; __shared__ float cum[128];
    const int e = threadIdx.x;
    float o = 0.f;
    for (int dir = 0; dir < 2; ++dir) { cum[e] = 0.f; __syncthreads();
        for (int n = 0; n < 768; ++n) { const int s = dir ? t + n : t - n; if (s < 0 || s >= SEQ) break;
            const bf16* row = PA + (size_t)(b * SEQ + s) * NPA; const bf16* rowt = PA + (size_t)m * NPA;
            { const int d = e; const float lf = (float)((const _Float16*)(row + (dir ? C_LB : C_LF) + 128 * h))[d];
              wgt[d] = bf2f(rowt[C_QH + 128 * h + d]) * (-expm1f(lf)) * expf(cum[d]); }
            __syncthreads();
            float w = 0.f; for (int d = 0; d < 128; ++d) w += wgt[d];
            o += w * bf2f(row[C_VH + 128 * h + e]);
            __syncthreads();
            { const int d = e; cum[d] += (float)((const _Float16*)(row + (dir ? C_LB : C_LF) + 128 * h))[d]; }
            __syncthreads(); } }
    osum[e] = o * o; __syncthreads(); for (int k = 64; k > 0; k >>= 1) { if (e < k) osum[e] += osum[e + k]; __syncthreads(); }
    if (e == 0) ck_cmp(ssq[m * 4 + h], osum[0], 0.03f, 1e-3f, cnt + 1);
    const float sg = bf2f(PA[(size_t)m * NPA + C_SG + 128 * h + e]);
    ck_cmp(bf2f(YH[(size_t)m * 512 + 128 * h + e]), o * hng[128 * h + e] * sg, 0.03f, 0.01f, cnt + 0);
}
__global__ void ck_comb(const float* xold, const float* xnew, const int* tok_p, const float* tok_w, const bf16* Y, const float* gfin, int last, unsigned* cnt) {
    const int m = ck_row(blockIdx.x); __shared__ float red[256]; __shared__ float xv[D];
    if (m >= SEQ) return;
    const int p1 = tok_p[2 * m], p2 = tok_p[2 * m + 1]; const float w1 = tok_w[2 * m], w2 = tok_w[2 * m + 1]; float s = 0.f;
    for (int c = threadIdx.x; c < D; c += 256) { const float v = xold[(size_t)m * D + c] + w1 * bf2f(Y[(size_t)p1 * D + c]) + w2 * bf2f(Y[(size_t)p2 * D + c]); xv[c] = v; s += v * v; }
    red[threadIdx.x] = s; __syncthreads(); for (int o = 128; o > 0; o >>= 1) { if (threadIdx.x < o) red[threadIdx.x] += red[threadIdx.x + o]; __syncthreads(); }
    const float rstd = 1.0f / sqrtf(red[0] / D + NORM_EPS);
    for (int c = threadIdx.x; c < D; c += 256) ck_cmp(xnew[(size_t)m * D + c], last ? xv[c] * rstd * gfin[c] : xv[c], 0.005f, 0.005f, cnt);
}

__global__ void ck_gates_full(const bf16* XN, const float* w_in, const bf16* GT, unsigned* st) {
    const int m = blockIdx.x >> 3, pn = blockIdx.x & 7, c = pn * 256 + threadIdx.x; __shared__ float xr[D];
    for (int k = threadIdx.x; k < D; k += 256) xr[k] = bf2f(XN[(size_t)m * D + k]);
    __syncthreads();
    float a = 0.f; for (int k = 0; k < D; ++k) a += xr[k] * w_in[(size_t)k * INW + NPA + c];
#if defined(CK_PLAIN)
    const float ref = a, got = bf2f(GT[(size_t)m * NGATE + c]);
#else
    const float ref = 1.f / (1.f + expf(-a)), got = bf2f(GT[(size_t)m * NGATE + c]);
#endif
    if (m == 8122 && !(fabsf(got - ref) <= 0.05f)) atomicMin(st + 700, (unsigned)c);
    if (m == 8123 && !(fabsf(got - ref) <= 0.05f)) atomicMin(st + 701, (unsigned)c);
    if (m == 8122) { if (c == 130) st[702] = __float_as_uint(got), st[703] = __float_as_uint(ref), st[704] = __float_as_uint(a); if (c == 131) st[705] = __float_as_uint(got), st[706] = __float_as_uint(ref); }
    if (!(fabsf(got - ref) <= 0.05f)) { atomicAdd(st + (m >> 8), 1u); atomicAdd(st + 128 + (m & 255), 1u); atomicAdd(st + 384 + threadIdx.x, 1u); atomicAdd(st + 640 + pn, 1u); }
}
__global__ void ck_flush() { asm volatile("buffer_wbl2 sc0 sc1\n\ts_waitcnt vmcnt(0)\n\tbuffer_inv sc0 sc1\n\ts_waitcnt vmcnt(0)" ::: "memory"); }
#ifndef CK_SKIP
#define CK_SKIP 0ull
#endif
__global__ void ck_report(const unsigned* cnt, int n, float* out) { if (threadIdx.x == 0 && blockIdx.x == 0) {
#if defined(CK_DBG7)
    const unsigned* dbg = cnt + 7 + 100; int nrows = 0, ngrp = 0; unsigned mx = 0, first = 99; for (int i = 0; i < CK_NS; ++i) if (dbg[i]) { ++nrows; mx = dbg[i] > mx ? dbg[i] : mx; } for (int i = 0; i < 64; ++i) if (dbg[64 + i]) { ++ngrp; if (first == 99) first = i; }
    if (CK_DBG7 == 4) { const float me = __uint_as_float(dbg[200]), ma = __uint_as_float(dbg[201]); out[0] = (1.0f + fminf(me, 0.89f) * 10.0f) * powf(10.0f, 5.0f + floorf(fminf(ma, 30.0f))); return; }
    if (CK_DBG7 == 5) { int nl = 0; unsigned mxl = 0; for (int i = 0; i < 32; ++i) if (dbg[300 + i]) { ++nl; mxl = dbg[300 + i] > mxl ? dbg[300 + i] : mxl; } out[0] = (1.0f + 0.1f * (float)nl) * powf(10.0f, 5.0f + (float)(mxl > 30 ? 30 : mxl)); return; }
    if (CK_DBG7 == 7) { out[0] = (1.0f + 0.01f * (float)(dbg[203] % 100)) * powf(10.0f, 5.0f + (float)(dbg[203] / 100)); return; }
    if (CK_DBG7 >= 10) { const unsigned* st = cnt + 512; int npan = 0, nrit = 0, ncol = 0, ntile = 0; unsigned tot = 0, mxp = 0; int firstp = -1, firstr = -1, firstc = -1;
        for (int i = 0; i < 128; ++i) if (st[i]) { ++npan; tot += st[i]; if (st[i] > mxp) mxp = st[i]; if (firstp < 0) firstp = i; }
        for (int i = 0; i < 256; ++i) { if (st[128 + i]) { ++nrit; if (firstr < 0) firstr = i; } if (st[384 + i]) { ++ncol; if (firstc < 0) firstc = i; } }
        for (int i = 0; i < 8; ++i) if (st[640 + i]) ++ntile;
        float a = 0.f, b = 0.f;
        if (CK_DBG7 == 10) { a = (float)npan; b = log10f((float)(tot ? tot : 1)) * 4.0f; }
        if (CK_DBG7 == 11) { a = (float)nrit; b = (float)ncol / 10.0f; }
        if (CK_DBG7 == 12) { a = (float)firstp; b = (float)firstr / 10.0f; }
        if (CK_DBG7 == 13) { a = (float)firstc; b = (float)ntile; }
        if (CK_DBG7 == 22) { out[0] = (1.0f + 8.0f * __uint_as_float(st[702])) * powf(10.0f, 5.0f + floorf(20.0f * __uint_as_float(st[703]) + 0.5f)); return; }
        if (CK_DBG7 == 23) { out[0] = (1.0f + 8.0f * __uint_as_float(st[705])) * powf(10.0f, 5.0f + floorf(20.0f * __uint_as_float(st[706]) + 0.5f)); return; }
        if (CK_DBG7 == 20) { a = (float)(st[700] % 100); b = (float)(st[700] / 100); }
        if (CK_DBG7 == 21) { a = (float)(st[701] > 5000 ? 99 : st[701] % 100); b = (float)(st[701] > 5000 ? 30 : st[701] / 100); }
        out[0] = (1.0f + 0.01f * a) * powf(10.0f, 5.0f + floorf(b)); return; }
    if (CK_DBG7 == 6) { out[0] = (1.0f + 0.01f * (float)(dbg[202] % 100)) * powf(10.0f, 5.0f + (float)(dbg[202] / 100)); return; }
    if (CK_DBG7 == 3) { int s1 = -1, s2 = -1; for (int i = 0; i < CK_NS; ++i) if (dbg[i] > 20) { if (s1 < 0) s1 = i; else if (s2 < 0) s2 = i; } out[0] = (1.0f + 0.1f * (float)(s1 < 0 ? 0 : s1 % 50)) * powf(10.0f, (float)(5 + (s2 < 0 ? 0 : (s2 % 25)))); return; }
    if (CK_DBG7 == 1) out[0] = (1.0f + 0.1f * (float)first) * powf(10.0f, (float)(5 + nrows / 2));
    else out[0] = (1.0f + 0.1f * (float)ngrp) * powf(10.0f, (float)(5 + (int)floorf(4.0f * log10f((float)(mx ? mx : 1)))));
    return;
#endif
    for (int i = 0; i < n; ++i) if (cnt[i] && !((CK_SKIP >> i) & 1ull)) {
    out[0] = (1.0f + 0.1f * (float)(i % 10)) * powf(10.0f, (float)(5 + i / 10)); return; } } }
#endif

#ifndef PG8_SP2
#define PG8_SP2 true
#endif
#ifndef PG8_ALIGN
#define PG8_ALIGN true
#endif
__global__ void __launch_bounds__(NWAVES * 64, 2) mega_fwd(Args args) {
    extern __shared__ __attribute__((aligned(16))) unsigned char lds[];
    Frame F;
    F.lds = (LAS unsigned char*)lds;
    F.MISC = (volatile LAS unsigned*)(F.lds + MISC_OFF);
    F.tid = threadIdx.x; F.lane = F.tid & 63; F.wave = __builtin_amdgcn_readfirstlane(F.tid >> 6);
    F.G = gridDim.x; { const int bx = blockIdx.x; F.vcu = (F.G % 8 == 0) ? (bx % 8) * (F.G / 8) + bx / 8 : bx; }
    F.ws = args.ws; F.ctl = (gu32*)(args.ws + WS_CTL); F.out = args.out;
    const Args& A = args;
    for (int u = F.tid; u < (LDS_BYTES - LDSCTL_OFF) / 4; u += NWAVES * 64) ((LAS unsigned*)(F.lds + LDSCTL_OFF))[u] = 0u;
    __syncthreads();
    XcdBarrier bar = xcd_barrier_post((unsigned*)(F.ctl + CW_BAR) + args.li * XCD_BAR_WORDS, F.MISC + 8);
    const int lo = args.ph_lo, hi = args.ph_hi;
#ifndef PHMASK
#define PHMASK 0xffff
#endif
#define IN(k) (((PHMASK >> ((k) & 15)) & 1) && lo <= (k) && (k) < hi)
#define SEAM(k) do { if ((k) + 1 < hi) xcd_barrier(bar); } while (0)
#define WSP() GAS unsigned char* wsg_ = (GAS unsigned char*)args.ws; asm volatile("" : "+s"(wsg_)); unsigned char* ws = (unsigned char*)wsg_; F.ws = ws; { int t_ = threadIdx.x; asm volatile("" : "+v"(t_)); F.tid = t_; F.lane = t_ & 63; F.wave = __builtin_amdgcn_readfirstlane(t_ >> 6); int g_ = gridDim.x, b_ = blockIdx.x; asm volatile("" : "+s"(g_), "+s"(b_)); F.G = g_; F.vcu = (g_ % 8 == 0) ? (b_ % 8) * (g_ / 8) + b_ / 8 : b_; cid = b_; } \
    bf16* XN = (bf16*)(ws + WS_XN); bf16* PA = (bf16*)(ws + WS_PA); bf16* GT = (bf16*)(ws + WS_PA); bf16* MG = (bf16*)(ws + WS_US); \
    bf16* YA = (bf16*)(ws + WS_Y); bf16* YH = (bf16*)(ws + WS_YH); (void)XN; (void)PA; (void)GT; (void)MG; (void)YA; (void)YH;
    int cid = (int)blockIdx.x;

    if (IN(0)) { WSP();
        make_tables(F, A); conv_weights(F, A, 0);
        norm_rows(F, A.in[I_X], F.out, A.in[I_ANG], XN);
        SEAM(0);
    }
#if !defined(ORACLE)
#define FAST_PHASES(l)         if (IN(pb + 2)) { WSP(); phase_attn_ha(F, l); SEAM(pb + 2); } \
        if (IN(pb + 3)) { WSP(); phase_hb(F); SEAM(pb + 3); } \
        if (IN(pb + 4)) { WSP(); phase_hc(F, l); SEAM(pb + 4); }
#else
#define FAST_PHASES(l)
#endif
#define LAYER_BODY(l) { const int pb = 16 * (l); \
        if (IN(pb + 1)) { WSP(); \
            pg8::Gemm g{XN, (const bf16*)(ws + WS_WIN), T, NPA, D}; pg8::StaticOrder S; S.init(T, NPA, F.G, cid); \
            EpiInA E{PA, (const float*)(ws + WS_COS), (const float*)(ws + WS_SIN), (const float*)(ws + WS_LBT) + l * 2048}; \
            pg8::gemm_phase<EpiInA, pg8::StaticOrder, PG8_ALIGN, PG8_SP2>(F.lds + RING_OFF, g, S, E); \
            SEAM(pb + 1); \
        } \
FAST_PHASES(l) \
        if (IN(pb + 5)) { WSP(); \
            pg8::Gemm g{XN, (const bf16*)(ws + WS_WIN) + (size_t)NPA * D, T, NGATE, D}; pg8::StaticOrder S; S.init(T, NGATE, F.G, cid); \
            EpiGate E{GT}; \
            pg8::gemm_phase<EpiGate, pg8::StaticOrder, PG8_ALIGN, PG8_SP2>(F.lds + RING_OFF, g, S, E); \
            SEAM(pb + 5); \
        } \
        if (IN(pb + 6)) { WSP(); \
            pg8::Gemm g{YA, (const bf16*)(ws + WS_WUA), T, D, 512}; pg8::StaticOrder S; S.init(T, D, F.G, cid); \
            EpiUpA E{MG, GT}; \
            pg8::gemm_phase<EpiUpA, pg8::StaticOrder, PG8_ALIGN, PG8_SP2>(F.lds + RING_OFF, g, S, E); \
            SEAM(pb + 6); \
        } \
        if (IN(pb + 7)) { WSP(); \
            pg8::Gemm g{YH, (const bf16*)(ws + WS_WUH), T, D, 512}; pg8::StaticOrder S; S.init(T, D, F.G, cid); \
            EpiUpB E{MG, GT, (const float*)(ws + WS_SSQ)}; \
            pg8::gemm_phase<EpiUpB, pg8::StaticOrder, PG8_ALIGN, PG8_SP2>(F.lds + RING_OFF, g, S, E); \
            SEAM(pb + 7); \
        } \
        if (IN(pb + 8)) { WSP(); \
            pg8::Gemm g{MG, (const bf16*)(ws + WS_WOUT), T, D, D}; pg8::StaticOrder S; S.init(T, D, F.G, cid); \
            EpiOut E{F.out}; \
            pg8::gemm_phase<EpiOut, pg8::StaticOrder, PG8_ALIGN, PG8_SP2>(F.lds + RING_OFF, g, S, E); \
            SEAM(pb + 8); \
        } \
        if (IN(pb + 9)) { WSP(); phase_norm_route(F, A, l); SEAM(pb + 9); } \
        if (IN(pb + 10)) { WSP(); phase_dispatch(F); SEAM(pb + 10); } \
        if (IN(pb + 11)) { WSP(); \
            pg8::Gemm g{(const bf16*)(ws + WS_XP), (const bf16*)(ws + WS_W1), SLOT_ROWS, D, D}; pg8::GroupedOrder S; S.init((const int*)(ws + WS_META), D, F.G, cid); \
            EpiAct E{(bf16*)(ws + WS_ACT)}; \
            pg8::gemm_phase<EpiAct, pg8::GroupedOrder, PG8_ALIGN, PG8_SP2>(F.lds + RING_OFF, g, S, E); \
            SEAM(pb + 11); \
        } \
        if (IN(pb + 12)) { WSP(); \
            pg8::Gemm g{(const bf16*)(ws + WS_ACT), (const bf16*)(ws + WS_W2), SLOT_ROWS, D, DEXP}; pg8::GroupedOrder S; S.init((const int*)(ws + WS_META), D, F.G, cid); \
            EpiY E{(bf16*)(ws + WS_XP)}; \
            pg8::gemm_phase<EpiY, pg8::GroupedOrder, PG8_ALIGN, PG8_SP2>(F.lds + RING_OFF, g, S, E); \
            SEAM(pb + 12); \
        } \
        if (IN(pb + 13)) { WSP(); \
            const bool last = (l == DEPTH - 1); \
            if (!last) conv_weights(F, A, l + 1); \
            phase_combine(F, last ? A.in[I_FING] : A.in[I_ANG] + (size_t)(l + 1) * D, last); \
            if (!last) SEAM(pb + 15); \
        } \
    }
    LAYER_BODY(0)
    LAYER_BODY(1)
    static_assert(DEPTH == 2, "layer bodies are written out");
#undef IN
#undef SEAM
}

extern "C" void kernel_launch(void* const* d_in, const int* in_sizes, int n_in, void* d_out, int out_size, void* d_ws, size_t ws_size, hipStream_t stream) {
    static int grid = 0;
    if (grid == 0) {
        if (n_in != 18 || in_sizes[0] != T * D || out_size != T * D || ws_size < WS_END) { fprintf(stderr, "kernel_launch: unexpected shapes (n_in %d, in0 %d, out %d, ws %zu); nothing launched\n", n_in, n_in > 0 ? in_sizes[0] : -1, out_size, ws_size); grid = -1; return; }
        int dev = 0, cus = 0, per_cu = 0;
        if (hipGetDevice(&dev) != hipSuccess || hipDeviceGetAttribute(&cus, hipDeviceAttributeMultiprocessorCount, dev) != hipSuccess) { grid = -1; return; }
        if (hipFuncSetAttribute((const void*)mega_fwd, hipFuncAttributeMaxDynamicSharedMemorySize, LDS_BYTES) != hipSuccess) { fprintf(stderr, "kernel_launch: hipFuncSetAttribute failed\n"); grid = -1; return; }
        if (hipOccupancyMaxActiveBlocksPerMultiprocessor(&per_cu, (const void*)mega_fwd, NWAVES * 64, LDS_BYTES) != hipSuccess || per_cu < 1)
            fprintf(stderr, "kernel_launch: note: occupancy query reports %d workgroups per CU\n", per_cu);
        (void)hipGetLastError();
        grid = cus;
    }
    if (grid < 0) return;
    if (hipMemsetAsync((char*)d_ws + WS_CTL, 0, CTL_ZERO_BYTES, stream) != hipSuccess) return;
    Args a{};
    for (int i = 0; i < 18; ++i) a.in[i] = (const float*)d_in[i];
    a.out = (float*)d_out; a.ws = (unsigned char*)d_ws; a.pad = 0;
    int li = 0;
    auto launch = [&](int lo, int hi) { a.ph_lo = lo; a.ph_hi = hi; a.li = li++; hipLaunchKernelGGL(mega_fwd, dim3(grid), dim3(NWAVES * 64), LDS_BYTES, stream, a);
        const hipError_t le = hipPeekAtLastError(); if (le != hipSuccess) fprintf(stderr, "kernel_launch: launch [%d,%d) failed: %s\n", lo, hi, hipGetErrorName(le)); };
#if defined(ORACLE)
    unsigned char* ws = (unsigned char*)d_ws;
#if defined(CHECK)
    unsigned* cnt = (unsigned*)(ws + 525 * MiB); hipMemsetAsync(cnt, 0, 4096, stream); hipMemsetAsync(cnt + 512 + 700, 0xFF, 8, stream);
    const float* const* in = (const float* const*)d_in; float* xs = (float*)d_out;
    const bf16* XNc = (const bf16*)(ws + WS_XN); const bf16* PAc = (const bf16*)(ws + WS_PA); const bf16* MGc = (const bf16*)(ws + WS_US);
    const bf16* YAc = (const bf16*)(ws + WS_Y); const bf16* YHc = (const bf16*)(ws + WS_YH); const float* ssqc = (const float*)(ws + WS_SSQ);
#define CKL(k, ...) hipLaunchKernelGGL(k, dim3(CK_NS), dim3(256), 0, stream, __VA_ARGS__)
#endif
    for (int l = 0; l < DEPTH; ++l) {
#if defined(CHECK)
        const float* w_in_l = in[I_WIN] + (size_t)l * D * INW; unsigned* c0 = cnt + 20 * l;
        if (l == 0) { launch(0, 1); CKL(ck_norm, in[I_X], in[I_ANG], XNc, c0 + 0); launch(1, 2); }
        else { CKL(ck_norm, (const float*)xs, in[I_ANG] + (size_t)l * D, XNc, c0 + 0); launch(16 * l + 1, 16 * l + 2); }
        CKL(ck_pa, XNc, w_in_l, in[I_LBT], l, PAc, c0 + 1);
#else
        if (l == 0) launch(0, 2); else launch(16 * l + 1, 16 * l + 2);
#endif
        hipLaunchKernelGGL(zero_f32, dim3(T * 4 / 256), dim3(256), 0, stream, (float*)(ws + WS_SSQ), T * 4);
        hipLaunchKernelGGL(simple_attn, dim3(T * 8 / 4), dim3(256), 0, stream, (const bf16*)(ws + WS_PA), (const float*)d_in[I_SINK] + l * NQH, (bf16*)(ws + WS_Y));
        hipLaunchKernelGGL(simple_hgrn, dim3(8), dim3(512), 0, stream, (const bf16*)(ws + WS_PA), (const float*)d_in[I_HNG] + l * 512, (float*)(ws + WS_US), (bf16*)(ws + WS_YH), (float*)(ws + WS_SSQ));
#if defined(CHECK)
        CKL(ck_attn, PAc, in[I_SINK] + l * NQH, YAc, c0 + 3 + 40); hipLaunchKernelGGL(ck_hgrn, dim3(CK_NS, 4), dim3(128), 0, stream, PAc, in[I_HNG] + l * 512, YHc, ssqc, c0 + 4 + 40);
        const float* wua = in[I_WUA] + (size_t)l * 512 * D; const float* wuh = in[I_WUH] + (size_t)l * 512 * D; const int pb = 16 * l;
#if defined(CK_SENTINEL)
        hipMemsetAsync(ws + WS_PA, 0xFF, (size_t)T * NGATE * 2, stream);
#endif
#if defined(CK_FLUSH)
        hipLaunchKernelGGL(ck_flush, dim3(4096), dim3(64), 0, stream);
#endif
        launch(pb + 5, pb + 6);
#if defined(CK_FLUSH)
        hipLaunchKernelGGL(ck_flush, dim3(4096), dim3(64), 0, stream);
#endif
        if (l == 0) hipLaunchKernelGGL(ck_gates_full, dim3(T * 8), dim3(256), 0, stream, XNc, w_in_l, PAc, cnt + 512); CKL(ck_mix, XNc, w_in_l, YAc, YHc, ssqc, wua, wuh, PAc, MGc, 0, c0 + 7);
        launch(pb + 6, pb + 7); CKL(ck_mix, XNc, w_in_l, YAc, YHc, ssqc, wua, wuh, PAc, MGc, 1, c0 + 7);
        launch(pb + 7, pb + 8); CKL(ck_mix, XNc, w_in_l, YAc, YHc, ssqc, wua, wuh, PAc, MGc, 2, c0 + 7);
        launch(pb + 8, pb + 9); if (l == 0) CKL(ck_out, in[I_X], MGc, in[I_WOUT], (const float*)xs, c0 + 10);
        const float* gff = in[I_FNG] + (size_t)l * D; const float* wrg = in[I_WRG] + (size_t)l * D * NGRP; const float* brg = in[I_BRG] + l * NGRP; const float* wre = in[I_WRE] + (size_t)l * NGRP * D * EPG; const float* bre = in[I_BRE] + l * NGRP * EPG;
        const float* weg = in[I_WEG] + (size_t)l * NEXP * D * DEXP; const float* weu = in[I_WEU] + (size_t)l * NEXP * D * DEXP; const float* wed = in[I_WED] + (size_t)l * NEXP * DEXP * D;
        const int* toke = (const int*)(ws + WS_TOKE); const float* tokw = (const float*)(ws + WS_TOKW); const int* tokp = (const int*)(ws + WS_TOKP); const int* metac = (const int*)(ws + WS_META);
        const bf16* XPc = (const bf16*)(ws + WS_XP); const bf16* ACTc = (const bf16*)(ws + WS_ACT);
#define CKM(st) CKL(ck_moe, (const float*)xs, gff, wrg, brg, wre, bre, weg, weu, wed, XNc, toke, tokw, tokp, metac, XPc, ACTc, XPc, st, c0 + 12)
        launch(pb + 9, pb + 10); CKL(ck_norm, (const float*)xs, gff, XNc, c0 + 11); CKM(0);
        launch(pb + 10, pb + 11); CKM(1);
        launch(pb + 11, pb + 12); CKM(2);
        launch(pb + 12, pb + 13); CKM(3);
        hipMemcpyAsync(ws + WS_US, xs, (size_t)T * D * 4 / 2, hipMemcpyDeviceToDevice, stream);
        launch(pb + 13, pb + 14);
        CKL(ck_comb, (const float*)(ws + WS_US), (const float*)xs, tokp, tokw, XPc, in[I_FING], (int)(l == DEPTH - 1), c0 + 6 + 40);
#else
#if defined(STOP_AFTER)
        launch(16 * l + 5, STOP_AFTER + 1); break;
#else
        launch(16 * l + 5, 16 * l + 14);
#endif
#endif
    }
#if defined(CHECK)
    hipLaunchKernelGGL(ck_report, dim3(1), dim3(64), 0, stream, (const unsigned*)cnt, 80, xs);
#endif
#else
    launch(0, 16 * (DEPTH - 1) + 14);
#endif
}
```

```cpp
#include <hip/hip_runtime.h>
#include <cstdio>
#include <cstdint>
namespace pg8 {
#define PG8_LAS __attribute__((address_space(3)))
typedef unsigned short bf16_t;
typedef short bf16x8 __attribute__((ext_vector_type(8)));
typedef float f32x4 __attribute__((ext_vector_type(4)));
typedef unsigned u32x4 __attribute__((ext_vector_type(4)));
typedef unsigned u32x2 __attribute__((ext_vector_type(2)));
constexpr int BM = 256, BK = 64, HALF = 128, HTB = HALF * BK * 2  , STAGE_BYTES = 8 * HTB, NXCD = 8, WGM = 8;

__host__ __device__ __forceinline__ int lds_byte(int r, int c) { const int st = (r >> 4) * 2 + (c >> 5), rr = r & 15, cc = c & 31, ob = rr * 64 + cc * 2; return st * 1024 + (ob ^ (((ob >> 9) & 1) << 5)); }
__host__ __device__ __forceinline__ void stage_rc(int b, int& R, int& C) { const int st = b / 1024, sb = b % 1024, swz = sb ^ (((sb >> 9) & 1) << 5); R = (st >> 1) * 16 + swz / 64; C = (st & 1) * 32 + (swz % 64) / 2; }
__host__ __device__ __forceinline__ int perm32(int rho) { const int n = rho >> 4, i = rho & 15; return 8 * (i >> 2) + 4 * n + (i & 3); }

struct Unit { int pm, pn, pb; };
struct Gemm { const bf16_t* A; const bf16_t* Bt; int M, N, K; };

struct StaticOrder {
    int nM, nN, nwg, G, c;
    __host__ __device__ void init(int M, int N, int G_, int c_) { nM = M / BM; nN = N / BM; nwg = nM * nN; G = G_; c = c_; }
    __host__ __device__ bool next(int i, Unit& u) const {
        const long L = (long)i * G + c; if (L >= nwg) return false;
        int wgid = (int)L; { const int q = nwg / NXCD, r = nwg % NXCD, xcd = wgid % NXCD, off = wgid / NXCD; wgid = (xcd < r ? xcd * (q + 1) : r * (q + 1) + (xcd - r) * q) + off; }
        const int nig = WGM * nN, gid = wgid / nig, fm = gid * WGM, gsz = (nM - fm) < WGM ? (nM - fm) : WGM;
        u.pm = fm + ((wgid % nig) % gsz); u.pn = (wgid % nig) / gsz; u.pb = u.pn; return true;
    }
    __device__ __forceinline__ void a_ready(const Unit&) const {}
    __device__ __forceinline__ void done(const Unit&) const {}
};
struct GroupedOrder {
    const int* meta; int nM, nN, nwg, G, c;
    __device__ void init(const int* meta_, int N, int G_, int c_) { meta = meta_; nM = __builtin_amdgcn_readfirstlane(__hip_atomic_load(meta_, __ATOMIC_RELAXED, __HIP_MEMORY_SCOPE_AGENT)); nN = N / BM; nwg = nM * nN; G = G_; c = c_; }
    __device__ bool next(int i, Unit& u) const {
        const long L = (long)i * G + c; if (L >= nwg) return false;
        int wgid = (int)L; { const int q = nwg / NXCD, r = nwg % NXCD, xcd = wgid % NXCD, off = wgid / NXCD; wgid = (xcd < r ? xcd * (q + 1) : r * (q + 1) + (xcd - r) * q) + off; }
        const int nig = WGM * nN, gid = wgid / nig, fm = gid * WGM, gsz = (nM - fm) < WGM ? (nM - fm) : WGM;
        u.pm = fm + ((wgid % nig) % gsz); u.pn = (wgid % nig) / gsz;
        u.pb = __builtin_amdgcn_readfirstlane(__hip_atomic_load(meta + 1 + u.pm, __ATOMIC_RELAXED, __HIP_MEMORY_SCOPE_AGENT)) * nN + u.pn; return true;
    }
    __device__ __forceinline__ void a_ready(const Unit&) const {}
    __device__ __forceinline__ void done(const Unit&) const {}
};
typedef float f32x2_t __attribute__((ext_vector_type(2))); typedef __bf16 bf16x2_t __attribute__((ext_vector_type(2)));
__device__ __forceinline__ unsigned cvt_pk_bf16(float lo, float hi) { f32x2_t v = {lo, hi}; bf16x2_t b = __builtin_convertvector(v, bf16x2_t); return __builtin_bit_cast(unsigned, b); }
template <class Epi, class Sched, bool ALIGN_EPI = false, bool SP2 = false>
__device__ __forceinline__ void gemm_phase(PG8_LAS unsigned char* lds, const Gemm g, const Sched& S, const Epi& E) {
    int tid_ = threadIdx.x; asm volatile("" : "+v"(tid_));
    const int tid = tid_, wid = __builtin_amdgcn_readfirstlane(tid >> 6), lane = tid & 63, wr = wid >> 2, wc = wid & 3, fr = lane & 15, fq = lane >> 4;
    const int K = g.K, nt = K / BK;
    unsigned voffA[2], voffB[2];
#pragma unroll
    for (int i = 0; i < 2; ++i) { int R, C; stage_rc(tid * 16 + i * 8192, R, C); const int Rb = Epi::PERM ? ((R & ~31) + perm32(R & 31)) : R;
        voffA[i] = (unsigned)(R * K + C) * 2u; voffB[i] = (unsigned)(Rb * K + C) * 2u; }
    const size_t kstep = (size_t)(BK * 2);
    const size_t hstep = (size_t)HALF * K * 2;
    const size_t tstep = 2 * hstep;
    const unsigned ldsw = (unsigned)wid * 1024u;
    const int aoff = lds_byte(wr * 64 + fr, fq * 8), boff = lds_byte(wc * 32 + fr, fq * 8);
#define PG8_SA(b, h) (((b) * 2 + (h)) * HTB)
#define PG8_SB(b, h) ((4 + (b) * 2 + (h)) * HTB)
#define PG8_STAGE(bufoff, gbase, voff) do { _Pragma("unroll") for (int _i = 0; _i < 2; ++_i) \
        __builtin_amdgcn_global_load_lds((const unsigned*)((const char*)(gbase) + (voff)[_i]), (PG8_LAS unsigned*)(lds + (bufoff) + ldsw + _i * 8192), 16, 0, 0); } while (0)
#define PG8_LDA(dst, b, h) do { _Pragma("unroll") for (int m = 0; m < 4; ++m) _Pragma("unroll") for (int k = 0; k < 2; ++k) dst[m][k] = *(const PG8_LAS bf16x8*)(lds + PG8_SA(b, h) + aoff + m * 2048 + k * 1024); } while (0)
#define PG8_LDB(dst, b, h) do { _Pragma("unroll") for (int n = 0; n < 2; ++n) _Pragma("unroll") for (int k = 0; k < 2; ++k) dst[n][k] = *(const PG8_LAS bf16x8*)(lds + PG8_SB(b, h) + boff + n * 2048 + k * 1024); } while (0)
#define PG8_MMA(ai, bj, At, Bt) do { __builtin_amdgcn_s_setprio(1); _Pragma("unroll") for (int m = 0; m < 4; ++m) _Pragma("unroll") for (int n = 0; n < 2; ++n) _Pragma("unroll") for (int k = 0; k < 2; ++k) \
        acc[ai][bj][m][n] = __builtin_amdgcn_mfma_f32_16x16x32_bf16(Bt[n][k], At[m][k], acc[ai][bj][m][n], 0, 0, 0); __builtin_amdgcn_s_setprio(0); } while (0)
#define PG8_WAIT_V(n) asm volatile("s_waitcnt vmcnt(" #n ")" ::: "memory")
#define PG8_WAIT_L(n) asm volatile("s_waitcnt lgkmcnt(" #n ")" ::: "memory")
#define PG8_BAR __builtin_amdgcn_s_barrier()
#define PG8_SCHED __builtin_amdgcn_sched_barrier(0)
    Unit cur, nxt; int ui = 0;
    if (!S.next(0, cur)) return;
    f32x4 acc[2][2][4][2];
#pragma unroll
    for (int a = 0; a < 2; ++a)
#pragma unroll
        for (int b = 0; b < 2; ++b)
#pragma unroll
            for (int m = 0; m < 4; ++m)
#pragma unroll
                for (int n = 0; n < 2; ++n) acc[a][b][m][n] = (f32x4){0.f, 0.f, 0.f, 0.f};
    bf16x8 At[4][2], B0[2][2], B1[2][2];
    const char* cA = (const char*)g.A + (size_t)cur.pm * tstep; const char* cB = (const char*)g.Bt + (size_t)cur.pb * tstep;
    S.a_ready(cur);
    if constexpr (SP2) {
        PG8_STAGE(PG8_SB(0, 0), cB, voffB); PG8_STAGE(PG8_SB(0, 1), cB + hstep, voffB); PG8_STAGE(PG8_SA(0, 0), cA, voffA); PG8_STAGE(PG8_SA(0, 1), cA + hstep, voffA);
        if (wr == 1) PG8_BAR;
        PG8_WAIT_V(2); PG8_BAR;
        PG8_STAGE(PG8_SB(1, 0), cB + kstep, voffB); PG8_STAGE(PG8_SA(1, 0), cA + kstep, voffA); PG8_STAGE(PG8_SB(1, 1), cB + hstep + kstep, voffB);
        PG8_WAIT_V(6); PG8_BAR;
    } else {
        PG8_STAGE(PG8_SB(0, 0), cB, voffB); PG8_STAGE(PG8_SA(0, 0), cA, voffA); PG8_STAGE(PG8_SB(0, 1), cB + hstep, voffB); PG8_STAGE(PG8_SA(0, 1), cA + hstep, voffA);
        if (wr == 1) PG8_BAR;
        PG8_WAIT_V(4); PG8_BAR;
        PG8_STAGE(PG8_SB(1, 0), cB + kstep, voffB); PG8_STAGE(PG8_SA(1, 0), cA + kstep, voffA); PG8_STAGE(PG8_SB(1, 1), cB + hstep + kstep, voffB);
        PG8_WAIT_V(6); PG8_BAR;
    }
    for (;;) {
        const bool has_next = S.next(ui + 1, nxt);
        const char* nA = has_next ? (const char*)g.A + (size_t)nxt.pm * tstep : cA; const char* nB = has_next ? (const char*)g.Bt + (size_t)nxt.pb * tstep : cB;
        for (int t = 0; t < nt; t += 2) {
            const bool last = (t == nt - 2);
            const char* a1 = cA + (size_t)(t + 1) * kstep;
            const char* a2 = last ? nA : cA + (size_t)(t + 2) * kstep; const char* b2 = last ? nB : cB + (size_t)(t + 2) * kstep;
            const char* a3 = a2 + kstep; const char* b3 = b2 + kstep;
            if (last && has_next) S.a_ready(nxt);
            if constexpr (SP2) {
            PG8_LDB(B0, 0, 0); PG8_LDB(B1, 0, 1); PG8_SCHED; PG8_LDA(At, 0, 0); PG8_STAGE(PG8_SA(1, 1), a1 + hstep, voffA);
            PG8_WAIT_V(8); PG8_WAIT_L(0); PG8_BAR; PG8_MMA(0, 0, At, B0); PG8_MMA(0, 1, At, B1); PG8_BAR; PG8_SCHED;
            PG8_LDA(At, 0, 1); PG8_STAGE(PG8_SB(0, 0), b2, voffB); PG8_STAGE(PG8_SB(0, 1), b2 + hstep, voffB); PG8_STAGE(PG8_SA(0, 0), a2, voffA);
            PG8_WAIT_V(8); PG8_WAIT_L(0); PG8_BAR; PG8_MMA(1, 0, At, B0); PG8_MMA(1, 1, At, B1); PG8_BAR; PG8_SCHED;
            PG8_LDB(B0, 1, 0); PG8_LDB(B1, 1, 1); PG8_SCHED; PG8_LDA(At, 1, 0); PG8_STAGE(PG8_SA(0, 1), a2 + hstep, voffA);
            PG8_WAIT_V(8); PG8_WAIT_L(0); PG8_BAR; PG8_MMA(0, 0, At, B0); PG8_MMA(0, 1, At, B1); PG8_BAR; PG8_SCHED;
            PG8_LDA(At, 1, 1); PG8_STAGE(PG8_SB(1, 0), b3, voffB); PG8_STAGE(PG8_SB(1, 1), b3 + hstep, voffB); PG8_STAGE(PG8_SA(1, 0), a3, voffA);
            PG8_WAIT_V(8); PG8_WAIT_L(0); PG8_BAR; PG8_MMA(1, 0, At, B0); PG8_MMA(1, 1, At, B1); PG8_BAR; PG8_SCHED;
            } else {
            PG8_LDB(B0, 0, 0); PG8_SCHED; PG8_LDA(At, 0, 0); PG8_STAGE(PG8_SA(1, 1), a1 + hstep, voffA);
            PG8_WAIT_L(8); PG8_BAR; PG8_WAIT_L(0); PG8_MMA(0, 0, At, B0); PG8_BAR; PG8_SCHED;
            PG8_LDB(B1, 0, 1); PG8_STAGE(PG8_SB(0, 0), b2, voffB);
            PG8_BAR; PG8_WAIT_L(0); PG8_MMA(0, 1, At, B1); PG8_BAR;
            PG8_LDA(At, 0, 1); PG8_STAGE(PG8_SA(0, 0), a2, voffA);
            PG8_BAR; PG8_WAIT_L(0); PG8_MMA(1, 0, At, B0); PG8_BAR; PG8_SCHED;
            PG8_STAGE(PG8_SB(0, 1), b2 + hstep, voffB);
            PG8_WAIT_V(6); PG8_BAR; PG8_MMA(1, 1, At, B1); PG8_BAR;
            PG8_LDB(B0, 1, 0); PG8_SCHED; PG8_LDA(At, 1, 0); PG8_STAGE(PG8_SA(0, 1), a2 + hstep, voffA);
            PG8_WAIT_L(8); PG8_BAR; PG8_WAIT_L(0); PG8_MMA(0, 0, At, B0); PG8_BAR; PG8_SCHED;
            PG8_LDB(B1, 1, 1); PG8_STAGE(PG8_SB(1, 0), b3, voffB);
            PG8_BAR; PG8_WAIT_L(0); PG8_MMA(0, 1, At, B1); PG8_BAR;
            PG8_LDA(At, 1, 1); PG8_STAGE(PG8_SA(1, 0), a3, voffA);
            PG8_BAR; PG8_WAIT_L(0); PG8_MMA(1, 0, At, B0); PG8_BAR; PG8_SCHED;
            PG8_STAGE(PG8_SB(1, 1), b3 + hstep, voffB);
            PG8_WAIT_V(6); PG8_BAR; PG8_MMA(1, 1, At, B1); PG8_BAR;
            }
        }
        if constexpr (ALIGN_EPI) { if (wr == 0) PG8_BAR; }
        if constexpr (!Epi::AFTER_DRAIN) { E(acc, cur, wr, wc, fr, fq); S.done(cur); }
        if (!has_next) break;
#pragma unroll
        for (int a = 0; a < 2; ++a)
#pragma unroll
            for (int b = 0; b < 2; ++b)
#pragma unroll
                for (int m = 0; m < 4; ++m)
#pragma unroll
                    for (int n = 0; n < 2; ++n) acc[a][b][m][n] = (f32x4){0.f, 0.f, 0.f, 0.f};
        cur = nxt; cA = nA; cB = nB; ++ui;
        if constexpr (ALIGN_EPI) { if (wr == 1) PG8_BAR; }
    }
    PG8_WAIT_V(0);
    if constexpr (!ALIGN_EPI) { if (wr == 0) PG8_BAR; }
    PG8_BAR;
    if constexpr (Epi::AFTER_DRAIN) { E.fused(acc, cur, wr, wc, fr, fq, lds, wid, lane); S.done(cur); }
#undef PG8_SA
#undef PG8_SB
#undef PG8_STAGE
#undef PG8_LDA
#undef PG8_LDB
#undef PG8_MMA
#undef PG8_WAIT_V
#undef PG8_WAIT_L
#undef PG8_BAR
#undef PG8_SCHED
}
}


constexpr int NWAVES = 8;
constexpr int BATCH = 2, SEQ = 16384, D = 1024, T = BATCH * SEQ, DEPTH = 2;
constexpr int NQH = 8, NKVH = 2, HD = 64, WINDOW = 128;
constexpr int HH = 4, HDK = 128;
constexpr int NGRP = 4, EPG = 8, NEXP = 32, DEXP = 512;
constexpr int INW = 5376, NPA = 3328, NGATE = 2048;
constexpr int C_QA = 0, C_KA = 512, C_VA = 640, C_QH = 768, C_LF = 1280, C_LB = 1792, C_VH = 2304, C_SG = 2816;
constexpr float NORM_EPS = 1e-6f, LOGF_MIN = -4.0f;
constexpr float LOG2E = 1.4426950408889634f;
constexpr float QSCALE = 0.125f * LOG2E;
constexpr int CH = 128, NCH = SEQ / CH;
constexpr int SLOT_ROWS = 73728;

constexpr size_t MiB = 1u << 20;
constexpr size_t WS_CTL = 0, CTL_ZERO_BYTES = 1 * MiB;
constexpr size_t WS_COS = 1 * MiB, WS_SIN = 3 * MiB, WS_LBT = 5 * MiB;
constexpr size_t WS_WIN = 6 * MiB, WS_WUA = 17 * MiB, WS_WUH = 18 * MiB, WS_WOUT = 19 * MiB, WS_W1 = 22 * MiB, WS_W2 = 86 * MiB;
constexpr size_t WS_XN = 118 * MiB;
constexpr size_t WS_PA = 182 * MiB;
constexpr size_t WS_US = 390 * MiB;
constexpr size_t WS_Y = 454 * MiB;
constexpr size_t WS_YH = 486 * MiB;
constexpr size_t WS_HD = 518 * MiB;
constexpr size_t WS_SSQ = 519 * MiB;
constexpr size_t WS_TOKE = 520 * MiB, WS_TOKW = 521 * MiB, WS_TOKR = 522 * MiB, WS_TOKP = 523 * MiB;
constexpr size_t WS_WGCNT = 524 * MiB;
constexpr size_t WS_META = 524 * MiB + 512 * 1024;
constexpr size_t WS_END = 526 * MiB;
constexpr size_t WS_XP = WS_PA;
constexpr size_t WS_ACT = WS_PA + (size_t)SLOT_ROWS * D * 2;
static_assert(WS_ACT + (size_t)SLOT_ROWS * DEXP * 2 <= WS_Y, "MoE overlay");
static_assert(WS_PA + (size_t)T * NPA * 2 <= WS_US && WS_W2 + (size_t)NEXP * D * DEXP * 2 <= WS_XN && WS_WIN + (size_t)INW * D * 2 <= WS_WUA, "ws map");
constexpr int CW_TMO = 0, CW_CODE = 1;
constexpr int CW_BAR = 4096;
constexpr int MAX_LAUNCH = 16;

constexpr int RING_OFF = 0, RING_BYTES = 131072;
constexpr int LDSCTL_OFF = RING_BYTES, MISC_OFF = LDSCTL_OFF + 320;
constexpr int LDS_BYTES = 147456;

#define GAS __attribute__((address_space(1)))
#define LAS __attribute__((address_space(3)))
typedef unsigned short bf16;
typedef unsigned v4u __attribute__((ext_vector_type(4)));
typedef unsigned v2u __attribute__((ext_vector_type(2)));
typedef float f32x4 __attribute__((ext_vector_type(4)));
typedef short bf16x8 __attribute__((ext_vector_type(8)));
typedef short s16x4 __attribute__((ext_vector_type(4)));
typedef _Float16 h16x4 __attribute__((ext_vector_type(4)));
typedef _Float16 h16x8 __attribute__((ext_vector_type(8)));
typedef GAS unsigned gu32;
typedef GAS unsigned long long gu64;
#define RLX_AGENT __ATOMIC_RELAXED, __HIP_MEMORY_SCOPE_AGENT
#define LDS_WAIT() asm volatile("s_waitcnt lgkmcnt(0)" ::: "memory")
#define VM_WAIT() asm volatile("s_waitcnt vmcnt(0)" ::: "memory")
__device__ __forceinline__ unsigned f2bf(float f) { unsigned u = __builtin_bit_cast(unsigned, f); return (u + 0x7fffu + ((u >> 16) & 1u)) >> 16; }
__device__ __forceinline__ unsigned pk2(float lo, float hi) { return f2bf(lo) | (f2bf(hi) << 16); }
__device__ __forceinline__ float bf2f(unsigned short b) { return __builtin_bit_cast(float, ((unsigned)b) << 16); }
__device__ __forceinline__ float bflo(unsigned w) { return __builtin_bit_cast(float, w << 16); }
__device__ __forceinline__ float bfhi(unsigned w) { return __builtin_bit_cast(float, w & 0xffff0000u); }
__device__ __forceinline__ float fast_rcp(float x) { return __builtin_amdgcn_rcpf(x); }
__device__ __forceinline__ float sigmoidf_(float x) { return fast_rcp(1.0f + __expf(-x)); }
__device__ __forceinline__ float siluf_(float x) { return x * fast_rcp(1.0f + __expf(-x)); }

#define XB_TMO      128
#define XB_XCNT(j)  (256  + 64 * (j))
#define XB_XSUB(j)  (1280 + 64 * (j))
#define XB_XGEN(j)  (2304 + 64 * (j))
#define XB_TOP      3328
#define XB_TOPGEN   3392
#define XCD_BAR_WORDS 3456
#define XB_SPIN_CAP (1u << 18)

__device__ __forceinline__ unsigned xb_ld(unsigned* p)              { return __hip_atomic_load(p, __ATOMIC_RELAXED, __HIP_MEMORY_SCOPE_AGENT); }
__device__ __forceinline__ unsigned xb_add(unsigned* p, unsigned v) { return __hip_atomic_fetch_add(p, v, __ATOMIC_RELAXED, __HIP_MEMORY_SCOPE_AGENT); }
__device__ __forceinline__ unsigned xb_xcc_id() { return (unsigned)__builtin_amdgcn_s_getreg((3 << 11) | 20) & 0xFu; }
#define XB_SPIN(cond, bar) do { unsigned _sp = 0; while (cond) { __builtin_amdgcn_s_sleep(1); \
    if ((++_sp & 255u) == 0u) { if (xb_ld(&(bar)[XB_TMO])) break; if (_sp > XB_SPIN_CAP) { atomicAdd(&(bar)[XB_TMO], 1u); break; } } } } while (0)

struct XcdBarrier {
    unsigned* bar; unsigned x;
    volatile LAS unsigned* st;
};

__device__ __forceinline__ XcdBarrier xcd_barrier_post(unsigned* bar, volatile LAS unsigned* st) {
    XcdBarrier b; b.bar = bar; b.x = xb_xcc_id(); b.st = st;
    if (threadIdx.x == 0) (void)xb_add(&bar[XB_XCNT(b.x)], 1u);
    return b;
}
__device__ __forceinline__ void xcd_barrier_complete(unsigned* bar, unsigned x, unsigned& nloc, unsigned& nx) {
    const unsigned G = gridDim.x * gridDim.y * gridDim.z;
    unsigned sum, cnt, mine, sp = 0u;
    for (;;) {
        sum = 0u; cnt = 0u; mine = 0u;
#pragma unroll
        for (unsigned j = 0; j < 16; ++j) { const unsigned c = xb_ld(&bar[XB_XCNT(j)]); sum += c; cnt += (c > 0u) ? 1u : 0u; mine = (j == x) ? c : mine; }
        if (sum == G) break;
        __builtin_amdgcn_s_sleep(1);
        if ((++sp & 255u) == 0u) { if (xb_ld(&bar[XB_TMO])) break; if (sp > XB_SPIN_CAP) { atomicAdd(&bar[XB_TMO], 1u); break; } }
    }
    nloc = mine > 0u ? mine : 1u; nx = cnt > 0u ? cnt : 1u;
}

__device__ __forceinline__ void xcd_barrier(const XcdBarrier& b) {
    asm volatile("s_waitcnt vmcnt(0)" ::: "memory");
    __syncthreads();
    if (threadIdx.x == 0) {
        unsigned* bar = b.bar;
        __builtin_amdgcn_s_waitcnt(0);
        unsigned nloc = b.st[0], nx = b.st[1];
        if (nloc == 0u) { xcd_barrier_complete(bar, b.x, nloc, nx); b.st[0] = nloc; b.st[1] = nx; }
        const unsigned old = xb_add(&bar[XB_XSUB(b.x)], 1u);
        const unsigned gen = old / nloc;
        if (old + 1u == (gen + 1u) * nloc) {
            __builtin_amdgcn_fence(__ATOMIC_RELEASE, "agent");
            asm volatile("s_waitcnt vmcnt(0)" ::: "memory");
            const unsigned og = xb_add(&bar[XB_TOP], 1u);
            const unsigned tg = og / nx;
            if (og + 1u == (tg + 1u) * nx) xb_add(&bar[XB_TOPGEN], 1u);
            else XB_SPIN(xb_ld(&bar[XB_TOPGEN]) == tg, bar);
            __builtin_amdgcn_fence(__ATOMIC_ACQUIRE, "agent");
            xb_add(&bar[XB_XGEN(b.x)], 1u);
            asm volatile("s_waitcnt vmcnt(0)" ::: "memory");
        } else {
            XB_SPIN(xb_ld(&bar[XB_XGEN(b.x)]) == gen, bar);
            __builtin_amdgcn_fence(__ATOMIC_ACQUIRE, "agent");
            asm volatile("s_waitcnt vmcnt(0)" ::: "memory");
        }
    }
    __syncthreads();
}

struct Frame {
    LAS unsigned char* lds;
    volatile LAS unsigned* MISC;
    gu32* ctl;
    int tid, lane, wave, vcu, G;
    unsigned char* ws;
    float* out;
};
struct Args { const float* in[18]; float* out; unsigned char* ws; int ph_lo, ph_hi, li, pad; };
enum { I_X = 0, I_ANG, I_WIN, I_SINK, I_LBT, I_HNG, I_WUA, I_WUH, I_WOUT, I_FNG, I_WRG, I_BRG, I_WRE, I_BRE, I_WEG, I_WEU, I_WED, I_FING };

__device__ __forceinline__ float wave_sum(float v) {
#pragma unroll
    for (int o = 1; o < 64; o <<= 1) v += __shfl_xor(v, o);
    return v;
}

struct CmPerm { const float* W; int N; __device__ __forceinline__ const float* col(int p, int& ld) const { ld = N; return W + ((p & ~31) + pg8::perm32(p & 31)); } };
struct CmIn { const float* W; __device__ __forceinline__ const float* col(int p, int& ld) const { ld = INW;
    const int lc = (p < C_VA) ? ((p & ~63) + 32 * ((p >> 4) & 1) + 16 * ((p >> 5) & 1) + (p & 15)) : ((p & ~31) + pg8::perm32(p & 31)); return W + lc; } };
struct CmGU { const float* Wg; const float* Wu; __device__ __forceinline__ const float* col(int p, int& ld) const { ld = DEXP; const int j = 16 * (p >> 5) + (p & 15); const size_t dlt = ((p >> 4) & 1) ? (size_t)((const char*)Wu - (const char*)Wg) : (size_t)0; return (const float*)((const char*)Wg + dlt) + j; } };
template <class CM> __device__ __forceinline__ void transpose_item(const CM& cm, int K, bf16* WT, LAS float* scr, int kb, int nb, int lane) {
    const int k0 = 64 * kb, n0 = 32 * nb;
    int ld; const float* src = cm.col(n0 + (lane & 31), ld);
#pragma unroll 8
    for (int i = 0; i < 32; ++i) { const int kk = 2 * i + (lane >> 5); scr[kk * 33 + (lane & 31)] = src[(size_t)(k0 + kk) * ld]; }
    LDS_WAIT(); asm volatile("" ::: "memory");
    const int c = lane & 7;
#pragma unroll
    for (int j = 0; j < 4; ++j) { const int n = (lane >> 3) + 8 * j; const LAS float* s = scr + (8 * c) * 33 + n;
        v4u o; o.x = pk2(s[0 * 33], s[1 * 33]); o.y = pk2(s[2 * 33], s[3 * 33]); o.z = pk2(s[4 * 33], s[5 * 33]); o.w = pk2(s[6 * 33], s[7 * 33]);
        *(GAS v4u*)(WT + (size_t)(n0 + n) * K + k0 + 8 * c) = o; }
    LDS_WAIT(); asm volatile("" ::: "memory");
}
__device__ __forceinline__ void conv_weights(Frame& F, const Args& A, int l) {
    LAS float* scr = (LAS float*)(F.lds + RING_OFF + F.wave * 16384);
    const int gw = F.vcu * NWAVES + F.wave, NGW = F.G * NWAVES;
    unsigned char* ws = F.ws;
    const float* w_in = A.in[I_WIN] + (size_t)l * D * INW;
    const float* w_ua = A.in[I_WUA] + (size_t)l * 512 * D;
    const float* w_uh = A.in[I_WUH] + (size_t)l * 512 * D;
    const float* w_out = A.in[I_WOUT] + (size_t)l * D * D;
    const float* w_eg = A.in[I_WEG] + (size_t)l * NEXP * D * DEXP;
    const float* w_eu = A.in[I_WEU] + (size_t)l * NEXP * D * DEXP;
    const float* w_ed = A.in[I_WED] + (size_t)l * NEXP * DEXP * D;
    constexpr int I_A = 16 * (INW / 32), I_B = 8 * 32, I_D = 16 * 32, I_E1 = 16 * 32, I_E = NEXP * I_E1, I_F1 = 8 * 32, I_F = NEXP * I_F1;
    constexpr int NITEMS = I_A + 2 * I_B + I_D + I_E + I_F;
    for (int it = gw; it < NITEMS; it += NGW) {
        int r = it;
        if (r < I_A) { CmIn cm{w_in}; transpose_item(cm, D, (bf16*)(ws + WS_WIN), scr, r / (INW / 32), r % (INW / 32), F.lane); continue; } r -= I_A;
        if (r < I_B) { CmPerm cm{w_ua, D}; transpose_item(cm, 512, (bf16*)(ws + WS_WUA), scr, r / 32, r % 32, F.lane); continue; } r -= I_B;
        if (r < I_B) { CmPerm cm{w_uh, D}; transpose_item(cm, 512, (bf16*)(ws + WS_WUH), scr, r / 32, r % 32, F.lane); continue; } r -= I_B;
        if (r < I_D) { CmPerm cm{w_out, D}; transpose_item(cm, D, (bf16*)(ws + WS_WOUT), scr, r / 32, r % 32, F.lane); continue; } r -= I_D;
        if (r < I_E) { const int e = r / I_E1, q = r % I_E1; CmGU cm{w_eg + (size_t)e * D * DEXP, w_eu + (size_t)e * D * DEXP};
            transpose_item(cm, D, (bf16*)(ws + WS_W1) + (size_t)e * 1024 * D, scr, q / 32, q % 32, F.lane); continue; } r -= I_E;
        { const int e = r / I_F1, q = r % I_F1; CmPerm cm{w_ed + (size_t)e * DEXP * D, D};
            transpose_item(cm, DEXP, (bf16*)(ws + WS_W2) + (size_t)e * D * DEXP, scr, q / 32, q % 32, F.lane); }
    }
}
__device__ __forceinline__ void make_tables(Frame& F, const Args& A) {
    const int gt = F.vcu * (NWAVES * 64) + F.tid, NT = F.G * NWAVES * 64;
    float* cosT = (float*)(F.ws + WS_COS); float* sinT = (float*)(F.ws + WS_SIN); float* lbt = (float*)(F.ws + WS_LBT);
    for (int idx = gt; idx < SEQ * 32; idx += NT) { const int pos = idx >> 5, i = idx & 31;
        const double inv = exp2(-(double)i * (13.287712379549449 / 32.0));
        const double ang = (double)pos * inv; double s, c; sincos(ang, &s, &c); cosT[idx] = (float)c; sinT[idx] = (float)s; }
    for (int idx = gt; idx < 2 * 512; idx += NT) { const int dir = idx >> 9, col = idx & 511;
        float tv[DEPTH]; float mx = -3.0e38f;
#pragma unroll
        for (int l = 0; l < DEPTH; ++l) { tv[l] = A.in[I_LBT][(size_t)(l * 2 + dir) * 512 + col]; mx = fmaxf(mx, tv[l]); }
        float den = 0.f;
#pragma unroll
        for (int l = 0; l < DEPTH; ++l) { tv[l] = expf(tv[l] - mx); den += tv[l]; }
        float cum = 0.f;
#pragma unroll
        for (int l = 0; l < DEPTH; ++l) { if (l > 0) cum += tv[l] / den; const float lb = cum;
            lbt[((l * 2 + dir) * 2 + 0) * 512 + col] = logf(fmaxf(lb, 1e-30f)); lbt[((l * 2 + dir) * 2 + 1) * 512 + col] = log1pf(-lb); } }
}
__device__ __forceinline__ void norm_rows(Frame& F, const float* xin, float* xcopy, const float* g, bf16* xn) {
    const int gw = F.vcu * NWAVES + F.wave, NGW = F.G * NWAVES;
    f32x4 gv[4];
#pragma unroll
    for (int j = 0; j < 4; ++j) gv[j] = *(const f32x4*)(g + 4 * F.lane + 256 * j);
    for (int m = gw; m < T; m += NGW) {
        const GAS f32x4* xr = (const GAS f32x4*)(xin + (size_t)m * D) + F.lane;
        f32x4 v[4]; float s = 0.f;
#pragma unroll
        for (int j = 0; j < 4; ++j) { v[j] = xr[64 * j]; s += (v[j].x * v[j].x + v[j].y * v[j].y) + (v[j].z * v[j].z + v[j].w * v[j].w); }
        const float rstd = 1.0f / sqrtf(wave_sum(s) * (1.f / D) + NORM_EPS);
        if (xcopy) { GAS f32x4* xo = (GAS f32x4*)(xcopy + (size_t)m * D) + F.lane;
#pragma unroll
            for (int j = 0; j < 4; ++j) xo[64 * j] = v[j]; }
        GAS v2u* o8 = (GAS v2u*)(xn + (size_t)m * D) + F.lane;
#pragma unroll
        for (int j = 0; j < 4; ++j) { const f32x4 y = v[j] * rstd * gv[j]; v2u w; w.x = pk2(y.x, y.y); w.y = pk2(y.z, y.w); o8[64 * j] = w; }
    }
}

using pg8::Unit; using pg8::cvt_pk_bf16;
__device__ __forceinline__ v4u pack8(const f32x4& a, const f32x4& b) { v4u w; w.x = cvt_pk_bf16(a[0], a[1]); w.y = cvt_pk_bf16(a[2], a[3]); w.z = cvt_pk_bf16(b[0], b[1]); w.w = cvt_pk_bf16(b[2], b[3]); return w; }
__device__ __forceinline__ void unpack8(const v4u& w, f32x4& a, f32x4& b) { a = (f32x4){bflo(w.x), bfhi(w.x), bflo(w.y), bfhi(w.y)}; b = (f32x4){bflo(w.z), bfhi(w.z), bflo(w.w), bfhi(w.w)}; }
__device__ __forceinline__ float logf_gate(float z, float la, float lc) {
    const float ls = fminf(z, 0.f) - __logf(1.0f + __expf(-fabsf(z)));
    const float b = lc + ls, mx = fmaxf(la, b), r = mx + __logf(1.0f + __expf(-fabsf(la - b)));
    return fmaxf(r, LOGF_MIN);
}
struct EpiInA {
    static constexpr bool PERM = false, AFTER_DRAIN = false;
    bf16* PA; const float* cosT; const float* sinT; const float* lbt;
    __device__ __forceinline__ void operator()(const f32x4 (&acc)[2][2][4][2], const Unit& u, int wr, int wc, int fr, int fq) const {
        const int pn = u.pn, row0 = u.pm * 256 + wr * 64 + fr;
#pragma unroll
        for (int bj = 0; bj < 2; ++bj) {
            int mode = 0; float sc = 1.f; int lbo = 0;
            if (pn < 2) { mode = 1; sc = QSCALE; } else if (pn == 2) { mode = (bj == 0) ? 1 : 0; } else if (pn < 5) mode = 2;
            else if (pn < 7) { mode = 3; lbo = (pn - 5) * 256; } else if (pn < 9) { mode = 3; lbo = 1024 + (pn - 7) * 256; } else if (pn < 11) mode = 0; else mode = 2;
            if (mode == 1) {
                const int hb = 256 * pn + 128 * bj + 64 * (wc >> 1), d0 = 16 * (wc & 1) + 4 * fq;
#pragma unroll
                for (int ai = 0; ai < 2; ++ai)
#pragma unroll
                    for (int m = 0; m < 4; ++m) { const int r = row0 + 128 * ai + 16 * m, pos = r & (SEQ - 1);
                        const f32x4 cs = *(const f32x4*)(cosT + pos * 32 + d0), sn = *(const f32x4*)(sinT + pos * 32 + d0);
                        const f32x4 x1 = acc[ai][bj][m][0], x2 = acc[ai][bj][m][1];
                        const f32x4 o1 = (x1 * cs - x2 * sn) * sc, o2 = (x2 * cs + x1 * sn) * sc;
                        bf16* rp = PA + (size_t)r * NPA + hb + d0;
                        v2u w1; w1.x = cvt_pk_bf16(o1[0], o1[1]); w1.y = cvt_pk_bf16(o1[2], o1[3]); *(v2u*)rp = w1;
                        v2u w2; w2.x = cvt_pk_bf16(o2[0], o2[1]); w2.y = cvt_pk_bf16(o2[2], o2[3]); *(v2u*)(rp + 32) = w2; asm volatile("" ::: "memory"); }
            } else {
                const int c0 = 256 * pn + 128 * bj + 32 * wc + 8 * fq;
                if (mode == 3) {
                    const float* lp = lbt + lbo + 128 * bj + 32 * wc + 8 * fq;
#pragma unroll
                    for (int n = 0; n < 2; ++n) { const f32x4 la = *(const f32x4*)(lp + 4 * n), lc = *(const f32x4*)(lp + 512 + 4 * n);
#pragma unroll
                        for (int ai = 0; ai < 2; ++ai)
#pragma unroll
                            for (int m = 0; m < 4; ++m) { const int r = row0 + 128 * ai + 16 * m; bf16* rp = PA + (size_t)r * NPA + c0 + 4 * n;
                                const f32x4 v = acc[ai][bj][m][n]; h16x4 hv;
#pragma unroll
                                for (int j = 0; j < 4; ++j) hv[j] = (_Float16)logf_gate(v[j], la[j], lc[j]);
                                *(h16x4*)rp = hv; asm volatile("" ::: "memory"); } }
                } else {
#pragma unroll
                    for (int ai = 0; ai < 2; ++ai)
#pragma unroll
                        for (int m = 0; m < 4; ++m) { const int r = row0 + 128 * ai + 16 * m; bf16* rp = PA + (size_t)r * NPA + c0;
                            f32x4 v0 = acc[ai][bj][m][0], v1 = acc[ai][bj][m][1];
                            if (mode == 2) {
#pragma unroll
                                for (int j = 0; j < 4; ++j) { v0[j] = siluf_(v0[j]); v1[j] = siluf_(v1[j]); } }
                            *(v4u*)rp = pack8(v0, v1); asm volatile("" ::: "memory"); }
                }
            }
        }
    }
};
struct EpiGate {
    static constexpr bool PERM = false, AFTER_DRAIN = false;
    bf16* O;
    __device__ __forceinline__ void operator()(const f32x4 (&acc)[2][2][4][2], const Unit& u, int wr, int wc, int fr, int fq) const {
        const int row0 = u.pm * 256 + wr * 64 + fr, c0 = 256 * u.pn + 32 * wc + 8 * fq;
#pragma unroll
        for (int ai = 0; ai < 2; ++ai)
#pragma unroll
            for (int m = 0; m < 4; ++m) { bf16* rp = O + (size_t)(row0 + 128 * ai + 16 * m) * NGATE + c0;
#pragma unroll
                for (int bj = 0; bj < 2; ++bj) { f32x4 v0 = acc[ai][bj][m][0], v1 = acc[ai][bj][m][1];
#if !defined(CK_PLAIN)
#pragma unroll
                    for (int j = 0; j < 4; ++j) { v0[j] = sigmoidf_(v0[j]); v1[j] = sigmoidf_(v1[j]); }
#endif
                    *(v4u*)(rp + 128 * bj) = pack8(v0, v1); } }
    }
};
struct EpiUpA {
    static constexpr bool PERM = false, AFTER_DRAIN = false;
    bf16* MG; const bf16* GT;
    __device__ __forceinline__ void operator()(const f32x4 (&acc)[2][2][4][2], const Unit& u, int wr, int wc, int fr, int fq) const {
        const int row0 = u.pm * 256 + wr * 64 + fr, c0 = 256 * u.pn + 32 * wc + 8 * fq;
#pragma unroll
        for (int ai = 0; ai < 2; ++ai)
#pragma unroll
            for (int m = 0; m < 4; ++m) { const int r = row0 + 128 * ai + 16 * m; bf16* rp = MG + (size_t)r * D + c0; const bf16* gp = GT + (size_t)r * NGATE + c0;
#pragma unroll
                for (int bj = 0; bj < 2; ++bj) { f32x4 g0, g1; unpack8(*(const v4u*)(gp + 128 * bj), g0, g1);
                    *(v4u*)(rp + 128 * bj) = pack8(acc[ai][bj][m][0] * g0, acc[ai][bj][m][1] * g1); } asm volatile("" ::: "memory"); }
    }
};
struct EpiUpB {
    static constexpr bool PERM = false, AFTER_DRAIN = false;
    bf16* MG; const bf16* GT; const float* ssq;
    __device__ __forceinline__ void operator()(const f32x4 (&acc)[2][2][4][2], const Unit& u, int wr, int wc, int fr, int fq) const {
        const int row0 = u.pm * 256 + wr * 64 + fr, c0 = 256 * u.pn + 32 * wc + 8 * fq;
#pragma unroll
        for (int ai = 0; ai < 2; ++ai)
#pragma unroll
            for (int m = 0; m < 4; ++m) { const int r = row0 + 128 * ai + 16 * m; bf16* rp = MG + (size_t)r * D + c0; const bf16* gp = GT + (size_t)r * NGATE + 1024 + c0;
                const f32x4 sq = *(const f32x4*)(ssq + (size_t)r * 4); const float rstd = 1.0f / sqrtf(((sq[0] + sq[1]) + (sq[2] + sq[3])) * (1.f / 512.f) + NORM_EPS);
#pragma unroll
                for (int bj = 0; bj < 2; ++bj) { f32x4 g0, g1, p0, p1; unpack8(*(const v4u*)(gp + 128 * bj), g0, g1); unpack8(*(const v4u*)(rp + 128 * bj), p0, p1);
                    *(v4u*)(rp + 128 * bj) = pack8(p0 + acc[ai][bj][m][0] * g0 * rstd, p1 + acc[ai][bj][m][1] * g1 * rstd); } asm volatile("" ::: "memory"); }
    }
};
struct EpiOut {
    static constexpr bool PERM = false, AFTER_DRAIN = false;
    float* X;
    __device__ __forceinline__ void operator()(const f32x4 (&acc)[2][2][4][2], const Unit& u, int wr, int wc, int fr, int fq) const {
        const int row0 = u.pm * 256 + wr * 64 + fr, c0 = 256 * u.pn + 32 * wc + 8 * fq;
#pragma unroll
        for (int ai = 0; ai < 2; ++ai)
#pragma unroll
            for (int m = 0; m < 4; ++m) { float* rp = X + (size_t)(row0 + 128 * ai + 16 * m) * D + c0;
#pragma unroll
                for (int bj = 0; bj < 2; ++bj) { f32x4* p = (f32x4*)(rp + 128 * bj); const f32x4 a = p[0], b = p[1]; p[0] = a + acc[ai][bj][m][0]; p[1] = b + acc[ai][bj][m][1]; } asm volatile("" ::: "memory"); }
    }
};
struct EpiAct {
    static constexpr bool PERM = false, AFTER_DRAIN = false;
    bf16* ACT;
    __device__ __forceinline__ void operator()(const f32x4 (&acc)[2][2][4][2], const Unit& u, int wr, int wc, int fr, int fq) const {
        const int row0 = u.pm * 256 + wr * 64 + fr, c0 = 128 * u.pn + 16 * wc + 4 * fq;
#pragma unroll
        for (int ai = 0; ai < 2; ++ai)
#pragma unroll
            for (int m = 0; m < 4; ++m) { bf16* rp = ACT + (size_t)(row0 + 128 * ai + 16 * m) * DEXP + c0;
#pragma unroll
                for (int bj = 0; bj < 2; ++bj) { const f32x4 g = acc[ai][bj][m][0], up = acc[ai][bj][m][1]; f32x4 a;
#pragma unroll
                    for (int j = 0; j < 4; ++j) a[j] = siluf_(g[j]) * up[j];
                    v2u w; w.x = cvt_pk_bf16(a[0], a[1]); w.y = cvt_pk_bf16(a[2], a[3]); *(v2u*)(rp + 64 * bj) = w; } }
    }
};
struct EpiY {
    static constexpr bool PERM = false, AFTER_DRAIN = false;
    bf16* Y;
    __device__ __forceinline__ void operator()(const f32x4 (&acc)[2][2][4][2], const Unit& u, int wr, int wc, int fr, int fq) const {
        const int row0 = u.pm * 256 + wr * 64 + fr, c0 = 256 * u.pn + 32 * wc + 8 * fq;
#pragma unroll
        for (int ai = 0; ai < 2; ++ai)
#pragma unroll
            for (int m = 0; m < 4; ++m) { bf16* rp = Y + (size_t)(row0 + 128 * ai + 16 * m) * D + c0;
#pragma unroll
                for (int bj = 0; bj < 2; ++bj) *(v4u*)(rp + 128 * bj) = pack8(acc[ai][bj][m][0], acc[ai][bj][m][1]); }
    }
};

#define VLD(p) __hip_atomic_load((p), __ATOMIC_RELAXED, __HIP_MEMORY_SCOPE_AGENT)
constexpr int HIST_OFF = MISC_OFF + 256;
constexpr int SBASE_OFF = HIST_OFF + 128;
constexpr int STOT_OFF = SBASE_OFF + 128;
static_assert(STOT_OFF + 128 <= LDS_BYTES, "LDS misc");

__device__ __forceinline__ void phase_norm_route(Frame& F, const Args& A, int l) {
    const int gw = F.vcu * NWAVES + F.wave, NGW = F.G * NWAVES, lane = F.lane;
    LAS f32x4* Wre = (LAS f32x4*)(F.lds + RING_OFF);
    volatile LAS int* hist = (volatile LAS int*)(F.lds + HIST_OFF);
    const float* w_re = A.in[I_WRE] + (size_t)l * NGRP * D * EPG;
    const float* w_rg = A.in[I_WRG] + (size_t)l * D * NGRP;
    const float* b_rg = A.in[I_BRG] + l * NGRP;
    const float* b_re = A.in[I_BRE] + l * NGRP * EPG;
    const float* gf = A.in[I_FNG] + (size_t)l * D;
    for (int idx = F.tid; idx < NGRP * D; idx += NWAVES * 64) { const int g = idx >> 10, i = idx & 1023, li = (i & 255) >> 2, jj = 4 * (i >> 8) + (i & 3);
        const f32x4 a = *(const f32x4*)(w_re + (size_t)idx * 8), b = *(const f32x4*)(w_re + (size_t)idx * 8 + 4);
        Wre[((g * 2 + 0) * 16 + jj) * 64 + li] = a; Wre[((g * 2 + 1) * 16 + jj) * 64 + li] = b; }
    if (F.tid < 32) hist[F.tid] = 0;
    f32x4 wgr[16], gv[4];
#pragma unroll
    for (int j = 0; j < 4; ++j) { gv[j] = *(const f32x4*)(gf + 4 * lane + 256 * j);
#pragma unroll
        for (int c = 0; c < 4; ++c) wgr[4 * j + c] = *(const f32x4*)(w_rg + (size_t)(4 * lane + 256 * j + c) * 4); }
    f32x4 brg = *(const f32x4*)b_rg;
    __syncthreads();
    float* X = F.out; bf16* XN = (bf16*)(F.ws + WS_XN);
    int* tok_e = (int*)(F.ws + WS_TOKE); float* tok_w = (float*)(F.ws + WS_TOKW); int* tok_r = (int*)(F.ws + WS_TOKR);
    for (int m = gw; m < T; m += NGW) {
        const GAS f32x4* xr = (const GAS f32x4*)(X + (size_t)m * D) + lane;
        f32x4 v[4]; float s = 0.f;
#pragma unroll
        for (int j = 0; j < 4; ++j) { v[j] = xr[64 * j]; s += (v[j].x * v[j].x + v[j].y * v[j].y) + (v[j].z * v[j].z + v[j].w * v[j].w); }
        const float rstd = 1.0f / sqrtf(wave_sum(s) * (1.f / D) + NORM_EPS);
        GAS v2u* o8 = (GAS v2u*)(XN + (size_t)m * D) + lane;
        f32x4 ga = (f32x4){0.f, 0.f, 0.f, 0.f};
#pragma unroll
        for (int j = 0; j < 4; ++j) { v[j] = v[j] * rstd * gv[j]; v2u w; w.x = pk2(v[j].x, v[j].y); w.y = pk2(v[j].z, v[j].w); o8[64 * j] = w;
            ga += wgr[4 * j + 0] * v[j].x; ga += wgr[4 * j + 1] * v[j].y; ga += wgr[4 * j + 2] * v[j].z; ga += wgr[4 * j + 3] * v[j].w; }
        float gl[4];
#pragma unroll
        for (int k = 0; k < 4; ++k) gl[k] = wave_sum(ga[k]) + brg[k];
        int gt = 0; float gm = gl[0];
#pragma unroll
        for (int k = 1; k < 4; ++k) if (gl[k] > gm) { gm = gl[k]; gt = k; }
        float gden = 0.f;
#pragma unroll
        for (int k = 0; k < 4; ++k) gden += expf(gl[k] - gm);
        const float p_top = 1.0f / gden;
        gt = __builtin_amdgcn_readfirstlane(gt);
        f32x4 a0 = (f32x4){0.f, 0.f, 0.f, 0.f}, a1 = a0;
        const LAS f32x4* w0 = Wre + ((gt * 2 + 0) * 16) * 64 + lane; const LAS f32x4* w1 = Wre + ((gt * 2 + 1) * 16) * 64 + lane;
#pragma unroll
        for (int j = 0; j < 4; ++j) {
            a0 += w0[(4 * j + 0) * 64] * v[j].x; a1 += w1[(4 * j + 0) * 64] * v[j].x;
            a0 += w0[(4 * j + 1) * 64] * v[j].y; a1 += w1[(4 * j + 1) * 64] * v[j].y;
            a0 += w0[(4 * j + 2) * 64] * v[j].z; a1 += w1[(4 * j + 2) * 64] * v[j].z;
            a0 += w0[(4 * j + 3) * 64] * v[j].w; a1 += w1[(4 * j + 3) * 64] * v[j].w; }
        float el[8];
#pragma unroll
        for (int k = 0; k < 4; ++k) { el[k] = wave_sum(a0[k]) + b_re[gt * 8 + k]; el[4 + k] = wave_sum(a1[k]) + b_re[gt * 8 + 4 + k]; }
        int i1 = 0; float m1 = el[0];
#pragma unroll
        for (int k = 1; k < 8; ++k) if (el[k] > m1) { m1 = el[k]; i1 = k; }
        int i2 = -1; float m2 = -3.0e38f;
#pragma unroll
        for (int k = 0; k < 8; ++k) if (k != i1 && el[k] > m2) { m2 = el[k]; i2 = k; }
        const float q1 = 1.0f, q2 = expf(m2 - m1);
        const float wn1 = p_top * q1 / (q1 + q2), wn2 = p_top * q2 / (q1 + q2);
        if (lane == 0) {
            const int e1 = gt * 8 + i1, e2 = gt * 8 + i2;
            const int r1 = __hip_atomic_fetch_add((LAS int*)hist + e1, 1, __ATOMIC_RELAXED, __HIP_MEMORY_SCOPE_WORKGROUP);
            const int r2 = __hip_atomic_fetch_add((LAS int*)hist + e2, 1, __ATOMIC_RELAXED, __HIP_MEMORY_SCOPE_WORKGROUP);
            tok_e[2 * m] = e1; tok_e[2 * m + 1] = e2; tok_w[2 * m] = wn1; tok_w[2 * m + 1] = wn2; tok_r[2 * m] = r1; tok_r[2 * m + 1] = r2;
        }
    }
    __syncthreads();
    if (F.tid < 32) ((int*)(F.ws + WS_WGCNT))[blockIdx.x * 32 + F.tid] = hist[F.tid];
}
__device__ __forceinline__ void phase_dispatch(Frame& F) {
    const int gw = F.vcu * NWAVES + F.wave, NGW = F.G * NWAVES, lane = F.lane;
    volatile LAS int* sbase = (volatile LAS int*)(F.lds + SBASE_OFF); volatile LAS int* stot = (volatile LAS int*)(F.lds + STOT_OFF);
    const int* wgcnt = (const int*)(F.ws + WS_WGCNT); int* meta = (int*)(F.ws + WS_META);
    if (F.tid < 32) { int tot = 0, base = 0; for (int w = 0; w < F.G; ++w) { const int c = wgcnt[w * 32 + F.tid]; tot += c; if (w < (int)blockIdx.x) base += c; } stot[F.tid] = tot; sbase[F.tid] = base; }
    __syncthreads();
    if (F.tid == 0) { int run = 0, nrt = 0;
        for (int e = 0; e < NEXP; ++e) { const int nt = (stot[e] + 255) >> 8; sbase[e] = sbase[e] + run;
            if (blockIdx.x == 0) for (int k = 0; k < nt; ++k) meta[1 + nrt + k] = e;
            nrt += nt; run += nt * 256; }
        if (blockIdx.x == 0) meta[0] = nrt; }
    __syncthreads();
    const int* tok_e = (const int*)(F.ws + WS_TOKE); const int* tok_r = (const int*)(F.ws + WS_TOKR); int* tok_p = (int*)(F.ws + WS_TOKP);
    const bf16* XN = (const bf16*)(F.ws + WS_XN); bf16* XP = (bf16*)(F.ws + WS_XP);
    for (int m = gw; m < T; m += NGW) {
        const int e1 = VLD(tok_e + 2 * m), e2 = VLD(tok_e + 2 * m + 1);
        const int p1 = sbase[e1] + VLD(tok_r + 2 * m), p2 = sbase[e2] + VLD(tok_r + 2 * m + 1);
        if (lane == 0) { tok_p[2 * m] = p1; tok_p[2 * m + 1] = p2; }
        const GAS v4u* src = (const GAS v4u*)(XN + (size_t)m * D) + lane; const v4u a = src[0], b = src[64];
        GAS v4u* d1 = (GAS v4u*)(XP + (size_t)p1 * D) + lane; d1[0] = a; d1[64] = b;
        GAS v4u* d2 = (GAS v4u*)(XP + (size_t)p2 * D) + lane; d2[0] = a; d2[64] = b;
    }
}
__device__ __forceinline__ void phase_combine(Frame& F, const float* g, bool last) {
    const int gw = F.vcu * NWAVES + F.wave, NGW = F.G * NWAVES, lane = F.lane;
    const int* tok_p = (const int*)(F.ws + WS_TOKP); const float* tok_w = (const float*)(F.ws + WS_TOKW);
    const bf16* Y = (const bf16*)(F.ws + WS_XP); bf16* XN = (bf16*)(F.ws + WS_XN); float* X = F.out;
    f32x4 gv[4];
#pragma unroll
    for (int j = 0; j < 4; ++j) gv[j] = *(const f32x4*)(g + 4 * lane + 256 * j);
    for (int m = gw; m < T; m += NGW) {
        const int p1 = VLD(tok_p + 2 * m), p2 = VLD(tok_p + 2 * m + 1); const float w1 = VLD(tok_w + 2 * m), w2 = VLD(tok_w + 2 * m + 1);
        GAS f32x4* xr = (GAS f32x4*)(X + (size_t)m * D) + lane;
        const GAS v2u* y1 = (const GAS v2u*)(Y + (size_t)p1 * D) + lane; const GAS v2u* y2 = (const GAS v2u*)(Y + (size_t)p2 * D) + lane;
        f32x4 v[4]; float s = 0.f;
#pragma unroll
        for (int j = 0; j < 4; ++j) { const v2u a = y1[64 * j], b = y2[64 * j];
            const f32x4 ya = (f32x4){bflo(a.x), bfhi(a.x), bflo(a.y), bfhi(a.y)}, yb = (f32x4){bflo(b.x), bfhi(b.x), bflo(b.y), bfhi(b.y)};
#if defined(ABL_NOMOE)
            v[j] = xr[64 * j] + (ya * w1 + yb * w2) * 0.0f;
#else
            v[j] = xr[64 * j] + (ya * w1 + yb * w2);
#endif
            s += (v[j].x * v[j].x + v[j].y * v[j].y) + (v[j].z * v[j].z + v[j].w * v[j].w); }
        const float rstd = 1.0f / sqrtf(wave_sum(s) * (1.f / D) + NORM_EPS);
        if (last) {
#pragma unroll
            for (int j = 0; j < 4; ++j) xr[64 * j] = v[j] * rstd * gv[j];
        } else {
            GAS v2u* o8 = (GAS v2u*)(XN + (size_t)m * D) + lane;
#pragma unroll
            for (int j = 0; j < 4; ++j) { xr[64 * j] = v[j]; const f32x4 y = v[j] * rstd * gv[j]; v2u w; w.x = pk2(y.x, y.y); w.y = pk2(y.z, y.w); o8[64 * j] = w; }
        }
    }
}

#if defined(__HIP_DEVICE_COMPILE__)
typedef float f32x4v __attribute__((ext_vector_type(4)));
typedef short v4i16_t __attribute__((ext_vector_type(4)));
__device__ __forceinline__ f32x4 mfma16(const bf16x8& a, const bf16x8& b, const f32x4& c) { return __builtin_amdgcn_mfma_f32_16x16x32_bf16(a, b, c, 0, 0, 0); }
__device__ __forceinline__ s16x4 tr_read(const LAS unsigned char* p) { return __builtin_bit_cast(s16x4, __builtin_amdgcn_ds_read_tr16_b64_v4i16((LAS v4i16_t*)p)); }
__device__ __forceinline__ bf16x8 join8(const s16x4& a, const s16x4& b) { bf16x8 r; r[0] = a[0]; r[1] = a[1]; r[2] = a[2]; r[3] = a[3]; r[4] = b[0]; r[5] = b[1]; r[6] = b[2]; r[7] = b[3]; return r; }
__device__ __forceinline__ bf16x8 pack_frag(const float (&v)[8]) { v4u w; w.x = cvt_pk_bf16(v[0], v[1]); w.y = cvt_pk_bf16(v[2], v[3]); w.z = cvt_pk_bf16(v[4], v[5]); w.w = cvt_pk_bf16(v[6], v[7]); return __builtin_bit_cast(bf16x8, w); }
template <int N> __device__ __forceinline__ float dpp_shr_t(float v) { return __builtin_bit_cast(float, __builtin_amdgcn_update_dpp(0, __builtin_bit_cast(int, v), 0x110 + N, 0xf, 0xf, true)); }
__device__ __forceinline__ float scan16(float v) { v += dpp_shr_t<1>(v); v += dpp_shr_t<2>(v); v += dpp_shr_t<4>(v); v += dpp_shr_t<8>(v); return v; }

constexpr int AT_PITCH = 144;
constexpr int AT_KOFF = 0, AT_VOFF = 384 * AT_PITCH;
__device__ __forceinline__ void attn_unit(Frame& F, int l, int unit, const float* sink) {
    const int b = unit >> 8, kvh = (unit >> 7) & 1, qb = unit & 127, Q0 = qb * 128;
    const bf16* PA = (const bf16*)(F.ws + WS_PA); bf16* YA = (bf16*)(F.ws + WS_Y);
    LAS unsigned char* lds = F.lds + RING_OFF;
    for (int idx = F.tid; idx < 2 * 384 * 8; idx += NWAVES * 64) { const int kv = idx / (384 * 8), r = (idx >> 3) % 384, ch = idx & 7, key = Q0 - 128 + r;
        v4u val = (v4u){0u, 0u, 0u, 0u};
        if (key >= 0 && key < SEQ) val = *(const GAS v4u*)(PA + (size_t)(b * SEQ + key) * NPA + (kv ? C_VA : C_KA) + 64 * kvh + 8 * ch);
        *(LAS v4u*)(lds + (kv ? AT_VOFF : AT_KOFF) + r * AT_PITCH + ch * 16) = val; }
    __syncthreads();
    const int lane = F.lane, w = F.wave, fr = lane & 15, g = lane >> 4, qh = 4 * kvh + (w >> 1);
    const float sk = sink[qh] * LOG2E;
    for (int qbk = 0; qbk < 4; ++qbk) {
        const int qrel = 64 * (w & 1) + 16 * qbk, q = Q0 + qrel + fr;
        bf16x8 qf[2];
        { const bf16* qp = PA + (size_t)(b * SEQ + q) * NPA + C_QA + 64 * qh + 8 * g; qf[0] = *(const GAS bf16x8*)qp; qf[1] = *(const GAS bf16x8*)(qp + 32); }
        f32x4 s[17]; float mx = sk;
#pragma unroll
        for (int t = 0; t < 17; ++t) { const int krel = qrel + 16 * t;
            const LAS unsigned char* kp = lds + AT_KOFF + (krel + fr) * AT_PITCH + g * 16;
            f32x4 a = (f32x4){0.f, 0.f, 0.f, 0.f};
            a = mfma16(*(const LAS bf16x8*)kp, qf[0], a); a = mfma16(*(const LAS bf16x8*)(kp + 64), qf[1], a);
#pragma unroll
            for (int r = 0; r < 4; ++r) { const int key = Q0 - 128 + krel + 4 * g + r; const int dlt = key - q;
                const bool ok = (dlt >= -WINDOW) && (dlt <= WINDOW) && (key >= 0) && (key < SEQ); a[r] = ok ? a[r] : -3.0e38f; mx = fmaxf(mx, a[r]); }
            s[t] = a; }
        mx = fmaxf(mx, __shfl_xor(mx, 16)); mx = fmaxf(mx, __shfl_xor(mx, 32));
        float den = 0.f;
#pragma unroll
        for (int t = 0; t < 17; ++t)
#pragma unroll
            for (int r = 0; r < 4; ++r) { const float p = (s[t][r] > -1.0e38f) ? exp2f(s[t][r] - mx) : 0.f; s[t][r] = p; den += p; }
        den += __shfl_xor(den, 16); den += __shfl_xor(den, 32); den += exp2f(sk - mx);
        const float inv = 1.0f / den;
        f32x4 o[4];
#pragma unroll
        for (int dt = 0; dt < 4; ++dt) o[dt] = (f32x4){0.f, 0.f, 0.f, 0.f};
#pragma unroll
        for (int tp = 0; tp < 9; ++tp) { const int t0 = 2 * tp, t1 = (2 * tp + 1 < 17) ? 2 * tp + 1 : 2 * tp;
            float pv[8];
#pragma unroll
            for (int r = 0; r < 4; ++r) { pv[r] = s[t0][r]; pv[4 + r] = (2 * tp + 1 < 17) ? s[t1][r] : 0.f; }
            const bf16x8 pf = pack_frag(pv);
            const LAS unsigned char* v0 = lds + AT_VOFF + (qrel + 16 * t0 + 4 * g + (fr >> 2)) * AT_PITCH + (fr & 3) * 8;
            const LAS unsigned char* v1 = lds + AT_VOFF + (qrel + 16 * t1 + 4 * g + (fr >> 2)) * AT_PITCH + (fr & 3) * 8;
#pragma unroll
            for (int dt = 0; dt < 4; ++dt) o[dt] = mfma16(join8(tr_read(v0 + dt * 32), tr_read(v1 + dt * 32)), pf, o[dt]); }
        bf16* yp = YA + (size_t)(b * SEQ + q) * 512 + 64 * qh + 4 * g;
#pragma unroll
        for (int dt = 0; dt < 4; ++dt) { v2u wv; wv.x = cvt_pk_bf16(o[dt][0] * inv, o[dt][1] * inv); wv.y = cvt_pk_bf16(o[dt][2] * inv, o[dt][3] * inv); *(GAS v2u*)(yp + 16 * dt) = wv; }
    }
    __syncthreads();
}

constexpr int HG_PITCH = 272;
constexpr int HG_V = 0, HG_KF = 128 * HG_PITCH, HG_KB = 2 * 128 * HG_PITCH, HG_TOT = 3 * 128 * HG_PITCH;
static_assert(HG_TOT + 2 * 8 * 128 * 4 <= RING_BYTES, "hgrn LDS");
__device__ __forceinline__ void hg_load_scan8(const bf16* p8  , float (&lf)[8], float (&P)[8], float (&T)[8], int lane) {
    const h16x8 hv = *(const GAS h16x8*)p8;
#pragma unroll
    for (int jj = 0; jj < 8; ++jj) { lf[jj] = (float)hv[jj]; P[jj] = scan16(lf[jj]); T[jj] = __shfl(P[jj], (lane & 48) | 15); }
}
__device__ __forceinline__ void ha_unit(Frame& F, int unit) {
    const int bh = unit >> 7, n = unit & 127, b = bh >> 2, h = bh & 3, t0 = n * CH;
    const bf16* PA = (const bf16*)(F.ws + WS_PA); bf16* US = (bf16*)(F.ws + WS_US); float* HD = (float*)(F.ws + WS_HD);
    LAS unsigned char* lds = F.lds + RING_OFF; LAS float* tot = (LAS float*)(lds + HG_TOT);
    const int lane = F.lane, w = F.wave, fr = lane & 15, g = lane >> 4, dir = w >> 2;
    for (int idx = F.tid; idx < 128 * 16; idx += NWAVES * 64) { const int r = idx >> 4, ch = idx & 15;
        *(LAS v4u*)(lds + HG_V + r * HG_PITCH + ch * 16) = *(const GAS v4u*)(PA + (size_t)(b * SEQ + t0 + r) * NPA + C_VH + 128 * h + 8 * ch); }
#pragma unroll
    for (int bb = 0; bb < 2; ++bb) { const int j = 2 * (w & 3) + bb; const bf16* rp = PA + (size_t)(b * SEQ + t0 + 16 * j + fr) * NPA + (dir ? C_LB : C_LF) + 128 * h + 8 * g;
#pragma unroll
        for (int ks = 0; ks < 4; ++ks) { float lf[8], P[8], T[8]; hg_load_scan8(rp + 32 * ks, lf, P, T, lane);
            if (fr == 0) {
#pragma unroll
                for (int jj = 0; jj < 8; ++jj) tot[(dir * 8 + j) * 128 + 32 * ks + 8 * g + jj] = T[jj]; } } }
    __syncthreads();
#pragma unroll
    for (int bb = 0; bb < 2; ++bb) { const int j = 2 * (w & 3) + bb; const bf16* rp = PA + (size_t)(b * SEQ + t0 + 16 * j + fr) * NPA + (dir ? C_LB : C_LF) + 128 * h + 8 * g;
#pragma unroll
        for (int ks = 0; ks < 4; ++ks) { float lf[8], P[8], T[8], kv[8]; hg_load_scan8(rp + 32 * ks, lf, P, T, lane);
#pragma unroll
            for (int jj = 0; jj < 8; ++jj) { const int d = 32 * ks + 8 * g + jj; float cr = 0.f;
#pragma unroll
                for (int j2 = 0; j2 < 8; ++j2) { const float tv = tot[(dir * 8 + j2) * 128 + d]; cr += ((dir ? (j2 < j) : (j2 > j)) ? tv : 0.f); }
                const float wi = dir ? (P[jj] - lf[jj]) : (T[jj] - P[jj]); kv[jj] = -expm1f(lf[jj]) * __expf(wi + cr); }
            *(LAS bf16x8*)(lds + (dir ? HG_KB : HG_KF) + (16 * j + fr) * HG_PITCH + (32 * ks + 8 * g) * 2) = pack_frag(kv); } }
    if ((w & 3) == 0 && lane < 32) {
#pragma unroll
        for (int k = 0; k < 4; ++k) { const int d = 4 * lane + k; float sacc = 0.f;
#pragma unroll
            for (int j2 = 0; j2 < 8; ++j2) sacc += tot[(dir * 8 + j2) * 128 + d];
            HD[((size_t)(bh * 2 + dir) * NCH + n) * 128 + d] = __expf(sacc); } }
    __syncthreads();
    const int dq = w & 3; f32x4 acc[2][8];
#pragma unroll
    for (int mt = 0; mt < 2; ++mt)
#pragma unroll
        for (int nt = 0; nt < 8; ++nt) acc[mt][nt] = (f32x4){0.f, 0.f, 0.f, 0.f};
    const LAS unsigned char* kb = lds + (dir ? HG_KB : HG_KF) + (8 * g + (fr >> 2)) * HG_PITCH + (fr & 3) * 8;
    const LAS unsigned char* vb = lds + HG_V + (8 * g + (fr >> 2)) * HG_PITCH + (fr & 3) * 8;
#pragma unroll
    for (int ks = 0; ks < 4; ++ks) { bf16x8 af[2];
#pragma unroll
        for (int mt = 0; mt < 2; ++mt) { const LAS unsigned char* p = kb + (32 * ks) * HG_PITCH + (16 * (2 * dq + mt)) * 2; af[mt] = join8(tr_read(p), tr_read(p + 4 * HG_PITCH)); }
#pragma unroll
        for (int nt = 0; nt < 8; ++nt) { const LAS unsigned char* p = vb + (32 * ks) * HG_PITCH + (16 * nt) * 2; const bf16x8 bfr = join8(tr_read(p), tr_read(p + 4 * HG_PITCH));
#pragma unroll
            for (int mt = 0; mt < 2; ++mt) acc[mt][nt] = mfma16(af[mt], bfr, acc[mt][nt]); } }
    bf16* up = US + ((size_t)(bh * 2 + dir) * NCH + n) * 128 * 128;
#pragma unroll
    for (int mt = 0; mt < 2; ++mt)
#pragma unroll
        for (int nt = 0; nt < 8; ++nt) { v2u wv; wv.x = cvt_pk_bf16(acc[mt][nt][0], acc[mt][nt][1]); wv.y = cvt_pk_bf16(acc[mt][nt][2], acc[mt][nt][3]);
            *(GAS v2u*)(up + (size_t)(16 * nt + fr) * 128 + 16 * (2 * dq + mt) + 4 * g) = wv; }
    __syncthreads();
}
__device__ __forceinline__ void phase_hb(Frame& F) {
    bf16* US = (bf16*)(F.ws + WS_US); const float* HD = (const float*)(F.ws + WS_HD);
    const int idx = F.vcu * (NWAVES * 64) + F.tid;
    for (int e0 = idx; e0 < 16 * 128 * 64; e0 += F.G * NWAVES * 64) { const int dp = e0 & 63, e = (e0 >> 6) & 127, combo = e0 >> 13, dir = combo & 1;
        float s0 = 0.f, s1 = 0.f;
        GAS unsigned* up = (GAS unsigned*)(US + (size_t)combo * NCH * 128 * 128 + (size_t)e * 128) + dp; const GAS float* dpp = (const GAS float*)HD + (size_t)combo * NCH * 128 + 2 * dp;
#pragma unroll 8
        for (int k = 0; k < NCH; ++k) { const int n = dir ? (NCH - 1 - k) : k;
            const unsigned u = up[(size_t)n * (128 * 128 / 2)]; const float d0 = dpp[n * 128], d1 = dpp[n * 128 + 1];
            up[(size_t)n * (128 * 128 / 2)] = pk2(s0, s1);
            s0 = d0 * s0 + bflo(u); s1 = d1 * s1 + bfhi(u); }
    }
}
#ifndef HC_TERMS
#define HC_TERMS 7
#endif
__device__ __forceinline__ void hc_unit(Frame& F, int unit, const float* hng) {
    const int h = unit & 3, n = (unit >> 2) & 127, b = unit >> 9, bh = b * 4 + h, t0 = n * CH;
    const bf16* PA = (const bf16*)(F.ws + WS_PA); const bf16* US = (const bf16*)(F.ws + WS_US); bf16* YH = (bf16*)(F.ws + WS_YH); float* ssq = (float*)(F.ws + WS_SSQ);
    LAS unsigned char* lds = F.lds + RING_OFF; LAS float* ebl = (LAS float*)(lds + HG_TOT);
    const int lane = F.lane, i = F.wave, fr = lane & 15, g = lane >> 4;
    const size_t trow = (size_t)(b * SEQ + t0 + 16 * i + fr);
    for (int idx = F.tid; idx < 128 * 16; idx += NWAVES * 64) { const int r = idx >> 4, ch = idx & 15;
        *(LAS v4u*)(lds + HG_V + r * HG_PITCH + ch * 16) = *(const GAS v4u*)(PA + (size_t)(b * SEQ + t0 + r) * NPA + C_VH + 128 * h + 8 * ch); }
    f32x4 o[8];
#pragma unroll
    for (int et = 0; et < 8; ++et) o[et] = (f32x4){0.f, 0.f, 0.f, 0.f};
    const LAS unsigned char* vtr = lds + HG_V + (4 * g + (fr >> 2)) * HG_PITCH + (fr & 3) * 8;
#pragma unroll
    for (int dir = 0; dir < 2; ++dir) {
        float ql[32]; bf16x8 kst[4]; bf16x8 qf[4];
#pragma unroll
        for (int ks = 0; ks < 4; ++ks) { float lf[8], P[8], T[8], ke[8], kd[8], t8[8];
            hg_load_scan8(PA + trow * NPA + (dir ? C_LB : C_LF) + 128 * h + 32 * ks + 8 * g, lf, P, T, lane);
            const v4u qw = *(const GAS v4u*)(PA + trow * NPA + C_QH + 128 * h + 32 * ks + 8 * g);
            const float qv[8] = {bflo(qw.x), bfhi(qw.x), bflo(qw.y), bfhi(qw.y), bflo(qw.z), bfhi(qw.z), bflo(qw.w), bfhi(qw.w)};
#pragma unroll
            for (int jj = 0; jj < 8; ++jj) { const float kk = -expm1f(lf[jj]);
                const float binc = dir ? (T[jj] - P[jj] + lf[jj]) : P[jj];
                const float wend = dir ? (P[jj] - lf[jj]) : (T[jj] - P[jj]);
                ql[8 * ks + jj] = qv[jj] * __expf(binc); t8[jj] = ql[8 * ks + jj]; ke[jj] = kk * __expf(wend); kd[jj] = kk * __expf(-binc);
#if defined(HC_DBG) && HC_DBG >= 3
                ql[8 * ks + jj] = qv[jj]; t8[jj] = qv[jj]; kd[jj] = kk;
                if (HC_DBG == 4) kd[jj] = (32 * ks + 8 * g + jj == 0) ? 1.0f : 0.f;
                if (HC_DBG == 5) kd[jj] = (32 * ks + 8 * g + jj == 0) ? kk : 0.f;
                if (HC_DBG >= 9) kd[jj] = 0.f;
                if (HC_DBG == 8) kd[jj] = (32 * ks + 8 * g + jj == 0) ? (float)fr : 0.f;
                if (HC_DBG == 6) kd[jj] = (32 * ks + 8 * g + jj == 0) ? lf[jj] : 0.f;
                if (HC_DBG == 7) kd[jj] = (32 * ks + 8 * g + jj == 0) ? (1.0f - __expf(lf[jj])) : 0.f;
#endif
                }
            *(LAS bf16x8*)(lds + (dir ? HG_KB : HG_KF) + (16 * i + fr) * HG_PITCH + (32 * ks + 8 * g) * 2) = pack_frag(ke);
            kst[ks] = pack_frag(kd); qf[ks] = pack_frag(t8);
            if (fr == 0) {
#pragma unroll
                for (int jj = 0; jj < 8; ++jj) ebl[(dir * 8 + i) * 128 + 32 * ks + 8 * g + jj] = __expf(T[jj]); } }
        __syncthreads();
        f32x4 at = (f32x4){0.f, 0.f, 0.f, 0.f};
#pragma unroll
        for (int ks = 0; ks < 4; ++ks) at = mfma16(kst[ks], qf[ks], at);
#if defined(HC_DBG) && HC_DBG >= 9
        { const float q0 = __shfl(ql[0], fr);
          for (int r = 0; r < 4; ++r) at[r] = (HC_DBG == 9) ? (float)(4 * g + r) * q0 : ((HC_DBG == 10) ? (float)(4 * g + r) : (float)fr); }
#endif
        float pend[4]; int jpend = i;
#pragma unroll
        for (int r = 0; r < 4; ++r) { const int s = 4 * g + r; const bool keep = (HC_TERMS & 1) && (dir ? (s >= fr) : (s <= fr)); pend[r] = keep ? at[r] : 0.f;
#if defined(HC_DBG) && HC_DBG == 1
            pend[r] = (dir == 0 && s == fr) ? 1.0f : 0.f;
#endif
            }
        bool have = true;
        const int nj = dir ? (7 - i) : i;
        for (int k = 0; k < nj; ++k) { const int j = dir ? (i + 1 + k) : (i - 1 - k);
            f32x4 a2 = (f32x4){0.f, 0.f, 0.f, 0.f};
            const LAS unsigned char* kp = lds + (dir ? HG_KB : HG_KF) + (16 * j + fr) * HG_PITCH + g * 16;
#pragma unroll
            for (int ks = 0; ks < 4; ++ks) a2 = mfma16(*(const LAS bf16x8*)(kp + ks * 64), qf[ks], a2);
#pragma unroll
            for (int ks = 0; ks < 4; ++ks) { const LAS float* ep = ebl + (dir * 8 + j) * 128 + 32 * ks + 8 * g; float t8[8];
#pragma unroll
                for (int jj = 0; jj < 8; ++jj) { ql[8 * ks + jj] *= ep[jj]; t8[jj] = ql[8 * ks + jj]; }
                qf[ks] = pack_frag(t8); }
            if (have) { float pv[8];
#pragma unroll
                for (int r = 0; r < 4; ++r) { pv[r] = pend[r]; pv[4 + r] = (HC_TERMS & 2) ? a2[r] : 0.f; }
                const bf16x8 pf = pack_frag(pv); const LAS unsigned char* v0 = vtr + 16 * jpend * HG_PITCH; const LAS unsigned char* v1 = vtr + 16 * j * HG_PITCH;
#pragma unroll
                for (int et = 0; et < 8; ++et) o[et] = mfma16(join8(tr_read(v0 + et * 32), tr_read(v1 + et * 32)), pf, o[et]);
                have = false;
            } else {
#pragma unroll
                for (int r = 0; r < 4; ++r) pend[r] = (HC_TERMS & 2) ? a2[r] : 0.f;
                jpend = j; have = true; }
        }
        if (have) { float pv[8];
#pragma unroll
            for (int r = 0; r < 4; ++r) { pv[r] = pend[r]; pv[4 + r] = 0.f; }
            const bf16x8 pf = pack_frag(pv); const LAS unsigned char* v0 = vtr + 16 * jpend * HG_PITCH;
#pragma unroll
            for (int et = 0; et < 8; ++et) o[et] = mfma16(join8(tr_read(v0 + et * 32), tr_read(v0 + et * 32)), pf, o[et]); }
        const bf16* sp = US + ((size_t)(bh * 2 + dir) * NCH + n) * 128 * 128 + (size_t)fr * 128 + 8 * g;
#pragma unroll
        for (int et = 0; et < 8; ++et)
#pragma unroll
            for (int ks = 0; ks < 4; ++ks) if (HC_TERMS & 4) o[et] = mfma16(*(const GAS bf16x8*)(sp + (size_t)(16 * et) * 128 + 32 * ks), qf[ks], o[et]);
    }
    float sq = 0.f; bf16* yp = YH + trow * 512 + 128 * h + 4 * g; const bf16* sgp = PA + trow * NPA + C_SG + 128 * h + 4 * g; const float* gp = hng + 128 * h + 4 * g;
#pragma unroll
    for (int et = 0; et < 8; ++et) { const v2u sw = *(const GAS v2u*)(sgp + 16 * et); const f32x4 gv = *(const f32x4*)(gp + 16 * et); const f32x4 ov = o[et];
        sq += (ov[0] * ov[0] + ov[1] * ov[1]) + (ov[2] * ov[2] + ov[3] * ov[3]);
        v2u wv; wv.x = cvt_pk_bf16(ov[0] * gv[0] * bflo(sw.x), ov[1] * gv[1] * bfhi(sw.x)); wv.y = cvt_pk_bf16(ov[2] * gv[2] * bflo(sw.y), ov[3] * gv[3] * bfhi(sw.y));
        *(GAS v2u*)(yp + 16 * et) = wv; }
    sq += __shfl_xor(sq, 16); sq += __shfl_xor(sq, 32);
    if (g == 0) ssq[trow * 4 + h] = sq;
    __syncthreads();
}
__device__ __forceinline__ void phase_attn_ha(Frame& F, const float* sink) {
    for (int u = F.vcu; u < BATCH * NKVH * (SEQ / 128); u += F.G) attn_unit(F, 0, u, sink);
    for (int u = F.vcu; u < BATCH * HH * NCH; u += F.G) ha_unit(F, u);
}
__device__ __forceinline__ void phase_hc(Frame& F, const float* hng) {
    for (int u = F.vcu; u < BATCH * NCH * HH; u += F.G) hc_unit(F, u, hng);
}

#else
__device__ void phase_attn_ha(Frame& F, const float* sink);
__device__ void phase_hb(Frame& F);
__device__ void phase_hc(Frame& F, const float* hng);
#endif

#if defined(ORACLE)
__global__ void __launch_bounds__(256) simple_attn(const bf16* PA, const float* sink, bf16* YA) {
    const int lane = threadIdx.x & 63, task = blockIdx.x * 4 + (threadIdx.x >> 6);
    const int m = task >> 3, qh = task & 7, kvh = qh >> 2, b = m / SEQ, t = m % SEQ;
    float q[64];
    { const bf16* qp = PA + (size_t)m * NPA + C_QA + 64 * qh;
#pragma unroll
      for (int d = 0; d < 64; ++d) q[d] = bf2f(qp[d]); }
    float s[5]; float mx = sink[qh] * LOG2E;
#pragma unroll
    for (int r = 0; r < 5; ++r) { const int j = t - WINDOW + 64 * r + lane; const bool ok = (j >= 0) && (j < SEQ) && (j <= t + WINDOW);
        float a = -3.0e38f;
        if (ok) { const bf16* kp = PA + (size_t)(b * SEQ + j) * NPA + C_KA + 64 * kvh; a = 0.f;
#pragma unroll
            for (int d = 0; d < 64; ++d) a += q[d] * bf2f(kp[d]); }
        s[r] = a; mx = fmaxf(mx, a); }
#pragma unroll
    for (int o = 1; o < 64; o <<= 1) mx = fmaxf(mx, __shfl_xor(mx, o));
    float den = 0.f;
#pragma unroll
    for (int r = 0; r < 5; ++r) { s[r] = (s[r] > -1.0e38f) ? exp2f(s[r] - mx) : 0.f; den += s[r]; }
    den = wave_sum(den) + exp2f(sink[qh] * LOG2E - mx);
    float o = 0.f;
    for (int r = 0; r < 5; ++r) for (int jj = 0; jj < 64; ++jj) { const int j = t - WINDOW + 64 * r + jj; const float p = __shfl(s[r], jj);
        if (j >= 0 && j < SEQ && j <= t + WINDOW) o += p * bf2f(PA[(size_t)(b * SEQ + j) * NPA + C_VA + 64 * kvh + lane]); }
#if defined(ABL_NOATTN)
    YA[(size_t)m * 512 + 64 * qh + lane] = 0;
#else
    YA[(size_t)m * 512 + 64 * qh + lane] = (bf16)f2bf(o / den);
#endif
}
__global__ void __launch_bounds__(512) simple_hgrn(const bf16* PA, const float* hng, float* obuf, bf16* YH, float* ssq) {
    __shared__ float part[32][4][128];
    const int tid = threadIdx.x, e = tid & 127, dq = tid >> 7, b = blockIdx.x >> 2, h = blockIdx.x & 3;
    for (int dir = 0; dir < 2; ++dir) {
        float S[32];
#pragma unroll
        for (int d = 0; d < 32; ++d) S[d] = 0.f;
        for (int t0 = 0; t0 < SEQ; t0 += 32) {
            for (int tt = 0; tt < 32; ++tt) { const int t = dir ? (SEQ - 1 - (t0 + tt)) : (t0 + tt); const bf16* row = PA + (size_t)(b * SEQ + t) * NPA;
                const float v = bf2f(row[C_VH + 128 * h + e]); const _Float16* lf = (const _Float16*)(row + (dir ? C_LB : C_LF) + 128 * h + 32 * dq); const bf16* qp = row + C_QH + 128 * h + 32 * dq;
                float o = 0.f;
#pragma unroll
                for (int d = 0; d < 32; ++d) { const float l = (float)lf[d], f = expf(l), k = -expm1f(l); S[d] = f * S[d] + k * v; o += S[d] * bf2f(qp[d]); }
                part[tt][dq][e] = o; }
            __syncthreads();
            for (int idx = tid; idx < 32 * 128; idx += 512) { const int tt = idx >> 7, ee = idx & 127; const int t = dir ? (SEQ - 1 - (t0 + tt)) : (t0 + tt); const size_t m = (size_t)b * SEQ + t;
                float o = (part[tt][0][ee] + part[tt][1][ee]) + (part[tt][2][ee] + part[tt][3][ee]);
                if (dir == 0) obuf[m * 512 + 128 * h + ee] = o;
                else { o += obuf[m * 512 + 128 * h + ee];
                    const float sg = bf2f(PA[m * NPA + C_SG + 128 * h + ee]);
#if defined(ABL_NOHGRN)
                    YH[m * 512 + 128 * h + ee] = 0;
#else
                    YH[m * 512 + 128 * h + ee] = (bf16)f2bf(o * hng[128 * h + ee] * sg);
#endif

                    const float q = wave_sum(o * o);
                    if ((tid & 63) == 0) atomicAdd(&ssq[m * 4 + h], q); } }
            __syncthreads();
        }
    }
}
__global__ void zero_f32(float* p, int n) { const int i = blockIdx.x * blockDim.x + threadIdx.x; if (i < n) p[i] = 0.f; }
#endif

#if defined(CHECK)
#define CK_NS 48
__device__ __forceinline__ int ck_row(int s) { return (int)(((long)s * 10007 + 77) % T); }
__device__ __forceinline__ bool ck_cmp(float got, float ref, float rtol, float atol, unsigned* cnt) { const float d = fabsf(got - ref); if (!(d <= rtol * fabsf(ref) + atol)) { atomicAdd(cnt, 1u); return true; } return false; }
__global__ void ck_norm(const float* x, const float* g, const bf16* XN, unsigned* cnt) {
    const int m = ck_row(blockIdx.x); __shared__ float red[256];
    float s = 0.f; for (int c = threadIdx.x; c < D; c += 256) { const float v = x[(size_t)m * D + c]; s += v * v; }
    red[threadIdx.x] = s; __syncthreads(); for (int o = 128; o > 0; o >>= 1) { if (threadIdx.x < o) red[threadIdx.x] += red[threadIdx.x + o]; __syncthreads(); }
    const float rstd = 1.0f / sqrtf(red[0] / D + NORM_EPS);
    for (int c = threadIdx.x; c < D; c += 256) ck_cmp(bf2f(XN[(size_t)m * D + c]), x[(size_t)m * D + c] * rstd * g[c], 0.01f, 0.01f, cnt);
}
__global__ void ck_pa(const bf16* XN, const float* w_in, const float* lb_tab  , int l, const bf16* PA, unsigned* cnt) {
    const int m = ck_row(blockIdx.x), pos = m % SEQ; __shared__ float z[NPA]; __shared__ float xr[D];
    for (int c = threadIdx.x; c < D; c += 256) xr[c] = bf2f(XN[(size_t)m * D + c]);
    __syncthreads();
    for (int c = threadIdx.x; c < NPA; c += 256) { float a = 0.f; for (int k = 0; k < D; ++k) a += xr[k] * w_in[(size_t)k * INW + c]; z[c] = a; }
    __syncthreads();
    for (int c = threadIdx.x; c < NPA; c += 256) {
        const float got_b = bf2f(PA[(size_t)m * NPA + c]); const float got_h = (float)((const _Float16*)PA)[(size_t)m * NPA + c];
        if (c < C_VA) { const int d = c & 63, i = d & 31; const double inv = exp2(-(double)i * (13.287712379549449 / 32.0)); const float cs = (float)cos((double)pos * inv), sn = (float)sin((double)pos * inv);
            const float x1 = z[(c & ~63) + i], x2 = z[(c & ~63) + i + 32]; float r = (d < 32) ? (x1 * cs - x2 * sn) : (x2 * cs + x1 * sn); if (c < C_KA) r *= QSCALE;
            ck_cmp(got_b, r, 0.02f, 0.03f, cnt + 0);
        } else if (c < C_QH) ck_cmp(got_b, z[c], 0.02f, 0.02f, cnt + 1);
        else if (c < C_LF) ck_cmp(got_b, z[c] / (1.f + expf(-z[c])), 0.02f, 0.02f, cnt + 2);
        else if (c < C_VH) { const int dir = (c >= C_LB), col = c - (dir ? C_LB : C_LF);
            float t0 = lb_tab[(0 * 2 + dir) * 512 + col], t1 = lb_tab[(1 * 2 + dir) * 512 + col]; const float mx = fmaxf(t0, t1); t0 = expf(t0 - mx); t1 = expf(t1 - mx);
            const float lb = (l == 0) ? 0.f : t1 / (t0 + t1); const float sg = 1.f / (1.f + expf(-z[c])); const float r = fmaxf(logf(lb + (1.f - lb) * sg), LOGF_MIN);
            ck_cmp(got_h, r, 0.01f, 0.02f, cnt + 3);
        } else if (c < C_SG) ck_cmp(got_b, z[c], 0.02f, 0.02f, cnt + 4);
        else ck_cmp(got_b, z[c] / (1.f + expf(-z[c])), 0.02f, 0.02f, cnt + 5);
    }
}
__global__ void ck_mix(const bf16* XN, const float* w_in, const bf16* YA, const bf16* YH, const float* ssq, const float* wua, const float* wuh, const bf16* GT, const bf16* MG, int which, unsigned* cnt) {
#ifndef CK_SHIFT
#define CK_SHIFT 0
#endif
    const int m = ck_row((blockIdx.x + CK_SHIFT) % CK_NS); __shared__ float xr[D]; __shared__ float ya[512]; __shared__ float yh[512];
    for (int c = threadIdx.x; c < D; c += 256) xr[c] = bf2f(XN[(size_t)m * D + c]);
    for (int c = threadIdx.x; c < 512; c += 256) { ya[c] = bf2f(YA[(size_t)m * 512 + c]); yh[c] = bf2f(YH[(size_t)m * 512 + c]); }
    __syncthreads();
    const float rstd = 1.0f / sqrtf((ssq[m * 4] + ssq[m * 4 + 1] + ssq[m * 4 + 2] + ssq[m * 4 + 3]) / 512.f + NORM_EPS);
    for (int c = threadIdx.x; c < D; c += 256) { float a = 0.f, b = 0.f, p = 0.f, q = 0.f;
        for (int k = 0; k < D; ++k) { a += xr[k] * w_in[(size_t)k * INW + NPA + c]; b += xr[k] * w_in[(size_t)k * INW + NPA + 1024 + c]; }
        for (int k = 0; k < 512; ++k) { p += ya[k] * wua[(size_t)k * D + c]; q += yh[k] * wuh[(size_t)k * D + c]; }
        float ga = 1.f / (1.f + expf(-a)), gb = 1.f / (1.f + expf(-b));
        if (which != 0) { ga = bf2f(GT[(size_t)m * NGATE + c]); gb = bf2f(GT[(size_t)m * NGATE + 1024 + c]); }
        if (which == 0) { unsigned* dbg = cnt + 100; if (blockIdx.x == 27) { const float e0 = fabsf(bf2f(GT[(size_t)m * NGATE + c]) - ga), e1 = fabsf(bf2f(GT[(size_t)m * NGATE + 1024 + c]) - gb); atomicMax(dbg + 200, __float_as_uint(e0)); atomicMax(dbg + 200, __float_as_uint(e1)); atomicMax(dbg + 201, __float_as_uint(fabsf(a))); atomicMax(dbg + 201, __float_as_uint(fabsf(b))); if (GT[(size_t)m * NGATE + c] == 0xFFFFu) atomicAdd(dbg + 203, 1u); if (GT[(size_t)m * NGATE + 1024 + c] == 0xFFFFu) atomicAdd(dbg + 203, 1u); if (e0 > 0.2f) { atomicAdd(dbg + 202, 1u); atomicOr(dbg + 210 + (c >> 11), 0u); atomicAdd(dbg + 300 + (c >> 6), 1u); } if (e1 > 0.2f) { atomicAdd(dbg + 202, 1u); atomicAdd(dbg + 300 + 16 + (c >> 6), 1u); } } if (ck_cmp(bf2f(GT[(size_t)m * NGATE + c]), ga, 0.01f, 0.01f, cnt + 0)) { atomicAdd(dbg + blockIdx.x, 1u); atomicAdd(dbg + 64 + (c >> 5), 1u); } if (ck_cmp(bf2f(GT[(size_t)m * NGATE + 1024 + c]), gb, 0.01f, 0.01f, cnt + 0)) { atomicAdd(dbg + blockIdx.x, 1u); atomicAdd(dbg + 64 + 32 + (c >> 5), 1u); } }
        else if (which == 1) ck_cmp(bf2f(MG[(size_t)m * D + c]), ga * p, 0.03f, 0.01f, cnt + 1);
        else ck_cmp(bf2f(MG[(size_t)m * D + c]), ga * p + gb * rstd * q, 0.03f, 0.02f, cnt + 2); }
}
__global__ void ck_out(const float* xprev, const bf16* MG, const float* wout, const float* X, unsigned* cnt) {
    const int m = ck_row(blockIdx.x); __shared__ float mg[D];
    for (int c = threadIdx.x; c < D; c += 256) mg[c] = bf2f(MG[(size_t)m * D + c]);
    __syncthreads();
    for (int c = threadIdx.x; c < D; c += 256) { float a = 0.f; for (int k = 0; k < D; ++k) a += mg[k] * wout[(size_t)k * D + c]; ck_cmp(X[(size_t)m * D + c], xprev[(size_t)m * D + c] + a, 0.01f, 0.02f, cnt); }
}
__global__ void ck_moe(const float* X, const float* g, const float* wrg, const float* brg, const float* wre, const float* bre, const float* weg, const float* weu, const float* wed,
                       const bf16* XN, const int* tok_e, const float* tok_w, const int* tok_p, const int* meta, const bf16* XP, const bf16* ACT, const bf16* Y, int stage, unsigned* cnt) {
    const int m = ck_row(blockIdx.x); __shared__ float h[D]; __shared__ float red[256]; __shared__ float lg[36]; __shared__ float act[DEXP];
    float s = 0.f; for (int c = threadIdx.x; c < D; c += 256) { const float v = X[(size_t)m * D + c]; s += v * v; }
    red[threadIdx.x] = s; __syncthreads(); for (int o = 128; o > 0; o >>= 1) { if (threadIdx.x < o) red[threadIdx.x] += red[threadIdx.x + o]; __syncthreads(); }
    const float rstd = 1.0f / sqrtf(red[0] / D + NORM_EPS);
    for (int c = threadIdx.x; c < D; c += 256) h[c] = X[(size_t)m * D + c] * rstd * g[c];
    __syncthreads();
    if (threadIdx.x < 36) { const int t = threadIdx.x; float a = 0.f;
        if (t < 4) { for (int k = 0; k < D; ++k) a += h[k] * wrg[k * 4 + t]; a += brg[t]; } else { const int gg = (t - 4) >> 3, e = (t - 4) & 7; for (int k = 0; k < D; ++k) a += h[k] * wre[((size_t)gg * D + k) * 8 + e]; a += bre[gg * 8 + e]; }
        lg[t] = a; }
    __syncthreads();
    int gt = 0; for (int k = 1; k < 4; ++k) if (lg[k] > lg[gt]) gt = k;
    float gden = 0.f; for (int k = 0; k < 4; ++k) gden += expf(lg[k] - lg[gt]);
    const float* el = lg + 4 + gt * 8; int i1 = 0; for (int k = 1; k < 8; ++k) if (el[k] > el[i1]) i1 = k; int i2 = (i1 == 0) ? 1 : 0; for (int k = 0; k < 8; ++k) if (k != i1 && el[k] > el[i2]) i2 = k;
    const float q2 = expf(el[i2] - el[i1]); const float w1 = (1.f / gden) / (1.f + q2), w2 = (1.f / gden) * q2 / (1.f + q2);
    const int e1 = gt * 8 + i1, e2 = gt * 8 + i2;
    if (stage == 0) { if (threadIdx.x == 0) { if (tok_e[2 * m] != e1 || tok_e[2 * m + 1] != e2) atomicAdd(cnt + 0, 1u); ck_cmp(tok_w[2 * m], w1, 0.01f, 1e-3f, cnt + 1); ck_cmp(tok_w[2 * m + 1], w2, 0.01f, 1e-3f, cnt + 1); } return; }
    for (int kk = 0; kk < 2; ++kk) { const int e = tok_e[2 * m + kk], p = tok_p[2 * m + kk];
        if (stage == 1) { if (threadIdx.x == 0) { const int rt = p >> 8; if (rt >= meta[0] || meta[1 + rt] != e) atomicAdd(cnt + 2, 1u); }
            for (int c = threadIdx.x; c < D; c += 256) if (XP[(size_t)p * D + c] != XN[(size_t)m * D + c]) atomicAdd(cnt + 3, 1u); continue; }
        const float* wg = weg + (size_t)e * D * DEXP; const float* wu = weu + (size_t)e * D * DEXP; const float* wd = wed + (size_t)e * DEXP * D;
        __syncthreads();
        for (int j = threadIdx.x; j < DEXP; j += 256) { float a = 0.f, b = 0.f; for (int k = 0; k < D; ++k) { const float hv = bf2f(XN[(size_t)m * D + k]); a += hv * wg[(size_t)k * DEXP + j]; b += hv * wu[(size_t)k * DEXP + j]; }
            const float r = a / (1.f + expf(-a)) * b; act[j] = r; if (stage == 2) ck_cmp(bf2f(ACT[(size_t)p * DEXP + j]), r, 0.03f, 0.02f, cnt + 4); }
        __syncthreads();
        if (stage == 3) for (int c = threadIdx.x; c < D; c += 256) { float a = 0.f; for (int j = 0; j < DEXP; ++j) a += act[j] * wd[(size_t)j * D + c]; ck_cmp(bf2f(Y[(size_t)p * D + c]), a, 0.03f, 0.03f, cnt + 5); }
    }
}

__global__ void ck_attn(const bf16* PA, const float* sink, const bf16* YA, unsigned* cnt) {
    const int m = ck_row(blockIdx.x), b = m / SEQ, t = m % SEQ; __shared__ float sc[512]; __shared__ float red[256];
    for (int qh = 0; qh < NQH; ++qh) { const int kvh = qh / 4;
        const bf16* qp = PA + (size_t)m * NPA + C_QA + 64 * qh;
        for (int jj = threadIdx.x; jj < 2 * WINDOW + 1; jj += 256) { const int j = t - WINDOW + jj; float a = -1e30f;
            if (j >= 0 && j < SEQ) { a = 0.f; const bf16* kp = PA + (size_t)(b * SEQ + j) * NPA + C_KA + 64 * kvh; for (int d = 0; d < 64; ++d) a += bf2f(qp[d]) * bf2f(kp[d]); a *= 0.6931471805599453f; }
            sc[jj] = a; }
        __syncthreads();
        float mx = sink[qh]; for (int jj = 0; jj < 2 * WINDOW + 1; ++jj) mx = fmaxf(mx, sc[jj]);
        float den = expf(sink[qh] - mx); for (int jj = 0; jj < 2 * WINDOW + 1; ++jj) den += expf(sc[jj] - mx);
        if (threadIdx.x < 64) { const int d = threadIdx.x; float o = 0.f; for (int jj = 0; jj < 2 * WINDOW + 1; ++jj) { const int j = t - WINDOW + jj; if (j >= 0 && j < SEQ) o += expf(sc[jj] - mx) * bf2f(PA[(size_t)(b * SEQ + j) * NPA + C_VA + 64 * kvh + d]); }
            ck_cmp(bf2f(YA[(size_t)m * 512 + 64 * qh + d]), o / den, 0.03f, 0.005f, cnt); }
        __syncthreads(); }
}
__global__ void ck_hgrn(const bf16* PA, const float* hng, const bf16* YH, const float* ssq, unsigned* cnt) {
    const int m = ck_row(blockIdx.x), b = m / SEQ, t = m % SEQ, h = blockIdx.y; __shared__ float wgt[128]; __shared__ float osum[128]; __shared__ float cum[128];
    const int e = threadIdx.x;
    float o = 0.f;
    for (int dir = 0; dir < 2; ++dir) { cum[e] = 0.f; __syncthreads();
        for (int n = 0; n < 768; ++n) { const int s = dir ? t + n : t - n; if (s < 0 || s >= SEQ) break;
            const bf16* row = PA + (size_t)(b * SEQ + s) * NPA; const bf16* rowt = PA + (size_t)m * NPA;
            { const int d = e; const float lf = (float)((const _Float16*)(row + (dir ? C_LB : C_LF) + 128 * h))[d];
              wgt[d] = bf2f(rowt[C_QH + 128 * h + d]) * (-expm1f(lf)) * expf(cum[d]);
#if defined(HC_DBG) && HC_DBG >= 3
              wgt[d] = bf2f(rowt[C_QH + 128 * h + d]) * (-expm1f(lf));
              if (HC_DBG == 4) wgt[d] = (d == 0) ? bf2f(rowt[C_QH + 128 * h]) : 0.f;
              if (HC_DBG == 5 || HC_DBG == 7) wgt[d] = (d == 0) ? wgt[d] : 0.f;
              if (HC_DBG == 10) wgt[d] = (d == 0) ? (float)(s & 15) : 0.f;
              if (HC_DBG == 11) wgt[d] = (d == 0) ? (float)(t & 15) : 0.f;
              if (HC_DBG == 8 || HC_DBG == 9) wgt[d] = (d == 0) ? bf2f(rowt[C_QH + 128 * h]) * (float)(s & 15) : 0.f;
              if (HC_DBG == 6) wgt[d] = (d == 0) ? bf2f(rowt[C_QH + 128 * h]) * lf : 0.f;
#endif
            }
            __syncthreads();
            float w = 0.f; for (int d = 0; d < 128; ++d) w += wgt[d];
#if defined(HC_TERMS)
            { const int cls = ((s >> 4) == (t >> 4)) ? 1 : (((s >> 7) == (t >> 7)) ? 2 : 4); if (!(HC_TERMS & cls)) w = 0.f; }
#endif
            o += w * bf2f(row[C_VH + 128 * h + e]);
            __syncthreads();
            { const int d = e; cum[d] += (float)((const _Float16*)(row + (dir ? C_LB : C_LF) + 128 * h))[d]; }
            __syncthreads(); } }
#if defined(HC_DBG) && HC_DBG == 1
    o = bf2f(PA[(size_t)m * NPA + C_VH + 128 * h + e]);
#endif
    osum[e] = o * o; __syncthreads(); for (int k = 64; k > 0; k >>= 1) { if (e < k) osum[e] += osum[e + k]; __syncthreads(); }
    if (e == 0) ck_cmp(ssq[m * 4 + h], osum[0], 0.03f, 1e-3f, cnt + 1);
    const float sg = bf2f(PA[(size_t)m * NPA + C_SG + 128 * h + e]);
    ck_cmp(bf2f(YH[(size_t)m * 512 + 128 * h + e]), o * hng[128 * h + e] * sg, 0.03f, 0.01f, cnt + 0);
}
__global__ void ck_comb(const float* xold, const float* xnew, const int* tok_p, const float* tok_w, const bf16* Y, const float* gfin, int last, unsigned* cnt) {
    const int m = ck_row(blockIdx.x); __shared__ float red[256]; __shared__ float xv[D];
    if (m >= SEQ) return;
    const int p1 = tok_p[2 * m], p2 = tok_p[2 * m + 1]; const float w1 = tok_w[2 * m], w2 = tok_w[2 * m + 1]; float s = 0.f;
    for (int c = threadIdx.x; c < D; c += 256) { const float v = xold[(size_t)m * D + c] + w1 * bf2f(Y[(size_t)p1 * D + c]) + w2 * bf2f(Y[(size_t)p2 * D + c]); xv[c] = v; s += v * v; }
    red[threadIdx.x] = s; __syncthreads(); for (int o = 128; o > 0; o >>= 1) { if (threadIdx.x < o) red[threadIdx.x] += red[threadIdx.x + o]; __syncthreads(); }
    const float rstd = 1.0f / sqrtf(red[0] / D + NORM_EPS);
    for (int c = threadIdx.x; c < D; c += 256) ck_cmp(xnew[(size_t)m * D + c], last ? xv[c] * rstd * gfin[c] : xv[c], 0.005f, 0.005f, cnt);
}

__global__ void ck_gates_full(const bf16* XN, const float* w_in, const bf16* GT, unsigned* st) {
    const int m = blockIdx.x >> 3, pn = blockIdx.x & 7, c = pn * 256 + threadIdx.x; __shared__ float xr[D];
    for (int k = threadIdx.x; k < D; k += 256) xr[k] = bf2f(XN[(size_t)m * D + k]);
    __syncthreads();
    float a = 0.f; for (int k = 0; k < D; ++k) a += xr[k] * w_in[(size_t)k * INW + NPA + c];
#if defined(CK_PLAIN)
    const float ref = a, got = bf2f(GT[(size_t)m * NGATE + c]);
#else
    const float ref = 1.f / (1.f + expf(-a)), got = bf2f(GT[(size_t)m * NGATE + c]);
#endif
    if (m == 8122 && !(fabsf(got - ref) <= 0.05f)) atomicMin(st + 700, (unsigned)c);
    if (m == 8123 && !(fabsf(got - ref) <= 0.05f)) atomicMin(st + 701, (unsigned)c);
    if (m == 8122) { if (c == 130) st[702] = __float_as_uint(got), st[703] = __float_as_uint(ref), st[704] = __float_as_uint(a); if (c == 131) st[705] = __float_as_uint(got), st[706] = __float_as_uint(ref); }
    if (!(fabsf(got - ref) <= 0.05f)) { atomicAdd(st + (m >> 8), 1u); atomicAdd(st + 128 + (m & 255), 1u); atomicAdd(st + 384 + threadIdx.x, 1u); atomicAdd(st + 640 + pn, 1u); }
}
__global__ void ck_flush() { asm volatile("buffer_wbl2 sc0 sc1\n\ts_waitcnt vmcnt(0)\n\tbuffer_inv sc0 sc1\n\ts_waitcnt vmcnt(0)" ::: "memory"); }

__global__ void ck_ha(const bf16* PA, const bf16* US, const float* HD, unsigned* cnt) {
    const int sidx = blockIdx.x, bh = sidx % 8, dir = (sidx >> 3) & 1, n = (sidx * 37 + 5) % NCH, b = bh >> 2, h = bh & 3, d = threadIdx.x, t0 = n * CH;
    __shared__ float kts[CH][128]; float cum = 0.f;
    for (int k = CH - 1; k >= 0; --k) { const int tok = dir ? (t0 + CH - 1 - k) : (t0 + k);
        const float lf = (float)((const _Float16*)(PA + (size_t)(b * SEQ + tok) * NPA + (dir ? C_LB : C_LF) + 128 * h))[d];
        kts[k][d] = -expm1f(lf) * expf(cum); cum += lf; }
    ck_cmp(HD[((size_t)(bh * 2 + dir) * NCH + n) * 128 + d], expf(cum), 0.01f, 1e-6f, cnt + 1);
    for (int e = 0; e < 128; e += 5) { float u = 0.f;
        for (int k = 0; k < CH; ++k) { const int tok = dir ? (t0 + CH - 1 - k) : (t0 + k); u += kts[k][d] * bf2f(PA[(size_t)(b * SEQ + tok) * NPA + C_VH + 128 * h + e]); }
        ck_cmp(bf2f(US[(((size_t)(bh * 2 + dir) * NCH + n) * 128 + e) * 128 + d]), u, 0.03f, 0.01f, cnt + 0); }
}
__global__ void ck_hb(const bf16* PA, const bf16* US, unsigned* cnt) {
    const int sidx = blockIdx.x, bh = sidx % 8, dir = (sidx >> 3) & 1, n = (sidx * 37 + 5) % NCH, b = bh >> 2, h = bh & 3, d = threadIdx.x, e = (sidx * 11 + 3) % 128;
    float cum = 0.f, sacc = 0.f;
    for (int k = 0; k < 1024; ++k) { const int tok = dir ? ((n + 1) * CH + k) : (n * CH - 1 - k); if (tok < 0 || tok >= SEQ) break;
        const bf16* row = PA + (size_t)(b * SEQ + tok) * NPA; const float lf = (float)((const _Float16*)(row + (dir ? C_LB : C_LF) + 128 * h))[d];
        sacc += -expm1f(lf) * expf(cum) * bf2f(row[C_VH + 128 * h + e]); cum += lf; }
    ck_cmp(bf2f(US[(((size_t)(bh * 2 + dir) * NCH + n) * 128 + e) * 128 + d]), sacc, 0.03f, 0.01f, cnt);
}

__global__ void ck_mfma(unsigned* cnt) {
#if defined(__HIP_DEVICE_COMPILE__)
    const int lane = threadIdx.x, fr = lane & 15, g = lane >> 4;
    float av[8], bv[8];
    for (int j = 0; j < 8; ++j) { const int k = 8 * g + j; av[j] = (k == 0) ? (float)fr : ((k == 9) ? (float)(fr * fr) : 0.f); bv[j] = (k == 0) ? (float)(fr + 1) : ((k == 9) ? 0.5f : 0.f); }
    f32x4 d = (f32x4){0.f, 0.f, 0.f, 0.f};
    d = mfma16(pack_frag(av), pack_frag(bv), d);
    for (int r = 0; r < 4; ++r) { const int s = 4 * g + r, c = fr; const float ref = (float)s * (float)(c + 1) + (float)(s * s) * 0.5f; if (fabsf(d[r] - ref) > 0.01f * fabsf(ref) + 0.01f) atomicAdd(cnt, 1u); }
#endif
}
#ifndef CK_SKIP
#define CK_SKIP 0ull
#endif
__global__ void ck_report(const unsigned* cnt, int n, float* out) { if (threadIdx.x == 0 && blockIdx.x == 0) {
#if defined(CK_DBG7)
    const unsigned* dbg = cnt + 7 + 100; int nrows = 0, ngrp = 0; unsigned mx = 0, first = 99; for (int i = 0; i < CK_NS; ++i) if (dbg[i]) { ++nrows; mx = dbg[i] > mx ? dbg[i] : mx; } for (int i = 0; i < 64; ++i) if (dbg[64 + i]) { ++ngrp; if (first == 99) first = i; }
    if (CK_DBG7 == 4) { const float me = __uint_as_float(dbg[200]), ma = __uint_as_float(dbg[201]); out[0] = (1.0f + fminf(me, 0.89f) * 10.0f) * powf(10.0f, 5.0f + floorf(fminf(ma, 30.0f))); return; }
    if (CK_DBG7 == 5) { int nl = 0; unsigned mxl = 0; for (int i = 0; i < 32; ++i) if (dbg[300 + i]) { ++nl; mxl = dbg[300 + i] > mxl ? dbg[300 + i] : mxl; } out[0] = (1.0f + 0.1f * (float)nl) * powf(10.0f, 5.0f + (float)(mxl > 30 ? 30 : mxl)); return; }
    if (CK_DBG7 == 7) { out[0] = (1.0f + 0.01f * (float)(dbg[203] % 100)) * powf(10.0f, 5.0f + (float)(dbg[203] / 100)); return; }
    if (CK_DBG7 >= 10) { const unsigned* st = cnt + 512; int npan = 0, nrit = 0, ncol = 0, ntile = 0; unsigned tot = 0, mxp = 0; int firstp = -1, firstr = -1, firstc = -1;
        for (int i = 0; i < 128; ++i) if (st[i]) { ++npan; tot += st[i]; if (st[i] > mxp) mxp = st[i]; if (firstp < 0) firstp = i; }
        for (int i = 0; i < 256; ++i) { if (st[128 + i]) { ++nrit; if (firstr < 0) firstr = i; } if (st[384 + i]) { ++ncol; if (firstc < 0) firstc = i; } }
        for (int i = 0; i < 8; ++i) if (st[640 + i]) ++ntile;
        float a = 0.f, b = 0.f;
        if (CK_DBG7 == 10) { a = (float)npan; b = log10f((float)(tot ? tot : 1)) * 4.0f; }
        if (CK_DBG7 == 11) { a = (float)nrit; b = (float)ncol / 10.0f; }
        if (CK_DBG7 == 12) { a = (float)firstp; b = (float)firstr / 10.0f; }
        if (CK_DBG7 == 13) { a = (float)firstc; b = (float)ntile; }
        if (CK_DBG7 == 22) { out[0] = (1.0f + 8.0f * __uint_as_float(st[702])) * powf(10.0f, 5.0f + floorf(20.0f * __uint_as_float(st[703]) + 0.5f)); return; }
        if (CK_DBG7 == 23) { out[0] = (1.0f + 8.0f * __uint_as_float(st[705])) * powf(10.0f, 5.0f + floorf(20.0f * __uint_as_float(st[706]) + 0.5f)); return; }
        if (CK_DBG7 == 20) { a = (float)(st[700] % 100); b = (float)(st[700] / 100); }
        if (CK_DBG7 == 21) { a = (float)(st[701] > 5000 ? 99 : st[701] % 100); b = (float)(st[701] > 5000 ? 30 : st[701] / 100); }
        out[0] = (1.0f + 0.01f * a) * powf(10.0f, 5.0f + floorf(b)); return; }
    if (CK_DBG7 == 6) { out[0] = (1.0f + 0.01f * (float)(dbg[202] % 100)) * powf(10.0f, 5.0f + (float)(dbg[202] / 100)); return; }
    if (CK_DBG7 == 3) { int s1 = -1, s2 = -1; for (int i = 0; i < CK_NS; ++i) if (dbg[i] > 20) { if (s1 < 0) s1 = i; else if (s2 < 0) s2 = i; } out[0] = (1.0f + 0.1f * (float)(s1 < 0 ? 0 : s1 % 50)) * powf(10.0f, (float)(5 + (s2 < 0 ? 0 : (s2 % 25)))); return; }
    if (CK_DBG7 == 1) out[0] = (1.0f + 0.1f * (float)first) * powf(10.0f, (float)(5 + nrows / 2));
    else out[0] = (1.0f + 0.1f * (float)ngrp) * powf(10.0f, (float)(5 + (int)floorf(4.0f * log10f((float)(mx ? mx : 1)))));
    return;
#endif
    for (int i = 0; i < n; ++i) if (cnt[i] && !((CK_SKIP >> i) & 1ull)) {
    out[0] = (1.0f + 0.1f * (float)(i % 10)) * powf(10.0f, (float)(5 + i / 10)); return; } } }
#endif

#ifndef PG8_SP2
#define PG8_SP2 true
#endif
#ifndef PG8_ALIGN
#define PG8_ALIGN true
#endif
__global__ void __launch_bounds__(NWAVES * 64, 2) mega_fwd(Args args) {
    extern __shared__ __attribute__((aligned(16))) unsigned char lds[];
    Frame F;
    F.lds = (LAS unsigned char*)lds;
    F.MISC = (volatile LAS unsigned*)(F.lds + MISC_OFF);
    F.tid = threadIdx.x; F.lane = F.tid & 63; F.wave = __builtin_amdgcn_readfirstlane(F.tid >> 6);
    F.G = gridDim.x; { const int bx = blockIdx.x; F.vcu = (F.G % 8 == 0) ? (bx % 8) * (F.G / 8) + bx / 8 : bx; }
    F.ws = args.ws; F.ctl = (gu32*)(args.ws + WS_CTL); F.out = args.out;
    const Args& A = args;
    for (int u = F.tid; u < (LDS_BYTES - LDSCTL_OFF) / 4; u += NWAVES * 64) ((LAS unsigned*)(F.lds + LDSCTL_OFF))[u] = 0u;
    __syncthreads();
    XcdBarrier bar = xcd_barrier_post((unsigned*)(F.ctl + CW_BAR) + args.li * XCD_BAR_WORDS, F.MISC + 8);
    const int lo = args.ph_lo, hi = args.ph_hi;
#ifndef PHMASK
#define PHMASK 0xffff
#endif
#define IN(k) (((PHMASK >> ((k) & 15)) & 1) && lo <= (k) && (k) < hi)
#define SEAM(k) do { if ((k) + 1 < hi) xcd_barrier(bar); } while (0)
#define WSP() GAS unsigned char* wsg_ = (GAS unsigned char*)args.ws; asm volatile("" : "+s"(wsg_)); unsigned char* ws = (unsigned char*)wsg_; F.ws = ws; { int t_ = threadIdx.x; asm volatile("" : "+v"(t_)); F.tid = t_; F.lane = t_ & 63; F.wave = __builtin_amdgcn_readfirstlane(t_ >> 6); int g_ = gridDim.x, b_ = blockIdx.x; asm volatile("" : "+s"(g_), "+s"(b_)); F.G = g_; F.vcu = (g_ % 8 == 0) ? (b_ % 8) * (g_ / 8) + b_ / 8 : b_; cid = b_; } \
    bf16* XN = (bf16*)(ws + WS_XN); bf16* PA = (bf16*)(ws + WS_PA); bf16* GT = (bf16*)(ws + WS_PA); bf16* MG = (bf16*)(ws + WS_US); \
    bf16* YA = (bf16*)(ws + WS_Y); bf16* YH = (bf16*)(ws + WS_YH); (void)XN; (void)PA; (void)GT; (void)MG; (void)YA; (void)YH;
    int cid = (int)blockIdx.x;

    if (IN(0)) { WSP();
        make_tables(F, A); conv_weights(F, A, 0);
        norm_rows(F, A.in[I_X], F.out, A.in[I_ANG], XN);
        SEAM(0);
    }
#if !defined(ORACLE) || defined(ORACLE_FAST)
#define FAST_PHASES(l)         if (IN(pb + 2)) { WSP(); phase_attn_ha(F, A.in[I_SINK] + (l) * NQH); SEAM(pb + 2); } \
        if (IN(pb + 3)) { WSP(); phase_hb(F); SEAM(pb + 3); } \
        if (IN(pb + 4)) { WSP(); phase_hc(F, A.in[I_HNG] + (l) * 512); SEAM(pb + 4); }
#else
#define FAST_PHASES(l)
#endif
#define LAYER_BODY(l) { const int pb = 16 * (l); \
        if (IN(pb + 1)) { WSP(); \
            pg8::Gemm g{XN, (const bf16*)(ws + WS_WIN), T, NPA, D}; pg8::StaticOrder S; S.init(T, NPA, F.G, cid); \
            EpiInA E{PA, (const float*)(ws + WS_COS), (const float*)(ws + WS_SIN), (const float*)(ws + WS_LBT) + l * 2048}; \
            pg8::gemm_phase<EpiInA, pg8::StaticOrder, PG8_ALIGN, PG8_SP2>(F.lds + RING_OFF, g, S, E); \
            SEAM(pb + 1); \
        } \
FAST_PHASES(l) \
        if (IN(pb + 5)) { WSP(); \
            pg8::Gemm g{XN, (const bf16*)(ws + WS_WIN) + (size_t)NPA * D, T, NGATE, D}; pg8::StaticOrder S; S.init(T, NGATE, F.G, cid); \
            EpiGate E{GT}; \
            pg8::gemm_phase<EpiGate, pg8::StaticOrder, PG8_ALIGN, PG8_SP2>(F.lds + RING_OFF, g, S, E); \
            SEAM(pb + 5); \
        } \
        if (IN(pb + 6)) { WSP(); \
            pg8::Gemm g{YA, (const bf16*)(ws + WS_WUA), T, D, 512}; pg8::StaticOrder S; S.init(T, D, F.G, cid); \
            EpiUpA E{MG, GT}; \
            pg8::gemm_phase<EpiUpA, pg8::StaticOrder, PG8_ALIGN, PG8_SP2>(F.lds + RING_OFF, g, S, E); \
            SEAM(pb + 6); \
        } \
        if (IN(pb + 7)) { WSP(); \
            pg8::Gemm g{YH, (const bf16*)(ws + WS_WUH), T, D, 512}; pg8::StaticOrder S; S.init(T, D, F.G, cid); \
            EpiUpB E{MG, GT, (const float*)(ws + WS_SSQ)}; \
            pg8::gemm_phase<EpiUpB, pg8::StaticOrder, PG8_ALIGN, PG8_SP2>(F.lds + RING_OFF, g, S, E); \
            SEAM(pb + 7); \
        } \
        if (IN(pb + 8)) { WSP(); \
            pg8::Gemm g{MG, (const bf16*)(ws + WS_WOUT), T, D, D}; pg8::StaticOrder S; S.init(T, D, F.G, cid); \
            EpiOut E{F.out}; \
            pg8::gemm_phase<EpiOut, pg8::StaticOrder, PG8_ALIGN, PG8_SP2>(F.lds + RING_OFF, g, S, E); \
            SEAM(pb + 8); \
        } \
        if (IN(pb + 9)) { WSP(); phase_norm_route(F, A, l); SEAM(pb + 9); } \
        if (IN(pb + 10)) { WSP(); phase_dispatch(F); SEAM(pb + 10); } \
        if (IN(pb + 11)) { WSP(); \
            pg8::Gemm g{(const bf16*)(ws + WS_XP), (const bf16*)(ws + WS_W1), SLOT_ROWS, D, D}; pg8::GroupedOrder S; S.init((const int*)(ws + WS_META), D, F.G, cid); \
            EpiAct E{(bf16*)(ws + WS_ACT)}; \
            pg8::gemm_phase<EpiAct, pg8::GroupedOrder, PG8_ALIGN, PG8_SP2>(F.lds + RING_OFF, g, S, E); \
            SEAM(pb + 11); \
        } \
        if (IN(pb + 12)) { WSP(); \
            pg8::Gemm g{(const bf16*)(ws + WS_ACT), (const bf16*)(ws + WS_W2), SLOT_ROWS, D, DEXP}; pg8::GroupedOrder S; S.init((const int*)(ws + WS_META), D, F.G, cid); \
            EpiY E{(bf16*)(ws + WS_XP)}; \
            pg8::gemm_phase<EpiY, pg8::GroupedOrder, PG8_ALIGN, PG8_SP2>(F.lds + RING_OFF, g, S, E); \
            SEAM(pb + 12); \
        } \
        if (IN(pb + 13)) { WSP(); \
            const bool last = (l == DEPTH - 1); \
            if (!last) conv_weights(F, A, l + 1); \
            phase_combine(F, last ? A.in[I_FING] : A.in[I_ANG] + (size_t)(l + 1) * D, last); \
            if (!last) SEAM(pb + 15); \
        } \
    }
    LAYER_BODY(0)
    LAYER_BODY(1)
    static_assert(DEPTH == 2, "layer bodies are written out");
#undef IN
#undef SEAM
}

extern "C" void kernel_launch(void* const* d_in, const int* in_sizes, int n_in, void* d_out, int out_size, void* d_ws, size_t ws_size, hipStream_t stream) {
    static int grid = 0;
    if (grid == 0) {
        if (n_in != 18 || in_sizes[0] != T * D || out_size != T * D || ws_size < WS_END) { fprintf(stderr, "kernel_launch: unexpected shapes (n_in %d, in0 %d, out %d, ws %zu); nothing launched\n", n_in, n_in > 0 ? in_sizes[0] : -1, out_size, ws_size); grid = -1; return; }
        int dev = 0, cus = 0, per_cu = 0;
        if (hipGetDevice(&dev) != hipSuccess || hipDeviceGetAttribute(&cus, hipDeviceAttributeMultiprocessorCount, dev) != hipSuccess) { grid = -1; return; }
        if (hipFuncSetAttribute((const void*)mega_fwd, hipFuncAttributeMaxDynamicSharedMemorySize, LDS_BYTES) != hipSuccess) { fprintf(stderr, "kernel_launch: hipFuncSetAttribute failed\n"); grid = -1; return; }
        if (hipOccupancyMaxActiveBlocksPerMultiprocessor(&per_cu, (const void*)mega_fwd, NWAVES * 64, LDS_BYTES) != hipSuccess || per_cu < 1)
            fprintf(stderr, "kernel_launch: note: occupancy query reports %d workgroups per CU\n", per_cu);
        (void)hipGetLastError();
        grid = cus;
    }
    if (grid < 0) return;
    if (hipMemsetAsync((char*)d_ws + WS_CTL, 0, CTL_ZERO_BYTES, stream) != hipSuccess) return;
    Args a{};
    for (int i = 0; i < 18; ++i) a.in[i] = (const float*)d_in[i];
    a.out = (float*)d_out; a.ws = (unsigned char*)d_ws; a.pad = 0;
    int li = 0;
    auto launch = [&](int lo, int hi) { a.ph_lo = lo; a.ph_hi = hi; a.li = li++; hipLaunchKernelGGL(mega_fwd, dim3(grid), dim3(NWAVES * 64), LDS_BYTES, stream, a);
        const hipError_t le = hipPeekAtLastError(); if (le != hipSuccess) fprintf(stderr, "kernel_launch: launch [%d,%d) failed: %s\n", lo, hi, hipGetErrorName(le)); };
#if defined(ORACLE)
    unsigned char* ws = (unsigned char*)d_ws;
#if defined(CHECK)
    unsigned* cnt = (unsigned*)(ws + 525 * MiB); hipMemsetAsync(cnt, 0, 4096, stream);
    hipLaunchKernelGGL(ck_mfma, dim3(1), dim3(64), 0, stream, cnt + 39); hipMemsetAsync(cnt + 512 + 700, 0xFF, 8, stream);
    const float* const* in = (const float* const*)d_in; float* xs = (float*)d_out;
    const bf16* XNc = (const bf16*)(ws + WS_XN); const bf16* PAc = (const bf16*)(ws + WS_PA); const bf16* MGc = (const bf16*)(ws + WS_US);
    const bf16* YAc = (const bf16*)(ws + WS_Y); const bf16* YHc = (const bf16*)(ws + WS_YH); const float* ssqc = (const float*)(ws + WS_SSQ);
#define CKL(k, ...) hipLaunchKernelGGL(k, dim3(CK_NS), dim3(256), 0, stream, __VA_ARGS__)
#endif
    for (int l = 0; l < DEPTH; ++l) {
#if defined(CHECK)
        const float* w_in_l = in[I_WIN] + (size_t)l * D * INW; unsigned* c0 = cnt + 20 * l;
        if (l == 0) { launch(0, 1); CKL(ck_norm, in[I_X], in[I_ANG], XNc, c0 + 0); launch(1, 2); }
        else { CKL(ck_norm, (const float*)xs, in[I_ANG] + (size_t)l * D, XNc, c0 + 0); launch(16 * l + 1, 16 * l + 2); }
        CKL(ck_pa, XNc, w_in_l, in[I_LBT], l, PAc, c0 + 1);
#else
        if (l == 0) launch(0, 2); else launch(16 * l + 1, 16 * l + 2);
#endif
#if defined(ORACLE_FAST)
        launch(16 * l + 2, 16 * l + 3);
#if defined(CHECK)
        hipLaunchKernelGGL(ck_ha, dim3(CK_NS), dim3(128), 0, stream, (const bf16*)(ws + WS_PA), (const bf16*)(ws + WS_US), (const float*)(ws + WS_HD), cnt + 20 * l + 40 + 0);
#endif
        launch(16 * l + 3, 16 * l + 4);
#if defined(CHECK)
        hipLaunchKernelGGL(ck_hb, dim3(CK_NS), dim3(128), 0, stream, (const bf16*)(ws + WS_PA), (const bf16*)(ws + WS_US), cnt + 20 * l + 40 + 2);
#endif
        launch(16 * l + 4, 16 * l + 5);
#else
        hipLaunchKernelGGL(zero_f32, dim3(T * 4 / 256), dim3(256), 0, stream, (float*)(ws + WS_SSQ), T * 4);
        hipLaunchKernelGGL(simple_attn, dim3(T * 8 / 4), dim3(256), 0, stream, (const bf16*)(ws + WS_PA), (const float*)d_in[I_SINK] + l * NQH, (bf16*)(ws + WS_Y));
        hipLaunchKernelGGL(simple_hgrn, dim3(8), dim3(512), 0, stream, (const bf16*)(ws + WS_PA), (const float*)d_in[I_HNG] + l * 512, (float*)(ws + WS_US), (bf16*)(ws + WS_YH), (float*)(ws + WS_SSQ));
#endif
#if defined(CHECK)
        CKL(ck_attn, PAc, in[I_SINK] + l * NQH, YAc, c0 + 3 + 40); hipLaunchKernelGGL(ck_hgrn, dim3(CK_NS, 4), dim3(128), 0, stream, PAc, in[I_HNG] + l * 512, YHc, ssqc, c0 + 4 + 40);
        const float* wua = in[I_WUA] + (size_t)l * 512 * D; const float* wuh = in[I_WUH] + (size_t)l * 512 * D; const int pb = 16 * l;
#if defined(CK_SENTINEL)
        hipMemsetAsync(ws + WS_PA, 0xFF, (size_t)T * NGATE * 2, stream);
#endif
#if defined(CK_FLUSH)
        hipLaunchKernelGGL(ck_flush, dim3(4096), dim3(64), 0, stream);
#endif
        launch(pb + 5, pb + 6);
#if defined(CK_FLUSH)
        hipLaunchKernelGGL(ck_flush, dim3(4096), dim3(64), 0, stream);
#endif
        if (l == 0) hipLaunchKernelGGL(ck_gates_full, dim3(T * 8), dim3(256), 0, stream, XNc, w_in_l, PAc, cnt + 512); CKL(ck_mix, XNc, w_in_l, YAc, YHc, ssqc, wua, wuh, PAc, MGc, 0, c0 + 7);
        launch(pb + 6, pb + 7); CKL(ck_mix, XNc, w_in_l, YAc, YHc, ssqc, wua, wuh, PAc, MGc, 1, c0 + 7);
        launch(pb + 7, pb + 8); CKL(ck_mix, XNc, w_in_l, YAc, YHc, ssqc, wua, wuh, PAc, MGc, 2, c0 + 7);
        launch(pb + 8, pb + 9); if (l == 0) CKL(ck_out, in[I_X], MGc, in[I_WOUT], (const float*)xs, c0 + 10);
        const float* gff = in[I_FNG] + (size_t)l * D; const float* wrg = in[I_WRG] + (size_t)l * D * NGRP; const float* brg = in[I_BRG] + l * NGRP; const float* wre = in[I_WRE] + (size_t)l * NGRP * D * EPG; const float* bre = in[I_BRE] + l * NGRP * EPG;
        const float* weg = in[I_WEG] + (size_t)l * NEXP * D * DEXP; const float* weu = in[I_WEU] + (size_t)l * NEXP * D * DEXP; const float* wed = in[I_WED] + (size_t)l * NEXP * DEXP * D;
        const int* toke = (const int*)(ws + WS_TOKE); const float* tokw = (const float*)(ws + WS_TOKW); const int* tokp = (const int*)(ws + WS_TOKP); const int* metac = (const int*)(ws + WS_META);
        const bf16* XPc = (const bf16*)(ws + WS_XP); const bf16* ACTc = (const bf16*)(ws + WS_ACT);
#define CKM(st) CKL(ck_moe, (const float*)xs, gff, wrg, brg, wre, bre, weg, weu, wed, XNc, toke, tokw, tokp, metac, XPc, ACTc, XPc, st, c0 + 12)
        launch(pb + 9, pb + 10); CKL(ck_norm, (const float*)xs, gff, XNc, c0 + 11); CKM(0);
        launch(pb + 10, pb + 11); CKM(1);
        launch(pb + 11, pb + 12); CKM(2);
        launch(pb + 12, pb + 13); CKM(3);
        hipMemcpyAsync(ws + WS_US, xs, (size_t)T * D * 4 / 2, hipMemcpyDeviceToDevice, stream);
        launch(pb + 13, pb + 14);
        CKL(ck_comb, (const float*)(ws + WS_US), (const float*)xs, tokp, tokw, XPc, in[I_FING], (int)(l == DEPTH - 1), c0 + 6 + 40);
#else
#if defined(STOP_AFTER)
        launch(16 * l + 5, STOP_AFTER + 1); break;
#else
        launch(16 * l + 5, 16 * l + 14);
#endif
#endif
    }
#if defined(CHECK)
    hipLaunchKernelGGL(ck_report, dim3(1), dim3(64), 0, stream, (const unsigned*)cnt, 80, xs);
#endif
#else
    launch(0, 16 * (DEPTH - 1) + 14);
#endif
}
```

```cpp
#include <hip/hip_runtime.h>
#include <cstdio>
#include <cstdint>
namespace pg8 {
#define PG8_LAS __attribute__((address_space(3)))
typedef unsigned short bf16_t;
typedef short bf16x8 __attribute__((ext_vector_type(8)));
typedef float f32x4 __attribute__((ext_vector_type(4)));
typedef unsigned u32x4 __attribute__((ext_vector_type(4)));
typedef unsigned u32x2 __attribute__((ext_vector_type(2)));
constexpr int BM = 256, BK = 64, HALF = 128, HTB = HALF * BK * 2  , STAGE_BYTES = 8 * HTB, NXCD = 8, WGM = 8;

__host__ __device__ __forceinline__ int lds_byte(int r, int c) { const int st = (r >> 4) * 2 + (c >> 5), rr = r & 15, cc = c & 31, ob = rr * 64 + cc * 2; return st * 1024 + (ob ^ (((ob >> 9) & 1) << 5)); }
__host__ __device__ __forceinline__ void stage_rc(int b, int& R, int& C) { const int st = b / 1024, sb = b % 1024, swz = sb ^ (((sb >> 9) & 1) << 5); R = (st >> 1) * 16 + swz / 64; C = (st & 1) * 32 + (swz % 64) / 2; }
__host__ __device__ __forceinline__ int perm32(int rho) { const int n = rho >> 4, i = rho & 15; return 8 * (i >> 2) + 4 * n + (i & 3); }

struct Unit { int pm, pn, pb; };
struct Gemm { const bf16_t* A; const bf16_t* Bt; int M, N, K; };

struct StaticOrder {
    int nM, nN, nwg, G, c;
    __host__ __device__ void init(int M, int N, int G_, int c_) { nM = M / BM; nN = N / BM; nwg = nM * nN; G = G_; c = c_; }
    __host__ __device__ bool next(int i, Unit& u) const {
        const long L = (long)i * G + c; if (L >= nwg) return false;
        int wgid = (int)L; { const int q = nwg / NXCD, r = nwg % NXCD, xcd = wgid % NXCD, off = wgid / NXCD; wgid = (xcd < r ? xcd * (q + 1) : r * (q + 1) + (xcd - r) * q) + off; }
        const int nig = WGM * nN, gid = wgid / nig, fm = gid * WGM, gsz = (nM - fm) < WGM ? (nM - fm) : WGM;
        u.pm = fm + ((wgid % nig) % gsz); u.pn = (wgid % nig) / gsz; u.pb = u.pn; return true;
    }
    __device__ __forceinline__ void a_ready(const Unit&) const {}
    __device__ __forceinline__ void done(const Unit&) const {}
};
struct GroupedOrder {
    const int* meta; int nM, nN, nwg, G, base;
    __device__ __forceinline__ void init(const int* meta_, int N, int G_, int c_, bool second = false) { meta = meta_; nM = __builtin_amdgcn_readfirstlane(__hip_atomic_load(meta_, __ATOMIC_RELAXED, __HIP_MEMORY_SCOPE_AGENT)); nN = N / BM; nwg = nM * nN; G = G_;
        base = second ? (((c_ < nwg) ? (nwg - c_ + G_ - 1) / G_ : 0) * G_ + c_ - nwg) : c_; }
    __device__ __forceinline__ bool next(int i, Unit& u) const {
        int wgid = i * G + base; if (wgid >= nwg) return false;
        { const int q = nwg / NXCD, r = nwg % NXCD, xcd = wgid % NXCD, off = wgid / NXCD; wgid = (xcd < r ? xcd * (q + 1) : r * (q + 1) + (xcd - r) * q) + off; }
        const int nig = WGM * nN, gid = wgid / nig, fm = gid * WGM, gsz = (nM - fm) < WGM ? (nM - fm) : WGM;
        u.pm = fm + ((wgid % nig) % gsz); u.pn = (wgid % nig) / gsz;
        u.pb = __builtin_amdgcn_readfirstlane(__hip_atomic_load(meta + 1 + u.pm, __ATOMIC_RELAXED, __HIP_MEMORY_SCOPE_AGENT)) * nN + u.pn; return true;
    }
    __device__ __forceinline__ void a_ready(const Unit&) const {}
    __device__ __forceinline__ void done(const Unit&) const {}
};
struct ProducerOrder : GroupedOrder {
    unsigned* cnt;
    __device__ __forceinline__ void done(const Unit& u) const {
        asm volatile("s_waitcnt vmcnt(0)" ::: "memory");
        if ((threadIdx.x & 63) == 0) __hip_atomic_fetch_add(cnt + 64 * u.pm, 1u, __ATOMIC_RELAXED, __HIP_MEMORY_SCOPE_AGENT);
    }
};
struct ConsumerOrder : GroupedOrder {
    unsigned* cnt; static constexpr unsigned NEED = 32u;
    __device__ __forceinline__ void a_ready(const Unit& u) const {
        if (threadIdx.x < 64) {
            unsigned* tmo = cnt - 64;
            const unsigned long long t0 = __builtin_amdgcn_s_memrealtime(); unsigned polls = 0;
            while ((unsigned)__builtin_amdgcn_readfirstlane(__hip_atomic_load(cnt + 64 * u.pm, __ATOMIC_RELAXED, __HIP_MEMORY_SCOPE_AGENT)) < NEED) {
                if ((++polls & 255u) == 0u && __builtin_amdgcn_readfirstlane(__hip_atomic_load(tmo, __ATOMIC_RELAXED, __HIP_MEMORY_SCOPE_AGENT)) != 0u) break;
                if (__builtin_amdgcn_s_memrealtime() - t0 > 2000000ull) {
                    if (threadIdx.x == 0) { unsigned expect = 0u; __hip_atomic_compare_exchange_strong(tmo + 1, &expect, 0x600u | (unsigned)(u.pm & 0xff), __ATOMIC_RELAXED, __ATOMIC_RELAXED, __HIP_MEMORY_SCOPE_AGENT); __hip_atomic_store(tmo, 1u, __ATOMIC_RELAXED, __HIP_MEMORY_SCOPE_AGENT); }
                    break; }
                __builtin_amdgcn_s_sleep(2); }
            asm volatile("s_waitcnt vmcnt(0)" ::: "memory");
        }
        asm volatile("" ::: "memory"); __builtin_amdgcn_s_barrier(); asm volatile("" ::: "memory");
    }
};
typedef float f32x2_t __attribute__((ext_vector_type(2))); typedef __bf16 bf16x2_t __attribute__((ext_vector_type(2)));
__device__ __forceinline__ unsigned cvt_pk_bf16(float lo, float hi) { f32x2_t v = {lo, hi}; bf16x2_t b = __builtin_convertvector(v, bf16x2_t); return __builtin_bit_cast(unsigned, b); }
template <class Epi, class Sched, bool ALIGN_EPI = false, bool SP2 = false, bool GATHER = false, int A_AUX = 0>
__device__ __forceinline__ void gemm_phase(PG8_LAS unsigned char* lds, const Gemm g, const Sched& S, const Epi& E, const int* rowtab = nullptr) {
    int tid_ = threadIdx.x; asm volatile("" : "+v"(tid_));
    const int tid = tid_, wid = __builtin_amdgcn_readfirstlane(tid >> 6), lane = tid & 63, wr = wid >> 2, wc = wid & 3, fr = lane & 15, fq = lane >> 4;
    const int K = g.K, nt = K / BK;
    unsigned voffA[2], voffB[2];
#pragma unroll
    for (int i = 0; i < 2; ++i) { int R, C; stage_rc(tid * 16 + i * 8192, R, C); const int Rb = Epi::PERM ? ((R & ~31) + perm32(R & 31)) : R;
        voffA[i] = (unsigned)(R * K + C) * 2u; voffB[i] = (unsigned)(Rb * K + C) * 2u; }
    const size_t kstep = (size_t)(BK * 2);
    const size_t hstep = (size_t)HALF * K * 2;
    const size_t tstep = 2 * hstep;
    const unsigned ldsw = (unsigned)wid * 1024u;
    const int aoff = lds_byte(wr * 64 + fr, fq * 8), boff = lds_byte(wc * 32 + fr, fq * 8);
#define PG8_SA(b, h) (((b) * 2 + (h)) * HTB)
#define PG8_SB(b, h) ((4 + (b) * 2 + (h)) * HTB)
#define PG8_STAGE(bufoff, gbase, voff) do { _Pragma("unroll") for (int _i = 0; _i < 2; ++_i) \
        __builtin_amdgcn_global_load_lds((const unsigned*)((const char*)(gbase) + (voff)[_i]), (PG8_LAS unsigned*)(lds + (bufoff) + ldsw + _i * 8192), 16, 0, 0); } while (0)
#define PG8_STAGE_A(bufoff, gbase, h, RO) do { _Pragma("unroll") for (int _i = 0; _i < 2; ++_i) \
        __builtin_amdgcn_global_load_lds((const unsigned*)((const char*)(gbase) + (GATHER ? (size_t)RO[h][_i] : (size_t)(((h) ? hstep : 0) + voffA[_i]))), (PG8_LAS unsigned*)(lds + (bufoff) + ldsw + _i * 8192), 16, 0, A_AUX); } while (0)
#define PG8_ROWOFS(RO, pm_) do { if constexpr (GATHER) { _Pragma("unroll") for (int _h = 0; _h < 2; ++_h) _Pragma("unroll") for (int _i = 0; _i < 2; ++_i) { int _R, _C; stage_rc(tid * 16 + _i * 8192, _R, _C); \
        const int _tok = __hip_atomic_load(rowtab + (pm_) * 256 + _h * 128 + _R, __ATOMIC_RELAXED, __HIP_MEMORY_SCOPE_AGENT); RO[_h][_i] = (unsigned)_tok * (unsigned)(K * 2) + (unsigned)(_C * 2); } } } while (0)
#define PG8_LDA(dst, b, h) do { _Pragma("unroll") for (int m = 0; m < 4; ++m) _Pragma("unroll") for (int k = 0; k < 2; ++k) dst[m][k] = *(const PG8_LAS bf16x8*)(lds + PG8_SA(b, h) + aoff + m * 2048 + k * 1024); } while (0)
#define PG8_LDB(dst, b, h) do { _Pragma("unroll") for (int n = 0; n < 2; ++n) _Pragma("unroll") for (int k = 0; k < 2; ++k) dst[n][k] = *(const PG8_LAS bf16x8*)(lds + PG8_SB(b, h) + boff + n * 2048 + k * 1024); } while (0)
#define PG8_MMA(ai, bj, At, Bt) do { __builtin_amdgcn_s_setprio(1); _Pragma("unroll") for (int m = 0; m < 4; ++m) _Pragma("unroll") for (int n = 0; n < 2; ++n) _Pragma("unroll") for (int k = 0; k < 2; ++k) \
        acc[ai][bj][m][n] = __builtin_amdgcn_mfma_f32_16x16x32_bf16(Bt[n][k], At[m][k], acc[ai][bj][m][n], 0, 0, 0); __builtin_amdgcn_s_setprio(0); } while (0)
#define PG8_WAIT_V(n) asm volatile("s_waitcnt vmcnt(" #n ")" ::: "memory")
#define PG8_WAIT_L(n) asm volatile("s_waitcnt lgkmcnt(" #n ")" ::: "memory")
#define PG8_BAR __builtin_amdgcn_s_barrier()
#define PG8_SCHED __builtin_amdgcn_sched_barrier(0)
    Unit cur, nxt; int ui = 0;
    if (!S.next(0, cur)) return;
    f32x4 acc[2][2][4][2];
#pragma unroll
    for (int a = 0; a < 2; ++a)
#pragma unroll
        for (int b = 0; b < 2; ++b)
#pragma unroll
            for (int m = 0; m < 4; ++m)
#pragma unroll
                for (int n = 0; n < 2; ++n) acc[a][b][m][n] = (f32x4){0.f, 0.f, 0.f, 0.f};
    bf16x8 At[4][2], B0[2][2], B1[2][2];
    const char* cA = (const char*)g.A + (GATHER ? (size_t)0 : (size_t)cur.pm * tstep); const char* cB = (const char*)g.Bt + (size_t)cur.pb * tstep;
    unsigned rofsC[2][2] = {{0u, 0u}, {0u, 0u}}, rofsN[2][2] = {{0u, 0u}, {0u, 0u}};
    PG8_ROWOFS(rofsC, cur.pm);
    S.a_ready(cur);
    if constexpr (SP2) {
        PG8_STAGE(PG8_SB(0, 0), cB, voffB); PG8_STAGE(PG8_SB(0, 1), cB + hstep, voffB); PG8_STAGE_A(PG8_SA(0, 0), cA, 0, rofsC); PG8_STAGE_A(PG8_SA(0, 1), cA, 1, rofsC);
        if (wr == 1) PG8_BAR;
        PG8_WAIT_V(2); PG8_BAR;
        PG8_STAGE(PG8_SB(1, 0), cB + kstep, voffB); PG8_STAGE_A(PG8_SA(1, 0), cA + kstep, 0, rofsC); PG8_STAGE(PG8_SB(1, 1), cB + hstep + kstep, voffB);
        PG8_WAIT_V(6); PG8_BAR;
    } else {
        PG8_STAGE(PG8_SB(0, 0), cB, voffB); PG8_STAGE_A(PG8_SA(0, 0), cA, 0, rofsC); PG8_STAGE(PG8_SB(0, 1), cB + hstep, voffB); PG8_STAGE_A(PG8_SA(0, 1), cA, 1, rofsC);
        if (wr == 1) PG8_BAR;
        PG8_WAIT_V(4); PG8_BAR;
        PG8_STAGE(PG8_SB(1, 0), cB + kstep, voffB); PG8_STAGE_A(PG8_SA(1, 0), cA + kstep, 0, rofsC); PG8_STAGE(PG8_SB(1, 1), cB + hstep + kstep, voffB);
        PG8_WAIT_V(6); PG8_BAR;
    }
    for (;;) {
        const bool has_next = S.next(ui + 1, nxt);
        const char* nA = (has_next && !GATHER) ? (const char*)g.A + (size_t)nxt.pm * tstep : cA; const char* nB = has_next ? (const char*)g.Bt + (size_t)nxt.pb * tstep : cB;
        for (int t = 0; t < nt; t += 2) {
            const bool last = (t == nt - 2);
            const char* a1 = cA + (size_t)(t + 1) * kstep;
            const char* a2 = last ? nA : cA + (size_t)(t + 2) * kstep; const char* b2 = last ? nB : cB + (size_t)(t + 2) * kstep;
            const char* a3 = a2 + kstep; const char* b3 = b2 + kstep;
            if (last && has_next) { S.a_ready(nxt); PG8_ROWOFS(rofsN, nxt.pm); }
            unsigned ro2[2][2];
#pragma unroll
            for (int _h = 0; _h < 2; ++_h)
#pragma unroll
                for (int _i = 0; _i < 2; ++_i) ro2[_h][_i] = (last && has_next) ? rofsN[_h][_i] : rofsC[_h][_i];
            if constexpr (SP2) {
            PG8_LDB(B0, 0, 0); PG8_LDB(B1, 0, 1); PG8_SCHED; PG8_LDA(At, 0, 0); PG8_STAGE_A(PG8_SA(1, 1), a1, 1, rofsC);
            PG8_WAIT_V(8); PG8_WAIT_L(0); PG8_BAR; PG8_MMA(0, 0, At, B0); PG8_MMA(0, 1, At, B1); PG8_BAR; PG8_SCHED;
            PG8_LDA(At, 0, 1); PG8_STAGE(PG8_SB(0, 0), b2, voffB); PG8_STAGE(PG8_SB(0, 1), b2 + hstep, voffB); PG8_STAGE_A(PG8_SA(0, 0), a2, 0, ro2);
            PG8_WAIT_V(8); PG8_WAIT_L(0); PG8_BAR; PG8_MMA(1, 0, At, B0); PG8_MMA(1, 1, At, B1); PG8_BAR; PG8_SCHED;
            PG8_LDB(B0, 1, 0); PG8_LDB(B1, 1, 1); PG8_SCHED; PG8_LDA(At, 1, 0); PG8_STAGE_A(PG8_SA(0, 1), a2, 1, ro2);
            PG8_WAIT_V(8); PG8_WAIT_L(0); PG8_BAR; PG8_MMA(0, 0, At, B0); PG8_MMA(0, 1, At, B1); PG8_BAR; PG8_SCHED;
            PG8_LDA(At, 1, 1); PG8_STAGE(PG8_SB(1, 0), b3, voffB); PG8_STAGE(PG8_SB(1, 1), b3 + hstep, voffB); PG8_STAGE_A(PG8_SA(1, 0), a3, 0, ro2);
            PG8_WAIT_V(8); PG8_WAIT_L(0); PG8_BAR; PG8_MMA(1, 0, At, B0); PG8_MMA(1, 1, At, B1); PG8_BAR; PG8_SCHED;
            } else {
            PG8_LDB(B0, 0, 0); PG8_SCHED; PG8_LDA(At, 0, 0); PG8_STAGE_A(PG8_SA(1, 1), a1, 1, rofsC);
            PG8_WAIT_L(8); PG8_BAR; PG8_WAIT_L(0); PG8_MMA(0, 0, At, B0); PG8_BAR; PG8_SCHED;
            PG8_LDB(B1, 0, 1); PG8_STAGE(PG8_SB(0, 0), b2, voffB);
            PG8_BAR; PG8_WAIT_L(0); PG8_MMA(0, 1, At, B1); PG8_BAR;
            PG8_LDA(At, 0, 1); PG8_STAGE_A(PG8_SA(0, 0), a2, 0, ro2);
            PG8_BAR; PG8_WAIT_L(0); PG8_MMA(1, 0, At, B0); PG8_BAR; PG8_SCHED;
            PG8_STAGE(PG8_SB(0, 1), b2 + hstep, voffB);
            PG8_WAIT_V(6); PG8_BAR; PG8_MMA(1, 1, At, B1); PG8_BAR;
            PG8_LDB(B0, 1, 0); PG8_SCHED; PG8_LDA(At, 1, 0); PG8_STAGE_A(PG8_SA(0, 1), a2, 1, ro2);
            PG8_WAIT_L(8); PG8_BAR; PG8_WAIT_L(0); PG8_MMA(0, 0, At, B0); PG8_BAR; PG8_SCHED;
            PG8_LDB(B1, 1, 1); PG8_STAGE(PG8_SB(1, 0), b3, voffB);
            PG8_BAR; PG8_WAIT_L(0); PG8_MMA(0, 1, At, B1); PG8_BAR;
            PG8_LDA(At, 1, 1); PG8_STAGE_A(PG8_SA(1, 0), a3, 0, ro2);
            PG8_BAR; PG8_WAIT_L(0); PG8_MMA(1, 0, At, B0); PG8_BAR; PG8_SCHED;
            PG8_STAGE(PG8_SB(1, 1), b3 + hstep, voffB);
            PG8_WAIT_V(6); PG8_BAR; PG8_MMA(1, 1, At, B1); PG8_BAR;
            }
        }
        if constexpr (ALIGN_EPI) { if (wr == 0) PG8_BAR; }
        if constexpr (!Epi::AFTER_DRAIN) { E(acc, cur, wr, wc, fr, fq); S.done(cur); }
        if (!has_next) break;
#pragma unroll
        for (int a = 0; a < 2; ++a)
#pragma unroll
            for (int b = 0; b < 2; ++b)
#pragma unroll
                for (int m = 0; m < 4; ++m)
#pragma unroll
                    for (int n = 0; n < 2; ++n) acc[a][b][m][n] = (f32x4){0.f, 0.f, 0.f, 0.f};
        cur = nxt; cA = nA; cB = nB; ++ui;
#pragma unroll
        for (int _h = 0; _h < 2; ++_h)
#pragma unroll
            for (int _i = 0; _i < 2; ++_i) rofsC[_h][_i] = rofsN[_h][_i];
        if constexpr (ALIGN_EPI) { if (wr == 1) PG8_BAR; }
    }
    PG8_WAIT_V(0);
    if constexpr (!ALIGN_EPI) { if (wr == 0) PG8_BAR; }
    PG8_BAR;
    if constexpr (Epi::AFTER_DRAIN) { E.fused(acc, cur, wr, wc, fr, fq, lds, wid, lane); S.done(cur); }
#undef PG8_SA
#undef PG8_SB
#undef PG8_STAGE
#undef PG8_STAGE_A
#undef PG8_ROWOFS
#undef PG8_LDA
#undef PG8_LDB
#undef PG8_MMA
#undef PG8_WAIT_V
#undef PG8_WAIT_L
#undef PG8_BAR
#undef PG8_SCHED
}
}


constexpr int NWAVES = 8;
constexpr int BATCH = 2, SEQ = 16384, D = 1024, T = BATCH * SEQ, DEPTH = 2;
constexpr int NQH = 8, NKVH = 2, HD = 64, WINDOW = 128;
constexpr int HH = 4, HDK = 128;
constexpr int NGRP = 4, EPG = 8, NEXP = 32, DEXP = 512;
constexpr int INW = 5376, NPA = 3328, NGATE = 2048;
constexpr int C_QA = 0, C_KA = 512, C_VA = 640, C_QH = 768, C_LF = 1280, C_LB = 1792, C_VH = 2304, C_SG = 2816;
constexpr float NORM_EPS = 1e-6f, LOGF_MIN = -4.0f;
constexpr float LOG2E = 1.4426950408889634f;
constexpr float QSCALE = 0.125f * LOG2E;
constexpr int CH = 128, NCH = SEQ / CH;
constexpr int SLOT_ROWS = 73728;

constexpr size_t MiB = 1u << 20;
constexpr size_t WS_CTL = 0, CTL_ZERO_BYTES = 1 * MiB;
constexpr size_t WS_COS = 1 * MiB, WS_SIN = 3 * MiB, WS_LBT = 5 * MiB;
constexpr size_t WS_WIN = 6 * MiB, WS_WUA = 17 * MiB, WS_WUH = 18 * MiB, WS_WOUT = 19 * MiB, WS_W1 = 22 * MiB, WS_W2 = 86 * MiB;
constexpr size_t WS_XN = 118 * MiB;
constexpr size_t WS_PA = 182 * MiB;
constexpr size_t WS_US = 390 * MiB;
constexpr size_t WS_Y = 454 * MiB;
constexpr size_t WS_YH = 486 * MiB;
constexpr size_t WS_HD = 518 * MiB;
constexpr size_t WS_SSQ = 519 * MiB;
constexpr size_t WS_TOKE = 520 * MiB, WS_TOKW = 521 * MiB, WS_TOKR = 522 * MiB, WS_TOKP = 523 * MiB;
constexpr size_t WS_WGCNT = 524 * MiB;
constexpr size_t WS_META = 524 * MiB + 512 * 1024;
constexpr size_t WS_STOK = 525 * MiB;
constexpr size_t WS_RSA = 526 * MiB;
constexpr size_t WS_RSF = 526 * MiB + 128 * 1024;
constexpr size_t WS_RSS = 526 * MiB + 256 * 1024;
constexpr size_t WS_END = 527 * MiB;
constexpr size_t WS_XP = WS_PA;
constexpr size_t WS_ACT = WS_PA + (size_t)SLOT_ROWS * D * 2;
static_assert(WS_ACT + (size_t)SLOT_ROWS * DEXP * 2 <= WS_Y, "MoE overlay");
static_assert(WS_PA + (size_t)T * NPA * 2 <= WS_US && WS_W2 + (size_t)NEXP * D * DEXP * 2 <= WS_XN && WS_WIN + (size_t)INW * D * 2 <= WS_WUA, "ws map");
constexpr int CW_TMO = 0, CW_CODE = 1;
constexpr int CW_BAR = 4096;
#ifndef G1A_SPLIT
#define G1A_SPLIT 0
#endif
#ifndef CONV_WGS
#define CONV_WGS 16
#endif
#ifndef CONV_WGS_MOE
#define CONV_WGS_MOE 32
#endif
#ifndef CONV_PER_WG1
#define CONV_PER_WG1 512
#endif
#ifndef CONV_PER_WG2
#define CONV_PER_WG2 256
#endif
#ifndef CONV_PER_WG12
#define CONV_PER_WG12 192
#endif
#ifndef NORM4
#define NORM4 0
#endif
#ifndef NORMFOLD
#define NORMFOLD 0
#endif
#ifndef XBF16
#define XBF16 1
#endif
#ifndef CONV_ASM_LOADS
#define CONV_ASM_LOADS 0
#endif
#ifndef EXPERTS_BY_QUEUE
#define EXPERTS_BY_QUEUE 1
#endif
#ifndef MOE_HANDOFF
#define MOE_HANDOFF 0
#endif
constexpr int MAX_LAUNCH = 16;
constexpr int CW_H12 = 2048;
constexpr int CW_MOE = 131072, MOE_BANK = 320 * 64;

constexpr int RING_OFF = 0, RING_BYTES = 131072;
constexpr int LDSCTL_OFF = RING_BYTES, MISC_OFF = LDSCTL_OFF + 320;
#ifndef ROUTE4
#define ROUTE4 1
#endif
constexpr int LDS_BYTES = ROUTE4 ? 163840 : 147456;

#define GAS __attribute__((address_space(1)))
#define LAS __attribute__((address_space(3)))
typedef unsigned short bf16;
typedef unsigned v4u __attribute__((ext_vector_type(4)));
typedef unsigned v2u __attribute__((ext_vector_type(2)));
typedef float f32x4 __attribute__((ext_vector_type(4)));
typedef short bf16x8 __attribute__((ext_vector_type(8)));
typedef short s16x4 __attribute__((ext_vector_type(4)));
typedef _Float16 h16x4 __attribute__((ext_vector_type(4)));
typedef _Float16 h16x8 __attribute__((ext_vector_type(8)));
typedef GAS unsigned gu32;
typedef GAS unsigned long long gu64;
#define RLX_AGENT __ATOMIC_RELAXED, __HIP_MEMORY_SCOPE_AGENT
#define LDS_WAIT() asm volatile("s_waitcnt lgkmcnt(0)" ::: "memory")
#define VM_WAIT() asm volatile("s_waitcnt vmcnt(0)" ::: "memory")
__device__ __forceinline__ unsigned f2bf(float f) { unsigned u = __builtin_bit_cast(unsigned, f); return (u + 0x7fffu + ((u >> 16) & 1u)) >> 16; }
__device__ __forceinline__ unsigned pk2(float lo, float hi) { return f2bf(lo) | (f2bf(hi) << 16); }
__device__ __forceinline__ float bf2f(unsigned short b) { return __builtin_bit_cast(float, ((unsigned)b) << 16); }
__device__ __forceinline__ float bflo(unsigned w) { return __builtin_bit_cast(float, w << 16); }
__device__ __forceinline__ float bfhi(unsigned w) { return __builtin_bit_cast(float, w & 0xffff0000u); }
__device__ __forceinline__ float fast_rcp(float x) { return __builtin_amdgcn_rcpf(x); }
__device__ __forceinline__ float sigmoidf_(float x) { return fast_rcp(1.0f + __expf(-x)); }
__device__ __forceinline__ float siluf_(float x) { return x * fast_rcp(1.0f + __expf(-x)); }

#define XB_TMO      128
#define XB_XCNT(j)  (256  + 64 * (j))
#define XB_XSUB(j)  (1280 + 64 * (j))
#define XB_XGEN(j)  (2304 + 64 * (j))
#define XB_TOP      3328
#define XB_TOPGEN   3392
#define XCD_BAR_WORDS 3456
#define XB_SPIN_CAP (1u << 18)

__device__ __forceinline__ unsigned xb_ld(unsigned* p)              { return __hip_atomic_load(p, __ATOMIC_RELAXED, __HIP_MEMORY_SCOPE_AGENT); }
__device__ __forceinline__ unsigned xb_add(unsigned* p, unsigned v) { return __hip_atomic_fetch_add(p, v, __ATOMIC_RELAXED, __HIP_MEMORY_SCOPE_AGENT); }
__device__ __forceinline__ unsigned xb_xcc_id() { return (unsigned)__builtin_amdgcn_s_getreg((3 << 11) | 20) & 0xFu; }
#define XB_SPIN(cond, bar) do { unsigned _sp = 0; while (cond) { __builtin_amdgcn_s_sleep(1); \
    if ((++_sp & 255u) == 0u) { if (xb_ld(&(bar)[XB_TMO])) break; if (_sp > XB_SPIN_CAP) { atomicAdd(&(bar)[XB_TMO], 1u); break; } } } } while (0)

struct XcdBarrier {
    unsigned* bar; unsigned x;
    volatile LAS unsigned* st;
};

__device__ __forceinline__ XcdBarrier xcd_barrier_post(unsigned* bar, volatile LAS unsigned* st) {
    XcdBarrier b; b.bar = bar; b.x = xb_xcc_id(); b.st = st;
    if (threadIdx.x == 0) (void)xb_add(&bar[XB_XCNT(b.x)], 1u);
    return b;
}
__device__ __forceinline__ void xcd_barrier_complete(unsigned* bar, unsigned x, unsigned& nloc, unsigned& nx) {
    const unsigned G = gridDim.x * gridDim.y * gridDim.z;
    unsigned sum, cnt, mine, sp = 0u;
    for (;;) {
        sum = 0u; cnt = 0u; mine = 0u;
#pragma unroll
        for (unsigned j = 0; j < 16; ++j) { const unsigned c = xb_ld(&bar[XB_XCNT(j)]); sum += c; cnt += (c > 0u) ? 1u : 0u; mine = (j == x) ? c : mine; }
        if (sum == G) break;
        __builtin_amdgcn_s_sleep(1);
        if ((++sp & 255u) == 0u) { if (xb_ld(&bar[XB_TMO])) break; if (sp > XB_SPIN_CAP) { atomicAdd(&bar[XB_TMO], 1u); break; } }
    }
    nloc = mine > 0u ? mine : 1u; nx = cnt > 0u ? cnt : 1u;
}

__device__ __forceinline__ void xcd_barrier(const XcdBarrier& b) {
    asm volatile("s_waitcnt vmcnt(0)" ::: "memory");
    __syncthreads();
    if (threadIdx.x == 0) {
        unsigned* bar = b.bar;
        __builtin_amdgcn_s_waitcnt(0);
        unsigned nloc = b.st[0], nx = b.st[1];
        if (nloc == 0u) { xcd_barrier_complete(bar, b.x, nloc, nx); b.st[0] = nloc; b.st[1] = nx; }
        const unsigned old = xb_add(&bar[XB_XSUB(b.x)], 1u);
        const unsigned gen = old / nloc;
        if (old + 1u == (gen + 1u) * nloc) {
            __builtin_amdgcn_fence(__ATOMIC_RELEASE, "agent");
            asm volatile("s_waitcnt vmcnt(0)" ::: "memory");
            const unsigned og = xb_add(&bar[XB_TOP], 1u);
            const unsigned tg = og / nx;
            if (og + 1u == (tg + 1u) * nx) xb_add(&bar[XB_TOPGEN], 1u);
            else XB_SPIN(xb_ld(&bar[XB_TOPGEN]) == tg, bar);
            __builtin_amdgcn_fence(__ATOMIC_ACQUIRE, "agent");
            xb_add(&bar[XB_XGEN(b.x)], 1u);
            asm volatile("s_waitcnt vmcnt(0)" ::: "memory");
        } else {
            XB_SPIN(xb_ld(&bar[XB_XGEN(b.x)]) == gen, bar);
            __builtin_amdgcn_fence(__ATOMIC_ACQUIRE, "agent");
            asm volatile("s_waitcnt vmcnt(0)" ::: "memory");
        }
    }
    __syncthreads();
}

struct Frame {
    LAS unsigned char* lds;
    volatile LAS unsigned* MISC;
    gu32* ctl;
    int tid, lane, wave, vcu, G;
    unsigned char* ws;
    float* out;
};
struct Args { const float* in[18]; float* out; unsigned char* ws; int ph_lo, ph_hi, li, pad; };
enum { I_X = 0, I_ANG, I_WIN, I_SINK, I_LBT, I_HNG, I_WUA, I_WUH, I_WOUT, I_FNG, I_WRG, I_BRG, I_WRE, I_BRE, I_WEG, I_WEU, I_WED, I_FING };

__device__ __forceinline__ float wave_sum(float v) {
#if defined(__HIP_DEVICE_COMPILE__)
#define WS_ROR(n) v += __builtin_bit_cast(float, __builtin_amdgcn_update_dpp(0, __builtin_bit_cast(int, v), 0x120 + (n), 0xf, 0xf, false))
    WS_ROR(8); WS_ROR(4); WS_ROR(2); WS_ROR(1);
#undef WS_ROR
    const int b = __builtin_bit_cast(int, v);
    const float r0 = __builtin_bit_cast(float, __builtin_amdgcn_readlane(b, 0)), r1 = __builtin_bit_cast(float, __builtin_amdgcn_readlane(b, 16));
    const float r2 = __builtin_bit_cast(float, __builtin_amdgcn_readlane(b, 32)), r3 = __builtin_bit_cast(float, __builtin_amdgcn_readlane(b, 48));
    return (r0 + r1) + (r2 + r3);
#else
    return v;
#endif
}

struct CmPerm { const float* W; int N; __device__ __forceinline__ const float* seg(int p0, int n, int c, int& ld) const { ld = N; return W + p0 + 8 * c + 4 * n; } };
struct CmIn { const float* W; __device__ __forceinline__ const float* seg(int p0, int n, int c, int& ld) const { ld = INW;
    return (p0 < C_VA) ? (W + (p0 & ~63) + 32 * n + 16 * ((p0 >> 5) & 1) + 4 * c) : (W + p0 + 8 * c + 4 * n); } };
struct CmGU { const float* Wg; const float* Wu; __device__ __forceinline__ const float* seg(int p0, int n, int c, int& ld) const { ld = DEXP; return (n ? Wu : Wg) + 16 * (p0 >> 5) + 4 * c; } };
template <class CM> __device__ __forceinline__ void transpose_load(const CM& cm, int kb, int nb, int lane, f32x4 (&v)[8]) {
    const int k0 = 64 * kb, n0 = 32 * nb;
    const int nc = lane & 7, kr = lane >> 3;
    int ld; const float* src; { const float* s0 = cm.seg(n0, 0, nc & 3, ld); const float* s1 = cm.seg(n0, 1, nc & 3, ld); src = (nc >> 2) ? s1 : s0; }
#pragma unroll
    for (int i = 0; i < 8; ++i) v[i] = *(const GAS f32x4*)(src + (size_t)(k0 + 8 * i + kr) * ld);
}
__device__ __forceinline__ void transpose_finish(int K, bf16* WT, LAS float* scr, int kb, int nb, int lane, const f32x4 (&v)[8], const LAS float* gk = nullptr) {
    constexpr int SP = 36;
    const int k0 = 64 * kb, n0 = 32 * nb;
    const int nc = lane & 7, kr = lane >> 3;
#pragma unroll
    for (int i = 0; i < 8; ++i) *(LAS f32x4*)(scr + (8 * i + kr) * SP + 4 * nc) = gk ? v[i] * gk[k0 + 8 * i + kr] : v[i];
    LDS_WAIT(); asm volatile("" ::: "memory");
    const int c = lane & 7;
#pragma unroll
    for (int j = 0; j < 4; ++j) { const int n = (lane >> 3) + 8 * j; const LAS float* s = scr + (8 * c) * SP + n;
        v4u o; o.x = pk2(s[0 * SP], s[1 * SP]); o.y = pk2(s[2 * SP], s[3 * SP]); o.z = pk2(s[4 * SP], s[5 * SP]); o.w = pk2(s[6 * SP], s[7 * SP]);
        *(GAS v4u*)(WT + (size_t)(n0 + n) * K + k0 + 8 * c) = o; }
    LDS_WAIT(); asm volatile("" ::: "memory");
}
template <class CM> __device__ __forceinline__ void transpose_item(const CM& cm, int K, bf16* WT, LAS float* scr, int kb, int nb, int lane, const LAS float* gk = nullptr) {
    f32x4 v[8]; transpose_load(cm, kb, nb, lane, v); transpose_finish(K, WT, scr, kb, nb, lane, v, gk);
}
__device__ __forceinline__ void conv_weights(Frame& F, const Args& A, int l) {
    LAS float* scr = (LAS float*)(F.lds + RING_OFF + F.wave * 16384);
    const int gw = F.vcu * NWAVES + F.wave, NGW = F.G * NWAVES;
    unsigned char* ws = F.ws;
    const float* w_in = A.in[I_WIN] + (size_t)l * D * INW;
    const float* w_ua = A.in[I_WUA] + (size_t)l * 512 * D;
    const float* w_uh = A.in[I_WUH] + (size_t)l * 512 * D;
    const float* w_out = A.in[I_WOUT] + (size_t)l * D * D;
    const float* w_eg = A.in[I_WEG] + (size_t)l * NEXP * D * DEXP;
    const float* w_eu = A.in[I_WEU] + (size_t)l * NEXP * D * DEXP;
    const float* w_ed = A.in[I_WED] + (size_t)l * NEXP * DEXP * D;
    constexpr int I_A = 16 * (INW / 32), I_B = 8 * 32, I_D = 16 * 32, I_E1 = 16 * 32, I_E = NEXP * I_E1, I_F1 = 8 * 32, I_F = NEXP * I_F1;
    constexpr int NITEMS = I_A + 2 * I_B + I_D + (EXPERTS_BY_QUEUE ? 0 : I_E + I_F);
    LAS float* gkl = scr + 2560;
    if (NORMFOLD) { const float* gsrc = A.in[I_ANG] + (size_t)l * D;
#pragma unroll
        for (int j = 0; j < 4; ++j) *(LAS f32x4*)(gkl + 4 * F.lane + 256 * j) = *(const f32x4*)(gsrc + 4 * F.lane + 256 * j);
        LDS_WAIT(); }
    for (int it = gw; it < NITEMS; it += NGW) {
        int r = it;
        if (r < I_A) { CmIn cm{w_in}; transpose_item(cm, D, (bf16*)(ws + WS_WIN), scr, r / (INW / 32), r % (INW / 32), F.lane, NORMFOLD ? gkl : nullptr); continue; } r -= I_A;
        if (r < I_B) { CmPerm cm{w_ua, D}; transpose_item(cm, 512, (bf16*)(ws + WS_WUA), scr, r / 32, r % 32, F.lane); continue; } r -= I_B;
        if (r < I_B) { CmPerm cm{w_uh, D}; transpose_item(cm, 512, (bf16*)(ws + WS_WUH), scr, r / 32, r % 32, F.lane); continue; } r -= I_B;
        if (r < I_D) { CmPerm cm{w_out, D}; transpose_item(cm, D, (bf16*)(ws + WS_WOUT), scr, r / 32, r % 32, F.lane); continue; } r -= I_D;
        if (r < I_E) { const int e = r / I_E1, q = r % I_E1; CmGU cm{w_eg + (size_t)e * D * DEXP, w_eu + (size_t)e * D * DEXP};
            transpose_item(cm, D, (bf16*)(ws + WS_W1) + (size_t)e * 1024 * D, scr, q / 32, q % 32, F.lane); continue; } r -= I_E;
        { const int e = r / I_F1, q = r % I_F1; CmPerm cm{w_ed + (size_t)e * DEXP * D, D};
            transpose_item(cm, DEXP, (bf16*)(ws + WS_W2) + (size_t)e * D * DEXP, scr, q / 32, q % 32, F.lane); }
    }
}
__device__ __forceinline__ int conv_wgs(int G, int units, int cmax) {
    if (!EXPERTS_BY_QUEUE || G < 64 || (G % 8) != 0) return 0;
    const int r = (units + G - 1) / G; int c = cmax;
    while (c > 0 && (units + (G - c) - 1) / (G - c) > r) c -= 8;
    return c;
}
__device__ __forceinline__ void conv_experts_range(Frame& F, const Args& A, int l, int first, int last, int wi, int nw) {
    LAS float* scr = (LAS float*)(F.lds + RING_OFF + F.wave * 16384);
    unsigned char* ws = F.ws;
    const float* w_eg = A.in[I_WEG] + (size_t)l * NEXP * D * DEXP;
    const float* w_eu = A.in[I_WEU] + (size_t)l * NEXP * D * DEXP;
    const float* w_ed = A.in[I_WED] + (size_t)l * NEXP * DEXP * D;
    LAS float* gkl = scr + 2560;
    if (NORMFOLD && first < last) { const float* gsrc = A.in[I_FNG] + (size_t)l * D;
#pragma unroll
        for (int j = 0; j < 4; ++j) *(LAS f32x4*)(gkl + 4 * F.lane + 256 * j) = *(const f32x4*)(gsrc + 4 * F.lane + 256 * j);
        LDS_WAIT(); }
    constexpr int I_E1 = 16 * 32, I_E = NEXP * I_E1, I_F1 = 8 * 32;
    static_assert(I_E % 2 == 0 && I_F1 % 2 == 0, "pairs do not straddle");
#define CQ_LOAD(q, va, vb) do { const bool w1_ = (q) < I_E; const int r0_ = w1_ ? (q) : (q) - I_E, e_ = w1_ ? (r0_ >> 9) : (r0_ >> 8), r_ = w1_ ? (r0_ & 511) : (r0_ & 255), kb_ = r_ >> 5, nb_ = r_ & 31; \
        const int nc_ = F.lane & 7, kr_ = F.lane >> 3, n_ = nc_ >> 2, c_ = nc_ & 3; const size_t eo_ = (size_t)e_ * D * DEXP; \
        const float* base_ = w1_ ? ((n_ ? w_eu : w_eg) + eo_ + 16 * nb_ + 4 * c_) : (w_ed + eo_ + 32 * nb_ + 8 * c_ + 4 * n_); const int ld_ = w1_ ? DEXP : D, st_ = w1_ ? 16 : 32; \
        _Pragma("unroll") for (int i_ = 0; i_ < 8; ++i_) { const GAS float* p_ = (const GAS float*)(base_ + (size_t)(64 * kb_ + 8 * i_ + kr_) * ld_); const GAS float* p2_ = p_ + st_; \
            CQ_LD(va[i_], p_); CQ_LD(vb[i_], p2_); } } while (0)
#if CONV_ASM_LOADS
#define CQ_LD(dst, p) asm volatile("global_load_dwordx4 %0, %1, off" : "=&v"(dst) : "v"(p) : "memory")
#define CQ_WAIT(n, va, vb) asm volatile("s_waitcnt vmcnt(" #n ")" : "+v"(va[0]), "+v"(va[1]), "+v"(va[2]), "+v"(va[3]), "+v"(va[4]), "+v"(va[5]), "+v"(va[6]), "+v"(va[7]), \
        "+v"(vb[0]), "+v"(vb[1]), "+v"(vb[2]), "+v"(vb[3]), "+v"(vb[4]), "+v"(vb[5]), "+v"(vb[6]), "+v"(vb[7]) :: "memory")
#else
#define CQ_LD(dst, p) dst = *(const GAS f32x4*)(p)
#define CQ_WAIT(n, va, vb) do { } while (0)
#endif
#define CQ_FINISH(q, va, vb) do { const bool w1_ = (q) < I_E; const int r0_ = w1_ ? (q) : (q) - I_E, e_ = w1_ ? (r0_ >> 9) : (r0_ >> 8), r_ = w1_ ? (r0_ & 511) : (r0_ & 255); \
        bf16* WT_ = (w1_ ? (bf16*)(ws + WS_W1) : (bf16*)(ws + WS_W2)) + (size_t)e_ * (w1_ ? 1024 * D : D * DEXP); const int K_ = w1_ ? D : DEXP; \
        const LAS float* gk_ = (NORMFOLD && w1_) ? gkl : nullptr; transpose_finish(K_, WT_, scr, r_ >> 5, r_ & 31, F.lane, va, gk_); transpose_finish(K_, WT_, scr, r_ >> 5, (r_ & 31) + 1, F.lane, vb, gk_); } while (0)
    static_assert(I_E1 == 512 && I_F1 == 256, "shifts above");
    f32x4 a0[8], a1[8], b0[8], b1[8];
    const int step = 2 * nw;
    int qa = first + 2 * wi, qb; if (qa >= last) return;
    CQ_LOAD(qa, a0, a1);
    for (;;) {
        qb = qa + step; const bool hb = qb < last; { const int ql = hb ? qb : qa; CQ_LOAD(ql, b0, b1); }
        CQ_WAIT(16, a0, a1); CQ_FINISH(qa, a0, a1);
        if (!hb) { CQ_WAIT(0, b0, b1); break; }
        qa = qb + step; const bool ha = qa < last; { const int ql = ha ? qa : qb; CQ_LOAD(ql, a0, a1); }
        CQ_WAIT(16, b0, b1); CQ_FINISH(qb, b0, b1);
        if (!ha) { CQ_WAIT(0, a0, a1); break; }
    }
#undef CQ_WAIT
#undef CQ_LD
#undef CQ_LOAD
#undef CQ_FINISH
}
__device__ __forceinline__ void make_tables(Frame& F, const Args& A) {
    const int gt = F.vcu * (NWAVES * 64) + F.tid, NT = F.G * NWAVES * 64;
    float* cosT = (float*)(F.ws + WS_COS); float* sinT = (float*)(F.ws + WS_SIN); float* lbt = (float*)(F.ws + WS_LBT);
    for (int idx = gt; idx < SEQ * 32; idx += NT) { const int pos = idx >> 5, i = idx & 31;
        const double inv = exp2(-(double)i * (13.287712379549449 / 32.0));
        const double ang = (double)pos * inv; const double r = ang - 6.283185307179586476925 * rint(ang * 0.15915494309189533577);
        float s, c; sincosf((float)r, &s, &c); cosT[idx] = c; sinT[idx] = s; }
    for (int idx = gt; idx < 2 * 512; idx += NT) { const int dir = idx >> 9, col = idx & 511;
        float tv[DEPTH]; float mx = -3.0e38f;
#pragma unroll
        for (int l = 0; l < DEPTH; ++l) { tv[l] = A.in[I_LBT][(size_t)(l * 2 + dir) * 512 + col]; mx = fmaxf(mx, tv[l]); }
        float den = 0.f;
#pragma unroll
        for (int l = 0; l < DEPTH; ++l) { tv[l] = expf(tv[l] - mx); den += tv[l]; }
        float cum = 0.f;
#pragma unroll
        for (int l = 0; l < DEPTH; ++l) { if (l > 0) cum += tv[l] / den; const float lb = cum;
            lbt[((l * 2 + dir) * 2 + 0) * 512 + col] = lb; lbt[((l * 2 + dir) * 2 + 1) * 512 + col] = 0.f; } }
}
__device__ __forceinline__ void norm_rows(Frame& F, const float* xin, float* xcopy, const float* g, bf16* xn, float* rs_out = nullptr) {
    const int gw = F.vcu * NWAVES + F.wave, NGW = F.G * NWAVES;
    f32x4 gv[4];
#pragma unroll
    for (int j = 0; j < 4; ++j) gv[j] = *(const f32x4*)(g + 4 * F.lane + 256 * j);
    f32x4 vn[4];
    { const GAS f32x4* xr = (const GAS f32x4*)(xin + (size_t)gw * D) + F.lane;
#pragma unroll
      for (int j = 0; j < 4; ++j) vn[j] = xr[64 * j]; }
    for (int m = gw; m < T; m += NGW) {
        f32x4 v[4]; float s = 0.f;
#pragma unroll
        for (int j = 0; j < 4; ++j) { v[j] = vn[j]; s += (v[j].x * v[j].x + v[j].y * v[j].y) + (v[j].z * v[j].z + v[j].w * v[j].w); }
        if (m + NGW < T) { const GAS f32x4* xr = (const GAS f32x4*)(xin + (size_t)(m + NGW) * D) + F.lane;
#pragma unroll
            for (int j = 0; j < 4; ++j) vn[j] = xr[64 * j]; }
        const float rstd = 1.0f / sqrtf(wave_sum(s) * (1.f / D) + NORM_EPS);
        if (xcopy) { GAS f32x4* xo = (GAS f32x4*)(xcopy + (size_t)m * D) + F.lane;
#pragma unroll
            for (int j = 0; j < 4; ++j) xo[64 * j] = v[j]; }
        GAS v2u* o8 = (GAS v2u*)(xn + (size_t)m * D) + F.lane;
#pragma unroll
        for (int j = 0; j < 4; ++j) { const f32x4 y = rs_out ? v[j] : v[j] * rstd * gv[j]; v2u w; w.x = pk2(y.x, y.y); w.y = pk2(y.z, y.w); o8[64 * j] = w; }
        if (rs_out && F.lane == 0) rs_out[m] = rstd;
    }
}

__device__ __forceinline__ float row_sum16n(float v) {
#if defined(__HIP_DEVICE_COMPILE__)
#define RS_ROR(n) v += __builtin_bit_cast(float, __builtin_amdgcn_update_dpp(0, __builtin_bit_cast(int, v), 0x120 + (n), 0xf, 0xf, false))
    RS_ROR(8); RS_ROR(4); RS_ROR(2); RS_ROR(1);
#undef RS_ROR
#endif
    return v;
}
__device__ __forceinline__ void norm_rows4(Frame& F, const float* xin, const float* g, bf16* xn) {
    const int gw = F.vcu * NWAVES + F.wave, NGW = F.G * NWAVES, r = F.lane >> 4, c = F.lane & 15;
    constexpr int NTG = T / 4;
    f32x4 vq[16], gq[16];
#pragma unroll
    for (int k = 0; k < 16; ++k) gq[k] = *(const f32x4*)(g + 64 * k + 4 * c);
    if (gw < NTG) { const GAS f32x4* xr = (const GAS f32x4*)(xin + (size_t)(4 * gw + r) * D) + c;
#pragma unroll
        for (int k = 0; k < 16; ++k) vq[k] = xr[16 * k]; }
    for (int tg = gw; tg < NTG; tg += NGW) { const int m = 4 * tg + r;
        f32x4 v[16]; float s = 0.f;
#pragma unroll
        for (int k = 0; k < 16; ++k) { v[k] = vq[k]; s += (v[k].x * v[k].x + v[k].y * v[k].y) + (v[k].z * v[k].z + v[k].w * v[k].w); }
        if (tg + NGW < NTG) { const GAS f32x4* xr = (const GAS f32x4*)(xin + (size_t)(4 * (tg + NGW) + r) * D) + c;
#pragma unroll
            for (int k = 0; k < 16; ++k) vq[k] = xr[16 * k]; }
        const float rstd = 1.0f / sqrtf(row_sum16n(s) * (1.f / D) + NORM_EPS);
        GAS v2u* o8 = (GAS v2u*)(xn + (size_t)m * D) + c;
#pragma unroll
        for (int k = 0; k < 16; ++k) { const f32x4 y = v[k] * rstd * gq[k]; v2u w; w.x = pk2(y.x, y.y); w.y = pk2(y.z, y.w); o8[16 * k] = w; }
    }
}

using pg8::Unit; using pg8::cvt_pk_bf16;
__device__ __forceinline__ v4u pack8(const f32x4& a, const f32x4& b) { v4u w; w.x = cvt_pk_bf16(a[0], a[1]); w.y = cvt_pk_bf16(a[2], a[3]); w.z = cvt_pk_bf16(b[0], b[1]); w.w = cvt_pk_bf16(b[2], b[3]); return w; }
__device__ __forceinline__ void unpack8(const v4u& w, f32x4& a, f32x4& b) { a = (f32x4){bflo(w.x), bfhi(w.x), bflo(w.y), bfhi(w.y)}; b = (f32x4){bflo(w.z), bfhi(w.z), bflo(w.w), bfhi(w.w)}; }
__device__ __forceinline__ float logf_gate(float z, float lb) {
    const float t = __expf(-fabsf(z)), num = (z >= 0.f) ? __builtin_fmaf(lb, t, 1.0f) : (lb + t);
    const float r2 = __builtin_amdgcn_logf(num) - __builtin_amdgcn_logf(1.0f + t);
    return fmaxf(r2, LOGF_MIN * 1.4426950408889634f);
}
struct EpiInA {
    static constexpr bool PERM = false, AFTER_DRAIN = false;
    bf16* PA; const float* cosT; const float* sinT; const float* lbt;
    int pofs;
    const float* rs;
    __device__ __forceinline__ void operator()(const f32x4 (&acc)[2][2][4][2], const Unit& u, int wr, int wc, int fr, int fq) const {
        const int pn = u.pn + pofs, row0 = u.pm * 256 + wr * 64 + fr;
        float rsv[2][4];
#pragma unroll
        for (int ai = 0; ai < 2; ++ai)
#pragma unroll
            for (int m = 0; m < 4; ++m) rsv[ai][m] = NORMFOLD ? rs[row0 + 128 * ai + 16 * m] : 1.0f;
#pragma unroll
        for (int bj = 0; bj < 2; ++bj) {
            int mode = 0; float sc = 1.f; int lbo = 0;
            if (pn < 2) { mode = 1; sc = QSCALE; } else if (pn == 2) { mode = (bj == 0) ? 1 : 0; } else if (pn < 5) mode = 2;
            else if (pn < 7) { mode = 3; lbo = (pn - 5) * 256; } else if (pn < 9) { mode = 3; lbo = 1024 + (pn - 7) * 256; } else if (pn < 11) mode = 0; else mode = 2;
            if (mode == 1) {
                const int hb = 256 * pn + 128 * bj + 64 * (wc >> 1), d0 = 16 * (wc & 1) + 4 * fq;
#pragma unroll
                for (int ai = 0; ai < 2; ++ai) { f32x4 csv[4], snv[4];
#pragma unroll
                    for (int m = 0; m < 4; ++m) { const int pos = (row0 + 128 * ai + 16 * m) & (SEQ - 1); csv[m] = *(const f32x4*)(cosT + pos * 32 + d0); snv[m] = *(const f32x4*)(sinT + pos * 32 + d0); }
#pragma unroll
                    for (int m = 0; m < 4; ++m) { const int r = row0 + 128 * ai + 16 * m;
                        const f32x4 cs = csv[m], sn = snv[m];
                        const f32x4 x1 = acc[ai][bj][m][0], x2 = acc[ai][bj][m][1];
                        const float scr_ = sc * rsv[ai][m];
                        const f32x4 o1 = (x1 * cs - x2 * sn) * scr_, o2 = (x2 * cs + x1 * sn) * scr_;
                        bf16* rp = PA + (size_t)r * NPA + hb + d0;
                        v2u w1; w1.x = cvt_pk_bf16(o1[0], o1[1]); w1.y = cvt_pk_bf16(o1[2], o1[3]); *(v2u*)rp = w1;
                        v2u w2; w2.x = cvt_pk_bf16(o2[0], o2[1]); w2.y = cvt_pk_bf16(o2[2], o2[3]); *(v2u*)(rp + 32) = w2; }
                    asm volatile("" ::: "memory"); }
            } else {
                const int c0 = 256 * pn + 128 * bj + 32 * wc + 8 * fq;
                if (mode == 3) {
                    const float* lp = lbt + lbo + 128 * bj + 32 * wc + 8 * fq;
#pragma unroll
                    for (int n = 0; n < 2; ++n) { const f32x4 la = *(const f32x4*)(lp + 4 * n);
#pragma unroll
                        for (int ai = 0; ai < 2; ++ai)
#pragma unroll
                            for (int m = 0; m < 4; ++m) { const int r = row0 + 128 * ai + 16 * m; bf16* rp = PA + (size_t)r * NPA + c0 + 4 * n;
                                const f32x4 v = acc[ai][bj][m][n] * rsv[ai][m]; h16x4 hv;
#pragma unroll
                                for (int j = 0; j < 4; ++j) hv[j] = (_Float16)logf_gate(v[j], la[j]);
                                *(h16x4*)rp = hv; asm volatile("" ::: "memory"); } }
                } else {
#pragma unroll
                    for (int ai = 0; ai < 2; ++ai)
#pragma unroll
                        for (int m = 0; m < 4; ++m) { const int r = row0 + 128 * ai + 16 * m; bf16* rp = PA + (size_t)r * NPA + c0;
                            f32x4 v0 = acc[ai][bj][m][0], v1 = acc[ai][bj][m][1];
                            if (NORMFOLD) { const float rr = rsv[ai][m]; v0 = v0 * rr; v1 = v1 * rr; }
                            if (mode == 2) {
#pragma unroll
                                for (int j = 0; j < 4; ++j) { v0[j] = siluf_(v0[j]); v1[j] = siluf_(v1[j]); } }
                            *(v4u*)rp = pack8(v0, v1); asm volatile("" ::: "memory"); }
                }
            }
        }
    }
};
struct EpiGate {
    static constexpr bool PERM = false, AFTER_DRAIN = false;
    bf16* O; const float* rs;
    __device__ __forceinline__ void operator()(const f32x4 (&acc)[2][2][4][2], const Unit& u, int wr, int wc, int fr, int fq) const {
        const int row0 = u.pm * 256 + wr * 64 + fr, c0 = 256 * u.pn + 32 * wc + 8 * fq;
        float rsv[2][4];
#pragma unroll
        for (int ai = 0; ai < 2; ++ai)
#pragma unroll
            for (int m = 0; m < 4; ++m) rsv[ai][m] = NORMFOLD ? rs[row0 + 128 * ai + 16 * m] : 1.0f;
#pragma unroll
        for (int ai = 0; ai < 2; ++ai)
#pragma unroll
            for (int m = 0; m < 4; ++m) { bf16* rp = O + (size_t)(row0 + 128 * ai + 16 * m) * NGATE + c0; const float rr = rsv[ai][m];
#pragma unroll
                for (int bj = 0; bj < 2; ++bj) { f32x4 v0 = acc[ai][bj][m][0] * rr, v1 = acc[ai][bj][m][1] * rr;
#if !defined(CK_PLAIN)
#pragma unroll
                    for (int j = 0; j < 4; ++j) { v0[j] = sigmoidf_(v0[j]); v1[j] = sigmoidf_(v1[j]); }
#endif
                    *(v4u*)(rp + 128 * bj) = pack8(v0, v1); } }
    }
};
#if defined(PROBE_KLOOP)
struct EpiNull {
    static constexpr bool PERM = false, AFTER_DRAIN = false;
    bf16* O;
    __device__ __forceinline__ void operator()(const f32x4 (&acc)[2][2][4][2], const Unit& u, int wr, int wc, int fr, int fq) const {
        float s = 0.f;
#pragma unroll
        for (int ai = 0; ai < 2; ++ai)
#pragma unroll
            for (int bj = 0; bj < 2; ++bj)
#pragma unroll
                for (int m = 0; m < 4; ++m)
#pragma unroll
                    for (int n = 0; n < 2; ++n) s += acc[ai][bj][m][n][0] + acc[ai][bj][m][n][1] + acc[ai][bj][m][n][2] + acc[ai][bj][m][n][3];
        if (s == 12345.678f) O[u.pm + wr + wc + fr + fq] = (bf16)1;
    }
};
#endif
struct EpiUpA {
    static constexpr bool PERM = false, AFTER_DRAIN = false;
    bf16* MG; const bf16* GT;
    __device__ __forceinline__ void operator()(const f32x4 (&acc)[2][2][4][2], const Unit& u, int wr, int wc, int fr, int fq) const {
        const int row0 = u.pm * 256 + wr * 64 + fr, c0 = 256 * u.pn + 32 * wc + 8 * fq;
        v4u gw[2][2][2];
#define UA_LOAD(q_, buf_) do { _Pragma("unroll") for (int mm = 0; mm < 2; ++mm) _Pragma("unroll") for (int bj = 0; bj < 2; ++bj) \
            gw[buf_][mm][bj] = *(const v4u*)(GT + (size_t)(row0 + 128 * ((q_) >> 1) + 16 * (2 * ((q_) & 1) + mm)) * NGATE + c0 + 128 * bj); } while (0)
        UA_LOAD(0, 0);
#pragma unroll
        for (int q = 0; q < 4; ++q) { const int ai = q >> 1, mh = q & 1;
            if (q < 3) UA_LOAD(q + 1, (q + 1) & 1);
            __builtin_amdgcn_sched_barrier(0);
#pragma unroll
            for (int mm = 0; mm < 2; ++mm) { const int m = 2 * mh + mm; bf16* rp = MG + (size_t)(row0 + 128 * ai + 16 * m) * D + c0;
#pragma unroll
                for (int bj = 0; bj < 2; ++bj) { f32x4 g0, g1; unpack8(gw[q & 1][mm][bj], g0, g1);
                    *(v4u*)(rp + 128 * bj) = pack8(acc[ai][bj][m][0] * g0, acc[ai][bj][m][1] * g1); } }
            __builtin_amdgcn_sched_barrier(0); }
#undef UA_LOAD
    }
};
struct EpiUpB {
    static constexpr bool PERM = false, AFTER_DRAIN = false;
    bf16* MG; const bf16* GT; const float* ssq;
    __device__ __forceinline__ void operator()(const f32x4 (&acc)[2][2][4][2], const Unit& u, int wr, int wc, int fr, int fq) const {
        const int row0 = u.pm * 256 + wr * 64 + fr, c0 = 256 * u.pn + 32 * wc + 8 * fq;
        v4u gw[2][2][2], pw[2][2][2]; f32x4 sq[2][2];
#define UB_LOAD(q_, buf_) do { _Pragma("unroll") for (int mm = 0; mm < 2; ++mm) { const int r_ = row0 + 128 * ((q_) >> 1) + 16 * (2 * ((q_) & 1) + mm); sq[buf_][mm] = *(const f32x4*)(ssq + (size_t)r_ * 4); \
            _Pragma("unroll") for (int bj = 0; bj < 2; ++bj) { gw[buf_][mm][bj] = *(const v4u*)(GT + (size_t)r_ * NGATE + 1024 + c0 + 128 * bj); pw[buf_][mm][bj] = *(const v4u*)(MG + (size_t)r_ * D + c0 + 128 * bj); } } } while (0)
        UB_LOAD(0, 0);
#pragma unroll
        for (int q = 0; q < 4; ++q) { const int ai = q >> 1, mh = q & 1;
            if (q < 3) UB_LOAD(q + 1, (q + 1) & 1);
            __builtin_amdgcn_sched_barrier(0);
#pragma unroll
            for (int mm = 0; mm < 2; ++mm) { const int m = 2 * mh + mm; bf16* rp = MG + (size_t)(row0 + 128 * ai + 16 * m) * D + c0; const f32x4 sv = sq[q & 1][mm];
                const float rstd = 1.0f / sqrtf(((sv[0] + sv[1]) + (sv[2] + sv[3])) * (1.f / 512.f) + NORM_EPS);
#pragma unroll
                for (int bj = 0; bj < 2; ++bj) { f32x4 g0, g1, p0, p1; unpack8(gw[q & 1][mm][bj], g0, g1); unpack8(pw[q & 1][mm][bj], p0, p1);
                    *(v4u*)(rp + 128 * bj) = pack8(p0 + acc[ai][bj][m][0] * g0 * rstd, p1 + acc[ai][bj][m][1] * g1 * rstd); } }
            __builtin_amdgcn_sched_barrier(0); }
#undef UB_LOAD
    }
};
struct EpiOut {
    static constexpr bool PERM = false, AFTER_DRAIN = false;
    float* X; const float* XI;
    __device__ __forceinline__ void operator()(const f32x4 (&acc)[2][2][4][2], const Unit& u, int wr, int wc, int fr, int fq) const {
        const int row0 = u.pm * 256 + wr * 64 + fr, c0 = 256 * u.pn + 32 * wc + 8 * fq;
#pragma unroll
        for (int ai = 0; ai < 2; ++ai) { f32x4 xv[4][2][2];
#pragma unroll
            for (int m = 0; m < 4; ++m)
#pragma unroll
                for (int bj = 0; bj < 2; ++bj) { const f32x4* p = (const f32x4*)(XI + (size_t)(row0 + 128 * ai + 16 * m) * D + c0 + 128 * bj); xv[m][bj][0] = p[0]; xv[m][bj][1] = p[1]; }
#pragma unroll
            for (int m = 0; m < 4; ++m)
#pragma unroll
                for (int bj = 0; bj < 2; ++bj) { f32x4* p = (f32x4*)(X + (size_t)(row0 + 128 * ai + 16 * m) * D + c0 + 128 * bj); p[0] = xv[m][bj][0] + acc[ai][bj][m][0]; p[1] = xv[m][bj][1] + acc[ai][bj][m][1]; }
            asm volatile("" ::: "memory"); }
    }
};
template <bool IN_F32> struct EpiOutB {
    static constexpr bool PERM = false, AFTER_DRAIN = false;
    bf16* XO; const void* XI;
    __device__ __forceinline__ void operator()(const f32x4 (&acc)[2][2][4][2], const Unit& u, int wr, int wc, int fr, int fq) const {
        const int row0 = u.pm * 256 + wr * 64 + fr, c0 = 256 * u.pn + 32 * wc + 8 * fq;
#pragma unroll
        for (int ai = 0; ai < 2; ++ai) { f32x4 xv[4][2][2];
#pragma unroll
            for (int m = 0; m < 4; ++m)
#pragma unroll
                for (int bj = 0; bj < 2; ++bj) { const size_t o = (size_t)(row0 + 128 * ai + 16 * m) * D + c0 + 128 * bj;
                    if constexpr (IN_F32) { const f32x4* p = (const f32x4*)((const float*)XI + o); xv[m][bj][0] = p[0]; xv[m][bj][1] = p[1]; }
                    else { const v4u w = *(const v4u*)((const bf16*)XI + o); unpack8(w, xv[m][bj][0], xv[m][bj][1]); } }
#pragma unroll
            for (int m = 0; m < 4; ++m)
#pragma unroll
                for (int bj = 0; bj < 2; ++bj) { const size_t o = (size_t)(row0 + 128 * ai + 16 * m) * D + c0 + 128 * bj;
                    *(v4u*)(XO + o) = pack8(xv[m][bj][0] + acc[ai][bj][m][0], xv[m][bj][1] + acc[ai][bj][m][1]); }
            asm volatile("" ::: "memory"); }
    }
};
struct EpiAct {
    static constexpr bool PERM = false, AFTER_DRAIN = false;
    bf16* ACT; const float* rs;
    __device__ __forceinline__ void operator()(const f32x4 (&acc)[2][2][4][2], const Unit& u, int wr, int wc, int fr, int fq) const {
        const int row0 = u.pm * 256 + wr * 64 + fr, c0 = 128 * u.pn + 16 * wc + 4 * fq;
        float rsv[2][4];
#pragma unroll
        for (int ai = 0; ai < 2; ++ai)
#pragma unroll
            for (int m = 0; m < 4; ++m) rsv[ai][m] = NORMFOLD ? rs[row0 + 128 * ai + 16 * m] : 1.0f;
#pragma unroll
        for (int ai = 0; ai < 2; ++ai)
#pragma unroll
            for (int m = 0; m < 4; ++m) { bf16* rp = ACT + (size_t)(row0 + 128 * ai + 16 * m) * DEXP + c0; const float rr = rsv[ai][m];
#pragma unroll
                for (int bj = 0; bj < 2; ++bj) { const f32x4 g = acc[ai][bj][m][0] * rr, up = acc[ai][bj][m][1] * rr; f32x4 a;
#pragma unroll
                    for (int j = 0; j < 4; ++j) a[j] = siluf_(g[j]) * up[j];
                    const unsigned long long w64 = (unsigned long long)cvt_pk_bf16(a[0], a[1]) | ((unsigned long long)cvt_pk_bf16(a[2], a[3]) << 32);
#if MOE_HANDOFF
                    __hip_atomic_store((gu64*)(rp + 64 * bj), w64, RLX_AGENT); } }
#else
                    *(unsigned long long*)(rp + 64 * bj) = w64; } }
#endif
    }
};
struct EpiY {
    static constexpr bool PERM = false, AFTER_DRAIN = false;
    bf16* Y;
    __device__ __forceinline__ void operator()(const f32x4 (&acc)[2][2][4][2], const Unit& u, int wr, int wc, int fr, int fq) const {
        const int row0 = u.pm * 256 + wr * 64 + fr, c0 = 256 * u.pn + 32 * wc + 8 * fq;
#pragma unroll
        for (int ai = 0; ai < 2; ++ai)
#pragma unroll
            for (int m = 0; m < 4; ++m) { bf16* rp = Y + (size_t)(row0 + 128 * ai + 16 * m) * D + c0;
#pragma unroll
                for (int bj = 0; bj < 2; ++bj) *(v4u*)(rp + 128 * bj) = pack8(acc[ai][bj][m][0], acc[ai][bj][m][1]); }
    }
};

#define VLD(p) __hip_atomic_load((p), __ATOMIC_RELAXED, __HIP_MEMORY_SCOPE_AGENT)
constexpr int HIST_OFF = MISC_OFF + 256;
constexpr int SBASE_OFF = HIST_OFF + 128;
constexpr int STOT_OFF = SBASE_OFF + 128;
constexpr int BRE_OFF = STOT_OFF + 128;
static_assert(BRE_OFF + 128 <= LDS_BYTES, "LDS misc");

__device__ __forceinline__ void phase_norm_route(Frame& F, const Args& A, int l, const void* xsrc) {
    const int gw = F.vcu * NWAVES + F.wave, NGW = F.G * NWAVES, lane = F.lane;
    LAS f32x4* Wre = (LAS f32x4*)(F.lds + RING_OFF);
    volatile LAS int* hist = (volatile LAS int*)(F.lds + HIST_OFF);
    const float* w_re = A.in[I_WRE] + (size_t)l * NGRP * D * EPG;
    const float* w_rg = A.in[I_WRG] + (size_t)l * D * NGRP;
    const float* b_rg = A.in[I_BRG] + l * NGRP;
    const float* b_re = A.in[I_BRE] + l * NGRP * EPG;
    const float* gf = A.in[I_FNG] + (size_t)l * D;
    for (int idx = F.tid; idx < NGRP * D; idx += NWAVES * 64) { const int g = idx >> 10, i = idx & 1023, li = (i & 255) >> 2, jj = 4 * (i >> 8) + (i & 3);
        const f32x4 a = *(const f32x4*)(w_re + (size_t)idx * 8), b = *(const f32x4*)(w_re + (size_t)idx * 8 + 4);
        Wre[((g * 2 + 0) * 16 + jj) * 64 + li] = a; Wre[((g * 2 + 1) * 16 + jj) * 64 + li] = b; }
    if (F.tid < 32) { hist[F.tid] = 0; ((LAS float*)(F.lds + BRE_OFF))[F.tid] = b_re[F.tid]; }
    { int* stok = (int*)(F.ws + WS_STOK); for (int i = F.vcu * (NWAVES * 64) + F.tid; i < SLOT_ROWS; i += F.G * NWAVES * 64) stok[i] = 0; }
    f32x4 wgr[16], gv[4];
#pragma unroll
    for (int j = 0; j < 4; ++j) { gv[j] = *(const f32x4*)(gf + 4 * lane + 256 * j);
#pragma unroll
        for (int c = 0; c < 4; ++c) wgr[4 * j + c] = *(const f32x4*)(w_rg + (size_t)(4 * lane + 256 * j + c) * 4); }
    f32x4 brg = *(const f32x4*)b_rg;
    __syncthreads();
    bf16* XN = (bf16*)(F.ws + WS_XN);
#if XBF16
    const bf16* X = (const bf16*)xsrc;
    typedef v2u xraw_t;
#define NR_LOAD(dst, row) do { const GAS v2u* xr_ = (const GAS v2u*)(X + (size_t)(row) * D) + lane; _Pragma("unroll") for (int j = 0; j < 4; ++j) dst[j] = xr_[64 * j]; } while (0)
#define NR_CVT(w_) ((f32x4){bflo((w_).x), bfhi((w_).x), bflo((w_).y), bfhi((w_).y)})
#else
    const float* X = (const float*)xsrc;
    typedef f32x4 xraw_t;
#define NR_LOAD(dst, row) do { const GAS f32x4* xr_ = (const GAS f32x4*)(X + (size_t)(row) * D) + lane; _Pragma("unroll") for (int j = 0; j < 4; ++j) dst[j] = xr_[64 * j]; } while (0)
#define NR_CVT(w_) (w_)
#endif
    int* tok_e = (int*)(F.ws + WS_TOKE); float* tok_w = (float*)(F.ws + WS_TOKW); int* tok_r = (int*)(F.ws + WS_TOKR);
    xraw_t vn[4], vn2[4];
    NR_LOAD(vn, gw); if (gw + NGW < T) NR_LOAD(vn2, gw + NGW);
    int pe1 = 0, pe2 = 0, pr1 = 0, pr2 = 0, pm = -1; float pw1 = 0.f, pw2 = 0.f;
    for (int m = gw; m < T; m += NGW) {
        f32x4 v[4]; float s = 0.f;
#pragma unroll
        for (int j = 0; j < 4; ++j) { v[j] = NR_CVT(vn[j]); vn[j] = vn2[j]; s += (v[j].x * v[j].x + v[j].y * v[j].y) + (v[j].z * v[j].z + v[j].w * v[j].w); }
        if (m + 2 * NGW < T) NR_LOAD(vn2, m + 2 * NGW);
        if (lane == 0 && pm >= 0) { tok_e[2 * pm] = pe1; tok_e[2 * pm + 1] = pe2; tok_w[2 * pm] = pw1; tok_w[2 * pm + 1] = pw2; tok_r[2 * pm] = pr1; tok_r[2 * pm + 1] = pr2; }
        const float rstd = 1.0f / sqrtf(wave_sum(s) * (1.f / D) + NORM_EPS);
        GAS v2u* o8 = (GAS v2u*)(XN + (size_t)m * D) + lane;
        f32x4 ga = (f32x4){0.f, 0.f, 0.f, 0.f};
#pragma unroll
        for (int j = 0; j < 4; ++j) { v[j] = v[j] * rstd * gv[j]; v2u w; w.x = pk2(v[j].x, v[j].y); w.y = pk2(v[j].z, v[j].w); o8[64 * j] = w;
            ga += wgr[4 * j + 0] * v[j].x; ga += wgr[4 * j + 1] * v[j].y; ga += wgr[4 * j + 2] * v[j].z; ga += wgr[4 * j + 3] * v[j].w; }
        float gl[4];
#pragma unroll
        for (int k = 0; k < 4; ++k) gl[k] = wave_sum(ga[k]) + brg[k];
        int gt = 0; float gm = gl[0];
#pragma unroll
        for (int k = 1; k < 4; ++k) if (gl[k] > gm) { gm = gl[k]; gt = k; }
        float gden = 0.f;
#pragma unroll
        for (int k = 0; k < 4; ++k) gden += expf(gl[k] - gm);
        const float p_top = 1.0f / gden;
        gt = __builtin_amdgcn_readfirstlane(gt);
        f32x4 a0 = (f32x4){0.f, 0.f, 0.f, 0.f}, a1 = a0;
        const LAS f32x4* w0 = Wre + ((gt * 2 + 0) * 16) * 64 + lane; const LAS f32x4* w1 = Wre + ((gt * 2 + 1) * 16) * 64 + lane;
        f32x4 wa[2][4], wb[2][4];
#pragma unroll
        for (int c = 0; c < 4; ++c) { wa[0][c] = w0[c * 64]; wb[0][c] = w1[c * 64]; }
#pragma unroll
        for (int j = 0; j < 4; ++j) {
            if (j < 3) {
#pragma unroll
                for (int c = 0; c < 4; ++c) { wa[(j + 1) & 1][c] = w0[(4 * (j + 1) + c) * 64]; wb[(j + 1) & 1][c] = w1[(4 * (j + 1) + c) * 64]; } }
            __builtin_amdgcn_sched_barrier(0);
            a0 += wa[j & 1][0] * v[j].x; a1 += wb[j & 1][0] * v[j].x;
            a0 += wa[j & 1][1] * v[j].y; a1 += wb[j & 1][1] * v[j].y;
            a0 += wa[j & 1][2] * v[j].z; a1 += wb[j & 1][2] * v[j].z;
            a0 += wa[j & 1][3] * v[j].w; a1 += wb[j & 1][3] * v[j].w;
            __builtin_amdgcn_sched_barrier(0); }
        const f32x4 bl0 = *(const LAS f32x4*)(F.lds + BRE_OFF + gt * 32), bl1 = *(const LAS f32x4*)(F.lds + BRE_OFF + gt * 32 + 16);
        float el[8];
#pragma unroll
        for (int k = 0; k < 4; ++k) { el[k] = wave_sum(a0[k]) + bl0[k]; el[4 + k] = wave_sum(a1[k]) + bl1[k]; }
        int i1 = 0; float m1 = el[0];
#pragma unroll
        for (int k = 1; k < 8; ++k) if (el[k] > m1) { m1 = el[k]; i1 = k; }
        int i2 = -1; float m2 = -3.0e38f;
#pragma unroll
        for (int k = 0; k < 8; ++k) if (k != i1 && el[k] > m2) { m2 = el[k]; i2 = k; }
        const float q1 = 1.0f, q2 = expf(m2 - m1);
        const float wn1 = p_top * q1 / (q1 + q2), wn2 = p_top * q2 / (q1 + q2);
        if (lane == 0) {
            pe1 = gt * 8 + i1; pe2 = gt * 8 + i2; pw1 = wn1; pw2 = wn2; pm = m;
            pr1 = __hip_atomic_fetch_add((LAS int*)hist + pe1, 1, __ATOMIC_RELAXED, __HIP_MEMORY_SCOPE_WORKGROUP);
            pr2 = __hip_atomic_fetch_add((LAS int*)hist + pe2, 1, __ATOMIC_RELAXED, __HIP_MEMORY_SCOPE_WORKGROUP);
        }
    }
    if (lane == 0 && pm >= 0) { tok_e[2 * pm] = pe1; tok_e[2 * pm + 1] = pe2; tok_w[2 * pm] = pw1; tok_w[2 * pm + 1] = pw2; tok_r[2 * pm] = pr1; tok_r[2 * pm + 1] = pr2; }
    __syncthreads();
    if (F.tid < 32) ((int*)(F.ws + WS_WGCNT))[blockIdx.x * 32 + F.tid] = hist[F.tid];
#undef NR_LOAD
#undef NR_CVT
}
#if ROUTE4
constexpr int WGR_OFF = (BRE_OFF + 128 + 255) & ~255, GNW_OFF = WGR_OFF + 16384;
static_assert(GNW_OFF + 4096 <= LDS_BYTES, "LDS route4");
__device__ __forceinline__ float row_sum16(float v) {
#if defined(__HIP_DEVICE_COMPILE__)
#define RS_ROR(n) v += __builtin_bit_cast(float, __builtin_amdgcn_update_dpp(0, __builtin_bit_cast(int, v), 0x120 + (n), 0xf, 0xf, false))
    RS_ROR(8); RS_ROR(4); RS_ROR(2); RS_ROR(1);
#undef RS_ROR
#endif
    return v;
}
__device__ __forceinline__ void phase_norm_route4(Frame& F, const Args& A, int l, const void* xsrc) {
    const int gw = F.vcu * NWAVES + F.wave, NGW = F.G * NWAVES, lane = F.lane, r = lane >> 4, c = lane & 15;
    LAS f32x4* WE = (LAS f32x4*)(F.lds + RING_OFF); LAS f32x4* WG = (LAS f32x4*)(F.lds + WGR_OFF); LAS f32x4* GL = (LAS f32x4*)(F.lds + GNW_OFF);
    volatile LAS int* hist = (volatile LAS int*)(F.lds + HIST_OFF);
    const float* w_re = A.in[I_WRE] + (size_t)l * NGRP * D * EPG;
    const float* w_rg = A.in[I_WRG] + (size_t)l * D * NGRP;
    const float* b_rg = A.in[I_BRG] + l * NGRP;
    const float* b_re = A.in[I_BRE] + l * NGRP * EPG;
    const float* gf = A.in[I_FNG] + (size_t)l * D;
    static_assert(XBF16 == 1, "route4 reads the bf16 residual stream");
    const bf16* X = (const bf16*)xsrc;
    constexpr int NTG = T / 4;
    v2u xn[16];
    if (gw < NTG) { const GAS v2u* xr = (const GAS v2u*)(X + (size_t)(4 * gw + r) * D) + c;
#pragma unroll
        for (int k = 0; k < 16; ++k) xn[k] = xr[16 * k]; }
    {
        f32x4 ta[8], tb[8], tg2[2], tgl = (f32x4){0.f, 0.f, 0.f, 0.f};
#pragma unroll
        for (int u = 0; u < 8; ++u) { const int idx = F.tid + u * (NWAVES * 64); ta[u] = *(const GAS f32x4*)(w_re + (size_t)idx * 8); tb[u] = *(const GAS f32x4*)(w_re + (size_t)idx * 8 + 4); }
#pragma unroll
        for (int u = 0; u < 2; ++u) tg2[u] = *(const GAS f32x4*)(w_rg + (size_t)(F.tid + u * (NWAVES * 64)) * 4);
        if (F.tid < 256) tgl = *(const GAS f32x4*)(gf + 64 * (F.tid >> 4) + 4 * (F.tid & 15));
        __builtin_amdgcn_sched_barrier(0);
#pragma unroll
        for (int u = 0; u < 8; ++u) { const int idx = F.tid + u * (NWAVES * 64), g = idx >> 10, e = idx & 1023, k = e >> 6, cc = (e >> 2) & 15, i = e & 3;
            WE[((g * 16 + k) * 8 + 2 * i) * 16 + cc] = ta[u]; WE[((g * 16 + k) * 8 + 2 * i + 1) * 16 + cc] = tb[u]; }
#pragma unroll
        for (int u = 0; u < 2; ++u) { const int e = F.tid + u * (NWAVES * 64), k = e >> 6, cc = (e >> 2) & 15, i = e & 3; WG[(k * 4 + i) * 16 + cc] = tg2[u]; }
        if (F.tid < 256) GL[F.tid] = tgl;
    }
    static_assert(NGRP * D == 8 * NWAVES * 64 && D == 2 * NWAVES * 64, "staging loops above");
    if (F.tid < 32) { hist[F.tid] = 0; ((LAS float*)(F.lds + BRE_OFF))[F.tid] = b_re[F.tid]; }
    { int* stok = (int*)(F.ws + WS_STOK); for (int i = F.vcu * (NWAVES * 64) + F.tid; i < SLOT_ROWS; i += F.G * NWAVES * 64) stok[i] = 0; }
    const f32x4 brg = *(const f32x4*)b_rg;
    __syncthreads();
    bf16* XN = (bf16*)(F.ws + WS_XN);
    int* tok_e = (int*)(F.ws + WS_TOKE); float* tok_w = (float*)(F.ws + WS_TOKW); int* tok_r = (int*)(F.ws + WS_TOKR);
    int pe1 = 0, pe2 = 0, pr1 = 0, pr2 = 0, pm = -1; float pw1 = 0.f, pw2 = 0.f, prs = 0.f; float* rsf = (float*)(F.ws + WS_RSF);
    for (int tg = gw; tg < NTG; tg += NGW) {
        const int m = 4 * tg + r;
        f32x4 v[16]; float s = 0.f;
#pragma unroll
        for (int k = 0; k < 16; ++k) { const v2u w = xn[k]; v[k] = (f32x4){bflo(w.x), bfhi(w.x), bflo(w.y), bfhi(w.y)}; s += (v[k].x * v[k].x + v[k].y * v[k].y) + (v[k].z * v[k].z + v[k].w * v[k].w); }
        if (tg + NGW < NTG) { const GAS v2u* xr = (const GAS v2u*)(X + (size_t)(4 * (tg + NGW) + r) * D) + c;
#pragma unroll
            for (int k = 0; k < 16; ++k) xn[k] = xr[16 * k]; }
        if (c == 0 && pm >= 0) { tok_e[2 * pm] = pe1; tok_e[2 * pm + 1] = pe2; tok_w[2 * pm] = pw1; tok_w[2 * pm + 1] = pw2; tok_r[2 * pm] = pr1; tok_r[2 * pm + 1] = pr2; if (NORMFOLD) rsf[pm] = prs; }
        const float rstd = 1.0f / sqrtf(row_sum16(s) * (1.f / D) + NORM_EPS);
        GAS v2u* o8 = (GAS v2u*)(XN + (size_t)m * D) + c;
        f32x4 ga = (f32x4){0.f, 0.f, 0.f, 0.f};
#pragma unroll
        for (int k = 0; k < 16; ++k) { const f32x4 gk = GL[k * 16 + c]; const f32x4 w0 = WG[(k * 4 + 0) * 16 + c], w1 = WG[(k * 4 + 1) * 16 + c], w2 = WG[(k * 4 + 2) * 16 + c], w3 = WG[(k * 4 + 3) * 16 + c];
            v[k] = v[k] * rstd * gk; if (!NORMFOLD) { v2u w; w.x = pk2(v[k].x, v[k].y); w.y = pk2(v[k].z, v[k].w); o8[16 * k] = w; }
            ga += w0 * v[k].x; ga += w1 * v[k].y; ga += w2 * v[k].z; ga += w3 * v[k].w; }
        float gl[4];
#pragma unroll
        for (int q = 0; q < 4; ++q) gl[q] = row_sum16(ga[q]) + brg[q];
        int gt = 0; float gm = gl[0];
#pragma unroll
        for (int q = 1; q < 4; ++q) if (gl[q] > gm) { gm = gl[q]; gt = q; }
        float gden = 0.f;
#pragma unroll
        for (int q = 0; q < 4; ++q) gden += expf(gl[q] - gm);
        const float p_top = 1.0f / gden;
        f32x4 a0 = (f32x4){0.f, 0.f, 0.f, 0.f}, a1 = a0;
        const LAS f32x4* we = WE + (gt * 16) * 8 * 16 + c;
        f32x4 wb[2][8];
#pragma unroll
        for (int q = 0; q < 8; ++q) wb[0][q] = we[q * 16];
#pragma unroll
        for (int k = 0; k < 16; ++k) {
            if (k < 15) {
#pragma unroll
                for (int q = 0; q < 8; ++q) wb[(k + 1) & 1][q] = we[((k + 1) * 8 + q) * 16]; }
            __builtin_amdgcn_sched_barrier(0);
            a0 += wb[k & 1][0] * v[k].x; a1 += wb[k & 1][1] * v[k].x;
            a0 += wb[k & 1][2] * v[k].y; a1 += wb[k & 1][3] * v[k].y;
            a0 += wb[k & 1][4] * v[k].z; a1 += wb[k & 1][5] * v[k].z;
            a0 += wb[k & 1][6] * v[k].w; a1 += wb[k & 1][7] * v[k].w;
            __builtin_amdgcn_sched_barrier(0); }
        const f32x4 bl0 = *(const LAS f32x4*)(F.lds + BRE_OFF + gt * 32), bl1 = *(const LAS f32x4*)(F.lds + BRE_OFF + gt * 32 + 16);
        float el[8];
#pragma unroll
        for (int q = 0; q < 4; ++q) { el[q] = row_sum16(a0[q]) + bl0[q]; el[4 + q] = row_sum16(a1[q]) + bl1[q]; }
        int i1 = 0; float m1 = el[0];
#pragma unroll
        for (int q = 1; q < 8; ++q) if (el[q] > m1) { m1 = el[q]; i1 = q; }
        int i2 = -1; float m2 = -3.0e38f;
#pragma unroll
        for (int q = 0; q < 8; ++q) if (q != i1 && el[q] > m2) { m2 = el[q]; i2 = q; }
        const float q1 = 1.0f, q2 = expf(m2 - m1);
        const float wn1 = p_top * q1 / (q1 + q2), wn2 = p_top * q2 / (q1 + q2);
        if (c == 0) {
            pe1 = gt * 8 + i1; pe2 = gt * 8 + i2; pw1 = wn1; pw2 = wn2; pm = m; prs = rstd;
            pr1 = __hip_atomic_fetch_add((LAS int*)hist + pe1, 1, __ATOMIC_RELAXED, __HIP_MEMORY_SCOPE_WORKGROUP);
            pr2 = __hip_atomic_fetch_add((LAS int*)hist + pe2, 1, __ATOMIC_RELAXED, __HIP_MEMORY_SCOPE_WORKGROUP);
        }
    }
    if (c == 0 && pm >= 0) { tok_e[2 * pm] = pe1; tok_e[2 * pm + 1] = pe2; tok_w[2 * pm] = pw1; tok_w[2 * pm + 1] = pw2; tok_r[2 * pm] = pr1; tok_r[2 * pm + 1] = pr2; if (NORMFOLD) rsf[pm] = prs; }
    __syncthreads();
    if (F.tid < 32) ((int*)(F.ws + WS_WGCNT))[blockIdx.x * 32 + F.tid] = hist[F.tid];
}
#endif
__device__ __forceinline__ void phase_dispatch(Frame& F) {
    const int gw = F.vcu * NWAVES + F.wave, NGW = F.G * NWAVES, lane = F.lane;
    volatile LAS int* sbase = (volatile LAS int*)(F.lds + SBASE_OFF); volatile LAS int* stot = (volatile LAS int*)(F.lds + STOT_OFF);
    const int* wgcnt = (const int*)(F.ws + WS_WGCNT); int* meta = (int*)(F.ws + WS_META);
    {
        volatile LAS int* part = (volatile LAS int*)(F.lds + RING_OFF);
        const int e = F.tid & 31, sl = F.tid >> 5; int tot = 0, base = 0;
        for (int w = sl; w < F.G; w += 16) { const int c = wgcnt[w * 32 + e]; tot += c; if (w < (int)blockIdx.x) base += c; }
        part[sl * 32 + e] = tot; part[512 + sl * 32 + e] = base;
        __syncthreads();
        if (F.tid < 32) { int t2 = 0, b2 = 0;
#pragma unroll
            for (int k = 0; k < 16; ++k) { t2 += part[k * 32 + F.tid]; b2 += part[512 + k * 32 + F.tid]; }
            stot[F.tid] = t2; sbase[F.tid] = b2; } }
    __syncthreads();
    if (F.tid == 0) { int run = 0, nrt = 0;
        for (int e = 0; e < NEXP; ++e) { const int nt = (stot[e] + 255) >> 8; sbase[e] = sbase[e] + run;
            if (blockIdx.x == 0) for (int k = 0; k < nt; ++k) meta[1 + nrt + k] = e;
            nrt += nt; run += nt * 256; }
        if (blockIdx.x == 0) meta[0] = nrt; }
    __syncthreads();
    const int* tok_e = (const int*)(F.ws + WS_TOKE); const int* tok_r = (const int*)(F.ws + WS_TOKR); int* tok_p = (int*)(F.ws + WS_TOKP);
    int* stok = (int*)(F.ws + WS_STOK);
    if (F.tid < T / F.G) {
#if ROUTE4
        const int m = 4 * ((F.tid >> 5) * NGW + F.vcu * NWAVES + ((F.tid >> 2) & 7)) + (F.tid & 3);
#else
        const int m = (F.tid >> 3) * NGW + F.vcu * NWAVES + (F.tid & 7);
#endif
        const int e1 = VLD(tok_e + 2 * m), e2 = VLD(tok_e + 2 * m + 1);
        const int p1 = sbase[e1] + VLD(tok_r + 2 * m), p2 = sbase[e2] + VLD(tok_r + 2 * m + 1);
        tok_p[2 * m] = p1; tok_p[2 * m + 1] = p2; stok[p1] = m; stok[p2] = m;
        if (NORMFOLD) { const float rr = VLD((const float*)(F.ws + WS_RSF) + m); float* rss = (float*)(F.ws + WS_RSS); rss[p1] = rr; rss[p2] = rr; } }
    (void)gw; (void)lane;
}
__device__ __forceinline__ void phase_combine(Frame& F, const float* g, bool last, const void* xsrc, void* xdst) {
    const int gw = F.vcu * NWAVES + F.wave, NGW = F.G * NWAVES, lane = F.lane;
    const int* tok_p = (const int*)(F.ws + WS_TOKP); const float* tok_w = (const float*)(F.ws + WS_TOKW);
    const bf16* Y = (const bf16*)(F.ws + WS_XP); bf16* XN = (bf16*)(F.ws + WS_XN);
#if XBF16
    typedef v2u xraw_t; const bf16* X = (const bf16*)xsrc;
#define PC_CVT(w_) ((f32x4){bflo((w_).x), bfhi((w_).x), bflo((w_).y), bfhi((w_).y)})
#else
    typedef f32x4 xraw_t; const float* X = (const float*)xsrc;
#define PC_CVT(w_) (w_)
#endif
    f32x4 gv[4];
#pragma unroll
    for (int j = 0; j < 4; ++j) gv[j] = *(const f32x4*)(g + 4 * lane + 256 * j);
    float cw1, cw2, dw1 = 0.f, dw2 = 0.f; xraw_t xn_[4], xm_[4]; v2u ya_[4], yb_[4], yc_[4], yd_[4];
    { const int p1 = VLD(tok_p + 2 * gw), p2 = VLD(tok_p + 2 * gw + 1); cw1 = VLD(tok_w + 2 * gw); cw2 = VLD(tok_w + 2 * gw + 1);
      const GAS xraw_t* xr = (const GAS xraw_t*)(X + (size_t)gw * D) + lane; const GAS v2u* y1 = (const GAS v2u*)(Y + (size_t)p1 * D) + lane; const GAS v2u* y2 = (const GAS v2u*)(Y + (size_t)p2 * D) + lane;
#pragma unroll
      for (int j = 0; j < 4; ++j) { xn_[j] = xr[64 * j]; ya_[j] = y1[64 * j]; yb_[j] = y2[64 * j]; } }
    if (gw + NGW < T) { const int mn = gw + NGW; const int p1 = VLD(tok_p + 2 * mn), p2 = VLD(tok_p + 2 * mn + 1); dw1 = VLD(tok_w + 2 * mn); dw2 = VLD(tok_w + 2 * mn + 1);
      const GAS xraw_t* xr = (const GAS xraw_t*)(X + (size_t)mn * D) + lane; const GAS v2u* y1 = (const GAS v2u*)(Y + (size_t)p1 * D) + lane; const GAS v2u* y2 = (const GAS v2u*)(Y + (size_t)p2 * D) + lane;
#pragma unroll
      for (int j = 0; j < 4; ++j) { xm_[j] = xr[64 * j]; yc_[j] = y1[64 * j]; yd_[j] = y2[64 * j]; } }
    int tp1 = 0, tp2 = 0; float tw1 = 0.f, tw2 = 0.f;
    if (gw + 2 * NGW < T) { const int mn = gw + 2 * NGW; tp1 = VLD(tok_p + 2 * mn); tp2 = VLD(tok_p + 2 * mn + 1); tw1 = VLD(tok_w + 2 * mn); tw2 = VLD(tok_w + 2 * mn + 1); }
    float prsd = 0.f; f32x4 po[4]; v2u pox[4], pon[4]; int pm = -1;
#pragma unroll
    for (int j = 0; j < 4; ++j) { po[j] = (f32x4){0.f, 0.f, 0.f, 0.f}; pox[j] = (v2u){0u, 0u}; pon[j] = (v2u){0u, 0u}; }
#if XBF16
#define PC_FLUSH() do { if (pm >= 0) { if (last) { GAS f32x4* xr_ = (GAS f32x4*)(F.out + (size_t)pm * D) + lane; _Pragma("unroll") for (int j = 0; j < 4; ++j) xr_[64 * j] = po[j]; } \
        else { GAS v2u* o8_ = (GAS v2u*)(XN + (size_t)pm * D) + lane; GAS v2u* xo_ = (GAS v2u*)((bf16*)xdst + (size_t)pm * D) + lane; _Pragma("unroll") for (int j = 0; j < 4; ++j) { xo_[64 * j] = pox[j]; if (!NORMFOLD) o8_[64 * j] = pon[j]; } \
            if (NORMFOLD && lane == 0) ((float*)(F.ws + WS_RSA))[pm] = prsd; } } } while (0)
#else
#define PC_FLUSH() do { if (pm >= 0) { if (last) { GAS f32x4* xr_ = (GAS f32x4*)(F.out + (size_t)pm * D) + lane; _Pragma("unroll") for (int j = 0; j < 4; ++j) xr_[64 * j] = po[j]; } \
        else { GAS v2u* o8_ = (GAS v2u*)(XN + (size_t)pm * D) + lane; GAS f32x4* xo_ = (GAS f32x4*)((float*)xdst + (size_t)pm * D) + lane; _Pragma("unroll") for (int j = 0; j < 4; ++j) { xo_[64 * j] = po[j]; o8_[64 * j] = pon[j]; } } } } while (0)
#endif
    for (int m = gw; m < T; m += NGW) {
        const float w1 = cw1, w2 = cw2;
        f32x4 v[4]; float s = 0.f;
#pragma unroll
        for (int j = 0; j < 4; ++j) { const v2u a = ya_[j], b = yb_[j];
            const f32x4 ya = (f32x4){bflo(a.x), bfhi(a.x), bflo(a.y), bfhi(a.y)}, yb = (f32x4){bflo(b.x), bfhi(b.x), bflo(b.y), bfhi(b.y)};
            v[j] = PC_CVT(xn_[j]) + (ya * w1 + yb * w2);
            s += (v[j].x * v[j].x + v[j].y * v[j].y) + (v[j].z * v[j].z + v[j].w * v[j].w);
            xn_[j] = xm_[j]; ya_[j] = yc_[j]; yb_[j] = yd_[j]; }
        cw1 = dw1; cw2 = dw2; dw1 = tw1; dw2 = tw2;
        if (m + 2 * NGW < T) { const int mn = m + 2 * NGW;
            const GAS xraw_t* xq = (const GAS xraw_t*)(X + (size_t)mn * D) + lane; const GAS v2u* y1 = (const GAS v2u*)(Y + (size_t)tp1 * D) + lane; const GAS v2u* y2 = (const GAS v2u*)(Y + (size_t)tp2 * D) + lane;
#pragma unroll
            for (int j = 0; j < 4; ++j) { xm_[j] = xq[64 * j]; yc_[j] = y1[64 * j]; yd_[j] = y2[64 * j]; } }
        if (m + 3 * NGW < T) { const int mn = m + 3 * NGW; tp1 = VLD(tok_p + 2 * mn); tp2 = VLD(tok_p + 2 * mn + 1); tw1 = VLD(tok_w + 2 * mn); tw2 = VLD(tok_w + 2 * mn + 1); }
        PC_FLUSH();
        const float rstd = 1.0f / sqrtf(wave_sum(s) * (1.f / D) + NORM_EPS);
        pm = m;
        if (last) {
#pragma unroll
            for (int j = 0; j < 4; ++j) po[j] = v[j] * rstd * gv[j];
        } else {
            if (NORMFOLD) prsd = rstd;
#pragma unroll
            for (int j = 0; j < 4; ++j) { const f32x4 y = v[j] * rstd * gv[j]; pon[j].x = pk2(y.x, y.y); pon[j].y = pk2(y.z, y.w);
#if XBF16
                pox[j].x = pk2(v[j].x, v[j].y); pox[j].y = pk2(v[j].z, v[j].w);
#else
                po[j] = v[j];
#endif
            }
        }
    }
    PC_FLUSH();
#undef PC_FLUSH
#undef PC_CVT
}

#if defined(__HIP_DEVICE_COMPILE__)
typedef float f32x4v __attribute__((ext_vector_type(4)));
typedef short v4i16_t __attribute__((ext_vector_type(4)));
__device__ __forceinline__ f32x4 mfma16(const bf16x8& a, const bf16x8& b, const f32x4& c) { return __builtin_amdgcn_mfma_f32_16x16x32_bf16(a, b, c, 0, 0, 0); }
__device__ __forceinline__ s16x4 tr_read(const LAS unsigned char* p) { return __builtin_bit_cast(s16x4, __builtin_amdgcn_ds_read_tr16_b64_v4i16((LAS v4i16_t*)p)); }
__device__ __forceinline__ bf16x8 join8(const s16x4& a, const s16x4& b) { bf16x8 r; r[0] = a[0]; r[1] = a[1]; r[2] = a[2]; r[3] = a[3]; r[4] = b[0]; r[5] = b[1]; r[6] = b[2]; r[7] = b[3]; return r; }
__device__ __forceinline__ bf16x8 pack_frag(const float (&v)[8]) { v4u w; w.x = cvt_pk_bf16(v[0], v[1]); w.y = cvt_pk_bf16(v[2], v[3]); w.z = cvt_pk_bf16(v[4], v[5]); w.w = cvt_pk_bf16(v[6], v[7]); return __builtin_bit_cast(bf16x8, w); }
template <int N> __device__ __forceinline__ float dpp_shr_t(float v) { return __builtin_bit_cast(float, __builtin_amdgcn_update_dpp(0, __builtin_bit_cast(int, v), 0x110 + N, 0xf, 0xf, true)); }
template <int N> __device__ __forceinline__ float dpp_ror_t(float v) { return __builtin_bit_cast(float, __builtin_amdgcn_update_dpp(0, __builtin_bit_cast(int, v), 0x120 + N, 0xf, 0xf, false)); }
__device__ __forceinline__ float rowsum16(float v) { v += dpp_ror_t<8>(v); v += dpp_ror_t<4>(v); v += dpp_ror_t<2>(v); v += dpp_ror_t<1>(v); return v; }
__device__ __forceinline__ float scan16(float v) { v += dpp_shr_t<1>(v); v += dpp_shr_t<2>(v); v += dpp_shr_t<4>(v); v += dpp_shr_t<8>(v); return v; }

constexpr int AT_PITCH = 160;
constexpr int AT_KOFF = 0, AT_VOFF = 384 * AT_PITCH;
__device__ __forceinline__ void attn_stage_load(Frame& F, int unit, v4u (&st)[12]) {
    const int b = unit >> 8, kvh = (unit >> 7) & 1, Q0 = (unit & 127) * 128; const bf16* PA = (const bf16*)(F.ws + WS_PA);
#pragma unroll
    for (int k = 0; k < 12; ++k) { const int idx = F.tid + 512 * k, kv = idx / (384 * 8), r = (idx >> 3) % 384, ch = idx & 7, key = Q0 - 128 + r;
        st[k] = (v4u){0u, 0u, 0u, 0u};
        if (key >= 0 && key < SEQ) st[k] = *(const GAS v4u*)(PA + (size_t)(b * SEQ + key) * NPA + (kv ? C_VA : C_KA) + 64 * kvh + 8 * ch); }
}
__device__ __forceinline__ void attn_stage_write(Frame& F, const v4u (&st)[12]) {
    LAS unsigned char* lds = F.lds + RING_OFF;
#pragma unroll
    for (int k = 0; k < 12; ++k) { const int idx = F.tid + 512 * k, kv = idx / (384 * 8), r = (idx >> 3) % 384, ch = idx & 7;
        *(LAS v4u*)(lds + (kv ? AT_VOFF : AT_KOFF) + r * AT_PITCH + ch * 16) = st[k]; }
}
__device__ __forceinline__ void attn_unit(Frame& F, int unit, int next_unit, v4u (&st)[12], const float* sink) {
    const int b = unit >> 8, kvh = (unit >> 7) & 1, qb = unit & 127, Q0 = qb * 128;
    const bf16* PA = (const bf16*)(F.ws + WS_PA); bf16* YA = (bf16*)(F.ws + WS_Y);
    LAS unsigned char* lds = F.lds + RING_OFF;
    attn_stage_write(F, st);
    __syncthreads();
    const int lane = F.lane, w = F.wave, fr = lane & 15, g = lane >> 4, qh = 4 * kvh + (w >> 1);
    const float sk = sink[qh] * LOG2E;
    const bool edge = (qb == 0) || (qb == SEQ / 128 - 1);
    static_assert(WINDOW == 128, "interior-tile test below");
    bf16x8 qn0, qn1;
    { const bf16* qp = PA + (size_t)(b * SEQ + Q0 + 64 * (w & 1) + fr) * NPA + C_QA + 64 * qh + 8 * g; qn0 = *(const GAS bf16x8*)qp; qn1 = *(const GAS bf16x8*)(qp + 32); }
    if (next_unit >= 0) attn_stage_load(F, next_unit, st);
    v2u py[4]; bf16* pyp = YA;
#pragma unroll
    for (int dt = 0; dt < 4; ++dt) py[dt] = (v2u){0u, 0u};
    for (int qbk = 0; qbk < 4; ++qbk) {
        const int qrel = 64 * (w & 1) + 16 * qbk, q = Q0 + qrel + fr;
        const bf16x8 qf0 = qn0, qf1 = qn1;
        f32x4 s[17]; float mx = sk;
#pragma unroll
        for (int t = 0; t < 17; ++t) { const int krel = qrel + 16 * t;
            const LAS unsigned char* kp = lds + AT_KOFF + (krel + fr) * AT_PITCH + g * 16;
            f32x4 a = (f32x4){0.f, 0.f, 0.f, 0.f};
            a = mfma16(*(const LAS bf16x8*)kp, qf0, a); a = mfma16(*(const LAS bf16x8*)(kp + 64), qf1, a);
            s[t] = a; }
#define AT_MASK(t) do { _Pragma("unroll") for (int r = 0; r < 4; ++r) { const int key = Q0 - 128 + qrel + 16 * (t) + 4 * g + r; const int dlt = key - q; \
            const bool ok = (dlt >= -WINDOW) && (dlt <= WINDOW) && (key >= 0) && (key < SEQ); s[t][r] = ok ? s[t][r] : -3.0e38f; } } while (0)
        if (edge) {
#pragma unroll
            for (int t = 0; t < 17; ++t) AT_MASK(t);
        } else { AT_MASK(0); AT_MASK(16); }
#undef AT_MASK
#pragma unroll
        for (int t = 0; t < 17; ++t) mx = fmaxf(fmaxf(mx, fmaxf(s[t][0], s[t][1])), fmaxf(s[t][2], s[t][3]));
        __builtin_amdgcn_sched_barrier(0);
        if (qbk < 3) { const bf16* qp = PA + (size_t)(b * SEQ + q + 16) * NPA + C_QA + 64 * qh + 8 * g; qn0 = *(const GAS bf16x8*)qp; qn1 = *(const GAS bf16x8*)(qp + 32); }
        if (qbk > 0) {
#pragma unroll
            for (int dt = 0; dt < 4; ++dt) *(GAS v2u*)(pyp + 16 * dt) = py[dt]; }
        __builtin_amdgcn_sched_barrier(0);
        mx = fmaxf(mx, __shfl_xor(mx, 16)); mx = fmaxf(mx, __shfl_xor(mx, 32));
        float den = 0.f;
#pragma unroll
        for (int t = 0; t < 17; ++t)
#pragma unroll
            for (int r = 0; r < 4; ++r) { const float p = __builtin_amdgcn_exp2f(s[t][r] - mx); s[t][r] = p; den += p; }
        den += __shfl_xor(den, 16); den += __shfl_xor(den, 32); den += __builtin_amdgcn_exp2f(sk - mx);
        const float inv = 1.0f / den;
        f32x4 o[4];
#pragma unroll
        for (int dt = 0; dt < 4; ++dt) o[dt] = (f32x4){0.f, 0.f, 0.f, 0.f};
#pragma unroll
        for (int tp = 0; tp < 9; ++tp) { const int t0 = 2 * tp, t1 = (2 * tp + 1 < 17) ? 2 * tp + 1 : 2 * tp;
            float pv[8];
#pragma unroll
            for (int r = 0; r < 4; ++r) { pv[r] = s[t0][r]; pv[4 + r] = (2 * tp + 1 < 17) ? s[t1][r] : 0.f; }
            const bf16x8 pf = pack_frag(pv);
            const LAS unsigned char* v0 = lds + AT_VOFF + (qrel + 16 * t0 + 4 * g + (fr >> 2)) * AT_PITCH + (fr & 3) * 8;
            const LAS unsigned char* v1 = lds + AT_VOFF + (qrel + 16 * t1 + 4 * g + (fr >> 2)) * AT_PITCH + (fr & 3) * 8;
#pragma unroll
            for (int dt = 0; dt < 4; ++dt) o[dt] = mfma16(join8(tr_read(v0 + dt * 32), tr_read(v1 + dt * 32)), pf, o[dt]); }
        pyp = YA + (size_t)(b * SEQ + q) * 512 + 64 * qh + 4 * g;
#pragma unroll
        for (int dt = 0; dt < 4; ++dt) { py[dt].x = cvt_pk_bf16(o[dt][0] * inv, o[dt][1] * inv); py[dt].y = cvt_pk_bf16(o[dt][2] * inv, o[dt][3] * inv); }
    }
#pragma unroll
    for (int dt = 0; dt < 4; ++dt) *(GAS v2u*)(pyp + 16 * dt) = py[dt];
    __syncthreads();
}
constexpr int HG_PITCH = 288;
constexpr int HG_V = 0, HG_KF = 128 * HG_PITCH, HG_KB = 2 * 128 * HG_PITCH, HG_TOT = 3 * 128 * HG_PITCH;
static_assert(HG_TOT + (4 * 8 * 128 + 256) * 4 <= RING_BYTES, "hgrn LDS");
__device__ __forceinline__ void hg_load_scan8(const bf16* p8  , float (&lf)[8], float (&P)[8], float (&T)[8], int lane) {
    const h16x8 hv = *(const GAS h16x8*)p8;
#pragma unroll
    for (int jj = 0; jj < 8; ++jj) { lf[jj] = (float)hv[jj]; P[jj] = scan16(lf[jj]); T[jj] = __shfl(P[jj], (lane & 48) | 15); }
}
__device__ __forceinline__ void hg_v_load(Frame& F, int b, int h, int t0, v4u (&vst)[4]) { const bf16* PA = (const bf16*)(F.ws + WS_PA);
#pragma unroll
    for (int k = 0; k < 4; ++k) { const int idx = F.tid + 512 * k, r = idx >> 4, ch = idx & 15; vst[k] = *(const GAS v4u*)(PA + (size_t)(b * SEQ + t0 + r) * NPA + C_VH + 128 * h + 8 * ch); } }
__device__ __forceinline__ void hg_v_write(Frame& F, const v4u (&vst)[4]) { LAS unsigned char* lds = F.lds + RING_OFF;
#pragma unroll
    for (int k = 0; k < 4; ++k) { const int idx = F.tid + 512 * k, r = idx >> 4, ch = idx & 15; *(LAS v4u*)(lds + HG_V + r * HG_PITCH + ch * 16) = vst[k]; } }
__device__ __forceinline__ void ha_decay_load(Frame& F, int unit, h16x8 (&hvv)[8]) {
    const int bh = unit >> 7, n = unit & 127, b = bh >> 2, h = bh & 3, t0 = n * CH, lane = F.lane, w = F.wave, fr = lane & 15, g = lane >> 4, dir = w >> 2, dq = w & 3;
    const bf16* lp = (const bf16*)(F.ws + WS_PA) + (size_t)(b * SEQ + t0 + fr) * NPA + (dir ? C_LB : C_LF) + 128 * h + 32 * dq + 8 * g;
#pragma unroll
    for (int k = 0; k < 8; ++k) { const int j = dir ? k : (7 - k); hvv[k] = *(const GAS h16x8*)(lp + (size_t)(16 * j) * NPA); }
}
__device__ __forceinline__ void ha_unit(Frame& F, int unit, int next_unit, v4u (&vst)[4], h16x8 (&hvv)[8]) {
    const int bh = unit >> 7, n = unit & 127, b = bh >> 2, h = bh & 3, t0 = n * CH;
    const bf16* PA = (const bf16*)(F.ws + WS_PA); bf16* US = (bf16*)(F.ws + WS_US); float* HD = (float*)(F.ws + WS_HD);
    LAS unsigned char* lds = F.lds + RING_OFF;
    const int lane = F.lane, w = F.wave, fr = lane & 15, g = lane >> 4, dir = w >> 2, dq = w & 3;
    hg_v_write(F, vst);
    if (next_unit >= 0) { const int bh2 = next_unit >> 7; hg_v_load(F, bh2 >> 2, bh2 & 3, (next_unit & 127) * CH, vst); }
    float run[8];
#pragma unroll
    for (int jj = 0; jj < 8; ++jj) run[jj] = 0.f;
    __builtin_amdgcn_sched_barrier(0);
#pragma unroll
    for (int k = 0; k < 8; ++k) { const int j = dir ? k : (7 - k);
        float kv[8];
#pragma unroll
        for (int jj = 0; jj < 8; ++jj) { const float lf = (float)hvv[k][jj], P = scan16(lf), Tt = __shfl(P, (lane & 48) | 15);
            const float wi = dir ? (P - lf) : (Tt - P); kv[jj] = (1.0f - __builtin_amdgcn_exp2f(lf)) * __builtin_amdgcn_exp2f(wi + run[jj]); run[jj] += Tt; }
        *(LAS bf16x8*)(lds + (dir ? HG_KB : HG_KF) + (16 * j + fr) * HG_PITCH + (32 * dq + 8 * g) * 2) = pack_frag(kv); }
    __builtin_amdgcn_sched_barrier(0);
    if (next_unit >= 0) ha_decay_load(F, next_unit, hvv);
    __builtin_amdgcn_sched_barrier(0);
    if (fr == 0) {
#pragma unroll
        for (int jj = 0; jj < 8; ++jj) HD[((size_t)(bh * 2 + dir) * NCH + n) * 128 + 32 * dq + 8 * g + jj] = __builtin_amdgcn_exp2f(run[jj]); }
    __syncthreads();
    f32x4 acc[2][8];
#pragma unroll
    for (int mt = 0; mt < 2; ++mt)
#pragma unroll
        for (int nt = 0; nt < 8; ++nt) acc[mt][nt] = (f32x4){0.f, 0.f, 0.f, 0.f};
    const LAS unsigned char* kb = lds + (dir ? HG_KB : HG_KF) + (4 * g + (fr >> 2)) * HG_PITCH + (fr & 3) * 8;
    const LAS unsigned char* vb = lds + HG_V + (4 * g + (fr >> 2)) * HG_PITCH + (fr & 3) * 8;
#pragma unroll
    for (int ks = 0; ks < 4; ++ks) { bf16x8 af[2];
#pragma unroll
        for (int mt = 0; mt < 2; ++mt) { const LAS unsigned char* p = kb + (32 * ks) * HG_PITCH + (16 * (2 * dq + mt)) * 2; af[mt] = join8(tr_read(p), tr_read(p + 16 * HG_PITCH)); }
#pragma unroll
        for (int nt = 0; nt < 8; ++nt) { const LAS unsigned char* p = vb + (32 * ks) * HG_PITCH + (16 * nt) * 2; const bf16x8 bfr = join8(tr_read(p), tr_read(p + 16 * HG_PITCH));
#pragma unroll
            for (int mt = 0; mt < 2; ++mt) acc[mt][nt] = mfma16(af[mt], bfr, acc[mt][nt]); } }
    bf16* up = US + ((size_t)(bh * 2 + dir) * NCH + n) * 128 * 128;
#pragma unroll
    for (int mt = 0; mt < 2; ++mt)
#pragma unroll
        for (int nt = 0; nt < 8; ++nt) { v2u wv; wv.x = cvt_pk_bf16(acc[mt][nt][0], acc[mt][nt][1]); wv.y = cvt_pk_bf16(acc[mt][nt][2], acc[mt][nt][3]);
            *(GAS v2u*)(up + (size_t)(16 * nt + fr) * 128 + 16 * (2 * dq + mt) + 4 * g) = wv; }
    __syncthreads();
}
#if G1A_SPLIT
__device__ __forceinline__ void phase_hb(Frame& F, int v, int g) {
    bf16* US = (bf16*)(F.ws + WS_US); const float* HD = (const float*)(F.ws + WS_HD);
    const int stride = g * NWAVES * 64, TOT = 16 * 128 * 64;
    for (int ea = v * (NWAVES * 64) + F.tid; ea < TOT; ea += 2 * stride) {
        const bool two = G1A_SPLIT && (ea + stride < TOT); const int eb = two ? ea + stride : ea;
        const int dpa = ea & 63, ca = ea >> 13, dira = ca & 1, dpb = eb & 63, cb = eb >> 13, dirb = cb & 1;
        float a0 = 0.f, a1 = 0.f, b0 = 0.f, b1 = 0.f;
        GAS unsigned* upa = (GAS unsigned*)(US + (size_t)ca * NCH * 128 * 128 + (size_t)((ea >> 6) & 127) * 128) + dpa; const GAS pg8::f32x2_t* dda = (const GAS pg8::f32x2_t*)((const GAS float*)HD + (size_t)ca * NCH * 128) + dpa;
        GAS unsigned* upb = (GAS unsigned*)(US + (size_t)cb * NCH * 128 * 128 + (size_t)((eb >> 6) & 127) * 128) + dpb; const GAS pg8::f32x2_t* ddb = (const GAS pg8::f32x2_t*)((const GAS float*)HD + (size_t)cb * NCH * 128) + dpb;
        for (int k0 = 0; k0 < NCH; k0 += 16) {
            unsigned ua[16], ub[16]; pg8::f32x2_t da[16], db[16];
#pragma unroll
            for (int k = 0; k < 16; ++k) { const int na = dira ? (NCH - 1 - (k0 + k)) : (k0 + k), nb = dirb ? (NCH - 1 - (k0 + k)) : (k0 + k);
                ua[k] = upa[(size_t)na * (128 * 128 / 2)]; da[k] = dda[na * 64]; ub[k] = upb[(size_t)nb * (128 * 128 / 2)]; db[k] = ddb[nb * 64]; }
#pragma unroll
            for (int k = 0; k < 16; ++k) { const int na = dira ? (NCH - 1 - (k0 + k)) : (k0 + k), nb = dirb ? (NCH - 1 - (k0 + k)) : (k0 + k);
                upa[(size_t)na * (128 * 128 / 2)] = pk2(a0, a1);
                a0 = da[k].x * a0 + bflo(ua[k]); a1 = da[k].y * a1 + bfhi(ua[k]);
                if (two) upb[(size_t)nb * (128 * 128 / 2)] = pk2(b0, b1);
                b0 = db[k].x * b0 + bflo(ub[k]); b1 = db[k].y * b1 + bfhi(ub[k]); } }
    }
}
#else
__device__ __forceinline__ void phase_hb(Frame& F, int v, int g) {
    bf16* US = (bf16*)(F.ws + WS_US); const float* HD = (const float*)(F.ws + WS_HD);
    const int idx = v * (NWAVES * 64) + F.tid;
    for (int e0 = idx; e0 < 16 * 128 * 64; e0 += g * NWAVES * 64) { const int dp = e0 & 63, e = (e0 >> 6) & 127, combo = e0 >> 13, dir = combo & 1;
        float s0 = 0.f, s1 = 0.f;
        GAS unsigned* up = (GAS unsigned*)(US + (size_t)combo * NCH * 128 * 128 + (size_t)e * 128) + dp; const GAS float* dpp = (const GAS float*)HD + (size_t)combo * NCH * 128 + 2 * dp;
        for (int k0 = 0; k0 < NCH; k0 += 16) {
            unsigned u[16]; float d0[16], d1[16];
#pragma unroll
            for (int k = 0; k < 16; ++k) { const int n = dir ? (NCH - 1 - (k0 + k)) : (k0 + k); u[k] = up[(size_t)n * (128 * 128 / 2)]; d0[k] = dpp[n * 128]; d1[k] = dpp[n * 128 + 1]; }
#pragma unroll
            for (int k = 0; k < 16; ++k) { const int n = dir ? (NCH - 1 - (k0 + k)) : (k0 + k);
                up[(size_t)n * (128 * 128 / 2)] = pk2(s0, s1);
                s0 = d0[k] * s0 + bflo(u[k]); s1 = d1[k] * s1 + bfhi(u[k]); } }
    }
}
#endif
constexpr int HC_SPITCH = 272;
constexpr int HC_K = 128 * HG_PITCH, HC_S = 2 * 128 * HG_PITCH, HC_E = HC_S + 128 * HC_SPITCH;
static_assert(HC_E + 2 * 8 * 128 * 4 <= RING_BYTES, "hc LDS");
#ifndef HC_TERMS
#define HC_TERMS 7
#endif
__device__ __forceinline__ void hc_unit(Frame& F, int unit, int next_unit, v4u (&vst)[4], const float* hng) {
    const int h = unit & 3, n = (unit >> 2) & 127, b = unit >> 9, bh = b * 4 + h, t0 = n * CH;
    const bf16* PA = (const bf16*)(F.ws + WS_PA); const bf16* US = (const bf16*)(F.ws + WS_US); bf16* YH = (bf16*)(F.ws + WS_YH); float* ssq = (float*)(F.ws + WS_SSQ);
    LAS unsigned char* lds = F.lds + RING_OFF; LAS float* ebl = (LAS float*)(lds + HC_E);
    const int lane = F.lane, i = F.wave, fr = lane & 15, g = lane >> 4;
    const size_t trow = (size_t)(b * SEQ + t0 + 16 * i + fr);
    hg_v_write(F, vst);
    if (next_unit >= 0) hg_v_load(F, next_unit >> 9, next_unit & 3, ((next_unit >> 2) & 127) * CH, vst);
    const bf16* sbase0 = US + ((size_t)(bh * 2) * NCH + n) * 128 * 128;
    v4u sreg[4];
#pragma unroll
    for (int k = 0; k < 4; ++k) { const int c = F.tid + 512 * k; sreg[k] = *(const GAS v4u*)(sbase0 + (size_t)(c >> 4) * 128 + (c & 15) * 8); }
    h16x8 lfv[2][4]; v4u qwv[4];
#pragma unroll
    for (int ks = 0; ks < 4; ++ks) { lfv[0][ks] = *(const GAS h16x8*)(PA + trow * NPA + C_LF + 128 * h + 32 * ks + 8 * g); qwv[ks] = *(const GAS v4u*)(PA + trow * NPA + C_QH + 128 * h + 32 * ks + 8 * g); }
#pragma unroll
    for (int ks = 0; ks < 4; ++ks) lfv[1][ks] = *(const GAS h16x8*)(PA + trow * NPA + C_LB + 128 * h + 32 * ks + 8 * g);
    __builtin_amdgcn_sched_barrier(0);
    f32x4 o[8];
#pragma unroll
    for (int et = 0; et < 8; ++et) o[et] = (f32x4){0.f, 0.f, 0.f, 0.f};
    const LAS unsigned char* vtr = lds + HG_V + (4 * g + (fr >> 2)) * HG_PITCH + (fr & 3) * 8;
#pragma unroll
    for (int dir = 0; dir < 2; ++dir) {
        if (dir == 1) __syncthreads();
#pragma unroll
        for (int k = 0; k < 4; ++k) { const int c = F.tid + 512 * k; *(LAS v4u*)(lds + HC_S + (c >> 4) * HC_SPITCH + (c & 15) * 16) = sreg[k]; }
        float ql[32]; bf16x8 kst[4]; bf16x8 qf[4];
#pragma unroll
        for (int ks = 0; ks < 4; ++ks) { float lf[8], P[8], T[8], ke[8], kd[8], t8[8], et_[8];
            { const h16x8 hv = lfv[dir][ks];
#pragma unroll
              for (int jj = 0; jj < 8; ++jj) { lf[jj] = (float)hv[jj]; P[jj] = scan16(lf[jj]); T[jj] = __shfl(P[jj], (lane & 48) | 15); } }
            const v4u qw = qwv[ks];
            const float qv[8] = {bflo(qw.x), bfhi(qw.x), bflo(qw.y), bfhi(qw.y), bflo(qw.z), bfhi(qw.z), bflo(qw.w), bfhi(qw.w)};
#pragma unroll
            for (int jj = 0; jj < 8; ++jj) { const float kk = 1.0f - __builtin_amdgcn_exp2f(lf[jj]);
                const float binc = dir ? (T[jj] - P[jj] + lf[jj]) : P[jj];
                const float ea = __builtin_amdgcn_exp2f(binc), ra = __builtin_amdgcn_rcpf(ea); et_[jj] = __builtin_amdgcn_exp2f(T[jj]);
                ql[8 * ks + jj] = qv[jj] * ea; t8[jj] = ql[8 * ks + jj]; ke[jj] = kk * et_[jj] * ra; kd[jj] = kk * ra;
#if defined(HC_DBG) && HC_DBG >= 3
                ql[8 * ks + jj] = qv[jj]; t8[jj] = qv[jj]; kd[jj] = kk;
                if (HC_DBG == 4) kd[jj] = (32 * ks + 8 * g + jj == 0) ? 1.0f : 0.f;
                if (HC_DBG == 5) kd[jj] = (32 * ks + 8 * g + jj == 0) ? kk : 0.f;
                if (HC_DBG >= 9) kd[jj] = 0.f;
                if (HC_DBG == 8) kd[jj] = (32 * ks + 8 * g + jj == 0) ? (float)fr : 0.f;
                if (HC_DBG == 6) kd[jj] = (32 * ks + 8 * g + jj == 0) ? lf[jj] : 0.f;
                if (HC_DBG == 7) kd[jj] = (32 * ks + 8 * g + jj == 0) ? (1.0f - __expf(lf[jj])) : 0.f;
#endif
                }
            *(LAS bf16x8*)(lds + HC_K + (16 * i + fr) * HG_PITCH + (32 * ks + 8 * g) * 2) = pack_frag(ke);
            kst[ks] = pack_frag(kd); qf[ks] = pack_frag(t8);
            if (fr == 0) {
#pragma unroll
                for (int jj = 0; jj < 8; ++jj) ebl[(dir * 8 + i) * 128 + 32 * ks + 8 * g + jj] = et_[jj]; }
            __builtin_amdgcn_sched_barrier(0); }
        __syncthreads();
        if (dir == 0) {
#pragma unroll
            for (int k = 0; k < 4; ++k) { const int c = F.tid + 512 * k; sreg[k] = *(const GAS v4u*)(sbase0 + (size_t)NCH * 128 * 128 + (size_t)(c >> 4) * 128 + (c & 15) * 8); } }
        f32x4 at = (f32x4){0.f, 0.f, 0.f, 0.f};
#pragma unroll
        for (int ks = 0; ks < 4; ++ks) at = mfma16(kst[ks], qf[ks], at);
#if defined(HC_DBG) && HC_DBG >= 9
        { const float q0 = __shfl(ql[0], fr);
          for (int r = 0; r < 4; ++r) at[r] = (HC_DBG == 9) ? (float)(4 * g + r) * q0 : ((HC_DBG == 10) ? (float)(4 * g + r) : (float)fr); }
#endif
        float pend[4]; int jpend = i;
#pragma unroll
        for (int r = 0; r < 4; ++r) { const int s = 4 * g + r; const bool keep = (HC_TERMS & 1) && (dir ? (s >= fr) : (s <= fr)); pend[r] = keep ? at[r] : 0.f;
#if defined(HC_DBG) && HC_DBG == 1
            pend[r] = (dir == 0 && s == fr) ? 1.0f : 0.f;
#endif
            }
        bool have = true;
        const int nj = dir ? (7 - i) : i;
        for (int k = 0; k < nj; ++k) { const int j = dir ? (i + 1 + k) : (i - 1 - k);
            f32x4 a2 = (f32x4){0.f, 0.f, 0.f, 0.f};
            const LAS unsigned char* kp = lds + HC_K + (16 * j + fr) * HG_PITCH + g * 16;
#pragma unroll
            for (int ks = 0; ks < 4; ++ks) a2 = mfma16(*(const LAS bf16x8*)(kp + ks * 64), qf[ks], a2);
#pragma unroll
            for (int ks = 0; ks < 4; ++ks) { const LAS float* ep = ebl + (dir * 8 + j) * 128 + 32 * ks + 8 * g; float t8[8];
#pragma unroll
                for (int jj = 0; jj < 8; ++jj) { ql[8 * ks + jj] *= ep[jj]; t8[jj] = ql[8 * ks + jj]; }
                qf[ks] = pack_frag(t8); }
            if (have) { float pv[8];
#pragma unroll
                for (int r = 0; r < 4; ++r) { pv[r] = pend[r]; pv[4 + r] = (HC_TERMS & 2) ? a2[r] : 0.f; }
                const bf16x8 pf = pack_frag(pv); const LAS unsigned char* v0 = vtr + 16 * jpend * HG_PITCH; const LAS unsigned char* v1 = vtr + 16 * j * HG_PITCH;
#pragma unroll
                for (int et = 0; et < 8; ++et) o[et] = mfma16(join8(tr_read(v0 + et * 32), tr_read(v1 + et * 32)), pf, o[et]);
                have = false;
            } else {
#pragma unroll
                for (int r = 0; r < 4; ++r) pend[r] = (HC_TERMS & 2) ? a2[r] : 0.f;
                jpend = j; have = true; }
        }
        if (have) { float pv[8];
#pragma unroll
            for (int r = 0; r < 4; ++r) { pv[r] = pend[r]; pv[4 + r] = 0.f; }
            const bf16x8 pf = pack_frag(pv); const LAS unsigned char* v0 = vtr + 16 * jpend * HG_PITCH;
#pragma unroll
            for (int et = 0; et < 8; ++et) o[et] = mfma16(join8(tr_read(v0 + et * 32), tr_read(v0 + et * 32)), pf, o[et]); }
        const LAS unsigned char* sp = lds + HC_S + fr * HC_SPITCH + g * 16;
#pragma unroll
        for (int et = 0; et < 8; ++et)
#pragma unroll
            for (int ks = 0; ks < 4; ++ks) if (HC_TERMS & 4) o[et] = mfma16(*(const LAS bf16x8*)(sp + 16 * et * HC_SPITCH + ks * 64), qf[ks], o[et]);
    }
    float sq = 0.f; bf16* yp = YH + trow * 512 + 128 * h + 4 * g; const bf16* sgp = PA + trow * NPA + C_SG + 128 * h + 4 * g; const float* gp = hng + 128 * h + 4 * g;
    v2u swv[8]; f32x4 gvv[8];
#pragma unroll
    for (int et = 0; et < 8; ++et) { swv[et] = *(const GAS v2u*)(sgp + 16 * et); gvv[et] = *(const GAS f32x4*)(gp + 16 * et); }
#pragma unroll
    for (int et = 0; et < 8; ++et) { const v2u sw = swv[et]; const f32x4 gv = gvv[et]; const f32x4 ov = o[et];
        sq += (ov[0] * ov[0] + ov[1] * ov[1]) + (ov[2] * ov[2] + ov[3] * ov[3]);
        v2u wv; wv.x = cvt_pk_bf16(ov[0] * gv[0] * bflo(sw.x), ov[1] * gv[1] * bfhi(sw.x)); wv.y = cvt_pk_bf16(ov[2] * gv[2] * bflo(sw.y), ov[3] * gv[3] * bfhi(sw.y));
        *(GAS v2u*)(yp + 16 * et) = wv; }
    sq += __shfl_xor(sq, 16); sq += __shfl_xor(sq, 32);
    if (g == 0) ssq[trow * 4 + h] = sq;
    __syncthreads();
}
__device__ __forceinline__ int attn_item_unit(int i) { return (i < 256) ? i : 256 + ((i + 64) & 255); }
__device__ __forceinline__ void phase_attn(Frame& F, const float* sink) { constexpr int NU = BATCH * NKVH * (SEQ / 128); v4u st[12];
    static_assert(NU == 512, "attn_item_unit");
    if (F.vcu < NU) attn_stage_load(F, attn_item_unit(F.vcu), st);
    for (int i = F.vcu; i < NU; i += F.G) attn_unit(F, attn_item_unit(i), (i + F.G < NU) ? attn_item_unit(i + F.G) : -1, st, sink); }
__device__ __forceinline__ void phase_ha(Frame& F) { constexpr int NU = BATCH * HH * NCH; v4u vst[4]; h16x8 hvv[8];
    if (F.vcu < NU) { const int bh = F.vcu >> 7; hg_v_load(F, bh >> 2, bh & 3, (F.vcu & 127) * CH, vst); ha_decay_load(F, F.vcu, hvv); }
    for (int u = F.vcu; u < NU; u += F.G) ha_unit(F, u, (u + F.G < NU) ? u + F.G : -1, vst, hvv); }
__device__ __forceinline__ void phase_hc(Frame& F, const float* hng) {
    constexpr int NU = BATCH * NCH * HH; v4u vst[4];
    if (F.vcu < NU) hg_v_load(F, F.vcu >> 9, F.vcu & 3, ((F.vcu >> 2) & 127) * CH, vst);
    for (int u = F.vcu; u < NU; u += F.G) hc_unit(F, u, (u + F.G < NU) ? u + F.G : -1, vst, hng);
}

#else
__device__ void phase_attn(Frame& F, const float* sink);
__device__ void phase_ha(Frame& F);
__device__ void phase_hb(Frame& F, int v, int g);
__device__ void phase_hc(Frame& F, const float* hng);
#endif


#if defined(ORACLE)
__global__ void __launch_bounds__(256) simple_attn(const bf16* PA, const float* sink, bf16* YA) {
    const int lane = threadIdx.x & 63, task = blockIdx.x * 4 + (threadIdx.x >> 6);
    const int m = task >> 3, qh = task & 7, kvh = qh >> 2, b = m / SEQ, t = m % SEQ;
    float q[64];
    { const bf16* qp = PA + (size_t)m * NPA + C_QA + 64 * qh;
#pragma unroll
      for (int d = 0; d < 64; ++d) q[d] = bf2f(qp[d]); }
    float s[5]; float mx = sink[qh] * LOG2E;
#pragma unroll
    for (int r = 0; r < 5; ++r) { const int j = t - WINDOW + 64 * r + lane; const bool ok = (j >= 0) && (j < SEQ) && (j <= t + WINDOW);
        float a = -3.0e38f;
        if (ok) { const bf16* kp = PA + (size_t)(b * SEQ + j) * NPA + C_KA + 64 * kvh; a = 0.f;
#pragma unroll
            for (int d = 0; d < 64; ++d) a += q[d] * bf2f(kp[d]); }
        s[r] = a; mx = fmaxf(mx, a); }
#pragma unroll
    for (int o = 1; o < 64; o <<= 1) mx = fmaxf(mx, __shfl_xor(mx, o));
    float den = 0.f;
#pragma unroll
    for (int r = 0; r < 5; ++r) { s[r] = (s[r] > -1.0e38f) ? exp2f(s[r] - mx) : 0.f; den += s[r]; }
    den = wave_sum(den) + exp2f(sink[qh] * LOG2E - mx);
    float o = 0.f;
    for (int r = 0; r < 5; ++r) for (int jj = 0; jj < 64; ++jj) { const int j = t - WINDOW + 64 * r + jj; const float p = __shfl(s[r], jj);
        if (j >= 0 && j < SEQ && j <= t + WINDOW) o += p * bf2f(PA[(size_t)(b * SEQ + j) * NPA + C_VA + 64 * kvh + lane]); }
#if defined(ABL_NOATTN)
    YA[(size_t)m * 512 + 64 * qh + lane] = 0;
#else
    YA[(size_t)m * 512 + 64 * qh + lane] = (bf16)f2bf(o / den);
#endif
}
__global__ void __launch_bounds__(512) simple_hgrn(const bf16* PA, const float* hng, float* obuf, bf16* YH, float* ssq) {
    __shared__ float part[32][4][128];
    const int tid = threadIdx.x, e = tid & 127, dq = tid >> 7, b = blockIdx.x >> 2, h = blockIdx.x & 3;
    for (int dir = 0; dir < 2; ++dir) {
        float S[32];
#pragma unroll
        for (int d = 0; d < 32; ++d) S[d] = 0.f;
        for (int t0 = 0; t0 < SEQ; t0 += 32) {
            for (int tt = 0; tt < 32; ++tt) { const int t = dir ? (SEQ - 1 - (t0 + tt)) : (t0 + tt); const bf16* row = PA + (size_t)(b * SEQ + t) * NPA;
                const float v = bf2f(row[C_VH + 128 * h + e]); const _Float16* lf = (const _Float16*)(row + (dir ? C_LB : C_LF) + 128 * h + 32 * dq); const bf16* qp = row + C_QH + 128 * h + 32 * dq;
                float o = 0.f;
#pragma unroll
                for (int d = 0; d < 32; ++d) { const float l = (float)lf[d], f = expf(l), k = -expm1f(l); S[d] = f * S[d] + k * v; o += S[d] * bf2f(qp[d]); }
                part[tt][dq][e] = o; }
            __syncthreads();
            for (int idx = tid; idx < 32 * 128; idx += 512) { const int tt = idx >> 7, ee = idx & 127; const int t = dir ? (SEQ - 1 - (t0 + tt)) : (t0 + tt); const size_t m = (size_t)b * SEQ + t;
                float o = (part[tt][0][ee] + part[tt][1][ee]) + (part[tt][2][ee] + part[tt][3][ee]);
                if (dir == 0) obuf[m * 512 + 128 * h + ee] = o;
                else { o += obuf[m * 512 + 128 * h + ee];
                    const float sg = bf2f(PA[m * NPA + C_SG + 128 * h + ee]);
#if defined(ABL_NOHGRN)
                    YH[m * 512 + 128 * h + ee] = 0;
#else
                    YH[m * 512 + 128 * h + ee] = (bf16)f2bf(o * hng[128 * h + ee] * sg);
#endif

                    const float q = wave_sum(o * o);
                    if ((tid & 63) == 0) atomicAdd(&ssq[m * 4 + h], q); } }
            __syncthreads();
        }
    }
}
__global__ void zero_f32(float* p, int n) { const int i = blockIdx.x * blockDim.x + threadIdx.x; if (i < n) p[i] = 0.f; }
#endif

#if defined(CHECK)
#define CK_NS 48
__device__ __forceinline__ int ck_row(int s) { return (int)(((long)s * 10007 + 77) % T); }
__device__ __forceinline__ bool ck_cmp(float got, float ref, float rtol, float atol, unsigned* cnt) { const float d = fabsf(got - ref); if (!(d <= rtol * fabsf(ref) + atol)) { atomicAdd(cnt, 1u); return true; } return false; }
__global__ void ck_norm(const float* x, const float* g, const bf16* XN, unsigned* cnt) {
    const int m = ck_row(blockIdx.x); __shared__ float red[256];
    float s = 0.f; for (int c = threadIdx.x; c < D; c += 256) { const float v = x[(size_t)m * D + c]; s += v * v; }
    red[threadIdx.x] = s; __syncthreads(); for (int o = 128; o > 0; o >>= 1) { if (threadIdx.x < o) red[threadIdx.x] += red[threadIdx.x + o]; __syncthreads(); }
    const float rstd = 1.0f / sqrtf(red[0] / D + NORM_EPS);
    for (int c = threadIdx.x; c < D; c += 256) ck_cmp(bf2f(XN[(size_t)m * D + c]), x[(size_t)m * D + c] * rstd * g[c], 0.01f, 0.01f, cnt);
}
__global__ void ck_pa(const bf16* XN, const float* w_in, const float* lb_tab  , int l, const bf16* PA, unsigned* cnt) {
    const int m = ck_row(blockIdx.x), pos = m % SEQ; __shared__ float z[NPA]; __shared__ float xr[D];
    for (int c = threadIdx.x; c < D; c += 256) xr[c] = bf2f(XN[(size_t)m * D + c]);
    __syncthreads();
    for (int c = threadIdx.x; c < NPA; c += 256) { float a = 0.f; for (int k = 0; k < D; ++k) a += xr[k] * w_in[(size_t)k * INW + c]; z[c] = a; }
    __syncthreads();
    for (int c = threadIdx.x; c < NPA; c += 256) {
        const float got_b = bf2f(PA[(size_t)m * NPA + c]); const float got_h = (float)((const _Float16*)PA)[(size_t)m * NPA + c];
        if (c < C_VA) { const int d = c & 63, i = d & 31; const double inv = exp2(-(double)i * (13.287712379549449 / 32.0)); const float cs = (float)cos((double)pos * inv), sn = (float)sin((double)pos * inv);
            const float x1 = z[(c & ~63) + i], x2 = z[(c & ~63) + i + 32]; float r = (d < 32) ? (x1 * cs - x2 * sn) : (x2 * cs + x1 * sn); if (c < C_KA) r *= QSCALE;
            ck_cmp(got_b, r, 0.02f, 0.03f, cnt + 0);
        } else if (c < C_QH) ck_cmp(got_b, z[c], 0.02f, 0.02f, cnt + 1);
        else if (c < C_LF) ck_cmp(got_b, z[c] / (1.f + expf(-z[c])), 0.02f, 0.02f, cnt + 2);
        else if (c < C_VH) { const int dir = (c >= C_LB), col = c - (dir ? C_LB : C_LF);
            float t0 = lb_tab[(0 * 2 + dir) * 512 + col], t1 = lb_tab[(1 * 2 + dir) * 512 + col]; const float mx = fmaxf(t0, t1); t0 = expf(t0 - mx); t1 = expf(t1 - mx);
            const float lb = (l == 0) ? 0.f : t1 / (t0 + t1); const float sg = 1.f / (1.f + expf(-z[c])); const float r = fmaxf(logf(lb + (1.f - lb) * sg), LOGF_MIN);
            ck_cmp(got_h, r, 0.01f, 0.02f, cnt + 3);
        } else if (c < C_SG) ck_cmp(got_b, z[c], 0.02f, 0.02f, cnt + 4);
        else ck_cmp(got_b, z[c] / (1.f + expf(-z[c])), 0.02f, 0.02f, cnt + 5);
    }
}
__global__ void ck_mix(const bf16* XN, const float* w_in, const bf16* YA, const bf16* YH, const float* ssq, const float* wua, const float* wuh, const bf16* GT, const bf16* MG, int which, unsigned* cnt) {
#ifndef CK_SHIFT
#define CK_SHIFT 0
#endif
    const int m = ck_row((blockIdx.x + CK_SHIFT) % CK_NS); __shared__ float xr[D]; __shared__ float ya[512]; __shared__ float yh[512];
    for (int c = threadIdx.x; c < D; c += 256) xr[c] = bf2f(XN[(size_t)m * D + c]);
    for (int c = threadIdx.x; c < 512; c += 256) { ya[c] = bf2f(YA[(size_t)m * 512 + c]); yh[c] = bf2f(YH[(size_t)m * 512 + c]); }
    __syncthreads();
    const float rstd = 1.0f / sqrtf((ssq[m * 4] + ssq[m * 4 + 1] + ssq[m * 4 + 2] + ssq[m * 4 + 3]) / 512.f + NORM_EPS);
    for (int c = threadIdx.x; c < D; c += 256) { float a = 0.f, b = 0.f, p = 0.f, q = 0.f;
        for (int k = 0; k < D; ++k) { a += xr[k] * w_in[(size_t)k * INW + NPA + c]; b += xr[k] * w_in[(size_t)k * INW + NPA + 1024 + c]; }
        for (int k = 0; k < 512; ++k) { p += ya[k] * wua[(size_t)k * D + c]; q += yh[k] * wuh[(size_t)k * D + c]; }
        float ga = 1.f / (1.f + expf(-a)), gb = 1.f / (1.f + expf(-b));
        if (which != 0) { ga = bf2f(GT[(size_t)m * NGATE + c]); gb = bf2f(GT[(size_t)m * NGATE + 1024 + c]); }
        if (which == 0) { unsigned* dbg = cnt + 100; if (blockIdx.x == 27) { const float e0 = fabsf(bf2f(GT[(size_t)m * NGATE + c]) - ga), e1 = fabsf(bf2f(GT[(size_t)m * NGATE + 1024 + c]) - gb); atomicMax(dbg + 200, __float_as_uint(e0)); atomicMax(dbg + 200, __float_as_uint(e1)); atomicMax(dbg + 201, __float_as_uint(fabsf(a))); atomicMax(dbg + 201, __float_as_uint(fabsf(b))); if (GT[(size_t)m * NGATE + c] == 0xFFFFu) atomicAdd(dbg + 203, 1u); if (GT[(size_t)m * NGATE + 1024 + c] == 0xFFFFu) atomicAdd(dbg + 203, 1u); if (e0 > 0.2f) { atomicAdd(dbg + 202, 1u); atomicOr(dbg + 210 + (c >> 11), 0u); atomicAdd(dbg + 300 + (c >> 6), 1u); } if (e1 > 0.2f) { atomicAdd(dbg + 202, 1u); atomicAdd(dbg + 300 + 16 + (c >> 6), 1u); } } if (ck_cmp(bf2f(GT[(size_t)m * NGATE + c]), ga, 0.01f, 0.01f, cnt + 0)) { atomicAdd(dbg + blockIdx.x, 1u); atomicAdd(dbg + 64 + (c >> 5), 1u); } if (ck_cmp(bf2f(GT[(size_t)m * NGATE + 1024 + c]), gb, 0.01f, 0.01f, cnt + 0)) { atomicAdd(dbg + blockIdx.x, 1u); atomicAdd(dbg + 64 + 32 + (c >> 5), 1u); } }
        else if (which == 1) ck_cmp(bf2f(MG[(size_t)m * D + c]), ga * p, 0.03f, 0.01f, cnt + 1);
        else ck_cmp(bf2f(MG[(size_t)m * D + c]), ga * p + gb * rstd * q, 0.03f, 0.02f, cnt + 2); }
}
__global__ void ck_out(const float* xprev, const bf16* MG, const float* wout, const float* X, unsigned* cnt) {
    const int m = ck_row(blockIdx.x); __shared__ float mg[D];
    for (int c = threadIdx.x; c < D; c += 256) mg[c] = bf2f(MG[(size_t)m * D + c]);
    __syncthreads();
    for (int c = threadIdx.x; c < D; c += 256) { float a = 0.f; for (int k = 0; k < D; ++k) a += mg[k] * wout[(size_t)k * D + c]; ck_cmp(X[(size_t)m * D + c], xprev[(size_t)m * D + c] + a, 0.01f, 0.02f, cnt); }
}
__global__ void ck_moe(const float* X, const float* g, const float* wrg, const float* brg, const float* wre, const float* bre, const float* weg, const float* weu, const float* wed,
                       const bf16* XN, const int* tok_e, const float* tok_w, const int* tok_p, const int* meta, const bf16* XP, const bf16* ACT, const bf16* Y, int stage, unsigned* cnt) {
    const int m = ck_row(blockIdx.x); __shared__ float h[D]; __shared__ float red[256]; __shared__ float lg[36]; __shared__ float act[DEXP];
    float s = 0.f; for (int c = threadIdx.x; c < D; c += 256) { const float v = X[(size_t)m * D + c]; s += v * v; }
    red[threadIdx.x] = s; __syncthreads(); for (int o = 128; o > 0; o >>= 1) { if (threadIdx.x < o) red[threadIdx.x] += red[threadIdx.x + o]; __syncthreads(); }
    const float rstd = 1.0f / sqrtf(red[0] / D + NORM_EPS);
    for (int c = threadIdx.x; c < D; c += 256) h[c] = X[(size_t)m * D + c] * rstd * g[c];
    __syncthreads();
    if (threadIdx.x < 36) { const int t = threadIdx.x; float a = 0.f;
        if (t < 4) { for (int k = 0; k < D; ++k) a += h[k] * wrg[k * 4 + t]; a += brg[t]; } else { const int gg = (t - 4) >> 3, e = (t - 4) & 7; for (int k = 0; k < D; ++k) a += h[k] * wre[((size_t)gg * D + k) * 8 + e]; a += bre[gg * 8 + e]; }
        lg[t] = a; }
    __syncthreads();
    int gt = 0; for (int k = 1; k < 4; ++k) if (lg[k] > lg[gt]) gt = k;
    float gden = 0.f; for (int k = 0; k < 4; ++k) gden += expf(lg[k] - lg[gt]);
    const float* el = lg + 4 + gt * 8; int i1 = 0; for (int k = 1; k < 8; ++k) if (el[k] > el[i1]) i1 = k; int i2 = (i1 == 0) ? 1 : 0; for (int k = 0; k < 8; ++k) if (k != i1 && el[k] > el[i2]) i2 = k;
    const float q2 = expf(el[i2] - el[i1]); const float w1 = (1.f / gden) / (1.f + q2), w2 = (1.f / gden) * q2 / (1.f + q2);
    const int e1 = gt * 8 + i1, e2 = gt * 8 + i2;
    if (stage == 0) { if (threadIdx.x == 0) { if (tok_e[2 * m] != e1 || tok_e[2 * m + 1] != e2) atomicAdd(cnt + 0, 1u); ck_cmp(tok_w[2 * m], w1, 0.01f, 1e-3f, cnt + 1); ck_cmp(tok_w[2 * m + 1], w2, 0.01f, 1e-3f, cnt + 1); } return; }
    for (int kk = 0; kk < 2; ++kk) { const int e = tok_e[2 * m + kk], p = tok_p[2 * m + kk];
        if (stage == 1) { if (threadIdx.x == 0) { const int rt = p >> 8; if (rt >= meta[0] || meta[1 + rt] != e) atomicAdd(cnt + 2, 1u); }
            for (int c = threadIdx.x; c < D; c += 256) if (XP[(size_t)p * D + c] != XN[(size_t)m * D + c]) atomicAdd(cnt + 3, 1u); continue; }
        const float* wg = weg + (size_t)e * D * DEXP; const float* wu = weu + (size_t)e * D * DEXP; const float* wd = wed + (size_t)e * DEXP * D;
        __syncthreads();
        for (int j = threadIdx.x; j < DEXP; j += 256) { float a = 0.f, b = 0.f; for (int k = 0; k < D; ++k) { const float hv = bf2f(XN[(size_t)m * D + k]); a += hv * wg[(size_t)k * DEXP + j]; b += hv * wu[(size_t)k * DEXP + j]; }
            const float r = a / (1.f + expf(-a)) * b; act[j] = r; if (stage == 2) ck_cmp(bf2f(ACT[(size_t)p * DEXP + j]), r, 0.03f, 0.02f, cnt + 4); }
        __syncthreads();
        if (stage == 3) for (int c = threadIdx.x; c < D; c += 256) { float a = 0.f; for (int j = 0; j < DEXP; ++j) a += act[j] * wd[(size_t)j * D + c]; ck_cmp(bf2f(Y[(size_t)p * D + c]), a, 0.03f, 0.03f, cnt + 5); }
    }
}

__global__ void ck_attn(const bf16* PA, const float* sink, const bf16* YA, unsigned* cnt) {
    const int m = ck_row(blockIdx.x), b = m / SEQ, t = m % SEQ; __shared__ float sc[512]; __shared__ float red[256];
    for (int qh = 0; qh < NQH; ++qh) { const int kvh = qh / 4;
        const bf16* qp = PA + (size_t)m * NPA + C_QA + 64 * qh;
        for (int jj = threadIdx.x; jj < 2 * WINDOW + 1; jj += 256) { const int j = t - WINDOW + jj; float a = -1e30f;
            if (j >= 0 && j < SEQ) { a = 0.f; const bf16* kp = PA + (size_t)(b * SEQ + j) * NPA + C_KA + 64 * kvh; for (int d = 0; d < 64; ++d) a += bf2f(qp[d]) * bf2f(kp[d]); a *= 0.6931471805599453f; }
            sc[jj] = a; }
        __syncthreads();
        float mx = sink[qh]; for (int jj = 0; jj < 2 * WINDOW + 1; ++jj) mx = fmaxf(mx, sc[jj]);
        float den = expf(sink[qh] - mx); for (int jj = 0; jj < 2 * WINDOW + 1; ++jj) den += expf(sc[jj] - mx);
        if (threadIdx.x < 64) { const int d = threadIdx.x; float o = 0.f; for (int jj = 0; jj < 2 * WINDOW + 1; ++jj) { const int j = t - WINDOW + jj; if (j >= 0 && j < SEQ) o += expf(sc[jj] - mx) * bf2f(PA[(size_t)(b * SEQ + j) * NPA + C_VA + 64 * kvh + d]); }
            ck_cmp(bf2f(YA[(size_t)m * 512 + 64 * qh + d]), o / den, 0.03f, 0.005f, cnt); }
        __syncthreads(); }
}
__global__ void ck_hgrn(const bf16* PA, const float* hng, const bf16* YH, const float* ssq, unsigned* cnt) {
    const int m = ck_row(blockIdx.x), b = m / SEQ, t = m % SEQ, h = blockIdx.y; __shared__ float wgt[128]; __shared__ float osum[128]; __shared__ float cum[128];
    const int e = threadIdx.x;
    float o = 0.f;
    for (int dir = 0; dir < 2; ++dir) { cum[e] = 0.f; __syncthreads();
        for (int n = 0; n < 768; ++n) { const int s = dir ? t + n : t - n; if (s < 0 || s >= SEQ) break;
            const bf16* row = PA + (size_t)(b * SEQ + s) * NPA; const bf16* rowt = PA + (size_t)m * NPA;
            { const int d = e; const float lf = (float)((const _Float16*)(row + (dir ? C_LB : C_LF) + 128 * h))[d];
              wgt[d] = bf2f(rowt[C_QH + 128 * h + d]) * (-expm1f(lf)) * expf(cum[d]);
#if defined(HC_DBG) && HC_DBG >= 3
              wgt[d] = bf2f(rowt[C_QH + 128 * h + d]) * (-expm1f(lf));
              if (HC_DBG == 4) wgt[d] = (d == 0) ? bf2f(rowt[C_QH + 128 * h]) : 0.f;
              if (HC_DBG == 5 || HC_DBG == 7) wgt[d] = (d == 0) ? wgt[d] : 0.f;
              if (HC_DBG == 10) wgt[d] = (d == 0) ? (float)(s & 15) : 0.f;
              if (HC_DBG == 11) wgt[d] = (d == 0) ? (float)(t & 15) : 0.f;
              if (HC_DBG == 8 || HC_DBG == 9) wgt[d] = (d == 0) ? bf2f(rowt[C_QH + 128 * h]) * (float)(s & 15) : 0.f;
              if (HC_DBG == 6) wgt[d] = (d == 0) ? bf2f(rowt[C_QH + 128 * h]) * lf : 0.f;
#endif
            }
            __syncthreads();
            float w = 0.f; for (int d = 0; d < 128; ++d) w += wgt[d];
#if defined(HC_TERMS)
            { const int cls = ((s >> 4) == (t >> 4)) ? 1 : (((s >> 7) == (t >> 7)) ? 2 : 4); if (!(HC_TERMS & cls)) w = 0.f; }
#endif
            o += w * bf2f(row[C_VH + 128 * h + e]);
            __syncthreads();
            { const int d = e; cum[d] += (float)((const _Float16*)(row + (dir ? C_LB : C_LF) + 128 * h))[d]; }
            __syncthreads(); } }
#if defined(HC_DBG) && HC_DBG == 1
    o = bf2f(PA[(size_t)m * NPA + C_VH + 128 * h + e]);
#endif
    osum[e] = o * o; __syncthreads(); for (int k = 64; k > 0; k >>= 1) { if (e < k) osum[e] += osum[e + k]; __syncthreads(); }
    if (e == 0) ck_cmp(ssq[m * 4 + h], osum[0], 0.03f, 1e-3f, cnt + 1);
    const float sg = bf2f(PA[(size_t)m * NPA + C_SG + 128 * h + e]);
    ck_cmp(bf2f(YH[(size_t)m * 512 + 128 * h + e]), o * hng[128 * h + e] * sg, 0.03f, 0.01f, cnt + 0);
}
__global__ void ck_comb(const float* xold, const float* xnew, const int* tok_p, const float* tok_w, const bf16* Y, const float* gfin, int last, unsigned* cnt) {
    const int m = ck_row(blockIdx.x); __shared__ float red[256]; __shared__ float xv[D];
    if (m >= SEQ) return;
    const int p1 = tok_p[2 * m], p2 = tok_p[2 * m + 1]; const float w1 = tok_w[2 * m], w2 = tok_w[2 * m + 1]; float s = 0.f;
    for (int c = threadIdx.x; c < D; c += 256) { const float v = xold[(size_t)m * D + c] + w1 * bf2f(Y[(size_t)p1 * D + c]) + w2 * bf2f(Y[(size_t)p2 * D + c]); xv[c] = v; s += v * v; }
    red[threadIdx.x] = s; __syncthreads(); for (int o = 128; o > 0; o >>= 1) { if (threadIdx.x < o) red[threadIdx.x] += red[threadIdx.x + o]; __syncthreads(); }
    const float rstd = 1.0f / sqrtf(red[0] / D + NORM_EPS);
    for (int c = threadIdx.x; c < D; c += 256) ck_cmp(xnew[(size_t)m * D + c], last ? xv[c] * rstd * gfin[c] : xv[c], 0.005f, 0.005f, cnt);
}

__global__ void ck_gates_full(const bf16* XN, const float* w_in, const bf16* GT, unsigned* st) {
    const int m = blockIdx.x >> 3, pn = blockIdx.x & 7, c = pn * 256 + threadIdx.x; __shared__ float xr[D];
    for (int k = threadIdx.x; k < D; k += 256) xr[k] = bf2f(XN[(size_t)m * D + k]);
    __syncthreads();
    float a = 0.f; for (int k = 0; k < D; ++k) a += xr[k] * w_in[(size_t)k * INW + NPA + c];
#if defined(CK_PLAIN)
    const float ref = a, got = bf2f(GT[(size_t)m * NGATE + c]);
#else
    const float ref = 1.f / (1.f + expf(-a)), got = bf2f(GT[(size_t)m * NGATE + c]);
#endif
    if (m == 8122 && !(fabsf(got - ref) <= 0.05f)) atomicMin(st + 700, (unsigned)c);
    if (m == 8123 && !(fabsf(got - ref) <= 0.05f)) atomicMin(st + 701, (unsigned)c);
    if (m == 8122) { if (c == 130) st[702] = __float_as_uint(got), st[703] = __float_as_uint(ref), st[704] = __float_as_uint(a); if (c == 131) st[705] = __float_as_uint(got), st[706] = __float_as_uint(ref); }
    if (!(fabsf(got - ref) <= 0.05f)) { atomicAdd(st + (m >> 8), 1u); atomicAdd(st + 128 + (m & 255), 1u); atomicAdd(st + 384 + threadIdx.x, 1u); atomicAdd(st + 640 + pn, 1u); }
}
__global__ void ck_flush() { asm volatile("buffer_wbl2 sc0 sc1\n\ts_waitcnt vmcnt(0)\n\tbuffer_inv sc0 sc1\n\ts_waitcnt vmcnt(0)" ::: "memory"); }

__global__ void ck_ha(const bf16* PA, const bf16* US, const float* HD, unsigned* cnt) {
    const int sidx = blockIdx.x, bh = sidx % 8, dir = (sidx >> 3) & 1, n = (sidx * 37 + 5) % NCH, b = bh >> 2, h = bh & 3, d = threadIdx.x, t0 = n * CH;
    __shared__ float kts[CH][128]; float cum = 0.f;
    for (int k = CH - 1; k >= 0; --k) { const int tok = dir ? (t0 + CH - 1 - k) : (t0 + k);
        const float lf = (float)((const _Float16*)(PA + (size_t)(b * SEQ + tok) * NPA + (dir ? C_LB : C_LF) + 128 * h))[d];
        kts[k][d] = -expm1f(lf) * expf(cum); cum += lf; }
    ck_cmp(HD[((size_t)(bh * 2 + dir) * NCH + n) * 128 + d], expf(cum), 0.01f, 1e-6f, cnt + 1);
    for (int e = 0; e < 128; e += 5) { float u = 0.f;
        for (int k = 0; k < CH; ++k) { const int tok = dir ? (t0 + CH - 1 - k) : (t0 + k); u += kts[k][d] * bf2f(PA[(size_t)(b * SEQ + tok) * NPA + C_VH + 128 * h + e]); }
        ck_cmp(bf2f(US[(((size_t)(bh * 2 + dir) * NCH + n) * 128 + e) * 128 + d]), u, 0.03f, 0.01f, cnt + 0); }
}
__global__ void ck_hb(const bf16* PA, const bf16* US, unsigned* cnt) {
    const int sidx = blockIdx.x, bh = sidx % 8, dir = (sidx >> 3) & 1, n = (sidx * 37 + 5) % NCH, b = bh >> 2, h = bh & 3, d = threadIdx.x, e = (sidx * 11 + 3) % 128;
    float cum = 0.f, sacc = 0.f;
    for (int k = 0; k < 1024; ++k) { const int tok = dir ? ((n + 1) * CH + k) : (n * CH - 1 - k); if (tok < 0 || tok >= SEQ) break;
        const bf16* row = PA + (size_t)(b * SEQ + tok) * NPA; const float lf = (float)((const _Float16*)(row + (dir ? C_LB : C_LF) + 128 * h))[d];
        sacc += -expm1f(lf) * expf(cum) * bf2f(row[C_VH + 128 * h + e]); cum += lf; }
    ck_cmp(bf2f(US[(((size_t)(bh * 2 + dir) * NCH + n) * 128 + e) * 128 + d]), sacc, 0.03f, 0.01f, cnt);
}

__global__ void ck_mfma(unsigned* cnt) {
#if defined(__HIP_DEVICE_COMPILE__)
    const int lane = threadIdx.x, fr = lane & 15, g = lane >> 4;
    float av[8], bv[8];
    for (int j = 0; j < 8; ++j) { const int k = 8 * g + j; av[j] = (k == 0) ? (float)fr : ((k == 9) ? (float)(fr * fr) : 0.f); bv[j] = (k == 0) ? (float)(fr + 1) : ((k == 9) ? 0.5f : 0.f); }
    f32x4 d = (f32x4){0.f, 0.f, 0.f, 0.f};
    d = mfma16(pack_frag(av), pack_frag(bv), d);
    for (int r = 0; r < 4; ++r) { const int s = 4 * g + r, c = fr; const float ref = (float)s * (float)(c + 1) + (float)(s * s) * 0.5f; if (fabsf(d[r] - ref) > 0.01f * fabsf(ref) + 0.01f) atomicAdd(cnt, 1u); }
#endif
}
#ifndef CK_SKIP
#define CK_SKIP 0ull
#endif
__global__ void ck_report(const unsigned* cnt, int n, float* out) { if (threadIdx.x == 0 && blockIdx.x == 0) {
#if defined(CK_DBG7)
    const unsigned* dbg = cnt + 7 + 100; int nrows = 0, ngrp = 0; unsigned mx = 0, first = 99; for (int i = 0; i < CK_NS; ++i) if (dbg[i]) { ++nrows; mx = dbg[i] > mx ? dbg[i] : mx; } for (int i = 0; i < 64; ++i) if (dbg[64 + i]) { ++ngrp; if (first == 99) first = i; }
    if (CK_DBG7 == 4) { const float me = __uint_as_float(dbg[200]), ma = __uint_as_float(dbg[201]); out[0] = (1.0f + fminf(me, 0.89f) * 10.0f) * powf(10.0f, 5.0f + floorf(fminf(ma, 30.0f))); return; }
    if (CK_DBG7 == 5) { int nl = 0; unsigned mxl = 0; for (int i = 0; i < 32; ++i) if (dbg[300 + i]) { ++nl; mxl = dbg[300 + i] > mxl ? dbg[300 + i] : mxl; } out[0] = (1.0f + 0.1f * (float)nl) * powf(10.0f, 5.0f + (float)(mxl > 30 ? 30 : mxl)); return; }
    if (CK_DBG7 == 7) { out[0] = (1.0f + 0.01f * (float)(dbg[203] % 100)) * powf(10.0f, 5.0f + (float)(dbg[203] / 100)); return; }
    if (CK_DBG7 >= 10) { const unsigned* st = cnt + 512; int npan = 0, nrit = 0, ncol = 0, ntile = 0; unsigned tot = 0, mxp = 0; int firstp = -1, firstr = -1, firstc = -1;
        for (int i = 0; i < 128; ++i) if (st[i]) { ++npan; tot += st[i]; if (st[i] > mxp) mxp = st[i]; if (firstp < 0) firstp = i; }
        for (int i = 0; i < 256; ++i) { if (st[128 + i]) { ++nrit; if (firstr < 0) firstr = i; } if (st[384 + i]) { ++ncol; if (firstc < 0) firstc = i; } }
        for (int i = 0; i < 8; ++i) if (st[640 + i]) ++ntile;
        float a = 0.f, b = 0.f;
        if (CK_DBG7 == 10) { a = (float)npan; b = log10f((float)(tot ? tot : 1)) * 4.0f; }
        if (CK_DBG7 == 11) { a = (float)nrit; b = (float)ncol / 10.0f; }
        if (CK_DBG7 == 12) { a = (float)firstp; b = (float)firstr / 10.0f; }
        if (CK_DBG7 == 13) { a = (float)firstc; b = (float)ntile; }
        if (CK_DBG7 == 22) { out[0] = (1.0f + 8.0f * __uint_as_float(st[702])) * powf(10.0f, 5.0f + floorf(20.0f * __uint_as_float(st[703]) + 0.5f)); return; }
        if (CK_DBG7 == 23) { out[0] = (1.0f + 8.0f * __uint_as_float(st[705])) * powf(10.0f, 5.0f + floorf(20.0f * __uint_as_float(st[706]) + 0.5f)); return; }
        if (CK_DBG7 == 20) { a = (float)(st[700] % 100); b = (float)(st[700] / 100); }
        if (CK_DBG7 == 21) { a = (float)(st[701] > 5000 ? 99 : st[701] % 100); b = (float)(st[701] > 5000 ? 30 : st[701] / 100); }
        out[0] = (1.0f + 0.01f * a) * powf(10.0f, 5.0f + floorf(b)); return; }
    if (CK_DBG7 == 6) { out[0] = (1.0f + 0.01f * (float)(dbg[202] % 100)) * powf(10.0f, 5.0f + (float)(dbg[202] / 100)); return; }
    if (CK_DBG7 == 3) { int s1 = -1, s2 = -1; for (int i = 0; i < CK_NS; ++i) if (dbg[i] > 20) { if (s1 < 0) s1 = i; else if (s2 < 0) s2 = i; } out[0] = (1.0f + 0.1f * (float)(s1 < 0 ? 0 : s1 % 50)) * powf(10.0f, (float)(5 + (s2 < 0 ? 0 : (s2 % 25)))); return; }
    if (CK_DBG7 == 1) out[0] = (1.0f + 0.1f * (float)first) * powf(10.0f, (float)(5 + nrows / 2));
    else out[0] = (1.0f + 0.1f * (float)ngrp) * powf(10.0f, (float)(5 + (int)floorf(4.0f * log10f((float)(mx ? mx : 1)))));
    return;
#endif
    for (int i = 0; i < n; ++i) if (cnt[i] && !((CK_SKIP >> i) & 1ull)) {
    out[0] = (1.0f + 0.1f * (float)(i % 10)) * powf(10.0f, (float)(5 + i / 10)); return; } } }
#endif

#ifndef PG8_SP2
#define PG8_SP2 true
#endif
#ifndef PG8_ALIGN
#define PG8_ALIGN true
#endif
__global__ void __launch_bounds__(NWAVES * 64, 2) mega_fwd(Args args) {
    extern __shared__ __attribute__((aligned(16))) unsigned char lds[];
    Frame F;
    F.lds = (LAS unsigned char*)lds;
    F.MISC = (volatile LAS unsigned*)(F.lds + MISC_OFF);
    F.tid = threadIdx.x; F.lane = F.tid & 63; F.wave = __builtin_amdgcn_readfirstlane(F.tid >> 6);
    F.G = gridDim.x; { const int bx = blockIdx.x; F.vcu = (F.G % 8 == 0) ? (bx % 8) * (F.G / 8) + bx / 8 : bx; }
    F.ws = args.ws; F.ctl = (gu32*)(args.ws + WS_CTL); F.out = args.out;
    const Args& A = args;
    for (int u = F.tid; u < (LDS_BYTES - LDSCTL_OFF) / 4; u += NWAVES * 64) ((LAS unsigned*)(F.lds + LDSCTL_OFF))[u] = 0u;
    __syncthreads();
    XcdBarrier bar = xcd_barrier_post((unsigned*)(F.ctl + CW_BAR) + args.li * XCD_BAR_WORDS, F.MISC + 8);
    const int lo = args.ph_lo, hi = args.ph_hi;
#ifndef PHMASK
#define PHMASK 0xffff
#endif
#define IN(k) (((PHMASK >> ((k) & 15)) & 1) && lo <= (k) && (k) < hi)
#if defined(PROBE_MASK)
    unsigned long long pr_acc = 0ull, pr_t0 = 0ull;
#define PR_BEGIN(k) do { if ((PROBE_MASK >> ((k) & 15)) & 1) pr_t0 = wall_clock64(); } while (0)
#define PR_END(k) do { if ((PROBE_MASK >> ((k) & 15)) & 1) pr_acc += wall_clock64() - pr_t0; } while (0)
#else
#define PR_BEGIN(k)
#define PR_END(k)
#endif
#define SEAM(k) do { if ((k) + 1 < hi) xcd_barrier(bar); PR_END(k); } while (0)
#define WSP() GAS unsigned char* wsg_ = (GAS unsigned char*)args.ws; asm volatile("" : "+s"(wsg_)); unsigned char* ws = (unsigned char*)wsg_; F.ws = ws; { int t_ = threadIdx.x; asm volatile("" : "+v"(t_)); F.tid = t_; F.lane = t_ & 63; F.wave = __builtin_amdgcn_readfirstlane(t_ >> 6); int g_ = gridDim.x, b_ = blockIdx.x; asm volatile("" : "+s"(g_), "+s"(b_)); F.G = g_; F.vcu = (g_ % 8 == 0) ? (b_ % 8) * (g_ / 8) + b_ / 8 : b_; cid = b_; } \
    bf16* XN = (bf16*)(ws + WS_XN); bf16* PA = (bf16*)(ws + WS_PA); bf16* GT = (bf16*)(ws + WS_PA); bf16* MG = (bf16*)(ws + WS_US); \
    bf16* YA = (bf16*)(ws + WS_Y); bf16* YH = (bf16*)(ws + WS_YH); (void)XN; (void)PA; (void)GT; (void)MG; (void)YA; (void)YH;
    int cid = (int)blockIdx.x;

#if !defined(ORACLE) || defined(ORACLE_FAST)
#if XBF16
#define XB_CUR(l) ((l) == 0 ? (NORMFOLD ? (void*)XN : (void*)A.in[I_X]) : (void*)F.out)
#define XB_NEW(l) ((l) == DEPTH - 1 ? (bf16*)(ws + WS_Y) : (bf16*)F.out)
#define XIN0(l) ((const void*)XB_CUR(l))
#define EPIOUT_T(l) EpiOutB<(l) == 0 && !NORMFOLD>
#else
#define XB_CUR(l) ((void*)F.out)
#define XB_NEW(l) (F.out)
#define XIN0(l) ((l) == 0 ? A.in[I_X] : (const float*)F.out)
#define EPIOUT_T(l) EpiOut
#endif
#if NORMFOLD
#define G1_A(l) ((l) == 0 ? XN : (const bf16*)F.out)
#define M1_A(l) ((const bf16*)XB_NEW(l))
#else
#define G1_A(l) XN
#define M1_A(l) XN
#endif
#define XCOPY0 nullptr
#else
#define XCOPY0 F.out
#define XIN0(l) ((const float*)F.out)
#endif
    if (IN(0)) { WSP(); PR_BEGIN(0);
        make_tables(F, A); conv_weights(F, A, 0);
#if NORM4 && !NORMFOLD
        norm_rows4(F, A.in[I_X], A.in[I_ANG], XN);
#else
        norm_rows(F, A.in[I_X], XCOPY0, A.in[I_ANG], XN, NORMFOLD ? (float*)(ws + WS_RSA) : nullptr);
#endif
        SEAM(0);
    }
#if G1A_SPLIT
#define PHASE3(l) if (IN(pb + 3)) { WSP(); PR_BEGIN(pb + 3);   \
            const int gh = G1A_SPLIT ? F.G / 2 : 0; \
            if (cid < gh) { pg8::Gemm g{XN, (const bf16*)(ws + WS_WIN) + (size_t)G1A_N * D, T, NPA - G1A_N, D}; pg8::StaticOrder S; S.init(T, NPA - G1A_N, gh, cid); \
                EpiInA E{PA, (const float*)(ws + WS_COS), (const float*)(ws + WS_SIN), (const float*)(ws + WS_LBT) + l * 2048, G1A_N / 256, (const float*)(ws + WS_RSA)}; \
                pg8::gemm_phase<EpiInA, pg8::StaticOrder, PG8_ALIGN, PG8_SP2>(F.lds + RING_OFF, g, S, E); } \
            else phase_hb(F, cid - gh, F.G - gh); \
            SEAM(pb + 3); }
#else
#define PHASE3(l) if (IN(pb + 3)) { WSP(); PR_BEGIN(pb + 3); phase_hb(F, F.vcu, F.G); SEAM(pb + 3); }
#endif
#if !defined(ORACLE) || defined(ORACLE_FAST)
#define G1A_N (NPA - 256 * G1A_SPLIT)
#define FAST_PHASES(l)         if (IN(pb + 2)) { WSP(); PR_BEGIN(pb + 2); PR_BEGIN(14); phase_attn(F, A.in[I_SINK] + (l) * NQH); PR_END(14); PR_BEGIN(15); phase_ha(F); PR_END(15); SEAM(pb + 2); } \
        PHASE3(l) \
        if (IN(pb + 4)) { WSP(); PR_BEGIN(pb + 4); phase_hc(F, A.in[I_HNG] + (l) * 512); SEAM(pb + 4); }
#else
#define G1A_N NPA
#define FAST_PHASES(l)
#endif
#if MOE_HANDOFF
#define MOE_ORDER1 pg8::ProducerOrder
#define MOE_ORDER2 pg8::ConsumerOrder
#define MOE_CNT(l) S.cnt = (unsigned*)(F.ctl + CW_MOE + (l) * MOE_BANK + 64);
#define MOE_SEAM(k) PR_END(k)
#else
#define MOE_ORDER1 pg8::GroupedOrder
#define MOE_ORDER2 pg8::GroupedOrder
#define MOE_CNT(l)
#define MOE_SEAM(k) SEAM(k)
#endif
#if ROUTE4
#define ROUTE_FN phase_norm_route4
#else
#define ROUTE_FN phase_norm_route
#endif
#if defined(PROBE_BARRIERS)
#define PROBE_BARRIERS_EXTRA for (int k_ = 0; k_ < PROBE_BARRIERS; ++k_) xcd_barrier(bar);
#else
#define PROBE_BARRIERS_EXTRA
#endif
#if defined(PROBE_KLOOP)
#define PROBE_KLOOP_EXTRA { EpiNull E2{GT}; pg8::gemm_phase<EpiNull, pg8::StaticOrder, PG8_ALIGN, PG8_SP2>(F.lds + RING_OFF, g, S, E2); }
#else
#define PROBE_KLOOP_EXTRA
#endif
#define LAYER_BODY(l) { const int pb = 16 * (l); \
        if (IN(pb + 1)) { WSP(); PR_BEGIN(pb + 1); \
            const int cw = conv_wgs(F.G, (T / 256) * (G1A_N / 256), CONV_WGS), gg = F.G - cw;     \
            if (cid < gg) { pg8::Gemm g{G1_A(l), (const bf16*)(ws + WS_WIN), T, G1A_N, D}; pg8::StaticOrder S; S.init(T, G1A_N, gg, cid); \
                EpiInA E{PA, (const float*)(ws + WS_COS), (const float*)(ws + WS_SIN), (const float*)(ws + WS_LBT) + l * 2048, 0, (const float*)(ws + WS_RSA)}; \
                pg8::gemm_phase<EpiInA, pg8::StaticOrder, PG8_ALIGN, PG8_SP2>(F.lds + RING_OFF, g, S, E); } \
            if (EXPERTS_BY_QUEUE) { const int n1 = NEXP * 16 * 32, h0 = __builtin_amdgcn_readfirstlane((int)VLD(F.ctl + CW_H12)), h1 = min(n1, h0 + cw * CONV_PER_WG1);     \
                if (cid >= gg) conv_experts_range(F, A, l, h0, h1, (cid - gg) * NWAVES + F.wave, cw * NWAVES); \
                conv_experts_range(F, A, l, h1, n1, F.vcu * NWAVES + F.wave, F.G * NWAVES); } \
            SEAM(pb + 1); \
        } \
FAST_PHASES(l) \
        if (IN(pb + 5)) { WSP(); PR_BEGIN(pb + 5); \
            pg8::Gemm g{G1_A(l), (const bf16*)(ws + WS_WIN) + (size_t)NPA * D, T, NGATE, D}; pg8::StaticOrder S; S.init(T, NGATE, F.G, cid); \
            EpiGate E{GT, (const float*)(ws + WS_RSA)}; \
            pg8::gemm_phase<EpiGate, pg8::StaticOrder, PG8_ALIGN, PG8_SP2>(F.lds + RING_OFF, g, S, E); \
            PROBE_KLOOP_EXTRA \
            SEAM(pb + 5); \
        } \
        if (IN(pb + 6)) { WSP(); PR_BEGIN(pb + 6); \
            pg8::Gemm g{YA, (const bf16*)(ws + WS_WUA), T, D, 512}; pg8::StaticOrder S; S.init(T, D, F.G, cid); \
            EpiUpA E{MG, GT}; \
            pg8::gemm_phase<EpiUpA, pg8::StaticOrder, PG8_ALIGN, PG8_SP2>(F.lds + RING_OFF, g, S, E); \
            PR_END(pb + 6);   \
        } \
        if (IN(pb + 7)) { WSP(); PR_BEGIN(pb + 7); \
            pg8::Gemm g{YH, (const bf16*)(ws + WS_WUH), T, D, 512}; pg8::StaticOrder S; S.init(T, D, F.G, cid); \
            EpiUpB E{MG, GT, (const float*)(ws + WS_SSQ)}; \
            pg8::gemm_phase<EpiUpB, pg8::StaticOrder, PG8_ALIGN, PG8_SP2>(F.lds + RING_OFF, g, S, E); \
            SEAM(pb + 7); \
        } \
        if (IN(pb + 8)) { WSP(); PR_BEGIN(pb + 8); \
            pg8::Gemm g{MG, (const bf16*)(ws + WS_WOUT), T, D, D}; pg8::StaticOrder S; S.init(T, D, F.G, cid); \
            EPIOUT_T(l) E{XB_NEW(l), XIN0(l)}; \
            pg8::gemm_phase<EPIOUT_T(l), pg8::StaticOrder, PG8_ALIGN, PG8_SP2>(F.lds + RING_OFF, g, S, E); \
            SEAM(pb + 8); \
        } \
        if (IN(pb + 9)) { WSP(); PR_BEGIN(pb + 9); ROUTE_FN(F, A, l, XB_NEW(l)); SEAM(pb + 9); } \
        if (IN(pb + 10)) { WSP(); PR_BEGIN(pb + 10); phase_dispatch(F); PROBE_BARRIERS_EXTRA SEAM(pb + 10); } \
        if (IN(pb + 11)) { WSP(); PR_BEGIN(pb + 11); \
            const int cw = MOE_HANDOFF ? 0 : conv_wgs(F.G, 4 * __builtin_amdgcn_readfirstlane((int)VLD((const int*)(ws + WS_META))), CONV_WGS_MOE), gg = F.G - cw;     \
            if (cid < gg) { pg8::Gemm g{M1_A(l), (const bf16*)(ws + WS_W1), SLOT_ROWS, D, D}; MOE_ORDER1 S; S.init((const int*)(ws + WS_META), D, gg, cid); MOE_CNT(l) \
                EpiAct E{(bf16*)(ws + WS_ACT), (const float*)(ws + WS_RSS)}; \
                pg8::gemm_phase<EpiAct, MOE_ORDER1, PG8_ALIGN, PG8_SP2, true>(F.lds + RING_OFF, g, S, E, (const int*)(ws + WS_STOK)); } \
            if (EXPERTS_BY_QUEUE) { const int n1 = NEXP * 16 * 32, n2 = NEXP * 8 * 32, h2 = min(n2, cw * CONV_PER_WG2); \
                if (cid >= gg) conv_experts_range(F, A, l, n1, n1 + h2, (cid - gg) * NWAVES + F.wave, cw * NWAVES); \
                conv_experts_range(F, A, l, n1 + h2, n1 + n2, F.vcu * NWAVES + F.wave, F.G * NWAVES); } \
            MOE_SEAM(pb + 11); \
        } \
        if (IN(pb + 12)) { WSP(); PR_BEGIN(pb + 12); \
            const int cw = (MOE_HANDOFF || !EXPERTS_BY_QUEUE || (l) == DEPTH - 1) ? 0 : conv_wgs(F.G, 4 * __builtin_amdgcn_readfirstlane((int)VLD((const int*)(ws + WS_META))), CONV_WGS_MOE), gg = F.G - cw;     \
            if (cid < gg) { pg8::Gemm g{(const bf16*)(ws + WS_ACT), (const bf16*)(ws + WS_W2), SLOT_ROWS, D, DEXP}; MOE_ORDER2 S; S.init((const int*)(ws + WS_META), D, gg, cid, MOE_HANDOFF != 0); MOE_CNT(l) \
                EpiY E{(bf16*)(ws + WS_XP)}; \
                pg8::gemm_phase<EpiY, MOE_ORDER2, PG8_ALIGN, PG8_SP2, false, MOE_HANDOFF ? 16 : 0>(F.lds + RING_OFF, g, S, E); } \
            else conv_experts_range(F, A, (l) + 1, 0, cw * CONV_PER_WG12, (cid - gg) * NWAVES + F.wave, cw * NWAVES); \
            if (cw > 0 && cid == 0 && F.tid == 0) __hip_atomic_store(F.ctl + CW_H12, (unsigned)(cw * CONV_PER_WG12), __ATOMIC_RELAXED, __HIP_MEMORY_SCOPE_AGENT);     \
            SEAM(pb + 12); \
        } \
        if (IN(pb + 13)) { WSP(); PR_BEGIN(pb + 13); \
            const bool last = (l == DEPTH - 1); \
            if (!last) conv_weights(F, A, l + 1); \
            phase_combine(F, last ? A.in[I_FING] : A.in[I_ANG] + (size_t)(l + 1) * D, last, XB_NEW(l), XB_CUR((l) + 1)); \
            if (!last) { if ((pb + 15) + 1 < hi) xcd_barrier(bar); } PR_END(pb + 13); \
        } \
    }
    LAYER_BODY(0)
    LAYER_BODY(1)
    static_assert(DEPTH == 2, "layer bodies are written out");
#if defined(PROBE_MASK)
    if (blockIdx.x == 0 && threadIdx.x == 0) { const unsigned long long t1 = wall_clock64(), want = (unsigned long long)PROBE_MULT * pr_acc; while (wall_clock64() - t1 < want) __builtin_amdgcn_s_sleep(8); }
#endif
#undef IN
#undef SEAM
}

extern "C" void kernel_launch(void* const* d_in, const int* in_sizes, int n_in, void* d_out, int out_size, void* d_ws, size_t ws_size, hipStream_t stream) {
    static int grid = 0;
    if (grid == 0) {
        if (n_in != 18 || in_sizes[0] != T * D || out_size != T * D || ws_size < WS_END) { fprintf(stderr, "kernel_launch: unexpected shapes (n_in %d, in0 %d, out %d, ws %zu); nothing launched\n", n_in, n_in > 0 ? in_sizes[0] : -1, out_size, ws_size); grid = -1; return; }
        int dev = 0, cus = 0, per_cu = 0;
        if (hipGetDevice(&dev) != hipSuccess || hipDeviceGetAttribute(&cus, hipDeviceAttributeMultiprocessorCount, dev) != hipSuccess) { grid = -1; return; }
        if (hipFuncSetAttribute((const void*)mega_fwd, hipFuncAttributeMaxDynamicSharedMemorySize, LDS_BYTES) != hipSuccess) { fprintf(stderr, "kernel_launch: hipFuncSetAttribute failed\n"); grid = -1; return; }
        if (hipOccupancyMaxActiveBlocksPerMultiprocessor(&per_cu, (const void*)mega_fwd, NWAVES * 64, LDS_BYTES) != hipSuccess || per_cu < 1)
            fprintf(stderr, "kernel_launch: note: occupancy query reports %d workgroups per CU\n", per_cu);
        (void)hipGetLastError();
        grid = cus;
    }
    if (grid < 0) return;
    if (hipMemsetAsync((char*)d_ws + WS_CTL, 0, CTL_ZERO_BYTES, stream) != hipSuccess) return;
    Args a{};
    for (int i = 0; i < 18; ++i) a.in[i] = (const float*)d_in[i];
    a.out = (float*)d_out; a.ws = (unsigned char*)d_ws; a.pad = 0;
    int li = 0;
    auto launch = [&](int lo, int hi) { a.ph_lo = lo; a.ph_hi = hi; a.li = li++; hipLaunchKernelGGL(mega_fwd, dim3(grid), dim3(NWAVES * 64), LDS_BYTES, stream, a);
        const hipError_t le = hipPeekAtLastError(); if (le != hipSuccess) fprintf(stderr, "kernel_launch: launch [%d,%d) failed: %s\n", lo, hi, hipGetErrorName(le)); };
#if defined(ORACLE)
    unsigned char* ws = (unsigned char*)d_ws;
#if defined(CHECK)
    unsigned* cnt = (unsigned*)(ws + 525 * MiB + 512 * 1024); hipMemsetAsync(cnt, 0, 4096, stream);
    hipLaunchKernelGGL(ck_mfma, dim3(1), dim3(64), 0, stream, cnt + 39); hipMemsetAsync(cnt + 512 + 700, 0xFF, 8, stream);
    const float* const* in = (const float* const*)d_in; float* xs = (float*)d_out;
    const bf16* XNc = (const bf16*)(ws + WS_XN); const bf16* PAc = (const bf16*)(ws + WS_PA); const bf16* MGc = (const bf16*)(ws + WS_US);
    const bf16* YAc = (const bf16*)(ws + WS_Y); const bf16* YHc = (const bf16*)(ws + WS_YH); const float* ssqc = (const float*)(ws + WS_SSQ);
#define CKL(k, ...) hipLaunchKernelGGL(k, dim3(CK_NS), dim3(256), 0, stream, __VA_ARGS__)
#endif
    for (int l = 0; l < DEPTH; ++l) {
#if defined(CHECK)
        const float* w_in_l = in[I_WIN] + (size_t)l * D * INW; unsigned* c0 = cnt + 20 * l;
        if (l == 0) { launch(0, 1); CKL(ck_norm, in[I_X], in[I_ANG], XNc, c0 + 0); launch(1, 2); }
        else { CKL(ck_norm, (const float*)xs, in[I_ANG] + (size_t)l * D, XNc, c0 + 0); launch(16 * l + 1, 16 * l + 2); }
        CKL(ck_pa, XNc, w_in_l, in[I_LBT], l, PAc, c0 + 1);
#else
        if (l == 0) launch(0, 2); else launch(16 * l + 1, 16 * l + 2);
#endif
#if defined(ORACLE_FAST)
        launch(16 * l + 2, 16 * l + 3);
#if defined(CHECK)
        hipLaunchKernelGGL(ck_ha, dim3(CK_NS), dim3(128), 0, stream, (const bf16*)(ws + WS_PA), (const bf16*)(ws + WS_US), (const float*)(ws + WS_HD), cnt + 20 * l + 40 + 0);
#endif
        launch(16 * l + 3, 16 * l + 4);
#if defined(CHECK)
        hipLaunchKernelGGL(ck_hb, dim3(CK_NS), dim3(128), 0, stream, (const bf16*)(ws + WS_PA), (const bf16*)(ws + WS_US), cnt + 20 * l + 40 + 2);
#endif
        launch(16 * l + 4, 16 * l + 5);
#else
        hipLaunchKernelGGL(zero_f32, dim3(T * 4 / 256), dim3(256), 0, stream, (float*)(ws + WS_SSQ), T * 4);
        hipLaunchKernelGGL(simple_attn, dim3(T * 8 / 4), dim3(256), 0, stream, (const bf16*)(ws + WS_PA), (const float*)d_in[I_SINK] + l * NQH, (bf16*)(ws + WS_Y));
        hipLaunchKernelGGL(simple_hgrn, dim3(8), dim3(512), 0, stream, (const bf16*)(ws + WS_PA), (const float*)d_in[I_HNG] + l * 512, (float*)(ws + WS_US), (bf16*)(ws + WS_YH), (float*)(ws + WS_SSQ));
#endif
#if defined(CHECK)
        CKL(ck_attn, PAc, in[I_SINK] + l * NQH, YAc, c0 + 3 + 40); hipLaunchKernelGGL(ck_hgrn, dim3(CK_NS, 4), dim3(128), 0, stream, PAc, in[I_HNG] + l * 512, YHc, ssqc, c0 + 4 + 40);
        const float* wua = in[I_WUA] + (size_t)l * 512 * D; const float* wuh = in[I_WUH] + (size_t)l * 512 * D; const int pb = 16 * l;
#if defined(CK_SENTINEL)
        hipMemsetAsync(ws + WS_PA, 0xFF, (size_t)T * NGATE * 2, stream);
#endif
#if defined(CK_FLUSH)
        hipLaunchKernelGGL(ck_flush, dim3(4096), dim3(64), 0, stream);
#endif
        launch(pb + 5, pb + 6);
#if defined(CK_FLUSH)
        hipLaunchKernelGGL(ck_flush, dim3(4096), dim3(64), 0, stream);
#endif
        if (l == 0) hipLaunchKernelGGL(ck_gates_full, dim3(T * 8), dim3(256), 0, stream, XNc, w_in_l, PAc, cnt + 512); CKL(ck_mix, XNc, w_in_l, YAc, YHc, ssqc, wua, wuh, PAc, MGc, 0, c0 + 7);
        launch(pb + 6, pb + 7); CKL(ck_mix, XNc, w_in_l, YAc, YHc, ssqc, wua, wuh, PAc, MGc, 1, c0 + 7);
        launch(pb + 7, pb + 8); CKL(ck_mix, XNc, w_in_l, YAc, YHc, ssqc, wua, wuh, PAc, MGc, 2, c0 + 7);
        launch(pb + 8, pb + 9); if (l == 0) CKL(ck_out, in[I_X], MGc, in[I_WOUT], (const float*)xs, c0 + 10);
        const float* gff = in[I_FNG] + (size_t)l * D; const float* wrg = in[I_WRG] + (size_t)l * D * NGRP; const float* brg = in[I_BRG] + l * NGRP; const float* wre = in[I_WRE] + (size_t)l * NGRP * D * EPG; const float* bre = in[I_BRE] + l * NGRP * EPG;
        const float* weg = in[I_WEG] + (size_t)l * NEXP * D * DEXP; const float* weu = in[I_WEU] + (size_t)l * NEXP * D * DEXP; const float* wed = in[I_WED] + (size_t)l * NEXP * DEXP * D;
        const int* toke = (const int*)(ws + WS_TOKE); const float* tokw = (const float*)(ws + WS_TOKW); const int* tokp = (const int*)(ws + WS_TOKP); const int* metac = (const int*)(ws + WS_META);
        const bf16* XPc = (const bf16*)(ws + WS_XP); const bf16* ACTc = (const bf16*)(ws + WS_ACT);
#define CKM(st) CKL(ck_moe, (const float*)xs, gff, wrg, brg, wre, bre, weg, weu, wed, XNc, toke, tokw, tokp, metac, XPc, ACTc, XPc, st, c0 + 12)
        launch(pb + 9, pb + 10); CKL(ck_norm, (const float*)xs, gff, XNc, c0 + 11); CKM(0);
        launch(pb + 10, pb + 11); CKM(1);
        launch(pb + 11, pb + 12); CKM(2);
        launch(pb + 12, pb + 13); CKM(3);
        hipMemcpyAsync(ws + WS_US, xs, (size_t)T * D * 4 / 2, hipMemcpyDeviceToDevice, stream);
        launch(pb + 13, pb + 14);
        CKL(ck_comb, (const float*)(ws + WS_US), (const float*)xs, tokp, tokw, XPc, in[I_FING], (int)(l == DEPTH - 1), c0 + 6 + 40);
#else
#if defined(STOP_AFTER)
        launch(16 * l + 5, STOP_AFTER + 1); break;
#else
        launch(16 * l + 5, 16 * l + 14);
#endif
#endif
    }
#if defined(CHECK)
    hipLaunchKernelGGL(ck_report, dim3(1), dim3(64), 0, stream, (const unsigned*)cnt, 80, xs);
#endif
#else
    launch(0, 16 * (DEPTH - 1) + 14);
#endif
}
```

```cpp
#include <hip/hip_runtime.h>
#include <cstdio>
#include <cstdint>
namespace pg8 {
#define PG8_LAS __attribute__((address_space(3)))
typedef unsigned short bf16_t;
typedef short bf16x8 __attribute__((ext_vector_type(8)));
typedef float f32x4 __attribute__((ext_vector_type(4)));
typedef unsigned u32x4 __attribute__((ext_vector_type(4)));
typedef unsigned u32x2 __attribute__((ext_vector_type(2)));
constexpr int BM = 256, BK = 64, HALF = 128, HTB = HALF * BK * 2  , STAGE_BYTES = 8 * HTB, NXCD = 8, WGM = 8;

__host__ __device__ __forceinline__ int lds_byte(int r, int c) { const int st = (r >> 4) * 2 + (c >> 5), rr = r & 15, cc = c & 31, ob = rr * 64 + cc * 2; return st * 1024 + (ob ^ (((ob >> 9) & 1) << 5)); }
__host__ __device__ __forceinline__ void stage_rc(int b, int& R, int& C) { const int st = b / 1024, sb = b % 1024, swz = sb ^ (((sb >> 9) & 1) << 5); R = (st >> 1) * 16 + swz / 64; C = (st & 1) * 32 + (swz % 64) / 2; }
__host__ __device__ __forceinline__ int perm32(int rho) { const int n = rho >> 4, i = rho & 15; return 8 * (i >> 2) + 4 * n + (i & 3); }

struct Unit { int pm, pn, pb; };
struct Gemm { const bf16_t* A; const bf16_t* Bt; int M, N, K; };

struct StaticOrder {
    int nM, nN, nwg, G, c;
    __host__ __device__ void init(int M, int N, int G_, int c_) { nM = M / BM; nN = N / BM; nwg = nM * nN; G = G_; c = c_; }
    __host__ __device__ bool next(int i, Unit& u) const {
        const long L = (long)i * G + c; if (L >= nwg) return false;
        int wgid = (int)L; { const int q = nwg / NXCD, r = nwg % NXCD, xcd = wgid % NXCD, off = wgid / NXCD; wgid = (xcd < r ? xcd * (q + 1) : r * (q + 1) + (xcd - r) * q) + off; }
        const int nig = WGM * nN, gid = wgid / nig, fm = gid * WGM, gsz = (nM - fm) < WGM ? (nM - fm) : WGM;
        u.pm = fm + ((wgid % nig) % gsz); u.pn = (wgid % nig) / gsz; u.pb = u.pn; return true;
    }
    __device__ __forceinline__ void a_ready(const Unit&) const {}
    __device__ __forceinline__ void done(const Unit&) const {}
};
struct GroupedOrder {
    const int* meta; int nM, nN, nwg, G, base;
    __device__ __forceinline__ void init(const int* meta_, int N, int G_, int c_, bool second = false) { meta = meta_; nM = __builtin_amdgcn_readfirstlane(__hip_atomic_load(meta_, __ATOMIC_RELAXED, __HIP_MEMORY_SCOPE_AGENT)); nN = N / BM; nwg = nM * nN; G = G_;
        base = second ? (((c_ < nwg) ? (nwg - c_ + G_ - 1) / G_ : 0) * G_ + c_ - nwg) : c_; }
    __device__ __forceinline__ bool next(int i, Unit& u) const {
        int wgid = i * G + base; if (wgid >= nwg) return false;
        { const int q = nwg / NXCD, r = nwg % NXCD, xcd = wgid % NXCD, off = wgid / NXCD; wgid = (xcd < r ? xcd * (q + 1) : r * (q + 1) + (xcd - r) * q) + off; }
        const int nig = WGM * nN, gid = wgid / nig, fm = gid * WGM, gsz = (nM - fm) < WGM ? (nM - fm) : WGM;
        u.pm = fm + ((wgid % nig) % gsz); u.pn = (wgid % nig) / gsz;
        u.pb = __builtin_amdgcn_readfirstlane(__hip_atomic_load(meta + 1 + u.pm, __ATOMIC_RELAXED, __HIP_MEMORY_SCOPE_AGENT)) * nN + u.pn; return true;
    }
    __device__ __forceinline__ void a_ready(const Unit&) const {}
    __device__ __forceinline__ void done(const Unit&) const {}
};
struct ProducerOrder : GroupedOrder {
    unsigned* cnt;
    __device__ __forceinline__ void done(const Unit& u) const {
        asm volatile("s_waitcnt vmcnt(0)" ::: "memory");
        if ((threadIdx.x & 63) == 0) __hip_atomic_fetch_add(cnt + 64 * u.pm, 1u, __ATOMIC_RELAXED, __HIP_MEMORY_SCOPE_AGENT);
    }
};
struct ConsumerOrder : GroupedOrder {
    unsigned* cnt; static constexpr unsigned NEED = 32u;
    __device__ __forceinline__ void a_ready(const Unit& u) const {
        if (threadIdx.x < 64) {
            unsigned* tmo = cnt - 64;
            const unsigned long long t0 = __builtin_amdgcn_s_memrealtime(); unsigned polls = 0;
            while ((unsigned)__builtin_amdgcn_readfirstlane(__hip_atomic_load(cnt + 64 * u.pm, __ATOMIC_RELAXED, __HIP_MEMORY_SCOPE_AGENT)) < NEED) {
                if ((++polls & 255u) == 0u && __builtin_amdgcn_readfirstlane(__hip_atomic_load(tmo, __ATOMIC_RELAXED, __HIP_MEMORY_SCOPE_AGENT)) != 0u) break;
                if (__builtin_amdgcn_s_memrealtime() - t0 > 2000000ull) {
                    if (threadIdx.x == 0) { unsigned expect = 0u; __hip_atomic_compare_exchange_strong(tmo + 1, &expect, 0x600u | (unsigned)(u.pm & 0xff), __ATOMIC_RELAXED, __ATOMIC_RELAXED, __HIP_MEMORY_SCOPE_AGENT); __hip_atomic_store(tmo, 1u, __ATOMIC_RELAXED, __HIP_MEMORY_SCOPE_AGENT); }
                    break; }
                __builtin_amdgcn_s_sleep(2); }
            asm volatile("s_waitcnt vmcnt(0)" ::: "memory");
        }
        asm volatile("" ::: "memory"); __builtin_amdgcn_s_barrier(); asm volatile("" ::: "memory");
    }
};
typedef float f32x2_t __attribute__((ext_vector_type(2))); typedef __bf16 bf16x2_t __attribute__((ext_vector_type(2)));
__device__ __forceinline__ unsigned cvt_pk_bf16(float lo, float hi) { f32x2_t v = {lo, hi}; bf16x2_t b = __builtin_convertvector(v, bf16x2_t); return __builtin_bit_cast(unsigned, b); }
template <class Epi, class Sched, bool ALIGN_EPI = false, bool SP2 = false, bool GATHER = false, int A_AUX = 0>
__device__ __forceinline__ void gemm_phase(PG8_LAS unsigned char* lds, const Gemm g, const Sched& S, const Epi& E, const int* rowtab = nullptr) {
    int tid_ = threadIdx.x; asm volatile("" : "+v"(tid_));
    const int tid = tid_, wid = __builtin_amdgcn_readfirstlane(tid >> 6), lane = tid & 63, wr = wid >> 2, wc = wid & 3, fr = lane & 15, fq = lane >> 4;
    const int K = g.K, nt = K / BK;
    unsigned voffA[2], voffB[2];
#pragma unroll
    for (int i = 0; i < 2; ++i) { int R, C; stage_rc(tid * 16 + i * 8192, R, C); const int Rb = Epi::PERM ? ((R & ~31) + perm32(R & 31)) : R;
        voffA[i] = (unsigned)(R * K + C) * 2u; voffB[i] = (unsigned)(Rb * K + C) * 2u; }
    const size_t kstep = (size_t)(BK * 2);
    const size_t hstep = (size_t)HALF * K * 2;
    const size_t tstep = 2 * hstep;
    const unsigned ldsw = (unsigned)wid * 1024u;
    const int aoff = lds_byte(wr * 64 + fr, fq * 8), boff = lds_byte(wc * 32 + fr, fq * 8);
#define PG8_SA(b, h) (((b) * 2 + (h)) * HTB)
#define PG8_SB(b, h) ((4 + (b) * 2 + (h)) * HTB)
#define PG8_STAGE(bufoff, gbase, voff) do { _Pragma("unroll") for (int _i = 0; _i < 2; ++_i) \
        __builtin_amdgcn_global_load_lds((const unsigned*)((const char*)(gbase) + (voff)[_i]), (PG8_LAS unsigned*)(lds + (bufoff) + ldsw + _i * 8192), 16, 0, 0); } while (0)
#define PG8_STAGE_A(bufoff, gbase, h, RO) do { _Pragma("unroll") for (int _i = 0; _i < 2; ++_i) \
        __builtin_amdgcn_global_load_lds((const unsigned*)((const char*)(gbase) + (GATHER ? (size_t)RO[h][_i] : (size_t)(((h) ? hstep : 0) + voffA[_i]))), (PG8_LAS unsigned*)(lds + (bufoff) + ldsw + _i * 8192), 16, 0, A_AUX); } while (0)
#define PG8_ROWOFS(RO, pm_) do { if constexpr (GATHER) { _Pragma("unroll") for (int _h = 0; _h < 2; ++_h) _Pragma("unroll") for (int _i = 0; _i < 2; ++_i) { int _R, _C; stage_rc(tid * 16 + _i * 8192, _R, _C); \
        const int _tok = __hip_atomic_load(rowtab + (pm_) * 256 + _h * 128 + _R, __ATOMIC_RELAXED, __HIP_MEMORY_SCOPE_AGENT); RO[_h][_i] = (unsigned)_tok * (unsigned)(K * 2) + (unsigned)(_C * 2); } } } while (0)
#define PG8_LDA(dst, b, h) do { _Pragma("unroll") for (int m = 0; m < 4; ++m) _Pragma("unroll") for (int k = 0; k < 2; ++k) dst[m][k] = *(const PG8_LAS bf16x8*)(lds + PG8_SA(b, h) + aoff + m * 2048 + k * 1024); } while (0)
#define PG8_LDB(dst, b, h) do { _Pragma("unroll") for (int n = 0; n < 2; ++n) _Pragma("unroll") for (int k = 0; k < 2; ++k) dst[n][k] = *(const PG8_LAS bf16x8*)(lds + PG8_SB(b, h) + boff + n * 2048 + k * 1024); } while (0)
#define PG8_MMA(ai, bj, At, Bt) do { __builtin_amdgcn_s_setprio(1); _Pragma("unroll") for (int m = 0; m < 4; ++m) _Pragma("unroll") for (int n = 0; n < 2; ++n) _Pragma("unroll") for (int k = 0; k < 2; ++k) \
        acc[ai][bj][m][n] = __builtin_amdgcn_mfma_f32_16x16x32_bf16(Bt[n][k], At[m][k], acc[ai][bj][m][n], 0, 0, 0); __builtin_amdgcn_s_setprio(0); } while (0)
#define PG8_WAIT_V(n) asm volatile("s_waitcnt vmcnt(" #n ")" ::: "memory")
#define PG8_WAIT_L(n) asm volatile("s_waitcnt lgkmcnt(" #n ")" ::: "memory")
#define PG8_BAR __builtin_amdgcn_s_barrier()
#define PG8_SCHED __builtin_amdgcn_sched_barrier(0)
    Unit cur, nxt; int ui = 0;
    if (!S.next(0, cur)) return;
    f32x4 acc[2][2][4][2];
#pragma unroll
    for (int a = 0; a < 2; ++a)
#pragma unroll
        for (int b = 0; b < 2; ++b)
#pragma unroll
            for (int m = 0; m < 4; ++m)
#pragma unroll
                for (int n = 0; n < 2; ++n) acc[a][b][m][n] = (f32x4){0.f, 0.f, 0.f, 0.f};
    bf16x8 At[4][2], B0[2][2], B1[2][2];
    const char* cA = (const char*)g.A + (GATHER ? (size_t)0 : (size_t)cur.pm * tstep); const char* cB = (const char*)g.Bt + (size_t)cur.pb * tstep;
    unsigned rofsC[2][2] = {{0u, 0u}, {0u, 0u}}, rofsN[2][2] = {{0u, 0u}, {0u, 0u}};
    PG8_ROWOFS(rofsC, cur.pm);
    S.a_ready(cur);
    if constexpr (SP2) {
        PG8_STAGE(PG8_SB(0, 0), cB, voffB); PG8_STAGE(PG8_SB(0, 1), cB + hstep, voffB); PG8_STAGE_A(PG8_SA(0, 0), cA, 0, rofsC); PG8_STAGE_A(PG8_SA(0, 1), cA, 1, rofsC);
        if (wr == 1) PG8_BAR;
        PG8_WAIT_V(2); PG8_BAR;
        PG8_STAGE(PG8_SB(1, 0), cB + kstep, voffB); PG8_STAGE_A(PG8_SA(1, 0), cA + kstep, 0, rofsC); PG8_STAGE(PG8_SB(1, 1), cB + hstep + kstep, voffB);
        PG8_WAIT_V(6); PG8_BAR;
    } else {
        PG8_STAGE(PG8_SB(0, 0), cB, voffB); PG8_STAGE_A(PG8_SA(0, 0), cA, 0, rofsC); PG8_STAGE(PG8_SB(0, 1), cB + hstep, voffB); PG8_STAGE_A(PG8_SA(0, 1), cA, 1, rofsC);
        if (wr == 1) PG8_BAR;
        PG8_WAIT_V(4); PG8_BAR;
        PG8_STAGE(PG8_SB(1, 0), cB + kstep, voffB); PG8_STAGE_A(PG8_SA(1, 0), cA + kstep, 0, rofsC); PG8_STAGE(PG8_SB(1, 1), cB + hstep + kstep, voffB);
        PG8_WAIT_V(6); PG8_BAR;
    }
    for (;;) {
        const bool has_next = S.next(ui + 1, nxt);
        const char* nA = (has_next && !GATHER) ? (const char*)g.A + (size_t)nxt.pm * tstep : cA; const char* nB = has_next ? (const char*)g.Bt + (size_t)nxt.pb * tstep : cB;
        for (int t = 0; t < nt; t += 2) {
            const bool last = (t == nt - 2);
            const char* a1 = cA + (size_t)(t + 1) * kstep;
            const char* a2 = last ? nA : cA + (size_t)(t + 2) * kstep; const char* b2 = last ? nB : cB + (size_t)(t + 2) * kstep;
            const char* a3 = a2 + kstep; const char* b3 = b2 + kstep;
            if (last && has_next) { S.a_ready(nxt); PG8_ROWOFS(rofsN, nxt.pm); }
            unsigned ro2[2][2];
#pragma unroll
            for (int _h = 0; _h < 2; ++_h)
#pragma unroll
                for (int _i = 0; _i < 2; ++_i) ro2[_h][_i] = (last && has_next) ? rofsN[_h][_i] : rofsC[_h][_i];
            if constexpr (SP2) {
            PG8_LDB(B0, 0, 0); PG8_LDB(B1, 0, 1); PG8_SCHED; PG8_LDA(At, 0, 0); PG8_STAGE_A(PG8_SA(1, 1), a1, 1, rofsC);
            PG8_WAIT_V(8); PG8_WAIT_L(0); PG8_BAR; PG8_MMA(0, 0, At, B0); PG8_MMA(0, 1, At, B1); PG8_BAR; PG8_SCHED;
            PG8_LDA(At, 0, 1); PG8_STAGE(PG8_SB(0, 0), b2, voffB); PG8_STAGE(PG8_SB(0, 1), b2 + hstep, voffB); PG8_STAGE_A(PG8_SA(0, 0), a2, 0, ro2);
            PG8_WAIT_V(8); PG8_WAIT_L(0); PG8_BAR; PG8_MMA(1, 0, At, B0); PG8_MMA(1, 1, At, B1); PG8_BAR; PG8_SCHED;
            PG8_LDB(B0, 1, 0); PG8_LDB(B1, 1, 1); PG8_SCHED; PG8_LDA(At, 1, 0); PG8_STAGE_A(PG8_SA(0, 1), a2, 1, ro2);
            PG8_WAIT_V(8); PG8_WAIT_L(0); PG8_BAR; PG8_MMA(0, 0, At, B0); PG8_MMA(0, 1, At, B1); PG8_BAR; PG8_SCHED;
            PG8_LDA(At, 1, 1); PG8_STAGE(PG8_SB(1, 0), b3, voffB); PG8_STAGE(PG8_SB(1, 1), b3 + hstep, voffB); PG8_STAGE_A(PG8_SA(1, 0), a3, 0, ro2);
            PG8_WAIT_V(8); PG8_WAIT_L(0); PG8_BAR; PG8_MMA(1, 0, At, B0); PG8_MMA(1, 1, At, B1); PG8_BAR; PG8_SCHED;
            } else {
            PG8_LDB(B0, 0, 0); PG8_SCHED; PG8_LDA(At, 0, 0); PG8_STAGE_A(PG8_SA(1, 1), a1, 1, rofsC);
            PG8_WAIT_L(8); PG8_BAR; PG8_WAIT_L(0); PG8_MMA(0, 0, At, B0); PG8_BAR; PG8_SCHED;
            PG8_LDB(B1, 0, 1); PG8_STAGE(PG8_SB(0, 0), b2, voffB);
            PG8_BAR; PG8_WAIT_L(0); PG8_MMA(0, 1, At, B1); PG8_BAR;
            PG8_LDA(At, 0, 1); PG8_STAGE_A(PG8_SA(0, 0), a2, 0, ro2);
            PG8_BAR; PG8_WAIT_L(0); PG8_MMA(1, 0, At, B0); PG8_BAR; PG8_SCHED;
            PG8_STAGE(PG8_SB(0, 1), b2 + hstep, voffB);
            PG8_WAIT_V(6); PG8_BAR; PG8_MMA(1, 1, At, B1); PG8_BAR;
            PG8_LDB(B0, 1, 0); PG8_SCHED; PG8_LDA(At, 1, 0); PG8_STAGE_A(PG8_SA(0, 1), a2, 1, ro2);
            PG8_WAIT_L(8); PG8_BAR; PG8_WAIT_L(0); PG8_MMA(0, 0, At, B0); PG8_BAR; PG8_SCHED;
            PG8_LDB(B1, 1, 1); PG8_STAGE(PG8_SB(1, 0), b3, voffB);
            PG8_BAR; PG8_WAIT_L(0); PG8_MMA(0, 1, At, B1); PG8_BAR;
            PG8_LDA(At, 1, 1); PG8_STAGE_A(PG8_SA(1, 0), a3, 0, ro2);
            PG8_BAR; PG8_WAIT_L(0); PG8_MMA(1, 0, At, B0); PG8_BAR; PG8_SCHED;
            PG8_STAGE(PG8_SB(1, 1), b3 + hstep, voffB);
            PG8_WAIT_V(6); PG8_BAR; PG8_MMA(1, 1, At, B1); PG8_BAR;
            }
        }
        if constexpr (ALIGN_EPI) { if (wr == 0) PG8_BAR; }
        if constexpr (!Epi::AFTER_DRAIN) { E(acc, cur, wr, wc, fr, fq); S.done(cur); }
        if (!has_next) break;
#pragma unroll
        for (int a = 0; a < 2; ++a)
#pragma unroll
            for (int b = 0; b < 2; ++b)
#pragma unroll
                for (int m = 0; m < 4; ++m)
#pragma unroll
                    for (int n = 0; n < 2; ++n) acc[a][b][m][n] = (f32x4){0.f, 0.f, 0.f, 0.f};
        cur = nxt; cA = nA; cB = nB; ++ui;
#pragma unroll
        for (int _h = 0; _h < 2; ++_h)
#pragma unroll
            for (int _i = 0; _i < 2; ++_i) rofsC[_h][_i] = rofsN[_h][_i];
        if constexpr (ALIGN_EPI) { if (wr == 1) PG8_BAR; }
    }
    PG8_WAIT_V(0);
    if constexpr (!ALIGN_EPI) { if (wr == 0) PG8_BAR; }
    PG8_BAR;
    if constexpr (Epi::AFTER_DRAIN) { E.fused(acc, cur, wr, wc, fr, fq, lds, wid, lane); S.done(cur); }
#undef PG8_SA
#undef PG8_SB
#undef PG8_STAGE
#undef PG8_STAGE_A
#undef PG8_ROWOFS
#undef PG8_LDA
#undef PG8_LDB
#undef PG8_MMA
#undef PG8_WAIT_V
#undef PG8_WAIT_L
#undef PG8_BAR
#undef PG8_SCHED
}
}


constexpr int NWAVES = 8;
constexpr int BATCH = 2, SEQ = 16384, D = 1024, T = BATCH * SEQ, DEPTH = 2;
constexpr int NQH = 8, NKVH = 2, HD = 64, WINDOW = 128;
constexpr int HH = 4, HDK = 128;
constexpr int NGRP = 4, EPG = 8, NEXP = 32, DEXP = 512;
constexpr int INW = 5376, NPA = 3328, NGATE = 2048;
constexpr int C_QA = 0, C_KA = 512, C_VA = 640, C_QH = 768, C_LF = 1280, C_LB = 1792, C_VH = 2304, C_SG = 2816;
constexpr float NORM_EPS = 1e-6f, LOGF_MIN = -4.0f;
constexpr float LOG2E = 1.4426950408889634f;
constexpr float QSCALE = 0.125f * LOG2E;
constexpr int CH = 128, NCH = SEQ / CH;
constexpr int SLOT_ROWS = 73728;

constexpr size_t MiB = 1u << 20;
constexpr size_t WS_CTL = 0, CTL_ZERO_BYTES = 1 * MiB;
constexpr size_t WS_COS = 1 * MiB, WS_SIN = 3 * MiB, WS_LBT = 5 * MiB;
constexpr size_t WS_WIN = 6 * MiB, WS_WUA = 17 * MiB, WS_WUH = 18 * MiB, WS_WOUT = 19 * MiB, WS_W1 = 22 * MiB, WS_W2 = 86 * MiB;
constexpr size_t WS_XN = 118 * MiB;
constexpr size_t WS_PA = 182 * MiB;
constexpr size_t WS_US = 390 * MiB;
constexpr size_t WS_Y = 454 * MiB;
constexpr size_t WS_YH = 486 * MiB;
constexpr size_t WS_HD = 518 * MiB;
constexpr size_t WS_SSQ = 519 * MiB;
constexpr size_t WS_TOKE = 520 * MiB, WS_TOKW = 521 * MiB, WS_TOKR = 522 * MiB, WS_TOKP = 523 * MiB;
constexpr size_t WS_WGCNT = 524 * MiB;
constexpr size_t WS_META = 524 * MiB + 512 * 1024;
constexpr size_t WS_STOK = 525 * MiB;
constexpr size_t WS_RSA = 526 * MiB;
constexpr size_t WS_RSF = 526 * MiB + 128 * 1024;
constexpr size_t WS_RSS = 526 * MiB + 256 * 1024;
constexpr size_t WS_END = 527 * MiB;
constexpr size_t WS_XP = WS_PA;
constexpr size_t WS_ACT = WS_PA + (size_t)SLOT_ROWS * D * 2;
static_assert(WS_ACT + (size_t)SLOT_ROWS * DEXP * 2 <= WS_Y, "MoE overlay");
static_assert(WS_PA + (size_t)T * NPA * 2 <= WS_US && WS_W2 + (size_t)NEXP * D * DEXP * 2 <= WS_XN && WS_WIN + (size_t)INW * D * 2 <= WS_WUA, "ws map");
constexpr int CW_TMO = 0, CW_CODE = 1;
constexpr int CW_BAR = 4096;
#ifndef G1A_SPLIT
#define G1A_SPLIT 0
#endif
#ifndef CONV_WGS
#define CONV_WGS 16
#endif
#ifndef CONV_WGS_MOE
#define CONV_WGS_MOE 32
#endif
#ifndef CONV_PER_WG1
#define CONV_PER_WG1 512
#endif
#ifndef CONV_PER_WG2
#define CONV_PER_WG2 256
#endif
#ifndef CONV_PER_WG12
#define CONV_PER_WG12 192
#endif
#ifndef NORM4
#define NORM4 0
#endif
#ifndef NORMFOLD
#define NORMFOLD 0
#endif
#ifndef XBF16
#define XBF16 1
#endif
#ifndef CONV_ASM_LOADS
#define CONV_ASM_LOADS 0
#endif
#ifndef EXPERTS_BY_QUEUE
#define EXPERTS_BY_QUEUE 1
#endif
#ifndef MOE_HANDOFF
#define MOE_HANDOFF 0
#endif
constexpr int MAX_LAUNCH = 16;
constexpr int CW_H12 = 2048;
constexpr int CW_MOE = 131072, MOE_BANK = 320 * 64;

constexpr int RING_OFF = 0, RING_BYTES = 131072;
constexpr int LDSCTL_OFF = RING_BYTES, MISC_OFF = LDSCTL_OFF + 320;
#ifndef ROUTE4
#define ROUTE4 1
#endif
constexpr int LDS_BYTES = ROUTE4 ? 163840 : 147456;

#define GAS __attribute__((address_space(1)))
#define LAS __attribute__((address_space(3)))
typedef unsigned short bf16;
typedef unsigned v4u __attribute__((ext_vector_type(4)));
typedef unsigned v2u __attribute__((ext_vector_type(2)));
typedef float f32x4 __attribute__((ext_vector_type(4)));
typedef short bf16x8 __attribute__((ext_vector_type(8)));
typedef short s16x4 __attribute__((ext_vector_type(4)));
typedef _Float16 h16x4 __attribute__((ext_vector_type(4)));
typedef _Float16 h16x8 __attribute__((ext_vector_type(8)));
typedef GAS unsigned gu32;
typedef GAS unsigned long long gu64;
#define RLX_AGENT __ATOMIC_RELAXED, __HIP_MEMORY_SCOPE_AGENT
#define LDS_WAIT() asm volatile("s_waitcnt lgkmcnt(0)" ::: "memory")
#define VM_WAIT() asm volatile("s_waitcnt vmcnt(0)" ::: "memory")
__device__ __forceinline__ unsigned f2bf(float f) { unsigned u = __builtin_bit_cast(unsigned, f); return (u + 0x7fffu + ((u >> 16) & 1u)) >> 16; }
__device__ __forceinline__ unsigned pk2(float lo, float hi) { return f2bf(lo) | (f2bf(hi) << 16); }
__device__ __forceinline__ float bf2f(unsigned short b) { return __builtin_bit_cast(float, ((unsigned)b) << 16); }
__device__ __forceinline__ float bflo(unsigned w) { return __builtin_bit_cast(float, w << 16); }
__device__ __forceinline__ float bfhi(unsigned w) { return __builtin_bit_cast(float, w & 0xffff0000u); }
__device__ __forceinline__ float fast_rcp(float x) { return __builtin_amdgcn_rcpf(x); }
__device__ __forceinline__ float sigmoidf_(float x) { return fast_rcp(1.0f + __expf(-x)); }
__device__ __forceinline__ float siluf_(float x) { return x * fast_rcp(1.0f + __expf(-x)); }

#define XB_TMO      128
#define XB_XCNT(j)  (256  + 64 * (j))
#define XB_XSUB(j)  (1280 + 64 * (j))
#define XB_XGEN(j)  (2304 + 64 * (j))
#define XB_TOP      3328
#define XB_TOPGEN   3392
#define XCD_BAR_WORDS 3456
#define XB_SPIN_CAP (1u << 18)

__device__ __forceinline__ unsigned xb_ld(unsigned* p)              { return __hip_atomic_load(p, __ATOMIC_RELAXED, __HIP_MEMORY_SCOPE_AGENT); }
__device__ __forceinline__ unsigned xb_add(unsigned* p, unsigned v) { return __hip_atomic_fetch_add(p, v, __ATOMIC_RELAXED, __HIP_MEMORY_SCOPE_AGENT); }
__device__ __forceinline__ unsigned xb_xcc_id() { return (unsigned)__builtin_amdgcn_s_getreg((3 << 11) | 20) & 0xFu; }
#define XB_SPIN(cond, bar) do { unsigned _sp = 0; while (cond) { __builtin_amdgcn_s_sleep(1); \
    if ((++_sp & 255u) == 0u) { if (xb_ld(&(bar)[XB_TMO])) break; if (_sp > XB_SPIN_CAP) { atomicAdd(&(bar)[XB_TMO], 1u); break; } } } } while (0)

struct XcdBarrier {
    unsigned* bar; unsigned x;
    volatile LAS unsigned* st;
};

__device__ __forceinline__ XcdBarrier xcd_barrier_post(unsigned* bar, volatile LAS unsigned* st) {
    XcdBarrier b; b.bar = bar; b.x = xb_xcc_id(); b.st = st;
    if (threadIdx.x == 0) (void)xb_add(&bar[XB_XCNT(b.x)], 1u);
    return b;
}
__device__ __forceinline__ void xcd_barrier_complete(unsigned* bar, unsigned x, unsigned& nloc, unsigned& nx) {
    const unsigned G = gridDim.x * gridDim.y * gridDim.z;
    unsigned sum, cnt, mine, sp = 0u;
    for (;;) {
        sum = 0u; cnt = 0u; mine = 0u;
#pragma unroll
        for (unsigned j = 0; j < 16; ++j) { const unsigned c = xb_ld(&bar[XB_XCNT(j)]); sum += c; cnt += (c > 0u) ? 1u : 0u; mine = (j == x) ? c : mine; }
        if (sum == G) break;
        __builtin_amdgcn_s_sleep(1);
        if ((++sp & 255u) == 0u) { if (xb_ld(&bar[XB_TMO])) break; if (sp > XB_SPIN_CAP) { atomicAdd(&bar[XB_TMO], 1u); break; } }
    }
    nloc = mine > 0u ? mine : 1u; nx = cnt > 0u ? cnt : 1u;
}

__device__ __forceinline__ void xcd_barrier(const XcdBarrier& b) {
    asm volatile("s_waitcnt vmcnt(0)" ::: "memory");
    __syncthreads();
    if (threadIdx.x == 0) {
        unsigned* bar = b.bar;
        __builtin_amdgcn_s_waitcnt(0);
        unsigned nloc = b.st[0], nx = b.st[1];
        if (nloc == 0u) { xcd_barrier_complete(bar, b.x, nloc, nx); b.st[0] = nloc; b.st[1] = nx; }
        const unsigned old = xb_add(&bar[XB_XSUB(b.x)], 1u);
        const unsigned gen = old / nloc;
        if (old + 1u == (gen + 1u) * nloc) {
            __builtin_amdgcn_fence(__ATOMIC_RELEASE, "agent");
            asm volatile("s_waitcnt vmcnt(0)" ::: "memory");
            const unsigned og = xb_add(&bar[XB_TOP], 1u);
            const unsigned tg = og / nx;
            if (og + 1u == (tg + 1u) * nx) xb_add(&bar[XB_TOPGEN], 1u);
            else XB_SPIN(xb_ld(&bar[XB_TOPGEN]) == tg, bar);
            __builtin_amdgcn_fence(__ATOMIC_ACQUIRE, "agent");
            xb_add(&bar[XB_XGEN(b.x)], 1u);
            asm volatile("s_waitcnt vmcnt(0)" ::: "memory");
        } else {
            XB_SPIN(xb_ld(&bar[XB_XGEN(b.x)]) == gen, bar);
            __builtin_amdgcn_fence(__ATOMIC_ACQUIRE, "agent");
            asm volatile("s_waitcnt vmcnt(0)" ::: "memory");
        }
    }
    __syncthreads();
}

struct Frame {
    LAS unsigned char* lds;
    volatile LAS unsigned* MISC;
    gu32* ctl;
    int tid, lane, wave, vcu, G;
    unsigned char* ws;
    float* out;
};
struct Args { const float* in[18]; float* out; unsigned char* ws; int ph_lo, ph_hi, li, pad; };
enum { I_X = 0, I_ANG, I_WIN, I_SINK, I_LBT, I_HNG, I_WUA, I_WUH, I_WOUT, I_FNG, I_WRG, I_BRG, I_WRE, I_BRE, I_WEG, I_WEU, I_WED, I_FING };

__device__ __forceinline__ float wave_sum(float v) {
#if defined(__HIP_DEVICE_COMPILE__)
#define WS_ROR(n) v += __builtin_bit_cast(float, __builtin_amdgcn_update_dpp(0, __builtin_bit_cast(int, v), 0x120 + (n), 0xf, 0xf, false))
    WS_ROR(8); WS_ROR(4); WS_ROR(2); WS_ROR(1);
#undef WS_ROR
    const int b = __builtin_bit_cast(int, v);
    const float r0 = __builtin_bit_cast(float, __builtin_amdgcn_readlane(b, 0)), r1 = __builtin_bit_cast(float, __builtin_amdgcn_readlane(b, 16));
    const float r2 = __builtin_bit_cast(float, __builtin_amdgcn_readlane(b, 32)), r3 = __builtin_bit_cast(float, __builtin_amdgcn_readlane(b, 48));
    return (r0 + r1) + (r2 + r3);
#else
    return v;
#endif
}

struct CmPerm { const float* W; int N; __device__ __forceinline__ const float* seg(int p0, int n, int c, int& ld) const { ld = N; return W + p0 + 8 * c + 4 * n; } };
struct CmIn { const float* W; __device__ __forceinline__ const float* seg(int p0, int n, int c, int& ld) const { ld = INW;
    return (p0 < C_VA) ? (W + (p0 & ~63) + 32 * n + 16 * ((p0 >> 5) & 1) + 4 * c) : (W + p0 + 8 * c + 4 * n); } };
struct CmGU { const float* Wg; const float* Wu; __device__ __forceinline__ const float* seg(int p0, int n, int c, int& ld) const { ld = DEXP; return (n ? Wu : Wg) + 16 * (p0 >> 5) + 4 * c; } };
template <class CM> __device__ __forceinline__ void transpose_load(const CM& cm, int kb, int nb, int lane, f32x4 (&v)[8]) {
    const int k0 = 64 * kb, n0 = 32 * nb;
    const int nc = lane & 7, kr = lane >> 3;
    int ld; const float* src; { const float* s0 = cm.seg(n0, 0, nc & 3, ld); const float* s1 = cm.seg(n0, 1, nc & 3, ld); src = (nc >> 2) ? s1 : s0; }
#pragma unroll
    for (int i = 0; i < 8; ++i) v[i] = *(const GAS f32x4*)(src + (size_t)(k0 + 8 * i + kr) * ld);
}
__device__ __forceinline__ void transpose_finish(int K, bf16* WT, LAS float* scr, int kb, int nb, int lane, const f32x4 (&v)[8], const LAS float* gk = nullptr) {
    constexpr int SP = 36;
    const int k0 = 64 * kb, n0 = 32 * nb;
    const int nc = lane & 7, kr = lane >> 3;
#pragma unroll
    for (int i = 0; i < 8; ++i) *(LAS f32x4*)(scr + (8 * i + kr) * SP + 4 * nc) = gk ? v[i] * gk[k0 + 8 * i + kr] : v[i];
    LDS_WAIT(); asm volatile("" ::: "memory");
    const int c = lane & 7;
#pragma unroll
    for (int j = 0; j < 4; ++j) { const int n = (lane >> 3) + 8 * j; const LAS float* s = scr + (8 * c) * SP + n;
        v4u o; o.x = pk2(s[0 * SP], s[1 * SP]); o.y = pk2(s[2 * SP], s[3 * SP]); o.z = pk2(s[4 * SP], s[5 * SP]); o.w = pk2(s[6 * SP], s[7 * SP]);
        *(GAS v4u*)(WT + (size_t)(n0 + n) * K + k0 + 8 * c) = o; }
    LDS_WAIT(); asm volatile("" ::: "memory");
}
template <class CM> __device__ __forceinline__ void transpose_item(const CM& cm, int K, bf16* WT, LAS float* scr, int kb, int nb, int lane, const LAS float* gk = nullptr) {
    f32x4 v[8]; transpose_load(cm, kb, nb, lane, v); transpose_finish(K, WT, scr, kb, nb, lane, v, gk);
}
__device__ __forceinline__ void conv_weights(Frame& F, const Args& A, int l) {
    LAS float* scr = (LAS float*)(F.lds + RING_OFF + F.wave * 16384);
    const int gw = F.vcu * NWAVES + F.wave, NGW = F.G * NWAVES;
    unsigned char* ws = F.ws;
    const float* w_in = A.in[I_WIN] + (size_t)l * D * INW;
    const float* w_ua = A.in[I_WUA] + (size_t)l * 512 * D;
    const float* w_uh = A.in[I_WUH] + (size_t)l * 512 * D;
    const float* w_out = A.in[I_WOUT] + (size_t)l * D * D;
    const float* w_eg = A.in[I_WEG] + (size_t)l * NEXP * D * DEXP;
    const float* w_eu = A.in[I_WEU] + (size_t)l * NEXP * D * DEXP;
    const float* w_ed = A.in[I_WED] + (size_t)l * NEXP * DEXP * D;
    constexpr int I_A = 16 * (INW / 32), I_B = 8 * 32, I_D = 16 * 32, I_E1 = 16 * 32, I_E = NEXP * I_E1, I_F1 = 8 * 32, I_F = NEXP * I_F1;
    constexpr int NITEMS = I_A + 2 * I_B + I_D + (EXPERTS_BY_QUEUE ? 0 : I_E + I_F);
    LAS float* gkl = scr + 2560;
    if (NORMFOLD) { const float* gsrc = A.in[I_ANG] + (size_t)l * D;
#pragma unroll
        for (int j = 0; j < 4; ++j) *(LAS f32x4*)(gkl + 4 * F.lane + 256 * j) = *(const f32x4*)(gsrc + 4 * F.lane + 256 * j);
        LDS_WAIT(); }
    for (int it = gw; it < NITEMS; it += NGW) {
        int r = it;
        if (r < I_A) { CmIn cm{w_in}; transpose_item(cm, D, (bf16*)(ws + WS_WIN), scr, r / (INW / 32), r % (INW / 32), F.lane, NORMFOLD ? gkl : nullptr); continue; } r -= I_A;
        if (r < I_B) { CmPerm cm{w_ua, D}; transpose_item(cm, 512, (bf16*)(ws + WS_WUA), scr, r / 32, r % 32, F.lane); continue; } r -= I_B;
        if (r < I_B) { CmPerm cm{w_uh, D}; transpose_item(cm, 512, (bf16*)(ws + WS_WUH), scr, r / 32, r % 32, F.lane); continue; } r -= I_B;
        if (r < I_D) { CmPerm cm{w_out, D}; transpose_item(cm, D, (bf16*)(ws + WS_WOUT), scr, r / 32, r % 32, F.lane); continue; } r -= I_D;
        if (r < I_E) { const int e = r / I_E1, q = r % I_E1; CmGU cm{w_eg + (size_t)e * D * DEXP, w_eu + (size_t)e * D * DEXP};
            transpose_item(cm, D, (bf16*)(ws + WS_W1) + (size_t)e * 1024 * D, scr, q / 32, q % 32, F.lane); continue; } r -= I_E;
        { const int e = r / I_F1, q = r % I_F1; CmPerm cm{w_ed + (size_t)e * DEXP * D, D};
            transpose_item(cm, DEXP, (bf16*)(ws + WS_W2) + (size_t)e * D * DEXP, scr, q / 32, q % 32, F.lane); }
    }
}
__device__ __forceinline__ int conv_wgs(int G, int units, int cmax) {
    if (!EXPERTS_BY_QUEUE || G < 64 || (G % 8) != 0) return 0;
    const int r = (units + G - 1) / G; int c = cmax;
    while (c > 0 && (units + (G - c) - 1) / (G - c) > r) c -= 8;
    return c;
}
__device__ __forceinline__ void conv_experts_range(Frame& F, const Args& A, int l, int first, int last, int wi, int nw) {
    LAS float* scr = (LAS float*)(F.lds + RING_OFF + F.wave * 16384);
    unsigned char* ws = F.ws;
    const float* w_eg = A.in[I_WEG] + (size_t)l * NEXP * D * DEXP;
    const float* w_eu = A.in[I_WEU] + (size_t)l * NEXP * D * DEXP;
    const float* w_ed = A.in[I_WED] + (size_t)l * NEXP * DEXP * D;
    LAS float* gkl = scr + 2560;
    if (NORMFOLD && first < last) { const float* gsrc = A.in[I_FNG] + (size_t)l * D;
#pragma unroll
        for (int j = 0; j < 4; ++j) *(LAS f32x4*)(gkl + 4 * F.lane + 256 * j) = *(const f32x4*)(gsrc + 4 * F.lane + 256 * j);
        LDS_WAIT(); }
    constexpr int I_E1 = 16 * 32, I_E = NEXP * I_E1, I_F1 = 8 * 32;
    static_assert(I_E % 2 == 0 && I_F1 % 2 == 0, "pairs do not straddle");
#define CQ_LOAD(q, va, vb) do { const bool w1_ = (q) < I_E; const int r0_ = w1_ ? (q) : (q) - I_E, e_ = w1_ ? (r0_ >> 9) : (r0_ >> 8), r_ = w1_ ? (r0_ & 511) : (r0_ & 255), kb_ = r_ >> 5, nb_ = r_ & 31; \
        const int nc_ = F.lane & 7, kr_ = F.lane >> 3, n_ = nc_ >> 2, c_ = nc_ & 3; const size_t eo_ = (size_t)e_ * D * DEXP; \
        const float* base_ = w1_ ? ((n_ ? w_eu : w_eg) + eo_ + 16 * nb_ + 4 * c_) : (w_ed + eo_ + 32 * nb_ + 8 * c_ + 4 * n_); const int ld_ = w1_ ? DEXP : D, st_ = w1_ ? 16 : 32; \
        _Pragma("unroll") for (int i_ = 0; i_ < 8; ++i_) { const GAS float* p_ = (const GAS float*)(base_ + (size_t)(64 * kb_ + 8 * i_ + kr_) * ld_); const GAS float* p2_ = p_ + st_; \
            CQ_LD(va[i_], p_); CQ_LD(vb[i_], p2_); } } while (0)
#if CONV_ASM_LOADS
#define CQ_LD(dst, p) asm volatile("global_load_dwordx4 %0, %1, off" : "=&v"(dst) : "v"(p) : "memory")
#define CQ_WAIT(n, va, vb) asm volatile("s_waitcnt vmcnt(" #n ")" : "+v"(va[0]), "+v"(va[1]), "+v"(va[2]), "+v"(va[3]), "+v"(va[4]), "+v"(va[5]), "+v"(va[6]), "+v"(va[7]), \
        "+v"(vb[0]), "+v"(vb[1]), "+v"(vb[2]), "+v"(vb[3]), "+v"(vb[4]), "+v"(vb[5]), "+v"(vb[6]), "+v"(vb[7]) :: "memory")
#else
#define CQ_LD(dst, p) dst = *(const GAS f32x4*)(p)
#define CQ_WAIT(n, va, vb) do { } while (0)
#endif
#define CQ_FINISH(q, va, vb) do { const bool w1_ = (q) < I_E; const int r0_ = w1_ ? (q) : (q) - I_E, e_ = w1_ ? (r0_ >> 9) : (r0_ >> 8), r_ = w1_ ? (r0_ & 511) : (r0_ & 255); \
        bf16* WT_ = (w1_ ? (bf16*)(ws + WS_W1) : (bf16*)(ws + WS_W2)) + (size_t)e_ * (w1_ ? 1024 * D : D * DEXP); const int K_ = w1_ ? D : DEXP; \
        const LAS float* gk_ = (NORMFOLD && w1_) ? gkl : nullptr; transpose_finish(K_, WT_, scr, r_ >> 5, r_ & 31, F.lane, va, gk_); transpose_finish(K_, WT_, scr, r_ >> 5, (r_ & 31) + 1, F.lane, vb, gk_); } while (0)
    static_assert(I_E1 == 512 && I_F1 == 256, "shifts above");
    f32x4 a0[8], a1[8], b0[8], b1[8];
    const int step = 2 * nw;
    int qa = first + 2 * wi, qb; if (qa >= last) return;
    CQ_LOAD(qa, a0, a1);
    for (;;) {
        qb = qa + step; const bool hb = qb < last; { const int ql = hb ? qb : qa; CQ_LOAD(ql, b0, b1); }
        CQ_WAIT(16, a0, a1); CQ_FINISH(qa, a0, a1);
        if (!hb) { CQ_WAIT(0, b0, b1); break; }
        qa = qb + step; const bool ha = qa < last; { const int ql = ha ? qa : qb; CQ_LOAD(ql, a0, a1); }
        CQ_WAIT(16, b0, b1); CQ_FINISH(qb, b0, b1);
        if (!ha) { CQ_WAIT(0, a0, a1); break; }
    }
#undef CQ_WAIT
#undef CQ_LD
#undef CQ_LOAD
#undef CQ_FINISH
}
__device__ __forceinline__ void make_tables(Frame& F, const Args& A) {
    const int gt = F.vcu * (NWAVES * 64) + F.tid, NT = F.G * NWAVES * 64;
    float* cosT = (float*)(F.ws + WS_COS); float* sinT = (float*)(F.ws + WS_SIN); float* lbt = (float*)(F.ws + WS_LBT);
    for (int idx = gt; idx < SEQ * 32; idx += NT) { const int pos = idx >> 5, i = idx & 31;
        const double inv = exp2(-(double)i * (13.287712379549449 / 32.0));
        const double ang = (double)pos * inv; const double r = ang - 6.283185307179586476925 * rint(ang * 0.15915494309189533577);
        float s, c; sincosf((float)r, &s, &c); cosT[idx] = c; sinT[idx] = s; }
    for (int idx = gt; idx < 2 * 512; idx += NT) { const int dir = idx >> 9, col = idx & 511;
        float tv[DEPTH]; float mx = -3.0e38f;
#pragma unroll
        for (int l = 0; l < DEPTH; ++l) { tv[l] = A.in[I_LBT][(size_t)(l * 2 + dir) * 512 + col]; mx = fmaxf(mx, tv[l]); }
        float den = 0.f;
#pragma unroll
        for (int l = 0; l < DEPTH; ++l) { tv[l] = expf(tv[l] - mx); den += tv[l]; }
        float cum = 0.f;
#pragma unroll
        for (int l = 0; l < DEPTH; ++l) { if (l > 0) cum += tv[l] / den; const float lb = cum;
            lbt[((l * 2 + dir) * 2 + 0) * 512 + col] = lb; lbt[((l * 2 + dir) * 2 + 1) * 512 + col] = 0.f; } }
}
__device__ __forceinline__ void norm_rows(Frame& F, const float* xin, float* xcopy, const float* g, bf16* xn, float* rs_out = nullptr) {
    const int gw = F.vcu * NWAVES + F.wave, NGW = F.G * NWAVES;
    f32x4 gv[4];
#pragma unroll
    for (int j = 0; j < 4; ++j) gv[j] = *(const f32x4*)(g + 4 * F.lane + 256 * j);
    f32x4 vn[4];
    { const GAS f32x4* xr = (const GAS f32x4*)(xin + (size_t)gw * D) + F.lane;
#pragma unroll
      for (int j = 0; j < 4; ++j) vn[j] = xr[64 * j]; }
    for (int m = gw; m < T; m += NGW) {
        f32x4 v[4]; float s = 0.f;
#pragma unroll
        for (int j = 0; j < 4; ++j) { v[j] = vn[j]; s += (v[j].x * v[j].x + v[j].y * v[j].y) + (v[j].z * v[j].z + v[j].w * v[j].w); }
        if (m + NGW < T) { const GAS f32x4* xr = (const GAS f32x4*)(xin + (size_t)(m + NGW) * D) + F.lane;
#pragma unroll
            for (int j = 0; j < 4; ++j) vn[j] = xr[64 * j]; }
        const float rstd = 1.0f / sqrtf(wave_sum(s) * (1.f / D) + NORM_EPS);
        if (xcopy) { GAS f32x4* xo = (GAS f32x4*)(xcopy + (size_t)m * D) + F.lane;
#pragma unroll
            for (int j = 0; j < 4; ++j) xo[64 * j] = v[j]; }
        GAS v2u* o8 = (GAS v2u*)(xn + (size_t)m * D) + F.lane;
#pragma unroll
        for (int j = 0; j < 4; ++j) { const f32x4 y = rs_out ? v[j] : v[j] * rstd * gv[j]; v2u w; w.x = pk2(y.x, y.y); w.y = pk2(y.z, y.w); o8[64 * j] = w; }
        if (rs_out && F.lane == 0) rs_out[m] = rstd;
    }
}

__device__ __forceinline__ float row_sum16n(float v) {
#if defined(__HIP_DEVICE_COMPILE__)
#define RS_ROR(n) v += __builtin_bit_cast(float, __builtin_amdgcn_update_dpp(0, __builtin_bit_cast(int, v), 0x120 + (n), 0xf, 0xf, false))
    RS_ROR(8); RS_ROR(4); RS_ROR(2); RS_ROR(1);
#undef RS_ROR
#endif
    return v;
}
__device__ __forceinline__ void norm_rows4(Frame& F, const float* xin, const float* g, bf16* xn) {
    const int gw = F.vcu * NWAVES + F.wave, NGW = F.G * NWAVES, r = F.lane >> 4, c = F.lane & 15;
    constexpr int NTG = T / 4;
    f32x4 vq[16], gq[16];
#pragma unroll
    for (int k = 0; k < 16; ++k) gq[k] = *(const f32x4*)(g + 64 * k + 4 * c);
    if (gw < NTG) { const GAS f32x4* xr = (const GAS f32x4*)(xin + (size_t)(4 * gw + r) * D) + c;
#pragma unroll
        for (int k = 0; k < 16; ++k) vq[k] = xr[16 * k]; }
    for (int tg = gw; tg < NTG; tg += NGW) { const int m = 4 * tg + r;
        f32x4 v[16]; float s = 0.f;
#pragma unroll
        for (int k = 0; k < 16; ++k) { v[k] = vq[k]; s += (v[k].x * v[k].x + v[k].y * v[k].y) + (v[k].z * v[k].z + v[k].w * v[k].w); }
        if (tg + NGW < NTG) { const GAS f32x4* xr = (const GAS f32x4*)(xin + (size_t)(4 * (tg + NGW) + r) * D) + c;
#pragma unroll
            for (int k = 0; k < 16; ++k) vq[k] = xr[16 * k]; }
        const float rstd = 1.0f / sqrtf(row_sum16n(s) * (1.f / D) + NORM_EPS);
        GAS v2u* o8 = (GAS v2u*)(xn + (size_t)m * D) + c;
#pragma unroll
        for (int k = 0; k < 16; ++k) { const f32x4 y = v[k] * rstd * gq[k]; v2u w; w.x = pk2(y.x, y.y); w.y = pk2(y.z, y.w); o8[16 * k] = w; }
    }
}

using pg8::Unit; using pg8::cvt_pk_bf16;
__device__ __forceinline__ v4u pack8(const f32x4& a, const f32x4& b) { v4u w; w.x = cvt_pk_bf16(a[0], a[1]); w.y = cvt_pk_bf16(a[2], a[3]); w.z = cvt_pk_bf16(b[0], b[1]); w.w = cvt_pk_bf16(b[2], b[3]); return w; }
__device__ __forceinline__ void unpack8(const v4u& w, f32x4& a, f32x4& b) { a = (f32x4){bflo(w.x), bfhi(w.x), bflo(w.y), bfhi(w.y)}; b = (f32x4){bflo(w.z), bfhi(w.z), bflo(w.w), bfhi(w.w)}; }
__device__ __forceinline__ float logf_gate(float z, float lb) {
    const float t = __expf(-fabsf(z)), num = (z >= 0.f) ? __builtin_fmaf(lb, t, 1.0f) : (lb + t);
    const float r2 = __builtin_amdgcn_logf(num) - __builtin_amdgcn_logf(1.0f + t);
    return fmaxf(r2, LOGF_MIN * 1.4426950408889634f);
}
struct EpiInA {
    static constexpr bool PERM = false, AFTER_DRAIN = false;
    bf16* PA; const float* cosT; const float* sinT; const float* lbt;
    int pofs;
    const float* rs;
    __device__ __forceinline__ void operator()(const f32x4 (&acc)[2][2][4][2], const Unit& u, int wr, int wc, int fr, int fq) const {
        const int pn = u.pn + pofs, row0 = u.pm * 256 + wr * 64 + fr;
        float rsv[2][4];
#pragma unroll
        for (int ai = 0; ai < 2; ++ai)
#pragma unroll
            for (int m = 0; m < 4; ++m) rsv[ai][m] = NORMFOLD ? rs[row0 + 128 * ai + 16 * m] : 1.0f;
#pragma unroll
        for (int bj = 0; bj < 2; ++bj) {
            int mode = 0; float sc = 1.f; int lbo = 0;
            if (pn < 2) { mode = 1; sc = QSCALE; } else if (pn == 2) { mode = (bj == 0) ? 1 : 0; } else if (pn < 5) mode = 2;
            else if (pn < 7) { mode = 3; lbo = (pn - 5) * 256; } else if (pn < 9) { mode = 3; lbo = 1024 + (pn - 7) * 256; } else if (pn < 11) mode = 0; else mode = 2;
            if (mode == 1) {
                const int hb = 256 * pn + 128 * bj + 64 * (wc >> 1), d0 = 16 * (wc & 1) + 4 * fq;
#pragma unroll
                for (int ai = 0; ai < 2; ++ai) { f32x4 csv[4], snv[4];
#pragma unroll
                    for (int m = 0; m < 4; ++m) { const int pos = (row0 + 128 * ai + 16 * m) & (SEQ - 1); csv[m] = *(const f32x4*)(cosT + pos * 32 + d0); snv[m] = *(const f32x4*)(sinT + pos * 32 + d0); }
#pragma unroll
                    for (int m = 0; m < 4; ++m) { const int r = row0 + 128 * ai + 16 * m;
                        const f32x4 cs = csv[m], sn = snv[m];
                        const f32x4 x1 = acc[ai][bj][m][0], x2 = acc[ai][bj][m][1];
                        const float scr_ = sc * rsv[ai][m];
                        const f32x4 o1 = (x1 * cs - x2 * sn) * scr_, o2 = (x2 * cs + x1 * sn) * scr_;
                        bf16* rp = PA + (size_t)r * NPA + hb + d0;
                        v2u w1; w1.x = cvt_pk_bf16(o1[0], o1[1]); w1.y = cvt_pk_bf16(o1[2], o1[3]); *(v2u*)rp = w1;
                        v2u w2; w2.x = cvt_pk_bf16(o2[0], o2[1]); w2.y = cvt_pk_bf16(o2[2], o2[3]); *(v2u*)(rp + 32) = w2; }
                    asm volatile("" ::: "memory"); }
            } else {
                const int c0 = 256 * pn + 128 * bj + 32 * wc + 8 * fq;
                if (mode == 3) {
                    const float* lp = lbt + lbo + 128 * bj + 32 * wc + 8 * fq;
#pragma unroll
                    for (int n = 0; n < 2; ++n) { const f32x4 la = *(const f32x4*)(lp + 4 * n);
#pragma unroll
                        for (int ai = 0; ai < 2; ++ai)
#pragma unroll
                            for (int m = 0; m < 4; ++m) { const int r = row0 + 128 * ai + 16 * m; bf16* rp = PA + (size_t)r * NPA + c0 + 4 * n;
                                const f32x4 v = acc[ai][bj][m][n] * rsv[ai][m]; h16x4 hv;
#pragma unroll
                                for (int j = 0; j < 4; ++j) hv[j] = (_Float16)logf_gate(v[j], la[j]);
                                *(h16x4*)rp = hv; asm volatile("" ::: "memory"); } }
                } else {
#pragma unroll
                    for (int ai = 0; ai < 2; ++ai)
#pragma unroll
                        for (int m = 0; m < 4; ++m) { const int r = row0 + 128 * ai + 16 * m; bf16* rp = PA + (size_t)r * NPA + c0;
                            f32x4 v0 = acc[ai][bj][m][0], v1 = acc[ai][bj][m][1];
                            if (NORMFOLD) { const float rr = rsv[ai][m]; v0 = v0 * rr; v1 = v1 * rr; }
                            if (mode == 2) {
#pragma unroll
                                for (int j = 0; j < 4; ++j) { v0[j] = siluf_(v0[j]); v1[j] = siluf_(v1[j]); } }
                            *(v4u*)rp = pack8(v0, v1); asm volatile("" ::: "memory"); }
                }
            }
        }
    }
};
struct EpiGate {
    static constexpr bool PERM = false, AFTER_DRAIN = false;
    bf16* O; const float* rs;
    __device__ __forceinline__ void operator()(const f32x4 (&acc)[2][2][4][2], const Unit& u, int wr, int wc, int fr, int fq) const {
        const int row0 = u.pm * 256 + wr * 64 + fr, c0 = 256 * u.pn + 32 * wc + 8 * fq;
        float rsv[2][4];
#pragma unroll
        for (int ai = 0; ai < 2; ++ai)
#pragma unroll
            for (int m = 0; m < 4; ++m) rsv[ai][m] = NORMFOLD ? rs[row0 + 128 * ai + 16 * m] : 1.0f;
#pragma unroll
        for (int ai = 0; ai < 2; ++ai)
#pragma unroll
            for (int m = 0; m < 4; ++m) { bf16* rp = O + (size_t)(row0 + 128 * ai + 16 * m) * NGATE + c0; const float rr = rsv[ai][m];
#pragma unroll
                for (int bj = 0; bj < 2; ++bj) { f32x4 v0 = acc[ai][bj][m][0] * rr, v1 = acc[ai][bj][m][1] * rr;
#if !defined(CK_PLAIN)
#pragma unroll
                    for (int j = 0; j < 4; ++j) { v0[j] = sigmoidf_(v0[j]); v1[j] = sigmoidf_(v1[j]); }
#endif
                    *(v4u*)(rp + 128 * bj) = pack8(v0, v1); } }
    }
};
#if defined(PROBE_KLOOP)
struct EpiNull {
    static constexpr bool PERM = false, AFTER_DRAIN = false;
    bf16* O;
    __device__ __forceinline__ void operator()(const f32x4 (&acc)[2][2][4][2], const Unit& u, int wr, int wc, int fr, int fq) const {
        float s = 0.f;
#pragma unroll
        for (int ai = 0; ai < 2; ++ai)
#pragma unroll
            for (int bj = 0; bj < 2; ++bj)
#pragma unroll
                for (int m = 0; m < 4; ++m)
#pragma unroll
                    for (int n = 0; n < 2; ++n) s += acc[ai][bj][m][n][0] + acc[ai][bj][m][n][1] + acc[ai][bj][m][n][2] + acc[ai][bj][m][n][3];
        if (s == 12345.678f) O[u.pm + wr + wc + fr + fq] = (bf16)1;
    }
};
#endif
struct EpiUpA {
    static constexpr bool PERM = false, AFTER_DRAIN = false;
    bf16* MG; const bf16* GT;
    __device__ __forceinline__ void operator()(const f32x4 (&acc)[2][2][4][2], const Unit& u, int wr, int wc, int fr, int fq) const {
        const int row0 = u.pm * 256 + wr * 64 + fr, c0 = 256 * u.pn + 32 * wc + 8 * fq;
        v4u gw[2][2][2];
#define UA_LOAD(q_, buf_) do { _Pragma("unroll") for (int mm = 0; mm < 2; ++mm) _Pragma("unroll") for (int bj = 0; bj < 2; ++bj) \
            gw[buf_][mm][bj] = *(const v4u*)(GT + (size_t)(row0 + 128 * ((q_) >> 1) + 16 * (2 * ((q_) & 1) + mm)) * NGATE + c0 + 128 * bj); } while (0)
        UA_LOAD(0, 0);
#pragma unroll
        for (int q = 0; q < 4; ++q) { const int ai = q >> 1, mh = q & 1;
            if (q < 3) UA_LOAD(q + 1, (q + 1) & 1);
            __builtin_amdgcn_sched_barrier(0);
#pragma unroll
            for (int mm = 0; mm < 2; ++mm) { const int m = 2 * mh + mm; bf16* rp = MG + (size_t)(row0 + 128 * ai + 16 * m) * D + c0;
#pragma unroll
                for (int bj = 0; bj < 2; ++bj) { f32x4 g0, g1; unpack8(gw[q & 1][mm][bj], g0, g1);
                    *(v4u*)(rp + 128 * bj) = pack8(acc[ai][bj][m][0] * g0, acc[ai][bj][m][1] * g1); } }
            __builtin_amdgcn_sched_barrier(0); }
#undef UA_LOAD
    }
};
struct EpiUpB {
    static constexpr bool PERM = false, AFTER_DRAIN = false;
    bf16* MG; const bf16* GT; const float* ssq;
    __device__ __forceinline__ void operator()(const f32x4 (&acc)[2][2][4][2], const Unit& u, int wr, int wc, int fr, int fq) const {
        const int row0 = u.pm * 256 + wr * 64 + fr, c0 = 256 * u.pn + 32 * wc + 8 * fq;
        v4u gw[2][2][2], pw[2][2][2]; f32x4 sq[2][2];
#define UB_LOAD(q_, buf_) do { _Pragma("unroll") for (int mm = 0; mm < 2; ++mm) { const int r_ = row0 + 128 * ((q_) >> 1) + 16 * (2 * ((q_) & 1) + mm); sq[buf_][mm] = *(const f32x4*)(ssq + (size_t)r_ * 4); \
            _Pragma("unroll") for (int bj = 0; bj < 2; ++bj) { gw[buf_][mm][bj] = *(const v4u*)(GT + (size_t)r_ * NGATE + 1024 + c0 + 128 * bj); pw[buf_][mm][bj] = *(const v4u*)(MG + (size_t)r_ * D + c0 + 128 * bj); } } } while (0)
        UB_LOAD(0, 0);
#pragma unroll
        for (int q = 0; q < 4; ++q) { const int ai = q >> 1, mh = q & 1;
            if (q < 3) UB_LOAD(q + 1, (q + 1) & 1);
            __builtin_amdgcn_sched_barrier(0);
#pragma unroll
            for (int mm = 0; mm < 2; ++mm) { const int m = 2 * mh + mm; bf16* rp = MG + (size_t)(row0 + 128 * ai + 16 * m) * D + c0; const f32x4 sv = sq[q & 1][mm];
                const float rstd = 1.0f / sqrtf(((sv[0] + sv[1]) + (sv[2] + sv[3])) * (1.f / 512.f) + NORM_EPS);
#pragma unroll
                for (int bj = 0; bj < 2; ++bj) { f32x4 g0, g1, p0, p1; unpack8(gw[q & 1][mm][bj], g0, g1); unpack8(pw[q & 1][mm][bj], p0, p1);
                    *(v4u*)(rp + 128 * bj) = pack8(p0 + acc[ai][bj][m][0] * g0 * rstd, p1 + acc[ai][bj][m][1] * g1 * rstd); } }
            __builtin_amdgcn_sched_barrier(0); }
#undef UB_LOAD
    }
};
struct EpiOut {
    static constexpr bool PERM = false, AFTER_DRAIN = false;
    float* X; const float* XI;
    __device__ __forceinline__ void operator()(const f32x4 (&acc)[2][2][4][2], const Unit& u, int wr, int wc, int fr, int fq) const {
        const int row0 = u.pm * 256 + wr * 64 + fr, c0 = 256 * u.pn + 32 * wc + 8 * fq;
#pragma unroll
        for (int ai = 0; ai < 2; ++ai) { f32x4 xv[4][2][2];
#pragma unroll
            for (int m = 0; m < 4; ++m)
#pragma unroll
                for (int bj = 0; bj < 2; ++bj) { const f32x4* p = (const f32x4*)(XI + (size_t)(row0 + 128 * ai + 16 * m) * D + c0 + 128 * bj); xv[m][bj][0] = p[0]; xv[m][bj][1] = p[1]; }
#pragma unroll
            for (int m = 0; m < 4; ++m)
#pragma unroll
                for (int bj = 0; bj < 2; ++bj) { f32x4* p = (f32x4*)(X + (size_t)(row0 + 128 * ai + 16 * m) * D + c0 + 128 * bj); p[0] = xv[m][bj][0] + acc[ai][bj][m][0]; p[1] = xv[m][bj][1] + acc[ai][bj][m][1]; }
            asm volatile("" ::: "memory"); }
    }
};
template <bool IN_F32> struct EpiOutB {
    static constexpr bool PERM = false, AFTER_DRAIN = false;
    bf16* XO; const void* XI;
    __device__ __forceinline__ void operator()(const f32x4 (&acc)[2][2][4][2], const Unit& u, int wr, int wc, int fr, int fq) const {
        const int row0 = u.pm * 256 + wr * 64 + fr, c0 = 256 * u.pn + 32 * wc + 8 * fq;
#pragma unroll
        for (int ai = 0; ai < 2; ++ai) { f32x4 xv[4][2][2];
#pragma unroll
            for (int m = 0; m < 4; ++m)
#pragma unroll
                for (int bj = 0; bj < 2; ++bj) { const size_t o = (size_t)(row0 + 128 * ai + 16 * m) * D + c0 + 128 * bj;
                    if constexpr (IN_F32) { const f32x4* p = (const f32x4*)((const float*)XI + o); xv[m][bj][0] = p[0]; xv[m][bj][1] = p[1]; }
                    else { const v4u w = *(const v4u*)((const bf16*)XI + o); unpack8(w, xv[m][bj][0], xv[m][bj][1]); } }
#pragma unroll
            for (int m = 0; m < 4; ++m)
#pragma unroll
                for (int bj = 0; bj < 2; ++bj) { const size_t o = (size_t)(row0 + 128 * ai + 16 * m) * D + c0 + 128 * bj;
                    *(v4u*)(XO + o) = pack8(xv[m][bj][0] + acc[ai][bj][m][0], xv[m][bj][1] + acc[ai][bj][m][1]); }
            asm volatile("" ::: "memory"); }
    }
};
struct EpiAct {
    static constexpr bool PERM = false, AFTER_DRAIN = false;
    bf16* ACT; const float* rs;
    __device__ __forceinline__ void operator()(const f32x4 (&acc)[2][2][4][2], const Unit& u, int wr, int wc, int fr, int fq) const {
        const int row0 = u.pm * 256 + wr * 64 + fr, c0 = 128 * u.pn + 16 * wc + 4 * fq;
        float rsv[2][4];
#pragma unroll
        for (int ai = 0; ai < 2; ++ai)
#pragma unroll
            for (int m = 0; m < 4; ++m) rsv[ai][m] = NORMFOLD ? rs[row0 + 128 * ai + 16 * m] : 1.0f;
#pragma unroll
        for (int ai = 0; ai < 2; ++ai)
#pragma unroll
            for (int m = 0; m < 4; ++m) { bf16* rp = ACT + (size_t)(row0 + 128 * ai + 16 * m) * DEXP + c0; const float rr = rsv[ai][m];
#pragma unroll
                for (int bj = 0; bj < 2; ++bj) { const f32x4 g = acc[ai][bj][m][0] * rr, up = acc[ai][bj][m][1] * rr; f32x4 a;
#pragma unroll
                    for (int j = 0; j < 4; ++j) a[j] = siluf_(g[j]) * up[j];
                    const unsigned long long w64 = (unsigned long long)cvt_pk_bf16(a[0], a[1]) | ((unsigned long long)cvt_pk_bf16(a[2], a[3]) << 32);
#if MOE_HANDOFF
                    __hip_atomic_store((gu64*)(rp + 64 * bj), w64, RLX_AGENT); } }
#else
                    *(unsigned long long*)(rp + 64 * bj) = w64; } }
#endif
    }
};
struct EpiY {
    static constexpr bool PERM = false, AFTER_DRAIN = false;
    bf16* Y;
    __device__ __forceinline__ void operator()(const f32x4 (&acc)[2][2][4][2], const Unit& u, int wr, int wc, int fr, int fq) const {
        const int row0 = u.pm * 256 + wr * 64 + fr, c0 = 256 * u.pn + 32 * wc + 8 * fq;
#pragma unroll
        for (int ai = 0; ai < 2; ++ai)
#pragma unroll
            for (int m = 0; m < 4; ++m) { bf16* rp = Y + (size_t)(row0 + 128 * ai + 16 * m) * D + c0;
#pragma unroll
                for (int bj = 0; bj < 2; ++bj) *(v4u*)(rp + 128 * bj) = pack8(acc[ai][bj][m][0], acc[ai][bj][m][1]); }
    }
};

#define VLD(p) __hip_atomic_load((p), __ATOMIC_RELAXED, __HIP_MEMORY_SCOPE_AGENT)
constexpr int HIST_OFF = MISC_OFF + 256;
constexpr int SBASE_OFF = HIST_OFF + 128;
constexpr int STOT_OFF = SBASE_OFF + 128;
constexpr int BRE_OFF = STOT_OFF + 128;
static_assert(BRE_OFF + 128 <= LDS_BYTES, "LDS misc");

__device__ __forceinline__ void phase_norm_route(Frame& F, const Args& A, int l, const void* xsrc) {
    const int gw = F.vcu * NWAVES + F.wave, NGW = F.G * NWAVES, lane = F.lane;
    LAS f32x4* Wre = (LAS f32x4*)(F.lds + RING_OFF);
    volatile LAS int* hist = (volatile LAS int*)(F.lds + HIST_OFF);
    const float* w_re = A.in[I_WRE] + (size_t)l * NGRP * D * EPG;
    const float* w_rg = A.in[I_WRG] + (size_t)l * D * NGRP;
    const float* b_rg = A.in[I_BRG] + l * NGRP;
    const float* b_re = A.in[I_BRE] + l * NGRP * EPG;
    const float* gf = A.in[I_FNG] + (size_t)l * D;
    for (int idx = F.tid; idx < NGRP * D; idx += NWAVES * 64) { const int g = idx >> 10, i = idx & 1023, li = (i & 255) >> 2, jj = 4 * (i >> 8) + (i & 3);
        const f32x4 a = *(const f32x4*)(w_re + (size_t)idx * 8), b = *(const f32x4*)(w_re + (size_t)idx * 8 + 4);
        Wre[((g * 2 + 0) * 16 + jj) * 64 + li] = a; Wre[((g * 2 + 1) * 16 + jj) * 64 + li] = b; }
    if (F.tid < 32) { hist[F.tid] = 0; ((LAS float*)(F.lds + BRE_OFF))[F.tid] = b_re[F.tid]; }
    { int* stok = (int*)(F.ws + WS_STOK); for (int i = F.vcu * (NWAVES * 64) + F.tid; i < SLOT_ROWS; i += F.G * NWAVES * 64) stok[i] = 0; }
    f32x4 wgr[16], gv[4];
#pragma unroll
    for (int j = 0; j < 4; ++j) { gv[j] = *(const f32x4*)(gf + 4 * lane + 256 * j);
#pragma unroll
        for (int c = 0; c < 4; ++c) wgr[4 * j + c] = *(const f32x4*)(w_rg + (size_t)(4 * lane + 256 * j + c) * 4); }
    f32x4 brg = *(const f32x4*)b_rg;
    __syncthreads();
    bf16* XN = (bf16*)(F.ws + WS_XN);
#if XBF16
    const bf16* X = (const bf16*)xsrc;
    typedef v2u xraw_t;
#define NR_LOAD(dst, row) do { const GAS v2u* xr_ = (const GAS v2u*)(X + (size_t)(row) * D) + lane; _Pragma("unroll") for (int j = 0; j < 4; ++j) dst[j] = xr_[64 * j]; } while (0)
#define NR_CVT(w_) ((f32x4){bflo((w_).x), bfhi((w_).x), bflo((w_).y), bfhi((w_).y)})
#else
    const float* X = (const float*)xsrc;
    typedef f32x4 xraw_t;
#define NR_LOAD(dst, row) do { const GAS f32x4* xr_ = (const GAS f32x4*)(X + (size_t)(row) * D) + lane; _Pragma("unroll") for (int j = 0; j < 4; ++j) dst[j] = xr_[64 * j]; } while (0)
#define NR_CVT(w_) (w_)
#endif
    int* tok_e = (int*)(F.ws + WS_TOKE); float* tok_w = (float*)(F.ws + WS_TOKW); int* tok_r = (int*)(F.ws + WS_TOKR);
    xraw_t vn[4], vn2[4];
    NR_LOAD(vn, gw); if (gw + NGW < T) NR_LOAD(vn2, gw + NGW);
    int pe1 = 0, pe2 = 0, pr1 = 0, pr2 = 0, pm = -1; float pw1 = 0.f, pw2 = 0.f;
    for (int m = gw; m < T; m += NGW) {
        f32x4 v[4]; float s = 0.f;
#pragma unroll
        for (int j = 0; j < 4; ++j) { v[j] = NR_CVT(vn[j]); vn[j] = vn2[j]; s += (v[j].x * v[j].x + v[j].y * v[j].y) + (v[j].z * v[j].z + v[j].w * v[j].w); }
        if (m + 2 * NGW < T) NR_LOAD(vn2, m + 2 * NGW);
        if (lane == 0 && pm >= 0) { tok_e[2 * pm] = pe1; tok_e[2 * pm + 1] = pe2; tok_w[2 * pm] = pw1; tok_w[2 * pm + 1] = pw2; tok_r[2 * pm] = pr1; tok_r[2 * pm + 1] = pr2; }
        const float rstd = 1.0f / sqrtf(wave_sum(s) * (1.f / D) + NORM_EPS);
        GAS v2u* o8 = (GAS v2u*)(XN + (size_t)m * D) + lane;
        f32x4 ga = (f32x4){0.f, 0.f, 0.f, 0.f};
#pragma unroll
        for (int j = 0; j < 4; ++j) { v[j] = v[j] * rstd * gv[j]; v2u w; w.x = pk2(v[j].x, v[j].y); w.y = pk2(v[j].z, v[j].w); o8[64 * j] = w;
            ga += wgr[4 * j + 0] * v[j].x; ga += wgr[4 * j + 1] * v[j].y; ga += wgr[4 * j + 2] * v[j].z; ga += wgr[4 * j + 3] * v[j].w; }
        float gl[4];
#pragma unroll
        for (int k = 0; k < 4; ++k) gl[k] = wave_sum(ga[k]) + brg[k];
        int gt = 0; float gm = gl[0];
#pragma unroll
        for (int k = 1; k < 4; ++k) if (gl[k] > gm) { gm = gl[k]; gt = k; }
        float gden = 0.f;
#pragma unroll
        for (int k = 0; k < 4; ++k) gden += expf(gl[k] - gm);
        const float p_top = 1.0f / gden;
        gt = __builtin_amdgcn_readfirstlane(gt);
        f32x4 a0 = (f32x4){0.f, 0.f, 0.f, 0.f}, a1 = a0;
        const LAS f32x4* w0 = Wre + ((gt * 2 + 0) * 16) * 64 + lane; const LAS f32x4* w1 = Wre + ((gt * 2 + 1) * 16) * 64 + lane;
        f32x4 wa[2][4], wb[2][4];
#pragma unroll
        for (int c = 0; c < 4; ++c) { wa[0][c] = w0[c * 64]; wb[0][c] = w1[c * 64]; }
#pragma unroll
        for (int j = 0; j < 4; ++j) {
            if (j < 3) {
#pragma unroll
                for (int c = 0; c < 4; ++c) { wa[(j + 1) & 1][c] = w0[(4 * (j + 1) + c) * 64]; wb[(j + 1) & 1][c] = w1[(4 * (j + 1) + c) * 64]; } }
            __builtin_amdgcn_sched_barrier(0);
            a0 += wa[j & 1][0] * v[j].x; a1 += wb[j & 1][0] * v[j].x;
            a0 += wa[j & 1][1] * v[j].y; a1 += wb[j & 1][1] * v[j].y;
            a0 += wa[j & 1][2] * v[j].z; a1 += wb[j & 1][2] * v[j].z;
            a0 += wa[j & 1][3] * v[j].w; a1 += wb[j & 1][3] * v[j].w;
            __builtin_amdgcn_sched_barrier(0); }
        const f32x4 bl0 = *(const LAS f32x4*)(F.lds + BRE_OFF + gt * 32), bl1 = *(const LAS f32x4*)(F.lds + BRE_OFF + gt * 32 + 16);
        float el[8];
#pragma unroll
        for (int k = 0; k < 4; ++k) { el[k] = wave_sum(a0[k]) + bl0[k]; el[4 + k] = wave_sum(a1[k]) + bl1[k]; }
        int i1 = 0; float m1 = el[0];
#pragma unroll
        for (int k = 1; k < 8; ++k) if (el[k] > m1) { m1 = el[k]; i1 = k; }
        int i2 = -1; float m2 = -3.0e38f;
#pragma unroll
        for (int k = 0; k < 8; ++k) if (k != i1 && el[k] > m2) { m2 = el[k]; i2 = k; }
        const float q1 = 1.0f, q2 = expf(m2 - m1);
        const float wn1 = p_top * q1 / (q1 + q2), wn2 = p_top * q2 / (q1 + q2);
        if (lane == 0) {
            pe1 = gt * 8 + i1; pe2 = gt * 8 + i2; pw1 = wn1; pw2 = wn2; pm = m;
            pr1 = __hip_atomic_fetch_add((LAS int*)hist + pe1, 1, __ATOMIC_RELAXED, __HIP_MEMORY_SCOPE_WORKGROUP);
            pr2 = __hip_atomic_fetch_add((LAS int*)hist + pe2, 1, __ATOMIC_RELAXED, __HIP_MEMORY_SCOPE_WORKGROUP);
        }
    }
    if (lane == 0 && pm >= 0) { tok_e[2 * pm] = pe1; tok_e[2 * pm + 1] = pe2; tok_w[2 * pm] = pw1; tok_w[2 * pm + 1] = pw2; tok_r[2 * pm] = pr1; tok_r[2 * pm + 1] = pr2; }
    __syncthreads();
    if (F.tid < 32) ((int*)(F.ws + WS_WGCNT))[blockIdx.x * 32 + F.tid] = hist[F.tid];
#undef NR_LOAD
#undef NR_CVT
}
#if ROUTE4
constexpr int WGR_OFF = (BRE_OFF + 128 + 255) & ~255, GNW_OFF = WGR_OFF + 16384;
static_assert(GNW_OFF + 4096 <= LDS_BYTES, "LDS route4");
__device__ __forceinline__ float row_sum16(float v) {
#if defined(__HIP_DEVICE_COMPILE__)
#define RS_ROR(n) v += __builtin_bit_cast(float, __builtin_amdgcn_update_dpp(0, __builtin_bit_cast(int, v), 0x120 + (n), 0xf, 0xf, false))
    RS_ROR(8); RS_ROR(4); RS_ROR(2); RS_ROR(1);
#undef RS_ROR
#endif
    return v;
}
__device__ __forceinline__ void phase_norm_route4(Frame& F, const Args& A, int l, const void* xsrc) {
    const int gw = F.vcu * NWAVES + F.wave, NGW = F.G * NWAVES, lane = F.lane, r = lane >> 4, c = lane & 15;
    LAS f32x4* WE = (LAS f32x4*)(F.lds + RING_OFF); LAS f32x4* WG = (LAS f32x4*)(F.lds + WGR_OFF); LAS f32x4* GL = (LAS f32x4*)(F.lds + GNW_OFF);
    volatile LAS int* hist = (volatile LAS int*)(F.lds + HIST_OFF);
    const float* w_re = A.in[I_WRE] + (size_t)l * NGRP * D * EPG;
    const float* w_rg = A.in[I_WRG] + (size_t)l * D * NGRP;
    const float* b_rg = A.in[I_BRG] + l * NGRP;
    const float* b_re = A.in[I_BRE] + l * NGRP * EPG;
    const float* gf = A.in[I_FNG] + (size_t)l * D;
    static_assert(XBF16 == 1, "route4 reads the bf16 residual stream");
    const bf16* X = (const bf16*)xsrc;
    constexpr int NTG = T / 4;
    v2u xn[16];
    if (gw < NTG) { const GAS v2u* xr = (const GAS v2u*)(X + (size_t)(4 * gw + r) * D) + c;
#pragma unroll
        for (int k = 0; k < 16; ++k) xn[k] = xr[16 * k]; }
    {
        f32x4 ta[8], tb[8], tg2[2], tgl = (f32x4){0.f, 0.f, 0.f, 0.f};
#pragma unroll
        for (int u = 0; u < 8; ++u) { const int idx = F.tid + u * (NWAVES * 64); ta[u] = *(const GAS f32x4*)(w_re + (size_t)idx * 8); tb[u] = *(const GAS f32x4*)(w_re + (size_t)idx * 8 + 4); }
#pragma unroll
        for (int u = 0; u < 2; ++u) tg2[u] = *(const GAS f32x4*)(w_rg + (size_t)(F.tid + u * (NWAVES * 64)) * 4);
        if (F.tid < 256) tgl = *(const GAS f32x4*)(gf + 64 * (F.tid >> 4) + 4 * (F.tid & 15));
        __builtin_amdgcn_sched_barrier(0);
#pragma unroll
        for (int u = 0; u < 8; ++u) { const int idx = F.tid + u * (NWAVES * 64), g = idx >> 10, e = idx & 1023, k = e >> 6, cc = (e >> 2) & 15, i = e & 3;
            WE[((g * 16 + k) * 8 + 2 * i) * 16 + cc] = ta[u]; WE[((g * 16 + k) * 8 + 2 * i + 1) * 16 + cc] = tb[u]; }
#pragma unroll
        for (int u = 0; u < 2; ++u) { const int e = F.tid + u * (NWAVES * 64), k = e >> 6, cc = (e >> 2) & 15, i = e & 3; WG[(k * 4 + i) * 16 + cc] = tg2[u]; }
        if (F.tid < 256) GL[F.tid] = tgl;
    }
    static_assert(NGRP * D == 8 * NWAVES * 64 && D == 2 * NWAVES * 64, "staging loops above");
    if (F.tid < 32) { hist[F.tid] = 0; ((LAS float*)(F.lds + BRE_OFF))[F.tid] = b_re[F.tid]; }
    { int* stok = (int*)(F.ws + WS_STOK); for (int i = F.vcu * (NWAVES * 64) + F.tid; i < SLOT_ROWS; i += F.G * NWAVES * 64) stok[i] = 0; }
    const f32x4 brg = *(const f32x4*)b_rg;
    __syncthreads();
    bf16* XN = (bf16*)(F.ws + WS_XN);
    int* tok_e = (int*)(F.ws + WS_TOKE); float* tok_w = (float*)(F.ws + WS_TOKW); int* tok_r = (int*)(F.ws + WS_TOKR);
    int pe1 = 0, pe2 = 0, pr1 = 0, pr2 = 0, pm = -1; float pw1 = 0.f, pw2 = 0.f, prs = 0.f; float* rsf = (float*)(F.ws + WS_RSF);
    for (int tg = gw; tg < NTG; tg += NGW) {
        const int m = 4 * tg + r;
        f32x4 v[16]; float s = 0.f;
#pragma unroll
        for (int k = 0; k < 16; ++k) { const v2u w = xn[k]; v[k] = (f32x4){bflo(w.x), bfhi(w.x), bflo(w.y), bfhi(w.y)}; s += (v[k].x * v[k].x + v[k].y * v[k].y) + (v[k].z * v[k].z + v[k].w * v[k].w); }
        if (tg + NGW < NTG) { const GAS v2u* xr = (const GAS v2u*)(X + (size_t)(4 * (tg + NGW) + r) * D) + c;
#pragma unroll
            for (int k = 0; k < 16; ++k) xn[k] = xr[16 * k]; }
        if (c == 0 && pm >= 0) { tok_e[2 * pm] = pe1; tok_e[2 * pm + 1] = pe2; tok_w[2 * pm] = pw1; tok_w[2 * pm + 1] = pw2; tok_r[2 * pm] = pr1; tok_r[2 * pm + 1] = pr2; if (NORMFOLD) rsf[pm] = prs; }
        const float rstd = 1.0f / sqrtf(row_sum16(s) * (1.f / D) + NORM_EPS);
        GAS v2u* o8 = (GAS v2u*)(XN + (size_t)m * D) + c;
        f32x4 ga = (f32x4){0.f, 0.f, 0.f, 0.f};
#pragma unroll
        for (int k = 0; k < 16; ++k) { const f32x4 gk = GL[k * 16 + c]; const f32x4 w0 = WG[(k * 4 + 0) * 16 + c], w1 = WG[(k * 4 + 1) * 16 + c], w2 = WG[(k * 4 + 2) * 16 + c], w3 = WG[(k * 4 + 3) * 16 + c];
            v[k] = v[k] * rstd * gk; if (!NORMFOLD) { v2u w; w.x = pk2(v[k].x, v[k].y); w.y = pk2(v[k].z, v[k].w); o8[16 * k] = w; }
            ga += w0 * v[k].x; ga += w1 * v[k].y; ga += w2 * v[k].z; ga += w3 * v[k].w; }
        float gl[4];
#pragma unroll
        for (int q = 0; q < 4; ++q) gl[q] = row_sum16(ga[q]) + brg[q];
        int gt = 0; float gm = gl[0];
#pragma unroll
        for (int q = 1; q < 4; ++q) if (gl[q] > gm) { gm = gl[q]; gt = q; }
        float gden = 0.f;
#pragma unroll
        for (int q = 0; q < 4; ++q) gden += expf(gl[q] - gm);
        const float p_top = 1.0f / gden;
        f32x4 a0 = (f32x4){0.f, 0.f, 0.f, 0.f}, a1 = a0;
        const LAS f32x4* we = WE + (gt * 16) * 8 * 16 + c;
        f32x4 wb[2][8];
#pragma unroll
        for (int q = 0; q < 8; ++q) wb[0][q] = we[q * 16];
#pragma unroll
        for (int k = 0; k < 16; ++k) {
            if (k < 15) {
#pragma unroll
                for (int q = 0; q < 8; ++q) wb[(k + 1) & 1][q] = we[((k + 1) * 8 + q) * 16]; }
            __builtin_amdgcn_sched_barrier(0);
            a0 += wb[k & 1][0] * v[k].x; a1 += wb[k & 1][1] * v[k].x;
            a0 += wb[k & 1][2] * v[k].y; a1 += wb[k & 1][3] * v[k].y;
            a0 += wb[k & 1][4] * v[k].z; a1 += wb[k & 1][5] * v[k].z;
            a0 += wb[k & 1][6] * v[k].w; a1 += wb[k & 1][7] * v[k].w;
            __builtin_amdgcn_sched_barrier(0); }
        const f32x4 bl0 = *(const LAS f32x4*)(F.lds + BRE_OFF + gt * 32), bl1 = *(const LAS f32x4*)(F.lds + BRE_OFF + gt * 32 + 16);
        float el[8];
#pragma unroll
        for (int q = 0; q < 4; ++q) { el[q] = row_sum16(a0[q]) + bl0[q]; el[4 + q] = row_sum16(a1[q]) + bl1[q]; }
        int i1 = 0; float m1 = el[0];
#pragma unroll
        for (int q = 1; q < 8; ++q) if (el[q] > m1) { m1 = el[q]; i1 = q; }
        int i2 = -1; float m2 = -3.0e38f;
#pragma unroll
        for (int q = 0; q < 8; ++q) if (q != i1 && el[q] > m2) { m2 = el[q]; i2 = q; }
        const float q1 = 1.0f, q2 = expf(m2 - m1);
        const float wn1 = p_top * q1 / (q1 + q2), wn2 = p_top * q2 / (q1 + q2);
        if (c == 0) {
            pe1 = gt * 8 + i1; pe2 = gt * 8 + i2; pw1 = wn1; pw2 = wn2; pm = m; prs = rstd;
            pr1 = __hip_atomic_fetch_add((LAS int*)hist + pe1, 1, __ATOMIC_RELAXED, __HIP_MEMORY_SCOPE_WORKGROUP);
            pr2 = __hip_atomic_fetch_add((LAS int*)hist + pe2, 1, __ATOMIC_RELAXED, __HIP_MEMORY_SCOPE_WORKGROUP);
        }
    }
    if (c == 0 && pm >= 0) { tok_e[2 * pm] = pe1; tok_e[2 * pm + 1] = pe2; tok_w[2 * pm] = pw1; tok_w[2 * pm + 1] = pw2; tok_r[2 * pm] = pr1; tok_r[2 * pm + 1] = pr2; if (NORMFOLD) rsf[pm] = prs; }
    __syncthreads();
    if (F.tid < 32) ((int*)(F.ws + WS_WGCNT))[blockIdx.x * 32 + F.tid] = hist[F.tid];
}
#endif
__device__ __forceinline__ void phase_dispatch(Frame& F) {
    const int gw = F.vcu * NWAVES + F.wave, NGW = F.G * NWAVES, lane = F.lane;
    volatile LAS int* sbase = (volatile LAS int*)(F.lds + SBASE_OFF); volatile LAS int* stot = (volatile LAS int*)(F.lds + STOT_OFF);
    const int* wgcnt = (const int*)(F.ws + WS_WGCNT); int* meta = (int*)(F.ws + WS_META);
    {
        volatile LAS int* part = (volatile LAS int*)(F.lds + RING_OFF);
        const int e = F.tid & 31, sl = F.tid >> 5; int tot = 0, base = 0;
        for (int w = sl; w < F.G; w += 16) { const int c = wgcnt[w * 32 + e]; tot += c; if (w < (int)blockIdx.x) base += c; }
        part[sl * 32 + e] = tot; part[512 + sl * 32 + e] = base;
        __syncthreads();
        if (F.tid < 32) { int t2 = 0, b2 = 0;
#pragma unroll
            for (int k = 0; k < 16; ++k) { t2 += part[k * 32 + F.tid]; b2 += part[512 + k * 32 + F.tid]; }
            stot[F.tid] = t2; sbase[F.tid] = b2; } }
    __syncthreads();
    if (F.tid == 0) { int run = 0, nrt = 0;
        for (int e = 0; e < NEXP; ++e) { const int nt = (stot[e] + 255) >> 8; sbase[e] = sbase[e] + run;
            if (blockIdx.x == 0) for (int k = 0; k < nt; ++k) meta[1 + nrt + k] = e;
            nrt += nt; run += nt * 256; }
        if (blockIdx.x == 0) meta[0] = nrt; }
    __syncthreads();
    const int* tok_e = (const int*)(F.ws + WS_TOKE); const int* tok_r = (const int*)(F.ws + WS_TOKR); int* tok_p = (int*)(F.ws + WS_TOKP);
    int* stok = (int*)(F.ws + WS_STOK);
    if (F.tid < T / F.G) {
#if ROUTE4
        const int m = 4 * ((F.tid >> 5) * NGW + F.vcu * NWAVES + ((F.tid >> 2) & 7)) + (F.tid & 3);
#else
        const int m = (F.tid >> 3) * NGW + F.vcu * NWAVES + (F.tid & 7);
#endif
        const int e1 = VLD(tok_e + 2 * m), e2 = VLD(tok_e + 2 * m + 1);
        const int p1 = sbase[e1] + VLD(tok_r + 2 * m), p2 = sbase[e2] + VLD(tok_r + 2 * m + 1);
        tok_p[2 * m] = p1; tok_p[2 * m + 1] = p2; stok[p1] = m; stok[p2] = m;
        if (NORMFOLD) { const float rr = VLD((const float*)(F.ws + WS_RSF) + m); float* rss = (float*)(F.ws + WS_RSS); rss[p1] = rr; rss[p2] = rr; } }
    (void)gw; (void)lane;
}
__device__ __forceinline__ void phase_combine(Frame& F, const float* g, bool last, const void* xsrc, void* xdst) {
    const int gw = F.vcu * NWAVES + F.wave, NGW = F.G * NWAVES, lane = F.lane;
    const int* tok_p = (const int*)(F.ws + WS_TOKP); const float* tok_w = (const float*)(F.ws + WS_TOKW);
    const bf16* Y = (const bf16*)(F.ws + WS_XP); bf16* XN = (bf16*)(F.ws + WS_XN);
#if XBF16
    typedef v2u xraw_t; const bf16* X = (const bf16*)xsrc;
#define PC_CVT(w_) ((f32x4){bflo((w_).x), bfhi((w_).x), bflo((w_).y), bfhi((w_).y)})
#else
    typedef f32x4 xraw_t; const float* X = (const float*)xsrc;
#define PC_CVT(w_) (w_)
#endif
    f32x4 gv[4];
#pragma unroll
    for (int j = 0; j < 4; ++j) gv[j] = *(const f32x4*)(g + 4 * lane + 256 * j);
    float cw1, cw2, dw1 = 0.f, dw2 = 0.f; xraw_t xn_[4], xm_[4]; v2u ya_[4], yb_[4], yc_[4], yd_[4];
    { const int p1 = VLD(tok_p + 2 * gw), p2 = VLD(tok_p + 2 * gw + 1); cw1 = VLD(tok_w + 2 * gw); cw2 = VLD(tok_w + 2 * gw + 1);
      const GAS xraw_t* xr = (const GAS xraw_t*)(X + (size_t)gw * D) + lane; const GAS v2u* y1 = (const GAS v2u*)(Y + (size_t)p1 * D) + lane; const GAS v2u* y2 = (const GAS v2u*)(Y + (size_t)p2 * D) + lane;
#pragma unroll
      for (int j = 0; j < 4; ++j) { xn_[j] = xr[64 * j]; ya_[j] = y1[64 * j]; yb_[j] = y2[64 * j]; } }
    if (gw + NGW < T) { const int mn = gw + NGW; const int p1 = VLD(tok_p + 2 * mn), p2 = VLD(tok_p + 2 * mn + 1); dw1 = VLD(tok_w + 2 * mn); dw2 = VLD(tok_w + 2 * mn + 1);
      const GAS xraw_t* xr = (const GAS xraw_t*)(X + (size_t)mn * D) + lane; const GAS v2u* y1 = (const GAS v2u*)(Y + (size_t)p1 * D) + lane; const GAS v2u* y2 = (const GAS v2u*)(Y + (size_t)p2 * D) + lane;
#pragma unroll
      for (int j = 0; j < 4; ++j) { xm_[j] = xr[64 * j]; yc_[j] = y1[64 * j]; yd_[j] = y2[64 * j]; } }
    int tp1 = 0, tp2 = 0; float tw1 = 0.f, tw2 = 0.f;
    if (gw + 2 * NGW < T) { const int mn = gw + 2 * NGW; tp1 = VLD(tok_p + 2 * mn); tp2 = VLD(tok_p + 2 * mn + 1); tw1 = VLD(tok_w + 2 * mn); tw2 = VLD(tok_w + 2 * mn + 1); }
    float prsd = 0.f; f32x4 po[4]; v2u pox[4], pon[4]; int pm = -1;
#pragma unroll
    for (int j = 0; j < 4; ++j) { po[j] = (f32x4){0.f, 0.f, 0.f, 0.f}; pox[j] = (v2u){0u, 0u}; pon[j] = (v2u){0u, 0u}; }
#if XBF16
#define PC_FLUSH() do { if (pm >= 0) { if (last) { GAS f32x4* xr_ = (GAS f32x4*)(F.out + (size_t)pm * D) + lane; _Pragma("unroll") for (int j = 0; j < 4; ++j) xr_[64 * j] = po[j]; } \
        else { GAS v2u* o8_ = (GAS v2u*)(XN + (size_t)pm * D) + lane; GAS v2u* xo_ = (GAS v2u*)((bf16*)xdst + (size_t)pm * D) + lane; _Pragma("unroll") for (int j = 0; j < 4; ++j) { xo_[64 * j] = pox[j]; if (!NORMFOLD) o8_[64 * j] = pon[j]; } \
            if (NORMFOLD && lane == 0) ((float*)(F.ws + WS_RSA))[pm] = prsd; } } } while (0)
#else
#define PC_FLUSH() do { if (pm >= 0) { if (last) { GAS f32x4* xr_ = (GAS f32x4*)(F.out + (size_t)pm * D) + lane; _Pragma("unroll") for (int j = 0; j < 4; ++j) xr_[64 * j] = po[j]; } \
        else { GAS v2u* o8_ = (GAS v2u*)(XN + (size_t)pm * D) + lane; GAS f32x4* xo_ = (GAS f32x4*)((float*)xdst + (size_t)pm * D) + lane; _Pragma("unroll") for (int j = 0; j < 4; ++j) { xo_[64 * j] = po[j]; o8_[64 * j] = pon[j]; } } } } while (0)
#endif
    for (int m = gw; m < T; m += NGW) {
        const float w1 = cw1, w2 = cw2;
        f32x4 v[4]; float s = 0.f;
#pragma unroll
        for (int j = 0; j < 4; ++j) { const v2u a = ya_[j], b = yb_[j];
            const f32x4 ya = (f32x4){bflo(a.x), bfhi(a.x), bflo(a.y), bfhi(a.y)}, yb = (f32x4){bflo(b.x), bfhi(b.x), bflo(b.y), bfhi(b.y)};
            v[j] = PC_CVT(xn_[j]) + (ya * w1 + yb * w2);
            s += (v[j].x * v[j].x + v[j].y * v[j].y) + (v[j].z * v[j].z + v[j].w * v[j].w);
            xn_[j] = xm_[j]; ya_[j] = yc_[j]; yb_[j] = yd_[j]; }
        cw1 = dw1; cw2 = dw2; dw1 = tw1; dw2 = tw2;
        if (m + 2 * NGW < T) { const int mn = m + 2 * NGW;
            const GAS xraw_t* xq = (const GAS xraw_t*)(X + (size_t)mn * D) + lane; const GAS v2u* y1 = (const GAS v2u*)(Y + (size_t)tp1 * D) + lane; const GAS v2u* y2 = (const GAS v2u*)(Y + (size_t)tp2 * D) + lane;
#pragma unroll
            for (int j = 0; j < 4; ++j) { xm_[j] = xq[64 * j]; yc_[j] = y1[64 * j]; yd_[j] = y2[64 * j]; } }
        if (m + 3 * NGW < T) { const int mn = m + 3 * NGW; tp1 = VLD(tok_p + 2 * mn); tp2 = VLD(tok_p + 2 * mn + 1); tw1 = VLD(tok_w + 2 * mn); tw2 = VLD(tok_w + 2 * mn + 1); }
        PC_FLUSH();
        const float rstd = 1.0f / sqrtf(wave_sum(s) * (1.f / D) + NORM_EPS);
        pm = m;
        if (last) {
#pragma unroll
            for (int j = 0; j < 4; ++j) po[j] = v[j] * rstd * gv[j];
        } else {
            if (NORMFOLD) prsd = rstd;
#pragma unroll
            for (int j = 0; j < 4; ++j) { const f32x4 y = v[j] * rstd * gv[j]; pon[j].x = pk2(y.x, y.y); pon[j].y = pk2(y.z, y.w);
#if XBF16
                pox[j].x = pk2(v[j].x, v[j].y); pox[j].y = pk2(v[j].z, v[j].w);
#else
                po[j] = v[j];
#endif
            }
        }
    }
    PC_FLUSH();
#undef PC_FLUSH
#undef PC_CVT
}

#if defined(__HIP_DEVICE_COMPILE__)
typedef float f32x4v __attribute__((ext_vector_type(4)));
typedef short v4i16_t __attribute__((ext_vector_type(4)));
__device__ __forceinline__ f32x4 mfma16(const bf16x8& a, const bf16x8& b, const f32x4& c) { return __builtin_amdgcn_mfma_f32_16x16x32_bf16(a, b, c, 0, 0, 0); }
__device__ __forceinline__ s16x4 tr_read(const LAS unsigned char* p) { return __builtin_bit_cast(s16x4, __builtin_amdgcn_ds_read_tr16_b64_v4i16((LAS v4i16_t*)p)); }
__device__ __forceinline__ bf16x8 join8(const s16x4& a, const s16x4& b) { bf16x8 r; r[0] = a[0]; r[1] = a[1]; r[2] = a[2]; r[3] = a[3]; r[4] = b[0]; r[5] = b[1]; r[6] = b[2]; r[7] = b[3]; return r; }
__device__ __forceinline__ bf16x8 pack_frag(const float (&v)[8]) { v4u w; w.x = cvt_pk_bf16(v[0], v[1]); w.y = cvt_pk_bf16(v[2], v[3]); w.z = cvt_pk_bf16(v[4], v[5]); w.w = cvt_pk_bf16(v[6], v[7]); return __builtin_bit_cast(bf16x8, w); }
template <int N> __device__ __forceinline__ float dpp_shr_t(float v) { return __builtin_bit_cast(float, __builtin_amdgcn_update_dpp(0, __builtin_bit_cast(int, v), 0x110 + N, 0xf, 0xf, true)); }
template <int N> __device__ __forceinline__ float dpp_ror_t(float v) { return __builtin_bit_cast(float, __builtin_amdgcn_update_dpp(0, __builtin_bit_cast(int, v), 0x120 + N, 0xf, 0xf, false)); }
__device__ __forceinline__ float rowsum16(float v) { v += dpp_ror_t<8>(v); v += dpp_ror_t<4>(v); v += dpp_ror_t<2>(v); v += dpp_ror_t<1>(v); return v; }
__device__ __forceinline__ float scan16(float v) { v += dpp_shr_t<1>(v); v += dpp_shr_t<2>(v); v += dpp_shr_t<4>(v); v += dpp_shr_t<8>(v); return v; }

constexpr int AT_PITCH = 160;
constexpr int AT_KOFF = 0, AT_VOFF = 384 * AT_PITCH;
__device__ __forceinline__ void attn_stage_load(Frame& F, int unit, v4u (&st)[12]) {
    const int b = unit >> 8, kvh = (unit >> 7) & 1, Q0 = (unit & 127) * 128; const bf16* PA = (const bf16*)(F.ws + WS_PA);
#pragma unroll
    for (int k = 0; k < 12; ++k) { const int idx = F.tid + 512 * k, kv = idx / (384 * 8), r = (idx >> 3) % 384, ch = idx & 7, key = Q0 - 128 + r;
        st[k] = (v4u){0u, 0u, 0u, 0u};
        if (key >= 0 && key < SEQ) st[k] = *(const GAS v4u*)(PA + (size_t)(b * SEQ + key) * NPA + (kv ? C_VA : C_KA) + 64 * kvh + 8 * ch); }
}
__device__ __forceinline__ void attn_stage_write(Frame& F, const v4u (&st)[12]) {
    LAS unsigned char* lds = F.lds + RING_OFF;
#pragma unroll
    for (int k = 0; k < 12; ++k) { const int idx = F.tid + 512 * k, kv = idx / (384 * 8), r = (idx >> 3) % 384, ch = idx & 7;
        *(LAS v4u*)(lds + (kv ? AT_VOFF : AT_KOFF) + r * AT_PITCH + ch * 16) = st[k]; }
}
__device__ __forceinline__ void attn_unit(Frame& F, int unit, int next_unit, v4u (&st)[12], const float* sink) {
    const int b = unit >> 8, kvh = (unit >> 7) & 1, qb = unit & 127, Q0 = qb * 128;
    const bf16* PA = (const bf16*)(F.ws + WS_PA); bf16* YA = (bf16*)(F.ws + WS_Y);
    LAS unsigned char* lds = F.lds + RING_OFF;
    attn_stage_write(F, st);
    __syncthreads();
    const int lane = F.lane, w = F.wave, fr = lane & 15, g = lane >> 4, qh = 4 * kvh + (w >> 1);
    const float sk = sink[qh] * LOG2E;
    const bool edge = (qb == 0) || (qb == SEQ / 128 - 1);
    static_assert(WINDOW == 128, "interior-tile test below");
    bf16x8 qn0, qn1;
    { const bf16* qp = PA + (size_t)(b * SEQ + Q0 + 64 * (w & 1) + fr) * NPA + C_QA + 64 * qh + 8 * g; qn0 = *(const GAS bf16x8*)qp; qn1 = *(const GAS bf16x8*)(qp + 32); }
    if (next_unit >= 0) attn_stage_load(F, next_unit, st);
    v2u py[4]; bf16* pyp = YA;
#pragma unroll
    for (int dt = 0; dt < 4; ++dt) py[dt] = (v2u){0u, 0u};
    for (int qbk = 0; qbk < 4; ++qbk) {
        const int qrel = 64 * (w & 1) + 16 * qbk, q = Q0 + qrel + fr;
        const bf16x8 qf0 = qn0, qf1 = qn1;
        f32x4 s[17]; float mx = sk;
#pragma unroll
        for (int t = 0; t < 17; ++t) { const int krel = qrel + 16 * t;
            const LAS unsigned char* kp = lds + AT_KOFF + (krel + fr) * AT_PITCH + g * 16;
            f32x4 a = (f32x4){0.f, 0.f, 0.f, 0.f};
            a = mfma16(*(const LAS bf16x8*)kp, qf0, a); a = mfma16(*(const LAS bf16x8*)(kp + 64), qf1, a);
            s[t] = a; }
#define AT_MASK(t) do { _Pragma("unroll") for (int r = 0; r < 4; ++r) { const int key = Q0 - 128 + qrel + 16 * (t) + 4 * g + r; const int dlt = key - q; \
            const bool ok = (dlt >= -WINDOW) && (dlt <= WINDOW) && (key >= 0) && (key < SEQ); s[t][r] = ok ? s[t][r] : -3.0e38f; } } while (0)
        if (edge) {
#pragma unroll
            for (int t = 0; t < 17; ++t) AT_MASK(t);
        } else { AT_MASK(0); AT_MASK(16); }
#undef AT_MASK
#pragma unroll
        for (int t = 0; t < 17; ++t) mx = fmaxf(fmaxf(mx, fmaxf(s[t][0], s[t][1])), fmaxf(s[t][2], s[t][3]));
        __builtin_amdgcn_sched_barrier(0);
        if (qbk < 3) { const bf16* qp = PA + (size_t)(b * SEQ + q + 16) * NPA + C_QA + 64 * qh + 8 * g; qn0 = *(const GAS bf16x8*)qp; qn1 = *(const GAS bf16x8*)(qp + 32); }
        if (qbk > 0) {
#pragma unroll
            for (int dt = 0; dt < 4; ++dt) *(GAS v2u*)(pyp + 16 * dt) = py[dt]; }
        __builtin_amdgcn_sched_barrier(0);
        mx = fmaxf(mx, __shfl_xor(mx, 16)); mx = fmaxf(mx, __shfl_xor(mx, 32));
        float den = 0.f;
#pragma unroll
        for (int t = 0; t < 17; ++t)
#pragma unroll
            for (int r = 0; r < 4; ++r) { const float p = __builtin_amdgcn_exp2f(s[t][r] - mx); s[t][r] = p; den += p; }
        den += __shfl_xor(den, 16); den += __shfl_xor(den, 32); den += __builtin_amdgcn_exp2f(sk - mx);
        const float inv = 1.0f / den;
        f32x4 o[4];
#pragma unroll
        for (int dt = 0; dt < 4; ++dt) o[dt] = (f32x4){0.f, 0.f, 0.f, 0.f};
#pragma unroll
        for (int tp = 0; tp < 9; ++tp) { const int t0 = 2 * tp, t1 = (2 * tp + 1 < 17) ? 2 * tp + 1 : 2 * tp;
            float pv[8];
#pragma unroll
            for (int r = 0; r < 4; ++r) { pv[r] = s[t0][r]; pv[4 + r] = (2 * tp + 1 < 17) ? s[t1][r] : 0.f; }
            const bf16x8 pf = pack_frag(pv);
            const LAS unsigned char* v0 = lds + AT_VOFF + (qrel + 16 * t0 + 4 * g + (fr >> 2)) * AT_PITCH + (fr & 3) * 8;
            const LAS unsigned char* v1 = lds + AT_VOFF + (qrel + 16 * t1 + 4 * g + (fr >> 2)) * AT_PITCH + (fr & 3) * 8;
#pragma unroll
            for (int dt = 0; dt < 4; ++dt) o[dt] = mfma16(join8(tr_read(v0 + dt * 32), tr_read(v1 + dt * 32)), pf, o[dt]); }
        pyp = YA + (size_t)(b * SEQ + q) * 512 + 64 * qh + 4 * g;
#pragma unroll
        for (int dt = 0; dt < 4; ++dt) { py[dt].x = cvt_pk_bf16(o[dt][0] * inv, o[dt][1] * inv); py[dt].y = cvt_pk_bf16(o[dt][2] * inv, o[dt][3] * inv); }
    }
#pragma unroll
    for (int dt = 0; dt < 4; ++dt) *(GAS v2u*)(pyp + 16 * dt) = py[dt];
    __syncthreads();
}
constexpr int HG_PITCH = 288;
constexpr int HG_V = 0, HG_KF = 128 * HG_PITCH, HG_KB = 2 * 128 * HG_PITCH, HG_TOT = 3 * 128 * HG_PITCH;
static_assert(HG_TOT + (4 * 8 * 128 + 256) * 4 <= RING_BYTES, "hgrn LDS");
__device__ __forceinline__ void hg_load_scan8(const bf16* p8  , float (&lf)[8], float (&P)[8], float (&T)[8], int lane) {
    const h16x8 hv = *(const GAS h16x8*)p8;
#pragma unroll
    for (int jj = 0; jj < 8; ++jj) { lf[jj] = (float)hv[jj]; P[jj] = scan16(lf[jj]); T[jj] = __shfl(P[jj], (lane & 48) | 15); }
}
__device__ __forceinline__ void hg_v_load(Frame& F, int b, int h, int t0, v4u (&vst)[4]) { const bf16* PA = (const bf16*)(F.ws + WS_PA);
#pragma unroll
    for (int k = 0; k < 4; ++k) { const int idx = F.tid + 512 * k, r = idx >> 4, ch = idx & 15; vst[k] = *(const GAS v4u*)(PA + (size_t)(b * SEQ + t0 + r) * NPA + C_VH + 128 * h + 8 * ch); } }
__device__ __forceinline__ void hg_v_write(Frame& F, const v4u (&vst)[4]) { LAS unsigned char* lds = F.lds + RING_OFF;
#pragma unroll
    for (int k = 0; k < 4; ++k) { const int idx = F.tid + 512 * k, r = idx >> 4, ch = idx & 15; *(LAS v4u*)(lds + HG_V + r * HG_PITCH + ch * 16) = vst[k]; } }
__device__ __forceinline__ void ha_decay_load(Frame& F, int unit, h16x8 (&hvv)[8]) {
    const int bh = unit >> 7, n = unit & 127, b = bh >> 2, h = bh & 3, t0 = n * CH, lane = F.lane, w = F.wave, fr = lane & 15, g = lane >> 4, dir = w >> 2, dq = w & 3;
    const bf16* lp = (const bf16*)(F.ws + WS_PA) + (size_t)(b * SEQ + t0 + fr) * NPA + (dir ? C_LB : C_LF) + 128 * h + 32 * dq + 8 * g;
#pragma unroll
    for (int k = 0; k < 8; ++k) { const int j = dir ? k : (7 - k); hvv[k] = *(const GAS h16x8*)(lp + (size_t)(16 * j) * NPA); }
}
__device__ __forceinline__ void ha_unit(Frame& F, int unit, int next_unit, v4u (&vst)[4], h16x8 (&hvv)[8]) {
    const int bh = unit >> 7, n = unit & 127, b = bh >> 2, h = bh & 3, t0 = n * CH;
    const bf16* PA = (const bf16*)(F.ws + WS_PA); bf16* US = (bf16*)(F.ws + WS_US); float* HD = (float*)(F.ws + WS_HD);
    LAS unsigned char* lds = F.lds + RING_OFF;
    const int lane = F.lane, w = F.wave, fr = lane & 15, g = lane >> 4, dir = w >> 2, dq = w & 3;
    hg_v_write(F, vst);
    if (next_unit >= 0) { const int bh2 = next_unit >> 7; hg_v_load(F, bh2 >> 2, bh2 & 3, (next_unit & 127) * CH, vst); }
    float run[8];
#pragma unroll
    for (int jj = 0; jj < 8; ++jj) run[jj] = 0.f;
    __builtin_amdgcn_sched_barrier(0);
#pragma unroll
    for (int k = 0; k < 8; ++k) { const int j = dir ? k : (7 - k);
        float kv[8];
#pragma unroll
        for (int jj = 0; jj < 8; ++jj) { const float lf = (float)hvv[k][jj], P = scan16(lf), Tt = __shfl(P, (lane & 48) | 15);
            const float wi = dir ? (P - lf) : (Tt - P); kv[jj] = (1.0f - __builtin_amdgcn_exp2f(lf)) * __builtin_amdgcn_exp2f(wi + run[jj]); run[jj] += Tt; }
        *(LAS bf16x8*)(lds + (dir ? HG_KB : HG_KF) + (16 * j + fr) * HG_PITCH + (32 * dq + 8 * g) * 2) = pack_frag(kv); }
    __builtin_amdgcn_sched_barrier(0);
    if (next_unit >= 0) ha_decay_load(F, next_unit, hvv);
    __builtin_amdgcn_sched_barrier(0);
    if (fr == 0) {
#pragma unroll
        for (int jj = 0; jj < 8; ++jj) HD[((size_t)(bh * 2 + dir) * NCH + n) * 128 + 32 * dq + 8 * g + jj] = __builtin_amdgcn_exp2f(run[jj]); }
    __syncthreads();
    f32x4 acc[2][8];
#pragma unroll
    for (int mt = 0; mt < 2; ++mt)
#pragma unroll
        for (int nt = 0; nt < 8; ++nt) acc[mt][nt] = (f32x4){0.f, 0.f, 0.f, 0.f};
    const LAS unsigned char* kb = lds + (dir ? HG_KB : HG_KF) + (4 * g + (fr >> 2)) * HG_PITCH + (fr & 3) * 8;
    const LAS unsigned char* vb = lds + HG_V + (4 * g + (fr >> 2)) * HG_PITCH + (fr & 3) * 8;
#pragma unroll
    for (int ks = 0; ks < 4; ++ks) { bf16x8 af[2];
#pragma unroll
        for (int mt = 0; mt < 2; ++mt) { const LAS unsigned char* p = kb + (32 * ks) * HG_PITCH + (16 * (2 * dq + mt)) * 2; af[mt] = join8(tr_read(p), tr_read(p + 16 * HG_PITCH)); }
#pragma unroll
        for (int nt = 0; nt < 8; ++nt) { const LAS unsigned char* p = vb + (32 * ks) * HG_PITCH + (16 * nt) * 2; const bf16x8 bfr = join8(tr_read(p), tr_read(p + 16 * HG_PITCH));
#pragma unroll
            for (int mt = 0; mt < 2; ++mt) acc[mt][nt] = mfma16(af[mt], bfr, acc[mt][nt]); } }
    bf16* up = US + ((size_t)(bh * 2 + dir) * NCH + n) * 128 * 128;
#pragma unroll
    for (int mt = 0; mt < 2; ++mt)
#pragma unroll
        for (int nt = 0; nt < 8; ++nt) { v2u wv; wv.x = cvt_pk_bf16(acc[mt][nt][0], acc[mt][nt][1]); wv.y = cvt_pk_bf16(acc[mt][nt][2], acc[mt][nt][3]);
            *(GAS v2u*)(up + (size_t)(16 * nt + fr) * 128 + 16 * (2 * dq + mt) + 4 * g) = wv; }
    __syncthreads();
}
#if G1A_SPLIT
__device__ __forceinline__ void phase_hb(Frame& F, int v, int g) {
    bf16* US = (bf16*)(F.ws + WS_US); const float* HD = (const float*)(F.ws + WS_HD);
    const int stride = g * NWAVES * 64, TOT = 16 * 128 * 64;
    for (int ea = v * (NWAVES * 64) + F.tid; ea < TOT; ea += 2 * stride) {
        const bool two = G1A_SPLIT && (ea + stride < TOT); const int eb = two ? ea + stride : ea;
        const int dpa = ea & 63, ca = ea >> 13, dira = ca & 1, dpb = eb & 63, cb = eb >> 13, dirb = cb & 1;
        float a0 = 0.f, a1 = 0.f, b0 = 0.f, b1 = 0.f;
        GAS unsigned* upa = (GAS unsigned*)(US + (size_t)ca * NCH * 128 * 128 + (size_t)((ea >> 6) & 127) * 128) + dpa; const GAS pg8::f32x2_t* dda = (const GAS pg8::f32x2_t*)((const GAS float*)HD + (size_t)ca * NCH * 128) + dpa;
        GAS unsigned* upb = (GAS unsigned*)(US + (size_t)cb * NCH * 128 * 128 + (size_t)((eb >> 6) & 127) * 128) + dpb; const GAS pg8::f32x2_t* ddb = (const GAS pg8::f32x2_t*)((const GAS float*)HD + (size_t)cb * NCH * 128) + dpb;
        for (int k0 = 0; k0 < NCH; k0 += 16) {
            unsigned ua[16], ub[16]; pg8::f32x2_t da[16], db[16];
#pragma unroll
            for (int k = 0; k < 16; ++k) { const int na = dira ? (NCH - 1 - (k0 + k)) : (k0 + k), nb = dirb ? (NCH - 1 - (k0 + k)) : (k0 + k);
                ua[k] = upa[(size_t)na * (128 * 128 / 2)]; da[k] = dda[na * 64]; ub[k] = upb[(size_t)nb * (128 * 128 / 2)]; db[k] = ddb[nb * 64]; }
#pragma unroll
            for (int k = 0; k < 16; ++k) { const int na = dira ? (NCH - 1 - (k0 + k)) : (k0 + k), nb = dirb ? (NCH - 1 - (k0 + k)) : (k0 + k);
                upa[(size_t)na * (128 * 128 / 2)] = pk2(a0, a1);
                a0 = da[k].x * a0 + bflo(ua[k]); a1 = da[k].y * a1 + bfhi(ua[k]);
                if (two) upb[(size_t)nb * (128 * 128 / 2)] = pk2(b0, b1);
                b0 = db[k].x * b0 + bflo(ub[k]); b1 = db[k].y * b1 + bfhi(ub[k]); } }
    }
}
#else
__device__ __forceinline__ void phase_hb(Frame& F, int v, int g) {
    bf16* US = (bf16*)(F.ws + WS_US); const float* HD = (const float*)(F.ws + WS_HD);
    const int idx = v * (NWAVES * 64) + F.tid;
    for (int e0 = idx; e0 < 16 * 128 * 64; e0 += g * NWAVES * 64) { const int dp = e0 & 63, e = (e0 >> 6) & 127, combo = e0 >> 13, dir = combo & 1;
        float s0 = 0.f, s1 = 0.f;
        GAS unsigned* up = (GAS unsigned*)(US + (size_t)combo * NCH * 128 * 128 + (size_t)e * 128) + dp; const GAS float* dpp = (const GAS float*)HD + (size_t)combo * NCH * 128 + 2 * dp;
        for (int k0 = 0; k0 < NCH; k0 += 16) {
            unsigned u[16]; float d0[16], d1[16];
#pragma unroll
            for (int k = 0; k < 16; ++k) { const int n = dir ? (NCH - 1 - (k0 + k)) : (k0 + k); u[k] = up[(size_t)n * (128 * 128 / 2)]; d0[k] = dpp[n * 128]; d1[k] = dpp[n * 128 + 1]; }
#pragma unroll
            for (int k = 0; k < 16; ++k) { const int n = dir ? (NCH - 1 - (k0 + k)) : (k0 + k);
                up[(size_t)n * (128 * 128 / 2)] = pk2(s0, s1);
                s0 = d0[k] * s0 + bflo(u[k]); s1 = d1[k] * s1 + bfhi(u[k]); } }
    }
}
#endif
constexpr int HC_SPITCH = 272;
constexpr int HC_K = 128 * HG_PITCH, HC_S = 2 * 128 * HG_PITCH, HC_E = HC_S + 128 * HC_SPITCH;
static_assert(HC_E + 2 * 8 * 128 * 4 <= RING_BYTES, "hc LDS");
#ifndef HC_TERMS
#define HC_TERMS 7
#endif
__device__ __forceinline__ void hc_unit(Frame& F, int unit, int next_unit, v4u (&vst)[4], const float* hng) {
    const int h = unit & 3, n = (unit >> 2) & 127, b = unit >> 9, bh = b * 4 + h, t0 = n * CH;
    const bf16* PA = (const bf16*)(F.ws + WS_PA); const bf16* US = (const bf16*)(F.ws + WS_US); bf16* YH = (bf16*)(F.ws + WS_YH); float* ssq = (float*)(F.ws + WS_SSQ);
    LAS unsigned char* lds = F.lds + RING_OFF; LAS float* ebl = (LAS float*)(lds + HC_E);
    const int lane = F.lane, i = F.wave, fr = lane & 15, g = lane >> 4;
    const size_t trow = (size_t)(b * SEQ + t0 + 16 * i + fr);
    hg_v_write(F, vst);
    if (next_unit >= 0) hg_v_load(F, next_unit >> 9, next_unit & 3, ((next_unit >> 2) & 127) * CH, vst);
    const bf16* sbase0 = US + ((size_t)(bh * 2) * NCH + n) * 128 * 128;
    v4u sreg[4];
#pragma unroll
    for (int k = 0; k < 4; ++k) { const int c = F.tid + 512 * k; sreg[k] = *(const GAS v4u*)(sbase0 + (size_t)(c >> 4) * 128 + (c & 15) * 8); }
    h16x8 lfv[2][4]; v4u qwv[4];
#pragma unroll
    for (int ks = 0; ks < 4; ++ks) { lfv[0][ks] = *(const GAS h16x8*)(PA + trow * NPA + C_LF + 128 * h + 32 * ks + 8 * g); qwv[ks] = *(const GAS v4u*)(PA + trow * NPA + C_QH + 128 * h + 32 * ks + 8 * g); }
#pragma unroll
    for (int ks = 0; ks < 4; ++ks) lfv[1][ks] = *(const GAS h16x8*)(PA + trow * NPA + C_LB + 128 * h + 32 * ks + 8 * g);
    __builtin_amdgcn_sched_barrier(0);
    f32x4 o[8];
#pragma unroll
    for (int et = 0; et < 8; ++et) o[et] = (f32x4){0.f, 0.f, 0.f, 0.f};
    const LAS unsigned char* vtr = lds + HG_V + (4 * g + (fr >> 2)) * HG_PITCH + (fr & 3) * 8;
#pragma unroll
    for (int dir = 0; dir < 2; ++dir) {
        if (dir == 1) __syncthreads();
#pragma unroll
        for (int k = 0; k < 4; ++k) { const int c = F.tid + 512 * k; *(LAS v4u*)(lds + HC_S + (c >> 4) * HC_SPITCH + (c & 15) * 16) = sreg[k]; }
        float ql[32]; bf16x8 kst[4]; bf16x8 qf[4];
#pragma unroll
        for (int ks = 0; ks < 4; ++ks) { float lf[8], P[8], T[8], ke[8], kd[8], t8[8], et_[8];
            { const h16x8 hv = lfv[dir][ks];
#pragma unroll
              for (int jj = 0; jj < 8; ++jj) { lf[jj] = (float)hv[jj]; P[jj] = scan16(lf[jj]); T[jj] = __shfl(P[jj], (lane & 48) | 15); } }
            const v4u qw = qwv[ks];
            const float qv[8] = {bflo(qw.x), bfhi(qw.x), bflo(qw.y), bfhi(qw.y), bflo(qw.z), bfhi(qw.z), bflo(qw.w), bfhi(qw.w)};
#pragma unroll
            for (int jj = 0; jj < 8; ++jj) { const float kk = 1.0f - __builtin_amdgcn_exp2f(lf[jj]);
                const float binc = dir ? (T[jj] - P[jj] + lf[jj]) : P[jj];
                const float ea = __builtin_amdgcn_exp2f(binc), ra = __builtin_amdgcn_rcpf(ea); et_[jj] = __builtin_amdgcn_exp2f(T[jj]);
                ql[8 * ks + jj] = qv[jj] * ea; t8[jj] = ql[8 * ks + jj]; ke[jj] = kk * et_[jj] * ra; kd[jj] = kk * ra;
#if defined(HC_DBG) && HC_DBG >= 3
                ql[8 * ks + jj] = qv[jj]; t8[jj] = qv[jj]; kd[jj] = kk;
                if (HC_DBG == 4) kd[jj] = (32 * ks + 8 * g + jj == 0) ? 1.0f : 0.f;
                if (HC_DBG == 5) kd[jj] = (32 * ks + 8 * g + jj == 0) ? kk : 0.f;
                if (HC_DBG >= 9) kd[jj] = 0.f;
                if (HC_DBG == 8) kd[jj] = (32 * ks + 8 * g + jj == 0) ? (float)fr : 0.f;
                if (HC_DBG == 6) kd[jj] = (32 * ks + 8 * g + jj == 0) ? lf[jj] : 0.f;
                if (HC_DBG == 7) kd[jj] = (32 * ks + 8 * g + jj == 0) ? (1.0f - __expf(lf[jj])) : 0.f;
#endif
                }
            *(LAS bf16x8*)(lds + HC_K + (16 * i + fr) * HG_PITCH + (32 * ks + 8 * g) * 2) = pack_frag(ke);
            kst[ks] = pack_frag(kd); qf[ks] = pack_frag(t8);
            if (fr == 0) {
#pragma unroll
                for (int jj = 0; jj < 8; ++jj) ebl[(dir * 8 + i) * 128 + 32 * ks + 8 * g + jj] = et_[jj]; }
            __builtin_amdgcn_sched_barrier(0); }
        __syncthreads();
        if (dir == 0) {
#pragma unroll
            for (int k = 0; k < 4; ++k) { const int c = F.tid + 512 * k; sreg[k] = *(const GAS v4u*)(sbase0 + (size_t)NCH * 128 * 128 + (size_t)(c >> 4) * 128 + (c & 15) * 8); } }
        f32x4 at = (f32x4){0.f, 0.f, 0.f, 0.f};
#pragma unroll
        for (int ks = 0; ks < 4; ++ks) at = mfma16(kst[ks], qf[ks], at);
#if defined(HC_DBG) && HC_DBG >= 9
        { const float q0 = __shfl(ql[0], fr);
          for (int r = 0; r < 4; ++r) at[r] = (HC_DBG == 9) ? (float)(4 * g + r) * q0 : ((HC_DBG == 10) ? (float)(4 * g + r) : (float)fr); }
#endif
        float pend[4]; int jpend = i;
#pragma unroll
        for (int r = 0; r < 4; ++r) { const int s = 4 * g + r; const bool keep = (HC_TERMS & 1) && (dir ? (s >= fr) : (s <= fr)); pend[r] = keep ? at[r] : 0.f;
#if defined(HC_DBG) && HC_DBG == 1
            pend[r] = (dir == 0 && s == fr) ? 1.0f : 0.f;
#endif
            }
        bool have = true;
        const int nj = dir ? (7 - i) : i;
        for (int k = 0; k < nj; ++k) { const int j = dir ? (i + 1 + k) : (i - 1 - k);
            f32x4 a2 = (f32x4){0.f, 0.f, 0.f, 0.f};
            const LAS unsigned char* kp = lds + HC_K + (16 * j + fr) * HG_PITCH + g * 16;
#pragma unroll
            for (int ks = 0; ks < 4; ++ks) a2 = mfma16(*(const LAS bf16x8*)(kp + ks * 64), qf[ks], a2);
#pragma unroll
            for (int ks = 0; ks < 4; ++ks) { const LAS float* ep = ebl + (dir * 8 + j) * 128 + 32 * ks + 8 * g; float t8[8];
#pragma unroll
                for (int jj = 0; jj < 8; ++jj) { ql[8 * ks + jj] *= ep[jj]; t8[jj] = ql[8 * ks + jj]; }
                qf[ks] = pack_frag(t8); }
            if (have) { float pv[8];
#pragma unroll
                for (int r = 0; r < 4; ++r) { pv[r] = pend[r]; pv[4 + r] = (HC_TERMS & 2) ? a2[r] : 0.f; }
                const bf16x8 pf = pack_frag(pv); const LAS unsigned char* v0 = vtr + 16 * jpend * HG_PITCH; const LAS unsigned char* v1 = vtr + 16 * j * HG_PITCH;
#pragma unroll
                for (int et = 0; et < 8; ++et) o[et] = mfma16(join8(tr_read(v0 + et * 32), tr_read(v1 + et * 32)), pf, o[et]);
                have = false;
            } else {
#pragma unroll
                for (int r = 0; r < 4; ++r) pend[r] = (HC_TERMS & 2) ? a2[r] : 0.f;
                jpend = j; have = true; }
        }
        if (have) { float pv[8];
#pragma unroll
            for (int r = 0; r < 4; ++r) { pv[r] = pend[r]; pv[4 + r] = 0.f; }
            const bf16x8 pf = pack_frag(pv); const LAS unsigned char* v0 = vtr + 16 * jpend * HG_PITCH;
#pragma unroll
            for (int et = 0; et < 8; ++et) o[et] = mfma16(join8(tr_read(v0 + et * 32), tr_read(v0 + et * 32)), pf, o[et]); }
        const LAS unsigned char* sp = lds + HC_S + fr * HC_SPITCH + g * 16;
#pragma unroll
        for (int et = 0; et < 8; ++et)
#pragma unroll
            for (int ks = 0; ks < 4; ++ks) if (HC_TERMS & 4) o[et] = mfma16(*(const LAS bf16x8*)(sp + 16 * et * HC_SPITCH + ks * 64), qf[ks], o[et]);
    }
    float sq = 0.f; bf16* yp = YH + trow * 512 + 128 * h + 4 * g; const bf16* sgp = PA + trow * NPA + C_SG + 128 * h + 4 * g; const float* gp = hng + 128 * h + 4 * g;
    v2u swv[8]; f32x4 gvv[8];
#pragma unroll
    for (int et = 0; et < 8; ++et) { swv[et] = *(const GAS v2u*)(sgp + 16 * et); gvv[et] = *(const GAS f32x4*)(gp + 16 * et); }
#pragma unroll
    for (int et = 0; et < 8; ++et) { const v2u sw = swv[et]; const f32x4 gv = gvv[et]; const f32x4 ov = o[et];
        sq += (ov[0] * ov[0] + ov[1] * ov[1]) + (ov[2] * ov[2] + ov[3] * ov[3]);
        v2u wv; wv.x = cvt_pk_bf16(ov[0] * gv[0] * bflo(sw.x), ov[1] * gv[1] * bfhi(sw.x)); wv.y = cvt_pk_bf16(ov[2] * gv[2] * bflo(sw.y), ov[3] * gv[3] * bfhi(sw.y));
        *(GAS v2u*)(yp + 16 * et) = wv; }
    sq += __shfl_xor(sq, 16); sq += __shfl_xor(sq, 32);
    if (g == 0) ssq[trow * 4 + h] = sq;
    __syncthreads();
}
__device__ __forceinline__ int attn_item_unit(int i) { return (i < 256) ? i : 256 + ((i + 64) & 255); }
__device__ __forceinline__ void phase_attn(Frame& F, const float* sink) { constexpr int NU = BATCH * NKVH * (SEQ / 128); v4u st[12];
    static_assert(NU == 512, "attn_item_unit");
    if (F.vcu < NU) attn_stage_load(F, attn_item_unit(F.vcu), st);
    for (int i = F.vcu; i < NU; i += F.G) attn_unit(F, attn_item_unit(i), (i + F.G < NU) ? attn_item_unit(i + F.G) : -1, st, sink); }
__device__ __forceinline__ void phase_ha(Frame& F) { constexpr int NU = BATCH * HH * NCH; v4u vst[4]; h16x8 hvv[8];
    if (F.vcu < NU) { const int bh = F.vcu >> 7; hg_v_load(F, bh >> 2, bh & 3, (F.vcu & 127) * CH, vst); ha_decay_load(F, F.vcu, hvv); }
    for (int u = F.vcu; u < NU; u += F.G) ha_unit(F, u, (u + F.G < NU) ? u + F.G : -1, vst, hvv); }
__device__ __forceinline__ void phase_hc(Frame& F, const float* hng) {
    constexpr int NU = BATCH * NCH * HH; v4u vst[4];
    if (F.vcu < NU) hg_v_load(F, F.vcu >> 9, F.vcu & 3, ((F.vcu >> 2) & 127) * CH, vst);
    for (int u = F.vcu; u < NU; u += F.G) hc_unit(F, u, (u + F.G < NU) ? u + F.G : -1, vst, hng);
}

#else
__device__ void phase_attn(Frame& F, const float* sink);
__device__ void phase_ha(Frame& F);
__device__ void phase_hb(Frame& F, int v, int g);
__device__ void phase_hc(Frame& F, const float* hng);
#endif


#if defined(ORACLE)
__global__ void __launch_bounds__(256) simple_attn(const bf16* PA, const float* sink, bf16* YA) {
    const int lane = threadIdx.x & 63, task = blockIdx.x * 4 + (threadIdx.x >> 6);
    const int m = task >> 3, qh = task & 7, kvh = qh >> 2, b = m / SEQ, t = m % SEQ;
    float q[64];
    { const bf16* qp = PA + (size_t)m * NPA + C_QA + 64 * qh;
#pragma unroll
      for (int d = 0; d < 64; ++d) q[d] = bf2f(qp[d]); }
    float s[5]; float mx = sink[qh] * LOG2E;
#pragma unroll
    for (int r = 0; r < 5; ++r) { const int j = t - WINDOW + 64 * r + lane; const bool ok = (j >= 0) && (j < SEQ) && (j <= t + WINDOW);
        float a = -3.0e38f;
        if (ok) { const bf16* kp = PA + (size_t)(b * SEQ + j) * NPA + C_KA + 64 * kvh; a = 0.f;
#pragma unroll
            for (int d = 0; d < 64; ++d) a += q[d] * bf2f(kp[d]); }
        s[r] = a; mx = fmaxf(mx, a); }
#pragma unroll
    for (int o = 1; o < 64; o <<= 1) mx = fmaxf(mx, __shfl_xor(mx, o));
    float den = 0.f;
#pragma unroll
    for (int r = 0; r < 5; ++r) { s[r] = (s[r] > -1.0e38f) ? exp2f(s[r] - mx) : 0.f; den += s[r]; }
    den = wave_sum(den) + exp2f(sink[qh] * LOG2E - mx);
    float o = 0.f;
    for (int r = 0; r < 5; ++r) for (int jj = 0; jj < 64; ++jj) { const int j = t - WINDOW + 64 * r + jj; const float p = __shfl(s[r], jj);
        if (j >= 0 && j < SEQ && j <= t + WINDOW) o += p * bf2f(PA[(size_t)(b * SEQ + j) * NPA + C_VA + 64 * kvh + lane]); }
#if defined(ABL_NOATTN)
    YA[(size_t)m * 512 + 64 * qh + lane] = 0;
#else
    YA[(size_t)m * 512 + 64 * qh + lane] = (bf16)f2bf(o / den);
#endif
}
__global__ void __launch_bounds__(512) simple_hgrn(const bf16* PA, const float* hng, float* obuf, bf16* YH, float* ssq) {
    __shared__ float part[32][4][128];
    const int tid = threadIdx.x, e = tid & 127, dq = tid >> 7, b = blockIdx.x >> 2, h = blockIdx.x & 3;
    for (int dir = 0; dir < 2; ++dir) {
        float S[32];
#pragma unroll
        for (int d = 0; d < 32; ++d) S[d] = 0.f;
        for (int t0 = 0; t0 < SEQ; t0 += 32) {
            for (int tt = 0; tt < 32; ++tt) { const int t = dir ? (SEQ - 1 - (t0 + tt)) : (t0 + tt); const bf16* row = PA + (size_t)(b * SEQ + t) * NPA;
                const float v = bf2f(row[C_VH + 128 * h + e]); const _Float16* lf = (const _Float16*)(row + (dir ? C_LB : C_LF) + 128 * h + 32 * dq); const bf16* qp = row + C_QH + 128 * h + 32 * dq;
                float o = 0.f;
#pragma unroll
                for (int d = 0; d < 32; ++d) { const float l = (float)lf[d], f = expf(l), k = -expm1f(l); S[d] = f * S[d] + k * v; o += S[d] * bf2f(qp[d]); }
                part[tt][dq][e] = o; }
            __syncthreads();
            for (int idx = tid; idx < 32 * 128; idx += 512) { const int tt = idx >> 7, ee = idx & 127; const int t = dir ? (SEQ - 1 - (t0 + tt)) : (t0 + tt); const size_t m = (size_t)b * SEQ + t;
                float o = (part[tt][0][ee] + part[tt][1][ee]) + (part[tt][2][ee] + part[tt][3][ee]);
                if (dir == 0) obuf[m * 512 + 128 * h + ee] = o;
                else { o += obuf[m * 512 + 128 * h + ee];
                    const float sg = bf2f(PA[m * NPA + C_SG + 128 * h + ee]);
#if defined(ABL_NOHGRN)
                    YH[m * 512 + 128 * h + ee] = 0;
#else
                    YH[m * 512 + 128 * h + ee] = (bf16)f2bf(o * hng[128 * h + ee] * sg);
#endif

                    const float q = wave_sum(o * o);
                    if ((tid & 63) == 0) atomicAdd(&ssq[m * 4 + h], q); } }
            __syncthreads();
        }
    }
}
__global__ void zero_f32(float* p, int n) { const int i = blockIdx.x * blockDim.x + threadIdx.x; if (i < n) p[i] = 0.f; }
#endif

#if defined(CHECK)
#define CK_NS 48
__device__ __forceinline__ int ck_row(int s) { return (int)(((long)s * 10007 + 77) % T); }
__device__ __forceinline__ bool ck_cmp(float got, float ref, float rtol, float atol, unsigned* cnt) { const float d = fabsf(got - ref); if (!(d <= rtol * fabsf(ref) + atol)) { atomicAdd(cnt, 1u); return true; } return false; }
__global__ void ck_norm(const float* x, const float* g, const bf16* XN, unsigned* cnt) {
    const int m = ck_row(blockIdx.x); __shared__ float red[256];
    float s = 0.f; for (int c = threadIdx.x; c < D; c += 256) { const float v = x[(size_t)m * D + c]; s += v * v; }
    red[threadIdx.x] = s; __syncthreads(); for (int o = 128; o > 0; o >>= 1) { if (threadIdx.x < o) red[threadIdx.x] += red[threadIdx.x + o]; __syncthreads(); }
    const float rstd = 1.0f / sqrtf(red[0] / D + NORM_EPS);
    for (int c = threadIdx.x; c < D; c += 256) ck_cmp(bf2f(XN[(size_t)m * D + c]), x[(size_t)m * D + c] * rstd * g[c], 0.01f, 0.01f, cnt);
}
__global__ void ck_pa(const bf16* XN, const float* w_in, const float* lb_tab  , int l, const bf16* PA, unsigned* cnt) {
    const int m = ck_row(blockIdx.x), pos = m % SEQ; __shared__ float z[NPA]; __shared__ float xr[D];
    for (int c = threadIdx.x; c < D; c += 256) xr[c] = bf2f(XN[(size_t)m * D + c]);
    __syncthreads();
    for (int c = threadIdx.x; c < NPA; c += 256) { float a = 0.f; for (int k = 0; k < D; ++k) a += xr[k] * w_in[(size_t)k * INW + c]; z[c] = a; }
    __syncthreads();
    for (int c = threadIdx.x; c < NPA; c += 256) {
        const float got_b = bf2f(PA[(size_t)m * NPA + c]); const float got_h = (float)((const _Float16*)PA)[(size_t)m * NPA + c];
        if (c < C_VA) { const int d = c & 63, i = d & 31; const double inv = exp2(-(double)i * (13.287712379549449 / 32.0)); const float cs = (float)cos((double)pos * inv), sn = (float)sin((double)pos * inv);
            const float x1 = z[(c & ~63) + i], x2 = z[(c & ~63) + i + 32]; float r = (d < 32) ? (x1 * cs - x2 * sn) : (x2 * cs + x1 * sn); if (c < C_KA) r *= QSCALE;
            ck_cmp(got_b, r, 0.02f, 0.03f, cnt + 0);
        } else if (c < C_QH) ck_cmp(got_b, z[c], 0.02f, 0.02f, cnt + 1);
        else if (c < C_LF) ck_cmp(got_b, z[c] / (1.f + expf(-z[c])), 0.02f, 0.02f, cnt + 2);
        else if (c < C_VH) { const int dir = (c >= C_LB), col = c - (dir ? C_LB : C_LF);
            float t0 = lb_tab[(0 * 2 + dir) * 512 + col], t1 = lb_tab[(1 * 2 + dir) * 512 + col]; const float mx = fmaxf(t0, t1); t0 = expf(t0 - mx); t1 = expf(t1 - mx);
            const float lb = (l == 0) ? 0.f : t1 / (t0 + t1); const float sg = 1.f / (1.f + expf(-z[c])); const float r = fmaxf(logf(lb + (1.f - lb) * sg), LOGF_MIN);
            ck_cmp(got_h, r, 0.01f, 0.02f, cnt + 3);
        } else if (c < C_SG) ck_cmp(got_b, z[c], 0.02f, 0.02f, cnt + 4);
        else ck_cmp(got_b, z[c] / (1.f + expf(-z[c])), 0.02f, 0.02f, cnt + 5);
    }
}
__global__ void ck_mix(const bf16* XN, const float* w_in, const bf16* YA, const bf16* YH, const float* ssq, const float* wua, const float* wuh, const bf16* GT, const bf16* MG, int which, unsigned* cnt) {
#ifndef CK_SHIFT
#define CK_SHIFT 0
#endif
    const int m = ck_row((blockIdx.x + CK_SHIFT) % CK_NS); __shared__ float xr[D]; __shared__ float ya[512]; __shared__ float yh[512];
    for (int c = threadIdx.x; c < D; c += 256) xr[c] = bf2f(XN[(size_t)m * D + c]);
    for (int c = threadIdx.x; c < 512; c += 256) { ya[c] = bf2f(YA[(size_t)m * 512 + c]); yh[c] = bf2f(YH[(size_t)m * 512 + c]); }
    __syncthreads();
    const float rstd = 1.0f / sqrtf((ssq[m * 4] + ssq[m * 4 + 1] + ssq[m * 4 + 2] + ssq[m * 4 + 3]) / 512.f + NORM_EPS);
    for (int c = threadIdx.x; c < D; c += 256) { float a = 0.f, b = 0.f, p = 0.f, q = 0.f;
        for (int k = 0; k < D; ++k) { a += xr[k] * w_in[(size_t)k * INW + NPA + c]; b += xr[k] * w_in[(size_t)k * INW + NPA + 1024 + c]; }
        for (int k = 0; k < 512; ++k) { p += ya[k] * wua[(size_t)k * D + c]; q += yh[k] * wuh[(size_t)k * D + c]; }
        float ga = 1.f / (1.f + expf(-a)), gb = 1.f / (1.f + expf(-b));
        if (which != 0) { ga = bf2f(GT[(size_t)m * NGATE + c]); gb = bf2f(GT[(size_t)m * NGATE + 1024 + c]); }
        if (which == 0) { unsigned* dbg = cnt + 100; if (blockIdx.x == 27) { const float e0 = fabsf(bf2f(GT[(size_t)m * NGATE + c]) - ga), e1 = fabsf(bf2f(GT[(size_t)m * NGATE + 1024 + c]) - gb); atomicMax(dbg + 200, __float_as_uint(e0)); atomicMax(dbg + 200, __float_as_uint(e1)); atomicMax(dbg + 201, __float_as_uint(fabsf(a))); atomicMax(dbg + 201, __float_as_uint(fabsf(b))); if (GT[(size_t)m * NGATE + c] == 0xFFFFu) atomicAdd(dbg + 203, 1u); if (GT[(size_t)m * NGATE + 1024 + c] == 0xFFFFu) atomicAdd(dbg + 203, 1u); if (e0 > 0.2f) { atomicAdd(dbg + 202, 1u); atomicOr(dbg + 210 + (c >> 11), 0u); atomicAdd(dbg + 300 + (c >> 6), 1u); } if (e1 > 0.2f) { atomicAdd(dbg + 202, 1u); atomicAdd(dbg + 300 + 16 + (c >> 6), 1u); } } if (ck_cmp(bf2f(GT[(size_t)m * NGATE + c]), ga, 0.01f, 0.01f, cnt + 0)) { atomicAdd(dbg + blockIdx.x, 1u); atomicAdd(dbg + 64 + (c >> 5), 1u); } if (ck_cmp(bf2f(GT[(size_t)m * NGATE + 1024 + c]), gb, 0.01f, 0.01f, cnt + 0)) { atomicAdd(dbg + blockIdx.x, 1u); atomicAdd(dbg + 64 + 32 + (c >> 5), 1u); } }
        else if (which == 1) ck_cmp(bf2f(MG[(size_t)m * D + c]), ga * p, 0.03f, 0.01f, cnt + 1);
        else ck_cmp(bf2f(MG[(size_t)m * D + c]), ga * p + gb * rstd * q, 0.03f, 0.02f, cnt + 2); }
}
__global__ void ck_out(const float* xprev, const bf16* MG, const float* wout, const float* X, unsigned* cnt) {
    const int m = ck_row(blockIdx.x); __shared__ float mg[D];
    for (int c = threadIdx.x; c < D; c += 256) mg[c] = bf2f(MG[(size_t)m * D + c]);
    __syncthreads();
    for (int c = threadIdx.x; c < D; c += 256) { float a = 0.f; for (int k = 0; k < D; ++k) a += mg[k] * wout[(size_t)k * D + c]; ck_cmp(X[(size_t)m * D + c], xprev[(size_t)m * D + c] + a, 0.01f, 0.02f, cnt); }
}
__global__ void ck_moe(const float* X, const float* g, const float* wrg, const float* brg, const float* wre, const float* bre, const float* weg, const float* weu, const float* wed,
                       const bf16* XN, const int* tok_e, const float* tok_w, const int* tok_p, const int* meta, const bf16* XP, const bf16* ACT, const bf16* Y, int stage, unsigned* cnt) {
    const int m = ck_row(blockIdx.x); __shared__ float h[D]; __shared__ float red[256]; __shared__ float lg[36]; __shared__ float act[DEXP];
    float s = 0.f; for (int c = threadIdx.x; c < D; c += 256) { const float v = X[(size_t)m * D + c]; s += v * v; }
    red[threadIdx.x] = s; __syncthreads(); for (int o = 128; o > 0; o >>= 1) { if (threadIdx.x < o) red[threadIdx.x] += red[threadIdx.x + o]; __syncthreads(); }
    const float rstd = 1.0f / sqrtf(red[0] / D + NORM_EPS);
    for (int c = threadIdx.x; c < D; c += 256) h[c] = X[(size_t)m * D + c] * rstd * g[c];
    __syncthreads();
    if (threadIdx.x < 36) { const int t = threadIdx.x; float a = 0.f;
        if (t < 4) { for (int k = 0; k < D; ++k) a += h[k] * wrg[k * 4 + t]; a += brg[t]; } else { const int gg = (t - 4) >> 3, e = (t - 4) & 7; for (int k = 0; k < D; ++k) a += h[k] * wre[((size_t)gg * D + k) * 8 + e]; a += bre[gg * 8 + e]; }
        lg[t] = a; }
    __syncthreads();
    int gt = 0; for (int k = 1; k < 4; ++k) if (lg[k] > lg[gt]) gt = k;
    float gden = 0.f; for (int k = 0; k < 4; ++k) gden += expf(lg[k] - lg[gt]);
    const float* el = lg + 4 + gt * 8; int i1 = 0; for (int k = 1; k < 8; ++k) if (el[k] > el[i1]) i1 = k; int i2 = (i1 == 0) ? 1 : 0; for (int k = 0; k < 8; ++k) if (k != i1 && el[k] > el[i2]) i2 = k;
    const float q2 = expf(el[i2] - el[i1]); const float w1 = (1.f / gden) / (1.f + q2), w2 = (1.f / gden) * q2 / (1.f + q2);
    const int e1 = gt * 8 + i1, e2 = gt * 8 + i2;
    if (stage == 0) { if (threadIdx.x == 0) { if (tok_e[2 * m] != e1 || tok_e[2 * m + 1] != e2) atomicAdd(cnt + 0, 1u); ck_cmp(tok_w[2 * m], w1, 0.01f, 1e-3f, cnt + 1); ck_cmp(tok_w[2 * m + 1], w2, 0.01f, 1e-3f, cnt + 1); } return; }
    for (int kk = 0; kk < 2; ++kk) { const int e = tok_e[2 * m + kk], p = tok_p[2 * m + kk];
        if (stage == 1) { if (threadIdx.x == 0) { const int rt = p >> 8; if (rt >= meta[0] || meta[1 + rt] != e) atomicAdd(cnt + 2, 1u); }
            for (int c = threadIdx.x; c < D; c += 256) if (XP[(size_t)p * D + c] != XN[(size_t)m * D + c]) atomicAdd(cnt + 3, 1u); continue; }
        const float* wg = weg + (size_t)e * D * DEXP; const float* wu = weu + (size_t)e * D * DEXP; const float* wd = wed + (size_t)e * DEXP * D;
        __syncthreads();
        for (int j = threadIdx.x; j < DEXP; j += 256) { float a = 0.f, b = 0.f; for (int k = 0; k < D; ++k) { const float hv = bf2f(XN[(size_t)m * D + k]); a += hv * wg[(size_t)k * DEXP + j]; b += hv * wu[(size_t)k * DEXP + j]; }
            const float r = a / (1.f + expf(-a)) * b; act[j] = r; if (stage == 2) ck_cmp(bf2f(ACT[(size_t)p * DEXP + j]), r, 0.03f, 0.02f, cnt + 4); }
        __syncthreads();
        if (stage == 3) for (int c = threadIdx.x; c < D; c += 256) { float a = 0.f; for (int j = 0; j < DEXP; ++j) a += act[j] * wd[(size_t)j * D + c]; ck_cmp(bf2f(Y[(size_t)p * D + c]), a, 0.03f, 0.03f, cnt + 5); }
    }
}

__global__ void ck_attn(const bf16* PA, const float* sink, const bf16* YA, unsigned* cnt) {
    const int m = ck_row(blockIdx.x), b = m / SEQ, t = m % SEQ; __shared__ float sc[512]; __shared__ float red[256];
    for (int qh = 0; qh < NQH; ++qh) { const int kvh = qh / 4;
        const bf16* qp = PA + (size_t)m * NPA + C_QA + 64 * qh;
        for (int jj = threadIdx.x; jj < 2 * WINDOW + 1; jj += 256) { const int j = t - WINDOW + jj; float a = -1e30f;
            if (j >= 0 && j < SEQ) { a = 0.f; const bf16* kp = PA + (size_t)(b * SEQ + j) * NPA + C_KA + 64 * kvh; for (int d = 0; d < 64; ++d) a += bf2f(qp[d]) * bf2f(kp[d]); a *= 0.6931471805599453f; }
            sc[jj] = a; }
        __syncthreads();
        float mx = sink[qh]; for (int jj = 0; jj < 2 * WINDOW + 1; ++jj) mx = fmaxf(mx, sc[jj]);
        float den = expf(sink[qh] - mx); for (int jj = 0; jj < 2 * WINDOW + 1; ++jj) den += expf(sc[jj] - mx);
        if (threadIdx.x < 64) { const int d = threadIdx.x; float o = 0.f; for (int jj = 0; jj < 2 * WINDOW + 1; ++jj) { const int j = t - WINDOW + jj; if (j >= 0 && j < SEQ) o += expf(sc[jj] - mx) * bf2f(PA[(size_t)(b * SEQ + j) * NPA + C_VA + 64 * kvh + d]); }
            ck_cmp(bf2f(YA[(size_t)m * 512 + 64 * qh + d]), o / den, 0.03f, 0.005f, cnt); }
        __syncthreads(); }
}
__global__ void ck_hgrn(const bf16* PA, const float* hng, const bf16* YH, const float* ssq, unsigned* cnt) {
    const int m = ck_row(blockIdx.x), b = m / SEQ, t = m % SEQ, h = blockIdx.y; __shared__ float wgt[128]; __shared__ float osum[128]; __shared__ float cum[128];
    const int e = threadIdx.x;
    float o = 0.f;
    for (int dir = 0; dir < 2; ++dir) { cum[e] = 0.f; __syncthreads();
        for (int n = 0; n < 768; ++n) { const int s = dir ? t + n : t - n; if (s < 0 || s >= SEQ) break;
            const bf16* row = PA + (size_t)(b * SEQ + s) * NPA; const bf16* rowt = PA + (size_t)m * NPA;
            { const int d = e; const float lf = (float)((const _Float16*)(row + (dir ? C_LB : C_LF) + 128 * h))[d];
              wgt[d] = bf2f(rowt[C_QH + 128 * h + d]) * (-expm1f(lf)) * expf(cum[d]);
#if defined(HC_DBG) && HC_DBG >= 3
              wgt[d] = bf2f(rowt[C_QH + 128 * h + d]) * (-expm1f(lf));
              if (HC_DBG == 4) wgt[d] = (d == 0) ? bf2f(rowt[C_QH + 128 * h]) : 0.f;
              if (HC_DBG == 5 || HC_DBG == 7) wgt[d] = (d == 0) ? wgt[d] : 0.f;
              if (HC_DBG == 10) wgt[d] = (d == 0) ? (float)(s & 15) : 0.f;
              if (HC_DBG == 11) wgt[d] = (d == 0) ? (float)(t & 15) : 0.f;
              if (HC_DBG == 8 || HC_DBG == 9) wgt[d] = (d == 0) ? bf2f(rowt[C_QH + 128 * h]) * (float)(s & 15) : 0.f;
              if (HC_DBG == 6) wgt[d] = (d == 0) ? bf2f(rowt[C_QH + 128 * h]) * lf : 0.f;
#endif
            }
            __syncthreads();
            float w = 0.f; for (int d = 0; d < 128; ++d) w += wgt[d];
#if defined(HC_TERMS)
            { const int cls = ((s >> 4) == (t >> 4)) ? 1 : (((s >> 7) == (t >> 7)) ? 2 : 4); if (!(HC_TERMS & cls)) w = 0.f; }
#endif
            o += w * bf2f(row[C_VH + 128 * h + e]);
            __syncthreads();
            { const int d = e; cum[d] += (float)((const _Float16*)(row + (dir ? C_LB : C_LF) + 128 * h))[d]; }
            __syncthreads(); } }
#if defined(HC_DBG) && HC_DBG == 1
    o = bf2f(PA[(size_t)m * NPA + C_VH + 128 * h + e]);
#endif
    osum[e] = o * o; __syncthreads(); for (int k = 64; k > 0; k >>= 1) { if (e < k) osum[e] += osum[e + k]; __syncthreads(); }
    if (e == 0) ck_cmp(ssq[m * 4 + h], osum[0], 0.03f, 1e-3f, cnt + 1);
    const float sg = bf2f(PA[(size_t)m * NPA + C_SG + 128 * h + e]);
    ck_cmp(bf2f(YH[(size_t)m * 512 + 128 * h + e]), o * hng[128 * h + e] * sg, 0.03f, 0.01f, cnt + 0);
}
__global__ void ck_comb(const float* xold, const float* xnew, const int* tok_p, const float* tok_w, const bf16* Y, const float* gfin, int last, unsigned* cnt) {
    const int m = ck_row(blockIdx.x); __shared__ float red[256]; __shared__ float xv[D];
    if (m >= SEQ) return;
    const int p1 = tok_p[2 * m], p2 = tok_p[2 * m + 1]; const float w1 = tok_w[2 * m], w2 = tok_w[2 * m + 1]; float s = 0.f;
    for (int c = threadIdx.x; c < D; c += 256) { const float v = xold[(size_t)m * D + c] + w1 * bf2f(Y[(size_t)p1 * D + c]) + w2 * bf2f(Y[(size_t)p2 * D + c]); xv[c] = v; s += v * v; }
    red[threadIdx.x] = s; __syncthreads(); for (int o = 128; o > 0; o >>= 1) { if (threadIdx.x < o) red[threadIdx.x] += red[threadIdx.x + o]; __syncthreads(); }
    const float rstd = 1.0f / sqrtf(red[0] / D + NORM_EPS);
    for (int c = threadIdx.x; c < D; c += 256) ck_cmp(xnew[(size_t)m * D + c], last ? xv[c] * rstd * gfin[c] : xv[c], 0.005f, 0.005f, cnt);
}

__global__ void ck_gates_full(const bf16* XN, const float* w_in, const bf16* GT, unsigned* st) {
    const int m = blockIdx.x >> 3, pn = blockIdx.x & 7, c = pn * 256 + threadIdx.x; __shared__ float xr[D];
    for (int k = threadIdx.x; k < D; k += 256) xr[k] = bf2f(XN[(size_t)m * D + k]);
    __syncthreads();
    float a = 0.f; for (int k = 0; k < D; ++k) a += xr[k] * w_in[(size_t)k * INW + NPA + c];
#if defined(CK_PLAIN)
    const float ref = a, got = bf2f(GT[(size_t)m * NGATE + c]);
#else
    const float ref = 1.f / (1.f + expf(-a)), got = bf2f(GT[(size_t)m * NGATE + c]);
#endif
    if (m == 8122 && !(fabsf(got - ref) <= 0.05f)) atomicMin(st + 700, (unsigned)c);
    if (m == 8123 && !(fabsf(got - ref) <= 0.05f)) atomicMin(st + 701, (unsigned)c);
    if (m == 8122) { if (c == 130) st[702] = __float_as_uint(got), st[703] = __float_as_uint(ref), st[704] = __float_as_uint(a); if (c == 131) st[705] = __float_as_uint(got), st[706] = __float_as_uint(ref); }
    if (!(fabsf(got - ref) <= 0.05f)) { atomicAdd(st + (m >> 8), 1u); atomicAdd(st + 128 + (m & 255), 1u); atomicAdd(st + 384 + threadIdx.x, 1u); atomicAdd(st + 640 + pn, 1u); }
}
__global__ void ck_flush() { asm volatile("buffer_wbl2 sc0 sc1\n\ts_waitcnt vmcnt(0)\n\tbuffer_inv sc0 sc1\n\ts_waitcnt vmcnt(0)" ::: "memory"); }

__global__ void ck_ha(const bf16* PA, const bf16* US, const float* HD, unsigned* cnt) {
    const int sidx = blockIdx.x, bh = sidx % 8, dir = (sidx >> 3) & 1, n = (sidx * 37 + 5) % NCH, b = bh >> 2, h = bh & 3, d = threadIdx.x, t0 = n * CH;
    __shared__ float kts[CH][128]; float cum = 0.f;
    for (int k = CH - 1; k >= 0; --k) { const int tok = dir ? (t0 + CH - 1 - k) : (t0 + k);
        const float lf = (float)((const _Float16*)(PA + (size_t)(b * SEQ + tok) * NPA + (dir ? C_LB : C_LF) + 128 * h))[d];
        kts[k][d] = -expm1f(lf) * expf(cum); cum += lf; }
    ck_cmp(HD[((size_t)(bh * 2 + dir) * NCH + n) * 128 + d], expf(cum), 0.01f, 1e-6f, cnt + 1);
    for (int e = 0; e < 128; e += 5) { float u = 0.f;
        for (int k = 0; k < CH; ++k) { const int tok = dir ? (t0 + CH - 1 - k) : (t0 + k); u += kts[k][d] * bf2f(PA[(size_t)(b * SEQ + tok) * NPA + C_VH + 128 * h + e]); }
        ck_cmp(bf2f(US[(((size_t)(bh * 2 + dir) * NCH + n) * 128 + e) * 128 + d]), u, 0.03f, 0.01f, cnt + 0); }
}
__global__ void ck_hb(const bf16* PA, const bf16* US, unsigned* cnt) {
    const int sidx = blockIdx.x, bh = sidx % 8, dir = (sidx >> 3) & 1, n = (sidx * 37 + 5) % NCH, b = bh >> 2, h = bh & 3, d = threadIdx.x, e = (sidx * 11 + 3) % 128;
    float cum = 0.f, sacc = 0.f;
    for (int k = 0; k < 1024; ++k) { const int tok = dir ? ((n + 1) * CH + k) : (n * CH - 1 - k); if (tok < 0 || tok >= SEQ) break;
        const bf16* row = PA + (size_t)(b * SEQ + tok) * NPA; const float lf = (float)((const _Float16*)(row + (dir ? C_LB : C_LF) + 128 * h))[d];
        sacc += -expm1f(lf) * expf(cum) * bf2f(row[C_VH + 128 * h + e]); cum += lf; }
    ck_cmp(bf2f(US[(((size_t)(bh * 2 + dir) * NCH + n) * 128 + e) * 128 + d]), sacc, 0.03f, 0.01f, cnt);
}

__global__ void ck_mfma(unsigned* cnt) {
#if defined(__HIP_DEVICE_COMPILE__)
    const int lane = threadIdx.x, fr = lane & 15, g = lane >> 4;
    float av[8], bv[8];
    for (int j = 0; j < 8; ++j) { const int k = 8 * g + j; av[j] = (k == 0) ? (float)fr : ((k == 9) ? (float)(fr * fr) : 0.f); bv[j] = (k == 0) ? (float)(fr + 1) : ((k == 9) ? 0.5f : 0.f); }
    f32x4 d = (f32x4){0.f, 0.f, 0.f, 0.f};
    d = mfma16(pack_frag(av), pack_frag(bv), d);
    for (int r = 0; r < 4; ++r) { const int s = 4 * g + r, c = fr; const float ref = (float)s * (float)(c + 1) + (float)(s * s) * 0.5f; if (fabsf(d[r] - ref) > 0.01f * fabsf(ref) + 0.01f) atomicAdd(cnt, 1u); }
#endif
}
#ifndef CK_SKIP
#define CK_SKIP 0ull
#endif
__global__ void ck_report(const unsigned* cnt, int n, float* out) { if (threadIdx.x == 0 && blockIdx.x == 0) {
#if defined(CK_DBG7)
    const unsigned* dbg = cnt + 7 + 100; int nrows = 0, ngrp = 0; unsigned mx = 0, first = 99; for (int i = 0; i < CK_NS; ++i) if (dbg[i]) { ++nrows; mx = dbg[i] > mx ? dbg[i] : mx; } for (int i = 0; i < 64; ++i) if (dbg[64 + i]) { ++ngrp; if (first == 99) first = i; }
    if (CK_DBG7 == 4) { const float me = __uint_as_float(dbg[200]), ma = __uint_as_float(dbg[201]); out[0] = (1.0f + fminf(me, 0.89f) * 10.0f) * powf(10.0f, 5.0f + floorf(fminf(ma, 30.0f))); return; }
    if (CK_DBG7 == 5) { int nl = 0; unsigned mxl = 0; for (int i = 0; i < 32; ++i) if (dbg[300 + i]) { ++nl; mxl = dbg[300 + i] > mxl ? dbg[300 + i] : mxl; } out[0] = (1.0f + 0.1f * (float)nl) * powf(10.0f, 5.0f + (float)(mxl > 30 ? 30 : mxl)); return; }
    if (CK_DBG7 == 7) { out[0] = (1.0f + 0.01f * (float)(dbg[203] % 100)) * powf(10.0f, 5.0f + (float)(dbg[203] / 100)); return; }
    if (CK_DBG7 >= 10) { const unsigned* st = cnt + 512; int npan = 0, nrit = 0, ncol = 0, ntile = 0; unsigned tot = 0, mxp = 0; int firstp = -1, firstr = -1, firstc = -1;
        for (int i = 0; i < 128; ++i) if (st[i]) { ++npan; tot += st[i]; if (st[i] > mxp) mxp = st[i]; if (firstp < 0) firstp = i; }
        for (int i = 0; i < 256; ++i) { if (st[128 + i]) { ++nrit; if (firstr < 0) firstr = i; } if (st[384 + i]) { ++ncol; if (firstc < 0) firstc = i; } }
        for (int i = 0; i < 8; ++i) if (st[640 + i]) ++ntile;
        float a = 0.f, b = 0.f;
        if (CK_DBG7 == 10) { a = (float)npan; b = log10f((float)(tot ? tot : 1)) * 4.0f; }
        if (CK_DBG7 == 11) { a = (float)nrit; b = (float)ncol / 10.0f; }
        if (CK_DBG7 == 12) { a = (float)firstp; b = (float)firstr / 10.0f; }
        if (CK_DBG7 == 13) { a = (float)firstc; b = (float)ntile; }
        if (CK_DBG7 == 22) { out[0] = (1.0f + 8.0f * __uint_as_float(st[702])) * powf(10.0f, 5.0f + floorf(20.0f * __uint_as_float(st[703]) + 0.5f)); return; }
        if (CK_DBG7 == 23) { out[0] = (1.0f + 8.0f * __uint_as_float(st[705])) * powf(10.0f, 5.0f + floorf(20.0f * __uint_as_float(st[706]) + 0.5f)); return; }
        if (CK_DBG7 == 20) { a = (float)(st[700] % 100); b = (float)(st[700] / 100); }
        if (CK_DBG7 == 21) { a = (float)(st[701] > 5000 ? 99 : st[701] % 100); b = (float)(st[701] > 5000 ? 30 : st[701] / 100); }
        out[0] = (1.0f + 0.01f * a) * powf(10.0f, 5.0f + floorf(b)); return; }
    if (CK_DBG7 == 6) { out[0] = (1.0f + 0.01f * (float)(dbg[202] % 100)) * powf(10.0f, 5.0f + (float)(dbg[202] / 100)); return; }
    if (CK_DBG7 == 3) { int s1 = -1, s2 = -1; for (int i = 0; i < CK_NS; ++i) if (dbg[i] > 20) { if (s1 < 0) s1 = i; else if (s2 < 0) s2 = i; } out[0] = (1.0f + 0.1f * (float)(s1 < 0 ? 0 : s1 % 50)) * powf(10.0f, (float)(5 + (s2 < 0 ? 0 : (s2 % 25)))); return; }
    if (CK_DBG7 == 1) out[0] = (1.0f + 0.1f * (float)first) * powf(10.0f, (float)(5 + nrows / 2));
    else out[0] = (1.0f + 0.1f * (float)ngrp) * powf(10.0f, (float)(5 + (int)floorf(4.0f * log10f((float)(mx ? mx : 1)))));
    return;
#endif
    for (int i = 0; i < n; ++i) if (cnt[i] && !((CK_SKIP >> i) & 1ull)) {
    out[0] = (1.0f + 0.1f * (float)(i % 10)) * powf(10.0f, (float)(5 + i / 10)); return; } } }
#endif

#ifndef PG8_SP2
#define PG8_SP2 true
#endif
#ifndef PG8_ALIGN
#define PG8_ALIGN true
#endif
__global__ void __launch_bounds__(NWAVES * 64, 2) mega_fwd(Args args) {
    extern __shared__ __attribute__((aligned(16))) unsigned char lds[];
    Frame F;
    F.lds = (LAS unsigned char*)lds;
    F.MISC = (volatile LAS unsigned*)(F.lds + MISC_OFF);
    F.tid = threadIdx.x; F.lane = F.tid & 63; F.wave = __builtin_amdgcn_readfirstlane(F.tid >> 6);
    F.G = gridDim.x; { const int bx = blockIdx.x; F.vcu = (F.G % 8 == 0) ? (bx % 8) * (F.G / 8) + bx / 8 : bx; }
    F.ws = args.ws; F.ctl = (gu32*)(args.ws + WS_CTL); F.out = args.out;
    const Args& A = args;
    for (int u = F.tid; u < (LDS_BYTES - LDSCTL_OFF) / 4; u += NWAVES * 64) ((LAS unsigned*)(F.lds + LDSCTL_OFF))[u] = 0u;
    __syncthreads();
    XcdBarrier bar = xcd_barrier_post((unsigned*)(F.ctl + CW_BAR) + args.li * XCD_BAR_WORDS, F.MISC + 8);
    const int lo = args.ph_lo, hi = args.ph_hi;
#ifndef PHMASK
#define PHMASK 0xffff
#endif
#define IN(k) (((PHMASK >> ((k) & 15)) & 1) && lo <= (k) && (k) < hi)
#if defined(PROBE_MASK)
    unsigned long long pr_acc = 0ull, pr_t0 = 0ull;
#define PR_BEGIN(k) do { if ((PROBE_MASK >> ((k) & 15)) & 1) pr_t0 = wall_clock64(); } while (0)
#define PR_END(k) do { if ((PROBE_MASK >> ((k) & 15)) & 1) pr_acc += wall_clock64() - pr_t0; } while (0)
#else
#define PR_BEGIN(k)
#define PR_END(k)
#endif
#define SEAM(k) do { if ((k) + 1 < hi) xcd_barrier(bar); PR_END(k); } while (0)
#define WSP() GAS unsigned char* wsg_ = (GAS unsigned char*)args.ws; asm volatile("" : "+s"(wsg_)); unsigned char* ws = (unsigned char*)wsg_; F.ws = ws; { int t_ = threadIdx.x; asm volatile("" : "+v"(t_)); F.tid = t_; F.lane = t_ & 63; F.wave = __builtin_amdgcn_readfirstlane(t_ >> 6); int g_ = gridDim.x, b_ = blockIdx.x; asm volatile("" : "+s"(g_), "+s"(b_)); F.G = g_; F.vcu = (g_ % 8 == 0) ? (b_ % 8) * (g_ / 8) + b_ / 8 : b_; cid = b_; } \
    bf16* XN = (bf16*)(ws + WS_XN); bf16* PA = (bf16*)(ws + WS_PA); bf16* GT = (bf16*)(ws + WS_PA); bf16* MG = (bf16*)(ws + WS_US); \
    bf16* YA = (bf16*)(ws + WS_Y); bf16* YH = (bf16*)(ws + WS_YH); (void)XN; (void)PA; (void)GT; (void)MG; (void)YA; (void)YH;
    int cid = (int)blockIdx.x;

#if !defined(ORACLE) || defined(ORACLE_FAST)
#if XBF16
#define XB_CUR(l) ((l) == 0 ? (NORMFOLD ? (void*)XN : (void*)A.in[I_X]) : (void*)F.out)
#define XB_NEW(l) ((l) == DEPTH - 1 ? (bf16*)(ws + WS_Y) : (bf16*)F.out)
#define XIN0(l) ((const void*)XB_CUR(l))
#define EPIOUT_T(l) EpiOutB<(l) == 0 && !NORMFOLD>
#else
#define XB_CUR(l) ((void*)F.out)
#define XB_NEW(l) (F.out)
#define XIN0(l) ((l) == 0 ? A.in[I_X] : (const float*)F.out)
#define EPIOUT_T(l) EpiOut
#endif
#if NORMFOLD
#define G1_A(l) ((l) == 0 ? XN : (const bf16*)F.out)
#define M1_A(l) ((const bf16*)XB_NEW(l))
#else
#define G1_A(l) XN
#define M1_A(l) XN
#endif
#define XCOPY0 nullptr
#else
#define XCOPY0 F.out
#define XIN0(l) ((const float*)F.out)
#endif
    if (IN(0)) { WSP(); PR_BEGIN(0);
        make_tables(F, A); conv_weights(F, A, 0);
#if NORM4 && !NORMFOLD
        norm_rows4(F, A.in[I_X], A.in[I_ANG], XN);
#else
        norm_rows(F, A.in[I_X], XCOPY0, A.in[I_ANG], XN, NORMFOLD ? (float*)(ws + WS_RSA) : nullptr);
#endif
        SEAM(0);
    }
#if G1A_SPLIT
#define PHASE3(l) if (IN(pb + 3)) { WSP(); PR_BEGIN(pb + 3);   \
            const int gh = G1A_SPLIT ? F.G / 2 : 0; \
            if (cid < gh) { pg8::Gemm g{XN, (const bf16*)(ws + WS_WIN) + (size_t)G1A_N * D, T, NPA - G1A_N, D}; pg8::StaticOrder S; S.init(T, NPA - G1A_N, gh, cid); \
                EpiInA E{PA, (const float*)(ws + WS_COS), (const float*)(ws + WS_SIN), (const float*)(ws + WS_LBT) + l * 2048, G1A_N / 256, (const float*)(ws + WS_RSA)}; \
                pg8::gemm_phase<EpiInA, pg8::StaticOrder, PG8_ALIGN, PG8_SP2>(F.lds + RING_OFF, g, S, E); } \
            else phase_hb(F, cid - gh, F.G - gh); \
            SEAM(pb + 3); }
#else
#define PHASE3(l) if (IN(pb + 3)) { WSP(); PR_BEGIN(pb + 3); phase_hb(F, F.vcu, F.G); SEAM(pb + 3); }
#endif
#if !defined(ORACLE) || defined(ORACLE_FAST)
#define G1A_N (NPA - 256 * G1A_SPLIT)
#define FAST_PHASES(l)         if (IN(pb + 2)) { WSP(); PR_BEGIN(pb + 2); PR_BEGIN(14); phase_attn(F, A.in[I_SINK] + (l) * NQH); PR_END(14); PR_BEGIN(15); phase_ha(F); PR_END(15); SEAM(pb + 2); } \
        PHASE3(l) \
        if (IN(pb + 4)) { WSP(); PR_BEGIN(pb + 4); phase_hc(F, A.in[I_HNG] + (l) * 512); SEAM(pb + 4); }
#else
#define G1A_N NPA
#define FAST_PHASES(l)
#endif
#if MOE_HANDOFF
#define MOE_ORDER1 pg8::ProducerOrder
#define MOE_ORDER2 pg8::ConsumerOrder
#define MOE_CNT(l) S.cnt = (unsigned*)(F.ctl + CW_MOE + (l) * MOE_BANK + 64);
#define MOE_SEAM(k) PR_END(k)
#else
#define MOE_ORDER1 pg8::GroupedOrder
#define MOE_ORDER2 pg8::GroupedOrder
#define MOE_CNT(l)
#define MOE_SEAM(k) SEAM(k)
#endif
#if ROUTE4
#define ROUTE_FN phase_norm_route4
#else
#define ROUTE_FN phase_norm_route
#endif
#if defined(PROBE_BARRIERS)
#define PROBE_BARRIERS_EXTRA for (int k_ = 0; k_ < PROBE_BARRIERS; ++k_) xcd_barrier(bar);
#else
#define PROBE_BARRIERS_EXTRA
#endif
#if defined(PROBE_KLOOP)
#define PROBE_KLOOP_EXTRA { EpiNull E2{GT}; pg8::gemm_phase<EpiNull, pg8::StaticOrder, PG8_ALIGN, PG8_SP2>(F.lds + RING_OFF, g, S, E2); }
#else
#define PROBE_KLOOP_EXTRA
#endif
#define LAYER_BODY(l) { const int pb = 16 * (l); \
        if (IN(pb + 1)) { WSP(); PR_BEGIN(pb + 1); \
            const int cw = conv_wgs(F.G, (T / 256) * (G1A_N / 256), CONV_WGS), gg = F.G - cw;     \
            if (cid < gg) { pg8::Gemm g{G1_A(l), (const bf16*)(ws + WS_WIN), T, G1A_N, D}; pg8::StaticOrder S; S.init(T, G1A_N, gg, cid); \
                EpiInA E{PA, (const float*)(ws + WS_COS), (const float*)(ws + WS_SIN), (const float*)(ws + WS_LBT) + l * 2048, 0, (const float*)(ws + WS_RSA)}; \
                pg8::gemm_phase<EpiInA, pg8::StaticOrder, PG8_ALIGN, PG8_SP2>(F.lds + RING_OFF, g, S, E); } \
            if (EXPERTS_BY_QUEUE) { const int n1 = NEXP * 16 * 32, h0 = __builtin_amdgcn_readfirstlane((int)VLD(F.ctl + CW_H12)), h1 = min(n1, h0 + cw * (h0 ? CONV_PER_WG1 - 64 : CONV_PER_WG1));     \
                if (cid >= gg) conv_experts_range(F, A, l, h0, h1, (cid - gg) * NWAVES + F.wave, cw * NWAVES); \
                if (cw == 0) conv_experts_range(F, A, l, h1, n1, F.vcu * NWAVES + F.wave, F.G * NWAVES); \
                else if (cid < gg) conv_experts_range(F, A, l, h1, n1, cid * NWAVES + F.wave, gg * NWAVES); }   \
            SEAM(pb + 1); \
        } \
FAST_PHASES(l) \
        if (IN(pb + 5)) { WSP(); PR_BEGIN(pb + 5); \
            pg8::Gemm g{G1_A(l), (const bf16*)(ws + WS_WIN) + (size_t)NPA * D, T, NGATE, D}; pg8::StaticOrder S; S.init(T, NGATE, F.G, cid); \
            EpiGate E{GT, (const float*)(ws + WS_RSA)}; \
            pg8::gemm_phase<EpiGate, pg8::StaticOrder, PG8_ALIGN, PG8_SP2>(F.lds + RING_OFF, g, S, E); \
            PROBE_KLOOP_EXTRA \
            SEAM(pb + 5); \
        } \
        if (IN(pb + 6)) { WSP(); PR_BEGIN(pb + 6); \
            pg8::Gemm g{YA, (const bf16*)(ws + WS_WUA), T, D, 512}; pg8::StaticOrder S; S.init(T, D, F.G, cid); \
            EpiUpA E{MG, GT}; \
            pg8::gemm_phase<EpiUpA, pg8::StaticOrder, PG8_ALIGN, PG8_SP2>(F.lds + RING_OFF, g, S, E); \
            PR_END(pb + 6);   \
        } \
        if (IN(pb + 7)) { WSP(); PR_BEGIN(pb + 7); \
            pg8::Gemm g{YH, (const bf16*)(ws + WS_WUH), T, D, 512}; pg8::StaticOrder S; S.init(T, D, F.G, cid); \
            EpiUpB E{MG, GT, (const float*)(ws + WS_SSQ)}; \
            pg8::gemm_phase<EpiUpB, pg8::StaticOrder, PG8_ALIGN, PG8_SP2>(F.lds + RING_OFF, g, S, E); \
            SEAM(pb + 7); \
        } \
        if (IN(pb + 8)) { WSP(); PR_BEGIN(pb + 8); \
            pg8::Gemm g{MG, (const bf16*)(ws + WS_WOUT), T, D, D}; pg8::StaticOrder S; S.init(T, D, F.G, cid); \
            EPIOUT_T(l) E{XB_NEW(l), XIN0(l)}; \
            pg8::gemm_phase<EPIOUT_T(l), pg8::StaticOrder, PG8_ALIGN, PG8_SP2>(F.lds + RING_OFF, g, S, E); \
            SEAM(pb + 8); \
        } \
        if (IN(pb + 9)) { WSP(); PR_BEGIN(pb + 9); ROUTE_FN(F, A, l, XB_NEW(l)); SEAM(pb + 9); } \
        if (IN(pb + 10)) { WSP(); PR_BEGIN(pb + 10); phase_dispatch(F); PROBE_BARRIERS_EXTRA SEAM(pb + 10); } \
        if (IN(pb + 11)) { WSP(); PR_BEGIN(pb + 11); \
            const int cw = MOE_HANDOFF ? 0 : conv_wgs(F.G, 4 * __builtin_amdgcn_readfirstlane((int)VLD((const int*)(ws + WS_META))), CONV_WGS_MOE), gg = F.G - cw;     \
            if (cid < gg) { pg8::Gemm g{M1_A(l), (const bf16*)(ws + WS_W1), SLOT_ROWS, D, D}; MOE_ORDER1 S; S.init((const int*)(ws + WS_META), D, gg, cid); MOE_CNT(l) \
                EpiAct E{(bf16*)(ws + WS_ACT), (const float*)(ws + WS_RSS)}; \
                pg8::gemm_phase<EpiAct, MOE_ORDER1, PG8_ALIGN, PG8_SP2, true>(F.lds + RING_OFF, g, S, E, (const int*)(ws + WS_STOK)); } \
            if (EXPERTS_BY_QUEUE) { const int n1 = NEXP * 16 * 32, n2 = NEXP * 8 * 32, h2 = min(n2, cw * CONV_PER_WG2); \
                if (cid >= gg) conv_experts_range(F, A, l, n1, n1 + h2, (cid - gg) * NWAVES + F.wave, cw * NWAVES); \
                conv_experts_range(F, A, l, n1 + h2, n1 + n2, F.vcu * NWAVES + F.wave, F.G * NWAVES); } \
            MOE_SEAM(pb + 11); \
        } \
        if (IN(pb + 12)) { WSP(); PR_BEGIN(pb + 12); \
            const int cw = (MOE_HANDOFF || !EXPERTS_BY_QUEUE || (l) == DEPTH - 1) ? 0 : conv_wgs(F.G, 4 * __builtin_amdgcn_readfirstlane((int)VLD((const int*)(ws + WS_META))), CONV_WGS_MOE), gg = F.G - cw;     \
            if (cid < gg) { pg8::Gemm g{(const bf16*)(ws + WS_ACT), (const bf16*)(ws + WS_W2), SLOT_ROWS, D, DEXP}; MOE_ORDER2 S; S.init((const int*)(ws + WS_META), D, gg, cid, MOE_HANDOFF != 0); MOE_CNT(l) \
                EpiY E{(bf16*)(ws + WS_XP)}; \
                pg8::gemm_phase<EpiY, MOE_ORDER2, PG8_ALIGN, PG8_SP2, false, MOE_HANDOFF ? 16 : 0>(F.lds + RING_OFF, g, S, E); } \
            else conv_experts_range(F, A, (l) + 1, 0, cw * CONV_PER_WG12, (cid - gg) * NWAVES + F.wave, cw * NWAVES); \
            if (cw > 0 && cid == 0 && F.tid == 0) __hip_atomic_store(F.ctl + CW_H12, (unsigned)(cw * CONV_PER_WG12), __ATOMIC_RELAXED, __HIP_MEMORY_SCOPE_AGENT);     \
            SEAM(pb + 12); \
        } \
        if (IN(pb + 13)) { WSP(); PR_BEGIN(pb + 13); \
            const bool last = (l == DEPTH - 1); \
            if (!last) conv_weights(F, A, l + 1); \
            phase_combine(F, last ? A.in[I_FING] : A.in[I_ANG] + (size_t)(l + 1) * D, last, XB_NEW(l), XB_CUR((l) + 1)); \
            if (!last) { if ((pb + 15) + 1 < hi) xcd_barrier(bar); } PR_END(pb + 13); \
        } \
    }
    LAYER_BODY(0)
    LAYER_BODY(1)
    static_assert(DEPTH == 2, "layer bodies are written out");
#if defined(PROBE_MASK)
    if (blockIdx.x == 0 && threadIdx.x == 0) { const unsigned long long t1 = wall_clock64(), want = (unsigned long long)PROBE_MULT * pr_acc; while (wall_clock64() - t1 < want) __builtin_amdgcn_s_sleep(8); }
#endif
#undef IN
#undef SEAM
}

extern "C" void kernel_launch(void* const* d_in, const int* in_sizes, int n_in, void* d_out, int out_size, void* d_ws, size_t ws_size, hipStream_t stream) {
    static int grid = 0;
    if (grid == 0) {
        if (n_in != 18 || in_sizes[0] != T * D || out_size != T * D || ws_size < WS_END) { fprintf(stderr, "kernel_launch: unexpected shapes (n_in %d, in0 %d, out %d, ws %zu); nothing launched\n", n_in, n_in > 0 ? in_sizes[0] : -1, out_size, ws_size); grid = -1; return; }
        int dev = 0, cus = 0, per_cu = 0;
        if (hipGetDevice(&dev) != hipSuccess || hipDeviceGetAttribute(&cus, hipDeviceAttributeMultiprocessorCount, dev) != hipSuccess) { grid = -1; return; }
        if (hipFuncSetAttribute((const void*)mega_fwd, hipFuncAttributeMaxDynamicSharedMemorySize, LDS_BYTES) != hipSuccess) { fprintf(stderr, "kernel_launch: hipFuncSetAttribute failed\n"); grid = -1; return; }
        if (hipOccupancyMaxActiveBlocksPerMultiprocessor(&per_cu, (const void*)mega_fwd, NWAVES * 64, LDS_BYTES) != hipSuccess || per_cu < 1)
            fprintf(stderr, "kernel_launch: note: occupancy query reports %d workgroups per CU\n", per_cu);
        (void)hipGetLastError();
        grid = cus;
    }
    if (grid < 0) return;
    if (hipMemsetAsync((char*)d_ws + WS_CTL, 0, CTL_ZERO_BYTES, stream) != hipSuccess) return;
    Args a{};
    for (int i = 0; i < 18; ++i) a.in[i] = (const float*)d_in[i];
    a.out = (float*)d_out; a.ws = (unsigned char*)d_ws; a.pad = 0;
    int li = 0;
    auto launch = [&](int lo, int hi) { a.ph_lo = lo; a.ph_hi = hi; a.li = li++; hipLaunchKernelGGL(mega_fwd, dim3(grid), dim3(NWAVES * 64), LDS_BYTES, stream, a);
        const hipError_t le = hipPeekAtLastError(); if (le != hipSuccess) fprintf(stderr, "kernel_launch: launch [%d,%d) failed: %s\n", lo, hi, hipGetErrorName(le)); };
#if defined(ORACLE)
    unsigned char* ws = (unsigned char*)d_ws;
#if defined(CHECK)
    unsigned* cnt = (unsigned*)(ws + 525 * MiB + 512 * 1024); hipMemsetAsync(cnt, 0, 4096, stream);
    hipLaunchKernelGGL(ck_mfma, dim3(1), dim3(64), 0, stream, cnt + 39); hipMemsetAsync(cnt + 512 + 700, 0xFF, 8, stream);
    const float* const* in = (const float* const*)d_in; float* xs = (float*)d_out;
    const bf16* XNc = (const bf16*)(ws + WS_XN); const bf16* PAc = (const bf16*)(ws + WS_PA); const bf16* MGc = (const bf16*)(ws + WS_US);
    const bf16* YAc = (const bf16*)(ws + WS_Y); const bf16* YHc = (const bf16*)(ws + WS_YH); const float* ssqc = (const float*)(ws + WS_SSQ);
#define CKL(k, ...) hipLaunchKernelGGL(k, dim3(CK_NS), dim3(256), 0, stream, __VA_ARGS__)
#endif
    for (int l = 0; l < DEPTH; ++l) {
#if defined(CHECK)
        const float* w_in_l = in[I_WIN] + (size_t)l * D * INW; unsigned* c0 = cnt + 20 * l;
        if (l == 0) { launch(0, 1); CKL(ck_norm, in[I_X], in[I_ANG], XNc, c0 + 0); launch(1, 2); }
        else { CKL(ck_norm, (const float*)xs, in[I_ANG] + (size_t)l * D, XNc, c0 + 0); launch(16 * l + 1, 16 * l + 2); }
        CKL(ck_pa, XNc, w_in_l, in[I_LBT], l, PAc, c0 + 1);
#else
        if (l == 0) launch(0, 2); else launch(16 * l + 1, 16 * l + 2);
#endif
#if defined(ORACLE_FAST)
        launch(16 * l + 2, 16 * l + 3);
#if defined(CHECK)
        hipLaunchKernelGGL(ck_ha, dim3(CK_NS), dim3(128), 0, stream, (const bf16*)(ws + WS_PA), (const bf16*)(ws + WS_US), (const float*)(ws + WS_HD), cnt + 20 * l + 40 + 0);
#endif
        launch(16 * l + 3, 16 * l + 4);
#if defined(CHECK)
        hipLaunchKernelGGL(ck_hb, dim3(CK_NS), dim3(128), 0, stream, (const bf16*)(ws + WS_PA), (const bf16*)(ws + WS_US), cnt + 20 * l + 40 + 2);
#endif
        launch(16 * l + 4, 16 * l + 5);
#else
        hipLaunchKernelGGL(zero_f32, dim3(T * 4 / 256), dim3(256), 0, stream, (float*)(ws + WS_SSQ), T * 4);
        hipLaunchKernelGGL(simple_attn, dim3(T * 8 / 4), dim3(256), 0, stream, (const bf16*)(ws + WS_PA), (const float*)d_in[I_SINK] + l * NQH, (bf16*)(ws + WS_Y));
        hipLaunchKernelGGL(simple_hgrn, dim3(8), dim3(512), 0, stream, (const bf16*)(ws + WS_PA), (const float*)d_in[I_HNG] + l * 512, (float*)(ws + WS_US), (bf16*)(ws + WS_YH), (float*)(ws + WS_SSQ));
#endif
#if defined(CHECK)
        CKL(ck_attn, PAc, in[I_SINK] + l * NQH, YAc, c0 + 3 + 40); hipLaunchKernelGGL(ck_hgrn, dim3(CK_NS, 4), dim3(128), 0, stream, PAc, in[I_HNG] + l * 512, YHc, ssqc, c0 + 4 + 40);
        const float* wua = in[I_WUA] + (size_t)l * 512 * D; const float* wuh = in[I_WUH] + (size_t)l * 512 * D; const int pb = 16 * l;
#if defined(CK_SENTINEL)
        hipMemsetAsync(ws + WS_PA, 0xFF, (size_t)T * NGATE * 2, stream);
#endif
#if defined(CK_FLUSH)
        hipLaunchKernelGGL(ck_flush, dim3(4096), dim3(64), 0, stream);
#endif
        launch(pb + 5, pb + 6);
#if defined(CK_FLUSH)
        hipLaunchKernelGGL(ck_flush, dim3(4096), dim3(64), 0, stream);
#endif
        if (l == 0) hipLaunchKernelGGL(ck_gates_full, dim3(T * 8), dim3(256), 0, stream, XNc, w_in_l, PAc, cnt + 512); CKL(ck_mix, XNc, w_in_l, YAc, YHc, ssqc, wua, wuh, PAc, MGc, 0, c0 + 7);
        launch(pb + 6, pb + 7); CKL(ck_mix, XNc, w_in_l, YAc, YHc, ssqc, wua, wuh, PAc, MGc, 1, c0 + 7);
        launch(pb + 7, pb + 8); CKL(ck_mix, XNc, w_in_l, YAc, YHc, ssqc, wua, wuh, PAc, MGc, 2, c0 + 7);
        launch(pb + 8, pb + 9); if (l == 0) CKL(ck_out, in[I_X], MGc, in[I_WOUT], (const float*)xs, c0 + 10);
        const float* gff = in[I_FNG] + (size_t)l * D; const float* wrg = in[I_WRG] + (size_t)l * D * NGRP; const float* brg = in[I_BRG] + l * NGRP; const float* wre = in[I_WRE] + (size_t)l * NGRP * D * EPG; const float* bre = in[I_BRE] + l * NGRP * EPG;
        const float* weg = in[I_WEG] + (size_t)l * NEXP * D * DEXP; const float* weu = in[I_WEU] + (size_t)l * NEXP * D * DEXP; const float* wed = in[I_WED] + (size_t)l * NEXP * DEXP * D;
        const int* toke = (const int*)(ws + WS_TOKE); const float* tokw = (const float*)(ws + WS_TOKW); const int* tokp = (const int*)(ws + WS_TOKP); const int* metac = (const int*)(ws + WS_META);
        const bf16* XPc = (const bf16*)(ws + WS_XP); const bf16* ACTc = (const bf16*)(ws + WS_ACT);
#define CKM(st) CKL(ck_moe, (const float*)xs, gff, wrg, brg, wre, bre, weg, weu, wed, XNc, toke, tokw, tokp, metac, XPc, ACTc, XPc, st, c0 + 12)
        launch(pb + 9, pb + 10); CKL(ck_norm, (const float*)xs, gff, XNc, c0 + 11); CKM(0);
        launch(pb + 10, pb + 11); CKM(1);
        launch(pb + 11, pb + 12); CKM(2);
        launch(pb + 12, pb + 13); CKM(3);
        hipMemcpyAsync(ws + WS_US, xs, (size_t)T * D * 4 / 2, hipMemcpyDeviceToDevice, stream);
        launch(pb + 13, pb + 14);
        CKL(ck_comb, (const float*)(ws + WS_US), (const float*)xs, tokp, tokw, XPc, in[I_FING], (int)(l == DEPTH - 1), c0 + 6 + 40);
#else
#if defined(STOP_AFTER)
        launch(16 * l + 5, STOP_AFTER + 1); break;
#else
        launch(16 * l + 5, 16 * l + 14);
#endif
#endif
    }
#if defined(CHECK)
    hipLaunchKernelGGL(ck_report, dim3(1), dim3(64), 0, stream, (const unsigned*)cnt, 80, xs);
#endif
#else
    launch(0, 16 * (DEPTH - 1) + 14);
#endif
}
```

```cpp
#define NORMFOLD 1
#include <hip/hip_runtime.h>
#include <cstdio>
#include <cstdint>
namespace pg8 {
#define PG8_LAS __attribute__((address_space(3)))
typedef unsigned short bf16_t;
typedef short bf16x8 __attribute__((ext_vector_type(8)));
typedef float f32x4 __attribute__((ext_vector_type(4)));
typedef unsigned u32x4 __attribute__((ext_vector_type(4)));
typedef unsigned u32x2 __attribute__((ext_vector_type(2)));
constexpr int BM = 256, BK = 64, HALF = 128, HTB = HALF * BK * 2  , STAGE_BYTES = 8 * HTB, NXCD = 8, WGM = 8;

__host__ __device__ __forceinline__ int lds_byte(int r, int c) { const int st = (r >> 4) * 2 + (c >> 5), rr = r & 15, cc = c & 31, ob = rr * 64 + cc * 2; return st * 1024 + (ob ^ (((ob >> 9) & 1) << 5)); }
__host__ __device__ __forceinline__ void stage_rc(int b, int& R, int& C) { const int st = b / 1024, sb = b % 1024, swz = sb ^ (((sb >> 9) & 1) << 5); R = (st >> 1) * 16 + swz / 64; C = (st & 1) * 32 + (swz % 64) / 2; }
__host__ __device__ __forceinline__ int perm32(int rho) { const int n = rho >> 4, i = rho & 15; return 8 * (i >> 2) + 4 * n + (i & 3); }

struct Unit { int pm, pn, pb; };
struct Gemm { const bf16_t* A; const bf16_t* Bt; int M, N, K; };

struct StaticOrder {
    int nM, nN, nwg, G, c;
    __host__ __device__ void init(int M, int N, int G_, int c_) { nM = M / BM; nN = N / BM; nwg = nM * nN; G = G_; c = c_; }
    __host__ __device__ bool next(int i, Unit& u) const {
        const long L = (long)i * G + c; if (L >= nwg) return false;
        int wgid = (int)L; { const int q = nwg / NXCD, r = nwg % NXCD, xcd = wgid % NXCD, off = wgid / NXCD; wgid = (xcd < r ? xcd * (q + 1) : r * (q + 1) + (xcd - r) * q) + off; }
        const int nig = WGM * nN, gid = wgid / nig, fm = gid * WGM, gsz = (nM - fm) < WGM ? (nM - fm) : WGM;
        u.pm = fm + ((wgid % nig) % gsz); u.pn = (wgid % nig) / gsz; u.pb = u.pn; return true;
    }
    __device__ __forceinline__ void a_ready(const Unit&) const {}
    __device__ __forceinline__ void done(const Unit&) const {}
};
struct GroupedOrder {
    const int* meta; int nM, nN, nwg, G, base;
    __device__ __forceinline__ void init(const int* meta_, int N, int G_, int c_, bool second = false) { meta = meta_; nM = __builtin_amdgcn_readfirstlane(__hip_atomic_load(meta_, __ATOMIC_RELAXED, __HIP_MEMORY_SCOPE_AGENT)); nN = N / BM; nwg = nM * nN; G = G_;
        base = second ? (((c_ < nwg) ? (nwg - c_ + G_ - 1) / G_ : 0) * G_ + c_ - nwg) : c_; }
    __device__ __forceinline__ bool next(int i, Unit& u) const {
        int wgid = i * G + base; if (wgid >= nwg) return false;
        { const int q = nwg / NXCD, r = nwg % NXCD, xcd = wgid % NXCD, off = wgid / NXCD; wgid = (xcd < r ? xcd * (q + 1) : r * (q + 1) + (xcd - r) * q) + off; }
        const int nig = WGM * nN, gid = wgid / nig, fm = gid * WGM, gsz = (nM - fm) < WGM ? (nM - fm) : WGM;
        u.pm = fm + ((wgid % nig) % gsz); u.pn = (wgid % nig) / gsz;
        u.pb = __builtin_amdgcn_readfirstlane(__hip_atomic_load(meta + 1 + u.pm, __ATOMIC_RELAXED, __HIP_MEMORY_SCOPE_AGENT)) * nN + u.pn; return true;
    }
    __device__ __forceinline__ void a_ready(const Unit&) const {}
    __device__ __forceinline__ void done(const Unit&) const {}
};
struct ProducerOrder : GroupedOrder {
    unsigned* cnt;
    __device__ __forceinline__ void done(const Unit& u) const {
        asm volatile("s_waitcnt vmcnt(0)" ::: "memory");
        if ((threadIdx.x & 63) == 0) __hip_atomic_fetch_add(cnt + 64 * u.pm, 1u, __ATOMIC_RELAXED, __HIP_MEMORY_SCOPE_AGENT);
    }
};
struct ConsumerOrder : GroupedOrder {
    unsigned* cnt; static constexpr unsigned NEED = 32u;
    __device__ __forceinline__ void a_ready(const Unit& u) const {
        if (threadIdx.x < 64) {
            unsigned* tmo = cnt - 64;
            const unsigned long long t0 = __builtin_amdgcn_s_memrealtime(); unsigned polls = 0;
            while ((unsigned)__builtin_amdgcn_readfirstlane(__hip_atomic_load(cnt + 64 * u.pm, __ATOMIC_RELAXED, __HIP_MEMORY_SCOPE_AGENT)) < NEED) {
                if ((++polls & 255u) == 0u && __builtin_amdgcn_readfirstlane(__hip_atomic_load(tmo, __ATOMIC_RELAXED, __HIP_MEMORY_SCOPE_AGENT)) != 0u) break;
                if (__builtin_amdgcn_s_memrealtime() - t0 > 2000000ull) {
                    if (threadIdx.x == 0) { unsigned expect = 0u; __hip_atomic_compare_exchange_strong(tmo + 1, &expect, 0x600u | (unsigned)(u.pm & 0xff), __ATOMIC_RELAXED, __ATOMIC_RELAXED, __HIP_MEMORY_SCOPE_AGENT); __hip_atomic_store(tmo, 1u, __ATOMIC_RELAXED, __HIP_MEMORY_SCOPE_AGENT); }
                    break; }
                __builtin_amdgcn_s_sleep(2); }
            asm volatile("s_waitcnt vmcnt(0)" ::: "memory");
        }
        asm volatile("" ::: "memory"); __builtin_amdgcn_s_barrier(); asm volatile("" ::: "memory");
    }
};
typedef float f32x2_t __attribute__((ext_vector_type(2))); typedef __bf16 bf16x2_t __attribute__((ext_vector_type(2)));
__device__ __forceinline__ unsigned cvt_pk_bf16(float lo, float hi) { f32x2_t v = {lo, hi}; bf16x2_t b = __builtin_convertvector(v, bf16x2_t); return __builtin_bit_cast(unsigned, b); }
template <class Epi, class Sched, bool ALIGN_EPI = false, bool SP2 = false, bool GATHER = false, int A_AUX = 0>
__device__ __forceinline__ void gemm_phase(PG8_LAS unsigned char* lds, const Gemm g, const Sched& S, const Epi& E, const int* rowtab = nullptr) {
    int tid_ = threadIdx.x; asm volatile("" : "+v"(tid_));
    const int tid = tid_, wid = __builtin_amdgcn_readfirstlane(tid >> 6), lane = tid & 63, wr = wid >> 2, wc = wid & 3, fr = lane & 15, fq = lane >> 4;
    const int K = g.K, nt = K / BK;
    unsigned voffA[2], voffB[2];
#pragma unroll
    for (int i = 0; i < 2; ++i) { int R, C; stage_rc(tid * 16 + i * 8192, R, C); const int Rb = Epi::PERM ? ((R & ~31) + perm32(R & 31)) : R;
        voffA[i] = (unsigned)(R * K + C) * 2u; voffB[i] = (unsigned)(Rb * K + C) * 2u; }
    const size_t kstep = (size_t)(BK * 2);
    const size_t hstep = (size_t)HALF * K * 2;
    const size_t tstep = 2 * hstep;
    const unsigned ldsw = (unsigned)wid * 1024u;
    const int aoff = lds_byte(wr * 64 + fr, fq * 8), boff = lds_byte(wc * 32 + fr, fq * 8);
#define PG8_SA(b, h) (((b) * 2 + (h)) * HTB)
#define PG8_SB(b, h) ((4 + (b) * 2 + (h)) * HTB)
#define PG8_STAGE(bufoff, gbase, voff) do { _Pragma("unroll") for (int _i = 0; _i < 2; ++_i) \
        __builtin_amdgcn_global_load_lds((const unsigned*)((const char*)(gbase) + (voff)[_i]), (PG8_LAS unsigned*)(lds + (bufoff) + ldsw + _i * 8192), 16, 0, 0); } while (0)
#define PG8_STAGE_A(bufoff, gbase, h, RO) do { _Pragma("unroll") for (int _i = 0; _i < 2; ++_i) \
        __builtin_amdgcn_global_load_lds((const unsigned*)((const char*)(gbase) + (GATHER ? (size_t)RO[h][_i] : (size_t)(((h) ? hstep : 0) + voffA[_i]))), (PG8_LAS unsigned*)(lds + (bufoff) + ldsw + _i * 8192), 16, 0, A_AUX); } while (0)
#define PG8_ROWOFS(RO, pm_) do { if constexpr (GATHER) { _Pragma("unroll") for (int _h = 0; _h < 2; ++_h) _Pragma("unroll") for (int _i = 0; _i < 2; ++_i) { int _R, _C; stage_rc(tid * 16 + _i * 8192, _R, _C); \
        const int _tok = __hip_atomic_load(rowtab + (pm_) * 256 + _h * 128 + _R, __ATOMIC_RELAXED, __HIP_MEMORY_SCOPE_AGENT); RO[_h][_i] = (unsigned)_tok * (unsigned)(K * 2) + (unsigned)(_C * 2); } } } while (0)
#define PG8_LDA(dst, b, h) do { _Pragma("unroll") for (int m = 0; m < 4; ++m) _Pragma("unroll") for (int k = 0; k < 2; ++k) dst[m][k] = *(const PG8_LAS bf16x8*)(lds + PG8_SA(b, h) + aoff + m * 2048 + k * 1024); } while (0)
#define PG8_LDB(dst, b, h) do { _Pragma("unroll") for (int n = 0; n < 2; ++n) _Pragma("unroll") for (int k = 0; k < 2; ++k) dst[n][k] = *(const PG8_LAS bf16x8*)(lds + PG8_SB(b, h) + boff + n * 2048 + k * 1024); } while (0)
#define PG8_MMA(ai, bj, At, Bt) do { __builtin_amdgcn_s_setprio(1); _Pragma("unroll") for (int m = 0; m < 4; ++m) _Pragma("unroll") for (int n = 0; n < 2; ++n) _Pragma("unroll") for (int k = 0; k < 2; ++k) \
        acc[ai][bj][m][n] = __builtin_amdgcn_mfma_f32_16x16x32_bf16(Bt[n][k], At[m][k], acc[ai][bj][m][n], 0, 0, 0); __builtin_amdgcn_s_setprio(0); } while (0)
#define PG8_WAIT_V(n) asm volatile("s_waitcnt vmcnt(" #n ")" ::: "memory")
#define PG8_WAIT_L(n) asm volatile("s_waitcnt lgkmcnt(" #n ")" ::: "memory")
#define PG8_BAR __builtin_amdgcn_s_barrier()
#define PG8_SCHED __builtin_amdgcn_sched_barrier(0)
    Unit cur, nxt; int ui = 0;
    if (!S.next(0, cur)) return;
    f32x4 acc[2][2][4][2];
#pragma unroll
    for (int a = 0; a < 2; ++a)
#pragma unroll
        for (int b = 0; b < 2; ++b)
#pragma unroll
            for (int m = 0; m < 4; ++m)
#pragma unroll
                for (int n = 0; n < 2; ++n) acc[a][b][m][n] = (f32x4){0.f, 0.f, 0.f, 0.f};
    bf16x8 At[4][2], B0[2][2], B1[2][2];
    const char* cA = (const char*)g.A + (GATHER ? (size_t)0 : (size_t)cur.pm * tstep); const char* cB = (const char*)g.Bt + (size_t)cur.pb * tstep;
    unsigned rofsC[2][2] = {{0u, 0u}, {0u, 0u}}, rofsN[2][2] = {{0u, 0u}, {0u, 0u}};
    PG8_ROWOFS(rofsC, cur.pm);
    S.a_ready(cur);
    if constexpr (SP2) {
        PG8_STAGE(PG8_SB(0, 0), cB, voffB); PG8_STAGE(PG8_SB(0, 1), cB + hstep, voffB); PG8_STAGE_A(PG8_SA(0, 0), cA, 0, rofsC); PG8_STAGE_A(PG8_SA(0, 1), cA, 1, rofsC);
        if (wr == 1) PG8_BAR;
        PG8_WAIT_V(2); PG8_BAR;
        PG8_STAGE(PG8_SB(1, 0), cB + kstep, voffB); PG8_STAGE_A(PG8_SA(1, 0), cA + kstep, 0, rofsC); PG8_STAGE(PG8_SB(1, 1), cB + hstep + kstep, voffB);
        PG8_WAIT_V(6); PG8_BAR;
    } else {
        PG8_STAGE(PG8_SB(0, 0), cB, voffB); PG8_STAGE_A(PG8_SA(0, 0), cA, 0, rofsC); PG8_STAGE(PG8_SB(0, 1), cB + hstep, voffB); PG8_STAGE_A(PG8_SA(0, 1), cA, 1, rofsC);
        if (wr == 1) PG8_BAR;
        PG8_WAIT_V(4); PG8_BAR;
        PG8_STAGE(PG8_SB(1, 0), cB + kstep, voffB); PG8_STAGE_A(PG8_SA(1, 0), cA + kstep, 0, rofsC); PG8_STAGE(PG8_SB(1, 1), cB + hstep + kstep, voffB);
        PG8_WAIT_V(6); PG8_BAR;
    }
    for (;;) {
        const bool has_next = S.next(ui + 1, nxt);
        const char* nA = (has_next && !GATHER) ? (const char*)g.A + (size_t)nxt.pm * tstep : cA; const char* nB = has_next ? (const char*)g.Bt + (size_t)nxt.pb * tstep : cB;
        for (int t = 0; t < nt; t += 2) {
            const bool last = (t == nt - 2);
            const char* a1 = cA + (size_t)(t + 1) * kstep;
            const char* a2 = last ? nA : cA + (size_t)(t + 2) * kstep; const char* b2 = last ? nB : cB + (size_t)(t + 2) * kstep;
            const char* a3 = a2 + kstep; const char* b3 = b2 + kstep;
            if (last && has_next) { S.a_ready(nxt); PG8_ROWOFS(rofsN, nxt.pm); }
            unsigned ro2[2][2];
#pragma unroll
            for (int _h = 0; _h < 2; ++_h)
#pragma unroll
                for (int _i = 0; _i < 2; ++_i) ro2[_h][_i] = (last && has_next) ? rofsN[_h][_i] : rofsC[_h][_i];
            if constexpr (SP2) {
            PG8_LDB(B0, 0, 0); PG8_LDB(B1, 0, 1); PG8_SCHED; PG8_LDA(At, 0, 0); PG8_STAGE_A(PG8_SA(1, 1), a1, 1, rofsC);
            PG8_WAIT_V(8); PG8_WAIT_L(0); PG8_BAR; PG8_MMA(0, 0, At, B0); PG8_MMA(0, 1, At, B1); PG8_BAR; PG8_SCHED;
            PG8_LDA(At, 0, 1); PG8_STAGE(PG8_SB(0, 0), b2, voffB); PG8_STAGE(PG8_SB(0, 1), b2 + hstep, voffB); PG8_STAGE_A(PG8_SA(0, 0), a2, 0, ro2);
            PG8_WAIT_V(8); PG8_WAIT_L(0); PG8_BAR; PG8_MMA(1, 0, At, B0); PG8_MMA(1, 1, At, B1); PG8_BAR; PG8_SCHED;
            PG8_LDB(B0, 1, 0); PG8_LDB(B1, 1, 1); PG8_SCHED; PG8_LDA(At, 1, 0); PG8_STAGE_A(PG8_SA(0, 1), a2, 1, ro2);
            PG8_WAIT_V(8); PG8_WAIT_L(0); PG8_BAR; PG8_MMA(0, 0, At, B0); PG8_MMA(0, 1, At, B1); PG8_BAR; PG8_SCHED;
            PG8_LDA(At, 1, 1); PG8_STAGE(PG8_SB(1, 0), b3, voffB); PG8_STAGE(PG8_SB(1, 1), b3 + hstep, voffB); PG8_STAGE_A(PG8_SA(1, 0), a3, 0, ro2);
            PG8_WAIT_V(8); PG8_WAIT_L(0); PG8_BAR; PG8_MMA(1, 0, At, B0); PG8_MMA(1, 1, At, B1); PG8_BAR; PG8_SCHED;
            } else {
            PG8_LDB(B0, 0, 0); PG8_SCHED; PG8_LDA(At, 0, 0); PG8_STAGE_A(PG8_SA(1, 1), a1, 1, rofsC);
            PG8_WAIT_L(8); PG8_BAR; PG8_WAIT_L(0); PG8_MMA(0, 0, At, B0); PG8_BAR; PG8_SCHED;
            PG8_LDB(B1, 0, 1); PG8_STAGE(PG8_SB(0, 0), b2, voffB);
            PG8_BAR; PG8_WAIT_L(0); PG8_MMA(0, 1, At, B1); PG8_BAR;
            PG8_LDA(At, 0, 1); PG8_STAGE_A(PG8_SA(0, 0), a2, 0, ro2);
            PG8_BAR; PG8_WAIT_L(0); PG8_MMA(1, 0, At, B0); PG8_BAR; PG8_SCHED;
            PG8_STAGE(PG8_SB(0, 1), b2 + hstep, voffB);
            PG8_WAIT_V(6); PG8_BAR; PG8_MMA(1, 1, At, B1); PG8_BAR;
            PG8_LDB(B0, 1, 0); PG8_SCHED; PG8_LDA(At, 1, 0); PG8_STAGE_A(PG8_SA(0, 1), a2, 1, ro2);
            PG8_WAIT_L(8); PG8_BAR; PG8_WAIT_L(0); PG8_MMA(0, 0, At, B0); PG8_BAR; PG8_SCHED;
            PG8_LDB(B1, 1, 1); PG8_STAGE(PG8_SB(1, 0), b3, voffB);
            PG8_BAR; PG8_WAIT_L(0); PG8_MMA(0, 1, At, B1); PG8_BAR;
            PG8_LDA(At, 1, 1); PG8_STAGE_A(PG8_SA(1, 0), a3, 0, ro2);
            PG8_BAR; PG8_WAIT_L(0); PG8_MMA(1, 0, At, B0); PG8_BAR; PG8_SCHED;
            PG8_STAGE(PG8_SB(1, 1), b3 + hstep, voffB);
            PG8_WAIT_V(6); PG8_BAR; PG8_MMA(1, 1, At, B1); PG8_BAR;
            }
        }
        if constexpr (ALIGN_EPI) { if (wr == 0) PG8_BAR; }
        if constexpr (!Epi::AFTER_DRAIN) { E(acc, cur, wr, wc, fr, fq); S.done(cur); }
        if (!has_next) break;
#pragma unroll
        for (int a = 0; a < 2; ++a)
#pragma unroll
            for (int b = 0; b < 2; ++b)
#pragma unroll
                for (int m = 0; m < 4; ++m)
#pragma unroll
                    for (int n = 0; n < 2; ++n) acc[a][b][m][n] = (f32x4){0.f, 0.f, 0.f, 0.f};
        cur = nxt; cA = nA; cB = nB; ++ui;
#pragma unroll
        for (int _h = 0; _h < 2; ++_h)
#pragma unroll
            for (int _i = 0; _i < 2; ++_i) rofsC[_h][_i] = rofsN[_h][_i];
        if constexpr (ALIGN_EPI) { if (wr == 1) PG8_BAR; }
    }
    PG8_WAIT_V(0);
    if constexpr (!ALIGN_EPI) { if (wr == 0) PG8_BAR; }
    PG8_BAR;
    if constexpr (Epi::AFTER_DRAIN) { E.fused(acc, cur, wr, wc, fr, fq, lds, wid, lane); S.done(cur); }
#undef PG8_SA
#undef PG8_SB
#undef PG8_STAGE
#undef PG8_STAGE_A
#undef PG8_ROWOFS
#undef PG8_LDA
#undef PG8_LDB
#undef PG8_MMA
#undef PG8_WAIT_V
#undef PG8_WAIT_L
#undef PG8_BAR
#undef PG8_SCHED
}
}


constexpr int NWAVES = 8;
constexpr int BATCH = 2, SEQ = 16384, D = 1024, T = BATCH * SEQ, DEPTH = 2;
constexpr int NQH = 8, NKVH = 2, HD = 64, WINDOW = 128;
constexpr int HH = 4, HDK = 128;
constexpr int NGRP = 4, EPG = 8, NEXP = 32, DEXP = 512;
constexpr int INW = 5376, NPA = 3328, NGATE = 2048;
constexpr int C_QA = 0, C_KA = 512, C_VA = 640, C_QH = 768, C_LF = 1280, C_LB = 1792, C_VH = 2304, C_SG = 2816;
constexpr float NORM_EPS = 1e-6f, LOGF_MIN = -4.0f;
constexpr float LOG2E = 1.4426950408889634f;
constexpr float QSCALE = 0.125f * LOG2E;
constexpr int CH = 128, NCH = SEQ / CH;
constexpr int SLOT_ROWS = 73728;

constexpr size_t MiB = 1u << 20;
constexpr size_t WS_CTL = 0, CTL_ZERO_BYTES = 1 * MiB;
constexpr size_t WS_COS = 1 * MiB, WS_SIN = 3 * MiB, WS_LBT = 5 * MiB;
constexpr size_t WS_WIN = 6 * MiB, WS_WUA = 17 * MiB, WS_WUH = 18 * MiB, WS_WOUT = 19 * MiB, WS_W1 = 22 * MiB, WS_W2 = 86 * MiB;
constexpr size_t WS_XN = 118 * MiB;
constexpr size_t WS_PA = 182 * MiB;
constexpr size_t WS_US = 390 * MiB;
constexpr size_t WS_Y = 454 * MiB;
constexpr size_t WS_YH = 486 * MiB;
constexpr size_t WS_HD = 518 * MiB;
constexpr size_t WS_SSQ = 519 * MiB;
constexpr size_t WS_TOKE = 520 * MiB, WS_TOKW = 521 * MiB, WS_TOKR = 522 * MiB, WS_TOKP = 523 * MiB;
constexpr size_t WS_WGCNT = 524 * MiB;
constexpr size_t WS_META = 524 * MiB + 512 * 1024;
constexpr size_t WS_STOK = 525 * MiB;
constexpr size_t WS_RSA = 526 * MiB;
constexpr size_t WS_RSF = 526 * MiB + 128 * 1024;
constexpr size_t WS_RSS = 526 * MiB + 256 * 1024;
constexpr size_t WS_END = 527 * MiB;
constexpr size_t WS_XP = WS_PA;
constexpr size_t WS_ACT = WS_PA + (size_t)SLOT_ROWS * D * 2;
static_assert(WS_ACT + (size_t)SLOT_ROWS * DEXP * 2 <= WS_Y, "MoE overlay");
static_assert(WS_PA + (size_t)T * NPA * 2 <= WS_US && WS_W2 + (size_t)NEXP * D * DEXP * 2 <= WS_XN && WS_WIN + (size_t)INW * D * 2 <= WS_WUA, "ws map");
constexpr int CW_TMO = 0, CW_CODE = 1;
constexpr int CW_BAR = 4096;
#ifndef G1A_SPLIT
#define G1A_SPLIT 0
#endif
#ifndef CONV_WGS
#define CONV_WGS 16
#endif
#ifndef CONV_WGS_MOE
#define CONV_WGS_MOE 32
#endif
#ifndef CONV_PER_WG1
#define CONV_PER_WG1 512
#endif
#ifndef CONV_PER_WG2
#define CONV_PER_WG2 256
#endif
#ifndef CONV_PER_WG12
#define CONV_PER_WG12 192
#endif
#ifndef NORM4
#define NORM4 0
#endif
#ifndef NORMFOLD
#define NORMFOLD 0
#endif
#ifndef XBF16
#define XBF16 1
#endif
#ifndef CONV_ASM_LOADS
#define CONV_ASM_LOADS 0
#endif
#ifndef EXPERTS_BY_QUEUE
#define EXPERTS_BY_QUEUE 1
#endif
#ifndef MOE_HANDOFF
#define MOE_HANDOFF 0
#endif
constexpr int MAX_LAUNCH = 16;
constexpr int CW_H12 = 2048;
constexpr int CW_MOE = 131072, MOE_BANK = 320 * 64;

constexpr int RING_OFF = 0, RING_BYTES = 131072;
constexpr int LDSCTL_OFF = RING_BYTES, MISC_OFF = LDSCTL_OFF + 320;
#ifndef ROUTE4
#define ROUTE4 1
#endif
constexpr int LDS_BYTES = ROUTE4 ? 163840 : 147456;

#define GAS __attribute__((address_space(1)))
#define LAS __attribute__((address_space(3)))
typedef unsigned short bf16;
typedef unsigned v4u __attribute__((ext_vector_type(4)));
typedef unsigned v2u __attribute__((ext_vector_type(2)));
typedef float f32x4 __attribute__((ext_vector_type(4)));
typedef short bf16x8 __attribute__((ext_vector_type(8)));
typedef short s16x4 __attribute__((ext_vector_type(4)));
typedef _Float16 h16x4 __attribute__((ext_vector_type(4)));
typedef _Float16 h16x8 __attribute__((ext_vector_type(8)));
typedef GAS unsigned gu32;
typedef GAS unsigned long long gu64;
#define RLX_AGENT __ATOMIC_RELAXED, __HIP_MEMORY_SCOPE_AGENT
#define LDS_WAIT() asm volatile("s_waitcnt lgkmcnt(0)" ::: "memory")
#define VM_WAIT() asm volatile("s_waitcnt vmcnt(0)" ::: "memory")
__device__ __forceinline__ unsigned f2bf(float f) { unsigned u = __builtin_bit_cast(unsigned, f); return (u + 0x7fffu + ((u >> 16) & 1u)) >> 16; }
__device__ __forceinline__ unsigned pk2(float lo, float hi) { return f2bf(lo) | (f2bf(hi) << 16); }
__device__ __forceinline__ float bf2f(unsigned short b) { return __builtin_bit_cast(float, ((unsigned)b) << 16); }
__device__ __forceinline__ float bflo(unsigned w) { return __builtin_bit_cast(float, w << 16); }
__device__ __forceinline__ float bfhi(unsigned w) { return __builtin_bit_cast(float, w & 0xffff0000u); }
__device__ __forceinline__ float fast_rcp(float x) { return __builtin_amdgcn_rcpf(x); }
__device__ __forceinline__ float sigmoidf_(float x) { return fast_rcp(1.0f + __expf(-x)); }
__device__ __forceinline__ float siluf_(float x) { return x * fast_rcp(1.0f + __expf(-x)); }

#define XB_TMO      128
#define XB_XCNT(j)  (256  + 64 * (j))
#define XB_XSUB(j)  (1280 + 64 * (j))
#define XB_XGEN(j)  (2304 + 64 * (j))
#define XB_TOP      3328
#define XB_TOPGEN   3392
#define XCD_BAR_WORDS 3456
#define XB_SPIN_CAP (1u << 18)

__device__ __forceinline__ unsigned xb_ld(unsigned* p)              { return __hip_atomic_load(p, __ATOMIC_RELAXED, __HIP_MEMORY_SCOPE_AGENT); }
__device__ __forceinline__ unsigned xb_add(unsigned* p, unsigned v) { return __hip_atomic_fetch_add(p, v, __ATOMIC_RELAXED, __HIP_MEMORY_SCOPE_AGENT); }
__device__ __forceinline__ unsigned xb_xcc_id() { return (unsigned)__builtin_amdgcn_s_getreg((3 << 11) | 20) & 0xFu; }
#define XB_SPIN(cond, bar) do { unsigned _sp = 0; while (cond) { __builtin_amdgcn_s_sleep(1); \
    if ((++_sp & 255u) == 0u) { if (xb_ld(&(bar)[XB_TMO])) break; if (_sp > XB_SPIN_CAP) { atomicAdd(&(bar)[XB_TMO], 1u); break; } } } } while (0)

struct XcdBarrier {
    unsigned* bar; unsigned x;
    volatile LAS unsigned* st;
};

__device__ __forceinline__ XcdBarrier xcd_barrier_post(unsigned* bar, volatile LAS unsigned* st) {
    XcdBarrier b; b.bar = bar; b.x = xb_xcc_id(); b.st = st;
    if (threadIdx.x == 0) (void)xb_add(&bar[XB_XCNT(b.x)], 1u);
    return b;
}
__device__ __forceinline__ void xcd_barrier_complete(unsigned* bar, unsigned x, unsigned& nloc, unsigned& nx) {
    const unsigned G = gridDim.x * gridDim.y * gridDim.z;
    unsigned sum, cnt, mine, sp = 0u;
    for (;;) {
        sum = 0u; cnt = 0u; mine = 0u;
#pragma unroll
        for (unsigned j = 0; j < 16; ++j) { const unsigned c = xb_ld(&bar[XB_XCNT(j)]); sum += c; cnt += (c > 0u) ? 1u : 0u; mine = (j == x) ? c : mine; }
        if (sum == G) break;
        __builtin_amdgcn_s_sleep(1);
        if ((++sp & 255u) == 0u) { if (xb_ld(&bar[XB_TMO])) break; if (sp > XB_SPIN_CAP) { atomicAdd(&bar[XB_TMO], 1u); break; } }
    }
    nloc = mine > 0u ? mine : 1u; nx = cnt > 0u ? cnt : 1u;
}

__device__ __forceinline__ void xcd_barrier(const XcdBarrier& b) {
    asm volatile("s_waitcnt vmcnt(0)" ::: "memory");
    __syncthreads();
    if (threadIdx.x == 0) {
        unsigned* bar = b.bar;
        __builtin_amdgcn_s_waitcnt(0);
        unsigned nloc = b.st[0], nx = b.st[1];
        if (nloc == 0u) { xcd_barrier_complete(bar, b.x, nloc, nx); b.st[0] = nloc; b.st[1] = nx; }
        const unsigned old = xb_add(&bar[XB_XSUB(b.x)], 1u);
        const unsigned gen = old / nloc;
        if (old + 1u == (gen + 1u) * nloc) {
            __builtin_amdgcn_fence(__ATOMIC_RELEASE, "agent");
            asm volatile("s_waitcnt vmcnt(0)" ::: "memory");
            const unsigned og = xb_add(&bar[XB_TOP], 1u);
            const unsigned tg = og / nx;
            if (og + 1u == (tg + 1u) * nx) xb_add(&bar[XB_TOPGEN], 1u);
            else XB_SPIN(xb_ld(&bar[XB_TOPGEN]) == tg, bar);
            __builtin_amdgcn_fence(__ATOMIC_ACQUIRE, "agent");
            xb_add(&bar[XB_XGEN(b.x)], 1u);
            asm volatile("s_waitcnt vmcnt(0)" ::: "memory");
        } else {
            XB_SPIN(xb_ld(&bar[XB_XGEN(b.x)]) == gen, bar);
            __builtin_amdgcn_fence(__ATOMIC_ACQUIRE, "agent");
            asm volatile("s_waitcnt vmcnt(0)" ::: "memory");
        }
    }
    __syncthreads();
}

struct Frame {
    LAS unsigned char* lds;
    volatile LAS unsigned* MISC;
    gu32* ctl;
    int tid, lane, wave, vcu, G;
    unsigned char* ws;
    float* out;
};
struct Args { const float* in[18]; float* out; unsigned char* ws; int ph_lo, ph_hi, li, pad; };
enum { I_X = 0, I_ANG, I_WIN, I_SINK, I_LBT, I_HNG, I_WUA, I_WUH, I_WOUT, I_FNG, I_WRG, I_BRG, I_WRE, I_BRE, I_WEG, I_WEU, I_WED, I_FING };

__device__ __forceinline__ float wave_sum(float v) {
#if defined(__HIP_DEVICE_COMPILE__)
#define WS_ROR(n) v += __builtin_bit_cast(float, __builtin_amdgcn_update_dpp(0, __builtin_bit_cast(int, v), 0x120 + (n), 0xf, 0xf, false))
    WS_ROR(8); WS_ROR(4); WS_ROR(2); WS_ROR(1);
#undef WS_ROR
    const int b = __builtin_bit_cast(int, v);
    const float r0 = __builtin_bit_cast(float, __builtin_amdgcn_readlane(b, 0)), r1 = __builtin_bit_cast(float, __builtin_amdgcn_readlane(b, 16));
    const float r2 = __builtin_bit_cast(float, __builtin_amdgcn_readlane(b, 32)), r3 = __builtin_bit_cast(float, __builtin_amdgcn_readlane(b, 48));
    return (r0 + r1) + (r2 + r3);
#else
    return v;
#endif
}

struct CmPerm { const float* W; int N; __device__ __forceinline__ const float* seg(int p0, int n, int c, int& ld) const { ld = N; return W + p0 + 8 * c + 4 * n; } };
struct CmIn { const float* W; __device__ __forceinline__ const float* seg(int p0, int n, int c, int& ld) const { ld = INW;
    return (p0 < C_VA) ? (W + (p0 & ~63) + 32 * n + 16 * ((p0 >> 5) & 1) + 4 * c) : (W + p0 + 8 * c + 4 * n); } };
struct CmGU { const float* Wg; const float* Wu; __device__ __forceinline__ const float* seg(int p0, int n, int c, int& ld) const { ld = DEXP; return (n ? Wu : Wg) + 16 * (p0 >> 5) + 4 * c; } };
template <class CM> __device__ __forceinline__ void transpose_load(const CM& cm, int kb, int nb, int lane, f32x4 (&v)[8]) {
    const int k0 = 64 * kb, n0 = 32 * nb;
    const int nc = lane & 7, kr = lane >> 3;
    int ld; const float* src; { const float* s0 = cm.seg(n0, 0, nc & 3, ld); const float* s1 = cm.seg(n0, 1, nc & 3, ld); src = (nc >> 2) ? s1 : s0; }
#pragma unroll
    for (int i = 0; i < 8; ++i) v[i] = *(const GAS f32x4*)(src + (size_t)(k0 + 8 * i + kr) * ld);
}
__device__ __forceinline__ void transpose_finish(int K, bf16* WT, LAS float* scr, int kb, int nb, int lane, const f32x4 (&v)[8], const LAS float* gk = nullptr) {
    constexpr int SP = 36;
    const int k0 = 64 * kb, n0 = 32 * nb;
    const int nc = lane & 7, kr = lane >> 3;
#pragma unroll
    for (int i = 0; i < 8; ++i) *(LAS f32x4*)(scr + (8 * i + kr) * SP + 4 * nc) = gk ? v[i] * gk[k0 + 8 * i + kr] : v[i];
    LDS_WAIT(); asm volatile("" ::: "memory");
    const int c = lane & 7;
#pragma unroll
    for (int j = 0; j < 4; ++j) { const int n = (lane >> 3) + 8 * j; const LAS float* s = scr + (8 * c) * SP + n;
        v4u o; o.x = pk2(s[0 * SP], s[1 * SP]); o.y = pk2(s[2 * SP], s[3 * SP]); o.z = pk2(s[4 * SP], s[5 * SP]); o.w = pk2(s[6 * SP], s[7 * SP]);
        *(GAS v4u*)(WT + (size_t)(n0 + n) * K + k0 + 8 * c) = o; }
    LDS_WAIT(); asm volatile("" ::: "memory");
}
template <class CM> __device__ __forceinline__ void transpose_item(const CM& cm, int K, bf16* WT, LAS float* scr, int kb, int nb, int lane, const LAS float* gk = nullptr) {
    f32x4 v[8]; transpose_load(cm, kb, nb, lane, v); transpose_finish(K, WT, scr, kb, nb, lane, v, gk);
}
__device__ __forceinline__ void conv_weights(Frame& F, const Args& A, int l) {
    LAS float* scr = (LAS float*)(F.lds + RING_OFF + F.wave * 16384);
    const int gw = F.vcu * NWAVES + F.wave, NGW = F.G * NWAVES;
    unsigned char* ws = F.ws;
    const float* w_in = A.in[I_WIN] + (size_t)l * D * INW;
    const float* w_ua = A.in[I_WUA] + (size_t)l * 512 * D;
    const float* w_uh = A.in[I_WUH] + (size_t)l * 512 * D;
    const float* w_out = A.in[I_WOUT] + (size_t)l * D * D;
    const float* w_eg = A.in[I_WEG] + (size_t)l * NEXP * D * DEXP;
    const float* w_eu = A.in[I_WEU] + (size_t)l * NEXP * D * DEXP;
    const float* w_ed = A.in[I_WED] + (size_t)l * NEXP * DEXP * D;
    constexpr int I_A = 16 * (INW / 32), I_B = 8 * 32, I_D = 16 * 32, I_E1 = 16 * 32, I_E = NEXP * I_E1, I_F1 = 8 * 32, I_F = NEXP * I_F1;
    constexpr int NITEMS = I_A + 2 * I_B + I_D + (EXPERTS_BY_QUEUE ? 0 : I_E + I_F);
    LAS float* gkl = scr + 2560;
    if (NORMFOLD) { const float* gsrc = A.in[I_ANG] + (size_t)l * D;
#pragma unroll
        for (int j = 0; j < 4; ++j) *(LAS f32x4*)(gkl + 4 * F.lane + 256 * j) = *(const f32x4*)(gsrc + 4 * F.lane + 256 * j);
        LDS_WAIT(); }
    for (int it = gw; it < NITEMS; it += NGW) {
        int r = it;
        if (r < I_A) { CmIn cm{w_in}; transpose_item(cm, D, (bf16*)(ws + WS_WIN), scr, r / (INW / 32), r % (INW / 32), F.lane, NORMFOLD ? gkl : nullptr); continue; } r -= I_A;
        if (r < I_B) { CmPerm cm{w_ua, D}; transpose_item(cm, 512, (bf16*)(ws + WS_WUA), scr, r / 32, r % 32, F.lane); continue; } r -= I_B;
        if (r < I_B) { CmPerm cm{w_uh, D}; transpose_item(cm, 512, (bf16*)(ws + WS_WUH), scr, r / 32, r % 32, F.lane); continue; } r -= I_B;
        if (r < I_D) { CmPerm cm{w_out, D}; transpose_item(cm, D, (bf16*)(ws + WS_WOUT), scr, r / 32, r % 32, F.lane); continue; } r -= I_D;
        if (r < I_E) { const int e = r / I_E1, q = r % I_E1; CmGU cm{w_eg + (size_t)e * D * DEXP, w_eu + (size_t)e * D * DEXP};
            transpose_item(cm, D, (bf16*)(ws + WS_W1) + (size_t)e * 1024 * D, scr, q / 32, q % 32, F.lane); continue; } r -= I_E;
        { const int e = r / I_F1, q = r % I_F1; CmPerm cm{w_ed + (size_t)e * DEXP * D, D};
            transpose_item(cm, DEXP, (bf16*)(ws + WS_W2) + (size_t)e * D * DEXP, scr, q / 32, q % 32, F.lane); }
    }
}
__device__ __forceinline__ int conv_wgs(int G, int units, int cmax) {
    if (!EXPERTS_BY_QUEUE || G < 64 || (G % 8) != 0) return 0;
    const int r = (units + G - 1) / G; int c = cmax;
    while (c > 0 && (units + (G - c) - 1) / (G - c) > r) c -= 8;
    return c;
}
__device__ __forceinline__ void conv_experts_range(Frame& F, const Args& A, int l, int first, int last, int wi, int nw) {
    LAS float* scr = (LAS float*)(F.lds + RING_OFF + F.wave * 16384);
    unsigned char* ws = F.ws;
    const float* w_eg = A.in[I_WEG] + (size_t)l * NEXP * D * DEXP;
    const float* w_eu = A.in[I_WEU] + (size_t)l * NEXP * D * DEXP;
    const float* w_ed = A.in[I_WED] + (size_t)l * NEXP * DEXP * D;
    LAS float* gkl = scr + 2560;
    if (NORMFOLD && first < last) { const float* gsrc = A.in[I_FNG] + (size_t)l * D;
#pragma unroll
        for (int j = 0; j < 4; ++j) *(LAS f32x4*)(gkl + 4 * F.lane + 256 * j) = *(const f32x4*)(gsrc + 4 * F.lane + 256 * j);
        LDS_WAIT(); }
    constexpr int I_E1 = 16 * 32, I_E = NEXP * I_E1, I_F1 = 8 * 32;
    static_assert(I_E % 2 == 0 && I_F1 % 2 == 0, "pairs do not straddle");
#define CQ_LOAD(q, va, vb) do { const bool w1_ = (q) < I_E; const int r0_ = w1_ ? (q) : (q) - I_E, e_ = w1_ ? (r0_ >> 9) : (r0_ >> 8), r_ = w1_ ? (r0_ & 511) : (r0_ & 255), kb_ = r_ >> 5, nb_ = r_ & 31; \
        const int nc_ = F.lane & 7, kr_ = F.lane >> 3, n_ = nc_ >> 2, c_ = nc_ & 3; const size_t eo_ = (size_t)e_ * D * DEXP; \
        const float* base_ = w1_ ? ((n_ ? w_eu : w_eg) + eo_ + 16 * nb_ + 4 * c_) : (w_ed + eo_ + 32 * nb_ + 8 * c_ + 4 * n_); const int ld_ = w1_ ? DEXP : D, st_ = w1_ ? 16 : 32; \
        _Pragma("unroll") for (int i_ = 0; i_ < 8; ++i_) { const GAS float* p_ = (const GAS float*)(base_ + (size_t)(64 * kb_ + 8 * i_ + kr_) * ld_); const GAS float* p2_ = p_ + st_; \
            CQ_LD(va[i_], p_); CQ_LD(vb[i_], p2_); } } while (0)
#if CONV_ASM_LOADS
#define CQ_LD(dst, p) asm volatile("global_load_dwordx4 %0, %1, off" : "=&v"(dst) : "v"(p) : "memory")
#define CQ_WAIT(n, va, vb) asm volatile("s_waitcnt vmcnt(" #n ")" : "+v"(va[0]), "+v"(va[1]), "+v"(va[2]), "+v"(va[3]), "+v"(va[4]), "+v"(va[5]), "+v"(va[6]), "+v"(va[7]), \
        "+v"(vb[0]), "+v"(vb[1]), "+v"(vb[2]), "+v"(vb[3]), "+v"(vb[4]), "+v"(vb[5]), "+v"(vb[6]), "+v"(vb[7]) :: "memory")
#else
#define CQ_LD(dst, p) dst = *(const GAS f32x4*)(p)
#define CQ_WAIT(n, va, vb) do { } while (0)
#endif
#define CQ_FINISH(q, va, vb) do { const bool w1_ = (q) < I_E; const int r0_ = w1_ ? (q) : (q) - I_E, e_ = w1_ ? (r0_ >> 9) : (r0_ >> 8), r_ = w1_ ? (r0_ & 511) : (r0_ & 255); \
        bf16* WT_ = (w1_ ? (bf16*)(ws + WS_W1) : (bf16*)(ws + WS_W2)) + (size_t)e_ * (w1_ ? 1024 * D : D * DEXP); const int K_ = w1_ ? D : DEXP; \
        const LAS float* gk_ = (NORMFOLD && w1_) ? gkl : nullptr; transpose_finish(K_, WT_, scr, r_ >> 5, r_ & 31, F.lane, va, gk_); transpose_finish(K_, WT_, scr, r_ >> 5, (r_ & 31) + 1, F.lane, vb, gk_); } while (0)
    static_assert(I_E1 == 512 && I_F1 == 256, "shifts above");
    f32x4 a0[8], a1[8], b0[8], b1[8];
    const int step = 2 * nw;
    int qa = first + 2 * wi, qb; if (qa >= last) return;
    CQ_LOAD(qa, a0, a1);
    for (;;) {
        qb = qa + step; const bool hb = qb < last; { const int ql = hb ? qb : qa; CQ_LOAD(ql, b0, b1); }
        CQ_WAIT(16, a0, a1); CQ_FINISH(qa, a0, a1);
        if (!hb) { CQ_WAIT(0, b0, b1); break; }
        qa = qb + step; const bool ha = qa < last; { const int ql = ha ? qa : qb; CQ_LOAD(ql, a0, a1); }
        CQ_WAIT(16, b0, b1); CQ_FINISH(qb, b0, b1);
        if (!ha) { CQ_WAIT(0, a0, a1); break; }
    }
#undef CQ_WAIT
#undef CQ_LD
#undef CQ_LOAD
#undef CQ_FINISH
}
__device__ __forceinline__ void make_tables(Frame& F, const Args& A) {
    const int gt = F.vcu * (NWAVES * 64) + F.tid, NT = F.G * NWAVES * 64;
    float* cosT = (float*)(F.ws + WS_COS); float* sinT = (float*)(F.ws + WS_SIN); float* lbt = (float*)(F.ws + WS_LBT);
    for (int idx = gt; idx < SEQ * 32; idx += NT) { const int pos = idx >> 5, i = idx & 31;
        const double inv = exp2(-(double)i * (13.287712379549449 / 32.0));
        const double ang = (double)pos * inv; const double r = ang - 6.283185307179586476925 * rint(ang * 0.15915494309189533577);
        float s, c; sincosf((float)r, &s, &c); cosT[idx] = c; sinT[idx] = s; }
    for (int idx = gt; idx < 2 * 512; idx += NT) { const int dir = idx >> 9, col = idx & 511;
        float tv[DEPTH]; float mx = -3.0e38f;
#pragma unroll
        for (int l = 0; l < DEPTH; ++l) { tv[l] = A.in[I_LBT][(size_t)(l * 2 + dir) * 512 + col]; mx = fmaxf(mx, tv[l]); }
        float den = 0.f;
#pragma unroll
        for (int l = 0; l < DEPTH; ++l) { tv[l] = expf(tv[l] - mx); den += tv[l]; }
        float cum = 0.f;
#pragma unroll
        for (int l = 0; l < DEPTH; ++l) { if (l > 0) cum += tv[l] / den; const float lb = cum;
            lbt[((l * 2 + dir) * 2 + 0) * 512 + col] = lb; lbt[((l * 2 + dir) * 2 + 1) * 512 + col] = 0.f; } }
}
__device__ __forceinline__ void norm_rows(Frame& F, const float* xin, float* xcopy, const float* g, bf16* xn, float* rs_out = nullptr) {
    const int gw = F.vcu * NWAVES + F.wave, NGW = F.G * NWAVES;
    f32x4 gv[4];
#pragma unroll
    for (int j = 0; j < 4; ++j) gv[j] = *(const f32x4*)(g + 4 * F.lane + 256 * j);
    f32x4 vn[4];
    { const GAS f32x4* xr = (const GAS f32x4*)(xin + (size_t)gw * D) + F.lane;
#pragma unroll
      for (int j = 0; j < 4; ++j) vn[j] = xr[64 * j]; }
    for (int m = gw; m < T; m += NGW) {
        f32x4 v[4]; float s = 0.f;
#pragma unroll
        for (int j = 0; j < 4; ++j) { v[j] = vn[j]; s += (v[j].x * v[j].x + v[j].y * v[j].y) + (v[j].z * v[j].z + v[j].w * v[j].w); }
        if (m + NGW < T) { const GAS f32x4* xr = (const GAS f32x4*)(xin + (size_t)(m + NGW) * D) + F.lane;
#pragma unroll
            for (int j = 0; j < 4; ++j) vn[j] = xr[64 * j]; }
        const float rstd = 1.0f / sqrtf(wave_sum(s) * (1.f / D) + NORM_EPS);
        if (xcopy) { GAS f32x4* xo = (GAS f32x4*)(xcopy + (size_t)m * D) + F.lane;
#pragma unroll
            for (int j = 0; j < 4; ++j) xo[64 * j] = v[j]; }
        GAS v2u* o8 = (GAS v2u*)(xn + (size_t)m * D) + F.lane;
#pragma unroll
        for (int j = 0; j < 4; ++j) { const f32x4 y = rs_out ? v[j] : v[j] * rstd * gv[j]; v2u w; w.x = pk2(y.x, y.y); w.y = pk2(y.z, y.w); o8[64 * j] = w; }
        if (rs_out && F.lane == 0) rs_out[m] = rstd;
    }
}

__device__ __forceinline__ float row_sum16n(float v) {
#if defined(__HIP_DEVICE_COMPILE__)
#define RS_ROR(n) v += __builtin_bit_cast(float, __builtin_amdgcn_update_dpp(0, __builtin_bit_cast(int, v), 0x120 + (n), 0xf, 0xf, false))
    RS_ROR(8); RS_ROR(4); RS_ROR(2); RS_ROR(1);
#undef RS_ROR
#endif
    return v;
}
__device__ __forceinline__ void norm_rows4(Frame& F, const float* xin, const float* g, bf16* xn) {
    const int gw = F.vcu * NWAVES + F.wave, NGW = F.G * NWAVES, r = F.lane >> 4, c = F.lane & 15;
    constexpr int NTG = T / 4;
    f32x4 vq[16], gq[16];
#pragma unroll
    for (int k = 0; k < 16; ++k) gq[k] = *(const f32x4*)(g + 64 * k + 4 * c);
    if (gw < NTG) { const GAS f32x4* xr = (const GAS f32x4*)(xin + (size_t)(4 * gw + r) * D) + c;
#pragma unroll
        for (int k = 0; k < 16; ++k) vq[k] = xr[16 * k]; }
    for (int tg = gw; tg < NTG; tg += NGW) { const int m = 4 * tg + r;
        f32x4 v[16]; float s = 0.f;
#pragma unroll
        for (int k = 0; k < 16; ++k) { v[k] = vq[k]; s += (v[k].x * v[k].x + v[k].y * v[k].y) + (v[k].z * v[k].z + v[k].w * v[k].w); }
        if (tg + NGW < NTG) { const GAS f32x4* xr = (const GAS f32x4*)(xin + (size_t)(4 * (tg + NGW) + r) * D) + c;
#pragma unroll
            for (int k = 0; k < 16; ++k) vq[k] = xr[16 * k]; }
        const float rstd = 1.0f / sqrtf(row_sum16n(s) * (1.f / D) + NORM_EPS);
        GAS v2u* o8 = (GAS v2u*)(xn + (size_t)m * D) + c;
#pragma unroll
        for (int k = 0; k < 16; ++k) { const f32x4 y = v[k] * rstd * gq[k]; v2u w; w.x = pk2(y.x, y.y); w.y = pk2(y.z, y.w); o8[16 * k] = w; }
    }
}

using pg8::Unit; using pg8::cvt_pk_bf16;
__device__ __forceinline__ v4u pack8(const f32x4& a, const f32x4& b) { v4u w; w.x = cvt_pk_bf16(a[0], a[1]); w.y = cvt_pk_bf16(a[2], a[3]); w.z = cvt_pk_bf16(b[0], b[1]); w.w = cvt_pk_bf16(b[2], b[3]); return w; }
__device__ __forceinline__ void unpack8(const v4u& w, f32x4& a, f32x4& b) { a = (f32x4){bflo(w.x), bfhi(w.x), bflo(w.y), bfhi(w.y)}; b = (f32x4){bflo(w.z), bfhi(w.z), bflo(w.w), bfhi(w.w)}; }
__device__ __forceinline__ float logf_gate(float z, float lb) {
    const float t = __expf(-fabsf(z)), num = (z >= 0.f) ? __builtin_fmaf(lb, t, 1.0f) : (lb + t);
    const float r2 = __builtin_amdgcn_logf(num) - __builtin_amdgcn_logf(1.0f + t);
    return fmaxf(r2, LOGF_MIN * 1.4426950408889634f);
}
struct EpiInA {
    static constexpr bool PERM = false, AFTER_DRAIN = false;
    bf16* PA; const float* cosT; const float* sinT; const float* lbt;
    int pofs;
    const float* rs;
    __device__ __forceinline__ void operator()(const f32x4 (&acc)[2][2][4][2], const Unit& u, int wr, int wc, int fr, int fq) const {
        const int pn = u.pn + pofs, row0 = u.pm * 256 + wr * 64 + fr;
        float rsv[2][4];
#pragma unroll
        for (int ai = 0; ai < 2; ++ai)
#pragma unroll
            for (int m = 0; m < 4; ++m) rsv[ai][m] = NORMFOLD ? rs[row0 + 128 * ai + 16 * m] : 1.0f;
#pragma unroll
        for (int bj = 0; bj < 2; ++bj) {
            int mode = 0; float sc = 1.f; int lbo = 0;
            if (pn < 2) { mode = 1; sc = QSCALE; } else if (pn == 2) { mode = (bj == 0) ? 1 : 0; } else if (pn < 5) mode = 2;
            else if (pn < 7) { mode = 3; lbo = (pn - 5) * 256; } else if (pn < 9) { mode = 3; lbo = 1024 + (pn - 7) * 256; } else if (pn < 11) mode = 0; else mode = 2;
            if (mode == 1) {
                const int hb = 256 * pn + 128 * bj + 64 * (wc >> 1), d0 = 16 * (wc & 1) + 4 * fq;
#pragma unroll
                for (int ai = 0; ai < 2; ++ai) { f32x4 csv[4], snv[4];
#pragma unroll
                    for (int m = 0; m < 4; ++m) { const int pos = (row0 + 128 * ai + 16 * m) & (SEQ - 1); csv[m] = *(const f32x4*)(cosT + pos * 32 + d0); snv[m] = *(const f32x4*)(sinT + pos * 32 + d0); }
#pragma unroll
                    for (int m = 0; m < 4; ++m) { const int r = row0 + 128 * ai + 16 * m;
                        const f32x4 cs = csv[m], sn = snv[m];
                        const f32x4 x1 = acc[ai][bj][m][0], x2 = acc[ai][bj][m][1];
                        const float scr_ = sc * rsv[ai][m];
                        const f32x4 o1 = (x1 * cs - x2 * sn) * scr_, o2 = (x2 * cs + x1 * sn) * scr_;
                        bf16* rp = PA + (size_t)r * NPA + hb + d0;
                        v2u w1; w1.x = cvt_pk_bf16(o1[0], o1[1]); w1.y = cvt_pk_bf16(o1[2], o1[3]); *(v2u*)rp = w1;
                        v2u w2; w2.x = cvt_pk_bf16(o2[0], o2[1]); w2.y = cvt_pk_bf16(o2[2], o2[3]); *(v2u*)(rp + 32) = w2; }
                    asm volatile("" ::: "memory"); }
            } else {
                const int c0 = 256 * pn + 128 * bj + 32 * wc + 8 * fq;
                if (mode == 3) {
                    const float* lp = lbt + lbo + 128 * bj + 32 * wc + 8 * fq;
#pragma unroll
                    for (int n = 0; n < 2; ++n) { const f32x4 la = *(const f32x4*)(lp + 4 * n);
#pragma unroll
                        for (int ai = 0; ai < 2; ++ai)
#pragma unroll
                            for (int m = 0; m < 4; ++m) { const int r = row0 + 128 * ai + 16 * m; bf16* rp = PA + (size_t)r * NPA + c0 + 4 * n;
                                const f32x4 v = acc[ai][bj][m][n] * rsv[ai][m]; h16x4 hv;
#pragma unroll
                                for (int j = 0; j < 4; ++j) hv[j] = (_Float16)logf_gate(v[j], la[j]);
                                *(h16x4*)rp = hv; asm volatile("" ::: "memory"); } }
                } else {
#pragma unroll
                    for (int ai = 0; ai < 2; ++ai)
#pragma unroll
                        for (int m = 0; m < 4; ++m) { const int r = row0 + 128 * ai + 16 * m; bf16* rp = PA + (size_t)r * NPA + c0;
                            f32x4 v0 = acc[ai][bj][m][0], v1 = acc[ai][bj][m][1];
                            if (NORMFOLD) { const float rr = rsv[ai][m]; v0 = v0 * rr; v1 = v1 * rr; }
                            if (mode == 2) {
#pragma unroll
                                for (int j = 0; j < 4; ++j) { v0[j] = siluf_(v0[j]); v1[j] = siluf_(v1[j]); } }
                            *(v4u*)rp = pack8(v0, v1); asm volatile("" ::: "memory"); }
                }
            }
        }
    }
};
struct EpiGate {
    static constexpr bool PERM = false, AFTER_DRAIN = false;
    bf16* O; const float* rs;
    __device__ __forceinline__ void operator()(const f32x4 (&acc)[2][2][4][2], const Unit& u, int wr, int wc, int fr, int fq) const {
        const int row0 = u.pm * 256 + wr * 64 + fr, c0 = 256 * u.pn + 32 * wc + 8 * fq;
        float rsv[2][4];
#pragma unroll
        for (int ai = 0; ai < 2; ++ai)
#pragma unroll
            for (int m = 0; m < 4; ++m) rsv[ai][m] = NORMFOLD ? rs[row0 + 128 * ai + 16 * m] : 1.0f;
#pragma unroll
        for (int ai = 0; ai < 2; ++ai)
#pragma unroll
            for (int m = 0; m < 4; ++m) { bf16* rp = O + (size_t)(row0 + 128 * ai + 16 * m) * NGATE + c0; const float rr = rsv[ai][m];
#pragma unroll
                for (int bj = 0; bj < 2; ++bj) { f32x4 v0 = acc[ai][bj][m][0] * rr, v1 = acc[ai][bj][m][1] * rr;
#if !defined(CK_PLAIN)
#pragma unroll
                    for (int j = 0; j < 4; ++j) { v0[j] = sigmoidf_(v0[j]); v1[j] = sigmoidf_(v1[j]); }
#endif
                    *(v4u*)(rp + 128 * bj) = pack8(v0, v1); } }
    }
};
#if defined(PROBE_KLOOP)
struct EpiNull {
    static constexpr bool PERM = false, AFTER_DRAIN = false;
    bf16* O;
    __device__ __forceinline__ void operator()(const f32x4 (&acc)[2][2][4][2], const Unit& u, int wr, int wc, int fr, int fq) const {
        float s = 0.f;
#pragma unroll
        for (int ai = 0; ai < 2; ++ai)
#pragma unroll
            for (int bj = 0; bj < 2; ++bj)
#pragma unroll
                for (int m = 0; m < 4; ++m)
#pragma unroll
                    for (int n = 0; n < 2; ++n) s += acc[ai][bj][m][n][0] + acc[ai][bj][m][n][1] + acc[ai][bj][m][n][2] + acc[ai][bj][m][n][3];
        if (s == 12345.678f) O[u.pm + wr + wc + fr + fq] = (bf16)1;
    }
};
#endif
struct EpiUpA {
    static constexpr bool PERM = false, AFTER_DRAIN = false;
    bf16* MG; const bf16* GT;
    __device__ __forceinline__ void operator()(const f32x4 (&acc)[2][2][4][2], const Unit& u, int wr, int wc, int fr, int fq) const {
        const int row0 = u.pm * 256 + wr * 64 + fr, c0 = 256 * u.pn + 32 * wc + 8 * fq;
        v4u gw[2][2][2];
#define UA_LOAD(q_, buf_) do { _Pragma("unroll") for (int mm = 0; mm < 2; ++mm) _Pragma("unroll") for (int bj = 0; bj < 2; ++bj) \
            gw[buf_][mm][bj] = *(const v4u*)(GT + (size_t)(row0 + 128 * ((q_) >> 1) + 16 * (2 * ((q_) & 1) + mm)) * NGATE + c0 + 128 * bj); } while (0)
        UA_LOAD(0, 0);
#pragma unroll
        for (int q = 0; q < 4; ++q) { const int ai = q >> 1, mh = q & 1;
            if (q < 3) UA_LOAD(q + 1, (q + 1) & 1);
            __builtin_amdgcn_sched_barrier(0);
#pragma unroll
            for (int mm = 0; mm < 2; ++mm) { const int m = 2 * mh + mm; bf16* rp = MG + (size_t)(row0 + 128 * ai + 16 * m) * D + c0;
#pragma unroll
                for (int bj = 0; bj < 2; ++bj) { f32x4 g0, g1; unpack8(gw[q & 1][mm][bj], g0, g1);
                    *(v4u*)(rp + 128 * bj) = pack8(acc[ai][bj][m][0] * g0, acc[ai][bj][m][1] * g1); } }
            __builtin_amdgcn_sched_barrier(0); }
#undef UA_LOAD
    }
};
struct EpiUpB {
    static constexpr bool PERM = false, AFTER_DRAIN = false;
    bf16* MG; const bf16* GT; const float* ssq;
    __device__ __forceinline__ void operator()(const f32x4 (&acc)[2][2][4][2], const Unit& u, int wr, int wc, int fr, int fq) const {
        const int row0 = u.pm * 256 + wr * 64 + fr, c0 = 256 * u.pn + 32 * wc + 8 * fq;
        v4u gw[2][2][2], pw[2][2][2]; f32x4 sq[2][2];
#define UB_LOAD(q_, buf_) do { _Pragma("unroll") for (int mm = 0; mm < 2; ++mm) { const int r_ = row0 + 128 * ((q_) >> 1) + 16 * (2 * ((q_) & 1) + mm); sq[buf_][mm] = *(const f32x4*)(ssq + (size_t)r_ * 4); \
            _Pragma("unroll") for (int bj = 0; bj < 2; ++bj) { gw[buf_][mm][bj] = *(const v4u*)(GT + (size_t)r_ * NGATE + 1024 + c0 + 128 * bj); pw[buf_][mm][bj] = *(const v4u*)(MG + (size_t)r_ * D + c0 + 128 * bj); } } } while (0)
        UB_LOAD(0, 0);
#pragma unroll
        for (int q = 0; q < 4; ++q) { const int ai = q >> 1, mh = q & 1;
            if (q < 3) UB_LOAD(q + 1, (q + 1) & 1);
            __builtin_amdgcn_sched_barrier(0);
#pragma unroll
            for (int mm = 0; mm < 2; ++mm) { const int m = 2 * mh + mm; bf16* rp = MG + (size_t)(row0 + 128 * ai + 16 * m) * D + c0; const f32x4 sv = sq[q & 1][mm];
                const float rstd = 1.0f / sqrtf(((sv[0] + sv[1]) + (sv[2] + sv[3])) * (1.f / 512.f) + NORM_EPS);
#pragma unroll
                for (int bj = 0; bj < 2; ++bj) { f32x4 g0, g1, p0, p1; unpack8(gw[q & 1][mm][bj], g0, g1); unpack8(pw[q & 1][mm][bj], p0, p1);
                    *(v4u*)(rp + 128 * bj) = pack8(p0 + acc[ai][bj][m][0] * g0 * rstd, p1 + acc[ai][bj][m][1] * g1 * rstd); } }
            __builtin_amdgcn_sched_barrier(0); }
#undef UB_LOAD
    }
};
struct EpiOut {
    static constexpr bool PERM = false, AFTER_DRAIN = false;
    float* X; const float* XI;
    __device__ __forceinline__ void operator()(const f32x4 (&acc)[2][2][4][2], const Unit& u, int wr, int wc, int fr, int fq) const {
        const int row0 = u.pm * 256 + wr * 64 + fr, c0 = 256 * u.pn + 32 * wc + 8 * fq;
#pragma unroll
        for (int ai = 0; ai < 2; ++ai) { f32x4 xv[4][2][2];
#pragma unroll
            for (int m = 0; m < 4; ++m)
#pragma unroll
                for (int bj = 0; bj < 2; ++bj) { const f32x4* p = (const f32x4*)(XI + (size_t)(row0 + 128 * ai + 16 * m) * D + c0 + 128 * bj); xv[m][bj][0] = p[0]; xv[m][bj][1] = p[1]; }
#pragma unroll
            for (int m = 0; m < 4; ++m)
#pragma unroll
                for (int bj = 0; bj < 2; ++bj) { f32x4* p = (f32x4*)(X + (size_t)(row0 + 128 * ai + 16 * m) * D + c0 + 128 * bj); p[0] = xv[m][bj][0] + acc[ai][bj][m][0]; p[1] = xv[m][bj][1] + acc[ai][bj][m][1]; }
            asm volatile("" ::: "memory"); }
    }
};
template <bool IN_F32> struct EpiOutB {
    static constexpr bool PERM = false, AFTER_DRAIN = false;
    bf16* XO; const void* XI;
    __device__ __forceinline__ void operator()(const f32x4 (&acc)[2][2][4][2], const Unit& u, int wr, int wc, int fr, int fq) const {
        const int row0 = u.pm * 256 + wr * 64 + fr, c0 = 256 * u.pn + 32 * wc + 8 * fq;
#pragma unroll
        for (int ai = 0; ai < 2; ++ai) { f32x4 xv[4][2][2];
#pragma unroll
            for (int m = 0; m < 4; ++m)
#pragma unroll
                for (int bj = 0; bj < 2; ++bj) { const size_t o = (size_t)(row0 + 128 * ai + 16 * m) * D + c0 + 128 * bj;
                    if constexpr (IN_F32) { const f32x4* p = (const f32x4*)((const float*)XI + o); xv[m][bj][0] = p[0]; xv[m][bj][1] = p[1]; }
                    else { const v4u w = *(const v4u*)((const bf16*)XI + o); unpack8(w, xv[m][bj][0], xv[m][bj][1]); } }
#pragma unroll
            for (int m = 0; m < 4; ++m)
#pragma unroll
                for (int bj = 0; bj < 2; ++bj) { const size_t o = (size_t)(row0 + 128 * ai + 16 * m) * D + c0 + 128 * bj;
                    *(v4u*)(XO + o) = pack8(xv[m][bj][0] + acc[ai][bj][m][0], xv[m][bj][1] + acc[ai][bj][m][1]); }
            asm volatile("" ::: "memory"); }
    }
};
struct EpiAct {
    static constexpr bool PERM = false, AFTER_DRAIN = false;
    bf16* ACT; const float* rs;
    __device__ __forceinline__ void operator()(const f32x4 (&acc)[2][2][4][2], const Unit& u, int wr, int wc, int fr, int fq) const {
        const int row0 = u.pm * 256 + wr * 64 + fr, c0 = 128 * u.pn + 16 * wc + 4 * fq;
        float rsv[2][4];
#pragma unroll
        for (int ai = 0; ai < 2; ++ai)
#pragma unroll
            for (int m = 0; m < 4; ++m) rsv[ai][m] = NORMFOLD ? rs[row0 + 128 * ai + 16 * m] : 1.0f;
#pragma unroll
        for (int ai = 0; ai < 2; ++ai)
#pragma unroll
            for (int m = 0; m < 4; ++m) { bf16* rp = ACT + (size_t)(row0 + 128 * ai + 16 * m) * DEXP + c0; const float rr = rsv[ai][m];
#pragma unroll
                for (int bj = 0; bj < 2; ++bj) { const f32x4 g = acc[ai][bj][m][0] * rr, up = acc[ai][bj][m][1] * rr; f32x4 a;
#pragma unroll
                    for (int j = 0; j < 4; ++j) a[j] = siluf_(g[j]) * up[j];
                    const unsigned long long w64 = (unsigned long long)cvt_pk_bf16(a[0], a[1]) | ((unsigned long long)cvt_pk_bf16(a[2], a[3]) << 32);
#if MOE_HANDOFF
                    __hip_atomic_store((gu64*)(rp + 64 * bj), w64, RLX_AGENT); } }
#else
                    *(unsigned long long*)(rp + 64 * bj) = w64; } }
#endif
    }
};
struct EpiY {
    static constexpr bool PERM = false, AFTER_DRAIN = false;
    bf16* Y;
    __device__ __forceinline__ void operator()(const f32x4 (&acc)[2][2][4][2], const Unit& u, int wr, int wc, int fr, int fq) const {
        const int row0 = u.pm * 256 + wr * 64 + fr, c0 = 256 * u.pn + 32 * wc + 8 * fq;
#pragma unroll
        for (int ai = 0; ai < 2; ++ai)
#pragma unroll
            for (int m = 0; m < 4; ++m) { bf16* rp = Y + (size_t)(row0 + 128 * ai + 16 * m) * D + c0;
#pragma unroll
                for (int bj = 0; bj < 2; ++bj) *(v4u*)(rp + 128 * bj) = pack8(acc[ai][bj][m][0], acc[ai][bj][m][1]); }
    }
};

#define VLD(p) __hip_atomic_load((p), __ATOMIC_RELAXED, __HIP_MEMORY_SCOPE_AGENT)
constexpr int HIST_OFF = MISC_OFF + 256;
constexpr int SBASE_OFF = HIST_OFF + 128;
constexpr int STOT_OFF = SBASE_OFF + 128;
constexpr int BRE_OFF = STOT_OFF + 128;
static_assert(BRE_OFF + 128 <= LDS_BYTES, "LDS misc");

__device__ __forceinline__ void phase_norm_route(Frame& F, const Args& A, int l, const void* xsrc) {
    const int gw = F.vcu * NWAVES + F.wave, NGW = F.G * NWAVES, lane = F.lane;
    LAS f32x4* Wre = (LAS f32x4*)(F.lds + RING_OFF);
    volatile LAS int* hist = (volatile LAS int*)(F.lds + HIST_OFF);
    const float* w_re = A.in[I_WRE] + (size_t)l * NGRP * D * EPG;
    const float* w_rg = A.in[I_WRG] + (size_t)l * D * NGRP;
    const float* b_rg = A.in[I_BRG] + l * NGRP;
    const float* b_re = A.in[I_BRE] + l * NGRP * EPG;
    const float* gf = A.in[I_FNG] + (size_t)l * D;
    for (int idx = F.tid; idx < NGRP * D; idx += NWAVES * 64) { const int g = idx >> 10, i = idx & 1023, li = (i & 255) >> 2, jj = 4 * (i >> 8) + (i & 3);
        const f32x4 a = *(const f32x4*)(w_re + (size_t)idx * 8), b = *(const f32x4*)(w_re + (size_t)idx * 8 + 4);
        Wre[((g * 2 + 0) * 16 + jj) * 64 + li] = a; Wre[((g * 2 + 1) * 16 + jj) * 64 + li] = b; }
    if (F.tid < 32) { hist[F.tid] = 0; ((LAS float*)(F.lds + BRE_OFF))[F.tid] = b_re[F.tid]; }
    { int* stok = (int*)(F.ws + WS_STOK); for (int i = F.vcu * (NWAVES * 64) + F.tid; i < SLOT_ROWS; i += F.G * NWAVES * 64) stok[i] = 0; }
    f32x4 wgr[16], gv[4];
#pragma unroll
    for (int j = 0; j < 4; ++j) { gv[j] = *(const f32x4*)(gf + 4 * lane + 256 * j);
#pragma unroll
        for (int c = 0; c < 4; ++c) wgr[4 * j + c] = *(const f32x4*)(w_rg + (size_t)(4 * lane + 256 * j + c) * 4); }
    f32x4 brg = *(const f32x4*)b_rg;
    __syncthreads();
    bf16* XN = (bf16*)(F.ws + WS_XN);
#if XBF16
    const bf16* X = (const bf16*)xsrc;
    typedef v2u xraw_t;
#define NR_LOAD(dst, row) do { const GAS v2u* xr_ = (const GAS v2u*)(X + (size_t)(row) * D) + lane; _Pragma("unroll") for (int j = 0; j < 4; ++j) dst[j] = xr_[64 * j]; } while (0)
#define NR_CVT(w_) ((f32x4){bflo((w_).x), bfhi((w_).x), bflo((w_).y), bfhi((w_).y)})
#else
    const float* X = (const float*)xsrc;
    typedef f32x4 xraw_t;
#define NR_LOAD(dst, row) do { const GAS f32x4* xr_ = (const GAS f32x4*)(X + (size_t)(row) * D) + lane; _Pragma("unroll") for (int j = 0; j < 4; ++j) dst[j] = xr_[64 * j]; } while (0)
#define NR_CVT(w_) (w_)
#endif
    int* tok_e = (int*)(F.ws + WS_TOKE); float* tok_w = (float*)(F.ws + WS_TOKW); int* tok_r = (int*)(F.ws + WS_TOKR);
    xraw_t vn[4], vn2[4];
    NR_LOAD(vn, gw); if (gw + NGW < T) NR_LOAD(vn2, gw + NGW);
    int pe1 = 0, pe2 = 0, pr1 = 0, pr2 = 0, pm = -1; float pw1 = 0.f, pw2 = 0.f;
    for (int m = gw; m < T; m += NGW) {
        f32x4 v[4]; float s = 0.f;
#pragma unroll
        for (int j = 0; j < 4; ++j) { v[j] = NR_CVT(vn[j]); vn[j] = vn2[j]; s += (v[j].x * v[j].x + v[j].y * v[j].y) + (v[j].z * v[j].z + v[j].w * v[j].w); }
        if (m + 2 * NGW < T) NR_LOAD(vn2, m + 2 * NGW);
        if (lane == 0 && pm >= 0) { tok_e[2 * pm] = pe1; tok_e[2 * pm + 1] = pe2; tok_w[2 * pm] = pw1; tok_w[2 * pm + 1] = pw2; tok_r[2 * pm] = pr1; tok_r[2 * pm + 1] = pr2; }
        const float rstd = 1.0f / sqrtf(wave_sum(s) * (1.f / D) + NORM_EPS);
        GAS v2u* o8 = (GAS v2u*)(XN + (size_t)m * D) + lane;
        f32x4 ga = (f32x4){0.f, 0.f, 0.f, 0.f};
#pragma unroll
        for (int j = 0; j < 4; ++j) { v[j] = v[j] * rstd * gv[j]; v2u w; w.x = pk2(v[j].x, v[j].y); w.y = pk2(v[j].z, v[j].w); o8[64 * j] = w;
            ga += wgr[4 * j + 0] * v[j].x; ga += wgr[4 * j + 1] * v[j].y; ga += wgr[4 * j + 2] * v[j].z; ga += wgr[4 * j + 3] * v[j].w; }
        float gl[4];
#pragma unroll
        for (int k = 0; k < 4; ++k) gl[k] = wave_sum(ga[k]) + brg[k];
        int gt = 0; float gm = gl[0];
#pragma unroll
        for (int k = 1; k < 4; ++k) if (gl[k] > gm) { gm = gl[k]; gt = k; }
        float gden = 0.f;
#pragma unroll
        for (int k = 0; k < 4; ++k) gden += expf(gl[k] - gm);
        const float p_top = 1.0f / gden;
        gt = __builtin_amdgcn_readfirstlane(gt);
        f32x4 a0 = (f32x4){0.f, 0.f, 0.f, 0.f}, a1 = a0;
        const LAS f32x4* w0 = Wre + ((gt * 2 + 0) * 16) * 64 + lane; const LAS f32x4* w1 = Wre + ((gt * 2 + 1) * 16) * 64 + lane;
        f32x4 wa[2][4], wb[2][4];
#pragma unroll
        for (int c = 0; c < 4; ++c) { wa[0][c] = w0[c * 64]; wb[0][c] = w1[c * 64]; }
#pragma unroll
        for (int j = 0; j < 4; ++j) {
            if (j < 3) {
#pragma unroll
                for (int c = 0; c < 4; ++c) { wa[(j + 1) & 1][c] = w0[(4 * (j + 1) + c) * 64]; wb[(j + 1) & 1][c] = w1[(4 * (j + 1) + c) * 64]; } }
            __builtin_amdgcn_sched_barrier(0);
            a0 += wa[j & 1][0] * v[j].x; a1 += wb[j & 1][0] * v[j].x;
            a0 += wa[j & 1][1] * v[j].y; a1 += wb[j & 1][1] * v[j].y;
            a0 += wa[j & 1][2] * v[j].z; a1 += wb[j & 1][2] * v[j].z;
            a0 += wa[j & 1][3] * v[j].w; a1 += wb[j & 1][3] * v[j].w;
            __builtin_amdgcn_sched_barrier(0); }
        const f32x4 bl0 = *(const LAS f32x4*)(F.lds + BRE_OFF + gt * 32), bl1 = *(const LAS f32x4*)(F.lds + BRE_OFF + gt * 32 + 16);
        float el[8];
#pragma unroll
        for (int k = 0; k < 4; ++k) { el[k] = wave_sum(a0[k]) + bl0[k]; el[4 + k] = wave_sum(a1[k]) + bl1[k]; }
        int i1 = 0; float m1 = el[0];
#pragma unroll
        for (int k = 1; k < 8; ++k) if (el[k] > m1) { m1 = el[k]; i1 = k; }
        int i2 = -1; float m2 = -3.0e38f;
#pragma unroll
        for (int k = 0; k < 8; ++k) if (k != i1 && el[k] > m2) { m2 = el[k]; i2 = k; }
        const float q1 = 1.0f, q2 = expf(m2 - m1);
        const float wn1 = p_top * q1 / (q1 + q2), wn2 = p_top * q2 / (q1 + q2);
        if (lane == 0) {
            pe1 = gt * 8 + i1; pe2 = gt * 8 + i2; pw1 = wn1; pw2 = wn2; pm = m;
            pr1 = __hip_atomic_fetch_add((LAS int*)hist + pe1, 1, __ATOMIC_RELAXED, __HIP_MEMORY_SCOPE_WORKGROUP);
            pr2 = __hip_atomic_fetch_add((LAS int*)hist + pe2, 1, __ATOMIC_RELAXED, __HIP_MEMORY_SCOPE_WORKGROUP);
        }
    }
    if (lane == 0 && pm >= 0) { tok_e[2 * pm] = pe1; tok_e[2 * pm + 1] = pe2; tok_w[2 * pm] = pw1; tok_w[2 * pm + 1] = pw2; tok_r[2 * pm] = pr1; tok_r[2 * pm + 1] = pr2; }
    __syncthreads();
    if (F.tid < 32) ((int*)(F.ws + WS_WGCNT))[blockIdx.x * 32 + F.tid] = hist[F.tid];
#undef NR_LOAD
#undef NR_CVT
}
#if ROUTE4
constexpr int WGR_OFF = (BRE_OFF + 128 + 255) & ~255, GNW_OFF = WGR_OFF + 16384;
static_assert(GNW_OFF + 4096 <= LDS_BYTES, "LDS route4");
__device__ __forceinline__ float row_sum16(float v) {
#if defined(__HIP_DEVICE_COMPILE__)
#define RS_ROR(n) v += __builtin_bit_cast(float, __builtin_amdgcn_update_dpp(0, __builtin_bit_cast(int, v), 0x120 + (n), 0xf, 0xf, false))
    RS_ROR(8); RS_ROR(4); RS_ROR(2); RS_ROR(1);
#undef RS_ROR
#endif
    return v;
}
__device__ __forceinline__ void phase_norm_route4(Frame& F, const Args& A, int l, const void* xsrc) {
    const int gw = F.vcu * NWAVES + F.wave, NGW = F.G * NWAVES, lane = F.lane, r = lane >> 4, c = lane & 15;
    LAS f32x4* WE = (LAS f32x4*)(F.lds + RING_OFF); LAS f32x4* WG = (LAS f32x4*)(F.lds + WGR_OFF); LAS f32x4* GL = (LAS f32x4*)(F.lds + GNW_OFF);
    volatile LAS int* hist = (volatile LAS int*)(F.lds + HIST_OFF);
    const float* w_re = A.in[I_WRE] + (size_t)l * NGRP * D * EPG;
    const float* w_rg = A.in[I_WRG] + (size_t)l * D * NGRP;
    const float* b_rg = A.in[I_BRG] + l * NGRP;
    const float* b_re = A.in[I_BRE] + l * NGRP * EPG;
    const float* gf = A.in[I_FNG] + (size_t)l * D;
    static_assert(XBF16 == 1, "route4 reads the bf16 residual stream");
    const bf16* X = (const bf16*)xsrc;
    constexpr int NTG = T / 4;
    v2u xn[16];
    if (gw < NTG) { const GAS v2u* xr = (const GAS v2u*)(X + (size_t)(4 * gw + r) * D) + c;
#pragma unroll
        for (int k = 0; k < 16; ++k) xn[k] = xr[16 * k]; }
    {
        f32x4 ta[8], tb[8], tg2[2], tgl = (f32x4){0.f, 0.f, 0.f, 0.f};
#pragma unroll
        for (int u = 0; u < 8; ++u) { const int idx = F.tid + u * (NWAVES * 64); ta[u] = *(const GAS f32x4*)(w_re + (size_t)idx * 8); tb[u] = *(const GAS f32x4*)(w_re + (size_t)idx * 8 + 4); }
#pragma unroll
        for (int u = 0; u < 2; ++u) tg2[u] = *(const GAS f32x4*)(w_rg + (size_t)(F.tid + u * (NWAVES * 64)) * 4);
        if (F.tid < 256) tgl = *(const GAS f32x4*)(gf + 64 * (F.tid >> 4) + 4 * (F.tid & 15));
        __builtin_amdgcn_sched_barrier(0);
#pragma unroll
        for (int u = 0; u < 8; ++u) { const int idx = F.tid + u * (NWAVES * 64), g = idx >> 10, e = idx & 1023, k = e >> 6, cc = (e >> 2) & 15, i = e & 3;
            WE[((g * 16 + k) * 8 + 2 * i) * 16 + cc] = ta[u]; WE[((g * 16 + k) * 8 + 2 * i + 1) * 16 + cc] = tb[u]; }
#pragma unroll
        for (int u = 0; u < 2; ++u) { const int e = F.tid + u * (NWAVES * 64), k = e >> 6, cc = (e >> 2) & 15, i = e & 3; WG[(k * 4 + i) * 16 + cc] = tg2[u]; }
        if (F.tid < 256) GL[F.tid] = tgl;
    }
    static_assert(NGRP * D == 8 * NWAVES * 64 && D == 2 * NWAVES * 64, "staging loops above");
    if (F.tid < 32) { hist[F.tid] = 0; ((LAS float*)(F.lds + BRE_OFF))[F.tid] = b_re[F.tid]; }
    { int* stok = (int*)(F.ws + WS_STOK); for (int i = F.vcu * (NWAVES * 64) + F.tid; i < SLOT_ROWS; i += F.G * NWAVES * 64) stok[i] = 0; }
    const f32x4 brg = *(const f32x4*)b_rg;
    __syncthreads();
    bf16* XN = (bf16*)(F.ws + WS_XN);
    int* tok_e = (int*)(F.ws + WS_TOKE); float* tok_w = (float*)(F.ws + WS_TOKW); int* tok_r = (int*)(F.ws + WS_TOKR);
    int pe1 = 0, pe2 = 0, pr1 = 0, pr2 = 0, pm = -1; float pw1 = 0.f, pw2 = 0.f, prs = 0.f; float* rsf = (float*)(F.ws + WS_RSF);
    for (int tg = gw; tg < NTG; tg += NGW) {
        const int m = 4 * tg + r;
        f32x4 v[16]; float s = 0.f;
#pragma unroll
        for (int k = 0; k < 16; ++k) { const v2u w = xn[k]; v[k] = (f32x4){bflo(w.x), bfhi(w.x), bflo(w.y), bfhi(w.y)}; s += (v[k].x * v[k].x + v[k].y * v[k].y) + (v[k].z * v[k].z + v[k].w * v[k].w); }
        if (tg + NGW < NTG) { const GAS v2u* xr = (const GAS v2u*)(X + (size_t)(4 * (tg + NGW) + r) * D) + c;
#pragma unroll
            for (int k = 0; k < 16; ++k) xn[k] = xr[16 * k]; }
        if (c == 0 && pm >= 0) { tok_e[2 * pm] = pe1; tok_e[2 * pm + 1] = pe2; tok_w[2 * pm] = pw1; tok_w[2 * pm + 1] = pw2; tok_r[2 * pm] = pr1; tok_r[2 * pm + 1] = pr2; if (NORMFOLD) rsf[pm] = prs; }
        const float rstd = 1.0f / sqrtf(row_sum16(s) * (1.f / D) + NORM_EPS);
        GAS v2u* o8 = (GAS v2u*)(XN + (size_t)m * D) + c;
        f32x4 ga = (f32x4){0.f, 0.f, 0.f, 0.f};
#pragma unroll
        for (int k = 0; k < 16; ++k) { const f32x4 gk = GL[k * 16 + c]; const f32x4 w0 = WG[(k * 4 + 0) * 16 + c], w1 = WG[(k * 4 + 1) * 16 + c], w2 = WG[(k * 4 + 2) * 16 + c], w3 = WG[(k * 4 + 3) * 16 + c];
            v[k] = v[k] * rstd * gk; if (!NORMFOLD) { v2u w; w.x = pk2(v[k].x, v[k].y); w.y = pk2(v[k].z, v[k].w); o8[16 * k] = w; }
            ga += w0 * v[k].x; ga += w1 * v[k].y; ga += w2 * v[k].z; ga += w3 * v[k].w; }
        float gl[4];
#pragma unroll
        for (int q = 0; q < 4; ++q) gl[q] = row_sum16(ga[q]) + brg[q];
        int gt = 0; float gm = gl[0];
#pragma unroll
        for (int q = 1; q < 4; ++q) if (gl[q] > gm) { gm = gl[q]; gt = q; }
        float gden = 0.f;
#pragma unroll
        for (int q = 0; q < 4; ++q) gden += expf(gl[q] - gm);
        const float p_top = 1.0f / gden;
        f32x4 a0 = (f32x4){0.f, 0.f, 0.f, 0.f}, a1 = a0;
        const LAS f32x4* we = WE + (gt * 16) * 8 * 16 + c;
        f32x4 wb[2][8];
#pragma unroll
        for (int q = 0; q < 8; ++q) wb[0][q] = we[q * 16];
#pragma unroll
        for (int k = 0; k < 16; ++k) {
            if (k < 15) {
#pragma unroll
                for (int q = 0; q < 8; ++q) wb[(k + 1) & 1][q] = we[((k + 1) * 8 + q) * 16]; }
            __builtin_amdgcn_sched_barrier(0);
            a0 += wb[k & 1][0] * v[k].x; a1 += wb[k & 1][1] * v[k].x;
            a0 += wb[k & 1][2] * v[k].y; a1 += wb[k & 1][3] * v[k].y;
            a0 += wb[k & 1][4] * v[k].z; a1 += wb[k & 1][5] * v[k].z;
            a0 += wb[k & 1][6] * v[k].w; a1 += wb[k & 1][7] * v[k].w;
            __builtin_amdgcn_sched_barrier(0); }
        const f32x4 bl0 = *(const LAS f32x4*)(F.lds + BRE_OFF + gt * 32), bl1 = *(const LAS f32x4*)(F.lds + BRE_OFF + gt * 32 + 16);
        float el[8];
#pragma unroll
        for (int q = 0; q < 4; ++q) { el[q] = row_sum16(a0[q]) + bl0[q]; el[4 + q] = row_sum16(a1[q]) + bl1[q]; }
        int i1 = 0; float m1 = el[0];
#pragma unroll
        for (int q = 1; q < 8; ++q) if (el[q] > m1) { m1 = el[q]; i1 = q; }
        int i2 = -1; float m2 = -3.0e38f;
#pragma unroll
        for (int q = 0; q < 8; ++q) if (q != i1 && el[q] > m2) { m2 = el[q]; i2 = q; }
        const float q1 = 1.0f, q2 = expf(m2 - m1);
        const float wn1 = p_top * q1 / (q1 + q2), wn2 = p_top * q2 / (q1 + q2);
        if (c == 0) {
            pe1 = gt * 8 + i1; pe2 = gt * 8 + i2; pw1 = wn1; pw2 = wn2; pm = m; prs = rstd;
            pr1 = __hip_atomic_fetch_add((LAS int*)hist + pe1, 1, __ATOMIC_RELAXED, __HIP_MEMORY_SCOPE_WORKGROUP);
            pr2 = __hip_atomic_fetch_add((LAS int*)hist + pe2, 1, __ATOMIC_RELAXED, __HIP_MEMORY_SCOPE_WORKGROUP);
        }
    }
    if (c == 0 && pm >= 0) { tok_e[2 * pm] = pe1; tok_e[2 * pm + 1] = pe2; tok_w[2 * pm] = pw1; tok_w[2 * pm + 1] = pw2; tok_r[2 * pm] = pr1; tok_r[2 * pm + 1] = pr2; if (NORMFOLD) rsf[pm] = prs; }
    __syncthreads();
    if (F.tid < 32) ((int*)(F.ws + WS_WGCNT))[blockIdx.x * 32 + F.tid] = hist[F.tid];
}
#endif
__device__ __forceinline__ void phase_dispatch(Frame& F) {
    const int gw = F.vcu * NWAVES + F.wave, NGW = F.G * NWAVES, lane = F.lane;
    volatile LAS int* sbase = (volatile LAS int*)(F.lds + SBASE_OFF); volatile LAS int* stot = (volatile LAS int*)(F.lds + STOT_OFF);
    const int* wgcnt = (const int*)(F.ws + WS_WGCNT); int* meta = (int*)(F.ws + WS_META);
    {
        volatile LAS int* part = (volatile LAS int*)(F.lds + RING_OFF);
        const int e = F.tid & 31, sl = F.tid >> 5; int tot = 0, base = 0;
        for (int w = sl; w < F.G; w += 16) { const int c = wgcnt[w * 32 + e]; tot += c; if (w < (int)blockIdx.x) base += c; }
        part[sl * 32 + e] = tot; part[512 + sl * 32 + e] = base;
        __syncthreads();
        if (F.tid < 32) { int t2 = 0, b2 = 0;
#pragma unroll
            for (int k = 0; k < 16; ++k) { t2 += part[k * 32 + F.tid]; b2 += part[512 + k * 32 + F.tid]; }
            stot[F.tid] = t2; sbase[F.tid] = b2; } }
    __syncthreads();
    if (F.tid == 0) { int run = 0, nrt = 0;
        for (int e = 0; e < NEXP; ++e) { const int nt = (stot[e] + 255) >> 8; sbase[e] = sbase[e] + run;
            if (blockIdx.x == 0) for (int k = 0; k < nt; ++k) meta[1 + nrt + k] = e;
            nrt += nt; run += nt * 256; }
        if (blockIdx.x == 0) meta[0] = nrt; }
    __syncthreads();
    const int* tok_e = (const int*)(F.ws + WS_TOKE); const int* tok_r = (const int*)(F.ws + WS_TOKR); int* tok_p = (int*)(F.ws + WS_TOKP);
    int* stok = (int*)(F.ws + WS_STOK);
    if (F.tid < T / F.G) {
#if ROUTE4
        const int m = 4 * ((F.tid >> 5) * NGW + F.vcu * NWAVES + ((F.tid >> 2) & 7)) + (F.tid & 3);
#else
        const int m = (F.tid >> 3) * NGW + F.vcu * NWAVES + (F.tid & 7);
#endif
        const int e1 = VLD(tok_e + 2 * m), e2 = VLD(tok_e + 2 * m + 1);
        const int p1 = sbase[e1] + VLD(tok_r + 2 * m), p2 = sbase[e2] + VLD(tok_r + 2 * m + 1);
        tok_p[2 * m] = p1; tok_p[2 * m + 1] = p2; stok[p1] = m; stok[p2] = m;
        if (NORMFOLD) { const float rr = VLD((const float*)(F.ws + WS_RSF) + m); float* rss = (float*)(F.ws + WS_RSS); rss[p1] = rr; rss[p2] = rr; } }
    (void)gw; (void)lane;
}
__device__ __forceinline__ void phase_combine(Frame& F, const float* g, bool last, const void* xsrc, void* xdst) {
    const int gw = F.vcu * NWAVES + F.wave, NGW = F.G * NWAVES, lane = F.lane;
    const int* tok_p = (const int*)(F.ws + WS_TOKP); const float* tok_w = (const float*)(F.ws + WS_TOKW);
    const bf16* Y = (const bf16*)(F.ws + WS_XP); bf16* XN = (bf16*)(F.ws + WS_XN);
#if XBF16
    typedef v2u xraw_t; const bf16* X = (const bf16*)xsrc;
#define PC_CVT(w_) ((f32x4){bflo((w_).x), bfhi((w_).x), bflo((w_).y), bfhi((w_).y)})
#else
    typedef f32x4 xraw_t; const float* X = (const float*)xsrc;
#define PC_CVT(w_) (w_)
#endif
    f32x4 gv[4];
#pragma unroll
    for (int j = 0; j < 4; ++j) gv[j] = *(const f32x4*)(g + 4 * lane + 256 * j);
    float cw1, cw2, dw1 = 0.f, dw2 = 0.f; xraw_t xn_[4], xm_[4]; v2u ya_[4], yb_[4], yc_[4], yd_[4];
    { const int p1 = VLD(tok_p + 2 * gw), p2 = VLD(tok_p + 2 * gw + 1); cw1 = VLD(tok_w + 2 * gw); cw2 = VLD(tok_w + 2 * gw + 1);
      const GAS xraw_t* xr = (const GAS xraw_t*)(X + (size_t)gw * D) + lane; const GAS v2u* y1 = (const GAS v2u*)(Y + (size_t)p1 * D) + lane; const GAS v2u* y2 = (const GAS v2u*)(Y + (size_t)p2 * D) + lane;
#pragma unroll
      for (int j = 0; j < 4; ++j) { xn_[j] = xr[64 * j]; ya_[j] = y1[64 * j]; yb_[j] = y2[64 * j]; } }
    if (gw + NGW < T) { const int mn = gw + NGW; const int p1 = VLD(tok_p + 2 * mn), p2 = VLD(tok_p + 2 * mn + 1); dw1 = VLD(tok_w + 2 * mn); dw2 = VLD(tok_w + 2 * mn + 1);
      const GAS xraw_t* xr = (const GAS xraw_t*)(X + (size_t)mn * D) + lane; const GAS v2u* y1 = (const GAS v2u*)(Y + (size_t)p1 * D) + lane; const GAS v2u* y2 = (const GAS v2u*)(Y + (size_t)p2 * D) + lane;
#pragma unroll
      for (int j = 0; j < 4; ++j) { xm_[j] = xr[64 * j]; yc_[j] = y1[64 * j]; yd_[j] = y2[64 * j]; } }
    int tp1 = 0, tp2 = 0; float tw1 = 0.f, tw2 = 0.f;
    if (gw + 2 * NGW < T) { const int mn = gw + 2 * NGW; tp1 = VLD(tok_p + 2 * mn); tp2 = VLD(tok_p + 2 * mn + 1); tw1 = VLD(tok_w + 2 * mn); tw2 = VLD(tok_w + 2 * mn + 1); }
    float prsd = 0.f; f32x4 po[4]; v2u pox[4], pon[4]; int pm = -1;
#pragma unroll
    for (int j = 0; j < 4; ++j) { po[j] = (f32x4){0.f, 0.f, 0.f, 0.f}; pox[j] = (v2u){0u, 0u}; pon[j] = (v2u){0u, 0u}; }
#if XBF16
#define PC_FLUSH() do { if (pm >= 0) { if (last) { GAS f32x4* xr_ = (GAS f32x4*)(F.out + (size_t)pm * D) + lane; _Pragma("unroll") for (int j = 0; j < 4; ++j) xr_[64 * j] = po[j]; } \
        else { GAS v2u* o8_ = (GAS v2u*)(XN + (size_t)pm * D) + lane; GAS v2u* xo_ = (GAS v2u*)((bf16*)xdst + (size_t)pm * D) + lane; _Pragma("unroll") for (int j = 0; j < 4; ++j) { xo_[64 * j] = pox[j]; if (!NORMFOLD) o8_[64 * j] = pon[j]; } \
            if (NORMFOLD && lane == 0) ((float*)(F.ws + WS_RSA))[pm] = prsd; } } } while (0)
#else
#define PC_FLUSH() do { if (pm >= 0) { if (last) { GAS f32x4* xr_ = (GAS f32x4*)(F.out + (size_t)pm * D) + lane; _Pragma("unroll") for (int j = 0; j < 4; ++j) xr_[64 * j] = po[j]; } \
        else { GAS v2u* o8_ = (GAS v2u*)(XN + (size_t)pm * D) + lane; GAS f32x4* xo_ = (GAS f32x4*)((float*)xdst + (size_t)pm * D) + lane; _Pragma("unroll") for (int j = 0; j < 4; ++j) { xo_[64 * j] = po[j]; o8_[64 * j] = pon[j]; } } } } while (0)
#endif
    for (int m = gw; m < T; m += NGW) {
        const float w1 = cw1, w2 = cw2;
        f32x4 v[4]; float s = 0.f;
#pragma unroll
        for (int j = 0; j < 4; ++j) { const v2u a = ya_[j], b = yb_[j];
            const f32x4 ya = (f32x4){bflo(a.x), bfhi(a.x), bflo(a.y), bfhi(a.y)}, yb = (f32x4){bflo(b.x), bfhi(b.x), bflo(b.y), bfhi(b.y)};
            v[j] = PC_CVT(xn_[j]) + (ya * w1 + yb * w2);
            s += (v[j].x * v[j].x + v[j].y * v[j].y) + (v[j].z * v[j].z + v[j].w * v[j].w);
            xn_[j] = xm_[j]; ya_[j] = yc_[j]; yb_[j] = yd_[j]; }
        cw1 = dw1; cw2 = dw2; dw1 = tw1; dw2 = tw2;
        if (m + 2 * NGW < T) { const int mn = m + 2 * NGW;
            const GAS xraw_t* xq = (const GAS xraw_t*)(X + (size_t)mn * D) + lane; const GAS v2u* y1 = (const GAS v2u*)(Y + (size_t)tp1 * D) + lane; const GAS v2u* y2 = (const GAS v2u*)(Y + (size_t)tp2 * D) + lane;
#pragma unroll
            for (int j = 0; j < 4; ++j) { xm_[j] = xq[64 * j]; yc_[j] = y1[64 * j]; yd_[j] = y2[64 * j]; } }
        if (m + 3 * NGW < T) { const int mn = m + 3 * NGW; tp1 = VLD(tok_p + 2 * mn); tp2 = VLD(tok_p + 2 * mn + 1); tw1 = VLD(tok_w + 2 * mn); tw2 = VLD(tok_w + 2 * mn + 1); }
        PC_FLUSH();
        const float rstd = 1.0f / sqrtf(wave_sum(s) * (1.f / D) + NORM_EPS);
        pm = m;
        if (last) {
#pragma unroll
            for (int j = 0; j < 4; ++j) po[j] = v[j] * rstd * gv[j];
        } else {
            if (NORMFOLD) prsd = rstd;
#pragma unroll
            for (int j = 0; j < 4; ++j) { const f32x4 y = v[j] * rstd * gv[j]; pon[j].x = pk2(y.x, y.y); pon[j].y = pk2(y.z, y.w);
#if XBF16
                pox[j].x = pk2(v[j].x, v[j].y); pox[j].y = pk2(v[j].z, v[j].w);
#else
                po[j] = v[j];
#endif
            }
        }
    }
    PC_FLUSH();
#undef PC_FLUSH
#undef PC_CVT
}

#if defined(__HIP_DEVICE_COMPILE__)
typedef float f32x4v __attribute__((ext_vector_type(4)));
typedef short v4i16_t __attribute__((ext_vector_type(4)));
__device__ __forceinline__ f32x4 mfma16(const bf16x8& a, const bf16x8& b, const f32x4& c) { return __builtin_amdgcn_mfma_f32_16x16x32_bf16(a, b, c, 0, 0, 0); }
__device__ __forceinline__ s16x4 tr_read(const LAS unsigned char* p) { return __builtin_bit_cast(s16x4, __builtin_amdgcn_ds_read_tr16_b64_v4i16((LAS v4i16_t*)p)); }
__device__ __forceinline__ bf16x8 join8(const s16x4& a, const s16x4& b) { bf16x8 r; r[0] = a[0]; r[1] = a[1]; r[2] = a[2]; r[3] = a[3]; r[4] = b[0]; r[5] = b[1]; r[6] = b[2]; r[7] = b[3]; return r; }
__device__ __forceinline__ bf16x8 pack_frag(const float (&v)[8]) { v4u w; w.x = cvt_pk_bf16(v[0], v[1]); w.y = cvt_pk_bf16(v[2], v[3]); w.z = cvt_pk_bf16(v[4], v[5]); w.w = cvt_pk_bf16(v[6], v[7]); return __builtin_bit_cast(bf16x8, w); }
template <int N> __device__ __forceinline__ float dpp_shr_t(float v) { return __builtin_bit_cast(float, __builtin_amdgcn_update_dpp(0, __builtin_bit_cast(int, v), 0x110 + N, 0xf, 0xf, true)); }
template <int N> __device__ __forceinline__ float dpp_ror_t(float v) { return __builtin_bit_cast(float, __builtin_amdgcn_update_dpp(0, __builtin_bit_cast(int, v), 0x120 + N, 0xf, 0xf, false)); }
__device__ __forceinline__ float rowsum16(float v) { v += dpp_ror_t<8>(v); v += dpp_ror_t<4>(v); v += dpp_ror_t<2>(v); v += dpp_ror_t<1>(v); return v; }
__device__ __forceinline__ float scan16(float v) { v += dpp_shr_t<1>(v); v += dpp_shr_t<2>(v); v += dpp_shr_t<4>(v); v += dpp_shr_t<8>(v); return v; }

constexpr int AT_PITCH = 160;
constexpr int AT_KOFF = 0, AT_VOFF = 384 * AT_PITCH;
__device__ __forceinline__ void attn_stage_load(Frame& F, int unit, v4u (&st)[12]) {
    const int b = unit >> 8, kvh = (unit >> 7) & 1, Q0 = (unit & 127) * 128; const bf16* PA = (const bf16*)(F.ws + WS_PA);
#pragma unroll
    for (int k = 0; k < 12; ++k) { const int idx = F.tid + 512 * k, kv = idx / (384 * 8), r = (idx >> 3) % 384, ch = idx & 7, key = Q0 - 128 + r;
        st[k] = (v4u){0u, 0u, 0u, 0u};
        if (key >= 0 && key < SEQ) st[k] = *(const GAS v4u*)(PA + (size_t)(b * SEQ + key) * NPA + (kv ? C_VA : C_KA) + 64 * kvh + 8 * ch); }
}
__device__ __forceinline__ void attn_stage_write(Frame& F, const v4u (&st)[12]) {
    LAS unsigned char* lds = F.lds + RING_OFF;
#pragma unroll
    for (int k = 0; k < 12; ++k) { const int idx = F.tid + 512 * k, kv = idx / (384 * 8), r = (idx >> 3) % 384, ch = idx & 7;
        *(LAS v4u*)(lds + (kv ? AT_VOFF : AT_KOFF) + r * AT_PITCH + ch * 16) = st[k]; }
}
__device__ __forceinline__ void attn_unit(Frame& F, int unit, int next_unit, v4u (&st)[12], const float* sink) {
    const int b = unit >> 8, kvh = (unit >> 7) & 1, qb = unit & 127, Q0 = qb * 128;
    const bf16* PA = (const bf16*)(F.ws + WS_PA); bf16* YA = (bf16*)(F.ws + WS_Y);
    LAS unsigned char* lds = F.lds + RING_OFF;
    attn_stage_write(F, st);
    __syncthreads();
    const int lane = F.lane, w = F.wave, fr = lane & 15, g = lane >> 4, qh = 4 * kvh + (w >> 1);
    const float sk = sink[qh] * LOG2E;
    const bool edge = (qb == 0) || (qb == SEQ / 128 - 1);
    static_assert(WINDOW == 128, "interior-tile test below");
    bf16x8 qn0, qn1;
    { const bf16* qp = PA + (size_t)(b * SEQ + Q0 + 64 * (w & 1) + fr) * NPA + C_QA + 64 * qh + 8 * g; qn0 = *(const GAS bf16x8*)qp; qn1 = *(const GAS bf16x8*)(qp + 32); }
    if (next_unit >= 0) attn_stage_load(F, next_unit, st);
    v2u py[4]; bf16* pyp = YA;
#pragma unroll
    for (int dt = 0; dt < 4; ++dt) py[dt] = (v2u){0u, 0u};
    for (int qbk = 0; qbk < 4; ++qbk) {
        const int qrel = 64 * (w & 1) + 16 * qbk, q = Q0 + qrel + fr;
        const bf16x8 qf0 = qn0, qf1 = qn1;
        f32x4 s[17]; float mx = sk;
#pragma unroll
        for (int t = 0; t < 17; ++t) { const int krel = qrel + 16 * t;
            const LAS unsigned char* kp = lds + AT_KOFF + (krel + fr) * AT_PITCH + g * 16;
            f32x4 a = (f32x4){0.f, 0.f, 0.f, 0.f};
            a = mfma16(*(const LAS bf16x8*)kp, qf0, a); a = mfma16(*(const LAS bf16x8*)(kp + 64), qf1, a);
            s[t] = a; }
#define AT_MASK(t) do { _Pragma("unroll") for (int r = 0; r < 4; ++r) { const int key = Q0 - 128 + qrel + 16 * (t) + 4 * g + r; const int dlt = key - q; \
            const bool ok = (dlt >= -WINDOW) && (dlt <= WINDOW) && (key >= 0) && (key < SEQ); s[t][r] = ok ? s[t][r] : -3.0e38f; } } while (0)
        if (edge) {
#pragma unroll
            for (int t = 0; t < 17; ++t) AT_MASK(t);
        } else { AT_MASK(0); AT_MASK(16); }
#undef AT_MASK
#pragma unroll
        for (int t = 0; t < 17; ++t) mx = fmaxf(fmaxf(mx, fmaxf(s[t][0], s[t][1])), fmaxf(s[t][2], s[t][3]));
        __builtin_amdgcn_sched_barrier(0);
        if (qbk < 3) { const bf16* qp = PA + (size_t)(b * SEQ + q + 16) * NPA + C_QA + 64 * qh + 8 * g; qn0 = *(const GAS bf16x8*)qp; qn1 = *(const GAS bf16x8*)(qp + 32); }
        if (qbk > 0) {
#pragma unroll
            for (int dt = 0; dt < 4; ++dt) *(GAS v2u*)(pyp + 16 * dt) = py[dt]; }
        __builtin_amdgcn_sched_barrier(0);
        mx = fmaxf(mx, __shfl_xor(mx, 16)); mx = fmaxf(mx, __shfl_xor(mx, 32));
        float den = 0.f;
#pragma unroll
        for (int t = 0; t < 17; ++t)
#pragma unroll
            for (int r = 0; r < 4; ++r) { const float p = __builtin_amdgcn_exp2f(s[t][r] - mx); s[t][r] = p; den += p; }
        den += __shfl_xor(den, 16); den += __shfl_xor(den, 32); den += __builtin_amdgcn_exp2f(sk - mx);
        const float inv = 1.0f / den;
        f32x4 o[4];
#pragma unroll
        for (int dt = 0; dt < 4; ++dt) o[dt] = (f32x4){0.f, 0.f, 0.f, 0.f};
#pragma unroll
        for (int tp = 0; tp < 9; ++tp) { const int t0 = 2 * tp, t1 = (2 * tp + 1 < 17) ? 2 * tp + 1 : 2 * tp;
            float pv[8];
#pragma unroll
            for (int r = 0; r < 4; ++r) { pv[r] = s[t0][r]; pv[4 + r] = (2 * tp + 1 < 17) ? s[t1][r] : 0.f; }
            const bf16x8 pf = pack_frag(pv);
            const LAS unsigned char* v0 = lds + AT_VOFF + (qrel + 16 * t0 + 4 * g + (fr >> 2)) * AT_PITCH + (fr & 3) * 8;
            const LAS unsigned char* v1 = lds + AT_VOFF + (qrel + 16 * t1 + 4 * g + (fr >> 2)) * AT_PITCH + (fr & 3) * 8;
#pragma unroll
            for (int dt = 0; dt < 4; ++dt) o[dt] = mfma16(join8(tr_read(v0 + dt * 32), tr_read(v1 + dt * 32)), pf, o[dt]); }
        pyp = YA + (size_t)(b * SEQ + q) * 512 + 64 * qh + 4 * g;
#pragma unroll
        for (int dt = 0; dt < 4; ++dt) { py[dt].x = cvt_pk_bf16(o[dt][0] * inv, o[dt][1] * inv); py[dt].y = cvt_pk_bf16(o[dt][2] * inv, o[dt][3] * inv); }
    }
#pragma unroll
    for (int dt = 0; dt < 4; ++dt) *(GAS v2u*)(pyp + 16 * dt) = py[dt];
    __syncthreads();
}
constexpr int HG_PITCH = 288;
constexpr int HG_V = 0, HG_KF = 128 * HG_PITCH, HG_KB = 2 * 128 * HG_PITCH, HG_TOT = 3 * 128 * HG_PITCH;
static_assert(HG_TOT + (4 * 8 * 128 + 256) * 4 <= RING_BYTES, "hgrn LDS");
__device__ __forceinline__ void hg_load_scan8(const bf16* p8  , float (&lf)[8], float (&P)[8], float (&T)[8], int lane) {
    const h16x8 hv = *(const GAS h16x8*)p8;
#pragma unroll
    for (int jj = 0; jj < 8; ++jj) { lf[jj] = (float)hv[jj]; P[jj] = scan16(lf[jj]); T[jj] = __shfl(P[jj], (lane & 48) | 15); }
}
__device__ __forceinline__ void hg_v_load(Frame& F, int b, int h, int t0, v4u (&vst)[4]) { const bf16* PA = (const bf16*)(F.ws + WS_PA);
#pragma unroll
    for (int k = 0; k < 4; ++k) { const int idx = F.tid + 512 * k, r = idx >> 4, ch = idx & 15; vst[k] = *(const GAS v4u*)(PA + (size_t)(b * SEQ + t0 + r) * NPA + C_VH + 128 * h + 8 * ch); } }
__device__ __forceinline__ void hg_v_write(Frame& F, const v4u (&vst)[4]) { LAS unsigned char* lds = F.lds + RING_OFF;
#pragma unroll
    for (int k = 0; k < 4; ++k) { const int idx = F.tid + 512 * k, r = idx >> 4, ch = idx & 15; *(LAS v4u*)(lds + HG_V + r * HG_PITCH + ch * 16) = vst[k]; } }
__device__ __forceinline__ void ha_decay_load(Frame& F, int unit, h16x8 (&hvv)[8]) {
    const int bh = unit >> 7, n = unit & 127, b = bh >> 2, h = bh & 3, t0 = n * CH, lane = F.lane, w = F.wave, fr = lane & 15, g = lane >> 4, dir = w >> 2, dq = w & 3;
    const bf16* lp = (const bf16*)(F.ws + WS_PA) + (size_t)(b * SEQ + t0 + fr) * NPA + (dir ? C_LB : C_LF) + 128 * h + 32 * dq + 8 * g;
#pragma unroll
    for (int k = 0; k < 8; ++k) { const int j = dir ? k : (7 - k); hvv[k] = *(const GAS h16x8*)(lp + (size_t)(16 * j) * NPA); }
}
__device__ __forceinline__ void ha_unit(Frame& F, int unit, int next_unit, v4u (&vst)[4], h16x8 (&hvv)[8]) {
    const int bh = unit >> 7, n = unit & 127, b = bh >> 2, h = bh & 3, t0 = n * CH;
    const bf16* PA = (const bf16*)(F.ws + WS_PA); bf16* US = (bf16*)(F.ws + WS_US); float* HD = (float*)(F.ws + WS_HD);
    LAS unsigned char* lds = F.lds + RING_OFF;
    const int lane = F.lane, w = F.wave, fr = lane & 15, g = lane >> 4, dir = w >> 2, dq = w & 3;
    hg_v_write(F, vst);
    if (next_unit >= 0) { const int bh2 = next_unit >> 7; hg_v_load(F, bh2 >> 2, bh2 & 3, (next_unit & 127) * CH, vst); }
    float run[8];
#pragma unroll
    for (int jj = 0; jj < 8; ++jj) run[jj] = 0.f;
    __builtin_amdgcn_sched_barrier(0);
#pragma unroll
    for (int k = 0; k < 8; ++k) { const int j = dir ? k : (7 - k);
        float kv[8];
#pragma unroll
        for (int jj = 0; jj < 8; ++jj) { const float lf = (float)hvv[k][jj], P = scan16(lf), Tt = __shfl(P, (lane & 48) | 15);
            const float wi = dir ? (P - lf) : (Tt - P); kv[jj] = (1.0f - __builtin_amdgcn_exp2f(lf)) * __builtin_amdgcn_exp2f(wi + run[jj]); run[jj] += Tt; }
        *(LAS bf16x8*)(lds + (dir ? HG_KB : HG_KF) + (16 * j + fr) * HG_PITCH + (32 * dq + 8 * g) * 2) = pack_frag(kv); }
    __builtin_amdgcn_sched_barrier(0);
    if (next_unit >= 0) ha_decay_load(F, next_unit, hvv);
    __builtin_amdgcn_sched_barrier(0);
    if (fr == 0) {
#pragma unroll
        for (int jj = 0; jj < 8; ++jj) HD[((size_t)(bh * 2 + dir) * NCH + n) * 128 + 32 * dq + 8 * g + jj] = __builtin_amdgcn_exp2f(run[jj]); }
    __syncthreads();
    f32x4 acc[2][8];
#pragma unroll
    for (int mt = 0; mt < 2; ++mt)
#pragma unroll
        for (int nt = 0; nt < 8; ++nt) acc[mt][nt] = (f32x4){0.f, 0.f, 0.f, 0.f};
    const LAS unsigned char* kb = lds + (dir ? HG_KB : HG_KF) + (4 * g + (fr >> 2)) * HG_PITCH + (fr & 3) * 8;
    const LAS unsigned char* vb = lds + HG_V + (4 * g + (fr >> 2)) * HG_PITCH + (fr & 3) * 8;
#pragma unroll
    for (int ks = 0; ks < 4; ++ks) { bf16x8 af[2];
#pragma unroll
        for (int mt = 0; mt < 2; ++mt) { const LAS unsigned char* p = kb + (32 * ks) * HG_PITCH + (16 * (2 * dq + mt)) * 2; af[mt] = join8(tr_read(p), tr_read(p + 16 * HG_PITCH)); }
#pragma unroll
        for (int nt = 0; nt < 8; ++nt) { const LAS unsigned char* p = vb + (32 * ks) * HG_PITCH + (16 * nt) * 2; const bf16x8 bfr = join8(tr_read(p), tr_read(p + 16 * HG_PITCH));
#pragma unroll
            for (int mt = 0; mt < 2; ++mt) acc[mt][nt] = mfma16(af[mt], bfr, acc[mt][nt]); } }
    bf16* up = US + ((size_t)(bh * 2 + dir) * NCH + n) * 128 * 128;
#pragma unroll
    for (int mt = 0; mt < 2; ++mt)
#pragma unroll
        for (int nt = 0; nt < 8; ++nt) { v2u wv; wv.x = cvt_pk_bf16(acc[mt][nt][0], acc[mt][nt][1]); wv.y = cvt_pk_bf16(acc[mt][nt][2], acc[mt][nt][3]);
            *(GAS v2u*)(up + (size_t)(16 * nt + fr) * 128 + 16 * (2 * dq + mt) + 4 * g) = wv; }
    __syncthreads();
}
#if G1A_SPLIT
__device__ __forceinline__ void phase_hb(Frame& F, int v, int g) {
    bf16* US = (bf16*)(F.ws + WS_US); const float* HD = (const float*)(F.ws + WS_HD);
    const int stride = g * NWAVES * 64, TOT = 16 * 128 * 64;
    for (int ea = v * (NWAVES * 64) + F.tid; ea < TOT; ea += 2 * stride) {
        const bool two = G1A_SPLIT && (ea + stride < TOT); const int eb = two ? ea + stride : ea;
        const int dpa = ea & 63, ca = ea >> 13, dira = ca & 1, dpb = eb & 63, cb = eb >> 13, dirb = cb & 1;
        float a0 = 0.f, a1 = 0.f, b0 = 0.f, b1 = 0.f;
        GAS unsigned* upa = (GAS unsigned*)(US + (size_t)ca * NCH * 128 * 128 + (size_t)((ea >> 6) & 127) * 128) + dpa; const GAS pg8::f32x2_t* dda = (const GAS pg8::f32x2_t*)((const GAS float*)HD + (size_t)ca * NCH * 128) + dpa;
        GAS unsigned* upb = (GAS unsigned*)(US + (size_t)cb * NCH * 128 * 128 + (size_t)((eb >> 6) & 127) * 128) + dpb; const GAS pg8::f32x2_t* ddb = (const GAS pg8::f32x2_t*)((const GAS float*)HD + (size_t)cb * NCH * 128) + dpb;
        for (int k0 = 0; k0 < NCH; k0 += 16) {
            unsigned ua[16], ub[16]; pg8::f32x2_t da[16], db[16];
#pragma unroll
            for (int k = 0; k < 16; ++k) { const int na = dira ? (NCH - 1 - (k0 + k)) : (k0 + k), nb = dirb ? (NCH - 1 - (k0 + k)) : (k0 + k);
                ua[k] = upa[(size_t)na * (128 * 128 / 2)]; da[k] = dda[na * 64]; ub[k] = upb[(size_t)nb * (128 * 128 / 2)]; db[k] = ddb[nb * 64]; }
#pragma unroll
            for (int k = 0; k < 16; ++k) { const int na = dira ? (NCH - 1 - (k0 + k)) : (k0 + k), nb = dirb ? (NCH - 1 - (k0 + k)) : (k0 + k);
                upa[(size_t)na * (128 * 128 / 2)] = pk2(a0, a1);
                a0 = da[k].x * a0 + bflo(ua[k]); a1 = da[k].y * a1 + bfhi(ua[k]);
                if (two) upb[(size_t)nb * (128 * 128 / 2)] = pk2(b0, b1);
                b0 = db[k].x * b0 + bflo(ub[k]); b1 = db[k].y * b1 + bfhi(ub[k]); } }
    }
}
#else
__device__ __forceinline__ void phase_hb(Frame& F, int v, int g) {
    bf16* US = (bf16*)(F.ws + WS_US); const float* HD = (const float*)(F.ws + WS_HD);
    const int idx = v * (NWAVES * 64) + F.tid;
    for (int e0 = idx; e0 < 16 * 128 * 64; e0 += g * NWAVES * 64) { const int dp = e0 & 63, e = (e0 >> 6) & 127, combo = e0 >> 13, dir = combo & 1;
        float s0 = 0.f, s1 = 0.f;
        GAS unsigned* up = (GAS unsigned*)(US + (size_t)combo * NCH * 128 * 128 + (size_t)e * 128) + dp; const GAS float* dpp = (const GAS float*)HD + (size_t)combo * NCH * 128 + 2 * dp;
        for (int k0 = 0; k0 < NCH; k0 += 16) {
            unsigned u[16]; float d0[16], d1[16];
#pragma unroll
            for (int k = 0; k < 16; ++k) { const int n = dir ? (NCH - 1 - (k0 + k)) : (k0 + k); u[k] = up[(size_t)n * (128 * 128 / 2)]; d0[k] = dpp[n * 128]; d1[k] = dpp[n * 128 + 1]; }
#pragma unroll
            for (int k = 0; k < 16; ++k) { const int n = dir ? (NCH - 1 - (k0 + k)) : (k0 + k);
                up[(size_t)n * (128 * 128 / 2)] = pk2(s0, s1);
                s0 = d0[k] * s0 + bflo(u[k]); s1 = d1[k] * s1 + bfhi(u[k]); } }
    }
}
#endif
constexpr int HC_SPITCH = 272;
constexpr int HC_K = 128 * HG_PITCH, HC_S = 2 * 128 * HG_PITCH, HC_E = HC_S + 128 * HC_SPITCH;
static_assert(HC_E + 2 * 8 * 128 * 4 <= RING_BYTES, "hc LDS");
#ifndef HC_TERMS
#define HC_TERMS 7
#endif
__device__ __forceinline__ void hc_unit(Frame& F, int unit, int next_unit, v4u (&vst)[4], const float* hng) {
    const int h = unit & 3, n = (unit >> 2) & 127, b = unit >> 9, bh = b * 4 + h, t0 = n * CH;
    const bf16* PA = (const bf16*)(F.ws + WS_PA); const bf16* US = (const bf16*)(F.ws + WS_US); bf16* YH = (bf16*)(F.ws + WS_YH); float* ssq = (float*)(F.ws + WS_SSQ);
    LAS unsigned char* lds = F.lds + RING_OFF; LAS float* ebl = (LAS float*)(lds + HC_E);
    const int lane = F.lane, i = F.wave, fr = lane & 15, g = lane >> 4;
    const size_t trow = (size_t)(b * SEQ + t0 + 16 * i + fr);
    hg_v_write(F, vst);
    if (next_unit >= 0) hg_v_load(F, next_unit >> 9, next_unit & 3, ((next_unit >> 2) & 127) * CH, vst);
    const bf16* sbase0 = US + ((size_t)(bh * 2) * NCH + n) * 128 * 128;
    v4u sreg[4];
#pragma unroll
    for (int k = 0; k < 4; ++k) { const int c = F.tid + 512 * k; sreg[k] = *(const GAS v4u*)(sbase0 + (size_t)(c >> 4) * 128 + (c & 15) * 8); }
    h16x8 lfv[2][4]; v4u qwv[4];
#pragma unroll
    for (int ks = 0; ks < 4; ++ks) { lfv[0][ks] = *(const GAS h16x8*)(PA + trow * NPA + C_LF + 128 * h + 32 * ks + 8 * g); qwv[ks] = *(const GAS v4u*)(PA + trow * NPA + C_QH + 128 * h + 32 * ks + 8 * g); }
#pragma unroll
    for (int ks = 0; ks < 4; ++ks) lfv[1][ks] = *(const GAS h16x8*)(PA + trow * NPA + C_LB + 128 * h + 32 * ks + 8 * g);
    __builtin_amdgcn_sched_barrier(0);
    f32x4 o[8];
#pragma unroll
    for (int et = 0; et < 8; ++et) o[et] = (f32x4){0.f, 0.f, 0.f, 0.f};
    const LAS unsigned char* vtr = lds + HG_V + (4 * g + (fr >> 2)) * HG_PITCH + (fr & 3) * 8;
#pragma unroll
    for (int dir = 0; dir < 2; ++dir) {
        if (dir == 1) __syncthreads();
#pragma unroll
        for (int k = 0; k < 4; ++k) { const int c = F.tid + 512 * k; *(LAS v4u*)(lds + HC_S + (c >> 4) * HC_SPITCH + (c & 15) * 16) = sreg[k]; }
        float ql[32]; bf16x8 kst[4]; bf16x8 qf[4];
#pragma unroll
        for (int ks = 0; ks < 4; ++ks) { float lf[8], P[8], T[8], ke[8], kd[8], t8[8], et_[8];
            { const h16x8 hv = lfv[dir][ks];
#pragma unroll
              for (int jj = 0; jj < 8; ++jj) { lf[jj] = (float)hv[jj]; P[jj] = scan16(lf[jj]); T[jj] = __shfl(P[jj], (lane & 48) | 15); } }
            const v4u qw = qwv[ks];
            const float qv[8] = {bflo(qw.x), bfhi(qw.x), bflo(qw.y), bfhi(qw.y), bflo(qw.z), bfhi(qw.z), bflo(qw.w), bfhi(qw.w)};
#pragma unroll
            for (int jj = 0; jj < 8; ++jj) { const float kk = 1.0f - __builtin_amdgcn_exp2f(lf[jj]);
                const float binc = dir ? (T[jj] - P[jj] + lf[jj]) : P[jj];
                const float ea = __builtin_amdgcn_exp2f(binc), ra = __builtin_amdgcn_rcpf(ea); et_[jj] = __builtin_amdgcn_exp2f(T[jj]);
                ql[8 * ks + jj] = qv[jj] * ea; t8[jj] = ql[8 * ks + jj]; ke[jj] = kk * et_[jj] * ra; kd[jj] = kk * ra;
#if defined(HC_DBG) && HC_DBG >= 3
                ql[8 * ks + jj] = qv[jj]; t8[jj] = qv[jj]; kd[jj] = kk;
                if (HC_DBG == 4) kd[jj] = (32 * ks + 8 * g + jj == 0) ? 1.0f : 0.f;
                if (HC_DBG == 5) kd[jj] = (32 * ks + 8 * g + jj == 0) ? kk : 0.f;
                if (HC_DBG >= 9) kd[jj] = 0.f;
                if (HC_DBG == 8) kd[jj] = (32 * ks + 8 * g + jj == 0) ? (float)fr : 0.f;
                if (HC_DBG == 6) kd[jj] = (32 * ks + 8 * g + jj == 0) ? lf[jj] : 0.f;
                if (HC_DBG == 7) kd[jj] = (32 * ks + 8 * g + jj == 0) ? (1.0f - __expf(lf[jj])) : 0.f;
#endif
                }
            *(LAS bf16x8*)(lds + HC_K + (16 * i + fr) * HG_PITCH + (32 * ks + 8 * g) * 2) = pack_frag(ke);
            kst[ks] = pack_frag(kd); qf[ks] = pack_frag(t8);
            if (fr == 0) {
#pragma unroll
                for (int jj = 0; jj < 8; ++jj) ebl[(dir * 8 + i) * 128 + 32 * ks + 8 * g + jj] = et_[jj]; }
            __builtin_amdgcn_sched_barrier(0); }
        __syncthreads();
        if (dir == 0) {
#pragma unroll
            for (int k = 0; k < 4; ++k) { const int c = F.tid + 512 * k; sreg[k] = *(const GAS v4u*)(sbase0 + (size_t)NCH * 128 * 128 + (size_t)(c >> 4) * 128 + (c & 15) * 8); } }
        f32x4 at = (f32x4){0.f, 0.f, 0.f, 0.f};
#pragma unroll
        for (int ks = 0; ks < 4; ++ks) at = mfma16(kst[ks], qf[ks], at);
#if defined(HC_DBG) && HC_DBG >= 9
        { const float q0 = __shfl(ql[0], fr);
          for (int r = 0; r < 4; ++r) at[r] = (HC_DBG == 9) ? (float)(4 * g + r) * q0 : ((HC_DBG == 10) ? (float)(4 * g + r) : (float)fr); }
#endif
        float pend[4]; int jpend = i;
#pragma unroll
        for (int r = 0; r < 4; ++r) { const int s = 4 * g + r; const bool keep = (HC_TERMS & 1) && (dir ? (s >= fr) : (s <= fr)); pend[r] = keep ? at[r] : 0.f;
#if defined(HC_DBG) && HC_DBG == 1
            pend[r] = (dir == 0 && s == fr) ? 1.0f : 0.f;
#endif
            }
        bool have = true;
        const int nj = dir ? (7 - i) : i;
        for (int k = 0; k < nj; ++k) { const int j = dir ? (i + 1 + k) : (i - 1 - k);
            f32x4 a2 = (f32x4){0.f, 0.f, 0.f, 0.f};
            const LAS unsigned char* kp = lds + HC_K + (16 * j + fr) * HG_PITCH + g * 16;
#pragma unroll
            for (int ks = 0; ks < 4; ++ks) a2 = mfma16(*(const LAS bf16x8*)(kp + ks * 64), qf[ks], a2);
#pragma unroll
            for (int ks = 0; ks < 4; ++ks) { const LAS float* ep = ebl + (dir * 8 + j) * 128 + 32 * ks + 8 * g; float t8[8];
#pragma unroll
                for (int jj = 0; jj < 8; ++jj) { ql[8 * ks + jj] *= ep[jj]; t8[jj] = ql[8 * ks + jj]; }
                qf[ks] = pack_frag(t8); }
            if (have) { float pv[8];
#pragma unroll
                for (int r = 0; r < 4; ++r) { pv[r] = pend[r]; pv[4 + r] = (HC_TERMS & 2) ? a2[r] : 0.f; }
                const bf16x8 pf = pack_frag(pv); const LAS unsigned char* v0 = vtr + 16 * jpend * HG_PITCH; const LAS unsigned char* v1 = vtr + 16 * j * HG_PITCH;
#pragma unroll
                for (int et = 0; et < 8; ++et) o[et] = mfma16(join8(tr_read(v0 + et * 32), tr_read(v1 + et * 32)), pf, o[et]);
                have = false;
            } else {
#pragma unroll
                for (int r = 0; r < 4; ++r) pend[r] = (HC_TERMS & 2) ? a2[r] : 0.f;
                jpend = j; have = true; }
        }
        if (have) { float pv[8];
#pragma unroll
            for (int r = 0; r < 4; ++r) { pv[r] = pend[r]; pv[4 + r] = 0.f; }
            const bf16x8 pf = pack_frag(pv); const LAS unsigned char* v0 = vtr + 16 * jpend * HG_PITCH;
#pragma unroll
            for (int et = 0; et < 8; ++et) o[et] = mfma16(join8(tr_read(v0 + et * 32), tr_read(v0 + et * 32)), pf, o[et]); }
        const LAS unsigned char* sp = lds + HC_S + fr * HC_SPITCH + g * 16;
#pragma unroll
        for (int et = 0; et < 8; ++et)
#pragma unroll
            for (int ks = 0; ks < 4; ++ks) if (HC_TERMS & 4) o[et] = mfma16(*(const LAS bf16x8*)(sp + 16 * et * HC_SPITCH + ks * 64), qf[ks], o[et]);
    }
    float sq = 0.f; bf16* yp = YH + trow * 512 + 128 * h + 4 * g; const bf16* sgp = PA + trow * NPA + C_SG + 128 * h + 4 * g; const float* gp = hng + 128 * h + 4 * g;
    v2u swv[8]; f32x4 gvv[8];
#pragma unroll
    for (int et = 0; et < 8; ++et) { swv[et] = *(const GAS v2u*)(sgp + 16 * et); gvv[et] = *(const GAS f32x4*)(gp + 16 * et); }
#pragma unroll
    for (int et = 0; et < 8; ++et) { const v2u sw = swv[et]; const f32x4 gv = gvv[et]; const f32x4 ov = o[et];
        sq += (ov[0] * ov[0] + ov[1] * ov[1]) + (ov[2] * ov[2] + ov[3] * ov[3]);
        v2u wv; wv.x = cvt_pk_bf16(ov[0] * gv[0] * bflo(sw.x), ov[1] * gv[1] * bfhi(sw.x)); wv.y = cvt_pk_bf16(ov[2] * gv[2] * bflo(sw.y), ov[3] * gv[3] * bfhi(sw.y));
        *(GAS v2u*)(yp + 16 * et) = wv; }
    sq += __shfl_xor(sq, 16); sq += __shfl_xor(sq, 32);
    if (g == 0) ssq[trow * 4 + h] = sq;
    __syncthreads();
}
__device__ __forceinline__ int attn_item_unit(int i) { return (i < 256) ? i : 256 + ((i + 64) & 255); }
__device__ __forceinline__ void phase_attn(Frame& F, const float* sink) { constexpr int NU = BATCH * NKVH * (SEQ / 128); v4u st[12];
    static_assert(NU == 512, "attn_item_unit");
    if (F.vcu < NU) attn_stage_load(F, attn_item_unit(F.vcu), st);
    for (int i = F.vcu; i < NU; i += F.G) attn_unit(F, attn_item_unit(i), (i + F.G < NU) ? attn_item_unit(i + F.G) : -1, st, sink); }
__device__ __forceinline__ void phase_ha(Frame& F) { constexpr int NU = BATCH * HH * NCH; v4u vst[4]; h16x8 hvv[8];
    if (F.vcu < NU) { const int bh = F.vcu >> 7; hg_v_load(F, bh >> 2, bh & 3, (F.vcu & 127) * CH, vst); ha_decay_load(F, F.vcu, hvv); }
    for (int u = F.vcu; u < NU; u += F.G) ha_unit(F, u, (u + F.G < NU) ? u + F.G : -1, vst, hvv); }
__device__ __forceinline__ void phase_hc(Frame& F, const float* hng) {
    constexpr int NU = BATCH * NCH * HH; v4u vst[4];
    if (F.vcu < NU) hg_v_load(F, F.vcu >> 9, F.vcu & 3, ((F.vcu >> 2) & 127) * CH, vst);
    for (int u = F.vcu; u < NU; u += F.G) hc_unit(F, u, (u + F.G < NU) ? u + F.G : -1, vst, hng);
}

#else
__device__ void phase_attn(Frame& F, const float* sink);
__device__ void phase_ha(Frame& F);
__device__ void phase_hb(Frame& F, int v, int g);
__device__ void phase_hc(Frame& F, const float* hng);
#endif


#if defined(ORACLE)
__global__ void __launch_bounds__(256) simple_attn(const bf16* PA, const float* sink, bf16* YA) {
    const int lane = threadIdx.x & 63, task = blockIdx.x * 4 + (threadIdx.x >> 6);
    const int m = task >> 3, qh = task & 7, kvh = qh >> 2, b = m / SEQ, t = m % SEQ;
    float q[64];
    { const bf16* qp = PA + (size_t)m * NPA + C_QA + 64 * qh;
#pragma unroll
      for (int d = 0; d < 64; ++d) q[d] = bf2f(qp[d]); }
    float s[5]; float mx = sink[qh] * LOG2E;
#pragma unroll
    for (int r = 0; r < 5; ++r) { const int j = t - WINDOW + 64 * r + lane; const bool ok = (j >= 0) && (j < SEQ) && (j <= t + WINDOW);
        float a = -3.0e38f;
        if (ok) { const bf16* kp = PA + (size_t)(b * SEQ + j) * NPA + C_KA + 64 * kvh; a = 0.f;
#pragma unroll
            for (int d = 0; d < 64; ++d) a += q[d] * bf2f(kp[d]); }
        s[r] = a; mx = fmaxf(mx, a); }
#pragma unroll
    for (int o = 1; o < 64; o <<= 1) mx = fmaxf(mx, __shfl_xor(mx, o));
    float den = 0.f;
#pragma unroll
    for (int r = 0; r < 5; ++r) { s[r] = (s[r] > -1.0e38f) ? exp2f(s[r] - mx) : 0.f; den += s[r]; }
    den = wave_sum(den) + exp2f(sink[qh] * LOG2E - mx);
    float o = 0.f;
    for (int r = 0; r < 5; ++r) for (int jj = 0; jj < 64; ++jj) { const int j = t - WINDOW + 64 * r + jj; const float p = __shfl(s[r], jj);
        if (j >= 0 && j < SEQ && j <= t + WINDOW) o += p * bf2f(PA[(size_t)(b * SEQ + j) * NPA + C_VA + 64 * kvh + lane]); }
#if defined(ABL_NOATTN)
    YA[(size_t)m * 512 + 64 * qh + lane] = 0;
#else
    YA[(size_t)m * 512 + 64 * qh + lane] = (bf16)f2bf(o / den);
#endif
}
__global__ void __launch_bounds__(512) simple_hgrn(const bf16* PA, const float* hng, float* obuf, bf16* YH, float* ssq) {
    __shared__ float part[32][4][128];
    const int tid = threadIdx.x, e = tid & 127, dq = tid >> 7, b = blockIdx.x >> 2, h = blockIdx.x & 3;
    for (int dir = 0; dir < 2; ++dir) {
        float S[32];
#pragma unroll
        for (int d = 0; d < 32; ++d) S[d] = 0.f;
        for (int t0 = 0; t0 < SEQ; t0 += 32) {
            for (int tt = 0; tt < 32; ++tt) { const int t = dir ? (SEQ - 1 - (t0 + tt)) : (t0 + tt); const bf16* row = PA + (size_t)(b * SEQ + t) * NPA;
                const float v = bf2f(row[C_VH + 128 * h + e]); const _Float16* lf = (const _Float16*)(row + (dir ? C_LB : C_LF) + 128 * h + 32 * dq); const bf16* qp = row + C_QH + 128 * h + 32 * dq;
                float o = 0.f;
#pragma unroll
                for (int d = 0; d < 32; ++d) { const float l = (float)lf[d], f = expf(l), k = -expm1f(l); S[d] = f * S[d] + k * v; o += S[d] * bf2f(qp[d]); }
                part[tt][dq][e] = o; }
            __syncthreads();
            for (int idx = tid; idx < 32 * 128; idx += 512) { const int tt = idx >> 7, ee = idx & 127; const int t = dir ? (SEQ - 1 - (t0 + tt)) : (t0 + tt); const size_t m = (size_t)b * SEQ + t;
                float o = (part[tt][0][ee] + part[tt][1][ee]) + (part[tt][2][ee] + part[tt][3][ee]);
                if (dir == 0) obuf[m * 512 + 128 * h + ee] = o;
                else { o += obuf[m * 512 + 128 * h + ee];
                    const float sg = bf2f(PA[m * NPA + C_SG + 128 * h + ee]);
#if defined(ABL_NOHGRN)
                    YH[m * 512 + 128 * h + ee] = 0;
#else
                    YH[m * 512 + 128 * h + ee] = (bf16)f2bf(o * hng[128 * h + ee] * sg);
#endif

                    const float q = wave_sum(o * o);
                    if ((tid & 63) == 0) atomicAdd(&ssq[m * 4 + h], q); } }
            __syncthreads();
        }
    }
}
__global__ void zero_f32(float* p, int n) { const int i = blockIdx.x * blockDim.x + threadIdx.x; if (i < n) p[i] = 0.f; }
#endif

#if defined(CHECK)
#define CK_NS 48
__device__ __forceinline__ int ck_row(int s) { return (int)(((long)s * 10007 + 77) % T); }
__device__ __forceinline__ bool ck_cmp(float got, float ref, float rtol, float atol, unsigned* cnt) { const float d = fabsf(got - ref); if (!(d <= rtol * fabsf(ref) + atol)) { atomicAdd(cnt, 1u); return true; } return false; }
__global__ void ck_norm(const float* x, const float* g, const bf16* XN, unsigned* cnt) {
    const int m = ck_row(blockIdx.x); __shared__ float red[256];
    float s = 0.f; for (int c = threadIdx.x; c < D; c += 256) { const float v = x[(size_t)m * D + c]; s += v * v; }
    red[threadIdx.x] = s; __syncthreads(); for (int o = 128; o > 0; o >>= 1) { if (threadIdx.x < o) red[threadIdx.x] += red[threadIdx.x + o]; __syncthreads(); }
    const float rstd = 1.0f / sqrtf(red[0] / D + NORM_EPS);
    for (int c = threadIdx.x; c < D; c += 256) ck_cmp(bf2f(XN[(size_t)m * D + c]), x[(size_t)m * D + c] * rstd * g[c], 0.01f, 0.01f, cnt);
}
__global__ void ck_pa(const bf16* XN, const float* w_in, const float* lb_tab  , int l, const bf16* PA, unsigned* cnt) {
    const int m = ck_row(blockIdx.x), pos = m % SEQ; __shared__ float z[NPA]; __shared__ float xr[D];
    for (int c = threadIdx.x; c < D; c += 256) xr[c] = bf2f(XN[(size_t)m * D + c]);
    __syncthreads();
    for (int c = threadIdx.x; c < NPA; c += 256) { float a = 0.f; for (int k = 0; k < D; ++k) a += xr[k] * w_in[(size_t)k * INW + c]; z[c] = a; }
    __syncthreads();
    for (int c = threadIdx.x; c < NPA; c += 256) {
        const float got_b = bf2f(PA[(size_t)m * NPA + c]); const float got_h = (float)((const _Float16*)PA)[(size_t)m * NPA + c];
        if (c < C_VA) { const int d = c & 63, i = d & 31; const double inv = exp2(-(double)i * (13.287712379549449 / 32.0)); const float cs = (float)cos((double)pos * inv), sn = (float)sin((double)pos * inv);
            const float x1 = z[(c & ~63) + i], x2 = z[(c & ~63) + i + 32]; float r = (d < 32) ? (x1 * cs - x2 * sn) : (x2 * cs + x1 * sn); if (c < C_KA) r *= QSCALE;
            ck_cmp(got_b, r, 0.02f, 0.03f, cnt + 0);
        } else if (c < C_QH) ck_cmp(got_b, z[c], 0.02f, 0.02f, cnt + 1);
        else if (c < C_LF) ck_cmp(got_b, z[c] / (1.f + expf(-z[c])), 0.02f, 0.02f, cnt + 2);
        else if (c < C_VH) { const int dir = (c >= C_LB), col = c - (dir ? C_LB : C_LF);
            float t0 = lb_tab[(0 * 2 + dir) * 512 + col], t1 = lb_tab[(1 * 2 + dir) * 512 + col]; const float mx = fmaxf(t0, t1); t0 = expf(t0 - mx); t1 = expf(t1 - mx);
            const float lb = (l == 0) ? 0.f : t1 / (t0 + t1); const float sg = 1.f / (1.f + expf(-z[c])); const float r = fmaxf(logf(lb + (1.f - lb) * sg), LOGF_MIN);
            ck_cmp(got_h, r, 0.01f, 0.02f, cnt + 3);
        } else if (c < C_SG) ck_cmp(got_b, z[c], 0.02f, 0.02f, cnt + 4);
        else ck_cmp(got_b, z[c] / (1.f + expf(-z[c])), 0.02f, 0.02f, cnt + 5);
    }
}
__global__ void ck_mix(const bf16* XN, const float* w_in, const bf16* YA, const bf16* YH, const float* ssq, const float* wua, const float* wuh, const bf16* GT, const bf16* MG, int which, unsigned* cnt) {
#ifndef CK_SHIFT
#define CK_SHIFT 0
#endif
    const int m = ck_row((blockIdx.x + CK_SHIFT) % CK_NS); __shared__ float xr[D]; __shared__ float ya[512]; __shared__ float yh[512];
    for (int c = threadIdx.x; c < D; c += 256) xr[c] = bf2f(XN[(size_t)m * D + c]);
    for (int c = threadIdx.x; c < 512; c += 256) { ya[c] = bf2f(YA[(size_t)m * 512 + c]); yh[c] = bf2f(YH[(size_t)m * 512 + c]); }
    __syncthreads();
    const float rstd = 1.0f / sqrtf((ssq[m * 4] + ssq[m * 4 + 1] + ssq[m * 4 + 2] + ssq[m * 4 + 3]) / 512.f + NORM_EPS);
    for (int c = threadIdx.x; c < D; c += 256) { float a = 0.f, b = 0.f, p = 0.f, q = 0.f;
        for (int k = 0; k < D; ++k) { a += xr[k] * w_in[(size_t)k * INW + NPA + c]; b += xr[k] * w_in[(size_t)k * INW + NPA + 1024 + c]; }
        for (int k = 0; k < 512; ++k) { p += ya[k] * wua[(size_t)k * D + c]; q += yh[k] * wuh[(size_t)k * D + c]; }
        float ga = 1.f / (1.f + expf(-a)), gb = 1.f / (1.f + expf(-b));
        if (which != 0) { ga = bf2f(GT[(size_t)m * NGATE + c]); gb = bf2f(GT[(size_t)m * NGATE + 1024 + c]); }
        if (which == 0) { unsigned* dbg = cnt + 100; if (blockIdx.x == 27) { const float e0 = fabsf(bf2f(GT[(size_t)m * NGATE + c]) - ga), e1 = fabsf(bf2f(GT[(size_t)m * NGATE + 1024 + c]) - gb); atomicMax(dbg + 200, __float_as_uint(e0)); atomicMax(dbg + 200, __float_as_uint(e1)); atomicMax(dbg + 201, __float_as_uint(fabsf(a))); atomicMax(dbg + 201, __float_as_uint(fabsf(b))); if (GT[(size_t)m * NGATE + c] == 0xFFFFu) atomicAdd(dbg + 203, 1u); if (GT[(size_t)m * NGATE + 1024 + c] == 0xFFFFu) atomicAdd(dbg + 203, 1u); if (e0 > 0.2f) { atomicAdd(dbg + 202, 1u); atomicOr(dbg + 210 + (c >> 11), 0u); atomicAdd(dbg + 300 + (c >> 6), 1u); } if (e1 > 0.2f) { atomicAdd(dbg + 202, 1u); atomicAdd(dbg + 300 + 16 + (c >> 6), 1u); } } if (ck_cmp(bf2f(GT[(size_t)m * NGATE + c]), ga, 0.01f, 0.01f, cnt + 0)) { atomicAdd(dbg + blockIdx.x, 1u); atomicAdd(dbg + 64 + (c >> 5), 1u); } if (ck_cmp(bf2f(GT[(size_t)m * NGATE + 1024 + c]), gb, 0.01f, 0.01f, cnt + 0)) { atomicAdd(dbg + blockIdx.x, 1u); atomicAdd(dbg + 64 + 32 + (c >> 5), 1u); } }
        else if (which == 1) ck_cmp(bf2f(MG[(size_t)m * D + c]), ga * p, 0.03f, 0.01f, cnt + 1);
        else ck_cmp(bf2f(MG[(size_t)m * D + c]), ga * p + gb * rstd * q, 0.03f, 0.02f, cnt + 2); }
}
__global__ void ck_out(const float* xprev, const bf16* MG, const float* wout, const float* X, unsigned* cnt) {
    const int m = ck_row(blockIdx.x); __shared__ float mg[D];
    for (int c = threadIdx.x; c < D; c += 256) mg[c] = bf2f(MG[(size_t)m * D + c]);
    __syncthreads();
    for (int c = threadIdx.x; c < D; c += 256) { float a = 0.f; for (int k = 0; k < D; ++k) a += mg[k] * wout[(size_t)k * D + c]; ck_cmp(X[(size_t)m * D + c], xprev[(size_t)m * D + c] + a, 0.01f, 0.02f, cnt); }
}
__global__ void ck_moe(const float* X, const float* g, const float* wrg, const float* brg, const float* wre, const float* bre, const float* weg, const float* weu, const float* wed,
                       const bf16* XN, const int* tok_e, const float* tok_w, const int* tok_p, const int* meta, const bf16* XP, const bf16* ACT, const bf16* Y, int stage, unsigned* cnt) {
    const int m = ck_row(blockIdx.x); __shared__ float h[D]; __shared__ float red[256]; __shared__ float lg[36]; __shared__ float act[DEXP];
    float s = 0.f; for (int c = threadIdx.x; c < D; c += 256) { const float v = X[(size_t)m * D + c]; s += v * v; }
    red[threadIdx.x] = s; __syncthreads(); for (int o = 128; o > 0; o >>= 1) { if (threadIdx.x < o) red[threadIdx.x] += red[threadIdx.x + o]; __syncthreads(); }
    const float rstd = 1.0f / sqrtf(red[0] / D + NORM_EPS);
    for (int c = threadIdx.x; c < D; c += 256) h[c] = X[(size_t)m * D + c] * rstd * g[c];
    __syncthreads();
    if (threadIdx.x < 36) { const int t = threadIdx.x; float a = 0.f;
        if (t < 4) { for (int k = 0; k < D; ++k) a += h[k] * wrg[k * 4 + t]; a += brg[t]; } else { const int gg = (t - 4) >> 3, e = (t - 4) & 7; for (int k = 0; k < D; ++k) a += h[k] * wre[((size_t)gg * D + k) * 8 + e]; a += bre[gg * 8 + e]; }
        lg[t] = a; }
    __syncthreads();
    int gt = 0; for (int k = 1; k < 4; ++k) if (lg[k] > lg[gt]) gt = k;
    float gden = 0.f; for (int k = 0; k < 4; ++k) gden += expf(lg[k] - lg[gt]);
    const float* el = lg + 4 + gt * 8; int i1 = 0; for (int k = 1; k < 8; ++k) if (el[k] > el[i1]) i1 = k; int i2 = (i1 == 0) ? 1 : 0; for (int k = 0; k < 8; ++k) if (k != i1 && el[k] > el[i2]) i2 = k;
    const float q2 = expf(el[i2] - el[i1]); const float w1 = (1.f / gden) / (1.f + q2), w2 = (1.f / gden) * q2 / (1.f + q2);
    const int e1 = gt * 8 + i1, e2 = gt * 8 + i2;
    if (stage == 0) { if (threadIdx.x == 0) { if (tok_e[2 * m] != e1 || tok_e[2 * m + 1] != e2) atomicAdd(cnt + 0, 1u); ck_cmp(tok_w[2 * m], w1, 0.01f, 1e-3f, cnt + 1); ck_cmp(tok_w[2 * m + 1], w2, 0.01f, 1e-3f, cnt + 1); } return; }
    for (int kk = 0; kk < 2; ++kk) { const int e = tok_e[2 * m + kk], p = tok_p[2 * m + kk];
        if (stage == 1) { if (threadIdx.x == 0) { const int rt = p >> 8; if (rt >= meta[0] || meta[1 + rt] != e) atomicAdd(cnt + 2, 1u); }
            for (int c = threadIdx.x; c < D; c += 256) if (XP[(size_t)p * D + c] != XN[(size_t)m * D + c]) atomicAdd(cnt + 3, 1u); continue; }
        const float* wg = weg + (size_t)e * D * DEXP; const float* wu = weu + (size_t)e * D * DEXP; const float* wd = wed + (size_t)e * DEXP * D;
        __syncthreads();
        for (int j = threadIdx.x; j < DEXP; j += 256) { float a = 0.f, b = 0.f; for (int k = 0; k < D; ++k) { const float hv = bf2f(XN[(size_t)m * D + k]); a += hv * wg[(size_t)k * DEXP + j]; b += hv * wu[(size_t)k * DEXP + j]; }
            const float r = a / (1.f + expf(-a)) * b; act[j] = r; if (stage == 2) ck_cmp(bf2f(ACT[(size_t)p * DEXP + j]), r, 0.03f, 0.02f, cnt + 4); }
        __syncthreads();
        if (stage == 3) for (int c = threadIdx.x; c < D; c += 256) { float a = 0.f; for (int j = 0; j < DEXP; ++j) a += act[j] * wd[(size_t)j * D + c]; ck_cmp(bf2f(Y[(size_t)p * D + c]), a, 0.03f, 0.03f, cnt + 5); }
    }
}

__global__ void ck_attn(const bf16* PA, const float* sink, const bf16* YA, unsigned* cnt) {
    const int m = ck_row(blockIdx.x), b = m / SEQ, t = m % SEQ; __shared__ float sc[512]; __shared__ float red[256];
    for (int qh = 0; qh < NQH; ++qh) { const int kvh = qh / 4;
        const bf16* qp = PA + (size_t)m * NPA + C_QA + 64 * qh;
        for (int jj = threadIdx.x; jj < 2 * WINDOW + 1; jj += 256) { const int j = t - WINDOW + jj; float a = -1e30f;
            if (j >= 0 && j < SEQ) { a = 0.f; const bf16* kp = PA + (size_t)(b * SEQ + j) * NPA + C_KA + 64 * kvh; for (int d = 0; d < 64; ++d) a += bf2f(qp[d]) * bf2f(kp[d]); a *= 0.6931471805599453f; }
            sc[jj] = a; }
        __syncthreads();
        float mx = sink[qh]; for (int jj = 0; jj < 2 * WINDOW + 1; ++jj) mx = fmaxf(mx, sc[jj]);
        float den = expf(sink[qh] - mx); for (int jj = 0; jj < 2 * WINDOW + 1; ++jj) den += expf(sc[jj] - mx);
        if (threadIdx.x < 64) { const int d = threadIdx.x; float o = 0.f; for (int jj = 0; jj < 2 * WINDOW + 1; ++jj) { const int j = t - WINDOW + jj; if (j >= 0 && j < SEQ) o += expf(sc[jj] - mx) * bf2f(PA[(size_t)(b * SEQ + j) * NPA + C_VA + 64 * kvh + d]); }
            ck_cmp(bf2f(YA[(size_t)m * 512 + 64 * qh + d]), o / den, 0.03f, 0.005f, cnt); }
        __syncthreads(); }
}
__global__ void ck_hgrn(const bf16* PA, const float* hng, const bf16* YH, const float* ssq, unsigned* cnt) {
    const int m = ck_row(blockIdx.x), b = m / SEQ, t = m % SEQ, h = blockIdx.y; __shared__ float wgt[128]; __shared__ float osum[128]; __shared__ float cum[128];
    const int e = threadIdx.x;
    float o = 0.f;
    for (int dir = 0; dir < 2; ++dir) { cum[e] = 0.f; __syncthreads();
        for (int n = 0; n < 768; ++n) { const int s = dir ? t + n : t - n; if (s < 0 || s >= SEQ) break;
            const bf16* row = PA + (size_t)(b * SEQ + s) * NPA; const bf16* rowt = PA + (size_t)m * NPA;
            { const int d = e; const float lf = (float)((const _Float16*)(row + (dir ? C_LB : C_LF) + 128 * h))[d];
              wgt[d] = bf2f(rowt[C_QH + 128 * h + d]) * (-expm1f(lf)) * expf(cum[d]);
#if defined(HC_DBG) && HC_DBG >= 3
              wgt[d] = bf2f(rowt[C_QH + 128 * h + d]) * (-expm1f(lf));
              if (HC_DBG == 4) wgt[d] = (d == 0) ? bf2f(rowt[C_QH + 128 * h]) : 0.f;
              if (HC_DBG == 5 || HC_DBG == 7) wgt[d] = (d == 0) ? wgt[d] : 0.f;
              if (HC_DBG == 10) wgt[d] = (d == 0) ? (float)(s & 15) : 0.f;
              if (HC_DBG == 11) wgt[d] = (d == 0) ? (float)(t & 15) : 0.f;
              if (HC_DBG == 8 || HC_DBG == 9) wgt[d] = (d == 0) ? bf2f(rowt[C_QH + 128 * h]) * (float)(s & 15) : 0.f;
              if (HC_DBG == 6) wgt[d] = (d == 0) ? bf2f(rowt[C_QH + 128 * h]) * lf : 0.f;
#endif
            }
            __syncthreads();
            float w = 0.f; for (int d = 0; d < 128; ++d) w += wgt[d];
#if defined(HC_TERMS)
            { const int cls = ((s >> 4) == (t >> 4)) ? 1 : (((s >> 7) == (t >> 7)) ? 2 : 4); if (!(HC_TERMS & cls)) w = 0.f; }
#endif
            o += w * bf2f(row[C_VH + 128 * h + e]);
            __syncthreads();
            { const int d = e; cum[d] += (float)((const _Float16*)(row + (dir ? C_LB : C_LF) + 128 * h))[d]; }
            __syncthreads(); } }
#if defined(HC_DBG) && HC_DBG == 1
    o = bf2f(PA[(size_t)m * NPA + C_VH + 128 * h + e]);
#endif
    osum[e] = o * o; __syncthreads(); for (int k = 64; k > 0; k >>= 1) { if (e < k) osum[e] += osum[e + k]; __syncthreads(); }
    if (e == 0) ck_cmp(ssq[m * 4 + h], osum[0], 0.03f, 1e-3f, cnt + 1);
    const float sg = bf2f(PA[(size_t)m * NPA + C_SG + 128 * h + e]);
    ck_cmp(bf2f(YH[(size_t)m * 512 + 128 * h + e]), o * hng[128 * h + e] * sg, 0.03f, 0.01f, cnt + 0);
}
__global__ void ck_comb(const float* xold, const float* xnew, const int* tok_p, const float* tok_w, const bf16* Y, const float* gfin, int last, unsigned* cnt) {
    const int m = ck_row(blockIdx.x); __shared__ float red[256]; __shared__ float xv[D];
    if (m >= SEQ) return;
    const int p1 = tok_p[2 * m], p2 = tok_p[2 * m + 1]; const float w1 = tok_w[2 * m], w2 = tok_w[2 * m + 1]; float s = 0.f;
    for (int c = threadIdx.x; c < D; c += 256) { const float v = xold[(size_t)m * D + c] + w1 * bf2f(Y[(size_t)p1 * D + c]) + w2 * bf2f(Y[(size_t)p2 * D + c]); xv[c] = v; s += v * v; }
    red[threadIdx.x] = s; __syncthreads(); for (int o = 128; o > 0; o >>= 1) { if (threadIdx.x < o) red[threadIdx.x] += red[threadIdx.x + o]; __syncthreads(); }
    const float rstd = 1.0f / sqrtf(red[0] / D + NORM_EPS);
    for (int c = threadIdx.x; c < D; c += 256) ck_cmp(xnew[(size_t)m * D + c], last ? xv[c] * rstd * gfin[c] : xv[c], 0.005f, 0.005f, cnt);
}

__global__ void ck_gates_full(const bf16* XN, const float* w_in, const bf16* GT, unsigned* st) {
    const int m = blockIdx.x >> 3, pn = blockIdx.x & 7, c = pn * 256 + threadIdx.x; __shared__ float xr[D];
    for (int k = threadIdx.x; k < D; k += 256) xr[k] = bf2f(XN[(size_t)m * D + k]);
    __syncthreads();
    float a = 0.f; for (int k = 0; k < D; ++k) a += xr[k] * w_in[(size_t)k * INW + NPA + c];
#if defined(CK_PLAIN)
    const float ref = a, got = bf2f(GT[(size_t)m * NGATE + c]);
#else
    const float ref = 1.f / (1.f + expf(-a)), got = bf2f(GT[(size_t)m * NGATE + c]);
#endif
    if (m == 8122 && !(fabsf(got - ref) <= 0.05f)) atomicMin(st + 700, (unsigned)c);
    if (m == 8123 && !(fabsf(got - ref) <= 0.05f)) atomicMin(st + 701, (unsigned)c);
    if (m == 8122) { if (c == 130) st[702] = __float_as_uint(got), st[703] = __float_as_uint(ref), st[704] = __float_as_uint(a); if (c == 131) st[705] = __float_as_uint(got), st[706] = __float_as_uint(ref); }
    if (!(fabsf(got - ref) <= 0.05f)) { atomicAdd(st + (m >> 8), 1u); atomicAdd(st + 128 + (m & 255), 1u); atomicAdd(st + 384 + threadIdx.x, 1u); atomicAdd(st + 640 + pn, 1u); }
}
__global__ void ck_flush() { asm volatile("buffer_wbl2 sc0 sc1\n\ts_waitcnt vmcnt(0)\n\tbuffer_inv sc0 sc1\n\ts_waitcnt vmcnt(0)" ::: "memory"); }

__global__ void ck_ha(const bf16* PA, const bf16* US, const float* HD, unsigned* cnt) {
    const int sidx = blockIdx.x, bh = sidx % 8, dir = (sidx >> 3) & 1, n = (sidx * 37 + 5) % NCH, b = bh >> 2, h = bh & 3, d = threadIdx.x, t0 = n * CH;
    __shared__ float kts[CH][128]; float cum = 0.f;
    for (int k = CH - 1; k >= 0; --k) { const int tok = dir ? (t0 + CH - 1 - k) : (t0 + k);
        const float lf = (float)((const _Float16*)(PA + (size_t)(b * SEQ + tok) * NPA + (dir ? C_LB : C_LF) + 128 * h))[d];
        kts[k][d] = -expm1f(lf) * expf(cum); cum += lf; }
    ck_cmp(HD[((size_t)(bh * 2 + dir) * NCH + n) * 128 + d], expf(cum), 0.01f, 1e-6f, cnt + 1);
    for (int e = 0; e < 128; e += 5) { float u = 0.f;
        for (int k = 0; k < CH; ++k) { const int tok = dir ? (t0 + CH - 1 - k) : (t0 + k); u += kts[k][d] * bf2f(PA[(size_t)(b * SEQ + tok) * NPA + C_VH + 128 * h + e]); }
        ck_cmp(bf2f(US[(((size_t)(bh * 2 + dir) * NCH + n) * 128 + e) * 128 + d]), u, 0.03f, 0.01f, cnt + 0); }
}
__global__ void ck_hb(const bf16* PA, const bf16* US, unsigned* cnt) {
    const int sidx = blockIdx.x, bh = sidx % 8, dir = (sidx >> 3) & 1, n = (sidx * 37 + 5) % NCH, b = bh >> 2, h = bh & 3, d = threadIdx.x, e = (sidx * 11 + 3) % 128;
    float cum = 0.f, sacc = 0.f;
    for (int k = 0; k < 1024; ++k) { const int tok = dir ? ((n + 1) * CH + k) : (n * CH - 1 - k); if (tok < 0 || tok >= SEQ) break;
        const bf16* row = PA + (size_t)(b * SEQ + tok) * NPA; const float lf = (float)((const _Float16*)(row + (dir ? C_LB : C_LF) + 128 * h))[d];
        sacc += -expm1f(lf) * expf(cum) * bf2f(row[C_VH + 128 * h + e]); cum += lf; }
    ck_cmp(bf2f(US[(((size_t)(bh * 2 + dir) * NCH + n) * 128 + e) * 128 + d]), sacc, 0.03f, 0.01f, cnt);
}

__global__ void ck_mfma(unsigned* cnt) {
#if defined(__HIP_DEVICE_COMPILE__)
    const int lane = threadIdx.x, fr = lane & 15, g = lane >> 4;
    float av[8], bv[8];
    for (int j = 0; j < 8; ++j) { const int k = 8 * g + j; av[j] = (k == 0) ? (float)fr : ((k == 9) ? (float)(fr * fr) : 0.f); bv[j] = (k == 0) ? (float)(fr + 1) : ((k == 9) ? 0.5f : 0.f); }
    f32x4 d = (f32x4){0.f, 0.f, 0.f, 0.f};
    d = mfma16(pack_frag(av), pack_frag(bv), d);
    for (int r = 0; r < 4; ++r) { const int s = 4 * g + r, c = fr; const float ref = (float)s * (float)(c + 1) + (float)(s * s) * 0.5f; if (fabsf(d[r] - ref) > 0.01f * fabsf(ref) + 0.01f) atomicAdd(cnt, 1u); }
#endif
}
#ifndef CK_SKIP
#define CK_SKIP 0ull
#endif
__global__ void ck_report(const unsigned* cnt, int n, float* out) { if (threadIdx.x == 0 && blockIdx.x == 0) {
#if defined(CK_DBG7)
    const unsigned* dbg = cnt + 7 + 100; int nrows = 0, ngrp = 0; unsigned mx = 0, first = 99; for (int i = 0; i < CK_NS; ++i) if (dbg[i]) { ++nrows; mx = dbg[i] > mx ? dbg[i] : mx; } for (int i = 0; i < 64; ++i) if (dbg[64 + i]) { ++ngrp; if (first == 99) first = i; }
    if (CK_DBG7 == 4) { const float me = __uint_as_float(dbg[200]), ma = __uint_as_float(dbg[201]); out[0] = (1.0f + fminf(me, 0.89f) * 10.0f) * powf(10.0f, 5.0f + floorf(fminf(ma, 30.0f))); return; }
    if (CK_DBG7 == 5) { int nl = 0; unsigned mxl = 0; for (int i = 0; i < 32; ++i) if (dbg[300 + i]) { ++nl; mxl = dbg[300 + i] > mxl ? dbg[300 + i] : mxl; } out[0] = (1.0f + 0.1f * (float)nl) * powf(10.0f, 5.0f + (float)(mxl > 30 ? 30 : mxl)); return; }
    if (CK_DBG7 == 7) { out[0] = (1.0f + 0.01f * (float)(dbg[203] % 100)) * powf(10.0f, 5.0f + (float)(dbg[203] / 100)); return; }
    if (CK_DBG7 >= 10) { const unsigned* st = cnt + 512; int npan = 0, nrit = 0, ncol = 0, ntile = 0; unsigned tot = 0, mxp = 0; int firstp = -1, firstr = -1, firstc = -1;
        for (int i = 0; i < 128; ++i) if (st[i]) { ++npan; tot += st[i]; if (st[i] > mxp) mxp = st[i]; if (firstp < 0) firstp = i; }
        for (int i = 0; i < 256; ++i) { if (st[128 + i]) { ++nrit; if (firstr < 0) firstr = i; } if (st[384 + i]) { ++ncol; if (firstc < 0) firstc = i; } }
        for (int i = 0; i < 8; ++i) if (st[640 + i]) ++ntile;
        float a = 0.f, b = 0.f;
        if (CK_DBG7 == 10) { a = (float)npan; b = log10f((float)(tot ? tot : 1)) * 4.0f; }
        if (CK_DBG7 == 11) { a = (float)nrit; b = (float)ncol / 10.0f; }
        if (CK_DBG7 == 12) { a = (float)firstp; b = (float)firstr / 10.0f; }
        if (CK_DBG7 == 13) { a = (float)firstc; b = (float)ntile; }
        if (CK_DBG7 == 22) { out[0] = (1.0f + 8.0f * __uint_as_float(st[702])) * powf(10.0f, 5.0f + floorf(20.0f * __uint_as_float(st[703]) + 0.5f)); return; }
        if (CK_DBG7 == 23) { out[0] = (1.0f + 8.0f * __uint_as_float(st[705])) * powf(10.0f, 5.0f + floorf(20.0f * __uint_as_float(st[706]) + 0.5f)); return; }
        if (CK_DBG7 == 20) { a = (float)(st[700] % 100); b = (float)(st[700] / 100); }
        if (CK_DBG7 == 21) { a = (float)(st[701] > 5000 ? 99 : st[701] % 100); b = (float)(st[701] > 5000 ? 30 : st[701] / 100); }
        out[0] = (1.0f + 0.01f * a) * powf(10.0f, 5.0f + floorf(b)); return; }
    if (CK_DBG7 == 6) { out[0] = (1.0f + 0.01f * (float)(dbg[202] % 100)) * powf(10.0f, 5.0f + (float)(dbg[202] / 100)); return; }
    if (CK_DBG7 == 3) { int s1 = -1, s2 = -1; for (int i = 0; i < CK_NS; ++i) if (dbg[i] > 20) { if (s1 < 0) s1 = i; else if (s2 < 0) s2 = i; } out[0] = (1.0f + 0.1f * (float)(s1 < 0 ? 0 : s1 % 50)) * powf(10.0f, (float)(5 + (s2 < 0 ? 0 : (s2 % 25)))); return; }
    if (CK_DBG7 == 1) out[0] = (1.0f + 0.1f * (float)first) * powf(10.0f, (float)(5 + nrows / 2));
    else out[0] = (1.0f + 0.1f * (float)ngrp) * powf(10.0f, (float)(5 + (int)floorf(4.0f * log10f((float)(mx ? mx : 1)))));
    return;
#endif
    for (int i = 0; i < n; ++i) if (cnt[i] && !((CK_SKIP >> i) & 1ull)) {
    out[0] = (1.0f + 0.1f * (float)(i % 10)) * powf(10.0f, (float)(5 + i / 10)); return; } } }
#endif

#ifndef PG8_SP2
#define PG8_SP2 true
#endif
#ifndef PG8_ALIGN
#define PG8_ALIGN true
#endif
__global__ void __launch_bounds__(NWAVES * 64, 2) mega_fwd(Args args) {
    extern __shared__ __attribute__((aligned(16))) unsigned char lds[];
    Frame F;
    F.lds = (LAS unsigned char*)lds;
    F.MISC = (volatile LAS unsigned*)(F.lds + MISC_OFF);
    F.tid = threadIdx.x; F.lane = F.tid & 63; F.wave = __builtin_amdgcn_readfirstlane(F.tid >> 6);
    F.G = gridDim.x; { const int bx = blockIdx.x; F.vcu = (F.G % 8 == 0) ? (bx % 8) * (F.G / 8) + bx / 8 : bx; }
    F.ws = args.ws; F.ctl = (gu32*)(args.ws + WS_CTL); F.out = args.out;
    const Args& A = args;
    for (int u = F.tid; u < (LDS_BYTES - LDSCTL_OFF) / 4; u += NWAVES * 64) ((LAS unsigned*)(F.lds + LDSCTL_OFF))[u] = 0u;
    __syncthreads();
    XcdBarrier bar = xcd_barrier_post((unsigned*)(F.ctl + CW_BAR) + args.li * XCD_BAR_WORDS, F.MISC + 8);
    const int lo = args.ph_lo, hi = args.ph_hi;
#ifndef PHMASK
#define PHMASK 0xffff
#endif
#define IN(k) (((PHMASK >> ((k) & 15)) & 1) && lo <= (k) && (k) < hi)
#if defined(PROBE_MASK)
    unsigned long long pr_acc = 0ull, pr_t0 = 0ull;
#define PR_BEGIN(k) do { if ((PROBE_MASK >> ((k) & 15)) & 1) pr_t0 = wall_clock64(); } while (0)
#define PR_END(k) do { if ((PROBE_MASK >> ((k) & 15)) & 1) pr_acc += wall_clock64() - pr_t0; } while (0)
#else
#define PR_BEGIN(k)
#define PR_END(k)
#endif
#define SEAM(k) do { if ((k) + 1 < hi) xcd_barrier(bar); PR_END(k); } while (0)
#define WSP() GAS unsigned char* wsg_ = (GAS unsigned char*)args.ws; asm volatile("" : "+s"(wsg_)); unsigned char* ws = (unsigned char*)wsg_; F.ws = ws; { int t_ = threadIdx.x; asm volatile("" : "+v"(t_)); F.tid = t_; F.lane = t_ & 63; F.wave = __builtin_amdgcn_readfirstlane(t_ >> 6); int g_ = gridDim.x, b_ = blockIdx.x; asm volatile("" : "+s"(g_), "+s"(b_)); F.G = g_; F.vcu = (g_ % 8 == 0) ? (b_ % 8) * (g_ / 8) + b_ / 8 : b_; cid = b_; } \
    bf16* XN = (bf16*)(ws + WS_XN); bf16* PA = (bf16*)(ws + WS_PA); bf16* GT = (bf16*)(ws + WS_PA); bf16* MG = (bf16*)(ws + WS_US); \
    bf16* YA = (bf16*)(ws + WS_Y); bf16* YH = (bf16*)(ws + WS_YH); (void)XN; (void)PA; (void)GT; (void)MG; (void)YA; (void)YH;
    int cid = (int)blockIdx.x;

#if !defined(ORACLE) || defined(ORACLE_FAST)
#if XBF16
#define XB_CUR(l) ((l) == 0 ? (NORMFOLD ? (void*)XN : (void*)A.in[I_X]) : (void*)F.out)
#define XB_NEW(l) ((l) == DEPTH - 1 ? (bf16*)(ws + WS_Y) : (bf16*)F.out)
#define XIN0(l) ((const void*)XB_CUR(l))
#define EPIOUT_T(l) EpiOutB<(l) == 0 && !NORMFOLD>
#else
#define XB_CUR(l) ((void*)F.out)
#define XB_NEW(l) (F.out)
#define XIN0(l) ((l) == 0 ? A.in[I_X] : (const float*)F.out)
#define EPIOUT_T(l) EpiOut
#endif
#if NORMFOLD
#define G1_A(l) ((l) == 0 ? XN : (const bf16*)F.out)
#define M1_A(l) ((const bf16*)XB_NEW(l))
#else
#define G1_A(l) XN
#define M1_A(l) XN
#endif
#define XCOPY0 nullptr
#else
#define XCOPY0 F.out
#define XIN0(l) ((const float*)F.out)
#endif
    if (IN(0)) { WSP(); PR_BEGIN(0);
        make_tables(F, A); conv_weights(F, A, 0);
#if NORM4 && !NORMFOLD
        norm_rows4(F, A.in[I_X], A.in[I_ANG], XN);
#else
        norm_rows(F, A.in[I_X], XCOPY0, A.in[I_ANG], XN, NORMFOLD ? (float*)(ws + WS_RSA) : nullptr);
#endif
        SEAM(0);
    }
#if G1A_SPLIT
#define PHASE3(l) if (IN(pb + 3)) { WSP(); PR_BEGIN(pb + 3);   \
            const int gh = G1A_SPLIT ? F.G / 2 : 0; \
            if (cid < gh) { pg8::Gemm g{XN, (const bf16*)(ws + WS_WIN) + (size_t)G1A_N * D, T, NPA - G1A_N, D}; pg8::StaticOrder S; S.init(T, NPA - G1A_N, gh, cid); \
                EpiInA E{PA, (const float*)(ws + WS_COS), (const float*)(ws + WS_SIN), (const float*)(ws + WS_LBT) + l * 2048, G1A_N / 256, (const float*)(ws + WS_RSA)}; \
                pg8::gemm_phase<EpiInA, pg8::StaticOrder, PG8_ALIGN, PG8_SP2>(F.lds + RING_OFF, g, S, E); } \
            else phase_hb(F, cid - gh, F.G - gh); \
            SEAM(pb + 3); }
#else
#define PHASE3(l) if (IN(pb + 3)) { WSP(); PR_BEGIN(pb + 3); phase_hb(F, F.vcu, F.G); SEAM(pb + 3); }
#endif
#if !defined(ORACLE) || defined(ORACLE_FAST)
#define G1A_N (NPA - 256 * G1A_SPLIT)
#define FAST_PHASES(l)         if (IN(pb + 2)) { WSP(); PR_BEGIN(pb + 2); PR_BEGIN(14); phase_attn(F, A.in[I_SINK] + (l) * NQH); PR_END(14); PR_BEGIN(15); phase_ha(F); PR_END(15); SEAM(pb + 2); } \
        PHASE3(l) \
        if (IN(pb + 4)) { WSP(); PR_BEGIN(pb + 4); phase_hc(F, A.in[I_HNG] + (l) * 512); SEAM(pb + 4); }
#else
#define G1A_N NPA
#define FAST_PHASES(l)
#endif
#if MOE_HANDOFF
#define MOE_ORDER1 pg8::ProducerOrder
#define MOE_ORDER2 pg8::ConsumerOrder
#define MOE_CNT(l) S.cnt = (unsigned*)(F.ctl + CW_MOE + (l) * MOE_BANK + 64);
#define MOE_SEAM(k) PR_END(k)
#else
#define MOE_ORDER1 pg8::GroupedOrder
#define MOE_ORDER2 pg8::GroupedOrder
#define MOE_CNT(l)
#define MOE_SEAM(k) SEAM(k)
#endif
#if ROUTE4
#define ROUTE_FN phase_norm_route4
#else
#define ROUTE_FN phase_norm_route
#endif
#if defined(PROBE_BARRIERS)
#define PROBE_BARRIERS_EXTRA for (int k_ = 0; k_ < PROBE_BARRIERS; ++k_) xcd_barrier(bar);
#else
#define PROBE_BARRIERS_EXTRA
#endif
#if defined(PROBE_KLOOP)
#define PROBE_KLOOP_EXTRA { EpiNull E2{GT}; pg8::gemm_phase<EpiNull, pg8::StaticOrder, PG8_ALIGN, PG8_SP2>(F.lds + RING_OFF, g, S, E2); }
#else
#define PROBE_KLOOP_EXTRA
#endif
#define LAYER_BODY(l) { const int pb = 16 * (l); \
        if (IN(pb + 1)) { WSP(); PR_BEGIN(pb + 1); \
            const int cw = conv_wgs(F.G, (T / 256) * (G1A_N / 256), CONV_WGS), gg = F.G - cw;     \
            if (cid < gg) { pg8::Gemm g{G1_A(l), (const bf16*)(ws + WS_WIN), T, G1A_N, D}; pg8::StaticOrder S; S.init(T, G1A_N, gg, cid); \
                EpiInA E{PA, (const float*)(ws + WS_COS), (const float*)(ws + WS_SIN), (const float*)(ws + WS_LBT) + l * 2048, 0, (const float*)(ws + WS_RSA)}; \
                pg8::gemm_phase<EpiInA, pg8::StaticOrder, PG8_ALIGN, PG8_SP2>(F.lds + RING_OFF, g, S, E); } \
            if (EXPERTS_BY_QUEUE) { const int n1 = NEXP * 16 * 32, h0 = __builtin_amdgcn_readfirstlane((int)VLD(F.ctl + CW_H12)), h1 = min(n1, h0 + cw * (h0 ? CONV_PER_WG1 - 64 : CONV_PER_WG1));     \
                if (cid >= gg) conv_experts_range(F, A, l, h0, h1, (cid - gg) * NWAVES + F.wave, cw * NWAVES); \
                if (cw == 0) conv_experts_range(F, A, l, h1, n1, F.vcu * NWAVES + F.wave, F.G * NWAVES); \
                else if (cid < gg) conv_experts_range(F, A, l, h1, n1, cid * NWAVES + F.wave, gg * NWAVES); }   \
            SEAM(pb + 1); \
        } \
FAST_PHASES(l) \
        if (IN(pb + 5)) { WSP(); PR_BEGIN(pb + 5); \
            pg8::Gemm g{G1_A(l), (const bf16*)(ws + WS_WIN) + (size_t)NPA * D, T, NGATE, D}; pg8::StaticOrder S; S.init(T, NGATE, F.G, cid); \
            EpiGate E{GT, (const float*)(ws + WS_RSA)}; \
            pg8::gemm_phase<EpiGate, pg8::StaticOrder, PG8_ALIGN, PG8_SP2>(F.lds + RING_OFF, g, S, E); \
            PROBE_KLOOP_EXTRA \
            SEAM(pb + 5); \
        } \
        if (IN(pb + 6)) { WSP(); PR_BEGIN(pb + 6); \
            pg8::Gemm g{YA, (const bf16*)(ws + WS_WUA), T, D, 512}; pg8::StaticOrder S; S.init(T, D, F.G, cid); \
            EpiUpA E{MG, GT}; \
            pg8::gemm_phase<EpiUpA, pg8::StaticOrder, PG8_ALIGN, PG8_SP2>(F.lds + RING_OFF, g, S, E); \
            PR_END(pb + 6);   \
        } \
        if (IN(pb + 7)) { WSP(); PR_BEGIN(pb + 7); \
            pg8::Gemm g{YH, (const bf16*)(ws + WS_WUH), T, D, 512}; pg8::StaticOrder S; S.init(T, D, F.G, cid); \
            EpiUpB E{MG, GT, (const float*)(ws + WS_SSQ)}; \
            pg8::gemm_phase<EpiUpB, pg8::StaticOrder, PG8_ALIGN, PG8_SP2>(F.lds + RING_OFF, g, S, E); \
            SEAM(pb + 7); \
        } \
        if (IN(pb + 8)) { WSP(); PR_BEGIN(pb + 8); \
            pg8::Gemm g{MG, (const bf16*)(ws + WS_WOUT), T, D, D}; pg8::StaticOrder S; S.init(T, D, F.G, cid); \
            EPIOUT_T(l) E{XB_NEW(l), XIN0(l)}; \
            pg8::gemm_phase<EPIOUT_T(l), pg8::StaticOrder, PG8_ALIGN, PG8_SP2>(F.lds + RING_OFF, g, S, E); \
            SEAM(pb + 8); \
        } \
        if (IN(pb + 9)) { WSP(); PR_BEGIN(pb + 9); ROUTE_FN(F, A, l, XB_NEW(l)); SEAM(pb + 9); } \
        if (IN(pb + 10)) { WSP(); PR_BEGIN(pb + 10); phase_dispatch(F); PROBE_BARRIERS_EXTRA SEAM(pb + 10); } \
        if (IN(pb + 11)) { WSP(); PR_BEGIN(pb + 11); \
            const int cw = MOE_HANDOFF ? 0 : conv_wgs(F.G, 4 * __builtin_amdgcn_readfirstlane((int)VLD((const int*)(ws + WS_META))), CONV_WGS_MOE), gg = F.G - cw;     \
            if (cid < gg) { pg8::Gemm g{M1_A(l), (const bf16*)(ws + WS_W1), SLOT_ROWS, D, D}; MOE_ORDER1 S; S.init((const int*)(ws + WS_META), D, gg, cid); MOE_CNT(l) \
                EpiAct E{(bf16*)(ws + WS_ACT), (const float*)(ws + WS_RSS)}; \
                pg8::gemm_phase<EpiAct, MOE_ORDER1, PG8_ALIGN, PG8_SP2, true>(F.lds + RING_OFF, g, S, E, (const int*)(ws + WS_STOK)); } \
            if (EXPERTS_BY_QUEUE) { const int n1 = NEXP * 16 * 32, n2 = NEXP * 8 * 32, h2 = min(n2, cw * CONV_PER_WG2); \
                if (cid >= gg) conv_experts_range(F, A, l, n1, n1 + h2, (cid - gg) * NWAVES + F.wave, cw * NWAVES); \
                conv_experts_range(F, A, l, n1 + h2, n1 + n2, F.vcu * NWAVES + F.wave, F.G * NWAVES); } \
            MOE_SEAM(pb + 11); \
        } \
        if (IN(pb + 12)) { WSP(); PR_BEGIN(pb + 12); \
            const int cw = (MOE_HANDOFF || !EXPERTS_BY_QUEUE || (l) == DEPTH - 1) ? 0 : conv_wgs(F.G, 4 * __builtin_amdgcn_readfirstlane((int)VLD((const int*)(ws + WS_META))), CONV_WGS_MOE), gg = F.G - cw;     \
            if (cid < gg) { pg8::Gemm g{(const bf16*)(ws + WS_ACT), (const bf16*)(ws + WS_W2), SLOT_ROWS, D, DEXP}; MOE_ORDER2 S; S.init((const int*)(ws + WS_META), D, gg, cid, MOE_HANDOFF != 0); MOE_CNT(l) \
                EpiY E{(bf16*)(ws + WS_XP)}; \
                pg8::gemm_phase<EpiY, MOE_ORDER2, PG8_ALIGN, PG8_SP2, false, MOE_HANDOFF ? 16 : 0>(F.lds + RING_OFF, g, S, E); } \
            else conv_experts_range(F, A, (l) + 1, 0, cw * CONV_PER_WG12, (cid - gg) * NWAVES + F.wave, cw * NWAVES); \
            if (cw > 0 && cid == 0 && F.tid == 0) __hip_atomic_store(F.ctl + CW_H12, (unsigned)(cw * CONV_PER_WG12), __ATOMIC_RELAXED, __HIP_MEMORY_SCOPE_AGENT);     \
            SEAM(pb + 12); \
        } \
        if (IN(pb + 13)) { WSP(); PR_BEGIN(pb + 13); \
            const bool last = (l == DEPTH - 1); \
            if (!last) conv_weights(F, A, l + 1); \
            phase_combine(F, last ? A.in[I_FING] : A.in[I_ANG] + (size_t)(l + 1) * D, last, XB_NEW(l), XB_CUR((l) + 1)); \
            if (!last) { if ((pb + 15) + 1 < hi) xcd_barrier(bar); } PR_END(pb + 13); \
        } \
    }
    LAYER_BODY(0)
    LAYER_BODY(1)
    static_assert(DEPTH == 2, "layer bodies are written out");
#if defined(PROBE_MASK)
    if (blockIdx.x == 0 && threadIdx.x == 0) { const unsigned long long t1 = wall_clock64(), want = (unsigned long long)PROBE_MULT * pr_acc; while (wall_clock64() - t1 < want) __builtin_amdgcn_s_sleep(8); }
#endif
#undef IN
#undef SEAM
}

extern "C" void kernel_launch(void* const* d_in, const int* in_sizes, int n_in, void* d_out, int out_size, void* d_ws, size_t ws_size, hipStream_t stream) {
    static int grid = 0;
    if (grid == 0) {
        if (n_in != 18 || in_sizes[0] != T * D || out_size != T * D || ws_size < WS_END) { fprintf(stderr, "kernel_launch: unexpected shapes (n_in %d, in0 %d, out %d, ws %zu); nothing launched\n", n_in, n_in > 0 ? in_sizes[0] : -1, out_size, ws_size); grid = -1; return; }
        int dev = 0, cus = 0, per_cu = 0;
        if (hipGetDevice(&dev) != hipSuccess || hipDeviceGetAttribute(&cus, hipDeviceAttributeMultiprocessorCount, dev) != hipSuccess) { grid = -1; return; }
        if (hipFuncSetAttribute((const void*)mega_fwd, hipFuncAttributeMaxDynamicSharedMemorySize, LDS_BYTES) != hipSuccess) { fprintf(stderr, "kernel_launch: hipFuncSetAttribute failed\n"); grid = -1; return; }
        if (hipOccupancyMaxActiveBlocksPerMultiprocessor(&per_cu, (const void*)mega_fwd, NWAVES * 64, LDS_BYTES) != hipSuccess || per_cu < 1)
            fprintf(stderr, "kernel_launch: note: occupancy query reports %d workgroups per CU\n", per_cu);
        (void)hipGetLastError();
        grid = cus;
    }
    if (grid < 0) return;
    if (hipMemsetAsync((char*)d_ws + WS_CTL, 0, CTL_ZERO_BYTES, stream) != hipSuccess) return;
    Args a{};
    for (int i = 0; i < 18; ++i) a.in[i] = (const float*)d_in[i];
    a.out = (float*)d_out; a.ws = (unsigned char*)d_ws; a.pad = 0;
    int li = 0;
    auto launch = [&](int lo, int hi) { a.ph_lo = lo; a.ph_hi = hi; a.li = li++; hipLaunchKernelGGL(mega_fwd, dim3(grid), dim3(NWAVES * 64), LDS_BYTES, stream, a);
        const hipError_t le = hipPeekAtLastError(); if (le != hipSuccess) fprintf(stderr, "kernel_launch: launch [%d,%d) failed: %s\n", lo, hi, hipGetErrorName(le)); };
#if defined(ORACLE)
    unsigned char* ws = (unsigned char*)d_ws;
#if defined(CHECK)
    unsigned* cnt = (unsigned*)(ws + 525 * MiB + 512 * 1024); hipMemsetAsync(cnt, 0, 4096, stream);
    hipLaunchKernelGGL(ck_mfma, dim3(1), dim3(64), 0, stream, cnt + 39); hipMemsetAsync(cnt + 512 + 700, 0xFF, 8, stream);
    const float* const* in = (const float* const*)d_in; float* xs = (float*)d_out;
    const bf16* XNc = (const bf16*)(ws + WS_XN); const bf16* PAc = (const bf16*)(ws + WS_PA); const bf16* MGc = (const bf16*)(ws + WS_US);
    const bf16* YAc = (const bf16*)(ws + WS_Y); const bf16* YHc = (const bf16*)(ws + WS_YH); const float* ssqc = (const float*)(ws + WS_SSQ);
#define CKL(k, ...) hipLaunchKernelGGL(k, dim3(CK_NS), dim3(256), 0, stream, __VA_ARGS__)
#endif
    for (int l = 0; l < DEPTH; ++l) {
#if defined(CHECK)
        const float* w_in_l = in[I_WIN] + (size_t)l * D * INW; unsigned* c0 = cnt + 20 * l;
        if (l == 0) { launch(0, 1); CKL(ck_norm, in[I_X], in[I_ANG], XNc, c0 + 0); launch(1, 2); }
        else { CKL(ck_norm, (const float*)xs, in[I_ANG] + (size_t)l * D, XNc, c0 + 0); launch(16 * l + 1, 16 * l + 2); }
        CKL(ck_pa, XNc, w_in_l, in[I_LBT], l, PAc, c0 + 1);
#else
        if (l == 0) launch(0, 2); else launch(16 * l + 1, 16 * l + 2);
#endif
#if defined(ORACLE_FAST)
        launch(16 * l + 2, 16 * l + 3);
#if defined(CHECK)
        hipLaunchKernelGGL(ck_ha, dim3(CK_NS), dim3(128), 0, stream, (const bf16*)(ws + WS_PA), (const bf16*)(ws + WS_US), (const float*)(ws + WS_HD), cnt + 20 * l + 40 + 0);
#endif
        launch(16 * l + 3, 16 * l + 4);
#if defined(CHECK)
        hipLaunchKernelGGL(ck_hb, dim3(CK_NS), dim3(128), 0, stream, (const bf16*)(ws + WS_PA), (const bf16*)(ws + WS_US), cnt + 20 * l + 40 + 2);
#endif
        launch(16 * l + 4, 16 * l + 5);
#else
        hipLaunchKernelGGL(zero_f32, dim3(T * 4 / 256), dim3(256), 0, stream, (float*)(ws + WS_SSQ), T * 4);
        hipLaunchKernelGGL(simple_attn, dim3(T * 8 / 4), dim3(256), 0, stream, (const bf16*)(ws + WS_PA), (const float*)d_in[I_SINK] + l * NQH, (bf16*)(ws + WS_Y));
        hipLaunchKernelGGL(simple_hgrn, dim3(8), dim3(512), 0, stream, (const bf16*)(ws + WS_PA), (const float*)d_in[I_HNG] + l * 512, (float*)(ws + WS_US), (bf16*)(ws + WS_YH), (float*)(ws + WS_SSQ));
#endif
#if defined(CHECK)
        CKL(ck_attn, PAc, in[I_SINK] + l * NQH, YAc, c0 + 3 + 40); hipLaunchKernelGGL(ck_hgrn, dim3(CK_NS, 4), dim3(128), 0, stream, PAc, in[I_HNG] + l * 512, YHc, ssqc, c0 + 4 + 40);
        const float* wua = in[I_WUA] + (size_t)l * 512 * D; const float* wuh = in[I_WUH] + (size_t)l * 512 * D; const int pb = 16 * l;
#if defined(CK_SENTINEL)
        hipMemsetAsync(ws + WS_PA, 0xFF, (size_t)T * NGATE * 2, stream);
#endif
#if defined(CK_FLUSH)
        hipLaunchKernelGGL(ck_flush, dim3(4096), dim3(64), 0, stream);
#endif
        launch(pb + 5, pb + 6);
#if defined(CK_FLUSH)
        hipLaunchKernelGGL(ck_flush, dim3(4096), dim3(64), 0, stream);
#endif
        if (l == 0) hipLaunchKernelGGL(ck_gates_full, dim3(T * 8), dim3(256), 0, stream, XNc, w_in_l, PAc, cnt + 512); CKL(ck_mix, XNc, w_in_l, YAc, YHc, ssqc, wua, wuh, PAc, MGc, 0, c0 + 7);
        launch(pb + 6, pb + 7); CKL(ck_mix, XNc, w_in_l, YAc, YHc, ssqc, wua, wuh, PAc, MGc, 1, c0 + 7);
        launch(pb + 7, pb + 8); CKL(ck_mix, XNc, w_in_l, YAc, YHc, ssqc, wua, wuh, PAc, MGc, 2, c0 + 7);
        launch(pb + 8, pb + 9); if (l == 0) CKL(ck_out, in[I_X], MGc, in[I_WOUT], (const float*)xs, c0 + 10);
        const float* gff = in[I_FNG] + (size_t)l * D; const float* wrg = in[I_WRG] + (size_t)l * D * NGRP; const float* brg = in[I_BRG] + l * NGRP; const float* wre = in[I_WRE] + (size_t)l * NGRP * D * EPG; const float* bre = in[I_BRE] + l * NGRP * EPG;
        const float* weg = in[I_WEG] + (size_t)l * NEXP * D * DEXP; const float* weu = in[I_WEU] + (size_t)l * NEXP * D * DEXP; const float* wed = in[I_WED] + (size_t)l * NEXP * DEXP * D;
        const int* toke = (const int*)(ws + WS_TOKE); const float* tokw = (const float*)(ws + WS_TOKW); const int* tokp = (const int*)(ws + WS_TOKP); const int* metac = (const int*)(ws + WS_META);
        const bf16* XPc = (const bf16*)(ws + WS_XP); const bf16* ACTc = (const bf16*)(ws + WS_ACT);
#define CKM(st) CKL(ck_moe, (const float*)xs, gff, wrg, brg, wre, bre, weg, weu, wed, XNc, toke, tokw, tokp, metac, XPc, ACTc, XPc, st, c0 + 12)
        launch(pb + 9, pb + 10); CKL(ck_norm, (const float*)xs, gff, XNc, c0 + 11); CKM(0);
        launch(pb + 10, pb + 11); CKM(1);
        launch(pb + 11, pb + 12); CKM(2);
        launch(pb + 12, pb + 13); CKM(3);
        hipMemcpyAsync(ws + WS_US, xs, (size_t)T * D * 4 / 2, hipMemcpyDeviceToDevice, stream);
        launch(pb + 13, pb + 14);
        CKL(ck_comb, (const float*)(ws + WS_US), (const float*)xs, tokp, tokw, XPc, in[I_FING], (int)(l == DEPTH - 1), c0 + 6 + 40);
#else
#if defined(STOP_AFTER)
        launch(16 * l + 5, STOP_AFTER + 1); break;
#else
        launch(16 * l + 5, 16 * l + 14);
#endif
#endif
    }
#if defined(CHECK)
    hipLaunchKernelGGL(ck_report, dim3(1), dim3(64), 0, stream, (const unsigned*)cnt, 80, xs);
#endif
#else
    launch(0, 16 * (DEPTH - 1) + 14);
#endif
}
```

```cpp
#include <hip/hip_runtime.h>
#include <cstdio>
#include <cstdint>
namespace pg8 {
#define PG8_LAS __attribute__((address_space(3)))
typedef unsigned short bf16_t;
typedef short bf16x8 __attribute__((ext_vector_type(8)));
typedef float f32x4 __attribute__((ext_vector_type(4)));
typedef unsigned u32x4 __attribute__((ext_vector_type(4)));
typedef unsigned u32x2 __attribute__((ext_vector_type(2)));
constexpr int BM = 256, BK = 64, HALF = 128, HTB = HALF * BK * 2  , STAGE_BYTES = 8 * HTB, NXCD = 8, WGM = 8;

__host__ __device__ __forceinline__ int lds_byte(int r, int c) { const int st = (r >> 4) * 2 + (c >> 5), rr = r & 15, cc = c & 31, ob = rr * 64 + cc * 2; return st * 1024 + (ob ^ (((ob >> 9) & 1) << 5)); }
__host__ __device__ __forceinline__ void stage_rc(int b, int& R, int& C) { const int st = b / 1024, sb = b % 1024, swz = sb ^ (((sb >> 9) & 1) << 5); R = (st >> 1) * 16 + swz / 64; C = (st & 1) * 32 + (swz % 64) / 2; }
__host__ __device__ __forceinline__ int perm32(int rho) { const int n = rho >> 4, i = rho & 15; return 8 * (i >> 2) + 4 * n + (i & 3); }

struct Unit { int pm, pn, pb; };
struct Gemm { const bf16_t* A; const bf16_t* Bt; int M, N, K; };

struct StaticOrder {
    int nM, nN, nwg, G, c;
    __host__ __device__ void init(int M, int N, int G_, int c_) { nM = M / BM; nN = N / BM; nwg = nM * nN; G = G_; c = c_; }
    __host__ __device__ bool next(int i, Unit& u) const {
        const long L = (long)i * G + c; if (L >= nwg) return false;
        int wgid = (int)L; { const int q = nwg / NXCD, r = nwg % NXCD, xcd = wgid % NXCD, off = wgid / NXCD; wgid = (xcd < r ? xcd * (q + 1) : r * (q + 1) + (xcd - r) * q) + off; }
        const int nig = WGM * nN, gid = wgid / nig, fm = gid * WGM, gsz = (nM - fm) < WGM ? (nM - fm) : WGM;
        u.pm = fm + ((wgid % nig) % gsz); u.pn = (wgid % nig) / gsz; u.pb = u.pn; return true;
    }
    __device__ __forceinline__ void a_ready(const Unit&) const {}
    __device__ __forceinline__ void done(const Unit&) const {}
};
struct GroupedOrder {
    const int* meta; int nM, nN, nwg, G, base;
    __device__ __forceinline__ void init(const int* meta_, int N, int G_, int c_, bool second = false) { meta = meta_; nM = __builtin_amdgcn_readfirstlane(__hip_atomic_load(meta_, __ATOMIC_RELAXED, __HIP_MEMORY_SCOPE_AGENT)); nN = N / BM; nwg = nM * nN; G = G_;
        base = second ? (((c_ < nwg) ? (nwg - c_ + G_ - 1) / G_ : 0) * G_ + c_ - nwg) : c_; }
    __device__ __forceinline__ bool next(int i, Unit& u) const {
        int wgid = i * G + base; if (wgid >= nwg) return false;
        { const int q = nwg / NXCD, r = nwg % NXCD, xcd = wgid % NXCD, off = wgid / NXCD; wgid = (xcd < r ? xcd * (q + 1) : r * (q + 1) + (xcd - r) * q) + off; }
        const int nig = WGM * nN, gid = wgid / nig, fm = gid * WGM, gsz = (nM - fm) < WGM ? (nM - fm) : WGM;
        u.pm = fm + ((wgid % nig) % gsz); u.pn = (wgid % nig) / gsz;
        u.pb = __builtin_amdgcn_readfirstlane(__hip_atomic_load(meta + 1 + u.pm, __ATOMIC_RELAXED, __HIP_MEMORY_SCOPE_AGENT)) * nN + u.pn; return true;
    }
    __device__ __forceinline__ void a_ready(const Unit&) const {}
    __device__ __forceinline__ void done(const Unit&) const {}
};
struct ProducerOrder : GroupedOrder {
    unsigned* cnt;
    __device__ __forceinline__ void done(const Unit& u) const {
        asm volatile("s_waitcnt vmcnt(0)" ::: "memory");
        if ((threadIdx.x & 63) == 0) __hip_atomic_fetch_add(cnt + 64 * u.pm, 1u, __ATOMIC_RELAXED, __HIP_MEMORY_SCOPE_AGENT);
    }
};
struct ConsumerOrder : GroupedOrder {
    unsigned* cnt; static constexpr unsigned NEED = 32u;
    __device__ __forceinline__ void a_ready(const Unit& u) const {
        if (threadIdx.x < 64) {
            unsigned* tmo = cnt - 64;
            const unsigned long long t0 = __builtin_amdgcn_s_memrealtime(); unsigned polls = 0;
            while ((unsigned)__builtin_amdgcn_readfirstlane(__hip_atomic_load(cnt + 64 * u.pm, __ATOMIC_RELAXED, __HIP_MEMORY_SCOPE_AGENT)) < NEED) {
                if ((++polls & 255u) == 0u && __builtin_amdgcn_readfirstlane(__hip_atomic_load(tmo, __ATOMIC_RELAXED, __HIP_MEMORY_SCOPE_AGENT)) != 0u) break;
                if (__builtin_amdgcn_s_memrealtime() - t0 > 2000000ull) {
                    if (threadIdx.x == 0) { unsigned expect = 0u; __hip_atomic_compare_exchange_strong(tmo + 1, &expect, 0x600u | (unsigned)(u.pm & 0xff), __ATOMIC_RELAXED, __ATOMIC_RELAXED, __HIP_MEMORY_SCOPE_AGENT); __hip_atomic_store(tmo, 1u, __ATOMIC_RELAXED, __HIP_MEMORY_SCOPE_AGENT); }
                    break; }
                __builtin_amdgcn_s_sleep(2); }
            asm volatile("s_waitcnt vmcnt(0)" ::: "memory");
        }
        asm volatile("" ::: "memory"); __builtin_amdgcn_s_barrier(); asm volatile("" ::: "memory");
    }
};
typedef float f32x2_t __attribute__((ext_vector_type(2))); typedef __bf16 bf16x2_t __attribute__((ext_vector_type(2)));
__device__ __forceinline__ unsigned cvt_pk_bf16(float lo, float hi) { f32x2_t v = {lo, hi}; bf16x2_t b = __builtin_convertvector(v, bf16x2_t); return __builtin_bit_cast(unsigned, b); }
template <class Epi, class Sched, bool ALIGN_EPI = false, bool SP2 = false, bool GATHER = false, int A_AUX = 0>
__device__ __forceinline__ void gemm_phase(PG8_LAS unsigned char* lds, const Gemm g, const Sched& S, const Epi& E, const int* rowtab = nullptr) {
    int tid_ = threadIdx.x; asm volatile("" : "+v"(tid_));
    const int tid = tid_, wid = __builtin_amdgcn_readfirstlane(tid >> 6), lane = tid & 63, wr = wid >> 2, wc = wid & 3, fr = lane & 15, fq = lane >> 4;
    const int K = g.K, nt = K / BK;
    unsigned voffA[2], voffB[2];
#pragma unroll
    for (int i = 0; i < 2; ++i) { int R, C; stage_rc(tid * 16 + i * 8192, R, C); const int Rb = Epi::PERM ? ((R & ~31) + perm32(R & 31)) : R;
        voffA[i] = (unsigned)(R * K + C) * 2u; voffB[i] = (unsigned)(Rb * K + C) * 2u; }
    const size_t kstep = (size_t)(BK * 2);
    const size_t hstep = (size_t)HALF * K * 2;
    const size_t tstep = 2 * hstep;
    const unsigned ldsw = (unsigned)wid * 1024u;
    const int aoff = lds_byte(wr * 64 + fr, fq * 8), boff = lds_byte(wc * 32 + fr, fq * 8);
#define PG8_SA(b, h) (((b) * 2 + (h)) * HTB)
#define PG8_SB(b, h) ((4 + (b) * 2 + (h)) * HTB)
#define PG8_STAGE(bufoff, gbase, voff) do { _Pragma("unroll") for (int _i = 0; _i < 2; ++_i) \
        __builtin_amdgcn_global_load_lds((const unsigned*)((const char*)(gbase) + (voff)[_i]), (PG8_LAS unsigned*)(lds + (bufoff) + ldsw + _i * 8192), 16, 0, 0); } while (0)
#define PG8_STAGE_A(bufoff, gbase, h, RO) do { _Pragma("unroll") for (int _i = 0; _i < 2; ++_i) \
        __builtin_amdgcn_global_load_lds((const unsigned*)((const char*)(gbase) + (GATHER ? (size_t)RO[h][_i] : (size_t)(((h) ? hstep : 0) + voffA[_i]))), (PG8_LAS unsigned*)(lds + (bufoff) + ldsw + _i * 8192), 16, 0, A_AUX); } while (0)
#define PG8_ROWOFS(RO, pm_) do { if constexpr (GATHER) { _Pragma("unroll") for (int _h = 0; _h < 2; ++_h) _Pragma("unroll") for (int _i = 0; _i < 2; ++_i) { int _R, _C; stage_rc(tid * 16 + _i * 8192, _R, _C); \
        const int _tok = __hip_atomic_load(rowtab + (pm_) * 256 + _h * 128 + _R, __ATOMIC_RELAXED, __HIP_MEMORY_SCOPE_AGENT); RO[_h][_i] = (unsigned)_tok * (unsigned)(K * 2) + (unsigned)(_C * 2); } } } while (0)
#define PG8_LDA(dst, b, h) do { _Pragma("unroll") for (int m = 0; m < 4; ++m) _Pragma("unroll") for (int k = 0; k < 2; ++k) dst[m][k] = *(const PG8_LAS bf16x8*)(lds + PG8_SA(b, h) + aoff + m * 2048 + k * 1024); } while (0)
#define PG8_LDB(dst, b, h) do { _Pragma("unroll") for (int n = 0; n < 2; ++n) _Pragma("unroll") for (int k = 0; k < 2; ++k) dst[n][k] = *(const PG8_LAS bf16x8*)(lds + PG8_SB(b, h) + boff + n * 2048 + k * 1024); } while (0)
#define PG8_MMA(ai, bj, At, Bt) do { __builtin_amdgcn_s_setprio(1); _Pragma("unroll") for (int m = 0; m < 4; ++m) _Pragma("unroll") for (int n = 0; n < 2; ++n) _Pragma("unroll") for (int k = 0; k < 2; ++k) \
        acc[ai][bj][m][n] = __builtin_amdgcn_mfma_f32_16x16x32_bf16(Bt[n][k], At[m][k], acc[ai][bj][m][n], 0, 0, 0); __builtin_amdgcn_s_setprio(0); } while (0)
#define PG8_WAIT_V(n) asm volatile("s_waitcnt vmcnt(" #n ")" ::: "memory")
#define PG8_WAIT_L(n) asm volatile("s_waitcnt lgkmcnt(" #n ")" ::: "memory")
#define PG8_BAR __builtin_amdgcn_s_barrier()
#define PG8_SCHED __builtin_amdgcn_sched_barrier(0)
    Unit cur, nxt; int ui = 0;
    if (!S.next(0, cur)) return;
    f32x4 acc[2][2][4][2];
#pragma unroll
    for (int a = 0; a < 2; ++a)
#pragma unroll
        for (int b = 0; b < 2; ++b)
#pragma unroll
            for (int m = 0; m < 4; ++m)
#pragma unroll
                for (int n = 0; n < 2; ++n) acc[a][b][m][n] = (f32x4){0.f, 0.f, 0.f, 0.f};
    bf16x8 At[4][2], B0[2][2], B1[2][2];
    const char* cA = (const char*)g.A + (GATHER ? (size_t)0 : (size_t)cur.pm * tstep); const char* cB = (const char*)g.Bt + (size_t)cur.pb * tstep;
    unsigned rofsC[2][2] = {{0u, 0u}, {0u, 0u}}, rofsN[2][2] = {{0u, 0u}, {0u, 0u}};
    PG8_ROWOFS(rofsC, cur.pm);
    S.a_ready(cur);
    if constexpr (SP2) {
        PG8_STAGE(PG8_SB(0, 0), cB, voffB); PG8_STAGE(PG8_SB(0, 1), cB + hstep, voffB); PG8_STAGE_A(PG8_SA(0, 0), cA, 0, rofsC); PG8_STAGE_A(PG8_SA(0, 1), cA, 1, rofsC);
        if (wr == 1) PG8_BAR;
        PG8_WAIT_V(2); PG8_BAR;
        PG8_STAGE(PG8_SB(1, 0), cB + kstep, voffB); PG8_STAGE_A(PG8_SA(1, 0), cA + kstep, 0, rofsC); PG8_STAGE(PG8_SB(1, 1), cB + hstep + kstep, voffB);
        PG8_WAIT_V(6); PG8_BAR;
    } else {
        PG8_STAGE(PG8_SB(0, 0), cB, voffB); PG8_STAGE_A(PG8_SA(0, 0), cA, 0, rofsC); PG8_STAGE(PG8_SB(0, 1), cB + hstep, voffB); PG8_STAGE_A(PG8_SA(0, 1), cA, 1, rofsC);
        if (wr == 1) PG8_BAR;
        PG8_WAIT_V(4); PG8_BAR;
        PG8_STAGE(PG8_SB(1, 0), cB + kstep, voffB); PG8_STAGE_A(PG8_SA(1, 0), cA + kstep, 0, rofsC); PG8_STAGE(PG8_SB(1, 1), cB + hstep + kstep, voffB);
        PG8_WAIT_V(6); PG8_BAR;
    }
    for (;;) {
        const bool has_next = S.next(ui + 1, nxt);
        const char* nA = (has_next && !GATHER) ? (const char*)g.A + (size_t)nxt.pm * tstep : cA; const char* nB = has_next ? (const char*)g.Bt + (size_t)nxt.pb * tstep : cB;
        for (int t = 0; t < nt; t += 2) {
            const bool last = (t == nt - 2);
            const char* a1 = cA + (size_t)(t + 1) * kstep;
            const char* a2 = last ? nA : cA + (size_t)(t + 2) * kstep; const char* b2 = last ? nB : cB + (size_t)(t + 2) * kstep;
            const char* a3 = a2 + kstep; const char* b3 = b2 + kstep;
            if (last && has_next) { S.a_ready(nxt); PG8_ROWOFS(rofsN, nxt.pm); }
            unsigned ro2[2][2];
#pragma unroll
            for (int _h = 0; _h < 2; ++_h)
#pragma unroll
                for (int _i = 0; _i < 2; ++_i) ro2[_h][_i] = (last && has_next) ? rofsN[_h][_i] : rofsC[_h][_i];
            if constexpr (SP2) {
            PG8_LDB(B0, 0, 0); PG8_LDB(B1, 0, 1); PG8_SCHED; PG8_LDA(At, 0, 0); PG8_STAGE_A(PG8_SA(1, 1), a1, 1, rofsC);
            PG8_WAIT_V(8); PG8_WAIT_L(0); PG8_BAR; PG8_MMA(0, 0, At, B0); PG8_MMA(0, 1, At, B1); PG8_BAR; PG8_SCHED;
            PG8_LDA(At, 0, 1); PG8_STAGE(PG8_SB(0, 0), b2, voffB); PG8_STAGE(PG8_SB(0, 1), b2 + hstep, voffB); PG8_STAGE_A(PG8_SA(0, 0), a2, 0, ro2);
            PG8_WAIT_V(8); PG8_WAIT_L(0); PG8_BAR; PG8_MMA(1, 0, At, B0); PG8_MMA(1, 1, At, B1); PG8_BAR; PG8_SCHED;
            PG8_LDB(B0, 1, 0); PG8_LDB(B1, 1, 1); PG8_SCHED; PG8_LDA(At, 1, 0); PG8_STAGE_A(PG8_SA(0, 1), a2, 1, ro2);
            PG8_WAIT_V(8); PG8_WAIT_L(0); PG8_BAR; PG8_MMA(0, 0, At, B0); PG8_MMA(0, 1, At, B1); PG8_BAR; PG8_SCHED;
            PG8_LDA(At, 1, 1); PG8_STAGE(PG8_SB(1, 0), b3, voffB); PG8_STAGE(PG8_SB(1, 1), b3 + hstep, voffB); PG8_STAGE_A(PG8_SA(1, 0), a3, 0, ro2);
            PG8_WAIT_V(8); PG8_WAIT_L(0); PG8_BAR; PG8_MMA(1, 0, At, B0); PG8_MMA(1, 1, At, B1); PG8_BAR; PG8_SCHED;
            } else {
            PG8_LDB(B0, 0, 0); PG8_SCHED; PG8_LDA(At, 0, 0); PG8_STAGE_A(PG8_SA(1, 1), a1, 1, rofsC);
            PG8_WAIT_L(8); PG8_BAR; PG8_WAIT_L(0); PG8_MMA(0, 0, At, B0); PG8_BAR; PG8_SCHED;
            PG8_LDB(B1, 0, 1); PG8_STAGE(PG8_SB(0, 0), b2, voffB);
            PG8_BAR; PG8_WAIT_L(0); PG8_MMA(0, 1, At, B1); PG8_BAR;
            PG8_LDA(At, 0, 1); PG8_STAGE_A(PG8_SA(0, 0), a2, 0, ro2);
            PG8_BAR; PG8_WAIT_L(0); PG8_MMA(1, 0, At, B0); PG8_BAR; PG8_SCHED;
            PG8_STAGE(PG8_SB(0, 1), b2 + hstep, voffB);
            PG8_WAIT_V(6); PG8_BAR; PG8_MMA(1, 1, At, B1); PG8_BAR;
            PG8_LDB(B0, 1, 0); PG8_SCHED; PG8_LDA(At, 1, 0); PG8_STAGE_A(PG8_SA(0, 1), a2, 1, ro2);
            PG8_WAIT_L(8); PG8_BAR; PG8_WAIT_L(0); PG8_MMA(0, 0, At, B0); PG8_BAR; PG8_SCHED;
            PG8_LDB(B1, 1, 1); PG8_STAGE(PG8_SB(1, 0), b3, voffB);
            PG8_BAR; PG8_WAIT_L(0); PG8_MMA(0, 1, At, B1); PG8_BAR;
            PG8_LDA(At, 1, 1); PG8_STAGE_A(PG8_SA(1, 0), a3, 0, ro2);
            PG8_BAR; PG8_WAIT_L(0); PG8_MMA(1, 0, At, B0); PG8_BAR; PG8_SCHED;
            PG8_STAGE(PG8_SB(1, 1), b3 + hstep, voffB);
            PG8_WAIT_V(6); PG8_BAR; PG8_MMA(1, 1, At, B1); PG8_BAR;
            }
        }
        if constexpr (ALIGN_EPI) { if (wr == 0) PG8_BAR; }
        if constexpr (!Epi::AFTER_DRAIN) { E(acc, cur, wr, wc, fr, fq); S.done(cur); }
        if (!has_next) break;
#pragma unroll
        for (int a = 0; a < 2; ++a)
#pragma unroll
            for (int b = 0; b < 2; ++b)
#pragma unroll
                for (int m = 0; m < 4; ++m)
#pragma unroll
                    for (int n = 0; n < 2; ++n) acc[a][b][m][n] = (f32x4){0.f, 0.f, 0.f, 0.f};
        cur = nxt; cA = nA; cB = nB; ++ui;
#pragma unroll
        for (int _h = 0; _h < 2; ++_h)
#pragma unroll
            for (int _i = 0; _i < 2; ++_i) rofsC[_h][_i] = rofsN[_h][_i];
        if constexpr (ALIGN_EPI) { if (wr == 1) PG8_BAR; }
    }
    PG8_WAIT_V(0);
    if constexpr (!ALIGN_EPI) { if (wr == 0) PG8_BAR; }
    PG8_BAR;
    if constexpr (Epi::AFTER_DRAIN) { E.fused(acc, cur, wr, wc, fr, fq, lds, wid, lane); S.done(cur); }
#undef PG8_SA
#undef PG8_SB
#undef PG8_STAGE
#undef PG8_STAGE_A
#undef PG8_ROWOFS
#undef PG8_LDA
#undef PG8_LDB
#undef PG8_MMA
#undef PG8_WAIT_V
#undef PG8_WAIT_L
#undef PG8_BAR
#undef PG8_SCHED
}
}


constexpr int NWAVES = 8;
constexpr int BATCH = 2, SEQ = 16384, D = 1024, T = BATCH * SEQ, DEPTH = 2;
constexpr int NQH = 8, NKVH = 2, HD = 64, WINDOW = 128;
constexpr int HH = 4, HDK = 128;
constexpr int NGRP = 4, EPG = 8, NEXP = 32, DEXP = 512;
constexpr int INW = 5376, NPA = 3328, NGATE = 2048;
constexpr int C_QA = 0, C_KA = 512, C_VA = 640, C_QH = 768, C_LF = 1280, C_LB = 1792, C_VH = 2304, C_SG = 2816;
constexpr float NORM_EPS = 1e-6f, LOGF_MIN = -4.0f;
constexpr float LOG2E = 1.4426950408889634f;
constexpr float QSCALE = 0.125f * LOG2E;
constexpr int CH = 128, NCH = SEQ / CH;
constexpr int SLOT_ROWS = 73728;

constexpr size_t MiB = 1u << 20;
constexpr size_t WS_CTL = 0, CTL_ZERO_BYTES = 1 * MiB;
constexpr size_t WS_COS = 1 * MiB, WS_SIN = 3 * MiB, WS_LBT = 5 * MiB;
constexpr size_t WS_WIN = 6 * MiB, WS_WUA = 17 * MiB, WS_WUH = 18 * MiB, WS_WOUT = 19 * MiB, WS_W1 = 22 * MiB, WS_W2 = 86 * MiB;
constexpr size_t WS_XN = 118 * MiB;
constexpr size_t WS_PA = 182 * MiB;
constexpr size_t WS_US = 390 * MiB;
constexpr size_t WS_Y = 454 * MiB;
constexpr size_t WS_YH = 486 * MiB;
constexpr size_t WS_HD = 518 * MiB;
constexpr size_t WS_SSQ = 519 * MiB;
constexpr size_t WS_TOKE = 520 * MiB, WS_TOKW = 521 * MiB, WS_TOKR = 522 * MiB, WS_TOKP = 523 * MiB;
constexpr size_t WS_WGCNT = 524 * MiB;
constexpr size_t WS_META = 524 * MiB + 512 * 1024;
constexpr size_t WS_STOK = 525 * MiB;
constexpr size_t WS_RSA = 526 * MiB;
constexpr size_t WS_RSF = 526 * MiB + 128 * 1024;
constexpr size_t WS_RSS = 526 * MiB + 256 * 1024;
constexpr size_t WS_END = 527 * MiB;
constexpr size_t WS_XP = WS_PA;
constexpr size_t WS_ACT = WS_PA + (size_t)SLOT_ROWS * D * 2;
static_assert(WS_ACT + (size_t)SLOT_ROWS * DEXP * 2 <= WS_Y, "MoE overlay");
static_assert(WS_PA + (size_t)T * NPA * 2 <= WS_US && WS_W2 + (size_t)NEXP * D * DEXP * 2 <= WS_XN && WS_WIN + (size_t)INW * D * 2 <= WS_WUA, "ws map");
constexpr int CW_TMO = 0, CW_CODE = 1;
constexpr int CW_BAR = 4096;
#ifndef G1A_SPLIT
#define G1A_SPLIT 0
#endif
#ifndef CONV_WGS
#define CONV_WGS 16
#endif
#ifndef CONV_WGS_MOE
#define CONV_WGS_MOE 32
#endif
#ifndef CONV_PER_WG1
#define CONV_PER_WG1 512
#endif
#ifndef CONV_PER_WG2
#define CONV_PER_WG2 256
#endif
#ifndef CONV_PER_WG12
#define CONV_PER_WG12 192
#endif
#ifndef NORM4
#define NORM4 0
#endif
#ifndef NORMFOLD
#define NORMFOLD 1
#endif
#ifndef XBF16
#define XBF16 1
#endif
#ifndef CONV_ASM_LOADS
#define CONV_ASM_LOADS 0
#endif
#ifndef EXPERTS_BY_QUEUE
#define EXPERTS_BY_QUEUE 1
#endif
#ifndef MOE_HANDOFF
#define MOE_HANDOFF 0
#endif
constexpr int MAX_LAUNCH = 16;
constexpr int CW_H12 = 2048;
constexpr int CW_MOE = 131072, MOE_BANK = 320 * 64;

constexpr int RING_OFF = 0, RING_BYTES = 131072;
constexpr int LDSCTL_OFF = RING_BYTES, MISC_OFF = LDSCTL_OFF + 320;
#ifndef ROUTE4
#define ROUTE4 1
#endif
constexpr int LDS_BYTES = ROUTE4 ? 163840 : 147456;

#define GAS __attribute__((address_space(1)))
#define LAS __attribute__((address_space(3)))
typedef unsigned short bf16;
typedef unsigned v4u __attribute__((ext_vector_type(4)));
typedef unsigned v2u __attribute__((ext_vector_type(2)));
typedef float f32x4 __attribute__((ext_vector_type(4)));
typedef short bf16x8 __attribute__((ext_vector_type(8)));
typedef short s16x4 __attribute__((ext_vector_type(4)));
typedef _Float16 h16x4 __attribute__((ext_vector_type(4)));
typedef _Float16 h16x8 __attribute__((ext_vector_type(8)));
typedef GAS unsigned gu32;
typedef GAS unsigned long long gu64;
#define RLX_AGENT __ATOMIC_RELAXED, __HIP_MEMORY_SCOPE_AGENT
#define LDS_WAIT() asm volatile("s_waitcnt lgkmcnt(0)" ::: "memory")
#define VM_WAIT() asm volatile("s_waitcnt vmcnt(0)" ::: "memory")
__device__ __forceinline__ unsigned f2bf(float f) { unsigned u = __builtin_bit_cast(unsigned, f); return (u + 0x7fffu + ((u >> 16) & 1u)) >> 16; }
__device__ __forceinline__ unsigned pk2(float lo, float hi) { return f2bf(lo) | (f2bf(hi) << 16); }
__device__ __forceinline__ float bf2f(unsigned short b) { return __builtin_bit_cast(float, ((unsigned)b) << 16); }
__device__ __forceinline__ float bflo(unsigned w) { return __builtin_bit_cast(float, w << 16); }
__device__ __forceinline__ float bfhi(unsigned w) { return __builtin_bit_cast(float, w & 0xffff0000u); }
__device__ __forceinline__ float fast_rcp(float x) { return __builtin_amdgcn_rcpf(x); }
__device__ __forceinline__ float sigmoidf_(float x) { return fast_rcp(1.0f + __expf(-x)); }
__device__ __forceinline__ float siluf_(float x) { return x * fast_rcp(1.0f + __expf(-x)); }

#define XB_TMO      128
#define XB_XCNT(j)  (256  + 64 * (j))
#define XB_XSUB(j)  (1280 + 64 * (j))
#define XB_XGEN(j)  (2304 + 64 * (j))
#define XB_TOP      3328
#define XB_TOPGEN   3392
#define XCD_BAR_WORDS 3456
#define XB_SPIN_CAP (1u << 18)

__device__ __forceinline__ unsigned xb_ld(unsigned* p)              { return __hip_atomic_load(p, __ATOMIC_RELAXED, __HIP_MEMORY_SCOPE_AGENT); }
__device__ __forceinline__ unsigned xb_add(unsigned* p, unsigned v) { return __hip_atomic_fetch_add(p, v, __ATOMIC_RELAXED, __HIP_MEMORY_SCOPE_AGENT); }
__device__ __forceinline__ unsigned xb_xcc_id() { return (unsigned)__builtin_amdgcn_s_getreg((3 << 11) | 20) & 0xFu; }
#define XB_SPIN(cond, bar) do { unsigned _sp = 0; while (cond) { __builtin_amdgcn_s_sleep(1); \
    if ((++_sp & 255u) == 0u) { if (xb_ld(&(bar)[XB_TMO])) break; if (_sp > XB_SPIN_CAP) { atomicAdd(&(bar)[XB_TMO], 1u); break; } } } } while (0)

struct XcdBarrier {
    unsigned* bar; unsigned x;
    volatile LAS unsigned* st;
};

__device__ __forceinline__ XcdBarrier xcd_barrier_post(unsigned* bar, volatile LAS unsigned* st) {
    XcdBarrier b; b.bar = bar; b.x = xb_xcc_id(); b.st = st;
    if (threadIdx.x == 0) (void)xb_add(&bar[XB_XCNT(b.x)], 1u);
    return b;
}
__device__ __forceinline__ void xcd_barrier_complete(unsigned* bar, unsigned x, unsigned& nloc, unsigned& nx) {
    const unsigned G = gridDim.x * gridDim.y * gridDim.z;
    unsigned sum, cnt, mine, sp = 0u;
    for (;;) {
        sum = 0u; cnt = 0u; mine = 0u;
#pragma unroll
        for (unsigned j = 0; j < 16; ++j) { const unsigned c = xb_ld(&bar[XB_XCNT(j)]); sum += c; cnt += (c > 0u) ? 1u : 0u; mine = (j == x) ? c : mine; }
        if (sum == G) break;
        __builtin_amdgcn_s_sleep(1);
        if ((++sp & 255u) == 0u) { if (xb_ld(&bar[XB_TMO])) break; if (sp > XB_SPIN_CAP) { atomicAdd(&bar[XB_TMO], 1u); break; } }
    }
    nloc = mine > 0u ? mine : 1u; nx = cnt > 0u ? cnt : 1u;
}

__device__ __forceinline__ void xcd_barrier(const XcdBarrier& b) {
    asm volatile("s_waitcnt vmcnt(0)" ::: "memory");
    __syncthreads();
    if (threadIdx.x == 0) {
        unsigned* bar = b.bar;
        __builtin_amdgcn_s_waitcnt(0);
        unsigned nloc = b.st[0], nx = b.st[1];
        if (nloc == 0u) { xcd_barrier_complete(bar, b.x, nloc, nx); b.st[0] = nloc; b.st[1] = nx; }
        const unsigned old = xb_add(&bar[XB_XSUB(b.x)], 1u);
        const unsigned gen = old / nloc;
        if (old + 1u == (gen + 1u) * nloc) {
            __builtin_amdgcn_fence(__ATOMIC_RELEASE, "agent");
            asm volatile("s_waitcnt vmcnt(0)" ::: "memory");
            const unsigned og = xb_add(&bar[XB_TOP], 1u);
            const unsigned tg = og / nx;
            if (og + 1u == (tg + 1u) * nx) xb_add(&bar[XB_TOPGEN], 1u);
            else XB_SPIN(xb_ld(&bar[XB_TOPGEN]) == tg, bar);
            __builtin_amdgcn_fence(__ATOMIC_ACQUIRE, "agent");
            xb_add(&bar[XB_XGEN(b.x)], 1u);
            asm volatile("s_waitcnt vmcnt(0)" ::: "memory");
        } else {
            XB_SPIN(xb_ld(&bar[XB_XGEN(b.x)]) == gen, bar);
            __builtin_amdgcn_fence(__ATOMIC_ACQUIRE, "agent");
            asm volatile("s_waitcnt vmcnt(0)" ::: "memory");
        }
    }
    __syncthreads();
}

struct Frame {
    LAS unsigned char* lds;
    volatile LAS unsigned* MISC;
    gu32* ctl;
    int tid, lane, wave, vcu, G;
    unsigned char* ws;
    float* out;
};
struct Args { const float* in[18]; float* out; unsigned char* ws; int ph_lo, ph_hi, li, pad; };
enum { I_X = 0, I_ANG, I_WIN, I_SINK, I_LBT, I_HNG, I_WUA, I_WUH, I_WOUT, I_FNG, I_WRG, I_BRG, I_WRE, I_BRE, I_WEG, I_WEU, I_WED, I_FING };

__device__ __forceinline__ float wave_sum(float v) {
#if defined(__HIP_DEVICE_COMPILE__)
#define WS_ROR(n) v += __builtin_bit_cast(float, __builtin_amdgcn_update_dpp(0, __builtin_bit_cast(int, v), 0x120 + (n), 0xf, 0xf, false))
    WS_ROR(8); WS_ROR(4); WS_ROR(2); WS_ROR(1);
#undef WS_ROR
    const int b = __builtin_bit_cast(int, v);
    const float r0 = __builtin_bit_cast(float, __builtin_amdgcn_readlane(b, 0)), r1 = __builtin_bit_cast(float, __builtin_amdgcn_readlane(b, 16));
    const float r2 = __builtin_bit_cast(float, __builtin_amdgcn_readlane(b, 32)), r3 = __builtin_bit_cast(float, __builtin_amdgcn_readlane(b, 48));
    return (r0 + r1) + (r2 + r3);
#else
    return v;
#endif
}

struct CmPerm { const float* W; int N; __device__ __forceinline__ const float* seg(int p0, int n, int c, int& ld) const { ld = N; return W + p0 + 8 * c + 4 * n; } };
struct CmIn { const float* W; __device__ __forceinline__ const float* seg(int p0, int n, int c, int& ld) const { ld = INW;
    return (p0 < C_VA) ? (W + (p0 & ~63) + 32 * n + 16 * ((p0 >> 5) & 1) + 4 * c) : (W + p0 + 8 * c + 4 * n); } };
struct CmGU { const float* Wg; const float* Wu; __device__ __forceinline__ const float* seg(int p0, int n, int c, int& ld) const { ld = DEXP; return (n ? Wu : Wg) + 16 * (p0 >> 5) + 4 * c; } };
template <class CM> __device__ __forceinline__ void transpose_load(const CM& cm, int kb, int nb, int lane, f32x4 (&v)[8]) {
    const int k0 = 64 * kb, n0 = 32 * nb;
    const int nc = lane & 7, kr = lane >> 3;
    int ld; const float* src; { const float* s0 = cm.seg(n0, 0, nc & 3, ld); const float* s1 = cm.seg(n0, 1, nc & 3, ld); src = (nc >> 2) ? s1 : s0; }
#pragma unroll
    for (int i = 0; i < 8; ++i) v[i] = *(const GAS f32x4*)(src + (size_t)(k0 + 8 * i + kr) * ld);
}
__device__ __forceinline__ void transpose_finish(int K, bf16* WT, LAS float* scr, int kb, int nb, int lane, const f32x4 (&v)[8], const LAS float* gk = nullptr) {
    constexpr int SP = 36;
    const int k0 = 64 * kb, n0 = 32 * nb;
    const int nc = lane & 7, kr = lane >> 3;
#pragma unroll
    for (int i = 0; i < 8; ++i) *(LAS f32x4*)(scr + (8 * i + kr) * SP + 4 * nc) = gk ? v[i] * gk[k0 + 8 * i + kr] : v[i];
    LDS_WAIT(); asm volatile("" ::: "memory");
    const int c = lane & 7;
#pragma unroll
    for (int j = 0; j < 4; ++j) { const int n = (lane >> 3) + 8 * j; const LAS float* s = scr + (8 * c) * SP + n;
        v4u o; o.x = pk2(s[0 * SP], s[1 * SP]); o.y = pk2(s[2 * SP], s[3 * SP]); o.z = pk2(s[4 * SP], s[5 * SP]); o.w = pk2(s[6 * SP], s[7 * SP]);
        *(GAS v4u*)(WT + (size_t)(n0 + n) * K + k0 + 8 * c) = o; }
    LDS_WAIT(); asm volatile("" ::: "memory");
}
template <class CM> __device__ __forceinline__ void transpose_item(const CM& cm, int K, bf16* WT, LAS float* scr, int kb, int nb, int lane, const LAS float* gk = nullptr) {
    f32x4 v[8]; transpose_load(cm, kb, nb, lane, v); transpose_finish(K, WT, scr, kb, nb, lane, v, gk);
}
__device__ __forceinline__ void conv_weights(Frame& F, const Args& A, int l) {
    LAS float* scr = (LAS float*)(F.lds + RING_OFF + F.wave * 16384);
    const int gw = F.vcu * NWAVES + F.wave, NGW = F.G * NWAVES;
    unsigned char* ws = F.ws;
    const float* w_in = A.in[I_WIN] + (size_t)l * D * INW;
    const float* w_ua = A.in[I_WUA] + (size_t)l * 512 * D;
    const float* w_uh = A.in[I_WUH] + (size_t)l * 512 * D;
    const float* w_out = A.in[I_WOUT] + (size_t)l * D * D;
    const float* w_eg = A.in[I_WEG] + (size_t)l * NEXP * D * DEXP;
    const float* w_eu = A.in[I_WEU] + (size_t)l * NEXP * D * DEXP;
    const float* w_ed = A.in[I_WED] + (size_t)l * NEXP * DEXP * D;
    constexpr int I_A = 16 * (INW / 32), I_B = 8 * 32, I_D = 16 * 32, I_E1 = 16 * 32, I_E = NEXP * I_E1, I_F1 = 8 * 32, I_F = NEXP * I_F1;
    constexpr int NITEMS = I_A + 2 * I_B + I_D + (EXPERTS_BY_QUEUE ? 0 : I_E + I_F);
    LAS float* gkl = scr + 2560;
    if (NORMFOLD) { const float* gsrc = A.in[I_ANG] + (size_t)l * D;
#pragma unroll
        for (int j = 0; j < 4; ++j) *(LAS f32x4*)(gkl + 4 * F.lane + 256 * j) = *(const f32x4*)(gsrc + 4 * F.lane + 256 * j);
        LDS_WAIT(); }
    for (int it = gw; it < NITEMS; it += NGW) {
        int r = it;
        if (r < I_A) { CmIn cm{w_in}; transpose_item(cm, D, (bf16*)(ws + WS_WIN), scr, r / (INW / 32), r % (INW / 32), F.lane, NORMFOLD ? gkl : nullptr); continue; } r -= I_A;
        if (r < I_B) { CmPerm cm{w_ua, D}; transpose_item(cm, 512, (bf16*)(ws + WS_WUA), scr, r / 32, r % 32, F.lane); continue; } r -= I_B;
        if (r < I_B) { CmPerm cm{w_uh, D}; transpose_item(cm, 512, (bf16*)(ws + WS_WUH), scr, r / 32, r % 32, F.lane); continue; } r -= I_B;
        if (r < I_D) { CmPerm cm{w_out, D}; transpose_item(cm, D, (bf16*)(ws + WS_WOUT), scr, r / 32, r % 32, F.lane); continue; } r -= I_D;
        if (r < I_E) { const int e = r / I_E1, q = r % I_E1; CmGU cm{w_eg + (size_t)e * D * DEXP, w_eu + (size_t)e * D * DEXP};
            transpose_item(cm, D, (bf16*)(ws + WS_W1) + (size_t)e * 1024 * D, scr, q / 32, q % 32, F.lane); continue; } r -= I_E;
        { const int e = r / I_F1, q = r % I_F1; CmPerm cm{w_ed + (size_t)e * DEXP * D, D};
            transpose_item(cm, DEXP, (bf16*)(ws + WS_W2) + (size_t)e * D * DEXP, scr, q / 32, q % 32, F.lane); }
    }
}
__device__ __forceinline__ int conv_wgs(int G, int units, int cmax) {
    if (!EXPERTS_BY_QUEUE || G < 64 || (G % 8) != 0) return 0;
    const int r = (units + G - 1) / G; int c = cmax;
    while (c > 0 && (units + (G - c) - 1) / (G - c) > r) c -= 8;
    return c;
}
__device__ __forceinline__ void conv_experts_range(Frame& F, const Args& A, int l, int first, int last, int wi, int nw) {
    LAS float* scr = (LAS float*)(F.lds + RING_OFF + F.wave * 16384);
    unsigned char* ws = F.ws;
    const float* w_eg = A.in[I_WEG] + (size_t)l * NEXP * D * DEXP;
    const float* w_eu = A.in[I_WEU] + (size_t)l * NEXP * D * DEXP;
    const float* w_ed = A.in[I_WED] + (size_t)l * NEXP * DEXP * D;
    LAS float* gkl = scr + 2560;
    if (NORMFOLD && first < last) { const float* gsrc = A.in[I_FNG] + (size_t)l * D;
#pragma unroll
        for (int j = 0; j < 4; ++j) *(LAS f32x4*)(gkl + 4 * F.lane + 256 * j) = *(const f32x4*)(gsrc + 4 * F.lane + 256 * j);
        LDS_WAIT(); }
    constexpr int I_E1 = 16 * 32, I_E = NEXP * I_E1, I_F1 = 8 * 32;
    static_assert(I_E % 2 == 0 && I_F1 % 2 == 0, "pairs do not straddle");
#define CQ_LOAD(q, va, vb) do { const bool w1_ = (q) < I_E; const int r0_ = w1_ ? (q) : (q) - I_E, e_ = w1_ ? (r0_ >> 9) : (r0_ >> 8), r_ = w1_ ? (r0_ & 511) : (r0_ & 255), kb_ = r_ >> 5, nb_ = r_ & 31; \
        const int nc_ = F.lane & 7, kr_ = F.lane >> 3, n_ = nc_ >> 2, c_ = nc_ & 3; const size_t eo_ = (size_t)e_ * D * DEXP; \
        const float* base_ = w1_ ? ((n_ ? w_eu : w_eg) + eo_ + 16 * nb_ + 4 * c_) : (w_ed + eo_ + 32 * nb_ + 8 * c_ + 4 * n_); const int ld_ = w1_ ? DEXP : D, st_ = w1_ ? 16 : 32; \
        _Pragma("unroll") for (int i_ = 0; i_ < 8; ++i_) { const GAS float* p_ = (const GAS float*)(base_ + (size_t)(64 * kb_ + 8 * i_ + kr_) * ld_); const GAS float* p2_ = p_ + st_; \
            CQ_LD(va[i_], p_); CQ_LD(vb[i_], p2_); } } while (0)
#if CONV_ASM_LOADS
#define CQ_LD(dst, p) asm volatile("global_load_dwordx4 %0, %1, off" : "=&v"(dst) : "v"(p) : "memory")
#define CQ_WAIT(n, va, vb) asm volatile("s_waitcnt vmcnt(" #n ")" : "+v"(va[0]), "+v"(va[1]), "+v"(va[2]), "+v"(va[3]), "+v"(va[4]), "+v"(va[5]), "+v"(va[6]), "+v"(va[7]), \
        "+v"(vb[0]), "+v"(vb[1]), "+v"(vb[2]), "+v"(vb[3]), "+v"(vb[4]), "+v"(vb[5]), "+v"(vb[6]), "+v"(vb[7]) :: "memory")
#else
#define CQ_LD(dst, p) dst = *(const GAS f32x4*)(p)
#define CQ_WAIT(n, va, vb) do { } while (0)
#endif
#define CQ_FINISH(q, va, vb) do { const bool w1_ = (q) < I_E; const int r0_ = w1_ ? (q) : (q) - I_E, e_ = w1_ ? (r0_ >> 9) : (r0_ >> 8), r_ = w1_ ? (r0_ & 511) : (r0_ & 255); \
        bf16* WT_ = (w1_ ? (bf16*)(ws + WS_W1) : (bf16*)(ws + WS_W2)) + (size_t)e_ * (w1_ ? 1024 * D : D * DEXP); const int K_ = w1_ ? D : DEXP; \
        const LAS float* gk_ = (NORMFOLD && w1_) ? gkl : nullptr; transpose_finish(K_, WT_, scr, r_ >> 5, r_ & 31, F.lane, va, gk_); transpose_finish(K_, WT_, scr, r_ >> 5, (r_ & 31) + 1, F.lane, vb, gk_); } while (0)
    static_assert(I_E1 == 512 && I_F1 == 256, "shifts above");
    f32x4 a0[8], a1[8], b0[8], b1[8];
    const int step = 2 * nw;
    int qa = first + 2 * wi, qb; if (qa >= last) return;
    CQ_LOAD(qa, a0, a1);
    for (;;) {
        qb = qa + step; const bool hb = qb < last; { const int ql = hb ? qb : qa; CQ_LOAD(ql, b0, b1); }
        CQ_WAIT(16, a0, a1); CQ_FINISH(qa, a0, a1);
        if (!hb) { CQ_WAIT(0, b0, b1); break; }
        qa = qb + step; const bool ha = qa < last; { const int ql = ha ? qa : qb; CQ_LOAD(ql, a0, a1); }
        CQ_WAIT(16, b0, b1); CQ_FINISH(qb, b0, b1);
        if (!ha) { CQ_WAIT(0, a0, a1); break; }
    }
#undef CQ_WAIT
#undef CQ_LD
#undef CQ_LOAD
#undef CQ_FINISH
}
__device__ __forceinline__ void make_tables(Frame& F, const Args& A) {
    const int gt = F.vcu * (NWAVES * 64) + F.tid, NT = F.G * NWAVES * 64;
    float* cosT = (float*)(F.ws + WS_COS); float* sinT = (float*)(F.ws + WS_SIN); float* lbt = (float*)(F.ws + WS_LBT);
    for (int idx = gt; idx < SEQ * 32; idx += NT) { const int pos = idx >> 5, i = idx & 31;
        const double inv = exp2(-(double)i * (13.287712379549449 / 32.0));
        const double ang = (double)pos * inv; const double r = ang - 6.283185307179586476925 * rint(ang * 0.15915494309189533577);
        float s, c; sincosf((float)r, &s, &c); cosT[idx] = c; sinT[idx] = s; }
    for (int idx = gt; idx < 2 * 512; idx += NT) { const int dir = idx >> 9, col = idx & 511;
        float tv[DEPTH]; float mx = -3.0e38f;
#pragma unroll
        for (int l = 0; l < DEPTH; ++l) { tv[l] = A.in[I_LBT][(size_t)(l * 2 + dir) * 512 + col]; mx = fmaxf(mx, tv[l]); }
        float den = 0.f;
#pragma unroll
        for (int l = 0; l < DEPTH; ++l) { tv[l] = expf(tv[l] - mx); den += tv[l]; }
        float cum = 0.f;
#pragma unroll
        for (int l = 0; l < DEPTH; ++l) { if (l > 0) cum += tv[l] / den; const float lb = cum;
            lbt[((l * 2 + dir) * 2 + 0) * 512 + col] = lb; lbt[((l * 2 + dir) * 2 + 1) * 512 + col] = 0.f; } }
}
__device__ __forceinline__ void norm_rows(Frame& F, const float* xin, float* xcopy, const float* g, bf16* xn, float* rs_out = nullptr) {
    const int gw = F.vcu * NWAVES + F.wave, NGW = F.G * NWAVES;
    f32x4 gv[4];
#pragma unroll
    for (int j = 0; j < 4; ++j) gv[j] = *(const f32x4*)(g + 4 * F.lane + 256 * j);
    f32x4 vn[4];
    { const GAS f32x4* xr = (const GAS f32x4*)(xin + (size_t)gw * D) + F.lane;
#pragma unroll
      for (int j = 0; j < 4; ++j) vn[j] = xr[64 * j]; }
    for (int m = gw; m < T; m += NGW) {
        f32x4 v[4]; float s = 0.f;
#pragma unroll
        for (int j = 0; j < 4; ++j) { v[j] = vn[j]; s += (v[j].x * v[j].x + v[j].y * v[j].y) + (v[j].z * v[j].z + v[j].w * v[j].w); }
        if (m + NGW < T) { const GAS f32x4* xr = (const GAS f32x4*)(xin + (size_t)(m + NGW) * D) + F.lane;
#pragma unroll
            for (int j = 0; j < 4; ++j) vn[j] = xr[64 * j]; }
        const float rstd = 1.0f / sqrtf(wave_sum(s) * (1.f / D) + NORM_EPS);
        if (xcopy) { GAS f32x4* xo = (GAS f32x4*)(xcopy + (size_t)m * D) + F.lane;
#pragma unroll
            for (int j = 0; j < 4; ++j) xo[64 * j] = v[j]; }
        GAS v2u* o8 = (GAS v2u*)(xn + (size_t)m * D) + F.lane;
#pragma unroll
        for (int j = 0; j < 4; ++j) { const f32x4 y = rs_out ? v[j] : v[j] * rstd * gv[j]; v2u w; w.x = pk2(y.x, y.y); w.y = pk2(y.z, y.w); o8[64 * j] = w; }
        if (rs_out && F.lane == 0) rs_out[m] = rstd;
    }
}

__device__ __forceinline__ float row_sum16n(float v) {
#if defined(__HIP_DEVICE_COMPILE__)
#define RS_ROR(n) v += __builtin_bit_cast(float, __builtin_amdgcn_update_dpp(0, __builtin_bit_cast(int, v), 0x120 + (n), 0xf, 0xf, false))
    RS_ROR(8); RS_ROR(4); RS_ROR(2); RS_ROR(1);
#undef RS_ROR
#endif
    return v;
}
__device__ __forceinline__ void norm_rows4(Frame& F, const float* xin, const float* g, bf16* xn) {
    const int gw = F.vcu * NWAVES + F.wave, NGW = F.G * NWAVES, r = F.lane >> 4, c = F.lane & 15;
    constexpr int NTG = T / 4;
    f32x4 vq[16], gq[16];
#pragma unroll
    for (int k = 0; k < 16; ++k) gq[k] = *(const f32x4*)(g + 64 * k + 4 * c);
    if (gw < NTG) { const GAS f32x4* xr = (const GAS f32x4*)(xin + (size_t)(4 * gw + r) * D) + c;
#pragma unroll
        for (int k = 0; k < 16; ++k) vq[k] = xr[16 * k]; }
    for (int tg = gw; tg < NTG; tg += NGW) { const int m = 4 * tg + r;
        f32x4 v[16]; float s = 0.f;
#pragma unroll
        for (int k = 0; k < 16; ++k) { v[k] = vq[k]; s += (v[k].x * v[k].x + v[k].y * v[k].y) + (v[k].z * v[k].z + v[k].w * v[k].w); }
        if (tg + NGW < NTG) { const GAS f32x4* xr = (const GAS f32x4*)(xin + (size_t)(4 * (tg + NGW) + r) * D) + c;
#pragma unroll
            for (int k = 0; k < 16; ++k) vq[k] = xr[16 * k]; }
        const float rstd = 1.0f / sqrtf(row_sum16n(s) * (1.f / D) + NORM_EPS);
        GAS v2u* o8 = (GAS v2u*)(xn + (size_t)m * D) + c;
#pragma unroll
        for (int k = 0; k < 16; ++k) { const f32x4 y = v[k] * rstd * gq[k]; v2u w; w.x = pk2(y.x, y.y); w.y = pk2(y.z, y.w); o8[16 * k] = w; }
    }
}

using pg8::Unit; using pg8::cvt_pk_bf16;
__device__ __forceinline__ v4u pack8(const f32x4& a, const f32x4& b) { v4u w; w.x = cvt_pk_bf16(a[0], a[1]); w.y = cvt_pk_bf16(a[2], a[3]); w.z = cvt_pk_bf16(b[0], b[1]); w.w = cvt_pk_bf16(b[2], b[3]); return w; }
__device__ __forceinline__ void unpack8(const v4u& w, f32x4& a, f32x4& b) { a = (f32x4){bflo(w.x), bfhi(w.x), bflo(w.y), bfhi(w.y)}; b = (f32x4){bflo(w.z), bfhi(w.z), bflo(w.w), bfhi(w.w)}; }
__device__ __forceinline__ float logf_gate(float z, float lb) {
    const float t = __expf(-fabsf(z)), num = (z >= 0.f) ? __builtin_fmaf(lb, t, 1.0f) : (lb + t);
    const float r2 = __builtin_amdgcn_logf(num) - __builtin_amdgcn_logf(1.0f + t);
    return fmaxf(r2, LOGF_MIN * 1.4426950408889634f);
}
struct EpiInA {
    static constexpr bool PERM = false, AFTER_DRAIN = false;
    bf16* PA; const float* cosT; const float* sinT; const float* lbt;
    int pofs;
    const float* rs;
    __device__ __forceinline__ void operator()(const f32x4 (&acc)[2][2][4][2], const Unit& u, int wr, int wc, int fr, int fq) const {
        const int pn = u.pn + pofs, row0 = u.pm * 256 + wr * 64 + fr;
        float rsv[2][4];
#pragma unroll
        for (int ai = 0; ai < 2; ++ai)
#pragma unroll
            for (int m = 0; m < 4; ++m) rsv[ai][m] = NORMFOLD ? rs[row0 + 128 * ai + 16 * m] : 1.0f;
#pragma unroll
        for (int bj = 0; bj < 2; ++bj) {
            int mode = 0; float sc = 1.f; int lbo = 0;
            if (pn < 2) { mode = 1; sc = QSCALE; } else if (pn == 2) { mode = (bj == 0) ? 1 : 0; } else if (pn < 5) mode = 2;
            else if (pn < 7) { mode = 3; lbo = (pn - 5) * 256; } else if (pn < 9) { mode = 3; lbo = 1024 + (pn - 7) * 256; } else if (pn < 11) mode = 0; else mode = 2;
            if (mode == 1) {
                const int hb = 256 * pn + 128 * bj + 64 * (wc >> 1), d0 = 16 * (wc & 1) + 4 * fq;
#pragma unroll
                for (int ai = 0; ai < 2; ++ai) { f32x4 csv[4], snv[4];
#pragma unroll
                    for (int m = 0; m < 4; ++m) { const int pos = (row0 + 128 * ai + 16 * m) & (SEQ - 1); csv[m] = *(const f32x4*)(cosT + pos * 32 + d0); snv[m] = *(const f32x4*)(sinT + pos * 32 + d0); }
#pragma unroll
                    for (int m = 0; m < 4; ++m) { const int r = row0 + 128 * ai + 16 * m;
                        const f32x4 cs = csv[m], sn = snv[m];
                        const f32x4 x1 = acc[ai][bj][m][0], x2 = acc[ai][bj][m][1];
                        const float scr_ = sc * rsv[ai][m];
                        const f32x4 o1 = (x1 * cs - x2 * sn) * scr_, o2 = (x2 * cs + x1 * sn) * scr_;
                        bf16* rp = PA + (size_t)r * NPA + hb + d0;
                        v2u w1; w1.x = cvt_pk_bf16(o1[0], o1[1]); w1.y = cvt_pk_bf16(o1[2], o1[3]); *(v2u*)rp = w1;
                        v2u w2; w2.x = cvt_pk_bf16(o2[0], o2[1]); w2.y = cvt_pk_bf16(o2[2], o2[3]); *(v2u*)(rp + 32) = w2; }
                    asm volatile("" ::: "memory"); }
            } else {
                const int c0 = 256 * pn + 128 * bj + 32 * wc + 8 * fq;
                if (mode == 3) {
                    const float* lp = lbt + lbo + 128 * bj + 32 * wc + 8 * fq;
#pragma unroll
                    for (int n = 0; n < 2; ++n) { const f32x4 la = *(const f32x4*)(lp + 4 * n);
#pragma unroll
                        for (int ai = 0; ai < 2; ++ai)
#pragma unroll
                            for (int m = 0; m < 4; ++m) { const int r = row0 + 128 * ai + 16 * m; bf16* rp = PA + (size_t)r * NPA + c0 + 4 * n;
                                const f32x4 v = acc[ai][bj][m][n] * rsv[ai][m]; h16x4 hv;
#pragma unroll
                                for (int j = 0; j < 4; ++j) hv[j] = (_Float16)logf_gate(v[j], la[j]);
                                *(h16x4*)rp = hv; asm volatile("" ::: "memory"); } }
                } else {
#pragma unroll
                    for (int ai = 0; ai < 2; ++ai)
#pragma unroll
                        for (int m = 0; m < 4; ++m) { const int r = row0 + 128 * ai + 16 * m; bf16* rp = PA + (size_t)r * NPA + c0;
                            f32x4 v0 = acc[ai][bj][m][0], v1 = acc[ai][bj][m][1];
                            if (NORMFOLD) { const float rr = rsv[ai][m]; v0 = v0 * rr; v1 = v1 * rr; }
                            if (mode == 2) {
#pragma unroll
                                for (int j = 0; j < 4; ++j) { v0[j] = siluf_(v0[j]); v1[j] = siluf_(v1[j]); } }
                            *(v4u*)rp = pack8(v0, v1); asm volatile("" ::: "memory"); }
                }
            }
        }
    }
};
struct EpiGate {
    static constexpr bool PERM = false, AFTER_DRAIN = false;
    bf16* O; const float* rs;
    __device__ __forceinline__ void operator()(const f32x4 (&acc)[2][2][4][2], const Unit& u, int wr, int wc, int fr, int fq) const {
        const int row0 = u.pm * 256 + wr * 64 + fr, c0 = 256 * u.pn + 32 * wc + 8 * fq;
        float rsv[2][4];
#pragma unroll
        for (int ai = 0; ai < 2; ++ai)
#pragma unroll
            for (int m = 0; m < 4; ++m) rsv[ai][m] = NORMFOLD ? rs[row0 + 128 * ai + 16 * m] : 1.0f;
#pragma unroll
        for (int ai = 0; ai < 2; ++ai)
#pragma unroll
            for (int m = 0; m < 4; ++m) { bf16* rp = O + (size_t)(row0 + 128 * ai + 16 * m) * NGATE + c0; const float rr = rsv[ai][m];
#pragma unroll
                for (int bj = 0; bj < 2; ++bj) { f32x4 v0 = acc[ai][bj][m][0] * rr, v1 = acc[ai][bj][m][1] * rr;
#if !defined(CK_PLAIN)
#pragma unroll
                    for (int j = 0; j < 4; ++j) { v0[j] = sigmoidf_(v0[j]); v1[j] = sigmoidf_(v1[j]); }
#endif
                    *(v4u*)(rp + 128 * bj) = pack8(v0, v1); } }
    }
};
#if defined(PROBE_KLOOP)
struct EpiNull {
    static constexpr bool PERM = false, AFTER_DRAIN = false;
    bf16* O;
    __device__ __forceinline__ void operator()(const f32x4 (&acc)[2][2][4][2], const Unit& u, int wr, int wc, int fr, int fq) const {
        float s = 0.f;
#pragma unroll
        for (int ai = 0; ai < 2; ++ai)
#pragma unroll
            for (int bj = 0; bj < 2; ++bj)
#pragma unroll
                for (int m = 0; m < 4; ++m)
#pragma unroll
                    for (int n = 0; n < 2; ++n) s += acc[ai][bj][m][n][0] + acc[ai][bj][m][n][1] + acc[ai][bj][m][n][2] + acc[ai][bj][m][n][3];
        if (s == 12345.678f) O[u.pm + wr + wc + fr + fq] = (bf16)1;
    }
};
#endif
struct EpiUpA {
    static constexpr bool PERM = false, AFTER_DRAIN = false;
    bf16* MG; const bf16* GT;
    __device__ __forceinline__ void operator()(const f32x4 (&acc)[2][2][4][2], const Unit& u, int wr, int wc, int fr, int fq) const {
        const int row0 = u.pm * 256 + wr * 64 + fr, c0 = 256 * u.pn + 32 * wc + 8 * fq;
        v4u gw[2][2][2];
#define UA_LOAD(q_, buf_) do { _Pragma("unroll") for (int mm = 0; mm < 2; ++mm) _Pragma("unroll") for (int bj = 0; bj < 2; ++bj) \
            gw[buf_][mm][bj] = *(const v4u*)(GT + (size_t)(row0 + 128 * ((q_) >> 1) + 16 * (2 * ((q_) & 1) + mm)) * NGATE + c0 + 128 * bj); } while (0)
        UA_LOAD(0, 0);
#pragma unroll
        for (int q = 0; q < 4; ++q) { const int ai = q >> 1, mh = q & 1;
            if (q < 3) UA_LOAD(q + 1, (q + 1) & 1);
            __builtin_amdgcn_sched_barrier(0);
#pragma unroll
            for (int mm = 0; mm < 2; ++mm) { const int m = 2 * mh + mm; bf16* rp = MG + (size_t)(row0 + 128 * ai + 16 * m) * D + c0;
#pragma unroll
                for (int bj = 0; bj < 2; ++bj) { f32x4 g0, g1; unpack8(gw[q & 1][mm][bj], g0, g1);
                    *(v4u*)(rp + 128 * bj) = pack8(acc[ai][bj][m][0] * g0, acc[ai][bj][m][1] * g1); } }
            __builtin_amdgcn_sched_barrier(0); }
#undef UA_LOAD
    }
};
struct EpiUpB {
    static constexpr bool PERM = false, AFTER_DRAIN = false;
    bf16* MG; const bf16* GT; const float* ssq;
    __device__ __forceinline__ void operator()(const f32x4 (&acc)[2][2][4][2], const Unit& u, int wr, int wc, int fr, int fq) const {
        const int row0 = u.pm * 256 + wr * 64 + fr, c0 = 256 * u.pn + 32 * wc + 8 * fq;
        v4u gw[2][2][2], pw[2][2][2]; f32x4 sq[2][2];
#define UB_LOAD(q_, buf_) do { _Pragma("unroll") for (int mm = 0; mm < 2; ++mm) { const int r_ = row0 + 128 * ((q_) >> 1) + 16 * (2 * ((q_) & 1) + mm); sq[buf_][mm] = *(const f32x4*)(ssq + (size_t)r_ * 4); \
            _Pragma("unroll") for (int bj = 0; bj < 2; ++bj) { gw[buf_][mm][bj] = *(const v4u*)(GT + (size_t)r_ * NGATE + 1024 + c0 + 128 * bj); pw[buf_][mm][bj] = *(const v4u*)(MG + (size_t)r_ * D + c0 + 128 * bj); } } } while (0)
        UB_LOAD(0, 0);
#pragma unroll
        for (int q = 0; q < 4; ++q) { const int ai = q >> 1, mh = q & 1;
            if (q < 3) UB_LOAD(q + 1, (q + 1) & 1);
            __builtin_amdgcn_sched_barrier(0);
#pragma unroll
            for (int mm = 0; mm < 2; ++mm) { const int m = 2 * mh + mm; bf16* rp = MG + (size_t)(row0 + 128 * ai + 16 * m) * D + c0; const f32x4 sv = sq[q & 1][mm];
                const float rstd = 1.0f / sqrtf(((sv[0] + sv[1]) + (sv[2] + sv[3])) * (1.f / 512.f) + NORM_EPS);
#pragma unroll
                for (int bj = 0; bj < 2; ++bj) { f32x4 g0, g1, p0, p1; unpack8(gw[q & 1][mm][bj], g0, g1); unpack8(pw[q & 1][mm][bj], p0, p1);
                    *(v4u*)(rp + 128 * bj) = pack8(p0 + acc[ai][bj][m][0] * g0 * rstd, p1 + acc[ai][bj][m][1] * g1 * rstd); } }
            __builtin_amdgcn_sched_barrier(0); }
#undef UB_LOAD
    }
};
struct EpiOut {
    static constexpr bool PERM = false, AFTER_DRAIN = false;
    float* X; const float* XI;
    __device__ __forceinline__ void operator()(const f32x4 (&acc)[2][2][4][2], const Unit& u, int wr, int wc, int fr, int fq) const {
        const int row0 = u.pm * 256 + wr * 64 + fr, c0 = 256 * u.pn + 32 * wc + 8 * fq;
#pragma unroll
        for (int ai = 0; ai < 2; ++ai) { f32x4 xv[4][2][2];
#pragma unroll
            for (int m = 0; m < 4; ++m)
#pragma unroll
                for (int bj = 0; bj < 2; ++bj) { const f32x4* p = (const f32x4*)(XI + (size_t)(row0 + 128 * ai + 16 * m) * D + c0 + 128 * bj); xv[m][bj][0] = p[0]; xv[m][bj][1] = p[1]; }
#pragma unroll
            for (int m = 0; m < 4; ++m)
#pragma unroll
                for (int bj = 0; bj < 2; ++bj) { f32x4* p = (f32x4*)(X + (size_t)(row0 + 128 * ai + 16 * m) * D + c0 + 128 * bj); p[0] = xv[m][bj][0] + acc[ai][bj][m][0]; p[1] = xv[m][bj][1] + acc[ai][bj][m][1]; }
            asm volatile("" ::: "memory"); }
    }
};
template <bool IN_F32> struct EpiOutB {
    static constexpr bool PERM = false, AFTER_DRAIN = false;
    bf16* XO; const void* XI;
    __device__ __forceinline__ void operator()(const f32x4 (&acc)[2][2][4][2], const Unit& u, int wr, int wc, int fr, int fq) const {
        const int row0 = u.pm * 256 + wr * 64 + fr, c0 = 256 * u.pn + 32 * wc + 8 * fq;
#pragma unroll
        for (int ai = 0; ai < 2; ++ai) { f32x4 xv[4][2][2];
#pragma unroll
            for (int m = 0; m < 4; ++m)
#pragma unroll
                for (int bj = 0; bj < 2; ++bj) { const size_t o = (size_t)(row0 + 128 * ai + 16 * m) * D + c0 + 128 * bj;
                    if constexpr (IN_F32) { const f32x4* p = (const f32x4*)((const float*)XI + o); xv[m][bj][0] = p[0]; xv[m][bj][1] = p[1]; }
                    else { const v4u w = *(const v4u*)((const bf16*)XI + o); unpack8(w, xv[m][bj][0], xv[m][bj][1]); } }
#pragma unroll
            for (int m = 0; m < 4; ++m)
#pragma unroll
                for (int bj = 0; bj < 2; ++bj) { const size_t o = (size_t)(row0 + 128 * ai + 16 * m) * D + c0 + 128 * bj;
                    *(v4u*)(XO + o) = pack8(xv[m][bj][0] + acc[ai][bj][m][0], xv[m][bj][1] + acc[ai][bj][m][1]); }
            asm volatile("" ::: "memory"); }
    }
};
struct EpiAct {
    static constexpr bool PERM = false, AFTER_DRAIN = false;
    bf16* ACT; const float* rs;
    __device__ __forceinline__ void operator()(const f32x4 (&acc)[2][2][4][2], const Unit& u, int wr, int wc, int fr, int fq) const {
        const int row0 = u.pm * 256 + wr * 64 + fr, c0 = 128 * u.pn + 16 * wc + 4 * fq;
        float rsv[2][4];
#pragma unroll
        for (int ai = 0; ai < 2; ++ai)
#pragma unroll
            for (int m = 0; m < 4; ++m) rsv[ai][m] = NORMFOLD ? rs[row0 + 128 * ai + 16 * m] : 1.0f;
#pragma unroll
        for (int ai = 0; ai < 2; ++ai)
#pragma unroll
            for (int m = 0; m < 4; ++m) { bf16* rp = ACT + (size_t)(row0 + 128 * ai + 16 * m) * DEXP + c0; const float rr = rsv[ai][m];
#pragma unroll
                for (int bj = 0; bj < 2; ++bj) { const f32x4 g = acc[ai][bj][m][0] * rr, up = acc[ai][bj][m][1] * rr; f32x4 a;
#pragma unroll
                    for (int j = 0; j < 4; ++j) a[j] = siluf_(g[j]) * up[j];
                    const unsigned long long w64 = (unsigned long long)cvt_pk_bf16(a[0], a[1]) | ((unsigned long long)cvt_pk_bf16(a[2], a[3]) << 32);
#if MOE_HANDOFF
                    __hip_atomic_store((gu64*)(rp + 64 * bj), w64, RLX_AGENT); } }
#else
                    *(unsigned long long*)(rp + 64 * bj) = w64; } }
#endif
    }
};
struct EpiY {
    static constexpr bool PERM = false, AFTER_DRAIN = false;
    bf16* Y;
    __device__ __forceinline__ void operator()(const f32x4 (&acc)[2][2][4][2], const Unit& u, int wr, int wc, int fr, int fq) const {
        const int row0 = u.pm * 256 + wr * 64 + fr, c0 = 256 * u.pn + 32 * wc + 8 * fq;
#pragma unroll
        for (int ai = 0; ai < 2; ++ai)
#pragma unroll
            for (int m = 0; m < 4; ++m) { bf16* rp = Y + (size_t)(row0 + 128 * ai + 16 * m) * D + c0;
#pragma unroll
                for (int bj = 0; bj < 2; ++bj) *(v4u*)(rp + 128 * bj) = pack8(acc[ai][bj][m][0], acc[ai][bj][m][1]); }
    }
};

#define VLD(p) __hip_atomic_load((p), __ATOMIC_RELAXED, __HIP_MEMORY_SCOPE_AGENT)
constexpr int HIST_OFF = MISC_OFF + 256;
constexpr int SBASE_OFF = HIST_OFF + 128;
constexpr int STOT_OFF = SBASE_OFF + 128;
constexpr int BRE_OFF = STOT_OFF + 128;
static_assert(BRE_OFF + 128 <= LDS_BYTES, "LDS misc");

__device__ __forceinline__ void phase_norm_route(Frame& F, const Args& A, int l, const void* xsrc) {
    const int gw = F.vcu * NWAVES + F.wave, NGW = F.G * NWAVES, lane = F.lane;
    LAS f32x4* Wre = (LAS f32x4*)(F.lds + RING_OFF);
    volatile LAS int* hist = (volatile LAS int*)(F.lds + HIST_OFF);
    const float* w_re = A.in[I_WRE] + (size_t)l * NGRP * D * EPG;
    const float* w_rg = A.in[I_WRG] + (size_t)l * D * NGRP;
    const float* b_rg = A.in[I_BRG] + l * NGRP;
    const float* b_re = A.in[I_BRE] + l * NGRP * EPG;
    const float* gf = A.in[I_FNG] + (size_t)l * D;
    for (int idx = F.tid; idx < NGRP * D; idx += NWAVES * 64) { const int g = idx >> 10, i = idx & 1023, li = (i & 255) >> 2, jj = 4 * (i >> 8) + (i & 3);
        const f32x4 a = *(const f32x4*)(w_re + (size_t)idx * 8), b = *(const f32x4*)(w_re + (size_t)idx * 8 + 4);
        Wre[((g * 2 + 0) * 16 + jj) * 64 + li] = a; Wre[((g * 2 + 1) * 16 + jj) * 64 + li] = b; }
    if (F.tid < 32) { hist[F.tid] = 0; ((LAS float*)(F.lds + BRE_OFF))[F.tid] = b_re[F.tid]; }
    { int* stok = (int*)(F.ws + WS_STOK); for (int i = F.vcu * (NWAVES * 64) + F.tid; i < SLOT_ROWS; i += F.G * NWAVES * 64) stok[i] = 0; }
    f32x4 wgr[16], gv[4];
#pragma unroll
    for (int j = 0; j < 4; ++j) { gv[j] = *(const f32x4*)(gf + 4 * lane + 256 * j);
#pragma unroll
        for (int c = 0; c < 4; ++c) wgr[4 * j + c] = *(const f32x4*)(w_rg + (size_t)(4 * lane + 256 * j + c) * 4); }
    f32x4 brg = *(const f32x4*)b_rg;
    __syncthreads();
    bf16* XN = (bf16*)(F.ws + WS_XN);
#if XBF16
    const bf16* X = (const bf16*)xsrc;
    typedef v2u xraw_t;
#define NR_LOAD(dst, row) do { const GAS v2u* xr_ = (const GAS v2u*)(X + (size_t)(row) * D) + lane; _Pragma("unroll") for (int j = 0; j < 4; ++j) dst[j] = xr_[64 * j]; } while (0)
#define NR_CVT(w_) ((f32x4){bflo((w_).x), bfhi((w_).x), bflo((w_).y), bfhi((w_).y)})
#else
    const float* X = (const float*)xsrc;
    typedef f32x4 xraw_t;
#define NR_LOAD(dst, row) do { const GAS f32x4* xr_ = (const GAS f32x4*)(X + (size_t)(row) * D) + lane; _Pragma("unroll") for (int j = 0; j < 4; ++j) dst[j] = xr_[64 * j]; } while (0)
#define NR_CVT(w_) (w_)
#endif
    int* tok_e = (int*)(F.ws + WS_TOKE); float* tok_w = (float*)(F.ws + WS_TOKW); int* tok_r = (int*)(F.ws + WS_TOKR);
    xraw_t vn[4], vn2[4];
    NR_LOAD(vn, gw); if (gw + NGW < T) NR_LOAD(vn2, gw + NGW);
    int pe1 = 0, pe2 = 0, pr1 = 0, pr2 = 0, pm = -1; float pw1 = 0.f, pw2 = 0.f;
    for (int m = gw; m < T; m += NGW) {
        f32x4 v[4]; float s = 0.f;
#pragma unroll
        for (int j = 0; j < 4; ++j) { v[j] = NR_CVT(vn[j]); vn[j] = vn2[j]; s += (v[j].x * v[j].x + v[j].y * v[j].y) + (v[j].z * v[j].z + v[j].w * v[j].w); }
        if (m + 2 * NGW < T) NR_LOAD(vn2, m + 2 * NGW);
        if (lane == 0 && pm >= 0) { tok_e[2 * pm] = pe1; tok_e[2 * pm + 1] = pe2; tok_w[2 * pm] = pw1; tok_w[2 * pm + 1] = pw2; tok_r[2 * pm] = pr1; tok_r[2 * pm + 1] = pr2; }
        const float rstd = 1.0f / sqrtf(wave_sum(s) * (1.f / D) + NORM_EPS);
        GAS v2u* o8 = (GAS v2u*)(XN + (size_t)m * D) + lane;
        f32x4 ga = (f32x4){0.f, 0.f, 0.f, 0.f};
#pragma unroll
        for (int j = 0; j < 4; ++j) { v[j] = v[j] * rstd * gv[j]; v2u w; w.x = pk2(v[j].x, v[j].y); w.y = pk2(v[j].z, v[j].w); o8[64 * j] = w;
            ga += wgr[4 * j + 0] * v[j].x; ga += wgr[4 * j + 1] * v[j].y; ga += wgr[4 * j + 2] * v[j].z; ga += wgr[4 * j + 3] * v[j].w; }
        float gl[4];
#pragma unroll
        for (int k = 0; k < 4; ++k) gl[k] = wave_sum(ga[k]) + brg[k];
        int gt = 0; float gm = gl[0];
#pragma unroll
        for (int k = 1; k < 4; ++k) if (gl[k] > gm) { gm = gl[k]; gt = k; }
        float gden = 0.f;
#pragma unroll
        for (int k = 0; k < 4; ++k) gden += expf(gl[k] - gm);
        const float p_top = 1.0f / gden;
        gt = __builtin_amdgcn_readfirstlane(gt);
        f32x4 a0 = (f32x4){0.f, 0.f, 0.f, 0.f}, a1 = a0;
        const LAS f32x4* w0 = Wre + ((gt * 2 + 0) * 16) * 64 + lane; const LAS f32x4* w1 = Wre + ((gt * 2 + 1) * 16) * 64 + lane;
        f32x4 wa[2][4], wb[2][4];
#pragma unroll
        for (int c = 0; c < 4; ++c) { wa[0][c] = w0[c * 64]; wb[0][c] = w1[c * 64]; }
#pragma unroll
        for (int j = 0; j < 4; ++j) {
            if (j < 3) {
#pragma unroll
                for (int c = 0; c < 4; ++c) { wa[(j + 1) & 1][c] = w0[(4 * (j + 1) + c) * 64]; wb[(j + 1) & 1][c] = w1[(4 * (j + 1) + c) * 64]; } }
            __builtin_amdgcn_sched_barrier(0);
            a0 += wa[j & 1][0] * v[j].x; a1 += wb[j & 1][0] * v[j].x;
            a0 += wa[j & 1][1] * v[j].y; a1 += wb[j & 1][1] * v[j].y;
            a0 += wa[j & 1][2] * v[j].z; a1 += wb[j & 1][2] * v[j].z;
            a0 += wa[j & 1][3] * v[j].w; a1 += wb[j & 1][3] * v[j].w;
            __builtin_amdgcn_sched_barrier(0); }
        const f32x4 bl0 = *(const LAS f32x4*)(F.lds + BRE_OFF + gt * 32), bl1 = *(const LAS f32x4*)(F.lds + BRE_OFF + gt * 32 + 16);
        float el[8];
#pragma unroll
        for (int k = 0; k < 4; ++k) { el[k] = wave_sum(a0[k]) + bl0[k]; el[4 + k] = wave_sum(a1[k]) + bl1[k]; }
        int i1 = 0; float m1 = el[0];
#pragma unroll
        for (int k = 1; k < 8; ++k) if (el[k] > m1) { m1 = el[k]; i1 = k; }
        int i2 = -1; float m2 = -3.0e38f;
#pragma unroll
        for (int k = 0; k < 8; ++k) if (k != i1 && el[k] > m2) { m2 = el[k]; i2 = k; }
        const float q1 = 1.0f, q2 = expf(m2 - m1);
        const float wn1 = p_top * q1 / (q1 + q2), wn2 = p_top * q2 / (q1 + q2);
        if (lane == 0) {
            pe1 = gt * 8 + i1; pe2 = gt * 8 + i2; pw1 = wn1; pw2 = wn2; pm = m;
            pr1 = __hip_atomic_fetch_add((LAS int*)hist + pe1, 1, __ATOMIC_RELAXED, __HIP_MEMORY_SCOPE_WORKGROUP);
            pr2 = __hip_atomic_fetch_add((LAS int*)hist + pe2, 1, __ATOMIC_RELAXED, __HIP_MEMORY_SCOPE_WORKGROUP);
        }
    }
    if (lane == 0 && pm >= 0) { tok_e[2 * pm] = pe1; tok_e[2 * pm + 1] = pe2; tok_w[2 * pm] = pw1; tok_w[2 * pm + 1] = pw2; tok_r[2 * pm] = pr1; tok_r[2 * pm + 1] = pr2; }
    __syncthreads();
    if (F.tid < 32) ((int*)(F.ws + WS_WGCNT))[blockIdx.x * 32 + F.tid] = hist[F.tid];
#undef NR_LOAD
#undef NR_CVT
}
#if ROUTE4
constexpr int WGR_OFF = (BRE_OFF + 128 + 255) & ~255, GNW_OFF = WGR_OFF + 16384;
static_assert(GNW_OFF + 4096 <= LDS_BYTES, "LDS route4");
__device__ __forceinline__ float row_sum16(float v) {
#if defined(__HIP_DEVICE_COMPILE__)
#define RS_ROR(n) v += __builtin_bit_cast(float, __builtin_amdgcn_update_dpp(0, __builtin_bit_cast(int, v), 0x120 + (n), 0xf, 0xf, false))
    RS_ROR(8); RS_ROR(4); RS_ROR(2); RS_ROR(1);
#undef RS_ROR
#endif
    return v;
}
__device__ __forceinline__ void phase_norm_route4(Frame& F, const Args& A, int l, const void* xsrc) {
    const int gw = F.vcu * NWAVES + F.wave, NGW = F.G * NWAVES, lane = F.lane, r = lane >> 4, c = lane & 15;
    LAS f32x4* WE = (LAS f32x4*)(F.lds + RING_OFF); LAS f32x4* WG = (LAS f32x4*)(F.lds + WGR_OFF); LAS f32x4* GL = (LAS f32x4*)(F.lds + GNW_OFF);
    volatile LAS int* hist = (volatile LAS int*)(F.lds + HIST_OFF);
    const float* w_re = A.in[I_WRE] + (size_t)l * NGRP * D * EPG;
    const float* w_rg = A.in[I_WRG] + (size_t)l * D * NGRP;
    const float* b_rg = A.in[I_BRG] + l * NGRP;
    const float* b_re = A.in[I_BRE] + l * NGRP * EPG;
    const float* gf = A.in[I_FNG] + (size_t)l * D;
    static_assert(XBF16 == 1, "route4 reads the bf16 residual stream");
    const bf16* X = (const bf16*)xsrc;
    constexpr int NTG = T / 4;
    v2u xn[16];
    if (gw < NTG) { const GAS v2u* xr = (const GAS v2u*)(X + (size_t)(4 * gw + r) * D) + c;
#pragma unroll
        for (int k = 0; k < 16; ++k) xn[k] = xr[16 * k]; }
    {
        f32x4 ta[8], tb[8], tg2[2], tgl = (f32x4){0.f, 0.f, 0.f, 0.f};
#pragma unroll
        for (int u = 0; u < 8; ++u) { const int idx = F.tid + u * (NWAVES * 64); ta[u] = *(const GAS f32x4*)(w_re + (size_t)idx * 8); tb[u] = *(const GAS f32x4*)(w_re + (size_t)idx * 8 + 4); }
#pragma unroll
        for (int u = 0; u < 2; ++u) tg2[u] = *(const GAS f32x4*)(w_rg + (size_t)(F.tid + u * (NWAVES * 64)) * 4);
        if (F.tid < 256) tgl = *(const GAS f32x4*)(gf + 64 * (F.tid >> 4) + 4 * (F.tid & 15));
        float gs[2] = {1.0f, 1.0f};
        if (NORMFOLD) { gs[0] = gf[F.tid]; gs[1] = gf[F.tid + NWAVES * 64]; }
        __builtin_amdgcn_sched_barrier(0);
#pragma unroll
        for (int u = 0; u < 8; ++u) { const int idx = F.tid + u * (NWAVES * 64), g = idx >> 10, e = idx & 1023, k = e >> 6, cc = (e >> 2) & 15, i = e & 3; const float gg_ = gs[u & 1];
            WE[((g * 16 + k) * 8 + 2 * i) * 16 + cc] = ta[u] * gg_; WE[((g * 16 + k) * 8 + 2 * i + 1) * 16 + cc] = tb[u] * gg_; }
#pragma unroll
        for (int u = 0; u < 2; ++u) { const int e = F.tid + u * (NWAVES * 64), k = e >> 6, cc = (e >> 2) & 15, i = e & 3; WG[(k * 4 + i) * 16 + cc] = tg2[u] * gs[u]; }
        if (F.tid < 256) GL[F.tid] = tgl;
    }
    static_assert(NGRP * D == 8 * NWAVES * 64 && D == 2 * NWAVES * 64, "staging loops above");
    if (F.tid < 32) { hist[F.tid] = 0; ((LAS float*)(F.lds + BRE_OFF))[F.tid] = b_re[F.tid]; }
    { int* stok = (int*)(F.ws + WS_STOK); for (int i = F.vcu * (NWAVES * 64) + F.tid; i < SLOT_ROWS; i += F.G * NWAVES * 64) stok[i] = 0; }
    const f32x4 brg = *(const f32x4*)b_rg;
    __syncthreads();
    bf16* XN = (bf16*)(F.ws + WS_XN);
    int* tok_e = (int*)(F.ws + WS_TOKE); float* tok_w = (float*)(F.ws + WS_TOKW); int* tok_r = (int*)(F.ws + WS_TOKR);
    int pe1 = 0, pe2 = 0, pr1 = 0, pr2 = 0, pm = -1; float pw1 = 0.f, pw2 = 0.f, prs = 0.f; float* rsf = (float*)(F.ws + WS_RSF);
    for (int tg = gw; tg < NTG; tg += NGW) {
        const int m = 4 * tg + r;
        f32x4 v[16]; float s = 0.f;
#pragma unroll
        for (int k = 0; k < 16; ++k) { const v2u w = xn[k]; v[k] = (f32x4){bflo(w.x), bfhi(w.x), bflo(w.y), bfhi(w.y)}; s += (v[k].x * v[k].x + v[k].y * v[k].y) + (v[k].z * v[k].z + v[k].w * v[k].w); }
        if (tg + NGW < NTG) { const GAS v2u* xr = (const GAS v2u*)(X + (size_t)(4 * (tg + NGW) + r) * D) + c;
#pragma unroll
            for (int k = 0; k < 16; ++k) xn[k] = xr[16 * k]; }
        if (c == 0 && pm >= 0) { tok_e[2 * pm] = pe1; tok_e[2 * pm + 1] = pe2; tok_w[2 * pm] = pw1; tok_w[2 * pm + 1] = pw2; tok_r[2 * pm] = pr1; tok_r[2 * pm + 1] = pr2; if (NORMFOLD) rsf[pm] = prs; }
        const float rstd = 1.0f / sqrtf(row_sum16(s) * (1.f / D) + NORM_EPS);
        GAS v2u* o8 = (GAS v2u*)(XN + (size_t)m * D) + c;
        f32x4 ga = (f32x4){0.f, 0.f, 0.f, 0.f};
#pragma unroll
        for (int k = 0; k < 16; ++k) { const f32x4 w0 = WG[(k * 4 + 0) * 16 + c], w1 = WG[(k * 4 + 1) * 16 + c], w2 = WG[(k * 4 + 2) * 16 + c], w3 = WG[(k * 4 + 3) * 16 + c];
            if (NORMFOLD) v[k] = v[k] * rstd; else { const f32x4 gk = GL[k * 16 + c]; v[k] = v[k] * rstd * gk; } if (!NORMFOLD) { v2u w; w.x = pk2(v[k].x, v[k].y); w.y = pk2(v[k].z, v[k].w); o8[16 * k] = w; }
            ga += w0 * v[k].x; ga += w1 * v[k].y; ga += w2 * v[k].z; ga += w3 * v[k].w; }
        float gl[4];
#pragma unroll
        for (int q = 0; q < 4; ++q) gl[q] = row_sum16(ga[q]) + brg[q];
        int gt = 0; float gm = gl[0];
#pragma unroll
        for (int q = 1; q < 4; ++q) if (gl[q] > gm) { gm = gl[q]; gt = q; }
        float gden = 0.f;
#pragma unroll
        for (int q = 0; q < 4; ++q) gden += expf(gl[q] - gm);
        const float p_top = 1.0f / gden;
        f32x4 a0 = (f32x4){0.f, 0.f, 0.f, 0.f}, a1 = a0;
        const LAS f32x4* we = WE + (gt * 16) * 8 * 16 + c;
        f32x4 wb[2][8];
#pragma unroll
        for (int q = 0; q < 8; ++q) wb[0][q] = we[q * 16];
#pragma unroll
        for (int k = 0; k < 16; ++k) {
            if (k < 15) {
#pragma unroll
                for (int q = 0; q < 8; ++q) wb[(k + 1) & 1][q] = we[((k + 1) * 8 + q) * 16]; }
            __builtin_amdgcn_sched_barrier(0);
            a0 += wb[k & 1][0] * v[k].x; a1 += wb[k & 1][1] * v[k].x;
            a0 += wb[k & 1][2] * v[k].y; a1 += wb[k & 1][3] * v[k].y;
            a0 += wb[k & 1][4] * v[k].z; a1 += wb[k & 1][5] * v[k].z;
            a0 += wb[k & 1][6] * v[k].w; a1 += wb[k & 1][7] * v[k].w;
            __builtin_amdgcn_sched_barrier(0); }
        const f32x4 bl0 = *(const LAS f32x4*)(F.lds + BRE_OFF + gt * 32), bl1 = *(const LAS f32x4*)(F.lds + BRE_OFF + gt * 32 + 16);
        float el[8];
#pragma unroll
        for (int q = 0; q < 4; ++q) { el[q] = row_sum16(a0[q]) + bl0[q]; el[4 + q] = row_sum16(a1[q]) + bl1[q]; }
        int i1 = 0; float m1 = el[0];
#pragma unroll
        for (int q = 1; q < 8; ++q) if (el[q] > m1) { m1 = el[q]; i1 = q; }
        int i2 = -1; float m2 = -3.0e38f;
#pragma unroll
        for (int q = 0; q < 8; ++q) if (q != i1 && el[q] > m2) { m2 = el[q]; i2 = q; }
        const float q1 = 1.0f, q2 = expf(m2 - m1);
        const float wn1 = p_top * q1 / (q1 + q2), wn2 = p_top * q2 / (q1 + q2);
        if (c == 0) {
            pe1 = gt * 8 + i1; pe2 = gt * 8 + i2; pw1 = wn1; pw2 = wn2; pm = m; prs = rstd;
            pr1 = __hip_atomic_fetch_add((LAS int*)hist + pe1, 1, __ATOMIC_RELAXED, __HIP_MEMORY_SCOPE_WORKGROUP);
            pr2 = __hip_atomic_fetch_add((LAS int*)hist + pe2, 1, __ATOMIC_RELAXED, __HIP_MEMORY_SCOPE_WORKGROUP);
        }
    }
    if (c == 0 && pm >= 0) { tok_e[2 * pm] = pe1; tok_e[2 * pm + 1] = pe2; tok_w[2 * pm] = pw1; tok_w[2 * pm + 1] = pw2; tok_r[2 * pm] = pr1; tok_r[2 * pm + 1] = pr2; if (NORMFOLD) rsf[pm] = prs; }
    __syncthreads();
    if (F.tid < 32) ((int*)(F.ws + WS_WGCNT))[blockIdx.x * 32 + F.tid] = hist[F.tid];
}
#endif
__device__ __forceinline__ void phase_dispatch(Frame& F) {
    const int gw = F.vcu * NWAVES + F.wave, NGW = F.G * NWAVES, lane = F.lane;
    volatile LAS int* sbase = (volatile LAS int*)(F.lds + SBASE_OFF); volatile LAS int* stot = (volatile LAS int*)(F.lds + STOT_OFF);
    const int* wgcnt = (const int*)(F.ws + WS_WGCNT); int* meta = (int*)(F.ws + WS_META);
    {
        volatile LAS int* part = (volatile LAS int*)(F.lds + RING_OFF);
        const int e = F.tid & 31, sl = F.tid >> 5; int tot = 0, base = 0;
        for (int w = sl; w < F.G; w += 16) { const int c = wgcnt[w * 32 + e]; tot += c; if (w < (int)blockIdx.x) base += c; }
        part[sl * 32 + e] = tot; part[512 + sl * 32 + e] = base;
        __syncthreads();
        if (F.tid < 32) { int t2 = 0, b2 = 0;
#pragma unroll
            for (int k = 0; k < 16; ++k) { t2 += part[k * 32 + F.tid]; b2 += part[512 + k * 32 + F.tid]; }
            stot[F.tid] = t2; sbase[F.tid] = b2; } }
    __syncthreads();
    if (F.tid == 0) { int run = 0, nrt = 0;
        for (int e = 0; e < NEXP; ++e) { const int nt = (stot[e] + 255) >> 8; sbase[e] = sbase[e] + run;
            if (blockIdx.x == 0) for (int k = 0; k < nt; ++k) meta[1 + nrt + k] = e;
            nrt += nt; run += nt * 256; }
        if (blockIdx.x == 0) meta[0] = nrt; }
    __syncthreads();
    const int* tok_e = (const int*)(F.ws + WS_TOKE); const int* tok_r = (const int*)(F.ws + WS_TOKR); int* tok_p = (int*)(F.ws + WS_TOKP);
    int* stok = (int*)(F.ws + WS_STOK);
    if (F.tid < T / F.G) {
#if ROUTE4
        const int m = 4 * ((F.tid >> 5) * NGW + F.vcu * NWAVES + ((F.tid >> 2) & 7)) + (F.tid & 3);
#else
        const int m = (F.tid >> 3) * NGW + F.vcu * NWAVES + (F.tid & 7);
#endif
        const int e1 = VLD(tok_e + 2 * m), e2 = VLD(tok_e + 2 * m + 1);
        const int p1 = sbase[e1] + VLD(tok_r + 2 * m), p2 = sbase[e2] + VLD(tok_r + 2 * m + 1);
        tok_p[2 * m] = p1; tok_p[2 * m + 1] = p2; stok[p1] = m; stok[p2] = m;
        if (NORMFOLD) { const float rr = VLD((const float*)(F.ws + WS_RSF) + m); float* rss = (float*)(F.ws + WS_RSS); rss[p1] = rr; rss[p2] = rr; } }
    (void)gw; (void)lane;
}
__device__ __forceinline__ void phase_combine(Frame& F, const float* g, bool last, const void* xsrc, void* xdst) {
    const int gw = F.vcu * NWAVES + F.wave, NGW = F.G * NWAVES, lane = F.lane;
    const int* tok_p = (const int*)(F.ws + WS_TOKP); const float* tok_w = (const float*)(F.ws + WS_TOKW);
    const bf16* Y = (const bf16*)(F.ws + WS_XP); bf16* XN = (bf16*)(F.ws + WS_XN);
#if XBF16
    typedef v2u xraw_t; const bf16* X = (const bf16*)xsrc;
#define PC_CVT(w_) ((f32x4){bflo((w_).x), bfhi((w_).x), bflo((w_).y), bfhi((w_).y)})
#else
    typedef f32x4 xraw_t; const float* X = (const float*)xsrc;
#define PC_CVT(w_) (w_)
#endif
    f32x4 gv[4];
#pragma unroll
    for (int j = 0; j < 4; ++j) gv[j] = *(const f32x4*)(g + 4 * lane + 256 * j);
    float cw1, cw2, dw1 = 0.f, dw2 = 0.f; xraw_t xn_[4], xm_[4]; v2u ya_[4], yb_[4], yc_[4], yd_[4];
    { const int p1 = VLD(tok_p + 2 * gw), p2 = VLD(tok_p + 2 * gw + 1); cw1 = VLD(tok_w + 2 * gw); cw2 = VLD(tok_w + 2 * gw + 1);
      const GAS xraw_t* xr = (const GAS xraw_t*)(X + (size_t)gw * D) + lane; const GAS v2u* y1 = (const GAS v2u*)(Y + (size_t)p1 * D) + lane; const GAS v2u* y2 = (const GAS v2u*)(Y + (size_t)p2 * D) + lane;
#pragma unroll
      for (int j = 0; j < 4; ++j) { xn_[j] = xr[64 * j]; ya_[j] = y1[64 * j]; yb_[j] = y2[64 * j]; } }
    if (gw + NGW < T) { const int mn = gw + NGW; const int p1 = VLD(tok_p + 2 * mn), p2 = VLD(tok_p + 2 * mn + 1); dw1 = VLD(tok_w + 2 * mn); dw2 = VLD(tok_w + 2 * mn + 1);
      const GAS xraw_t* xr = (const GAS xraw_t*)(X + (size_t)mn * D) + lane; const GAS v2u* y1 = (const GAS v2u*)(Y + (size_t)p1 * D) + lane; const GAS v2u* y2 = (const GAS v2u*)(Y + (size_t)p2 * D) + lane;
#pragma unroll
      for (int j = 0; j < 4; ++j) { xm_[j] = xr[64 * j]; yc_[j] = y1[64 * j]; yd_[j] = y2[64 * j]; } }
    int tp1 = 0, tp2 = 0; float tw1 = 0.f, tw2 = 0.f;
    if (gw + 2 * NGW < T) { const int mn = gw + 2 * NGW; tp1 = VLD(tok_p + 2 * mn); tp2 = VLD(tok_p + 2 * mn + 1); tw1 = VLD(tok_w + 2 * mn); tw2 = VLD(tok_w + 2 * mn + 1); }
    float prsd = 0.f; f32x4 po[4]; v2u pox[4], pon[4]; int pm = -1;
#pragma unroll
    for (int j = 0; j < 4; ++j) { po[j] = (f32x4){0.f, 0.f, 0.f, 0.f}; pox[j] = (v2u){0u, 0u}; pon[j] = (v2u){0u, 0u}; }
#if XBF16
#define PC_FLUSH() do { if (pm >= 0) { if (last) { GAS f32x4* xr_ = (GAS f32x4*)(F.out + (size_t)pm * D) + lane; _Pragma("unroll") for (int j = 0; j < 4; ++j) xr_[64 * j] = po[j]; } \
        else { GAS v2u* o8_ = (GAS v2u*)(XN + (size_t)pm * D) + lane; GAS v2u* xo_ = (GAS v2u*)((bf16*)xdst + (size_t)pm * D) + lane; _Pragma("unroll") for (int j = 0; j < 4; ++j) { xo_[64 * j] = pox[j]; if (!NORMFOLD) o8_[64 * j] = pon[j]; } \
            if (NORMFOLD && lane == 0) ((float*)(F.ws + WS_RSA))[pm] = prsd; } } } while (0)
#else
#define PC_FLUSH() do { if (pm >= 0) { if (last) { GAS f32x4* xr_ = (GAS f32x4*)(F.out + (size_t)pm * D) + lane; _Pragma("unroll") for (int j = 0; j < 4; ++j) xr_[64 * j] = po[j]; } \
        else { GAS v2u* o8_ = (GAS v2u*)(XN + (size_t)pm * D) + lane; GAS f32x4* xo_ = (GAS f32x4*)((float*)xdst + (size_t)pm * D) + lane; _Pragma("unroll") for (int j = 0; j < 4; ++j) { xo_[64 * j] = po[j]; o8_[64 * j] = pon[j]; } } } } while (0)
#endif
    for (int m = gw; m < T; m += NGW) {
        const float w1 = cw1, w2 = cw2;
        f32x4 v[4]; float s = 0.f;
#pragma unroll
        for (int j = 0; j < 4; ++j) { const v2u a = ya_[j], b = yb_[j];
            const f32x4 ya = (f32x4){bflo(a.x), bfhi(a.x), bflo(a.y), bfhi(a.y)}, yb = (f32x4){bflo(b.x), bfhi(b.x), bflo(b.y), bfhi(b.y)};
            v[j] = PC_CVT(xn_[j]) + (ya * w1 + yb * w2);
            s += (v[j].x * v[j].x + v[j].y * v[j].y) + (v[j].z * v[j].z + v[j].w * v[j].w);
            xn_[j] = xm_[j]; ya_[j] = yc_[j]; yb_[j] = yd_[j]; }
        cw1 = dw1; cw2 = dw2; dw1 = tw1; dw2 = tw2;
        if (m + 2 * NGW < T) { const int mn = m + 2 * NGW;
            const GAS xraw_t* xq = (const GAS xraw_t*)(X + (size_t)mn * D) + lane; const GAS v2u* y1 = (const GAS v2u*)(Y + (size_t)tp1 * D) + lane; const GAS v2u* y2 = (const GAS v2u*)(Y + (size_t)tp2 * D) + lane;
#pragma unroll
            for (int j = 0; j < 4; ++j) { xm_[j] = xq[64 * j]; yc_[j] = y1[64 * j]; yd_[j] = y2[64 * j]; } }
        if (m + 3 * NGW < T) { const int mn = m + 3 * NGW; tp1 = VLD(tok_p + 2 * mn); tp2 = VLD(tok_p + 2 * mn + 1); tw1 = VLD(tok_w + 2 * mn); tw2 = VLD(tok_w + 2 * mn + 1); }
        PC_FLUSH();
        const float rstd = 1.0f / sqrtf(wave_sum(s) * (1.f / D) + NORM_EPS);
        pm = m;
        if (last) {
#pragma unroll
            for (int j = 0; j < 4; ++j) po[j] = v[j] * rstd * gv[j];
        } else {
            if (NORMFOLD) prsd = rstd;
#pragma unroll
            for (int j = 0; j < 4; ++j) { const f32x4 y = v[j] * rstd * gv[j]; pon[j].x = pk2(y.x, y.y); pon[j].y = pk2(y.z, y.w);
#if XBF16
                pox[j].x = pk2(v[j].x, v[j].y); pox[j].y = pk2(v[j].z, v[j].w);
#else
                po[j] = v[j];
#endif
            }
        }
    }
    PC_FLUSH();
#undef PC_FLUSH
#undef PC_CVT
}

#if defined(__HIP_DEVICE_COMPILE__)
typedef float f32x4v __attribute__((ext_vector_type(4)));
typedef short v4i16_t __attribute__((ext_vector_type(4)));
__device__ __forceinline__ f32x4 mfma16(const bf16x8& a, const bf16x8& b, const f32x4& c) { return __builtin_amdgcn_mfma_f32_16x16x32_bf16(a, b, c, 0, 0, 0); }
__device__ __forceinline__ s16x4 tr_read(const LAS unsigned char* p) { return __builtin_bit_cast(s16x4, __builtin_amdgcn_ds_read_tr16_b64_v4i16((LAS v4i16_t*)p)); }
__device__ __forceinline__ bf16x8 join8(const s16x4& a, const s16x4& b) { bf16x8 r; r[0] = a[0]; r[1] = a[1]; r[2] = a[2]; r[3] = a[3]; r[4] = b[0]; r[5] = b[1]; r[6] = b[2]; r[7] = b[3]; return r; }
__device__ __forceinline__ bf16x8 pack_frag(const float (&v)[8]) { v4u w; w.x = cvt_pk_bf16(v[0], v[1]); w.y = cvt_pk_bf16(v[2], v[3]); w.z = cvt_pk_bf16(v[4], v[5]); w.w = cvt_pk_bf16(v[6], v[7]); return __builtin_bit_cast(bf16x8, w); }
template <int N> __device__ __forceinline__ float dpp_shr_t(float v) { return __builtin_bit_cast(float, __builtin_amdgcn_update_dpp(0, __builtin_bit_cast(int, v), 0x110 + N, 0xf, 0xf, true)); }
template <int N> __device__ __forceinline__ float dpp_ror_t(float v) { return __builtin_bit_cast(float, __builtin_amdgcn_update_dpp(0, __builtin_bit_cast(int, v), 0x120 + N, 0xf, 0xf, false)); }
__device__ __forceinline__ float rowsum16(float v) { v += dpp_ror_t<8>(v); v += dpp_ror_t<4>(v); v += dpp_ror_t<2>(v); v += dpp_ror_t<1>(v); return v; }
__device__ __forceinline__ float scan16(float v) { v += dpp_shr_t<1>(v); v += dpp_shr_t<2>(v); v += dpp_shr_t<4>(v); v += dpp_shr_t<8>(v); return v; }

constexpr int AT_PITCH = 160;
constexpr int AT_KOFF = 0, AT_VOFF = 384 * AT_PITCH;
__device__ __forceinline__ void attn_stage_load(Frame& F, int unit, v4u (&st)[12]) {
    const int b = unit >> 8, kvh = (unit >> 7) & 1, Q0 = (unit & 127) * 128; const bf16* PA = (const bf16*)(F.ws + WS_PA);
#pragma unroll
    for (int k = 0; k < 12; ++k) { const int idx = F.tid + 512 * k, kv = idx / (384 * 8), r = (idx >> 3) % 384, ch = idx & 7, key = Q0 - 128 + r;
        st[k] = (v4u){0u, 0u, 0u, 0u};
        if (key >= 0 && key < SEQ) st[k] = *(const GAS v4u*)(PA + (size_t)(b * SEQ + key) * NPA + (kv ? C_VA : C_KA) + 64 * kvh + 8 * ch); }
}
__device__ __forceinline__ void attn_stage_write(Frame& F, const v4u (&st)[12]) {
    LAS unsigned char* lds = F.lds + RING_OFF;
#pragma unroll
    for (int k = 0; k < 12; ++k) { const int idx = F.tid + 512 * k, kv = idx / (384 * 8), r = (idx >> 3) % 384, ch = idx & 7;
        *(LAS v4u*)(lds + (kv ? AT_VOFF : AT_KOFF) + r * AT_PITCH + ch * 16) = st[k]; }
}
__device__ __forceinline__ void attn_unit(Frame& F, int unit, int next_unit, v4u (&st)[12], const float* sink) {
    const int b = unit >> 8, kvh = (unit >> 7) & 1, qb = unit & 127, Q0 = qb * 128;
    const bf16* PA = (const bf16*)(F.ws + WS_PA); bf16* YA = (bf16*)(F.ws + WS_Y);
    LAS unsigned char* lds = F.lds + RING_OFF;
    attn_stage_write(F, st);
    __syncthreads();
    const int lane = F.lane, w = F.wave, fr = lane & 15, g = lane >> 4, qh = 4 * kvh + (w >> 1);
    const float sk = sink[qh] * LOG2E;
    const bool edge = (qb == 0) || (qb == SEQ / 128 - 1);
    static_assert(WINDOW == 128, "interior-tile test below");
    bf16x8 qn0, qn1;
    { const bf16* qp = PA + (size_t)(b * SEQ + Q0 + 64 * (w & 1) + fr) * NPA + C_QA + 64 * qh + 8 * g; qn0 = *(const GAS bf16x8*)qp; qn1 = *(const GAS bf16x8*)(qp + 32); }
    if (next_unit >= 0) attn_stage_load(F, next_unit, st);
    v2u py[4]; bf16* pyp = YA;
#pragma unroll
    for (int dt = 0; dt < 4; ++dt) py[dt] = (v2u){0u, 0u};
    for (int qbk = 0; qbk < 4; ++qbk) {
        const int qrel = 64 * (w & 1) + 16 * qbk, q = Q0 + qrel + fr;
        const bf16x8 qf0 = qn0, qf1 = qn1;
        f32x4 s[17]; float mx = sk;
#pragma unroll
        for (int t = 0; t < 17; ++t) { const int krel = qrel + 16 * t;
            const LAS unsigned char* kp = lds + AT_KOFF + (krel + fr) * AT_PITCH + g * 16;
            f32x4 a = (f32x4){0.f, 0.f, 0.f, 0.f};
            a = mfma16(*(const LAS bf16x8*)kp, qf0, a); a = mfma16(*(const LAS bf16x8*)(kp + 64), qf1, a);
            s[t] = a; }
#define AT_MASK(t) do { _Pragma("unroll") for (int r = 0; r < 4; ++r) { const int key = Q0 - 128 + qrel + 16 * (t) + 4 * g + r; const int dlt = key - q; \
            const bool ok = (dlt >= -WINDOW) && (dlt <= WINDOW) && (key >= 0) && (key < SEQ); s[t][r] = ok ? s[t][r] : -3.0e38f; } } while (0)
        if (edge) {
#pragma unroll
            for (int t = 0; t < 17; ++t) AT_MASK(t);
        } else { AT_MASK(0); AT_MASK(16); }
#undef AT_MASK
#pragma unroll
        for (int t = 0; t < 17; ++t) mx = fmaxf(fmaxf(mx, fmaxf(s[t][0], s[t][1])), fmaxf(s[t][2], s[t][3]));
        __builtin_amdgcn_sched_barrier(0);
        if (qbk < 3) { const bf16* qp = PA + (size_t)(b * SEQ + q + 16) * NPA + C_QA + 64 * qh + 8 * g; qn0 = *(const GAS bf16x8*)qp; qn1 = *(const GAS bf16x8*)(qp + 32); }
        if (qbk > 0) {
#pragma unroll
            for (int dt = 0; dt < 4; ++dt) *(GAS v2u*)(pyp + 16 * dt) = py[dt]; }
        __builtin_amdgcn_sched_barrier(0);
        mx = fmaxf(mx, __shfl_xor(mx, 16)); mx = fmaxf(mx, __shfl_xor(mx, 32));
        float den = 0.f;
#pragma unroll
        for (int t = 0; t < 17; ++t)
#pragma unroll
            for (int r = 0; r < 4; ++r) { const float p = __builtin_amdgcn_exp2f(s[t][r] - mx); s[t][r] = p; den += p; }
        den += __shfl_xor(den, 16); den += __shfl_xor(den, 32); den += __builtin_amdgcn_exp2f(sk - mx);
        const float inv = 1.0f / den;
        f32x4 o[4];
#pragma unroll
        for (int dt = 0; dt < 4; ++dt) o[dt] = (f32x4){0.f, 0.f, 0.f, 0.f};
#pragma unroll
        for (int tp = 0; tp < 9; ++tp) { const int t0 = 2 * tp, t1 = (2 * tp + 1 < 17) ? 2 * tp + 1 : 2 * tp;
            float pv[8];
#pragma unroll
            for (int r = 0; r < 4; ++r) { pv[r] = s[t0][r]; pv[4 + r] = (2 * tp + 1 < 17) ? s[t1][r] : 0.f; }
            const bf16x8 pf = pack_frag(pv);
            const LAS unsigned char* v0 = lds + AT_VOFF + (qrel + 16 * t0 + 4 * g + (fr >> 2)) * AT_PITCH + (fr & 3) * 8;
            const LAS unsigned char* v1 = lds + AT_VOFF + (qrel + 16 * t1 + 4 * g + (fr >> 2)) * AT_PITCH + (fr & 3) * 8;
#pragma unroll
            for (int dt = 0; dt < 4; ++dt) o[dt] = mfma16(join8(tr_read(v0 + dt * 32), tr_read(v1 + dt * 32)), pf, o[dt]); }
        pyp = YA + (size_t)(b * SEQ + q) * 512 + 64 * qh + 4 * g;
#pragma unroll
        for (int dt = 0; dt < 4; ++dt) { py[dt].x = cvt_pk_bf16(o[dt][0] * inv, o[dt][1] * inv); py[dt].y = cvt_pk_bf16(o[dt][2] * inv, o[dt][3] * inv); }
    }
#pragma unroll
    for (int dt = 0; dt < 4; ++dt) *(GAS v2u*)(pyp + 16 * dt) = py[dt];
    __syncthreads();
}
constexpr int HG_PITCH = 288;
constexpr int HG_V = 0, HG_KF = 128 * HG_PITCH, HG_KB = 2 * 128 * HG_PITCH, HG_TOT = 3 * 128 * HG_PITCH;
static_assert(HG_TOT + (4 * 8 * 128 + 256) * 4 <= RING_BYTES, "hgrn LDS");
__device__ __forceinline__ void hg_load_scan8(const bf16* p8  , float (&lf)[8], float (&P)[8], float (&T)[8], int lane) {
    const h16x8 hv = *(const GAS h16x8*)p8;
#pragma unroll
    for (int jj = 0; jj < 8; ++jj) { lf[jj] = (float)hv[jj]; P[jj] = scan16(lf[jj]); T[jj] = __shfl(P[jj], (lane & 48) | 15); }
}
__device__ __forceinline__ void hg_v_load(Frame& F, int b, int h, int t0, v4u (&vst)[4]) { const bf16* PA = (const bf16*)(F.ws + WS_PA);
#pragma unroll
    for (int k = 0; k < 4; ++k) { const int idx = F.tid + 512 * k, r = idx >> 4, ch = idx & 15; vst[k] = *(const GAS v4u*)(PA + (size_t)(b * SEQ + t0 + r) * NPA + C_VH + 128 * h + 8 * ch); } }
__device__ __forceinline__ void hg_v_write(Frame& F, const v4u (&vst)[4]) { LAS unsigned char* lds = F.lds + RING_OFF;
#pragma unroll
    for (int k = 0; k < 4; ++k) { const int idx = F.tid + 512 * k, r = idx >> 4, ch = idx & 15; *(LAS v4u*)(lds + HG_V + r * HG_PITCH + ch * 16) = vst[k]; } }
__device__ __forceinline__ void ha_decay_load(Frame& F, int unit, h16x8 (&hvv)[8]) {
    const int bh = unit >> 7, n = unit & 127, b = bh >> 2, h = bh & 3, t0 = n * CH, lane = F.lane, w = F.wave, fr = lane & 15, g = lane >> 4, dir = w >> 2, dq = w & 3;
    const bf16* lp = (const bf16*)(F.ws + WS_PA) + (size_t)(b * SEQ + t0 + fr) * NPA + (dir ? C_LB : C_LF) + 128 * h + 32 * dq + 8 * g;
#pragma unroll
    for (int k = 0; k < 8; ++k) { const int j = dir ? k : (7 - k); hvv[k] = *(const GAS h16x8*)(lp + (size_t)(16 * j) * NPA); }
}
__device__ __forceinline__ void ha_unit(Frame& F, int unit, int next_unit, v4u (&vst)[4], h16x8 (&hvv)[8]) {
    const int bh = unit >> 7, n = unit & 127, b = bh >> 2, h = bh & 3, t0 = n * CH;
    const bf16* PA = (const bf16*)(F.ws + WS_PA); bf16* US = (bf16*)(F.ws + WS_US); float* HD = (float*)(F.ws + WS_HD);
    LAS unsigned char* lds = F.lds + RING_OFF;
    const int lane = F.lane, w = F.wave, fr = lane & 15, g = lane >> 4, dir = w >> 2, dq = w & 3;
    hg_v_write(F, vst);
    if (next_unit >= 0) { const int bh2 = next_unit >> 7; hg_v_load(F, bh2 >> 2, bh2 & 3, (next_unit & 127) * CH, vst); }
    float run[8];
#pragma unroll
    for (int jj = 0; jj < 8; ++jj) run[jj] = 0.f;
    __builtin_amdgcn_sched_barrier(0);
#pragma unroll
    for (int k = 0; k < 8; ++k) { const int j = dir ? k : (7 - k);
        float kv[8];
#pragma unroll
        for (int jj = 0; jj < 8; ++jj) { const float lf = (float)hvv[k][jj], P = scan16(lf), Tt = __shfl(P, (lane & 48) | 15);
            const float wi = dir ? (P - lf) : (Tt - P); kv[jj] = (1.0f - __builtin_amdgcn_exp2f(lf)) * __builtin_amdgcn_exp2f(wi + run[jj]); run[jj] += Tt; }
        *(LAS bf16x8*)(lds + (dir ? HG_KB : HG_KF) + (16 * j + fr) * HG_PITCH + (32 * dq + 8 * g) * 2) = pack_frag(kv); }
    __builtin_amdgcn_sched_barrier(0);
    if (next_unit >= 0) ha_decay_load(F, next_unit, hvv);
    __builtin_amdgcn_sched_barrier(0);
    if (fr == 0) {
#pragma unroll
        for (int jj = 0; jj < 8; ++jj) HD[((size_t)(bh * 2 + dir) * NCH + n) * 128 + 32 * dq + 8 * g + jj] = __builtin_amdgcn_exp2f(run[jj]); }
    __syncthreads();
    f32x4 acc[2][8];
#pragma unroll
    for (int mt = 0; mt < 2; ++mt)
#pragma unroll
        for (int nt = 0; nt < 8; ++nt) acc[mt][nt] = (f32x4){0.f, 0.f, 0.f, 0.f};
    const LAS unsigned char* kb = lds + (dir ? HG_KB : HG_KF) + (4 * g + (fr >> 2)) * HG_PITCH + (fr & 3) * 8;
    const LAS unsigned char* vb = lds + HG_V + (4 * g + (fr >> 2)) * HG_PITCH + (fr & 3) * 8;
#pragma unroll
    for (int ks = 0; ks < 4; ++ks) { bf16x8 af[2];
#pragma unroll
        for (int mt = 0; mt < 2; ++mt) { const LAS unsigned char* p = kb + (32 * ks) * HG_PITCH + (16 * (2 * dq + mt)) * 2; af[mt] = join8(tr_read(p), tr_read(p + 16 * HG_PITCH)); }
#pragma unroll
        for (int nt = 0; nt < 8; ++nt) { const LAS unsigned char* p = vb + (32 * ks) * HG_PITCH + (16 * nt) * 2; const bf16x8 bfr = join8(tr_read(p), tr_read(p + 16 * HG_PITCH));
#pragma unroll
            for (int mt = 0; mt < 2; ++mt) acc[mt][nt] = mfma16(af[mt], bfr, acc[mt][nt]); } }
    bf16* up = US + ((size_t)(bh * 2 + dir) * NCH + n) * 128 * 128;
#pragma unroll
    for (int mt = 0; mt < 2; ++mt)
#pragma unroll
        for (int nt = 0; nt < 8; ++nt) { v2u wv; wv.x = cvt_pk_bf16(acc[mt][nt][0], acc[mt][nt][1]); wv.y = cvt_pk_bf16(acc[mt][nt][2], acc[mt][nt][3]);
            *(GAS v2u*)(up + (size_t)(16 * nt + fr) * 128 + 16 * (2 * dq + mt) + 4 * g) = wv; }
    __syncthreads();
}
#if G1A_SPLIT
__device__ __forceinline__ void phase_hb(Frame& F, int v, int g) {
    bf16* US = (bf16*)(F.ws + WS_US); const float* HD = (const float*)(F.ws + WS_HD);
    const int stride = g * NWAVES * 64, TOT = 16 * 128 * 64;
    for (int ea = v * (NWAVES * 64) + F.tid; ea < TOT; ea += 2 * stride) {
        const bool two = G1A_SPLIT && (ea + stride < TOT); const int eb = two ? ea + stride : ea;
        const int dpa = ea & 63, ca = ea >> 13, dira = ca & 1, dpb = eb & 63, cb = eb >> 13, dirb = cb & 1;
        float a0 = 0.f, a1 = 0.f, b0 = 0.f, b1 = 0.f;
        GAS unsigned* upa = (GAS unsigned*)(US + (size_t)ca * NCH * 128 * 128 + (size_t)((ea >> 6) & 127) * 128) + dpa; const GAS pg8::f32x2_t* dda = (const GAS pg8::f32x2_t*)((const GAS float*)HD + (size_t)ca * NCH * 128) + dpa;
        GAS unsigned* upb = (GAS unsigned*)(US + (size_t)cb * NCH * 128 * 128 + (size_t)((eb >> 6) & 127) * 128) + dpb; const GAS pg8::f32x2_t* ddb = (const GAS pg8::f32x2_t*)((const GAS float*)HD + (size_t)cb * NCH * 128) + dpb;
        for (int k0 = 0; k0 < NCH; k0 += 16) {
            unsigned ua[16], ub[16]; pg8::f32x2_t da[16], db[16];
#pragma unroll
            for (int k = 0; k < 16; ++k) { const int na = dira ? (NCH - 1 - (k0 + k)) : (k0 + k), nb = dirb ? (NCH - 1 - (k0 + k)) : (k0 + k);
                ua[k] = upa[(size_t)na * (128 * 128 / 2)]; da[k] = dda[na * 64]; ub[k] = upb[(size_t)nb * (128 * 128 / 2)]; db[k] = ddb[nb * 64]; }
#pragma unroll
            for (int k = 0; k < 16; ++k) { const int na = dira ? (NCH - 1 - (k0 + k)) : (k0 + k), nb = dirb ? (NCH - 1 - (k0 + k)) : (k0 + k);
                upa[(size_t)na * (128 * 128 / 2)] = pk2(a0, a1);
                a0 = da[k].x * a0 + bflo(ua[k]); a1 = da[k].y * a1 + bfhi(ua[k]);
                if (two) upb[(size_t)nb * (128 * 128 / 2)] = pk2(b0, b1);
                b0 = db[k].x * b0 + bflo(ub[k]); b1 = db[k].y * b1 + bfhi(ub[k]); } }
    }
}
#else
__device__ __forceinline__ void phase_hb(Frame& F, int v, int g) {
    bf16* US = (bf16*)(F.ws + WS_US); const float* HD = (const float*)(F.ws + WS_HD);
    const int idx = v * (NWAVES * 64) + F.tid;
    for (int e0 = idx; e0 < 16 * 128 * 64; e0 += g * NWAVES * 64) { const int dp = e0 & 63, e = (e0 >> 6) & 127, combo = e0 >> 13, dir = combo & 1;
        float s0 = 0.f, s1 = 0.f;
        GAS unsigned* up = (GAS unsigned*)(US + (size_t)combo * NCH * 128 * 128 + (size_t)e * 128) + dp; const GAS float* dpp = (const GAS float*)HD + (size_t)combo * NCH * 128 + 2 * dp;
        for (int k0 = 0; k0 < NCH; k0 += 16) {
            unsigned u[16]; float d0[16], d1[16];
#pragma unroll
            for (int k = 0; k < 16; ++k) { const int n = dir ? (NCH - 1 - (k0 + k)) : (k0 + k); u[k] = up[(size_t)n * (128 * 128 / 2)]; d0[k] = dpp[n * 128]; d1[k] = dpp[n * 128 + 1]; }
#pragma unroll
            for (int k = 0; k < 16; ++k) { const int n = dir ? (NCH - 1 - (k0 + k)) : (k0 + k);
                up[(size_t)n * (128 * 128 / 2)] = pk2(s0, s1);
                s0 = d0[k] * s0 + bflo(u[k]); s1 = d1[k] * s1 + bfhi(u[k]); } }
    }
}
#endif
constexpr int HC_SPITCH = 272;
constexpr int HC_K = 128 * HG_PITCH, HC_S = 2 * 128 * HG_PITCH, HC_E = HC_S + 128 * HC_SPITCH;
static_assert(HC_E + 2 * 8 * 128 * 4 <= RING_BYTES, "hc LDS");
#ifndef HC_TERMS
#define HC_TERMS 7
#endif
__device__ __forceinline__ void hc_unit(Frame& F, int unit, int next_unit, v4u (&vst)[4], const float* hng) {
    const int h = unit & 3, n = (unit >> 2) & 127, b = unit >> 9, bh = b * 4 + h, t0 = n * CH;
    const bf16* PA = (const bf16*)(F.ws + WS_PA); const bf16* US = (const bf16*)(F.ws + WS_US); bf16* YH = (bf16*)(F.ws + WS_YH); float* ssq = (float*)(F.ws + WS_SSQ);
    LAS unsigned char* lds = F.lds + RING_OFF; LAS float* ebl = (LAS float*)(lds + HC_E);
    const int lane = F.lane, i = F.wave, fr = lane & 15, g = lane >> 4;
    const size_t trow = (size_t)(b * SEQ + t0 + 16 * i + fr);
    hg_v_write(F, vst);
    if (next_unit >= 0) hg_v_load(F, next_unit >> 9, next_unit & 3, ((next_unit >> 2) & 127) * CH, vst);
    const bf16* sbase0 = US + ((size_t)(bh * 2) * NCH + n) * 128 * 128;
    v4u sreg[4];
#pragma unroll
    for (int k = 0; k < 4; ++k) { const int c = F.tid + 512 * k; sreg[k] = *(const GAS v4u*)(sbase0 + (size_t)(c >> 4) * 128 + (c & 15) * 8); }
    h16x8 lfv[2][4]; v4u qwv[4];
#pragma unroll
    for (int ks = 0; ks < 4; ++ks) { lfv[0][ks] = *(const GAS h16x8*)(PA + trow * NPA + C_LF + 128 * h + 32 * ks + 8 * g); qwv[ks] = *(const GAS v4u*)(PA + trow * NPA + C_QH + 128 * h + 32 * ks + 8 * g); }
#pragma unroll
    for (int ks = 0; ks < 4; ++ks) lfv[1][ks] = *(const GAS h16x8*)(PA + trow * NPA + C_LB + 128 * h + 32 * ks + 8 * g);
    __builtin_amdgcn_sched_barrier(0);
    f32x4 o[8];
#pragma unroll
    for (int et = 0; et < 8; ++et) o[et] = (f32x4){0.f, 0.f, 0.f, 0.f};
    const LAS unsigned char* vtr = lds + HG_V + (4 * g + (fr >> 2)) * HG_PITCH + (fr & 3) * 8;
#pragma unroll
    for (int dir = 0; dir < 2; ++dir) {
        if (dir == 1) __syncthreads();
#pragma unroll
        for (int k = 0; k < 4; ++k) { const int c = F.tid + 512 * k; *(LAS v4u*)(lds + HC_S + (c >> 4) * HC_SPITCH + (c & 15) * 16) = sreg[k]; }
        float ql[32]; bf16x8 kst[4]; bf16x8 qf[4];
#pragma unroll
        for (int ks = 0; ks < 4; ++ks) { float lf[8], P[8], T[8], ke[8], kd[8], t8[8], et_[8];
            { const h16x8 hv = lfv[dir][ks];
#pragma unroll
              for (int jj = 0; jj < 8; ++jj) { lf[jj] = (float)hv[jj]; P[jj] = scan16(lf[jj]); T[jj] = __shfl(P[jj], (lane & 48) | 15); } }
            const v4u qw = qwv[ks];
            const float qv[8] = {bflo(qw.x), bfhi(qw.x), bflo(qw.y), bfhi(qw.y), bflo(qw.z), bfhi(qw.z), bflo(qw.w), bfhi(qw.w)};
#pragma unroll
            for (int jj = 0; jj < 8; ++jj) { const float kk = 1.0f - __builtin_amdgcn_exp2f(lf[jj]);
                const float binc = dir ? (T[jj] - P[jj] + lf[jj]) : P[jj];
                const float ea = __builtin_amdgcn_exp2f(binc), ra = __builtin_amdgcn_rcpf(ea); et_[jj] = __builtin_amdgcn_exp2f(T[jj]);
                ql[8 * ks + jj] = qv[jj] * ea; t8[jj] = ql[8 * ks + jj]; ke[jj] = kk * et_[jj] * ra; kd[jj] = kk * ra;
#if defined(HC_DBG) && HC_DBG >= 3
                ql[8 * ks + jj] = qv[jj]; t8[jj] = qv[jj]; kd[jj] = kk;
                if (HC_DBG == 4) kd[jj] = (32 * ks + 8 * g + jj == 0) ? 1.0f : 0.f;
                if (HC_DBG == 5) kd[jj] = (32 * ks + 8 * g + jj == 0) ? kk : 0.f;
                if (HC_DBG >= 9) kd[jj] = 0.f;
                if (HC_DBG == 8) kd[jj] = (32 * ks + 8 * g + jj == 0) ? (float)fr : 0.f;
                if (HC_DBG == 6) kd[jj] = (32 * ks + 8 * g + jj == 0) ? lf[jj] : 0.f;
                if (HC_DBG == 7) kd[jj] = (32 * ks + 8 * g + jj == 0) ? (1.0f - __expf(lf[jj])) : 0.f;
#endif
                }
            *(LAS bf16x8*)(lds + HC_K + (16 * i + fr) * HG_PITCH + (32 * ks + 8 * g) * 2) = pack_frag(ke);
            kst[ks] = pack_frag(kd); qf[ks] = pack_frag(t8);
            if (fr == 0) {
#pragma unroll
                for (int jj = 0; jj < 8; ++jj) ebl[(dir * 8 + i) * 128 + 32 * ks + 8 * g + jj] = et_[jj]; }
            __builtin_amdgcn_sched_barrier(0); }
        __syncthreads();
        if (dir == 0) {
#pragma unroll
            for (int k = 0; k < 4; ++k) { const int c = F.tid + 512 * k; sreg[k] = *(const GAS v4u*)(sbase0 + (size_t)NCH * 128 * 128 + (size_t)(c >> 4) * 128 + (c & 15) * 8); } }
        f32x4 at = (f32x4){0.f, 0.f, 0.f, 0.f};
#pragma unroll
        for (int ks = 0; ks < 4; ++ks) at = mfma16(kst[ks], qf[ks], at);
#if defined(HC_DBG) && HC_DBG >= 9
        { const float q0 = __shfl(ql[0], fr);
          for (int r = 0; r < 4; ++r) at[r] = (HC_DBG == 9) ? (float)(4 * g + r) * q0 : ((HC_DBG == 10) ? (float)(4 * g + r) : (float)fr); }
#endif
        float pend[4]; int jpend = i;
#pragma unroll
        for (int r = 0; r < 4; ++r) { const int s = 4 * g + r; const bool keep = (HC_TERMS & 1) && (dir ? (s >= fr) : (s <= fr)); pend[r] = keep ? at[r] : 0.f;
#if defined(HC_DBG) && HC_DBG == 1
            pend[r] = (dir == 0 && s == fr) ? 1.0f : 0.f;
#endif
            }
        bool have = true;
        const int nj = dir ? (7 - i) : i;
        for (int k = 0; k < nj; ++k) { const int j = dir ? (i + 1 + k) : (i - 1 - k);
            f32x4 a2 = (f32x4){0.f, 0.f, 0.f, 0.f};
            const LAS unsigned char* kp = lds + HC_K + (16 * j + fr) * HG_PITCH + g * 16;
#pragma unroll
            for (int ks = 0; ks < 4; ++ks) a2 = mfma16(*(const LAS bf16x8*)(kp + ks * 64), qf[ks], a2);
#pragma unroll
            for (int ks = 0; ks < 4; ++ks) { const LAS float* ep = ebl + (dir * 8 + j) * 128 + 32 * ks + 8 * g; float t8[8];
#pragma unroll
                for (int jj = 0; jj < 8; ++jj) { ql[8 * ks + jj] *= ep[jj]; t8[jj] = ql[8 * ks + jj]; }
                qf[ks] = pack_frag(t8); }
            if (have) { float pv[8];
#pragma unroll
                for (int r = 0; r < 4; ++r) { pv[r] = pend[r]; pv[4 + r] = (HC_TERMS & 2) ? a2[r] : 0.f; }
                const bf16x8 pf = pack_frag(pv); const LAS unsigned char* v0 = vtr + 16 * jpend * HG_PITCH; const LAS unsigned char* v1 = vtr + 16 * j * HG_PITCH;
#pragma unroll
                for (int et = 0; et < 8; ++et) o[et] = mfma16(join8(tr_read(v0 + et * 32), tr_read(v1 + et * 32)), pf, o[et]);
                have = false;
            } else {
#pragma unroll
                for (int r = 0; r < 4; ++r) pend[r] = (HC_TERMS & 2) ? a2[r] : 0.f;
                jpend = j; have = true; }
        }
        if (have) { float pv[8];
#pragma unroll
            for (int r = 0; r < 4; ++r) { pv[r] = pend[r]; pv[4 + r] = 0.f; }
            const bf16x8 pf = pack_frag(pv); const LAS unsigned char* v0 = vtr + 16 * jpend * HG_PITCH;
#pragma unroll
            for (int et = 0; et < 8; ++et) o[et] = mfma16(join8(tr_read(v0 + et * 32), tr_read(v0 + et * 32)), pf, o[et]); }
        const LAS unsigned char* sp = lds + HC_S + fr * HC_SPITCH + g * 16;
#pragma unroll
        for (int et = 0; et < 8; ++et)
#pragma unroll
            for (int ks = 0; ks < 4; ++ks) if (HC_TERMS & 4) o[et] = mfma16(*(const LAS bf16x8*)(sp + 16 * et * HC_SPITCH + ks * 64), qf[ks], o[et]);
    }
    float sq = 0.f; bf16* yp = YH + trow * 512 + 128 * h + 4 * g; const bf16* sgp = PA + trow * NPA + C_SG + 128 * h + 4 * g; const float* gp = hng + 128 * h + 4 * g;
    v2u swv[8]; f32x4 gvv[8];
#pragma unroll
    for (int et = 0; et < 8; ++et) { swv[et] = *(const GAS v2u*)(sgp + 16 * et); gvv[et] = *(const GAS f32x4*)(gp + 16 * et); }
#pragma unroll
    for (int et = 0; et < 8; ++et) { const v2u sw = swv[et]; const f32x4 gv = gvv[et]; const f32x4 ov = o[et];
        sq += (ov[0] * ov[0] + ov[1] * ov[1]) + (ov[2] * ov[2] + ov[3] * ov[3]);
        v2u wv; wv.x = cvt_pk_bf16(ov[0] * gv[0] * bflo(sw.x), ov[1] * gv[1] * bfhi(sw.x)); wv.y = cvt_pk_bf16(ov[2] * gv[2] * bflo(sw.y), ov[3] * gv[3] * bfhi(sw.y));
        *(GAS v2u*)(yp + 16 * et) = wv; }
    sq += __shfl_xor(sq, 16); sq += __shfl_xor(sq, 32);
    if (g == 0) ssq[trow * 4 + h] = sq;
    __syncthreads();
}
__device__ __forceinline__ int attn_item_unit(int i) { return (i < 256) ? i : 256 + ((i + 64) & 255); }
__device__ __forceinline__ void phase_attn(Frame& F, const float* sink) { constexpr int NU = BATCH * NKVH * (SEQ / 128); v4u st[12];
    static_assert(NU == 512, "attn_item_unit");
    if (F.vcu < NU) attn_stage_load(F, attn_item_unit(F.vcu), st);
    for (int i = F.vcu; i < NU; i += F.G) attn_unit(F, attn_item_unit(i), (i + F.G < NU) ? attn_item_unit(i + F.G) : -1, st, sink); }
__device__ __forceinline__ void phase_ha(Frame& F) { constexpr int NU = BATCH * HH * NCH; v4u vst[4]; h16x8 hvv[8];
    if (F.vcu < NU) { const int bh = F.vcu >> 7; hg_v_load(F, bh >> 2, bh & 3, (F.vcu & 127) * CH, vst); ha_decay_load(F, F.vcu, hvv); }
    for (int u = F.vcu; u < NU; u += F.G) ha_unit(F, u, (u + F.G < NU) ? u + F.G : -1, vst, hvv); }
__device__ __forceinline__ void phase_hc(Frame& F, const float* hng) {
    constexpr int NU = BATCH * NCH * HH; v4u vst[4];
    if (F.vcu < NU) hg_v_load(F, F.vcu >> 9, F.vcu & 3, ((F.vcu >> 2) & 127) * CH, vst);
    for (int u = F.vcu; u < NU; u += F.G) hc_unit(F, u, (u + F.G < NU) ? u + F.G : -1, vst, hng);
}

#else
__device__ void phase_attn(Frame& F, const float* sink);
__device__ void phase_ha(Frame& F);
__device__ void phase_hb(Frame& F, int v, int g);
__device__ void phase_hc(Frame& F, const float* hng);
#endif


#if defined(ORACLE)
__global__ void __launch_bounds__(256) simple_attn(const bf16* PA, const float* sink, bf16* YA) {
    const int lane = threadIdx.x & 63, task = blockIdx.x * 4 + (threadIdx.x >> 6);
    const int m = task >> 3, qh = task & 7, kvh = qh >> 2, b = m / SEQ, t = m % SEQ;
    float q[64];
    { const bf16* qp = PA + (size_t)m * NPA + C_QA + 64 * qh;
#pragma unroll
      for (int d = 0; d < 64; ++d) q[d] = bf2f(qp[d]); }
    float s[5]; float mx = sink[qh] * LOG2E;
#pragma unroll
    for (int r = 0; r < 5; ++r) { const int j = t - WINDOW + 64 * r + lane; const bool ok = (j >= 0) && (j < SEQ) && (j <= t + WINDOW);
        float a = -3.0e38f;
        if (ok) { const bf16* kp = PA + (size_t)(b * SEQ + j) * NPA + C_KA + 64 * kvh; a = 0.f;
#pragma unroll
            for (int d = 0; d < 64; ++d) a += q[d] * bf2f(kp[d]); }
        s[r] = a; mx = fmaxf(mx, a); }
#pragma unroll
    for (int o = 1; o < 64; o <<= 1) mx = fmaxf(mx, __shfl_xor(mx, o));
    float den = 0.f;
#pragma unroll
    for (int r = 0; r < 5; ++r) { s[r] = (s[r] > -1.0e38f) ? exp2f(s[r] - mx) : 0.f; den += s[r]; }
    den = wave_sum(den) + exp2f(sink[qh] * LOG2E - mx);
    float o = 0.f;
    for (int r = 0; r < 5; ++r) for (int jj = 0; jj < 64; ++jj) { const int j = t - WINDOW + 64 * r + jj; const float p = __shfl(s[r], jj);
        if (j >= 0 && j < SEQ && j <= t + WINDOW) o += p * bf2f(PA[(size_t)(b * SEQ + j) * NPA + C_VA + 64 * kvh + lane]); }
#if defined(ABL_NOATTN)
    YA[(size_t)m * 512 + 64 * qh + lane] = 0;
#else
    YA[(size_t)m * 512 + 64 * qh + lane] = (bf16)f2bf(o / den);
#endif
}
__global__ void __launch_bounds__(512) simple_hgrn(const bf16* PA, const float* hng, float* obuf, bf16* YH, float* ssq) {
    __shared__ float part[32][4][128];
    const int tid = threadIdx.x, e = tid & 127, dq = tid >> 7, b = blockIdx.x >> 2, h = blockIdx.x & 3;
    for (int dir = 0; dir < 2; ++dir) {
        float S[32];
#pragma unroll
        for (int d = 0; d < 32; ++d) S[d] = 0.f;
        for (int t0 = 0; t0 < SEQ; t0 += 32) {
            for (int tt = 0; tt < 32; ++tt) { const int t = dir ? (SEQ - 1 - (t0 + tt)) : (t0 + tt); const bf16* row = PA + (size_t)(b * SEQ + t) * NPA;
                const float v = bf2f(row[C_VH + 128 * h + e]); const _Float16* lf = (const _Float16*)(row + (dir ? C_LB : C_LF) + 128 * h + 32 * dq); const bf16* qp = row + C_QH + 128 * h + 32 * dq;
                float o = 0.f;
#pragma unroll
                for (int d = 0; d < 32; ++d) { const float l = (float)lf[d], f = expf(l), k = -expm1f(l); S[d] = f * S[d] + k * v; o += S[d] * bf2f(qp[d]); }
                part[tt][dq][e] = o; }
            __syncthreads();
            for (int idx = tid; idx < 32 * 128; idx += 512) { const int tt = idx >> 7, ee = idx & 127; const int t = dir ? (SEQ - 1 - (t0 + tt)) : (t0 + tt); const size_t m = (size_t)b * SEQ + t;
                float o = (part[tt][0][ee] + part[tt][1][ee]) + (part[tt][2][ee] + part[tt][3][ee]);
                if (dir == 0) obuf[m * 512 + 128 * h + ee] = o;
                else { o += obuf[m * 512 + 128 * h + ee];
                    const float sg = bf2f(PA[m * NPA + C_SG + 128 * h + ee]);
#if defined(ABL_NOHGRN)
                    YH[m * 512 + 128 * h + ee] = 0;
#else
                    YH[m * 512 + 128 * h + ee] = (bf16)f2bf(o * hng[128 * h + ee] * sg);
#endif

                    const float q = wave_sum(o * o);
                    if ((tid & 63) == 0) atomicAdd(&ssq[m * 4 + h], q); } }
            __syncthreads();
        }
    }
}
__global__ void zero_f32(float* p, int n) { const int i = blockIdx.x * blockDim.x + threadIdx.x; if (i < n) p[i] = 0.f; }
#endif

#if defined(CHECK)
#define CK_NS 48
__device__ __forceinline__ int ck_row(int s) { return (int)(((long)s * 10007 + 77) % T); }
__device__ __forceinline__ bool ck_cmp(float got, float ref, float rtol, float atol, unsigned* cnt) { const float d = fabsf(got - ref); if (!(d <= rtol * fabsf(ref) + atol)) { atomicAdd(cnt, 1u); return true; } return false; }
__global__ void ck_norm(const float* x, const float* g, const bf16* XN, unsigned* cnt) {
    const int m = ck_row(blockIdx.x); __shared__ float red[256];
    float s = 0.f; for (int c = threadIdx.x; c < D; c += 256) { const float v = x[(size_t)m * D + c]; s += v * v; }
    red[threadIdx.x] = s; __syncthreads(); for (int o = 128; o > 0; o >>= 1) { if (threadIdx.x < o) red[threadIdx.x] += red[threadIdx.x + o]; __syncthreads(); }
    const float rstd = 1.0f / sqrtf(red[0] / D + NORM_EPS);
    for (int c = threadIdx.x; c < D; c += 256) ck_cmp(bf2f(XN[(size_t)m * D + c]), x[(size_t)m * D + c] * rstd * g[c], 0.01f, 0.01f, cnt);
}
__global__ void ck_pa(const bf16* XN, const float* w_in, const float* lb_tab  , int l, const bf16* PA, unsigned* cnt) {
    const int m = ck_row(blockIdx.x), pos = m % SEQ; __shared__ float z[NPA]; __shared__ float xr[D];
    for (int c = threadIdx.x; c < D; c += 256) xr[c] = bf2f(XN[(size_t)m * D + c]);
    __syncthreads();
    for (int c = threadIdx.x; c < NPA; c += 256) { float a = 0.f; for (int k = 0; k < D; ++k) a += xr[k] * w_in[(size_t)k * INW + c]; z[c] = a; }
    __syncthreads();
    for (int c = threadIdx.x; c < NPA; c += 256) {
        const float got_b = bf2f(PA[(size_t)m * NPA + c]); const float got_h = (float)((const _Float16*)PA)[(size_t)m * NPA + c];
        if (c < C_VA) { const int d = c & 63, i = d & 31; const double inv = exp2(-(double)i * (13.287712379549449 / 32.0)); const float cs = (float)cos((double)pos * inv), sn = (float)sin((double)pos * inv);
            const float x1 = z[(c & ~63) + i], x2 = z[(c & ~63) + i + 32]; float r = (d < 32) ? (x1 * cs - x2 * sn) : (x2 * cs + x1 * sn); if (c < C_KA) r *= QSCALE;
            ck_cmp(got_b, r, 0.02f, 0.03f, cnt + 0);
        } else if (c < C_QH) ck_cmp(got_b, z[c], 0.02f, 0.02f, cnt + 1);
        else if (c < C_LF) ck_cmp(got_b, z[c] / (1.f + expf(-z[c])), 0.02f, 0.02f, cnt + 2);
        else if (c < C_VH) { const int dir = (c >= C_LB), col = c - (dir ? C_LB : C_LF);
            float t0 = lb_tab[(0 * 2 + dir) * 512 + col], t1 = lb_tab[(1 * 2 + dir) * 512 + col]; const float mx = fmaxf(t0, t1); t0 = expf(t0 - mx); t1 = expf(t1 - mx);
            const float lb = (l == 0) ? 0.f : t1 / (t0 + t1); const float sg = 1.f / (1.f + expf(-z[c])); const float r = fmaxf(logf(lb + (1.f - lb) * sg), LOGF_MIN);
            ck_cmp(got_h, r, 0.01f, 0.02f, cnt + 3);
        } else if (c < C_SG) ck_cmp(got_b, z[c], 0.02f, 0.02f, cnt + 4);
        else ck_cmp(got_b, z[c] / (1.f + expf(-z[c])), 0.02f, 0.02f, cnt + 5);
    }
}
__global__ void ck_mix(const bf16* XN, const float* w_in, const bf16* YA, const bf16* YH, const float* ssq, const float* wua, const float* wuh, const bf16* GT, const bf16* MG, int which, unsigned* cnt) {
#ifndef CK_SHIFT
#define CK_SHIFT 0
#endif
    const int m = ck_row((blockIdx.x + CK_SHIFT) % CK_NS); __shared__ float xr[D]; __shared__ float ya[512]; __shared__ float yh[512];
    for (int c = threadIdx.x; c < D; c += 256) xr[c] = bf2f(XN[(size_t)m * D + c]);
    for (int c = threadIdx.x; c < 512; c += 256) { ya[c] = bf2f(YA[(size_t)m * 512 + c]); yh[c] = bf2f(YH[(size_t)m * 512 + c]); }
    __syncthreads();
    const float rstd = 1.0f / sqrtf((ssq[m * 4] + ssq[m * 4 + 1] + ssq[m * 4 + 2] + ssq[m * 4 + 3]) / 512.f + NORM_EPS);
    for (int c = threadIdx.x; c < D; c += 256) { float a = 0.f, b = 0.f, p = 0.f, q = 0.f;
        for (int k = 0; k < D; ++k) { a += xr[k] * w_in[(size_t)k * INW + NPA + c]; b += xr[k] * w_in[(size_t)k * INW + NPA + 1024 + c]; }
        for (int k = 0; k < 512; ++k) { p += ya[k] * wua[(size_t)k * D + c]; q += yh[k] * wuh[(size_t)k * D + c]; }
        float ga = 1.f / (1.f + expf(-a)), gb = 1.f / (1.f + expf(-b));
        if (which != 0) { ga = bf2f(GT[(size_t)m * NGATE + c]); gb = bf2f(GT[(size_t)m * NGATE + 1024 + c]); }
        if (which == 0) { unsigned* dbg = cnt + 100; if (blockIdx.x == 27) { const float e0 = fabsf(bf2f(GT[(size_t)m * NGATE + c]) - ga), e1 = fabsf(bf2f(GT[(size_t)m * NGATE + 1024 + c]) - gb); atomicMax(dbg + 200, __float_as_uint(e0)); atomicMax(dbg + 200, __float_as_uint(e1)); atomicMax(dbg + 201, __float_as_uint(fabsf(a))); atomicMax(dbg + 201, __float_as_uint(fabsf(b))); if (GT[(size_t)m * NGATE + c] == 0xFFFFu) atomicAdd(dbg + 203, 1u); if (GT[(size_t)m * NGATE + 1024 + c] == 0xFFFFu) atomicAdd(dbg + 203, 1u); if (e0 > 0.2f) { atomicAdd(dbg + 202, 1u); atomicOr(dbg + 210 + (c >> 11), 0u); atomicAdd(dbg + 300 + (c >> 6), 1u); } if (e1 > 0.2f) { atomicAdd(dbg + 202, 1u); atomicAdd(dbg + 300 + 16 + (c >> 6), 1u); } } if (ck_cmp(bf2f(GT[(size_t)m * NGATE + c]), ga, 0.01f, 0.01f, cnt + 0)) { atomicAdd(dbg + blockIdx.x, 1u); atomicAdd(dbg + 64 + (c >> 5), 1u); } if (ck_cmp(bf2f(GT[(size_t)m * NGATE + 1024 + c]), gb, 0.01f, 0.01f, cnt + 0)) { atomicAdd(dbg + blockIdx.x, 1u); atomicAdd(dbg + 64 + 32 + (c >> 5), 1u); } }
        else if (which == 1) ck_cmp(bf2f(MG[(size_t)m * D + c]), ga * p, 0.03f, 0.01f, cnt + 1);
        else ck_cmp(bf2f(MG[(size_t)m * D + c]), ga * p + gb * rstd * q, 0.03f, 0.02f, cnt + 2); }
}
__global__ void ck_out(const float* xprev, const bf16* MG, const float* wout, const float* X, unsigned* cnt) {
    const int m = ck_row(blockIdx.x); __shared__ float mg[D];
    for (int c = threadIdx.x; c < D; c += 256) mg[c] = bf2f(MG[(size_t)m * D + c]);
    __syncthreads();
    for (int c = threadIdx.x; c < D; c += 256) { float a = 0.f; for (int k = 0; k < D; ++k) a += mg[k] * wout[(size_t)k * D + c]; ck_cmp(X[(size_t)m * D + c], xprev[(size_t)m * D + c] + a, 0.01f, 0.02f, cnt); }
}
__global__ void ck_moe(const float* X, const float* g, const float* wrg, const float* brg, const float* wre, const float* bre, const float* weg, const float* weu, const float* wed,
                       const bf16* XN, const int* tok_e, const float* tok_w, const int* tok_p, const int* meta, const bf16* XP, const bf16* ACT, const bf16* Y, int stage, unsigned* cnt) {
    const int m = ck_row(blockIdx.x); __shared__ float h[D]; __shared__ float red[256]; __shared__ float lg[36]; __shared__ float act[DEXP];
    float s = 0.f; for (int c = threadIdx.x; c < D; c += 256) { const float v = X[(size_t)m * D + c]; s += v * v; }
    red[threadIdx.x] = s; __syncthreads(); for (int o = 128; o > 0; o >>= 1) { if (threadIdx.x < o) red[threadIdx.x] += red[threadIdx.x + o]; __syncthreads(); }
    const float rstd = 1.0f / sqrtf(red[0] / D + NORM_EPS);
    for (int c = threadIdx.x; c < D; c += 256) h[c] = X[(size_t)m * D + c] * rstd * g[c];
    __syncthreads();
    if (threadIdx.x < 36) { const int t = threadIdx.x; float a = 0.f;
        if (t < 4) { for (int k = 0; k < D; ++k) a += h[k] * wrg[k * 4 + t]; a += brg[t]; } else { const int gg = (t - 4) >> 3, e = (t - 4) & 7; for (int k = 0; k < D; ++k) a += h[k] * wre[((size_t)gg * D + k) * 8 + e]; a += bre[gg * 8 + e]; }
        lg[t] = a; }
    __syncthreads();
    int gt = 0; for (int k = 1; k < 4; ++k) if (lg[k] > lg[gt]) gt = k;
    float gden = 0.f; for (int k = 0; k < 4; ++k) gden += expf(lg[k] - lg[gt]);
    const float* el = lg + 4 + gt * 8; int i1 = 0; for (int k = 1; k < 8; ++k) if (el[k] > el[i1]) i1 = k; int i2 = (i1 == 0) ? 1 : 0; for (int k = 0; k < 8; ++k) if (k != i1 && el[k] > el[i2]) i2 = k;
    const float q2 = expf(el[i2] - el[i1]); const float w1 = (1.f / gden) / (1.f + q2), w2 = (1.f / gden) * q2 / (1.f + q2);
    const int e1 = gt * 8 + i1, e2 = gt * 8 + i2;
    if (stage == 0) { if (threadIdx.x == 0) { if (tok_e[2 * m] != e1 || tok_e[2 * m + 1] != e2) atomicAdd(cnt + 0, 1u); ck_cmp(tok_w[2 * m], w1, 0.01f, 1e-3f, cnt + 1); ck_cmp(tok_w[2 * m + 1], w2, 0.01f, 1e-3f, cnt + 1); } return; }
    for (int kk = 0; kk < 2; ++kk) { const int e = tok_e[2 * m + kk], p = tok_p[2 * m + kk];
        if (stage == 1) { if (threadIdx.x == 0) { const int rt = p >> 8; if (rt >= meta[0] || meta[1 + rt] != e) atomicAdd(cnt + 2, 1u); }
            for (int c = threadIdx.x; c < D; c += 256) if (XP[(size_t)p * D + c] != XN[(size_t)m * D + c]) atomicAdd(cnt + 3, 1u); continue; }
        const float* wg = weg + (size_t)e * D * DEXP; const float* wu = weu + (size_t)e * D * DEXP; const float* wd = wed + (size_t)e * DEXP * D;
        __syncthreads();
        for (int j = threadIdx.x; j < DEXP; j += 256) { float a = 0.f, b = 0.f; for (int k = 0; k < D; ++k) { const float hv = bf2f(XN[(size_t)m * D + k]); a += hv * wg[(size_t)k * DEXP + j]; b += hv * wu[(size_t)k * DEXP + j]; }
            const float r = a / (1.f + expf(-a)) * b; act[j] = r; if (stage == 2) ck_cmp(bf2f(ACT[(size_t)p * DEXP + j]), r, 0.03f, 0.02f, cnt + 4); }
        __syncthreads();
        if (stage == 3) for (int c = threadIdx.x; c < D; c += 256) { float a = 0.f; for (int j = 0; j < DEXP; ++j) a += act[j] * wd[(size_t)j * D + c]; ck_cmp(bf2f(Y[(size_t)p * D + c]), a, 0.03f, 0.03f, cnt + 5); }
    }
}

__global__ void ck_attn(const bf16* PA, const float* sink, const bf16* YA, unsigned* cnt) {
    const int m = ck_row(blockIdx.x), b = m / SEQ, t = m % SEQ; __shared__ float sc[512]; __shared__ float red[256];
    for (int qh = 0; qh < NQH; ++qh) { const int kvh = qh / 4;
        const bf16* qp = PA + (size_t)m * NPA + C_QA + 64 * qh;
        for (int jj = threadIdx.x; jj < 2 * WINDOW + 1; jj += 256) { const int j = t - WINDOW + jj; float a = -1e30f;
            if (j >= 0 && j < SEQ) { a = 0.f; const bf16* kp = PA + (size_t)(b * SEQ + j) * NPA + C_KA + 64 * kvh; for (int d = 0; d < 64; ++d) a += bf2f(qp[d]) * bf2f(kp[d]); a *= 0.6931471805599453f; }
            sc[jj] = a; }
        __syncthreads();
        float mx = sink[qh]; for (int jj = 0; jj < 2 * WINDOW + 1; ++jj) mx = fmaxf(mx, sc[jj]);
        float den = expf(sink[qh] - mx); for (int jj = 0; jj < 2 * WINDOW + 1; ++jj) den += expf(sc[jj] - mx);
        if (threadIdx.x < 64) { const int d = threadIdx.x; float o = 0.f; for (int jj = 0; jj < 2 * WINDOW + 1; ++jj) { const int j = t - WINDOW + jj; if (j >= 0 && j < SEQ) o += expf(sc[jj] - mx) * bf2f(PA[(size_t)(b * SEQ + j) * NPA + C_VA + 64 * kvh + d]); }
            ck_cmp(bf2f(YA[(size_t)m * 512 + 64 * qh + d]), o / den, 0.03f, 0.005f, cnt); }
        __syncthreads(); }
}
__global__ void ck_hgrn(const bf16* PA, const float* hng, const bf16* YH, const float* ssq, unsigned* cnt) {
    const int m = ck_row(blockIdx.x), b = m / SEQ, t = m % SEQ, h = blockIdx.y; __shared__ float wgt[128]; __shared__ float osum[128]; __shared__ float cum[128];
    const int e = threadIdx.x;
    float o = 0.f;
    for (int dir = 0; dir < 2; ++dir) { cum[e] = 0.f; __syncthreads();
        for (int n = 0; n < 768; ++n) { const int s = dir ? t + n : t - n; if (s < 0 || s >= SEQ) break;
            const bf16* row = PA + (size_t)(b * SEQ + s) * NPA; const bf16* rowt = PA + (size_t)m * NPA;
            { const int d = e; const float lf = (float)((const _Float16*)(row + (dir ? C_LB : C_LF) + 128 * h))[d];
              wgt[d] = bf2f(rowt[C_QH + 128 * h + d]) * (-expm1f(lf)) * expf(cum[d]);
#if defined(HC_DBG) && HC_DBG >= 3
              wgt[d] = bf2f(rowt[C_QH + 128 * h + d]) * (-expm1f(lf));
              if (HC_DBG == 4) wgt[d] = (d == 0) ? bf2f(rowt[C_QH + 128 * h]) : 0.f;
              if (HC_DBG == 5 || HC_DBG == 7) wgt[d] = (d == 0) ? wgt[d] : 0.f;
              if (HC_DBG == 10) wgt[d] = (d == 0) ? (float)(s & 15) : 0.f;
              if (HC_DBG == 11) wgt[d] = (d == 0) ? (float)(t & 15) : 0.f;
              if (HC_DBG == 8 || HC_DBG == 9) wgt[d] = (d == 0) ? bf2f(rowt[C_QH + 128 * h]) * (float)(s & 15) : 0.f;
              if (HC_DBG == 6) wgt[d] = (d == 0) ? bf2f(rowt[C_QH + 128 * h]) * lf : 0.f;
#endif
            }
            __syncthreads();
            float w = 0.f; for (int d = 0; d < 128; ++d) w += wgt[d];
#if defined(HC_TERMS)
            { const int cls = ((s >> 4) == (t >> 4)) ? 1 : (((s >> 7) == (t >> 7)) ? 2 : 4); if (!(HC_TERMS & cls)) w = 0.f; }
#endif
            o += w * bf2f(row[C_VH + 128 * h + e]);
            __syncthreads();
            { const int d = e; cum[d] += (float)((const _Float16*)(row + (dir ? C_LB : C_LF) + 128 * h))[d]; }
            __syncthreads(); } }
#if defined(HC_DBG) && HC_DBG == 1
    o = bf2f(PA[(size_t)m * NPA + C_VH + 128 * h + e]);
#endif
    osum[e] = o * o; __syncthreads(); for (int k = 64; k > 0; k >>= 1) { if (e < k) osum[e] += osum[e + k]; __syncthreads(); }
    if (e == 0) ck_cmp(ssq[m * 4 + h], osum[0], 0.03f, 1e-3f, cnt + 1);
    const float sg = bf2f(PA[(size_t)m * NPA + C_SG + 128 * h + e]);
    ck_cmp(bf2f(YH[(size_t)m * 512 + 128 * h + e]), o * hng[128 * h + e] * sg, 0.03f, 0.01f, cnt + 0);
}
__global__ void ck_comb(const float* xold, const float* xnew, const int* tok_p, const float* tok_w, const bf16* Y, const float* gfin, int last, unsigned* cnt) {
    const int m = ck_row(blockIdx.x); __shared__ float red[256]; __shared__ float xv[D];
    if (m >= SEQ) return;
    const int p1 = tok_p[2 * m], p2 = tok_p[2 * m + 1]; const float w1 = tok_w[2 * m], w2 = tok_w[2 * m + 1]; float s = 0.f;
    for (int c = threadIdx.x; c < D; c += 256) { const float v = xold[(size_t)m * D + c] + w1 * bf2f(Y[(size_t)p1 * D + c]) + w2 * bf2f(Y[(size_t)p2 * D + c]); xv[c] = v; s += v * v; }
    red[threadIdx.x] = s; __syncthreads(); for (int o = 128; o > 0; o >>= 1) { if (threadIdx.x < o) red[threadIdx.x] += red[threadIdx.x + o]; __syncthreads(); }
    const float rstd = 1.0f / sqrtf(red[0] / D + NORM_EPS);
    for (int c = threadIdx.x; c < D; c += 256) ck_cmp(xnew[(size_t)m * D + c], last ? xv[c] * rstd * gfin[c] : xv[c], 0.005f, 0.005f, cnt);
}

__global__ void ck_gates_full(const bf16* XN, const float* w_in, const bf16* GT, unsigned* st) {
    const int m = blockIdx.x >> 3, pn = blockIdx.x & 7, c = pn * 256 + threadIdx.x; __shared__ float xr[D];
    for (int k = threadIdx.x; k < D; k += 256) xr[k] = bf2f(XN[(size_t)m * D + k]);
    __syncthreads();
    float a = 0.f; for (int k = 0; k < D; ++k) a += xr[k] * w_in[(size_t)k * INW + NPA + c];
#if defined(CK_PLAIN)
    const float ref = a, got = bf2f(GT[(size_t)m * NGATE + c]);
#else
    const float ref = 1.f / (1.f + expf(-a)), got = bf2f(GT[(size_t)m * NGATE + c]);
#endif
    if (m == 8122 && !(fabsf(got - ref) <= 0.05f)) atomicMin(st + 700, (unsigned)c);
    if (m == 8123 && !(fabsf(got - ref) <= 0.05f)) atomicMin(st + 701, (unsigned)c);
    if (m == 8122) { if (c == 130) st[702] = __float_as_uint(got), st[703] = __float_as_uint(ref), st[704] = __float_as_uint(a); if (c == 131) st[705] = __float_as_uint(got), st[706] = __float_as_uint(ref); }
    if (!(fabsf(got - ref) <= 0.05f)) { atomicAdd(st + (m >> 8), 1u); atomicAdd(st + 128 + (m & 255), 1u); atomicAdd(st + 384 + threadIdx.x, 1u); atomicAdd(st + 640 + pn, 1u); }
}
__global__ void ck_flush() { asm volatile("buffer_wbl2 sc0 sc1\n\ts_waitcnt vmcnt(0)\n\tbuffer_inv sc0 sc1\n\ts_waitcnt vmcnt(0)" ::: "memory"); }

__global__ void ck_ha(const bf16* PA, const bf16* US, const float* HD, unsigned* cnt) {
    const int sidx = blockIdx.x, bh = sidx % 8, dir = (sidx >> 3) & 1, n = (sidx * 37 + 5) % NCH, b = bh >> 2, h = bh & 3, d = threadIdx.x, t0 = n * CH;
    __shared__ float kts[CH][128]; float cum = 0.f;
    for (int k = CH - 1; k >= 0; --k) { const int tok = dir ? (t0 + CH - 1 - k) : (t0 + k);
        const float lf = (float)((const _Float16*)(PA + (size_t)(b * SEQ + tok) * NPA + (dir ? C_LB : C_LF) + 128 * h))[d];
        kts[k][d] = -expm1f(lf) * expf(cum); cum += lf; }
    ck_cmp(HD[((size_t)(bh * 2 + dir) * NCH + n) * 128 + d], expf(cum), 0.01f, 1e-6f, cnt + 1);
    for (int e = 0; e < 128; e += 5) { float u = 0.f;
        for (int k = 0; k < CH; ++k) { const int tok = dir ? (t0 + CH - 1 - k) : (t0 + k); u += kts[k][d] * bf2f(PA[(size_t)(b * SEQ + tok) * NPA + C_VH + 128 * h + e]); }
        ck_cmp(bf2f(US[(((size_t)(bh * 2 + dir) * NCH + n) * 128 + e) * 128 + d]), u, 0.03f, 0.01f, cnt + 0); }
}
__global__ void ck_hb(const bf16* PA, const bf16* US, unsigned* cnt) {
    const int sidx = blockIdx.x, bh = sidx % 8, dir = (sidx >> 3) & 1, n = (sidx * 37 + 5) % NCH, b = bh >> 2, h = bh & 3, d = threadIdx.x, e = (sidx * 11 + 3) % 128;
    float cum = 0.f, sacc = 0.f;
    for (int k = 0; k < 1024; ++k) { const int tok = dir ? ((n + 1) * CH + k) : (n * CH - 1 - k); if (tok < 0 || tok >= SEQ) break;
        const bf16* row = PA + (size_t)(b * SEQ + tok) * NPA; const float lf = (float)((const _Float16*)(row + (dir ? C_LB : C_LF) + 128 * h))[d];
        sacc += -expm1f(lf) * expf(cum) * bf2f(row[C_VH + 128 * h + e]); cum += lf; }
    ck_cmp(bf2f(US[(((size_t)(bh * 2 + dir) * NCH + n) * 128 + e) * 128 + d]), sacc, 0.03f, 0.01f, cnt);
}

__global__ void ck_mfma(unsigned* cnt) {
#if defined(__HIP_DEVICE_COMPILE__)
    const int lane = threadIdx.x, fr = lane & 15, g = lane >> 4;
    float av[8], bv[8];
    for (int j = 0; j < 8; ++j) { const int k = 8 * g + j; av[j] = (k == 0) ? (float)fr : ((k == 9) ? (float)(fr * fr) : 0.f); bv[j] = (k == 0) ? (float)(fr + 1) : ((k == 9) ? 0.5f : 0.f); }
    f32x4 d = (f32x4){0.f, 0.f, 0.f, 0.f};
    d = mfma16(pack_frag(av), pack_frag(bv), d);
    for (int r = 0; r < 4; ++r) { const int s = 4 * g + r, c = fr; const float ref = (float)s * (float)(c + 1) + (float)(s * s) * 0.5f; if (fabsf(d[r] - ref) > 0.01f * fabsf(ref) + 0.01f) atomicAdd(cnt, 1u); }
#endif
}
#ifndef CK_SKIP
#define CK_SKIP 0ull
#endif
__global__ void ck_report(const unsigned* cnt, int n, float* out) { if (threadIdx.x == 0 && blockIdx.x == 0) {
#if defined(CK_DBG7)
    const unsigned* dbg = cnt + 7 + 100; int nrows = 0, ngrp = 0; unsigned mx = 0, first = 99; for (int i = 0; i < CK_NS; ++i) if (dbg[i]) { ++nrows; mx = dbg[i] > mx ? dbg[i] : mx; } for (int i = 0; i < 64; ++i) if (dbg[64 + i]) { ++ngrp; if (first == 99) first = i; }
    if (CK_DBG7 == 4) { const float me = __uint_as_float(dbg[200]), ma = __uint_as_float(dbg[201]); out[0] = (1.0f + fminf(me, 0.89f) * 10.0f) * powf(10.0f, 5.0f + floorf(fminf(ma, 30.0f))); return; }
    if (CK_DBG7 == 5) { int nl = 0; unsigned mxl = 0; for (int i = 0; i < 32; ++i) if (dbg[300 + i]) { ++nl; mxl = dbg[300 + i] > mxl ? dbg[300 + i] : mxl; } out[0] = (1.0f + 0.1f * (float)nl) * powf(10.0f, 5.0f + (float)(mxl > 30 ? 30 : mxl)); return; }
    if (CK_DBG7 == 7) { out[0] = (1.0f + 0.01f * (float)(dbg[203] % 100)) * powf(10.0f, 5.0f + (float)(dbg[203] / 100)); return; }
    if (CK_DBG7 >= 10) { const unsigned* st = cnt + 512; int npan = 0, nrit = 0, ncol = 0, ntile = 0; unsigned tot = 0, mxp = 0; int firstp = -1, firstr = -1, firstc = -1;
        for (int i = 0; i < 128; ++i) if (st[i]) { ++npan; tot += st[i]; if (st[i] > mxp) mxp = st[i]; if (firstp < 0) firstp = i; }
        for (int i = 0; i < 256; ++i) { if (st[128 + i]) { ++nrit; if (firstr < 0) firstr = i; } if (st[384 + i]) { ++ncol; if (firstc < 0) firstc = i; } }
        for (int i = 0; i < 8; ++i) if (st[640 + i]) ++ntile;
        float a = 0.f, b = 0.f;
        if (CK_DBG7 == 10) { a = (float)npan; b = log10f((float)(tot ? tot : 1)) * 4.0f; }
        if (CK_DBG7 == 11) { a = (float)nrit; b = (float)ncol / 10.0f; }
        if (CK_DBG7 == 12) { a = (float)firstp; b = (float)firstr / 10.0f; }
        if (CK_DBG7 == 13) { a = (float)firstc; b = (float)ntile; }
        if (CK_DBG7 == 22) { out[0] = (1.0f + 8.0f * __uint_as_float(st[702])) * powf(10.0f, 5.0f + floorf(20.0f * __uint_as_float(st[703]) + 0.5f)); return; }
        if (CK_DBG7 == 23) { out[0] = (1.0f + 8.0f * __uint_as_float(st[705])) * powf(10.0f, 5.0f + floorf(20.0f * __uint_as_float(st[706]) + 0.5f)); return; }
        if (CK_DBG7 == 20) { a = (float)(st[700] % 100); b = (float)(st[700] / 100); }
        if (CK_DBG7 == 21) { a = (float)(st[701] > 5000 ? 99 : st[701] % 100); b = (float)(st[701] > 5000 ? 30 : st[701] / 100); }
        out[0] = (1.0f + 0.01f * a) * powf(10.0f, 5.0f + floorf(b)); return; }
    if (CK_DBG7 == 6) { out[0] = (1.0f + 0.01f * (float)(dbg[202] % 100)) * powf(10.0f, 5.0f + (float)(dbg[202] / 100)); return; }
    if (CK_DBG7 == 3) { int s1 = -1, s2 = -1; for (int i = 0; i < CK_NS; ++i) if (dbg[i] > 20) { if (s1 < 0) s1 = i; else if (s2 < 0) s2 = i; } out[0] = (1.0f + 0.1f * (float)(s1 < 0 ? 0 : s1 % 50)) * powf(10.0f, (float)(5 + (s2 < 0 ? 0 : (s2 % 25)))); return; }
    if (CK_DBG7 == 1) out[0] = (1.0f + 0.1f * (float)first) * powf(10.0f, (float)(5 + nrows / 2));
    else out[0] = (1.0f + 0.1f * (float)ngrp) * powf(10.0f, (float)(5 + (int)floorf(4.0f * log10f((float)(mx ? mx : 1)))));
    return;
#endif
    for (int i = 0; i < n; ++i) if (cnt[i] && !((CK_SKIP >> i) & 1ull)) {
    out[0] = (1.0f + 0.1f * (float)(i % 10)) * powf(10.0f, (float)(5 + i / 10)); return; } } }
#endif

#ifndef PG8_SP2
#define PG8_SP2 true
#endif
#ifndef PG8_ALIGN
#define PG8_ALIGN true
#endif
__global__ void __launch_bounds__(NWAVES * 64, 2) mega_fwd(Args args) {
    extern __shared__ __attribute__((aligned(16))) unsigned char lds[];
    Frame F;
    F.lds = (LAS unsigned char*)lds;
    F.MISC = (volatile LAS unsigned*)(F.lds + MISC_OFF);
    F.tid = threadIdx.x; F.lane = F.tid & 63; F.wave = __builtin_amdgcn_readfirstlane(F.tid >> 6);
    F.G = gridDim.x; { const int bx = blockIdx.x; F.vcu = (F.G % 8 == 0) ? (bx % 8) * (F.G / 8) + bx / 8 : bx; }
    F.ws = args.ws; F.ctl = (gu32*)(args.ws + WS_CTL); F.out = args.out;
    const Args& A = args;
    for (int u = F.tid; u < (LDS_BYTES - LDSCTL_OFF) / 4; u += NWAVES * 64) ((LAS unsigned*)(F.lds + LDSCTL_OFF))[u] = 0u;
    __syncthreads();
    XcdBarrier bar = xcd_barrier_post((unsigned*)(F.ctl + CW_BAR) + args.li * XCD_BAR_WORDS, F.MISC + 8);
    const int lo = args.ph_lo, hi = args.ph_hi;
#ifndef PHMASK
#define PHMASK 0xffff
#endif
#define IN(k) (((PHMASK >> ((k) & 15)) & 1) && lo <= (k) && (k) < hi)
#if defined(PROBE_MASK)
    unsigned long long pr_acc = 0ull, pr_t0 = 0ull;
#define PR_BEGIN(k) do { if ((PROBE_MASK >> ((k) & 15)) & 1) pr_t0 = wall_clock64(); } while (0)
#define PR_END(k) do { if ((PROBE_MASK >> ((k) & 15)) & 1) pr_acc += wall_clock64() - pr_t0; } while (0)
#else
#define PR_BEGIN(k)
#define PR_END(k)
#endif
#define SEAM(k) do { if ((k) + 1 < hi) xcd_barrier(bar); PR_END(k); } while (0)
#define WSP() GAS unsigned char* wsg_ = (GAS unsigned char*)args.ws; asm volatile("" : "+s"(wsg_)); unsigned char* ws = (unsigned char*)wsg_; F.ws = ws; { int t_ = threadIdx.x; asm volatile("" : "+v"(t_)); F.tid = t_; F.lane = t_ & 63; F.wave = __builtin_amdgcn_readfirstlane(t_ >> 6); int g_ = gridDim.x, b_ = blockIdx.x; asm volatile("" : "+s"(g_), "+s"(b_)); F.G = g_; F.vcu = (g_ % 8 == 0) ? (b_ % 8) * (g_ / 8) + b_ / 8 : b_; cid = b_; } \
    bf16* XN = (bf16*)(ws + WS_XN); bf16* PA = (bf16*)(ws + WS_PA); bf16* GT = (bf16*)(ws + WS_PA); bf16* MG = (bf16*)(ws + WS_US); \
    bf16* YA = (bf16*)(ws + WS_Y); bf16* YH = (bf16*)(ws + WS_YH); (void)XN; (void)PA; (void)GT; (void)MG; (void)YA; (void)YH;
    int cid = (int)blockIdx.x;

#if !defined(ORACLE) || defined(ORACLE_FAST)
#if XBF16
#define XB_CUR(l) ((l) == 0 ? (NORMFOLD ? (void*)XN : (void*)A.in[I_X]) : (void*)F.out)
#define XB_NEW(l) ((l) == DEPTH - 1 ? (bf16*)(ws + WS_Y) : (bf16*)F.out)
#define XIN0(l) ((const void*)XB_CUR(l))
#define EPIOUT_T(l) EpiOutB<(l) == 0 && !NORMFOLD>
#else
#define XB_CUR(l) ((void*)F.out)
#define XB_NEW(l) (F.out)
#define XIN0(l) ((l) == 0 ? A.in[I_X] : (const float*)F.out)
#define EPIOUT_T(l) EpiOut
#endif
#if NORMFOLD
#define G1_A(l) ((l) == 0 ? XN : (const bf16*)F.out)
#define M1_A(l) ((const bf16*)XB_NEW(l))
#else
#define G1_A(l) XN
#define M1_A(l) XN
#endif
#define XCOPY0 nullptr
#else
#define XCOPY0 F.out
#define XIN0(l) ((const float*)F.out)
#endif
    if (IN(0)) { WSP(); PR_BEGIN(0);
        make_tables(F, A); conv_weights(F, A, 0);
#if NORM4 && !NORMFOLD
        norm_rows4(F, A.in[I_X], A.in[I_ANG], XN);
#else
        norm_rows(F, A.in[I_X], XCOPY0, A.in[I_ANG], XN, NORMFOLD ? (float*)(ws + WS_RSA) : nullptr);
#endif
        SEAM(0);
    }
#if G1A_SPLIT
#define PHASE3(l) if (IN(pb + 3)) { WSP(); PR_BEGIN(pb + 3);   \
            const int gh = G1A_SPLIT ? F.G / 2 : 0; \
            if (cid < gh) { pg8::Gemm g{XN, (const bf16*)(ws + WS_WIN) + (size_t)G1A_N * D, T, NPA - G1A_N, D}; pg8::StaticOrder S; S.init(T, NPA - G1A_N, gh, cid); \
                EpiInA E{PA, (const float*)(ws + WS_COS), (const float*)(ws + WS_SIN), (const float*)(ws + WS_LBT) + l * 2048, G1A_N / 256, (const float*)(ws + WS_RSA)}; \
                pg8::gemm_phase<EpiInA, pg8::StaticOrder, PG8_ALIGN, PG8_SP2>(F.lds + RING_OFF, g, S, E); } \
            else phase_hb(F, cid - gh, F.G - gh); \
            SEAM(pb + 3); }
#else
#define PHASE3(l) if (IN(pb + 3)) { WSP(); PR_BEGIN(pb + 3); phase_hb(F, F.vcu, F.G); SEAM(pb + 3); }
#endif
#if !defined(ORACLE) || defined(ORACLE_FAST)
#define G1A_N (NPA - 256 * G1A_SPLIT)
#define FAST_PHASES(l)         if (IN(pb + 2)) { WSP(); PR_BEGIN(pb + 2); PR_BEGIN(14); phase_attn(F, A.in[I_SINK] + (l) * NQH); PR_END(14); PR_BEGIN(15); phase_ha(F); PR_END(15); SEAM(pb + 2); } \
        PHASE3(l) \
        if (IN(pb + 4)) { WSP(); PR_BEGIN(pb + 4); phase_hc(F, A.in[I_HNG] + (l) * 512); SEAM(pb + 4); }
#else
#define G1A_N NPA
#define FAST_PHASES(l)
#endif
#if MOE_HANDOFF
#define MOE_ORDER1 pg8::ProducerOrder
#define MOE_ORDER2 pg8::ConsumerOrder
#define MOE_CNT(l) S.cnt = (unsigned*)(F.ctl + CW_MOE + (l) * MOE_BANK + 64);
#define MOE_SEAM(k) PR_END(k)
#else
#define MOE_ORDER1 pg8::GroupedOrder
#define MOE_ORDER2 pg8::GroupedOrder
#define MOE_CNT(l)
#define MOE_SEAM(k) SEAM(k)
#endif
#if ROUTE4
#define ROUTE_FN phase_norm_route4
#else
#define ROUTE_FN phase_norm_route
#endif
#if defined(PROBE_BARRIERS)
#define PROBE_BARRIERS_EXTRA for (int k_ = 0; k_ < PROBE_BARRIERS; ++k_) xcd_barrier(bar);
#else
#define PROBE_BARRIERS_EXTRA
#endif
#if defined(PROBE_KLOOP)
#define PROBE_KLOOP_EXTRA { EpiNull E2{GT}; pg8::gemm_phase<EpiNull, pg8::StaticOrder, PG8_ALIGN, PG8_SP2>(F.lds + RING_OFF, g, S, E2); }
#else
#define PROBE_KLOOP_EXTRA
#endif
#define LAYER_BODY(l) { const int pb = 16 * (l); \
        if (IN(pb + 1)) { WSP(); PR_BEGIN(pb + 1); \
            const int cw = conv_wgs(F.G, (T / 256) * (G1A_N / 256), CONV_WGS), gg = F.G - cw;     \
            if (cid < gg) { pg8::Gemm g{G1_A(l), (const bf16*)(ws + WS_WIN), T, G1A_N, D}; pg8::StaticOrder S; S.init(T, G1A_N, gg, cid); \
                EpiInA E{PA, (const float*)(ws + WS_COS), (const float*)(ws + WS_SIN), (const float*)(ws + WS_LBT) + l * 2048, 0, (const float*)(ws + WS_RSA)}; \
                pg8::gemm_phase<EpiInA, pg8::StaticOrder, PG8_ALIGN, PG8_SP2>(F.lds + RING_OFF, g, S, E); } \
            if (EXPERTS_BY_QUEUE) { const int n1 = NEXP * 16 * 32, h0 = __builtin_amdgcn_readfirstlane((int)VLD(F.ctl + CW_H12)), h1 = min(n1, h0 + cw * (h0 ? CONV_PER_WG1 - 64 : CONV_PER_WG1));     \
                if (cid >= gg) conv_experts_range(F, A, l, h0, h1, (cid - gg) * NWAVES + F.wave, cw * NWAVES); \
                if (cw == 0) conv_experts_range(F, A, l, h1, n1, F.vcu * NWAVES + F.wave, F.G * NWAVES); \
                else if (cid < gg) conv_experts_range(F, A, l, h1, n1, cid * NWAVES + F.wave, gg * NWAVES); }   \
            SEAM(pb + 1); \
        } \
FAST_PHASES(l) \
        if (IN(pb + 5)) { WSP(); PR_BEGIN(pb + 5); \
            pg8::Gemm g{G1_A(l), (const bf16*)(ws + WS_WIN) + (size_t)NPA * D, T, NGATE, D}; pg8::StaticOrder S; S.init(T, NGATE, F.G, cid); \
            EpiGate E{GT, (const float*)(ws + WS_RSA)}; \
            pg8::gemm_phase<EpiGate, pg8::StaticOrder, PG8_ALIGN, PG8_SP2>(F.lds + RING_OFF, g, S, E); \
            PROBE_KLOOP_EXTRA \
            SEAM(pb + 5); \
        } \
        if (IN(pb + 6)) { WSP(); PR_BEGIN(pb + 6); \
            pg8::Gemm g{YA, (const bf16*)(ws + WS_WUA), T, D, 512}; pg8::StaticOrder S; S.init(T, D, F.G, cid); \
            EpiUpA E{MG, GT}; \
            pg8::gemm_phase<EpiUpA, pg8::StaticOrder, PG8_ALIGN, PG8_SP2>(F.lds + RING_OFF, g, S, E); \
            PR_END(pb + 6);   \
        } \
        if (IN(pb + 7)) { WSP(); PR_BEGIN(pb + 7); \
            pg8::Gemm g{YH, (const bf16*)(ws + WS_WUH), T, D, 512}; pg8::StaticOrder S; S.init(T, D, F.G, cid); \
            EpiUpB E{MG, GT, (const float*)(ws + WS_SSQ)}; \
            pg8::gemm_phase<EpiUpB, pg8::StaticOrder, PG8_ALIGN, PG8_SP2>(F.lds + RING_OFF, g, S, E); \
            SEAM(pb + 7); \
        } \
        if (IN(pb + 8)) { WSP(); PR_BEGIN(pb + 8); \
            pg8::Gemm g{MG, (const bf16*)(ws + WS_WOUT), T, D, D}; pg8::StaticOrder S; S.init(T, D, F.G, cid); \
            EPIOUT_T(l) E{XB_NEW(l), XIN0(l)}; \
            pg8::gemm_phase<EPIOUT_T(l), pg8::StaticOrder, PG8_ALIGN, PG8_SP2>(F.lds + RING_OFF, g, S, E); \
            SEAM(pb + 8); \
        } \
        if (IN(pb + 9)) { WSP(); PR_BEGIN(pb + 9); ROUTE_FN(F, A, l, XB_NEW(l)); SEAM(pb + 9); } \
        if (IN(pb + 10)) { WSP(); PR_BEGIN(pb + 10); phase_dispatch(F); PROBE_BARRIERS_EXTRA SEAM(pb + 10); } \
        if (IN(pb + 11)) { WSP(); PR_BEGIN(pb + 11); \
            const int cw = MOE_HANDOFF ? 0 : conv_wgs(F.G, 4 * __builtin_amdgcn_readfirstlane((int)VLD((const int*)(ws + WS_META))), CONV_WGS_MOE), gg = F.G - cw;     \
            if (cid < gg) { pg8::Gemm g{M1_A(l), (const bf16*)(ws + WS_W1), SLOT_ROWS, D, D}; MOE_ORDER1 S; S.init((const int*)(ws + WS_META), D, gg, cid); MOE_CNT(l) \
                EpiAct E{(bf16*)(ws + WS_ACT), (const float*)(ws + WS_RSS)}; \
                pg8::gemm_phase<EpiAct, MOE_ORDER1, PG8_ALIGN, PG8_SP2, true>(F.lds + RING_OFF, g, S, E, (const int*)(ws + WS_STOK)); } \
            if (EXPERTS_BY_QUEUE) { const int n1 = NEXP * 16 * 32, n2 = NEXP * 8 * 32, h2 = min(n2, cw * CONV_PER_WG2); \
                if (cid >= gg) conv_experts_range(F, A, l, n1, n1 + h2, (cid - gg) * NWAVES + F.wave, cw * NWAVES); \
                conv_experts_range(F, A, l, n1 + h2, n1 + n2, F.vcu * NWAVES + F.wave, F.G * NWAVES); } \
            MOE_SEAM(pb + 11); \
        } \
        if (IN(pb + 12)) { WSP(); PR_BEGIN(pb + 12); \
            const int cw = (MOE_HANDOFF || !EXPERTS_BY_QUEUE || (l) == DEPTH - 1) ? 0 : conv_wgs(F.G, 4 * __builtin_amdgcn_readfirstlane((int)VLD((const int*)(ws + WS_META))), CONV_WGS_MOE), gg = F.G - cw;     \
            if (cid < gg) { pg8::Gemm g{(const bf16*)(ws + WS_ACT), (const bf16*)(ws + WS_W2), SLOT_ROWS, D, DEXP}; MOE_ORDER2 S; S.init((const int*)(ws + WS_META), D, gg, cid, MOE_HANDOFF != 0); MOE_CNT(l) \
                EpiY E{(bf16*)(ws + WS_XP)}; \
                pg8::gemm_phase<EpiY, MOE_ORDER2, PG8_ALIGN, PG8_SP2, false, MOE_HANDOFF ? 16 : 0>(F.lds + RING_OFF, g, S, E); } \
            else conv_experts_range(F, A, (l) + 1, 0, cw * CONV_PER_WG12, (cid - gg) * NWAVES + F.wave, cw * NWAVES); \
            if (cw > 0 && cid == 0 && F.tid == 0) __hip_atomic_store(F.ctl + CW_H12, (unsigned)(cw * CONV_PER_WG12), __ATOMIC_RELAXED, __HIP_MEMORY_SCOPE_AGENT);     \
            SEAM(pb + 12); \
        } \
        if (IN(pb + 13)) { WSP(); PR_BEGIN(pb + 13); \
            const bool last = (l == DEPTH - 1); \
            if (!last) conv_weights(F, A, l + 1); \
            phase_combine(F, last ? A.in[I_FING] : A.in[I_ANG] + (size_t)(l + 1) * D, last, XB_NEW(l), XB_CUR((l) + 1)); \
            if (!last) { if ((pb + 15) + 1 < hi) xcd_barrier(bar); } PR_END(pb + 13); \
        } \
    }
    LAYER_BODY(0)
    LAYER_BODY(1)
    static_assert(DEPTH == 2, "layer bodies are written out");
#if defined(PROBE_MASK)
    if (blockIdx.x == 0 && threadIdx.x == 0) { const unsigned long long t1 = wall_clock64(), want = (unsigned long long)PROBE_MULT * pr_acc; while (wall_clock64() - t1 < want) __builtin_amdgcn_s_sleep(8); }
#endif
#undef IN
#undef SEAM
}

extern "C" void kernel_launch(void* const* d_in, const int* in_sizes, int n_in, void* d_out, int out_size, void* d_ws, size_t ws_size, hipStream_t stream) {
    static int grid = 0;
    if (grid == 0) {
        if (n_in != 18 || in_sizes[0] != T * D || out_size != T * D || ws_size < WS_END) { fprintf(stderr, "kernel_launch: unexpected shapes (n_in %d, in0 %d, out %d, ws %zu); nothing launched\n", n_in, n_in > 0 ? in_sizes[0] : -1, out_size, ws_size); grid = -1; return; }
        int dev = 0, cus = 0, per_cu = 0;
        if (hipGetDevice(&dev) != hipSuccess || hipDeviceGetAttribute(&cus, hipDeviceAttributeMultiprocessorCount, dev) != hipSuccess) { grid = -1; return; }
        if (hipFuncSetAttribute((const void*)mega_fwd, hipFuncAttributeMaxDynamicSharedMemorySize, LDS_BYTES) != hipSuccess) { fprintf(stderr, "kernel_launch: hipFuncSetAttribute failed\n"); grid = -1; return; }
        if (hipOccupancyMaxActiveBlocksPerMultiprocessor(&per_cu, (const void*)mega_fwd, NWAVES * 64, LDS_BYTES) != hipSuccess || per_cu < 1)
            fprintf(stderr, "kernel_launch: note: occupancy query reports %d workgroups per CU\n", per_cu);
        (void)hipGetLastError();
        grid = cus;
    }
    if (grid < 0) return;
    if (hipMemsetAsync((char*)d_ws + WS_CTL, 0, CTL_ZERO_BYTES, stream) != hipSuccess) return;
    Args a{};
    for (int i = 0; i < 18; ++i) a.in[i] = (const float*)d_in[i];
    a.out = (float*)d_out; a.ws = (unsigned char*)d_ws; a.pad = 0;
    int li = 0;
    auto launch = [&](int lo, int hi) { a.ph_lo = lo; a.ph_hi = hi; a.li = li++; hipLaunchKernelGGL(mega_fwd, dim3(grid), dim3(NWAVES * 64), LDS_BYTES, stream, a);
        const hipError_t le = hipPeekAtLastError(); if (le != hipSuccess) fprintf(stderr, "kernel_launch: launch [%d,%d) failed: %s\n", lo, hi, hipGetErrorName(le)); };
#if defined(ORACLE)
    unsigned char* ws = (unsigned char*)d_ws;
#if defined(CHECK)
    unsigned* cnt = (unsigned*)(ws + 525 * MiB + 512 * 1024); hipMemsetAsync(cnt, 0, 4096, stream);
    hipLaunchKernelGGL(ck_mfma, dim3(1), dim3(64), 0, stream, cnt + 39); hipMemsetAsync(cnt + 512 + 700, 0xFF, 8, stream);
    const float* const* in = (const float* const*)d_in; float* xs = (float*)d_out;
    const bf16* XNc = (const bf16*)(ws + WS_XN); const bf16* PAc = (const bf16*)(ws + WS_PA); const bf16* MGc = (const bf16*)(ws + WS_US);
    const bf16* YAc = (const bf16*)(ws + WS_Y); const bf16* YHc = (const bf16*)(ws + WS_YH); const float* ssqc = (const float*)(ws + WS_SSQ);
#define CKL(k, ...) hipLaunchKernelGGL(k, dim3(CK_NS), dim3(256), 0, stream, __VA_ARGS__)
#endif
    for (int l = 0; l < DEPTH; ++l) {
#if defined(CHECK)
        const float* w_in_l = in[I_WIN] + (size_t)l * D * INW; unsigned* c0 = cnt + 20 * l;
        if (l == 0) { launch(0, 1); CKL(ck_norm, in[I_X], in[I_ANG], XNc, c0 + 0); launch(1, 2); }
        else { CKL(ck_norm, (const float*)xs, in[I_ANG] + (size_t)l * D, XNc, c0 + 0); launch(16 * l + 1, 16 * l + 2); }
        CKL(ck_pa, XNc, w_in_l, in[I_LBT], l, PAc, c0 + 1);
#else
        if (l == 0) launch(0, 2); else launch(16 * l + 1, 16 * l + 2);
#endif
#if defined(ORACLE_FAST)
        launch(16 * l + 2, 16 * l + 3);
#if defined(CHECK)
        hipLaunchKernelGGL(ck_ha, dim3(CK_NS), dim3(128), 0, stream, (const bf16*)(ws + WS_PA), (const bf16*)(ws + WS_US), (const float*)(ws + WS_HD), cnt + 20 * l + 40 + 0);
#endif
        launch(16 * l + 3, 16 * l + 4);
#if defined(CHECK)
        hipLaunchKernelGGL(ck_hb, dim3(CK_NS), dim3(128), 0, stream, (const bf16*)(ws + WS_PA), (const bf16*)(ws + WS_US), cnt + 20 * l + 40 + 2);
#endif
        launch(16 * l + 4, 16 * l + 5);
#else
        hipLaunchKernelGGL(zero_f32, dim3(T * 4 / 256), dim3(256), 0, stream, (float*)(ws + WS_SSQ), T * 4);
        hipLaunchKernelGGL(simple_attn, dim3(T * 8 / 4), dim3(256), 0, stream, (const bf16*)(ws + WS_PA), (const float*)d_in[I_SINK] + l * NQH, (bf16*)(ws + WS_Y));
        hipLaunchKernelGGL(simple_hgrn, dim3(8), dim3(512), 0, stream, (const bf16*)(ws + WS_PA), (const float*)d_in[I_HNG] + l * 512, (float*)(ws + WS_US), (bf16*)(ws + WS_YH), (float*)(ws + WS_SSQ));
#endif
#if defined(CHECK)
        CKL(ck_attn, PAc, in[I_SINK] + l * NQH, YAc, c0 + 3 + 40); hipLaunchKernelGGL(ck_hgrn, dim3(CK_NS, 4), dim3(128), 0, stream, PAc, in[I_HNG] + l * 512, YHc, ssqc, c0 + 4 + 40);
        const float* wua = in[I_WUA] + (size_t)l * 512 * D; const float* wuh = in[I_WUH] + (size_t)l * 512 * D; const int pb = 16 * l;
#if defined(CK_SENTINEL)
        hipMemsetAsync(ws + WS_PA, 0xFF, (size_t)T * NGATE * 2, stream);
#endif
#if defined(CK_FLUSH)
        hipLaunchKernelGGL(ck_flush, dim3(4096), dim3(64), 0, stream);
#endif
        launch(pb + 5, pb + 6);
#if defined(CK_FLUSH)
        hipLaunchKernelGGL(ck_flush, dim3(4096), dim3(64), 0, stream);
#endif
        if (l == 0) hipLaunchKernelGGL(ck_gates_full, dim3(T * 8), dim3(256), 0, stream, XNc, w_in_l, PAc, cnt + 512); CKL(ck_mix, XNc, w_in_l, YAc, YHc, ssqc, wua, wuh, PAc, MGc, 0, c0 + 7);
        launch(pb + 6, pb + 7); CKL(ck_mix, XNc, w_in_l, YAc, YHc, ssqc, wua, wuh, PAc, MGc, 1, c0 + 7);
        launch(pb + 7, pb + 8); CKL(ck_mix, XNc, w_in_l, YAc, YHc, ssqc, wua, wuh, PAc, MGc, 2, c0 + 7);
        launch(pb + 8, pb + 9); if (l == 0) CKL(ck_out, in[I_X], MGc, in[I_WOUT], (const float*)xs, c0 + 10);
        const float* gff = in[I_FNG] + (size_t)l * D; const float* wrg = in[I_WRG] + (size_t)l * D * NGRP; const float* brg = in[I_BRG] + l * NGRP; const float* wre = in[I_WRE] + (size_t)l * NGRP * D * EPG; const float* bre = in[I_BRE] + l * NGRP * EPG;
        const float* weg = in[I_WEG] + (size_t)l * NEXP * D * DEXP; const float* weu = in[I_WEU] + (size_t)l * NEXP * D * DEXP; const float* wed = in[I_WED] + (size_t)l * NEXP * DEXP * D;
        const int* toke = (const int*)(ws + WS_TOKE); const float* tokw = (const float*)(ws + WS_TOKW); const int* tokp = (const int*)(ws + WS_TOKP); const int* metac = (const int*)(ws + WS_META);
        const bf16* XPc = (const bf16*)(ws + WS_XP); const bf16* ACTc = (const bf16*)(ws + WS_ACT);
#define CKM(st) CKL(ck_moe, (const float*)xs, gff, wrg, brg, wre, bre, weg, weu, wed, XNc, toke, tokw, tokp, metac, XPc, ACTc, XPc, st, c0 + 12)
        launch(pb + 9, pb + 10); CKL(ck_norm, (const float*)xs, gff, XNc, c0 + 11); CKM(0);
        launch(pb + 10, pb + 11); CKM(1);
        launch(pb + 11, pb + 12); CKM(2);
        launch(pb + 12, pb + 13); CKM(3);
        hipMemcpyAsync(ws + WS_US, xs, (size_t)T * D * 4 / 2, hipMemcpyDeviceToDevice, stream);
        launch(pb + 13, pb + 14);
        CKL(ck_comb, (const float*)(ws + WS_US), (const float*)xs, tokp, tokw, XPc, in[I_FING], (int)(l == DEPTH - 1), c0 + 6 + 40);
#else
#if defined(STOP_AFTER)
        launch(16 * l + 5, STOP_AFTER + 1); break;
#else
        launch(16 * l + 5, 16 * l + 14);
#endif
#endif
    }
#if defined(CHECK)
    hipLaunchKernelGGL(ck_report, dim3(1), dim3(64), 0, stream, (const unsigned*)cnt, 80, xs);
#endif
#else
    launch(0, 16 * (DEPTH - 1) + 14);
#endif
}
```

```cpp
#include <hip/hip_runtime.h>
#include <cstdio>
#include <cstdint>
namespace pg8 {
#define PG8_LAS __attribute__((address_space(3)))
typedef unsigned short bf16_t;
typedef short bf16x8 __attribute__((ext_vector_type(8)));
typedef float f32x4 __attribute__((ext_vector_type(4)));
typedef unsigned u32x4 __attribute__((ext_vector_type(4)));
typedef unsigned u32x2 __attribute__((ext_vector_type(2)));
constexpr int BM = 256, BK = 64, HALF = 128, HTB = HALF * BK * 2  , STAGE_BYTES = 8 * HTB, NXCD = 8, WGM = 8;

__host__ __device__ __forceinline__ int lds_byte(int r, int c) { const int st = (r >> 4) * 2 + (c >> 5), rr = r & 15, cc = c & 31, ob = rr * 64 + cc * 2; return st * 1024 + (ob ^ (((ob >> 9) & 1) << 5)); }
__host__ __device__ __forceinline__ void stage_rc(int b, int& R, int& C) { const int st = b / 1024, sb = b % 1024, swz = sb ^ (((sb >> 9) & 1) << 5); R = (st >> 1) * 16 + swz / 64; C = (st & 1) * 32 + (swz % 64) / 2; }
__host__ __device__ __forceinline__ int perm32(int rho) { const int n = rho >> 4, i = rho & 15; return 8 * (i >> 2) + 4 * n + (i & 3); }

struct Unit { int pm, pn, pb; };
struct Gemm { const bf16_t* A; const bf16_t* Bt; int M, N, K; };

struct StaticOrder {
    int nM, nN, nwg, G, c;
    __host__ __device__ void init(int M, int N, int G_, int c_) { nM = M / BM; nN = N / BM; nwg = nM * nN; G = G_; c = c_; }
    __host__ __device__ bool next(int i, Unit& u) const {
        const long L = (long)i * G + c; if (L >= nwg) return false;
        int wgid = (int)L; { const int q = nwg / NXCD, r = nwg % NXCD, xcd = wgid % NXCD, off = wgid / NXCD; wgid = (xcd < r ? xcd * (q + 1) : r * (q + 1) + (xcd - r) * q) + off; }
        const int nig = WGM * nN, gid = wgid / nig, fm = gid * WGM, gsz = (nM - fm) < WGM ? (nM - fm) : WGM;
        u.pm = fm + ((wgid % nig) % gsz); u.pn = (wgid % nig) / gsz; u.pb = u.pn; return true;
    }
    __device__ __forceinline__ void a_ready(const Unit&) const {}
    __device__ __forceinline__ void done(const Unit&) const {}
};
struct GroupedOrder {
    const int* meta; int nM, nN, nwg, G, base;
    __device__ __forceinline__ void init(const int* meta_, int N, int G_, int c_, bool second = false) { meta = meta_; nM = __builtin_amdgcn_readfirstlane(__hip_atomic_load(meta_, __ATOMIC_RELAXED, __HIP_MEMORY_SCOPE_AGENT)); nN = N / BM; nwg = nM * nN; G = G_;
        base = second ? (((c_ < nwg) ? (nwg - c_ + G_ - 1) / G_ : 0) * G_ + c_ - nwg) : c_; }
    __device__ __forceinline__ bool next(int i, Unit& u) const {
        int wgid = i * G + base; if (wgid >= nwg) return false;
        { const int q = nwg / NXCD, r = nwg % NXCD, xcd = wgid % NXCD, off = wgid / NXCD; wgid = (xcd < r ? xcd * (q + 1) : r * (q + 1) + (xcd - r) * q) + off; }
        const int nig = WGM * nN, gid = wgid / nig, fm = gid * WGM, gsz = (nM - fm) < WGM ? (nM - fm) : WGM;
        u.pm = fm + ((wgid % nig) % gsz); u.pn = (wgid % nig) / gsz;
        u.pb = __builtin_amdgcn_readfirstlane(__hip_atomic_load(meta + 1 + u.pm, __ATOMIC_RELAXED, __HIP_MEMORY_SCOPE_AGENT)) * nN + u.pn; return true;
    }
    __device__ __forceinline__ void a_ready(const Unit&) const {}
    __device__ __forceinline__ void done(const Unit&) const {}
};
struct ProducerOrder : GroupedOrder {
    unsigned* cnt;
    __device__ __forceinline__ void done(const Unit& u) const {
        asm volatile("s_waitcnt vmcnt(0)" ::: "memory");
        if ((threadIdx.x & 63) == 0) __hip_atomic_fetch_add(cnt + 64 * u.pm, 1u, __ATOMIC_RELAXED, __HIP_MEMORY_SCOPE_AGENT);
    }
};
struct ConsumerOrder : GroupedOrder {
    unsigned* cnt; static constexpr unsigned NEED = 32u;
    __device__ __forceinline__ void a_ready(const Unit& u) const {
        if (threadIdx.x < 64) {
            unsigned* tmo = cnt - 64;
            const unsigned long long t0 = __builtin_amdgcn_s_memrealtime(); unsigned polls = 0;
            while ((unsigned)__builtin_amdgcn_readfirstlane(__hip_atomic_load(cnt + 64 * u.pm, __ATOMIC_RELAXED, __HIP_MEMORY_SCOPE_AGENT)) < NEED) {
                if ((++polls & 255u) == 0u && __builtin_amdgcn_readfirstlane(__hip_atomic_load(tmo, __ATOMIC_RELAXED, __HIP_MEMORY_SCOPE_AGENT)) != 0u) break;
                if (__builtin_amdgcn_s_memrealtime() - t0 > 2000000ull) {
                    if (threadIdx.x == 0) { unsigned expect = 0u; __hip_atomic_compare_exchange_strong(tmo + 1, &expect, 0x600u | (unsigned)(u.pm & 0xff), __ATOMIC_RELAXED, __ATOMIC_RELAXED, __HIP_MEMORY_SCOPE_AGENT); __hip_atomic_store(tmo, 1u, __ATOMIC_RELAXED, __HIP_MEMORY_SCOPE_AGENT); }
                    break; }
                __builtin_amdgcn_s_sleep(2); }
            asm volatile("s_waitcnt vmcnt(0)" ::: "memory");
        }
        asm volatile("" ::: "memory"); __builtin_amdgcn_s_barrier(); asm volatile("" ::: "memory");
    }
};
typedef float f32x2_t __attribute__((ext_vector_type(2))); typedef __bf16 bf16x2_t __attribute__((ext_vector_type(2)));
__device__ __forceinline__ unsigned cvt_pk_bf16(float lo, float hi) { f32x2_t v = {lo, hi}; bf16x2_t b = __builtin_convertvector(v, bf16x2_t); return __builtin_bit_cast(unsigned, b); }
template <class Epi, class Sched, bool ALIGN_EPI = false, bool SP2 = false, bool GATHER = false, int A_AUX = 0>
__device__ __forceinline__ void gemm_phase(PG8_LAS unsigned char* lds, const Gemm g, const Sched& S, const Epi& E, const int* rowtab = nullptr) {
    int tid_ = threadIdx.x; asm volatile("" : "+v"(tid_));
    const int tid = tid_, wid = __builtin_amdgcn_readfirstlane(tid >> 6), lane = tid & 63, wr = wid >> 2, wc = wid & 3, fr = lane & 15, fq = lane >> 4;
    const int K = g.K, nt = K / BK;
    unsigned voffA[2], voffB[2];
#pragma unroll
    for (int i = 0; i < 2; ++i) { int R, C; stage_rc(tid * 16 + i * 8192, R, C); const int Rb = Epi::PERM ? ((R & ~31) + perm32(R & 31)) : R;
        voffA[i] = (unsigned)(R * K + C) * 2u; voffB[i] = (unsigned)(Rb * K + C) * 2u; }
    const size_t kstep = (size_t)(BK * 2);
    const size_t hstep = (size_t)HALF * K * 2;
    const size_t tstep = 2 * hstep;
    const unsigned ldsw = (unsigned)wid * 1024u;
    const int aoff = lds_byte(wr * 64 + fr, fq * 8), boff = lds_byte(wc * 32 + fr, fq * 8);
#define PG8_SA(b, h) (((b) * 2 + (h)) * HTB)
#define PG8_SB(b, h) ((4 + (b) * 2 + (h)) * HTB)
#define PG8_STAGE(bufoff, gbase, voff) do { _Pragma("unroll") for (int _i = 0; _i < 2; ++_i) \
        __builtin_amdgcn_global_load_lds((const unsigned*)((const char*)(gbase) + (voff)[_i]), (PG8_LAS unsigned*)(lds + (bufoff) + ldsw + _i * 8192), 16, 0, 0); } while (0)
#define PG8_STAGE_A(bufoff, gbase, h, RO) do { _Pragma("unroll") for (int _i = 0; _i < 2; ++_i) \
        __builtin_amdgcn_global_load_lds((const unsigned*)((const char*)(gbase) + (GATHER ? (size_t)RO[h][_i] : (size_t)(((h) ? hstep : 0) + voffA[_i]))), (PG8_LAS unsigned*)(lds + (bufoff) + ldsw + _i * 8192), 16, 0, A_AUX); } while (0)
#define PG8_ROWOFS(RO, pm_) do { if constexpr (GATHER) { _Pragma("unroll") for (int _h = 0; _h < 2; ++_h) _Pragma("unroll") for (int _i = 0; _i < 2; ++_i) { int _R, _C; stage_rc(tid * 16 + _i * 8192, _R, _C); \
        const int _tok = __hip_atomic_load(rowtab + (pm_) * 256 + _h * 128 + _R, __ATOMIC_RELAXED, __HIP_MEMORY_SCOPE_AGENT); RO[_h][_i] = (unsigned)_tok * (unsigned)(K * 2) + (unsigned)(_C * 2); } } } while (0)
#define PG8_LDA(dst, b, h) do { _Pragma("unroll") for (int m = 0; m < 4; ++m) _Pragma("unroll") for (int k = 0; k < 2; ++k) dst[m][k] = *(const PG8_LAS bf16x8*)(lds + PG8_SA(b, h) + aoff + m * 2048 + k * 1024); } while (0)
#define PG8_LDB(dst, b, h) do { _Pragma("unroll") for (int n = 0; n < 2; ++n) _Pragma("unroll") for (int k = 0; k < 2; ++k) dst[n][k] = *(const PG8_LAS bf16x8*)(lds + PG8_SB(b, h) + boff + n * 2048 + k * 1024); } while (0)
#define PG8_MMA(ai, bj, At, Bt) do { __builtin_amdgcn_s_setprio(1); _Pragma("unroll") for (int m = 0; m < 4; ++m) _Pragma("unroll") for (int n = 0; n < 2; ++n) _Pragma("unroll") for (int k = 0; k < 2; ++k) \
        acc[ai][bj][m][n] = __builtin_amdgcn_mfma_f32_16x16x32_bf16(Bt[n][k], At[m][k], acc[ai][bj][m][n], 0, 0, 0); __builtin_amdgcn_s_setprio(0); } while (0)
#define PG8_WAIT_V(n) asm volatile("s_waitcnt vmcnt(" #n ")" ::: "memory")
#define PG8_WAIT_L(n) asm volatile("s_waitcnt lgkmcnt(" #n ")" ::: "memory")
#define PG8_BAR __builtin_amdgcn_s_barrier()
#define PG8_SCHED __builtin_amdgcn_sched_barrier(0)
    Unit cur, nxt; int ui = 0;
    if (!S.next(0, cur)) return;
    f32x4 acc[2][2][4][2];
#pragma unroll
    for (int a = 0; a < 2; ++a)
#pragma unroll
        for (int b = 0; b < 2; ++b)
#pragma unroll
            for (int m = 0; m < 4; ++m)
#pragma unroll
                for (int n = 0; n < 2; ++n) acc[a][b][m][n] = (f32x4){0.f, 0.f, 0.f, 0.f};
    bf16x8 At[4][2], B0[2][2], B1[2][2];
    const char* cA = (const char*)g.A + (GATHER ? (size_t)0 : (size_t)cur.pm * tstep); const char* cB = (const char*)g.Bt + (size_t)cur.pb * tstep;
    unsigned rofsC[2][2] = {{0u, 0u}, {0u, 0u}}, rofsN[2][2] = {{0u, 0u}, {0u, 0u}};
    PG8_ROWOFS(rofsC, cur.pm);
    S.a_ready(cur);
    if constexpr (SP2) {
        PG8_STAGE(PG8_SB(0, 0), cB, voffB); PG8_STAGE(PG8_SB(0, 1), cB + hstep, voffB); PG8_STAGE_A(PG8_SA(0, 0), cA, 0, rofsC); PG8_STAGE_A(PG8_SA(0, 1), cA, 1, rofsC);
        if (wr == 1) PG8_BAR;
        PG8_WAIT_V(2); PG8_BAR;
        PG8_STAGE(PG8_SB(1, 0), cB + kstep, voffB); PG8_STAGE_A(PG8_SA(1, 0), cA + kstep, 0, rofsC); PG8_STAGE(PG8_SB(1, 1), cB + hstep + kstep, voffB);
        PG8_WAIT_V(6); PG8_BAR;
    } else {
        PG8_STAGE(PG8_SB(0, 0), cB, voffB); PG8_STAGE_A(PG8_SA(0, 0), cA, 0, rofsC); PG8_STAGE(PG8_SB(0, 1), cB + hstep, voffB); PG8_STAGE_A(PG8_SA(0, 1), cA, 1, rofsC);
        if (wr == 1) PG8_BAR;
        PG8_WAIT_V(4); PG8_BAR;
        PG8_STAGE(PG8_SB(1, 0), cB + kstep, voffB); PG8_STAGE_A(PG8_SA(1, 0), cA + kstep, 0, rofsC); PG8_STAGE(PG8_SB(1, 1), cB + hstep + kstep, voffB);
        PG8_WAIT_V(6); PG8_BAR;
    }
    for (;;) {
        const bool has_next = S.next(ui + 1, nxt);
        const char* nA = (has_next && !GATHER) ? (const char*)g.A + (size_t)nxt.pm * tstep : cA; const char* nB = has_next ? (const char*)g.Bt + (size_t)nxt.pb * tstep : cB;
        for (int t = 0; t < nt; t += 2) {
            const bool last = (t == nt - 2);
            const char* a1 = cA + (size_t)(t + 1) * kstep;
            const char* a2 = last ? nA : cA + (size_t)(t + 2) * kstep; const char* b2 = last ? nB : cB + (size_t)(t + 2) * kstep;
            const char* a3 = a2 + kstep; const char* b3 = b2 + kstep;
            if (last && has_next) { S.a_ready(nxt); PG8_ROWOFS(rofsN, nxt.pm); }
            unsigned ro2[2][2];
#pragma unroll
            for (int _h = 0; _h < 2; ++_h)
#pragma unroll
                for (int _i = 0; _i < 2; ++_i) ro2[_h][_i] = (last && has_next) ? rofsN[_h][_i] : rofsC[_h][_i];
            if constexpr (SP2) {
            PG8_LDB(B0, 0, 0); PG8_LDB(B1, 0, 1); PG8_SCHED; PG8_LDA(At, 0, 0); PG8_STAGE_A(PG8_SA(1, 1), a1, 1, rofsC);
            PG8_WAIT_V(8); PG8_WAIT_L(0); PG8_BAR; PG8_MMA(0, 0, At, B0); PG8_MMA(0, 1, At, B1); PG8_BAR; PG8_SCHED;
            PG8_LDA(At, 0, 1); PG8_STAGE(PG8_SB(0, 0), b2, voffB); PG8_STAGE(PG8_SB(0, 1), b2 + hstep, voffB); PG8_STAGE_A(PG8_SA(0, 0), a2, 0, ro2);
            PG8_WAIT_V(8); PG8_WAIT_L(0); PG8_BAR; PG8_MMA(1, 0, At, B0); PG8_MMA(1, 1, At, B1); PG8_BAR; PG8_SCHED;
            PG8_LDB(B0, 1, 0); PG8_LDB(B1, 1, 1); PG8_SCHED; PG8_LDA(At, 1, 0); PG8_STAGE_A(PG8_SA(0, 1), a2, 1, ro2);
            PG8_WAIT_V(8); PG8_WAIT_L(0); PG8_BAR; PG8_MMA(0, 0, At, B0); PG8_MMA(0, 1, At, B1); PG8_BAR; PG8_SCHED;
            PG8_LDA(At, 1, 1); PG8_STAGE(PG8_SB(1, 0), b3, voffB); PG8_STAGE(PG8_SB(1, 1), b3 + hstep, voffB); PG8_STAGE_A(PG8_SA(1, 0), a3, 0, ro2);
            PG8_WAIT_V(8); PG8_WAIT_L(0); PG8_BAR; PG8_MMA(1, 0, At, B0); PG8_MMA(1, 1, At, B1); PG8_BAR; PG8_SCHED;
            } else {
            PG8_LDB(B0, 0, 0); PG8_SCHED; PG8_LDA(At, 0, 0); PG8_STAGE_A(PG8_SA(1, 1), a1, 1, rofsC);
            PG8_WAIT_L(8); PG8_BAR; PG8_WAIT_L(0); PG8_MMA(0, 0, At, B0); PG8_BAR; PG8_SCHED;
            PG8_LDB(B1, 0, 1); PG8_STAGE(PG8_SB(0, 0), b2, voffB);
            PG8_BAR; PG8_WAIT_L(0); PG8_MMA(0, 1, At, B1); PG8_BAR;
            PG8_LDA(At, 0, 1); PG8_STAGE_A(PG8_SA(0, 0), a2, 0, ro2);
            PG8_BAR; PG8_WAIT_L(0); PG8_MMA(1, 0, At, B0); PG8_BAR; PG8_SCHED;
            PG8_STAGE(PG8_SB(0, 1), b2 + hstep, voffB);
            PG8_WAIT_V(6); PG8_BAR; PG8_MMA(1, 1, At, B1); PG8_BAR;
            PG8_LDB(B0, 1, 0); PG8_SCHED; PG8_LDA(At, 1, 0); PG8_STAGE_A(PG8_SA(0, 1), a2, 1, ro2);
            PG8_WAIT_L(8); PG8_BAR; PG8_WAIT_L(0); PG8_MMA(0, 0, At, B0); PG8_BAR; PG8_SCHED;
            PG8_LDB(B1, 1, 1); PG8_STAGE(PG8_SB(1, 0), b3, voffB);
            PG8_BAR; PG8_WAIT_L(0); PG8_MMA(0, 1, At, B1); PG8_BAR;
            PG8_LDA(At, 1, 1); PG8_STAGE_A(PG8_SA(1, 0), a3, 0, ro2);
            PG8_BAR; PG8_WAIT_L(0); PG8_MMA(1, 0, At, B0); PG8_BAR; PG8_SCHED;
            PG8_STAGE(PG8_SB(1, 1), b3 + hstep, voffB);
            PG8_WAIT_V(6); PG8_BAR; PG8_MMA(1, 1, At, B1); PG8_BAR;
            }
        }
        if constexpr (ALIGN_EPI) { if (wr == 0) PG8_BAR; }
        if constexpr (!Epi::AFTER_DRAIN) { E(acc, cur, wr, wc, fr, fq); S.done(cur); }
        if (!has_next) break;
#pragma unroll
        for (int a = 0; a < 2; ++a)
#pragma unroll
            for (int b = 0; b < 2; ++b)
#pragma unroll
                for (int m = 0; m < 4; ++m)
#pragma unroll
                    for (int n = 0; n < 2; ++n) acc[a][b][m][n] = (f32x4){0.f, 0.f, 0.f, 0.f};
        cur = nxt; cA = nA; cB = nB; ++ui;
#pragma unroll
        for (int _h = 0; _h < 2; ++_h)
#pragma unroll
            for (int _i = 0; _i < 2; ++_i) rofsC[_h][_i] = rofsN[_h][_i];
        if constexpr (ALIGN_EPI) { if (wr == 1) PG8_BAR; }
    }
    PG8_WAIT_V(0);
    if constexpr (!ALIGN_EPI) { if (wr == 0) PG8_BAR; }
    PG8_BAR;
    if constexpr (Epi::AFTER_DRAIN) { E.fused(acc, cur, wr, wc, fr, fq, lds, wid, lane); S.done(cur); }
#undef PG8_SA
#undef PG8_SB
#undef PG8_STAGE
#undef PG8_STAGE_A
#undef PG8_ROWOFS
#undef PG8_LDA
#undef PG8_LDB
#undef PG8_MMA
#undef PG8_WAIT_V
#undef PG8_WAIT_L
#undef PG8_BAR
#undef PG8_SCHED
}
}


constexpr int NWAVES = 8;
constexpr int BATCH = 2, SEQ = 16384, D = 1024, T = BATCH * SEQ, DEPTH = 2;
constexpr int NQH = 8, NKVH = 2, HD = 64, WINDOW = 128;
constexpr int HH = 4, HDK = 128;
constexpr int NGRP = 4, EPG = 8, NEXP = 32, DEXP = 512;
constexpr int INW = 5376, NPA = 3328, NGATE = 2048;
constexpr int C_QA = 0, C_KA = 512, C_VA = 640, C_QH = 768, C_LF = 1280, C_LB = 1792, C_VH = 2304, C_SG = 2816;
constexpr float NORM_EPS = 1e-6f, LOGF_MIN = -4.0f;
constexpr float LOG2E = 1.4426950408889634f;
constexpr float QSCALE = 0.125f * LOG2E;
constexpr int CH = 128, NCH = SEQ / CH;
constexpr int SLOT_ROWS = 73728;

constexpr size_t MiB = 1u << 20;
constexpr size_t WS_CTL = 0, CTL_ZERO_BYTES = 1 * MiB;
constexpr size_t WS_COS = 1 * MiB, WS_SIN = 3 * MiB, WS_LBT = 5 * MiB;
constexpr size_t WS_WIN = 6 * MiB, WS_WUA = 17 * MiB, WS_WUH = 18 * MiB, WS_WOUT = 19 * MiB, WS_W1 = 22 * MiB, WS_W2 = 86 * MiB;
constexpr size_t WS_XN = 118 * MiB;
constexpr size_t WS_PA = 182 * MiB;
constexpr size_t WS_US = 390 * MiB;
constexpr size_t WS_Y = 454 * MiB;
constexpr size_t WS_YH = 486 * MiB;
constexpr size_t WS_HD = 518 * MiB;
constexpr size_t WS_SSQ = 519 * MiB;
constexpr size_t WS_TOKE = 520 * MiB, WS_TOKW = 521 * MiB, WS_TOKR = 522 * MiB, WS_TOKP = 523 * MiB;
constexpr size_t WS_WGCNT = 524 * MiB;
constexpr size_t WS_META = 524 * MiB + 512 * 1024;
constexpr size_t WS_STOK = 525 * MiB;
constexpr size_t WS_RSA = 526 * MiB;
constexpr size_t WS_RSF = 526 * MiB + 128 * 1024;
constexpr size_t WS_RSS = 526 * MiB + 256 * 1024;
constexpr size_t WS_END = 527 * MiB;
constexpr size_t WS_XP = WS_PA;
constexpr size_t WS_ACT = WS_PA + (size_t)SLOT_ROWS * D * 2;
static_assert(WS_ACT + (size_t)SLOT_ROWS * DEXP * 2 <= WS_Y, "MoE overlay");
static_assert(WS_PA + (size_t)T * NPA * 2 <= WS_US && WS_W2 + (size_t)NEXP * D * DEXP * 2 <= WS_XN && WS_WIN + (size_t)INW * D * 2 <= WS_WUA, "ws map");
constexpr int CW_TMO = 0, CW_CODE = 1;
constexpr int CW_BAR = 4096;
#ifndef G1A_SPLIT
#define G1A_SPLIT 0
#endif
#ifndef CONV_WGS
#define CONV_WGS 16
#endif
#ifndef CONV_WGS_MOE
#define CONV_WGS_MOE 32
#endif
#ifndef CONV_PER_WG1
#define CONV_PER_WG1 512
#endif
#ifndef CONV_PER_WG2
#define CONV_PER_WG2 256
#endif
#ifndef CONV_PER_WG12
#define CONV_PER_WG12 192
#endif
#ifndef ROUTE_MFMA
#define ROUTE_MFMA 1
#endif
#ifndef NORM4
#define NORM4 0
#endif
#ifndef NORMFOLD
#define NORMFOLD 1
#endif
#ifndef XBF16
#define XBF16 1
#endif
#ifndef CONV_ASM_LOADS
#define CONV_ASM_LOADS 0
#endif
#ifndef EXPERTS_BY_QUEUE
#define EXPERTS_BY_QUEUE 1
#endif
#ifndef MOE_HANDOFF
#define MOE_HANDOFF 0
#endif
constexpr int MAX_LAUNCH = 16;
constexpr int CW_H12 = 2048;
constexpr int CW_MOE = 131072, MOE_BANK = 320 * 64;

constexpr int RING_OFF = 0, RING_BYTES = 131072;
constexpr int LDSCTL_OFF = RING_BYTES, MISC_OFF = LDSCTL_OFF + 320;
#ifndef ROUTE4
#define ROUTE4 1
#endif
constexpr int LDS_BYTES = ROUTE4 ? 163840 : 147456;

#define GAS __attribute__((address_space(1)))
#define LAS __attribute__((address_space(3)))
typedef unsigned short bf16;
typedef unsigned v4u __attribute__((ext_vector_type(4)));
typedef unsigned v2u __attribute__((ext_vector_type(2)));
typedef float f32x4 __attribute__((ext_vector_type(4)));
typedef short bf16x8 __attribute__((ext_vector_type(8)));
typedef short s16x4 __attribute__((ext_vector_type(4)));
typedef _Float16 h16x4 __attribute__((ext_vector_type(4)));
typedef _Float16 h16x8 __attribute__((ext_vector_type(8)));
typedef GAS unsigned gu32;
typedef GAS unsigned long long gu64;
#define RLX_AGENT __ATOMIC_RELAXED, __HIP_MEMORY_SCOPE_AGENT
#define LDS_WAIT() asm volatile("s_waitcnt lgkmcnt(0)" ::: "memory")
#define VM_WAIT() asm volatile("s_waitcnt vmcnt(0)" ::: "memory")
__device__ __forceinline__ unsigned f2bf(float f) { unsigned u = __builtin_bit_cast(unsigned, f); return (u + 0x7fffu + ((u >> 16) & 1u)) >> 16; }
__device__ __forceinline__ unsigned pk2(float lo, float hi) { return f2bf(lo) | (f2bf(hi) << 16); }
__device__ __forceinline__ float bf2f(unsigned short b) { return __builtin_bit_cast(float, ((unsigned)b) << 16); }
__device__ __forceinline__ float bflo(unsigned w) { return __builtin_bit_cast(float, w << 16); }
__device__ __forceinline__ float bfhi(unsigned w) { return __builtin_bit_cast(float, w & 0xffff0000u); }
__device__ __forceinline__ float fast_rcp(float x) { return __builtin_amdgcn_rcpf(x); }
__device__ __forceinline__ float sigmoidf_(float x) { return fast_rcp(1.0f + __expf(-x)); }
__device__ __forceinline__ float siluf_(float x) { return x * fast_rcp(1.0f + __expf(-x)); }

#define XB_TMO      128
#define XB_XCNT(j)  (256  + 64 * (j))
#define XB_XSUB(j)  (1280 + 64 * (j))
#define XB_XGEN(j)  (2304 + 64 * (j))
#define XB_TOP      3328
#define XB_TOPGEN   3392
#define XCD_BAR_WORDS 3456
#define XB_SPIN_CAP (1u << 18)

__device__ __forceinline__ unsigned xb_ld(unsigned* p)              { return __hip_atomic_load(p, __ATOMIC_RELAXED, __HIP_MEMORY_SCOPE_AGENT); }
__device__ __forceinline__ unsigned xb_add(unsigned* p, unsigned v) { return __hip_atomic_fetch_add(p, v, __ATOMIC_RELAXED, __HIP_MEMORY_SCOPE_AGENT); }
__device__ __forceinline__ unsigned xb_xcc_id() { return (unsigned)__builtin_amdgcn_s_getreg((3 << 11) | 20) & 0xFu; }
#define XB_SPIN(cond, bar) do { unsigned _sp = 0; while (cond) { __builtin_amdgcn_s_sleep(1); \
    if ((++_sp & 255u) == 0u) { if (xb_ld(&(bar)[XB_TMO])) break; if (_sp > XB_SPIN_CAP) { atomicAdd(&(bar)[XB_TMO], 1u); break; } } } } while (0)

struct XcdBarrier {
    unsigned* bar; unsigned x;
    volatile LAS unsigned* st;
};

__device__ __forceinline__ XcdBarrier xcd_barrier_post(unsigned* bar, volatile LAS unsigned* st) {
    XcdBarrier b; b.bar = bar; b.x = xb_xcc_id(); b.st = st;
    if (threadIdx.x == 0) (void)xb_add(&bar[XB_XCNT(b.x)], 1u);
    return b;
}
__device__ __forceinline__ void xcd_barrier_complete(unsigned* bar, unsigned x, unsigned& nloc, unsigned& nx) {
    const unsigned G = gridDim.x * gridDim.y * gridDim.z;
    unsigned sum, cnt, mine, sp = 0u;
    for (;;) {
        sum = 0u; cnt = 0u; mine = 0u;
#pragma unroll
        for (unsigned j = 0; j < 16; ++j) { const unsigned c = xb_ld(&bar[XB_XCNT(j)]); sum += c; cnt += (c > 0u) ? 1u : 0u; mine = (j == x) ? c : mine; }
        if (sum == G) break;
        __builtin_amdgcn_s_sleep(1);
        if ((++sp & 255u) == 0u) { if (xb_ld(&bar[XB_TMO])) break; if (sp > XB_SPIN_CAP) { atomicAdd(&bar[XB_TMO], 1u); break; } }
    }
    nloc = mine > 0u ? mine : 1u; nx = cnt > 0u ? cnt : 1u;
}

__device__ __forceinline__ void xcd_barrier(const XcdBarrier& b) {
    asm volatile("s_waitcnt vmcnt(0)" ::: "memory");
    __syncthreads();
    if (threadIdx.x == 0) {
        unsigned* bar = b.bar;
        __builtin_amdgcn_s_waitcnt(0);
        unsigned nloc = b.st[0], nx = b.st[1];
        if (nloc == 0u) { xcd_barrier_complete(bar, b.x, nloc, nx); b.st[0] = nloc; b.st[1] = nx; }
        const unsigned old = xb_add(&bar[XB_XSUB(b.x)], 1u);
        const unsigned gen = old / nloc;
        if (old + 1u == (gen + 1u) * nloc) {
            __builtin_amdgcn_fence(__ATOMIC_RELEASE, "agent");
            asm volatile("s_waitcnt vmcnt(0)" ::: "memory");
            const unsigned og = xb_add(&bar[XB_TOP], 1u);
            const unsigned tg = og / nx;
            if (og + 1u == (tg + 1u) * nx) xb_add(&bar[XB_TOPGEN], 1u);
            else XB_SPIN(xb_ld(&bar[XB_TOPGEN]) == tg, bar);
            __builtin_amdgcn_fence(__ATOMIC_ACQUIRE, "agent");
            xb_add(&bar[XB_XGEN(b.x)], 1u);
            asm volatile("s_waitcnt vmcnt(0)" ::: "memory");
        } else {
            XB_SPIN(xb_ld(&bar[XB_XGEN(b.x)]) == gen, bar);
            __builtin_amdgcn_fence(__ATOMIC_ACQUIRE, "agent");
            asm volatile("s_waitcnt vmcnt(0)" ::: "memory");
        }
    }
    __syncthreads();
}

struct Frame {
    LAS unsigned char* lds;
    volatile LAS unsigned* MISC;
    gu32* ctl;
    int tid, lane, wave, vcu, G;
    unsigned char* ws;
    float* out;
};
struct Args { const float* in[18]; float* out; unsigned char* ws; int ph_lo, ph_hi, li, pad; };
enum { I_X = 0, I_ANG, I_WIN, I_SINK, I_LBT, I_HNG, I_WUA, I_WUH, I_WOUT, I_FNG, I_WRG, I_BRG, I_WRE, I_BRE, I_WEG, I_WEU, I_WED, I_FING };

__device__ __forceinline__ float wave_sum(float v) {
#if defined(__HIP_DEVICE_COMPILE__)
#define WS_ROR(n) v += __builtin_bit_cast(float, __builtin_amdgcn_update_dpp(0, __builtin_bit_cast(int, v), 0x120 + (n), 0xf, 0xf, false))
    WS_ROR(8); WS_ROR(4); WS_ROR(2); WS_ROR(1);
#undef WS_ROR
    const int b = __builtin_bit_cast(int, v);
    const float r0 = __builtin_bit_cast(float, __builtin_amdgcn_readlane(b, 0)), r1 = __builtin_bit_cast(float, __builtin_amdgcn_readlane(b, 16));
    const float r2 = __builtin_bit_cast(float, __builtin_amdgcn_readlane(b, 32)), r3 = __builtin_bit_cast(float, __builtin_amdgcn_readlane(b, 48));
    return (r0 + r1) + (r2 + r3);
#else
    return v;
#endif
}

struct CmPerm { const float* W; int N; __device__ __forceinline__ const float* seg(int p0, int n, int c, int& ld) const { ld = N; return W + p0 + 8 * c + 4 * n; } };
struct CmIn { const float* W; __device__ __forceinline__ const float* seg(int p0, int n, int c, int& ld) const { ld = INW;
    return (p0 < C_VA) ? (W + (p0 & ~63) + 32 * n + 16 * ((p0 >> 5) & 1) + 4 * c) : (W + p0 + 8 * c + 4 * n); } };
struct CmGU { const float* Wg; const float* Wu; __device__ __forceinline__ const float* seg(int p0, int n, int c, int& ld) const { ld = DEXP; return (n ? Wu : Wg) + 16 * (p0 >> 5) + 4 * c; } };
template <class CM> __device__ __forceinline__ void transpose_load(const CM& cm, int kb, int nb, int lane, f32x4 (&v)[8]) {
    const int k0 = 64 * kb, n0 = 32 * nb;
    const int nc = lane & 7, kr = lane >> 3;
    int ld; const float* src; { const float* s0 = cm.seg(n0, 0, nc & 3, ld); const float* s1 = cm.seg(n0, 1, nc & 3, ld); src = (nc >> 2) ? s1 : s0; }
#pragma unroll
    for (int i = 0; i < 8; ++i) v[i] = *(const GAS f32x4*)(src + (size_t)(k0 + 8 * i + kr) * ld);
}
__device__ __forceinline__ void transpose_finish(int K, bf16* WT, LAS float* scr, int kb, int nb, int lane, const f32x4 (&v)[8], const LAS float* gk = nullptr) {
    constexpr int SP = 36;
    const int k0 = 64 * kb, n0 = 32 * nb;
    const int nc = lane & 7, kr = lane >> 3;
#pragma unroll
    for (int i = 0; i < 8; ++i) *(LAS f32x4*)(scr + (8 * i + kr) * SP + 4 * nc) = gk ? v[i] * gk[k0 + 8 * i + kr] : v[i];
    LDS_WAIT(); asm volatile("" ::: "memory");
    const int c = lane & 7;
#pragma unroll
    for (int j = 0; j < 4; ++j) { const int n = (lane >> 3) + 8 * j; const LAS float* s = scr + (8 * c) * SP + n;
        v4u o; o.x = pk2(s[0 * SP], s[1 * SP]); o.y = pk2(s[2 * SP], s[3 * SP]); o.z = pk2(s[4 * SP], s[5 * SP]); o.w = pk2(s[6 * SP], s[7 * SP]);
        *(GAS v4u*)(WT + (size_t)(n0 + n) * K + k0 + 8 * c) = o; }
    LDS_WAIT(); asm volatile("" ::: "memory");
}
template <class CM> __device__ __forceinline__ void transpose_item(const CM& cm, int K, bf16* WT, LAS float* scr, int kb, int nb, int lane, const LAS float* gk = nullptr) {
    f32x4 v[8]; transpose_load(cm, kb, nb, lane, v); transpose_finish(K, WT, scr, kb, nb, lane, v, gk);
}
__device__ __forceinline__ void conv_weights(Frame& F, const Args& A, int l) {
    LAS float* scr = (LAS float*)(F.lds + RING_OFF + F.wave * 16384);
    const int gw = F.vcu * NWAVES + F.wave, NGW = F.G * NWAVES;
    unsigned char* ws = F.ws;
    const float* w_in = A.in[I_WIN] + (size_t)l * D * INW;
    const float* w_ua = A.in[I_WUA] + (size_t)l * 512 * D;
    const float* w_uh = A.in[I_WUH] + (size_t)l * 512 * D;
    const float* w_out = A.in[I_WOUT] + (size_t)l * D * D;
    const float* w_eg = A.in[I_WEG] + (size_t)l * NEXP * D * DEXP;
    const float* w_eu = A.in[I_WEU] + (size_t)l * NEXP * D * DEXP;
    const float* w_ed = A.in[I_WED] + (size_t)l * NEXP * DEXP * D;
    constexpr int I_A = 16 * (INW / 32), I_B = 8 * 32, I_D = 16 * 32, I_E1 = 16 * 32, I_E = NEXP * I_E1, I_F1 = 8 * 32, I_F = NEXP * I_F1;
    constexpr int NITEMS = I_A + 2 * I_B + I_D + (EXPERTS_BY_QUEUE ? 0 : I_E + I_F);
    LAS float* gkl = scr + 2560;
    if (NORMFOLD) { const float* gsrc = A.in[I_ANG] + (size_t)l * D;
#pragma unroll
        for (int j = 0; j < 4; ++j) *(LAS f32x4*)(gkl + 4 * F.lane + 256 * j) = *(const f32x4*)(gsrc + 4 * F.lane + 256 * j);
        LDS_WAIT(); }
    for (int it = gw; it < NITEMS; it += NGW) {
        int r = it;
        if (r < I_A) { CmIn cm{w_in}; transpose_item(cm, D, (bf16*)(ws + WS_WIN), scr, r / (INW / 32), r % (INW / 32), F.lane, NORMFOLD ? gkl : nullptr); continue; } r -= I_A;
        if (r < I_B) { CmPerm cm{w_ua, D}; transpose_item(cm, 512, (bf16*)(ws + WS_WUA), scr, r / 32, r % 32, F.lane); continue; } r -= I_B;
        if (r < I_B) { CmPerm cm{w_uh, D}; transpose_item(cm, 512, (bf16*)(ws + WS_WUH), scr, r / 32, r % 32, F.lane); continue; } r -= I_B;
        if (r < I_D) { CmPerm cm{w_out, D}; transpose_item(cm, D, (bf16*)(ws + WS_WOUT), scr, r / 32, r % 32, F.lane); continue; } r -= I_D;
        if (r < I_E) { const int e = r / I_E1, q = r % I_E1; CmGU cm{w_eg + (size_t)e * D * DEXP, w_eu + (size_t)e * D * DEXP};
            transpose_item(cm, D, (bf16*)(ws + WS_W1) + (size_t)e * 1024 * D, scr, q / 32, q % 32, F.lane); continue; } r -= I_E;
        { const int e = r / I_F1, q = r % I_F1; CmPerm cm{w_ed + (size_t)e * DEXP * D, D};
            transpose_item(cm, DEXP, (bf16*)(ws + WS_W2) + (size_t)e * D * DEXP, scr, q / 32, q % 32, F.lane); }
    }
}
__device__ __forceinline__ int conv_wgs(int G, int units, int cmax) {
    if (!EXPERTS_BY_QUEUE || G < 64 || (G % 8) != 0) return 0;
    const int r = (units + G - 1) / G; int c = cmax;
    while (c > 0 && (units + (G - c) - 1) / (G - c) > r) c -= 8;
    return c;
}
__device__ __forceinline__ void conv_experts_range(Frame& F, const Args& A, int l, int first, int last, int wi, int nw) {
    LAS float* scr = (LAS float*)(F.lds + RING_OFF + F.wave * 16384);
    unsigned char* ws = F.ws;
    const float* w_eg = A.in[I_WEG] + (size_t)l * NEXP * D * DEXP;
    const float* w_eu = A.in[I_WEU] + (size_t)l * NEXP * D * DEXP;
    const float* w_ed = A.in[I_WED] + (size_t)l * NEXP * DEXP * D;
    LAS float* gkl = scr + 2560;
    if (NORMFOLD && first < last) { const float* gsrc = A.in[I_FNG] + (size_t)l * D;
#pragma unroll
        for (int j = 0; j < 4; ++j) *(LAS f32x4*)(gkl + 4 * F.lane + 256 * j) = *(const f32x4*)(gsrc + 4 * F.lane + 256 * j);
        LDS_WAIT(); }
    constexpr int I_E1 = 16 * 32, I_E = NEXP * I_E1, I_F1 = 8 * 32;
    static_assert(I_E % 2 == 0 && I_F1 % 2 == 0, "pairs do not straddle");
#define CQ_LOAD(q, va, vb) do { const bool w1_ = (q) < I_E; const int r0_ = w1_ ? (q) : (q) - I_E, e_ = w1_ ? (r0_ >> 9) : (r0_ >> 8), r_ = w1_ ? (r0_ & 511) : (r0_ & 255), kb_ = r_ >> 5, nb_ = r_ & 31; \
        const int nc_ = F.lane & 7, kr_ = F.lane >> 3, n_ = nc_ >> 2, c_ = nc_ & 3; const size_t eo_ = (size_t)e_ * D * DEXP; \
        const float* base_ = w1_ ? ((n_ ? w_eu : w_eg) + eo_ + 16 * nb_ + 4 * c_) : (w_ed + eo_ + 32 * nb_ + 8 * c_ + 4 * n_); const int ld_ = w1_ ? DEXP : D, st_ = w1_ ? 16 : 32; \
        _Pragma("unroll") for (int i_ = 0; i_ < 8; ++i_) { const GAS float* p_ = (const GAS float*)(base_ + (size_t)(64 * kb_ + 8 * i_ + kr_) * ld_); const GAS float* p2_ = p_ + st_; \
            CQ_LD(va[i_], p_); CQ_LD(vb[i_], p2_); } } while (0)
#if CONV_ASM_LOADS
#define CQ_LD(dst, p) asm volatile("global_load_dwordx4 %0, %1, off" : "=&v"(dst) : "v"(p) : "memory")
#define CQ_WAIT(n, va, vb) asm volatile("s_waitcnt vmcnt(" #n ")" : "+v"(va[0]), "+v"(va[1]), "+v"(va[2]), "+v"(va[3]), "+v"(va[4]), "+v"(va[5]), "+v"(va[6]), "+v"(va[7]), \
        "+v"(vb[0]), "+v"(vb[1]), "+v"(vb[2]), "+v"(vb[3]), "+v"(vb[4]), "+v"(vb[5]), "+v"(vb[6]), "+v"(vb[7]) :: "memory")
#else
#define CQ_LD(dst, p) dst = *(const GAS f32x4*)(p)
#define CQ_WAIT(n, va, vb) do { } while (0)
#endif
#define CQ_FINISH(q, va, vb) do { const bool w1_ = (q) < I_E; const int r0_ = w1_ ? (q) : (q) - I_E, e_ = w1_ ? (r0_ >> 9) : (r0_ >> 8), r_ = w1_ ? (r0_ & 511) : (r0_ & 255); \
        bf16* WT_ = (w1_ ? (bf16*)(ws + WS_W1) : (bf16*)(ws + WS_W2)) + (size_t)e_ * (w1_ ? 1024 * D : D * DEXP); const int K_ = w1_ ? D : DEXP; \
        const LAS float* gk_ = (NORMFOLD && w1_) ? gkl : nullptr; transpose_finish(K_, WT_, scr, r_ >> 5, r_ & 31, F.lane, va, gk_); transpose_finish(K_, WT_, scr, r_ >> 5, (r_ & 31) + 1, F.lane, vb, gk_); } while (0)
    static_assert(I_E1 == 512 && I_F1 == 256, "shifts above");
    f32x4 a0[8], a1[8], b0[8], b1[8];
    const int step = 2 * nw;
    int qa = first + 2 * wi, qb; if (qa >= last) return;
    CQ_LOAD(qa, a0, a1);
    for (;;) {
        qb = qa + step; const bool hb = qb < last; { const int ql = hb ? qb : qa; CQ_LOAD(ql, b0, b1); }
        CQ_WAIT(16, a0, a1); CQ_FINISH(qa, a0, a1);
        if (!hb) { CQ_WAIT(0, b0, b1); break; }
        qa = qb + step; const bool ha = qa < last; { const int ql = ha ? qa : qb; CQ_LOAD(ql, a0, a1); }
        CQ_WAIT(16, b0, b1); CQ_FINISH(qb, b0, b1);
        if (!ha) { CQ_WAIT(0, a0, a1); break; }
    }
#undef CQ_WAIT
#undef CQ_LD
#undef CQ_LOAD
#undef CQ_FINISH
}
__device__ __forceinline__ void make_tables(Frame& F, const Args& A) {
    const int gt = F.vcu * (NWAVES * 64) + F.tid, NT = F.G * NWAVES * 64;
    float* cosT = (float*)(F.ws + WS_COS); float* sinT = (float*)(F.ws + WS_SIN); float* lbt = (float*)(F.ws + WS_LBT);
    for (int idx = gt; idx < SEQ * 32; idx += NT) { const int pos = idx >> 5, i = idx & 31;
        const double inv = exp2(-(double)i * (13.287712379549449 / 32.0));
        const double ang = (double)pos * inv; const double r = ang - 6.283185307179586476925 * rint(ang * 0.15915494309189533577);
        float s, c; sincosf((float)r, &s, &c); cosT[idx] = c; sinT[idx] = s; }
    for (int idx = gt; idx < 2 * 512; idx += NT) { const int dir = idx >> 9, col = idx & 511;
        float tv[DEPTH]; float mx = -3.0e38f;
#pragma unroll
        for (int l = 0; l < DEPTH; ++l) { tv[l] = A.in[I_LBT][(size_t)(l * 2 + dir) * 512 + col]; mx = fmaxf(mx, tv[l]); }
        float den = 0.f;
#pragma unroll
        for (int l = 0; l < DEPTH; ++l) { tv[l] = expf(tv[l] - mx); den += tv[l]; }
        float cum = 0.f;
#pragma unroll
        for (int l = 0; l < DEPTH; ++l) { if (l > 0) cum += tv[l] / den; const float lb = cum;
            lbt[((l * 2 + dir) * 2 + 0) * 512 + col] = lb; lbt[((l * 2 + dir) * 2 + 1) * 512 + col] = 0.f; } }
}
__device__ __forceinline__ void norm_rows(Frame& F, const float* xin, float* xcopy, const float* g, bf16* xn, float* rs_out = nullptr) {
    const int gw = F.vcu * NWAVES + F.wave, NGW = F.G * NWAVES;
    f32x4 gv[4];
#pragma unroll
    for (int j = 0; j < 4; ++j) gv[j] = *(const f32x4*)(g + 4 * F.lane + 256 * j);
    f32x4 vn[4];
    { const GAS f32x4* xr = (const GAS f32x4*)(xin + (size_t)gw * D) + F.lane;
#pragma unroll
      for (int j = 0; j < 4; ++j) vn[j] = xr[64 * j]; }
    for (int m = gw; m < T; m += NGW) {
        f32x4 v[4]; float s = 0.f;
#pragma unroll
        for (int j = 0; j < 4; ++j) { v[j] = vn[j]; s += (v[j].x * v[j].x + v[j].y * v[j].y) + (v[j].z * v[j].z + v[j].w * v[j].w); }
        if (m + NGW < T) { const GAS f32x4* xr = (const GAS f32x4*)(xin + (size_t)(m + NGW) * D) + F.lane;
#pragma unroll
            for (int j = 0; j < 4; ++j) vn[j] = xr[64 * j]; }
        const float rstd = 1.0f / sqrtf(wave_sum(s) * (1.f / D) + NORM_EPS);
        if (xcopy) { GAS f32x4* xo = (GAS f32x4*)(xcopy + (size_t)m * D) + F.lane;
#pragma unroll
            for (int j = 0; j < 4; ++j) xo[64 * j] = v[j]; }
        GAS v2u* o8 = (GAS v2u*)(xn + (size_t)m * D) + F.lane;
#pragma unroll
        for (int j = 0; j < 4; ++j) { const f32x4 y = rs_out ? v[j] : v[j] * rstd * gv[j]; v2u w; w.x = pk2(y.x, y.y); w.y = pk2(y.z, y.w); o8[64 * j] = w; }
        if (rs_out && F.lane == 0) rs_out[m] = rstd;
    }
}

__device__ __forceinline__ float row_sum16n(float v) {
#if defined(__HIP_DEVICE_COMPILE__)
#define RS_ROR(n) v += __builtin_bit_cast(float, __builtin_amdgcn_update_dpp(0, __builtin_bit_cast(int, v), 0x120 + (n), 0xf, 0xf, false))
    RS_ROR(8); RS_ROR(4); RS_ROR(2); RS_ROR(1);
#undef RS_ROR
#endif
    return v;
}
__device__ __forceinline__ void norm_rows4(Frame& F, const float* xin, const float* g, bf16* xn) {
    const int gw = F.vcu * NWAVES + F.wave, NGW = F.G * NWAVES, r = F.lane >> 4, c = F.lane & 15;
    constexpr int NTG = T / 4;
    f32x4 vq[16], gq[16];
#pragma unroll
    for (int k = 0; k < 16; ++k) gq[k] = *(const f32x4*)(g + 64 * k + 4 * c);
    if (gw < NTG) { const GAS f32x4* xr = (const GAS f32x4*)(xin + (size_t)(4 * gw + r) * D) + c;
#pragma unroll
        for (int k = 0; k < 16; ++k) vq[k] = xr[16 * k]; }
    for (int tg = gw; tg < NTG; tg += NGW) { const int m = 4 * tg + r;
        f32x4 v[16]; float s = 0.f;
#pragma unroll
        for (int k = 0; k < 16; ++k) { v[k] = vq[k]; s += (v[k].x * v[k].x + v[k].y * v[k].y) + (v[k].z * v[k].z + v[k].w * v[k].w); }
        if (tg + NGW < NTG) { const GAS f32x4* xr = (const GAS f32x4*)(xin + (size_t)(4 * (tg + NGW) + r) * D) + c;
#pragma unroll
            for (int k = 0; k < 16; ++k) vq[k] = xr[16 * k]; }
        const float rstd = 1.0f / sqrtf(row_sum16n(s) * (1.f / D) + NORM_EPS);
        GAS v2u* o8 = (GAS v2u*)(xn + (size_t)m * D) + c;
#pragma unroll
        for (int k = 0; k < 16; ++k) { const f32x4 y = v[k] * rstd * gq[k]; v2u w; w.x = pk2(y.x, y.y); w.y = pk2(y.z, y.w); o8[16 * k] = w; }
    }
}

using pg8::Unit; using pg8::cvt_pk_bf16;
__device__ __forceinline__ v4u pack8(const f32x4& a, const f32x4& b) { v4u w; w.x = cvt_pk_bf16(a[0], a[1]); w.y = cvt_pk_bf16(a[2], a[3]); w.z = cvt_pk_bf16(b[0], b[1]); w.w = cvt_pk_bf16(b[2], b[3]); return w; }
__device__ __forceinline__ void unpack8(const v4u& w, f32x4& a, f32x4& b) { a = (f32x4){bflo(w.x), bfhi(w.x), bflo(w.y), bfhi(w.y)}; b = (f32x4){bflo(w.z), bfhi(w.z), bflo(w.w), bfhi(w.w)}; }
__device__ __forceinline__ float logf_gate(float z, float lb) {
    const float t = __expf(-fabsf(z)), num = (z >= 0.f) ? __builtin_fmaf(lb, t, 1.0f) : (lb + t);
    const float r2 = __builtin_amdgcn_logf(num) - __builtin_amdgcn_logf(1.0f + t);
    return fmaxf(r2, LOGF_MIN * 1.4426950408889634f);
}
struct EpiInA {
    static constexpr bool PERM = false, AFTER_DRAIN = false;
    bf16* PA; const float* cosT; const float* sinT; const float* lbt;
    int pofs;
    const float* rs;
    __device__ __forceinline__ void operator()(const f32x4 (&acc)[2][2][4][2], const Unit& u, int wr, int wc, int fr, int fq) const {
        const int pn = u.pn + pofs, row0 = u.pm * 256 + wr * 64 + fr;
        float rsv[2][4];
#pragma unroll
        for (int ai = 0; ai < 2; ++ai)
#pragma unroll
            for (int m = 0; m < 4; ++m) rsv[ai][m] = NORMFOLD ? rs[row0 + 128 * ai + 16 * m] : 1.0f;
#pragma unroll
        for (int bj = 0; bj < 2; ++bj) {
            int mode = 0; float sc = 1.f; int lbo = 0;
            if (pn < 2) { mode = 1; sc = QSCALE; } else if (pn == 2) { mode = (bj == 0) ? 1 : 0; } else if (pn < 5) mode = 2;
            else if (pn < 7) { mode = 3; lbo = (pn - 5) * 256; } else if (pn < 9) { mode = 3; lbo = 1024 + (pn - 7) * 256; } else if (pn < 11) mode = 0; else mode = 2;
            if (mode == 1) {
                const int hb = 256 * pn + 128 * bj + 64 * (wc >> 1), d0 = 16 * (wc & 1) + 4 * fq;
#pragma unroll
                for (int ai = 0; ai < 2; ++ai) { f32x4 csv[4], snv[4];
#pragma unroll
                    for (int m = 0; m < 4; ++m) { const int pos = (row0 + 128 * ai + 16 * m) & (SEQ - 1); csv[m] = *(const f32x4*)(cosT + pos * 32 + d0); snv[m] = *(const f32x4*)(sinT + pos * 32 + d0); }
#pragma unroll
                    for (int m = 0; m < 4; ++m) { const int r = row0 + 128 * ai + 16 * m;
                        const f32x4 cs = csv[m], sn = snv[m];
                        const f32x4 x1 = acc[ai][bj][m][0], x2 = acc[ai][bj][m][1];
                        const float scr_ = sc * rsv[ai][m];
                        const f32x4 o1 = (x1 * cs - x2 * sn) * scr_, o2 = (x2 * cs + x1 * sn) * scr_;
                        bf16* rp = PA + (size_t)r * NPA + hb + d0;
                        v2u w1; w1.x = cvt_pk_bf16(o1[0], o1[1]); w1.y = cvt_pk_bf16(o1[2], o1[3]); *(v2u*)rp = w1;
                        v2u w2; w2.x = cvt_pk_bf16(o2[0], o2[1]); w2.y = cvt_pk_bf16(o2[2], o2[3]); *(v2u*)(rp + 32) = w2; }
                    asm volatile("" ::: "memory"); }
            } else {
                const int c0 = 256 * pn + 128 * bj + 32 * wc + 8 * fq;
                if (mode == 3) {
                    const float* lp = lbt + lbo + 128 * bj + 32 * wc + 8 * fq;
#pragma unroll
                    for (int n = 0; n < 2; ++n) { const f32x4 la = *(const f32x4*)(lp + 4 * n);
#pragma unroll
                        for (int ai = 0; ai < 2; ++ai)
#pragma unroll
                            for (int m = 0; m < 4; ++m) { const int r = row0 + 128 * ai + 16 * m; bf16* rp = PA + (size_t)r * NPA + c0 + 4 * n;
                                const f32x4 v = acc[ai][bj][m][n] * rsv[ai][m]; h16x4 hv;
#pragma unroll
                                for (int j = 0; j < 4; ++j) hv[j] = (_Float16)logf_gate(v[j], la[j]);
                                *(h16x4*)rp = hv; asm volatile("" ::: "memory"); } }
                } else {
#pragma unroll
                    for (int ai = 0; ai < 2; ++ai)
#pragma unroll
                        for (int m = 0; m < 4; ++m) { const int r = row0 + 128 * ai + 16 * m; bf16* rp = PA + (size_t)r * NPA + c0;
                            f32x4 v0 = acc[ai][bj][m][0], v1 = acc[ai][bj][m][1];
                            if (NORMFOLD) { const float rr = rsv[ai][m]; v0 = v0 * rr; v1 = v1 * rr; }
                            if (mode == 2) {
#pragma unroll
                                for (int j = 0; j < 4; ++j) { v0[j] = siluf_(v0[j]); v1[j] = siluf_(v1[j]); } }
                            *(v4u*)rp = pack8(v0, v1); asm volatile("" ::: "memory"); }
                }
            }
        }
    }
};
struct EpiGate {
    static constexpr bool PERM = false, AFTER_DRAIN = false;
    bf16* O; const float* rs;
    __device__ __forceinline__ void operator()(const f32x4 (&acc)[2][2][4][2], const Unit& u, int wr, int wc, int fr, int fq) const {
        const int row0 = u.pm * 256 + wr * 64 + fr, c0 = 256 * u.pn + 32 * wc + 8 * fq;
        float rsv[2][4];
#pragma unroll
        for (int ai = 0; ai < 2; ++ai)
#pragma unroll
            for (int m = 0; m < 4; ++m) rsv[ai][m] = NORMFOLD ? rs[row0 + 128 * ai + 16 * m] : 1.0f;
#pragma unroll
        for (int ai = 0; ai < 2; ++ai)
#pragma unroll
            for (int m = 0; m < 4; ++m) { bf16* rp = O + (size_t)(row0 + 128 * ai + 16 * m) * NGATE + c0; const float rr = rsv[ai][m];
#pragma unroll
                for (int bj = 0; bj < 2; ++bj) { f32x4 v0 = acc[ai][bj][m][0] * rr, v1 = acc[ai][bj][m][1] * rr;
#if !defined(CK_PLAIN)
#pragma unroll
                    for (int j = 0; j < 4; ++j) { v0[j] = sigmoidf_(v0[j]); v1[j] = sigmoidf_(v1[j]); }
#endif
                    *(v4u*)(rp + 128 * bj) = pack8(v0, v1); } }
    }
};
#if defined(PROBE_KLOOP)
struct EpiNull {
    static constexpr bool PERM = false, AFTER_DRAIN = false;
    bf16* O;
    __device__ __forceinline__ void operator()(const f32x4 (&acc)[2][2][4][2], const Unit& u, int wr, int wc, int fr, int fq) const {
        float s = 0.f;
#pragma unroll
        for (int ai = 0; ai < 2; ++ai)
#pragma unroll
            for (int bj = 0; bj < 2; ++bj)
#pragma unroll
                for (int m = 0; m < 4; ++m)
#pragma unroll
                    for (int n = 0; n < 2; ++n) s += acc[ai][bj][m][n][0] + acc[ai][bj][m][n][1] + acc[ai][bj][m][n][2] + acc[ai][bj][m][n][3];
        if (s == 12345.678f) O[u.pm + wr + wc + fr + fq] = (bf16)1;
    }
};
#endif
struct EpiUpA {
    static constexpr bool PERM = false, AFTER_DRAIN = false;
    bf16* MG; const bf16* GT;
    __device__ __forceinline__ void operator()(const f32x4 (&acc)[2][2][4][2], const Unit& u, int wr, int wc, int fr, int fq) const {
        const int row0 = u.pm * 256 + wr * 64 + fr, c0 = 256 * u.pn + 32 * wc + 8 * fq;
        v4u gw[2][2][2];
#define UA_LOAD(q_, buf_) do { _Pragma("unroll") for (int mm = 0; mm < 2; ++mm) _Pragma("unroll") for (int bj = 0; bj < 2; ++bj) \
            gw[buf_][mm][bj] = *(const v4u*)(GT + (size_t)(row0 + 128 * ((q_) >> 1) + 16 * (2 * ((q_) & 1) + mm)) * NGATE + c0 + 128 * bj); } while (0)
        UA_LOAD(0, 0);
#pragma unroll
        for (int q = 0; q < 4; ++q) { const int ai = q >> 1, mh = q & 1;
            if (q < 3) UA_LOAD(q + 1, (q + 1) & 1);
            __builtin_amdgcn_sched_barrier(0);
#pragma unroll
            for (int mm = 0; mm < 2; ++mm) { const int m = 2 * mh + mm; bf16* rp = MG + (size_t)(row0 + 128 * ai + 16 * m) * D + c0;
#pragma unroll
                for (int bj = 0; bj < 2; ++bj) { f32x4 g0, g1; unpack8(gw[q & 1][mm][bj], g0, g1);
                    *(v4u*)(rp + 128 * bj) = pack8(acc[ai][bj][m][0] * g0, acc[ai][bj][m][1] * g1); } }
            __builtin_amdgcn_sched_barrier(0); }
#undef UA_LOAD
    }
};
struct EpiUpB {
    static constexpr bool PERM = false, AFTER_DRAIN = false;
    bf16* MG; const bf16* GT; const float* ssq;
    __device__ __forceinline__ void operator()(const f32x4 (&acc)[2][2][4][2], const Unit& u, int wr, int wc, int fr, int fq) const {
        const int row0 = u.pm * 256 + wr * 64 + fr, c0 = 256 * u.pn + 32 * wc + 8 * fq;
        v4u gw[2][2][2], pw[2][2][2]; f32x4 sq[2][2];
#define UB_LOAD(q_, buf_) do { _Pragma("unroll") for (int mm = 0; mm < 2; ++mm) { const int r_ = row0 + 128 * ((q_) >> 1) + 16 * (2 * ((q_) & 1) + mm); sq[buf_][mm] = *(const f32x4*)(ssq + (size_t)r_ * 4); \
            _Pragma("unroll") for (int bj = 0; bj < 2; ++bj) { gw[buf_][mm][bj] = *(const v4u*)(GT + (size_t)r_ * NGATE + 1024 + c0 + 128 * bj); pw[buf_][mm][bj] = *(const v4u*)(MG + (size_t)r_ * D + c0 + 128 * bj); } } } while (0)
        UB_LOAD(0, 0);
#pragma unroll
        for (int q = 0; q < 4; ++q) { const int ai = q >> 1, mh = q & 1;
            if (q < 3) UB_LOAD(q + 1, (q + 1) & 1);
            __builtin_amdgcn_sched_barrier(0);
#pragma unroll
            for (int mm = 0; mm < 2; ++mm) { const int m = 2 * mh + mm; bf16* rp = MG + (size_t)(row0 + 128 * ai + 16 * m) * D + c0; const f32x4 sv = sq[q & 1][mm];
                const float rstd = 1.0f / sqrtf(((sv[0] + sv[1]) + (sv[2] + sv[3])) * (1.f / 512.f) + NORM_EPS);
#pragma unroll
                for (int bj = 0; bj < 2; ++bj) { f32x4 g0, g1, p0, p1; unpack8(gw[q & 1][mm][bj], g0, g1); unpack8(pw[q & 1][mm][bj], p0, p1);
                    *(v4u*)(rp + 128 * bj) = pack8(p0 + acc[ai][bj][m][0] * g0 * rstd, p1 + acc[ai][bj][m][1] * g1 * rstd); } }
            __builtin_amdgcn_sched_barrier(0); }
#undef UB_LOAD
    }
};
struct EpiOut {
    static constexpr bool PERM = false, AFTER_DRAIN = false;
    float* X; const float* XI;
    __device__ __forceinline__ void operator()(const f32x4 (&acc)[2][2][4][2], const Unit& u, int wr, int wc, int fr, int fq) const {
        const int row0 = u.pm * 256 + wr * 64 + fr, c0 = 256 * u.pn + 32 * wc + 8 * fq;
#pragma unroll
        for (int ai = 0; ai < 2; ++ai) { f32x4 xv[4][2][2];
#pragma unroll
            for (int m = 0; m < 4; ++m)
#pragma unroll
                for (int bj = 0; bj < 2; ++bj) { const f32x4* p = (const f32x4*)(XI + (size_t)(row0 + 128 * ai + 16 * m) * D + c0 + 128 * bj); xv[m][bj][0] = p[0]; xv[m][bj][1] = p[1]; }
#pragma unroll
            for (int m = 0; m < 4; ++m)
#pragma unroll
                for (int bj = 0; bj < 2; ++bj) { f32x4* p = (f32x4*)(X + (size_t)(row0 + 128 * ai + 16 * m) * D + c0 + 128 * bj); p[0] = xv[m][bj][0] + acc[ai][bj][m][0]; p[1] = xv[m][bj][1] + acc[ai][bj][m][1]; }
            asm volatile("" ::: "memory"); }
    }
};
template <bool IN_F32> struct EpiOutB {
    static constexpr bool PERM = false, AFTER_DRAIN = false;
    bf16* XO; const void* XI;
    __device__ __forceinline__ void operator()(const f32x4 (&acc)[2][2][4][2], const Unit& u, int wr, int wc, int fr, int fq) const {
        const int row0 = u.pm * 256 + wr * 64 + fr, c0 = 256 * u.pn + 32 * wc + 8 * fq;
#pragma unroll
        for (int ai = 0; ai < 2; ++ai) { f32x4 xv[4][2][2];
#pragma unroll
            for (int m = 0; m < 4; ++m)
#pragma unroll
                for (int bj = 0; bj < 2; ++bj) { const size_t o = (size_t)(row0 + 128 * ai + 16 * m) * D + c0 + 128 * bj;
                    if constexpr (IN_F32) { const f32x4* p = (const f32x4*)((const float*)XI + o); xv[m][bj][0] = p[0]; xv[m][bj][1] = p[1]; }
                    else { const v4u w = *(const v4u*)((const bf16*)XI + o); unpack8(w, xv[m][bj][0], xv[m][bj][1]); } }
#pragma unroll
            for (int m = 0; m < 4; ++m)
#pragma unroll
                for (int bj = 0; bj < 2; ++bj) { const size_t o = (size_t)(row0 + 128 * ai + 16 * m) * D + c0 + 128 * bj;
                    *(v4u*)(XO + o) = pack8(xv[m][bj][0] + acc[ai][bj][m][0], xv[m][bj][1] + acc[ai][bj][m][1]); }
            asm volatile("" ::: "memory"); }
    }
};
struct EpiAct {
    static constexpr bool PERM = false, AFTER_DRAIN = false;
    bf16* ACT; const float* rs;
    __device__ __forceinline__ void operator()(const f32x4 (&acc)[2][2][4][2], const Unit& u, int wr, int wc, int fr, int fq) const {
        const int row0 = u.pm * 256 + wr * 64 + fr, c0 = 128 * u.pn + 16 * wc + 4 * fq;
        float rsv[2][4];
#pragma unroll
        for (int ai = 0; ai < 2; ++ai)
#pragma unroll
            for (int m = 0; m < 4; ++m) rsv[ai][m] = NORMFOLD ? rs[row0 + 128 * ai + 16 * m] : 1.0f;
#pragma unroll
        for (int ai = 0; ai < 2; ++ai)
#pragma unroll
            for (int m = 0; m < 4; ++m) { bf16* rp = ACT + (size_t)(row0 + 128 * ai + 16 * m) * DEXP + c0; const float rr = rsv[ai][m];
#pragma unroll
                for (int bj = 0; bj < 2; ++bj) { const f32x4 g = acc[ai][bj][m][0] * rr, up = acc[ai][bj][m][1] * rr; f32x4 a;
#pragma unroll
                    for (int j = 0; j < 4; ++j) a[j] = siluf_(g[j]) * up[j];
                    const unsigned long long w64 = (unsigned long long)cvt_pk_bf16(a[0], a[1]) | ((unsigned long long)cvt_pk_bf16(a[2], a[3]) << 32);
#if MOE_HANDOFF
                    __hip_atomic_store((gu64*)(rp + 64 * bj), w64, RLX_AGENT); } }
#else
                    *(unsigned long long*)(rp + 64 * bj) = w64; } }
#endif
    }
};
struct EpiY {
    static constexpr bool PERM = false, AFTER_DRAIN = false;
    bf16* Y;
    __device__ __forceinline__ void operator()(const f32x4 (&acc)[2][2][4][2], const Unit& u, int wr, int wc, int fr, int fq) const {
        const int row0 = u.pm * 256 + wr * 64 + fr, c0 = 256 * u.pn + 32 * wc + 8 * fq;
#pragma unroll
        for (int ai = 0; ai < 2; ++ai)
#pragma unroll
            for (int m = 0; m < 4; ++m) { bf16* rp = Y + (size_t)(row0 + 128 * ai + 16 * m) * D + c0;
#pragma unroll
                for (int bj = 0; bj < 2; ++bj) *(v4u*)(rp + 128 * bj) = pack8(acc[ai][bj][m][0], acc[ai][bj][m][1]); }
    }
};

#define VLD(p) __hip_atomic_load((p), __ATOMIC_RELAXED, __HIP_MEMORY_SCOPE_AGENT)
constexpr int HIST_OFF = MISC_OFF + 256;
constexpr int SBASE_OFF = HIST_OFF + 128;
constexpr int STOT_OFF = SBASE_OFF + 128;
constexpr int BRE_OFF = STOT_OFF + 128;
static_assert(BRE_OFF + 128 <= LDS_BYTES, "LDS misc");

__device__ __forceinline__ void phase_norm_route(Frame& F, const Args& A, int l, const void* xsrc) {
    const int gw = F.vcu * NWAVES + F.wave, NGW = F.G * NWAVES, lane = F.lane;
    LAS f32x4* Wre = (LAS f32x4*)(F.lds + RING_OFF);
    volatile LAS int* hist = (volatile LAS int*)(F.lds + HIST_OFF);
    const float* w_re = A.in[I_WRE] + (size_t)l * NGRP * D * EPG;
    const float* w_rg = A.in[I_WRG] + (size_t)l * D * NGRP;
    const float* b_rg = A.in[I_BRG] + l * NGRP;
    const float* b_re = A.in[I_BRE] + l * NGRP * EPG;
    const float* gf = A.in[I_FNG] + (size_t)l * D;
    for (int idx = F.tid; idx < NGRP * D; idx += NWAVES * 64) { const int g = idx >> 10, i = idx & 1023, li = (i & 255) >> 2, jj = 4 * (i >> 8) + (i & 3);
        const f32x4 a = *(const f32x4*)(w_re + (size_t)idx * 8), b = *(const f32x4*)(w_re + (size_t)idx * 8 + 4);
        Wre[((g * 2 + 0) * 16 + jj) * 64 + li] = a; Wre[((g * 2 + 1) * 16 + jj) * 64 + li] = b; }
    if (F.tid < 32) { hist[F.tid] = 0; ((LAS float*)(F.lds + BRE_OFF))[F.tid] = b_re[F.tid]; }
    { int* stok = (int*)(F.ws + WS_STOK); for (int i = F.vcu * (NWAVES * 64) + F.tid; i < SLOT_ROWS; i += F.G * NWAVES * 64) stok[i] = 0; }
    f32x4 wgr[16], gv[4];
#pragma unroll
    for (int j = 0; j < 4; ++j) { gv[j] = *(const f32x4*)(gf + 4 * lane + 256 * j);
#pragma unroll
        for (int c = 0; c < 4; ++c) wgr[4 * j + c] = *(const f32x4*)(w_rg + (size_t)(4 * lane + 256 * j + c) * 4); }
    f32x4 brg = *(const f32x4*)b_rg;
    __syncthreads();
    bf16* XN = (bf16*)(F.ws + WS_XN);
#if XBF16
    const bf16* X = (const bf16*)xsrc;
    typedef v2u xraw_t;
#define NR_LOAD(dst, row) do { const GAS v2u* xr_ = (const GAS v2u*)(X + (size_t)(row) * D) + lane; _Pragma("unroll") for (int j = 0; j < 4; ++j) dst[j] = xr_[64 * j]; } while (0)
#define NR_CVT(w_) ((f32x4){bflo((w_).x), bfhi((w_).x), bflo((w_).y), bfhi((w_).y)})
#else
    const float* X = (const float*)xsrc;
    typedef f32x4 xraw_t;
#define NR_LOAD(dst, row) do { const GAS f32x4* xr_ = (const GAS f32x4*)(X + (size_t)(row) * D) + lane; _Pragma("unroll") for (int j = 0; j < 4; ++j) dst[j] = xr_[64 * j]; } while (0)
#define NR_CVT(w_) (w_)
#endif
    int* tok_e = (int*)(F.ws + WS_TOKE); float* tok_w = (float*)(F.ws + WS_TOKW); int* tok_r = (int*)(F.ws + WS_TOKR);
    xraw_t vn[4], vn2[4];
    NR_LOAD(vn, gw); if (gw + NGW < T) NR_LOAD(vn2, gw + NGW);
    int pe1 = 0, pe2 = 0, pr1 = 0, pr2 = 0, pm = -1; float pw1 = 0.f, pw2 = 0.f;
    for (int m = gw; m < T; m += NGW) {
        f32x4 v[4]; float s = 0.f;
#pragma unroll
        for (int j = 0; j < 4; ++j) { v[j] = NR_CVT(vn[j]); vn[j] = vn2[j]; s += (v[j].x * v[j].x + v[j].y * v[j].y) + (v[j].z * v[j].z + v[j].w * v[j].w); }
        if (m + 2 * NGW < T) NR_LOAD(vn2, m + 2 * NGW);
        if (lane == 0 && pm >= 0) { tok_e[2 * pm] = pe1; tok_e[2 * pm + 1] = pe2; tok_w[2 * pm] = pw1; tok_w[2 * pm + 1] = pw2; tok_r[2 * pm] = pr1; tok_r[2 * pm + 1] = pr2; }
        const float rstd = 1.0f / sqrtf(wave_sum(s) * (1.f / D) + NORM_EPS);
        GAS v2u* o8 = (GAS v2u*)(XN + (size_t)m * D) + lane;
        f32x4 ga = (f32x4){0.f, 0.f, 0.f, 0.f};
#pragma unroll
        for (int j = 0; j < 4; ++j) { v[j] = v[j] * rstd * gv[j]; v2u w; w.x = pk2(v[j].x, v[j].y); w.y = pk2(v[j].z, v[j].w); o8[64 * j] = w;
            ga += wgr[4 * j + 0] * v[j].x; ga += wgr[4 * j + 1] * v[j].y; ga += wgr[4 * j + 2] * v[j].z; ga += wgr[4 * j + 3] * v[j].w; }
        float gl[4];
#pragma unroll
        for (int k = 0; k < 4; ++k) gl[k] = wave_sum(ga[k]) + brg[k];
        int gt = 0; float gm = gl[0];
#pragma unroll
        for (int k = 1; k < 4; ++k) if (gl[k] > gm) { gm = gl[k]; gt = k; }
        float gden = 0.f;
#pragma unroll
        for (int k = 0; k < 4; ++k) gden += expf(gl[k] - gm);
        const float p_top = 1.0f / gden;
        gt = __builtin_amdgcn_readfirstlane(gt);
        f32x4 a0 = (f32x4){0.f, 0.f, 0.f, 0.f}, a1 = a0;
        const LAS f32x4* w0 = Wre + ((gt * 2 + 0) * 16) * 64 + lane; const LAS f32x4* w1 = Wre + ((gt * 2 + 1) * 16) * 64 + lane;
        f32x4 wa[2][4], wb[2][4];
#pragma unroll
        for (int c = 0; c < 4; ++c) { wa[0][c] = w0[c * 64]; wb[0][c] = w1[c * 64]; }
#pragma unroll
        for (int j = 0; j < 4; ++j) {
            if (j < 3) {
#pragma unroll
                for (int c = 0; c < 4; ++c) { wa[(j + 1) & 1][c] = w0[(4 * (j + 1) + c) * 64]; wb[(j + 1) & 1][c] = w1[(4 * (j + 1) + c) * 64]; } }
            __builtin_amdgcn_sched_barrier(0);
            a0 += wa[j & 1][0] * v[j].x; a1 += wb[j & 1][0] * v[j].x;
            a0 += wa[j & 1][1] * v[j].y; a1 += wb[j & 1][1] * v[j].y;
            a0 += wa[j & 1][2] * v[j].z; a1 += wb[j & 1][2] * v[j].z;
            a0 += wa[j & 1][3] * v[j].w; a1 += wb[j & 1][3] * v[j].w;
            __builtin_amdgcn_sched_barrier(0); }
        const f32x4 bl0 = *(const LAS f32x4*)(F.lds + BRE_OFF + gt * 32), bl1 = *(const LAS f32x4*)(F.lds + BRE_OFF + gt * 32 + 16);
        float el[8];
#pragma unroll
        for (int k = 0; k < 4; ++k) { el[k] = wave_sum(a0[k]) + bl0[k]; el[4 + k] = wave_sum(a1[k]) + bl1[k]; }
        int i1 = 0; float m1 = el[0];
#pragma unroll
        for (int k = 1; k < 8; ++k) if (el[k] > m1) { m1 = el[k]; i1 = k; }
        int i2 = -1; float m2 = -3.0e38f;
#pragma unroll
        for (int k = 0; k < 8; ++k) if (k != i1 && el[k] > m2) { m2 = el[k]; i2 = k; }
        const float q1 = 1.0f, q2 = expf(m2 - m1);
        const float wn1 = p_top * q1 / (q1 + q2), wn2 = p_top * q2 / (q1 + q2);
        if (lane == 0) {
            pe1 = gt * 8 + i1; pe2 = gt * 8 + i2; pw1 = wn1; pw2 = wn2; pm = m;
            pr1 = __hip_atomic_fetch_add((LAS int*)hist + pe1, 1, __ATOMIC_RELAXED, __HIP_MEMORY_SCOPE_WORKGROUP);
            pr2 = __hip_atomic_fetch_add((LAS int*)hist + pe2, 1, __ATOMIC_RELAXED, __HIP_MEMORY_SCOPE_WORKGROUP);
        }
    }
    if (lane == 0 && pm >= 0) { tok_e[2 * pm] = pe1; tok_e[2 * pm + 1] = pe2; tok_w[2 * pm] = pw1; tok_w[2 * pm + 1] = pw2; tok_r[2 * pm] = pr1; tok_r[2 * pm + 1] = pr2; }
    __syncthreads();
    if (F.tid < 32) ((int*)(F.ws + WS_WGCNT))[blockIdx.x * 32 + F.tid] = hist[F.tid];
#undef NR_LOAD
#undef NR_CVT
}
#if ROUTE4
constexpr int WGR_OFF = (BRE_OFF + 128 + 255) & ~255, GNW_OFF = WGR_OFF + 16384;
static_assert(GNW_OFF + 4096 <= LDS_BYTES, "LDS route4");
__device__ __forceinline__ float row_sum16(float v) {
#if defined(__HIP_DEVICE_COMPILE__)
#define RS_ROR(n) v += __builtin_bit_cast(float, __builtin_amdgcn_update_dpp(0, __builtin_bit_cast(int, v), 0x120 + (n), 0xf, 0xf, false))
    RS_ROR(8); RS_ROR(4); RS_ROR(2); RS_ROR(1);
#undef RS_ROR
#endif
    return v;
}
__device__ __forceinline__ void phase_norm_route4(Frame& F, const Args& A, int l, const void* xsrc) {
    const int gw = F.vcu * NWAVES + F.wave, NGW = F.G * NWAVES, lane = F.lane, r = lane >> 4, c = lane & 15;
    LAS f32x4* WE = (LAS f32x4*)(F.lds + RING_OFF); LAS f32x4* WG = (LAS f32x4*)(F.lds + WGR_OFF); LAS f32x4* GL = (LAS f32x4*)(F.lds + GNW_OFF);
    volatile LAS int* hist = (volatile LAS int*)(F.lds + HIST_OFF);
    const float* w_re = A.in[I_WRE] + (size_t)l * NGRP * D * EPG;
    const float* w_rg = A.in[I_WRG] + (size_t)l * D * NGRP;
    const float* b_rg = A.in[I_BRG] + l * NGRP;
    const float* b_re = A.in[I_BRE] + l * NGRP * EPG;
    const float* gf = A.in[I_FNG] + (size_t)l * D;
    static_assert(XBF16 == 1, "route4 reads the bf16 residual stream");
    const bf16* X = (const bf16*)xsrc;
    constexpr int NTG = T / 4;
    v2u xn[16];
    if (gw < NTG) { const GAS v2u* xr = (const GAS v2u*)(X + (size_t)(4 * gw + r) * D) + c;
#pragma unroll
        for (int k = 0; k < 16; ++k) xn[k] = xr[16 * k]; }
    {
        f32x4 ta[8], tb[8], tg2[2], tgl = (f32x4){0.f, 0.f, 0.f, 0.f};
#pragma unroll
        for (int u = 0; u < 8; ++u) { const int idx = F.tid + u * (NWAVES * 64); ta[u] = *(const GAS f32x4*)(w_re + (size_t)idx * 8); tb[u] = *(const GAS f32x4*)(w_re + (size_t)idx * 8 + 4); }
#pragma unroll
        for (int u = 0; u < 2; ++u) tg2[u] = *(const GAS f32x4*)(w_rg + (size_t)(F.tid + u * (NWAVES * 64)) * 4);
        if (F.tid < 256) tgl = *(const GAS f32x4*)(gf + 64 * (F.tid >> 4) + 4 * (F.tid & 15));
        float gs[2] = {1.0f, 1.0f};
        if (NORMFOLD) { gs[0] = gf[F.tid]; gs[1] = gf[F.tid + NWAVES * 64]; }
        __builtin_amdgcn_sched_barrier(0);
#pragma unroll
        for (int u = 0; u < 8; ++u) { const int idx = F.tid + u * (NWAVES * 64), g = idx >> 10, e = idx & 1023, k = e >> 6, cc = (e >> 2) & 15, i = e & 3; const float gg_ = gs[u & 1];
            WE[((g * 16 + k) * 8 + 2 * i) * 16 + cc] = ta[u] * gg_; WE[((g * 16 + k) * 8 + 2 * i + 1) * 16 + cc] = tb[u] * gg_; }
#pragma unroll
        for (int u = 0; u < 2; ++u) { const int e = F.tid + u * (NWAVES * 64), k = e >> 6, cc = (e >> 2) & 15, i = e & 3; WG[(k * 4 + i) * 16 + cc] = tg2[u] * gs[u]; }
        if (F.tid < 256) GL[F.tid] = tgl;
    }
    static_assert(NGRP * D == 8 * NWAVES * 64 && D == 2 * NWAVES * 64, "staging loops above");
    if (F.tid < 32) { hist[F.tid] = 0; ((LAS float*)(F.lds + BRE_OFF))[F.tid] = b_re[F.tid]; }
    { int* stok = (int*)(F.ws + WS_STOK); for (int i = F.vcu * (NWAVES * 64) + F.tid; i < SLOT_ROWS; i += F.G * NWAVES * 64) stok[i] = 0; }
    const f32x4 brg = *(const f32x4*)b_rg;
    __syncthreads();
    bf16* XN = (bf16*)(F.ws + WS_XN);
    int* tok_e = (int*)(F.ws + WS_TOKE); float* tok_w = (float*)(F.ws + WS_TOKW); int* tok_r = (int*)(F.ws + WS_TOKR);
    int pe1 = 0, pe2 = 0, pr1 = 0, pr2 = 0, pm = -1; float pw1 = 0.f, pw2 = 0.f, prs = 0.f; float* rsf = (float*)(F.ws + WS_RSF);
    for (int tg = gw; tg < NTG; tg += NGW) {
        const int m = 4 * tg + r;
        f32x4 v[16]; float s = 0.f;
#pragma unroll
        for (int k = 0; k < 16; ++k) { const v2u w = xn[k]; v[k] = (f32x4){bflo(w.x), bfhi(w.x), bflo(w.y), bfhi(w.y)}; s += (v[k].x * v[k].x + v[k].y * v[k].y) + (v[k].z * v[k].z + v[k].w * v[k].w); }
        if (tg + NGW < NTG) { const GAS v2u* xr = (const GAS v2u*)(X + (size_t)(4 * (tg + NGW) + r) * D) + c;
#pragma unroll
            for (int k = 0; k < 16; ++k) xn[k] = xr[16 * k]; }
        if (c == 0 && pm >= 0) { tok_e[2 * pm] = pe1; tok_e[2 * pm + 1] = pe2; tok_w[2 * pm] = pw1; tok_w[2 * pm + 1] = pw2; tok_r[2 * pm] = pr1; tok_r[2 * pm + 1] = pr2; if (NORMFOLD) rsf[pm] = prs; }
        const float rstd = 1.0f / sqrtf(row_sum16(s) * (1.f / D) + NORM_EPS);
        GAS v2u* o8 = (GAS v2u*)(XN + (size_t)m * D) + c;
        f32x4 ga = (f32x4){0.f, 0.f, 0.f, 0.f};
#pragma unroll
        for (int k = 0; k < 16; ++k) { const f32x4 w0 = WG[(k * 4 + 0) * 16 + c], w1 = WG[(k * 4 + 1) * 16 + c], w2 = WG[(k * 4 + 2) * 16 + c], w3 = WG[(k * 4 + 3) * 16 + c];
            if (NORMFOLD) v[k] = v[k] * rstd; else { const f32x4 gk = GL[k * 16 + c]; v[k] = v[k] * rstd * gk; } if (!NORMFOLD) { v2u w; w.x = pk2(v[k].x, v[k].y); w.y = pk2(v[k].z, v[k].w); o8[16 * k] = w; }
            ga += w0 * v[k].x; ga += w1 * v[k].y; ga += w2 * v[k].z; ga += w3 * v[k].w; }
        float gl[4];
#pragma unroll
        for (int q = 0; q < 4; ++q) gl[q] = row_sum16(ga[q]) + brg[q];
        int gt = 0; float gm = gl[0];
#pragma unroll
        for (int q = 1; q < 4; ++q) if (gl[q] > gm) { gm = gl[q]; gt = q; }
        float gden = 0.f;
#pragma unroll
        for (int q = 0; q < 4; ++q) gden += expf(gl[q] - gm);
        const float p_top = 1.0f / gden;
        f32x4 a0 = (f32x4){0.f, 0.f, 0.f, 0.f}, a1 = a0;
        const LAS f32x4* we = WE + (gt * 16) * 8 * 16 + c;
        f32x4 wb[2][8];
#pragma unroll
        for (int q = 0; q < 8; ++q) wb[0][q] = we[q * 16];
#pragma unroll
        for (int k = 0; k < 16; ++k) {
            if (k < 15) {
#pragma unroll
                for (int q = 0; q < 8; ++q) wb[(k + 1) & 1][q] = we[((k + 1) * 8 + q) * 16]; }
            __builtin_amdgcn_sched_barrier(0);
            a0 += wb[k & 1][0] * v[k].x; a1 += wb[k & 1][1] * v[k].x;
            a0 += wb[k & 1][2] * v[k].y; a1 += wb[k & 1][3] * v[k].y;
            a0 += wb[k & 1][4] * v[k].z; a1 += wb[k & 1][5] * v[k].z;
            a0 += wb[k & 1][6] * v[k].w; a1 += wb[k & 1][7] * v[k].w;
            __builtin_amdgcn_sched_barrier(0); }
        const f32x4 bl0 = *(const LAS f32x4*)(F.lds + BRE_OFF + gt * 32), bl1 = *(const LAS f32x4*)(F.lds + BRE_OFF + gt * 32 + 16);
        float el[8];
#pragma unroll
        for (int q = 0; q < 4; ++q) { el[q] = row_sum16(a0[q]) + bl0[q]; el[4 + q] = row_sum16(a1[q]) + bl1[q]; }
        int i1 = 0; float m1 = el[0];
#pragma unroll
        for (int q = 1; q < 8; ++q) if (el[q] > m1) { m1 = el[q]; i1 = q; }
        int i2 = -1; float m2 = -3.0e38f;
#pragma unroll
        for (int q = 0; q < 8; ++q) if (q != i1 && el[q] > m2) { m2 = el[q]; i2 = q; }
        const float q1 = 1.0f, q2 = expf(m2 - m1);
        const float wn1 = p_top * q1 / (q1 + q2), wn2 = p_top * q2 / (q1 + q2);
        if (c == 0) {
            pe1 = gt * 8 + i1; pe2 = gt * 8 + i2; pw1 = wn1; pw2 = wn2; pm = m; prs = rstd;
            pr1 = __hip_atomic_fetch_add((LAS int*)hist + pe1, 1, __ATOMIC_RELAXED, __HIP_MEMORY_SCOPE_WORKGROUP);
            pr2 = __hip_atomic_fetch_add((LAS int*)hist + pe2, 1, __ATOMIC_RELAXED, __HIP_MEMORY_SCOPE_WORKGROUP);
        }
    }
    if (c == 0 && pm >= 0) { tok_e[2 * pm] = pe1; tok_e[2 * pm + 1] = pe2; tok_w[2 * pm] = pw1; tok_w[2 * pm + 1] = pw2; tok_r[2 * pm] = pr1; tok_r[2 * pm + 1] = pr2; if (NORMFOLD) rsf[pm] = prs; }
    __syncthreads();
    if (F.tid < 32) ((int*)(F.ws + WS_WGCNT))[blockIdx.x * 32 + F.tid] = hist[F.tid];
}
#endif
__device__ __forceinline__ void phase_dispatch(Frame& F) {
    const int gw = F.vcu * NWAVES + F.wave, NGW = F.G * NWAVES, lane = F.lane;
    volatile LAS int* sbase = (volatile LAS int*)(F.lds + SBASE_OFF); volatile LAS int* stot = (volatile LAS int*)(F.lds + STOT_OFF);
    const int* wgcnt = (const int*)(F.ws + WS_WGCNT); int* meta = (int*)(F.ws + WS_META);
    {
        volatile LAS int* part = (volatile LAS int*)(F.lds + RING_OFF);
        const int e = F.tid & 31, sl = F.tid >> 5; int tot = 0, base = 0;
        for (int w = sl; w < F.G; w += 16) { const int c = wgcnt[w * 32 + e]; tot += c; if (w < (int)blockIdx.x) base += c; }
        part[sl * 32 + e] = tot; part[512 + sl * 32 + e] = base;
        __syncthreads();
        if (F.tid < 32) { int t2 = 0, b2 = 0;
#pragma unroll
            for (int k = 0; k < 16; ++k) { t2 += part[k * 32 + F.tid]; b2 += part[512 + k * 32 + F.tid]; }
            stot[F.tid] = t2; sbase[F.tid] = b2; } }
    __syncthreads();
    if (F.tid == 0) { int run = 0, nrt = 0;
        for (int e = 0; e < NEXP; ++e) { const int nt = (stot[e] + 255) >> 8; sbase[e] = sbase[e] + run;
            if (blockIdx.x == 0) for (int k = 0; k < nt; ++k) meta[1 + nrt + k] = e;
            nrt += nt; run += nt * 256; }
        if (blockIdx.x == 0) meta[0] = nrt; }
    __syncthreads();
    const int* tok_e = (const int*)(F.ws + WS_TOKE); const int* tok_r = (const int*)(F.ws + WS_TOKR); int* tok_p = (int*)(F.ws + WS_TOKP);
    int* stok = (int*)(F.ws + WS_STOK);
    if (F.tid < T / F.G) {
#if ROUTE_MFMA
        const int m = 16 * ((F.tid >> 7) * NGW + F.vcu * NWAVES + ((F.tid >> 4) & 7)) + (F.tid & 15);
#elif ROUTE4
        const int m = 4 * ((F.tid >> 5) * NGW + F.vcu * NWAVES + ((F.tid >> 2) & 7)) + (F.tid & 3);
#else
        const int m = (F.tid >> 3) * NGW + F.vcu * NWAVES + (F.tid & 7);
#endif
        const int e1 = VLD(tok_e + 2 * m), e2 = VLD(tok_e + 2 * m + 1);
        const int p1 = sbase[e1] + VLD(tok_r + 2 * m), p2 = sbase[e2] + VLD(tok_r + 2 * m + 1);
        tok_p[2 * m] = p1; tok_p[2 * m + 1] = p2; stok[p1] = m; stok[p2] = m;
        if (NORMFOLD) { const float rr = VLD((const float*)(F.ws + WS_RSF) + m); float* rss = (float*)(F.ws + WS_RSS); rss[p1] = rr; rss[p2] = rr; } }
    (void)gw; (void)lane;
}
__device__ __forceinline__ void phase_combine(Frame& F, const float* g, bool last, const void* xsrc, void* xdst) {
    const int gw = F.vcu * NWAVES + F.wave, NGW = F.G * NWAVES, lane = F.lane;
    const int* tok_p = (const int*)(F.ws + WS_TOKP); const float* tok_w = (const float*)(F.ws + WS_TOKW);
    const bf16* Y = (const bf16*)(F.ws + WS_XP); bf16* XN = (bf16*)(F.ws + WS_XN);
#if XBF16
    typedef v2u xraw_t; const bf16* X = (const bf16*)xsrc;
#define PC_CVT(w_) ((f32x4){bflo((w_).x), bfhi((w_).x), bflo((w_).y), bfhi((w_).y)})
#else
    typedef f32x4 xraw_t; const float* X = (const float*)xsrc;
#define PC_CVT(w_) (w_)
#endif
    f32x4 gv[4];
#pragma unroll
    for (int j = 0; j < 4; ++j) gv[j] = *(const f32x4*)(g + 4 * lane + 256 * j);
    float cw1, cw2, dw1 = 0.f, dw2 = 0.f; xraw_t xn_[4], xm_[4]; v2u ya_[4], yb_[4], yc_[4], yd_[4];
    { const int p1 = VLD(tok_p + 2 * gw), p2 = VLD(tok_p + 2 * gw + 1); cw1 = VLD(tok_w + 2 * gw); cw2 = VLD(tok_w + 2 * gw + 1);
      const GAS xraw_t* xr = (const GAS xraw_t*)(X + (size_t)gw * D) + lane; const GAS v2u* y1 = (const GAS v2u*)(Y + (size_t)p1 * D) + lane; const GAS v2u* y2 = (const GAS v2u*)(Y + (size_t)p2 * D) + lane;
#pragma unroll
      for (int j = 0; j < 4; ++j) { xn_[j] = xr[64 * j]; ya_[j] = y1[64 * j]; yb_[j] = y2[64 * j]; } }
    if (gw + NGW < T) { const int mn = gw + NGW; const int p1 = VLD(tok_p + 2 * mn), p2 = VLD(tok_p + 2 * mn + 1); dw1 = VLD(tok_w + 2 * mn); dw2 = VLD(tok_w + 2 * mn + 1);
      const GAS xraw_t* xr = (const GAS xraw_t*)(X + (size_t)mn * D) + lane; const GAS v2u* y1 = (const GAS v2u*)(Y + (size_t)p1 * D) + lane; const GAS v2u* y2 = (const GAS v2u*)(Y + (size_t)p2 * D) + lane;
#pragma unroll
      for (int j = 0; j < 4; ++j) { xm_[j] = xr[64 * j]; yc_[j] = y1[64 * j]; yd_[j] = y2[64 * j]; } }
    int tp1 = 0, tp2 = 0; float tw1 = 0.f, tw2 = 0.f;
    if (gw + 2 * NGW < T) { const int mn = gw + 2 * NGW; tp1 = VLD(tok_p + 2 * mn); tp2 = VLD(tok_p + 2 * mn + 1); tw1 = VLD(tok_w + 2 * mn); tw2 = VLD(tok_w + 2 * mn + 1); }
    float prsd = 0.f; f32x4 po[4]; v2u pox[4], pon[4]; int pm = -1;
#pragma unroll
    for (int j = 0; j < 4; ++j) { po[j] = (f32x4){0.f, 0.f, 0.f, 0.f}; pox[j] = (v2u){0u, 0u}; pon[j] = (v2u){0u, 0u}; }
#if XBF16
#define PC_FLUSH() do { if (pm >= 0) { if (last) { GAS f32x4* xr_ = (GAS f32x4*)(F.out + (size_t)pm * D) + lane; _Pragma("unroll") for (int j = 0; j < 4; ++j) xr_[64 * j] = po[j]; } \
        else { GAS v2u* o8_ = (GAS v2u*)(XN + (size_t)pm * D) + lane; GAS v2u* xo_ = (GAS v2u*)((bf16*)xdst + (size_t)pm * D) + lane; _Pragma("unroll") for (int j = 0; j < 4; ++j) { xo_[64 * j] = pox[j]; if (!NORMFOLD) o8_[64 * j] = pon[j]; } \
            if (NORMFOLD && lane == 0) ((float*)(F.ws + WS_RSA))[pm] = prsd; } } } while (0)
#else
#define PC_FLUSH() do { if (pm >= 0) { if (last) { GAS f32x4* xr_ = (GAS f32x4*)(F.out + (size_t)pm * D) + lane; _Pragma("unroll") for (int j = 0; j < 4; ++j) xr_[64 * j] = po[j]; } \
        else { GAS v2u* o8_ = (GAS v2u*)(XN + (size_t)pm * D) + lane; GAS f32x4* xo_ = (GAS f32x4*)((float*)xdst + (size_t)pm * D) + lane; _Pragma("unroll") for (int j = 0; j < 4; ++j) { xo_[64 * j] = po[j]; o8_[64 * j] = pon[j]; } } } } while (0)
#endif
    for (int m = gw; m < T; m += NGW) {
        const float w1 = cw1, w2 = cw2;
        f32x4 v[4]; float s = 0.f;
#pragma unroll
        for (int j = 0; j < 4; ++j) { const v2u a = ya_[j], b = yb_[j];
            const f32x4 ya = (f32x4){bflo(a.x), bfhi(a.x), bflo(a.y), bfhi(a.y)}, yb = (f32x4){bflo(b.x), bfhi(b.x), bflo(b.y), bfhi(b.y)};
            v[j] = PC_CVT(xn_[j]) + (ya * w1 + yb * w2);
            s += (v[j].x * v[j].x + v[j].y * v[j].y) + (v[j].z * v[j].z + v[j].w * v[j].w);
            xn_[j] = xm_[j]; ya_[j] = yc_[j]; yb_[j] = yd_[j]; }
        cw1 = dw1; cw2 = dw2; dw1 = tw1; dw2 = tw2;
        if (m + 2 * NGW < T) { const int mn = m + 2 * NGW;
            const GAS xraw_t* xq = (const GAS xraw_t*)(X + (size_t)mn * D) + lane; const GAS v2u* y1 = (const GAS v2u*)(Y + (size_t)tp1 * D) + lane; const GAS v2u* y2 = (const GAS v2u*)(Y + (size_t)tp2 * D) + lane;
#pragma unroll
            for (int j = 0; j < 4; ++j) { xm_[j] = xq[64 * j]; yc_[j] = y1[64 * j]; yd_[j] = y2[64 * j]; } }
        if (m + 3 * NGW < T) { const int mn = m + 3 * NGW; tp1 = VLD(tok_p + 2 * mn); tp2 = VLD(tok_p + 2 * mn + 1); tw1 = VLD(tok_w + 2 * mn); tw2 = VLD(tok_w + 2 * mn + 1); }
        PC_FLUSH();
        const float rstd = 1.0f / sqrtf(wave_sum(s) * (1.f / D) + NORM_EPS);
        pm = m;
        if (last) {
#pragma unroll
            for (int j = 0; j < 4; ++j) po[j] = v[j] * rstd * gv[j];
        } else {
            if (NORMFOLD) prsd = rstd;
#pragma unroll
            for (int j = 0; j < 4; ++j) { const f32x4 y = v[j] * rstd * gv[j]; pon[j].x = pk2(y.x, y.y); pon[j].y = pk2(y.z, y.w);
#if XBF16
                pox[j].x = pk2(v[j].x, v[j].y); pox[j].y = pk2(v[j].z, v[j].w);
#else
                po[j] = v[j];
#endif
            }
        }
    }
    PC_FLUSH();
#undef PC_FLUSH
#undef PC_CVT
}

#if defined(__HIP_DEVICE_COMPILE__)
typedef float f32x4v __attribute__((ext_vector_type(4)));
typedef short v4i16_t __attribute__((ext_vector_type(4)));
__device__ __forceinline__ f32x4 mfma16(const bf16x8& a, const bf16x8& b, const f32x4& c) { return __builtin_amdgcn_mfma_f32_16x16x32_bf16(a, b, c, 0, 0, 0); }
__device__ __forceinline__ s16x4 tr_read(const LAS unsigned char* p) { return __builtin_bit_cast(s16x4, __builtin_amdgcn_ds_read_tr16_b64_v4i16((LAS v4i16_t*)p)); }
__device__ __forceinline__ bf16x8 join8(const s16x4& a, const s16x4& b) { bf16x8 r; r[0] = a[0]; r[1] = a[1]; r[2] = a[2]; r[3] = a[3]; r[4] = b[0]; r[5] = b[1]; r[6] = b[2]; r[7] = b[3]; return r; }
__device__ __forceinline__ bf16x8 pack_frag(const float (&v)[8]) { v4u w; w.x = cvt_pk_bf16(v[0], v[1]); w.y = cvt_pk_bf16(v[2], v[3]); w.z = cvt_pk_bf16(v[4], v[5]); w.w = cvt_pk_bf16(v[6], v[7]); return __builtin_bit_cast(bf16x8, w); }
template <int N> __device__ __forceinline__ float dpp_shr_t(float v) { return __builtin_bit_cast(float, __builtin_amdgcn_update_dpp(0, __builtin_bit_cast(int, v), 0x110 + N, 0xf, 0xf, true)); }
template <int N> __device__ __forceinline__ float dpp_ror_t(float v) { return __builtin_bit_cast(float, __builtin_amdgcn_update_dpp(0, __builtin_bit_cast(int, v), 0x120 + N, 0xf, 0xf, false)); }
__device__ __forceinline__ float rowsum16(float v) { v += dpp_ror_t<8>(v); v += dpp_ror_t<4>(v); v += dpp_ror_t<2>(v); v += dpp_ror_t<1>(v); return v; }
__device__ __forceinline__ float scan16(float v) { v += dpp_shr_t<1>(v); v += dpp_shr_t<2>(v); v += dpp_shr_t<4>(v); v += dpp_shr_t<8>(v); return v; }

constexpr int AT_PITCH = 160;
constexpr int AT_KOFF = 0, AT_VOFF = 384 * AT_PITCH;
__device__ __forceinline__ void attn_stage_load(Frame& F, int unit, v4u (&st)[12]) {
    const int b = unit >> 8, kvh = (unit >> 7) & 1, Q0 = (unit & 127) * 128; const bf16* PA = (const bf16*)(F.ws + WS_PA);
#pragma unroll
    for (int k = 0; k < 12; ++k) { const int idx = F.tid + 512 * k, kv = idx / (384 * 8), r = (idx >> 3) % 384, ch = idx & 7, key = Q0 - 128 + r;
        st[k] = (v4u){0u, 0u, 0u, 0u};
        if (key >= 0 && key < SEQ) st[k] = *(const GAS v4u*)(PA + (size_t)(b * SEQ + key) * NPA + (kv ? C_VA : C_KA) + 64 * kvh + 8 * ch); }
}
__device__ __forceinline__ void attn_stage_write(Frame& F, const v4u (&st)[12]) {
    LAS unsigned char* lds = F.lds + RING_OFF;
#pragma unroll
    for (int k = 0; k < 12; ++k) { const int idx = F.tid + 512 * k, kv = idx / (384 * 8), r = (idx >> 3) % 384, ch = idx & 7;
        *(LAS v4u*)(lds + (kv ? AT_VOFF : AT_KOFF) + r * AT_PITCH + ch * 16) = st[k]; }
}
__device__ __forceinline__ void attn_unit(Frame& F, int unit, int next_unit, v4u (&st)[12], const float* sink) {
    const int b = unit >> 8, kvh = (unit >> 7) & 1, qb = unit & 127, Q0 = qb * 128;
    const bf16* PA = (const bf16*)(F.ws + WS_PA); bf16* YA = (bf16*)(F.ws + WS_Y);
    LAS unsigned char* lds = F.lds + RING_OFF;
    attn_stage_write(F, st);
    __syncthreads();
    const int lane = F.lane, w = F.wave, fr = lane & 15, g = lane >> 4, qh = 4 * kvh + (w >> 1);
    const float sk = sink[qh] * LOG2E;
    const bool edge = (qb == 0) || (qb == SEQ / 128 - 1);
    static_assert(WINDOW == 128, "interior-tile test below");
    bf16x8 qn0, qn1;
    { const bf16* qp = PA + (size_t)(b * SEQ + Q0 + 64 * (w & 1) + fr) * NPA + C_QA + 64 * qh + 8 * g; qn0 = *(const GAS bf16x8*)qp; qn1 = *(const GAS bf16x8*)(qp + 32); }
    if (next_unit >= 0) attn_stage_load(F, next_unit, st);
    v2u py[4]; bf16* pyp = YA;
#pragma unroll
    for (int dt = 0; dt < 4; ++dt) py[dt] = (v2u){0u, 0u};
    for (int qbk = 0; qbk < 4; ++qbk) {
        const int qrel = 64 * (w & 1) + 16 * qbk, q = Q0 + qrel + fr;
        const bf16x8 qf0 = qn0, qf1 = qn1;
        f32x4 s[17]; float mx = sk;
#pragma unroll
        for (int t = 0; t < 17; ++t) { const int krel = qrel + 16 * t;
            const LAS unsigned char* kp = lds + AT_KOFF + (krel + fr) * AT_PITCH + g * 16;
            f32x4 a = (f32x4){0.f, 0.f, 0.f, 0.f};
            a = mfma16(*(const LAS bf16x8*)kp, qf0, a); a = mfma16(*(const LAS bf16x8*)(kp + 64), qf1, a);
            s[t] = a; }
#define AT_MASK(t) do { _Pragma("unroll") for (int r = 0; r < 4; ++r) { const int key = Q0 - 128 + qrel + 16 * (t) + 4 * g + r; const int dlt = key - q; \
            const bool ok = (dlt >= -WINDOW) && (dlt <= WINDOW) && (key >= 0) && (key < SEQ); s[t][r] = ok ? s[t][r] : -3.0e38f; } } while (0)
        if (edge) {
#pragma unroll
            for (int t = 0; t < 17; ++t) AT_MASK(t);
        } else { AT_MASK(0); AT_MASK(16); }
#undef AT_MASK
#pragma unroll
        for (int t = 0; t < 17; ++t) mx = fmaxf(fmaxf(mx, fmaxf(s[t][0], s[t][1])), fmaxf(s[t][2], s[t][3]));
        __builtin_amdgcn_sched_barrier(0);
        if (qbk < 3) { const bf16* qp = PA + (size_t)(b * SEQ + q + 16) * NPA + C_QA + 64 * qh + 8 * g; qn0 = *(const GAS bf16x8*)qp; qn1 = *(const GAS bf16x8*)(qp + 32); }
        if (qbk > 0) {
#pragma unroll
            for (int dt = 0; dt < 4; ++dt) *(GAS v2u*)(pyp + 16 * dt) = py[dt]; }
        __builtin_amdgcn_sched_barrier(0);
        mx = fmaxf(mx, __shfl_xor(mx, 16)); mx = fmaxf(mx, __shfl_xor(mx, 32));
        float den = 0.f;
#pragma unroll
        for (int t = 0; t < 17; ++t)
#pragma unroll
            for (int r = 0; r < 4; ++r) { const float p = __builtin_amdgcn_exp2f(s[t][r] - mx); s[t][r] = p; den += p; }
        den += __shfl_xor(den, 16); den += __shfl_xor(den, 32); den += __builtin_amdgcn_exp2f(sk - mx);
        const float inv = 1.0f / den;
        f32x4 o[4];
#pragma unroll
        for (int dt = 0; dt < 4; ++dt) o[dt] = (f32x4){0.f, 0.f, 0.f, 0.f};
#pragma unroll
        for (int tp = 0; tp < 9; ++tp) { const int t0 = 2 * tp, t1 = (2 * tp + 1 < 17) ? 2 * tp + 1 : 2 * tp;
            float pv[8];
#pragma unroll
            for (int r = 0; r < 4; ++r) { pv[r] = s[t0][r]; pv[4 + r] = (2 * tp + 1 < 17) ? s[t1][r] : 0.f; }
            const bf16x8 pf = pack_frag(pv);
            const LAS unsigned char* v0 = lds + AT_VOFF + (qrel + 16 * t0 + 4 * g + (fr >> 2)) * AT_PITCH + (fr & 3) * 8;
            const LAS unsigned char* v1 = lds + AT_VOFF + (qrel + 16 * t1 + 4 * g + (fr >> 2)) * AT_PITCH + (fr & 3) * 8;
#pragma unroll
            for (int dt = 0; dt < 4; ++dt) o[dt] = mfma16(join8(tr_read(v0 + dt * 32), tr_read(v1 + dt * 32)), pf, o[dt]); }
        pyp = YA + (size_t)(b * SEQ + q) * 512 + 64 * qh + 4 * g;
#pragma unroll
        for (int dt = 0; dt < 4; ++dt) { py[dt].x = cvt_pk_bf16(o[dt][0] * inv, o[dt][1] * inv); py[dt].y = cvt_pk_bf16(o[dt][2] * inv, o[dt][3] * inv); }
    }
#pragma unroll
    for (int dt = 0; dt < 4; ++dt) *(GAS v2u*)(pyp + 16 * dt) = py[dt];
    __syncthreads();
}
constexpr int HG_PITCH = 288;
constexpr int HG_V = 0, HG_KF = 128 * HG_PITCH, HG_KB = 2 * 128 * HG_PITCH, HG_TOT = 3 * 128 * HG_PITCH;
static_assert(HG_TOT + (4 * 8 * 128 + 256) * 4 <= RING_BYTES, "hgrn LDS");
__device__ __forceinline__ void hg_load_scan8(const bf16* p8  , float (&lf)[8], float (&P)[8], float (&T)[8], int lane) {
    const h16x8 hv = *(const GAS h16x8*)p8;
#pragma unroll
    for (int jj = 0; jj < 8; ++jj) { lf[jj] = (float)hv[jj]; P[jj] = scan16(lf[jj]); T[jj] = __shfl(P[jj], (lane & 48) | 15); }
}
__device__ __forceinline__ void hg_v_load(Frame& F, int b, int h, int t0, v4u (&vst)[4]) { const bf16* PA = (const bf16*)(F.ws + WS_PA);
#pragma unroll
    for (int k = 0; k < 4; ++k) { const int idx = F.tid + 512 * k, r = idx >> 4, ch = idx & 15; vst[k] = *(const GAS v4u*)(PA + (size_t)(b * SEQ + t0 + r) * NPA + C_VH + 128 * h + 8 * ch); } }
__device__ __forceinline__ void hg_v_write(Frame& F, const v4u (&vst)[4]) { LAS unsigned char* lds = F.lds + RING_OFF;
#pragma unroll
    for (int k = 0; k < 4; ++k) { const int idx = F.tid + 512 * k, r = idx >> 4, ch = idx & 15; *(LAS v4u*)(lds + HG_V + r * HG_PITCH + ch * 16) = vst[k]; } }
__device__ __forceinline__ void ha_decay_load(Frame& F, int unit, h16x8 (&hvv)[8]) {
    const int bh = unit >> 7, n = unit & 127, b = bh >> 2, h = bh & 3, t0 = n * CH, lane = F.lane, w = F.wave, fr = lane & 15, g = lane >> 4, dir = w >> 2, dq = w & 3;
    const bf16* lp = (const bf16*)(F.ws + WS_PA) + (size_t)(b * SEQ + t0 + fr) * NPA + (dir ? C_LB : C_LF) + 128 * h + 32 * dq + 8 * g;
#pragma unroll
    for (int k = 0; k < 8; ++k) { const int j = dir ? k : (7 - k); hvv[k] = *(const GAS h16x8*)(lp + (size_t)(16 * j) * NPA); }
}
__device__ __forceinline__ void ha_unit(Frame& F, int unit, int next_unit, v4u (&vst)[4], h16x8 (&hvv)[8]) {
    const int bh = unit >> 7, n = unit & 127, b = bh >> 2, h = bh & 3, t0 = n * CH;
    const bf16* PA = (const bf16*)(F.ws + WS_PA); bf16* US = (bf16*)(F.ws + WS_US); float* HD = (float*)(F.ws + WS_HD);
    LAS unsigned char* lds = F.lds + RING_OFF;
    const int lane = F.lane, w = F.wave, fr = lane & 15, g = lane >> 4, dir = w >> 2, dq = w & 3;
    hg_v_write(F, vst);
    if (next_unit >= 0) { const int bh2 = next_unit >> 7; hg_v_load(F, bh2 >> 2, bh2 & 3, (next_unit & 127) * CH, vst); }
    float run[8];
#pragma unroll
    for (int jj = 0; jj < 8; ++jj) run[jj] = 0.f;
    __builtin_amdgcn_sched_barrier(0);
#pragma unroll
    for (int k = 0; k < 8; ++k) { const int j = dir ? k : (7 - k);
        float kv[8];
#pragma unroll
        for (int jj = 0; jj < 8; ++jj) { const float lf = (float)hvv[k][jj], P = scan16(lf), Tt = __shfl(P, (lane & 48) | 15);
            const float wi = dir ? (P - lf) : (Tt - P); kv[jj] = (1.0f - __builtin_amdgcn_exp2f(lf)) * __builtin_amdgcn_exp2f(wi + run[jj]); run[jj] += Tt; }
        *(LAS bf16x8*)(lds + (dir ? HG_KB : HG_KF) + (16 * j + fr) * HG_PITCH + (32 * dq + 8 * g) * 2) = pack_frag(kv); }
    __builtin_amdgcn_sched_barrier(0);
    if (next_unit >= 0) ha_decay_load(F, next_unit, hvv);
    __builtin_amdgcn_sched_barrier(0);
    if (fr == 0) {
#pragma unroll
        for (int jj = 0; jj < 8; ++jj) HD[((size_t)(bh * 2 + dir) * NCH + n) * 128 + 32 * dq + 8 * g + jj] = __builtin_amdgcn_exp2f(run[jj]); }
    __syncthreads();
    f32x4 acc[2][8];
#pragma unroll
    for (int mt = 0; mt < 2; ++mt)
#pragma unroll
        for (int nt = 0; nt < 8; ++nt) acc[mt][nt] = (f32x4){0.f, 0.f, 0.f, 0.f};
    const LAS unsigned char* kb = lds + (dir ? HG_KB : HG_KF) + (4 * g + (fr >> 2)) * HG_PITCH + (fr & 3) * 8;
    const LAS unsigned char* vb = lds + HG_V + (4 * g + (fr >> 2)) * HG_PITCH + (fr & 3) * 8;
#pragma unroll
    for (int ks = 0; ks < 4; ++ks) { bf16x8 af[2];
#pragma unroll
        for (int mt = 0; mt < 2; ++mt) { const LAS unsigned char* p = kb + (32 * ks) * HG_PITCH + (16 * (2 * dq + mt)) * 2; af[mt] = join8(tr_read(p), tr_read(p + 16 * HG_PITCH)); }
#pragma unroll
        for (int nt = 0; nt < 8; ++nt) { const LAS unsigned char* p = vb + (32 * ks) * HG_PITCH + (16 * nt) * 2; const bf16x8 bfr = join8(tr_read(p), tr_read(p + 16 * HG_PITCH));
#pragma unroll
            for (int mt = 0; mt < 2; ++mt) acc[mt][nt] = mfma16(af[mt], bfr, acc[mt][nt]); } }
    bf16* up = US + ((size_t)(bh * 2 + dir) * NCH + n) * 128 * 128;
#pragma unroll
    for (int mt = 0; mt < 2; ++mt)
#pragma unroll
        for (int nt = 0; nt < 8; ++nt) { v2u wv; wv.x = cvt_pk_bf16(acc[mt][nt][0], acc[mt][nt][1]); wv.y = cvt_pk_bf16(acc[mt][nt][2], acc[mt][nt][3]);
            *(GAS v2u*)(up + (size_t)(16 * nt + fr) * 128 + 16 * (2 * dq + mt) + 4 * g) = wv; }
    __syncthreads();
}
#if G1A_SPLIT
__device__ __forceinline__ void phase_hb(Frame& F, int v, int g) {
    bf16* US = (bf16*)(F.ws + WS_US); const float* HD = (const float*)(F.ws + WS_HD);
    const int stride = g * NWAVES * 64, TOT = 16 * 128 * 64;
    for (int ea = v * (NWAVES * 64) + F.tid; ea < TOT; ea += 2 * stride) {
        const bool two = G1A_SPLIT && (ea + stride < TOT); const int eb = two ? ea + stride : ea;
        const int dpa = ea & 63, ca = ea >> 13, dira = ca & 1, dpb = eb & 63, cb = eb >> 13, dirb = cb & 1;
        float a0 = 0.f, a1 = 0.f, b0 = 0.f, b1 = 0.f;
        GAS unsigned* upa = (GAS unsigned*)(US + (size_t)ca * NCH * 128 * 128 + (size_t)((ea >> 6) & 127) * 128) + dpa; const GAS pg8::f32x2_t* dda = (const GAS pg8::f32x2_t*)((const GAS float*)HD + (size_t)ca * NCH * 128) + dpa;
        GAS unsigned* upb = (GAS unsigned*)(US + (size_t)cb * NCH * 128 * 128 + (size_t)((eb >> 6) & 127) * 128) + dpb; const GAS pg8::f32x2_t* ddb = (const GAS pg8::f32x2_t*)((const GAS float*)HD + (size_t)cb * NCH * 128) + dpb;
        for (int k0 = 0; k0 < NCH; k0 += 16) {
            unsigned ua[16], ub[16]; pg8::f32x2_t da[16], db[16];
#pragma unroll
            for (int k = 0; k < 16; ++k) { const int na = dira ? (NCH - 1 - (k0 + k)) : (k0 + k), nb = dirb ? (NCH - 1 - (k0 + k)) : (k0 + k);
                ua[k] = upa[(size_t)na * (128 * 128 / 2)]; da[k] = dda[na * 64]; ub[k] = upb[(size_t)nb * (128 * 128 / 2)]; db[k] = ddb[nb * 64]; }
#pragma unroll
            for (int k = 0; k < 16; ++k) { const int na = dira ? (NCH - 1 - (k0 + k)) : (k0 + k), nb = dirb ? (NCH - 1 - (k0 + k)) : (k0 + k);
                upa[(size_t)na * (128 * 128 / 2)] = pk2(a0, a1);
                a0 = da[k].x * a0 + bflo(ua[k]); a1 = da[k].y * a1 + bfhi(ua[k]);
                if (two) upb[(size_t)nb * (128 * 128 / 2)] = pk2(b0, b1);
                b0 = db[k].x * b0 + bflo(ub[k]); b1 = db[k].y * b1 + bfhi(ub[k]); } }
    }
}
#else
__device__ __forceinline__ void phase_hb(Frame& F, int v, int g) {
    bf16* US = (bf16*)(F.ws + WS_US); const float* HD = (const float*)(F.ws + WS_HD);
    const int idx = v * (NWAVES * 64) + F.tid;
    for (int e0 = idx; e0 < 16 * 128 * 64; e0 += g * NWAVES * 64) { const int dp = e0 & 63, e = (e0 >> 6) & 127, combo = e0 >> 13, dir = combo & 1;
        float s0 = 0.f, s1 = 0.f;
        GAS unsigned* up = (GAS unsigned*)(US + (size_t)combo * NCH * 128 * 128 + (size_t)e * 128) + dp; const GAS float* dpp = (const GAS float*)HD + (size_t)combo * NCH * 128 + 2 * dp;
        for (int k0 = 0; k0 < NCH; k0 += 16) {
            unsigned u[16]; float d0[16], d1[16];
#pragma unroll
            for (int k = 0; k < 16; ++k) { const int n = dir ? (NCH - 1 - (k0 + k)) : (k0 + k); u[k] = up[(size_t)n * (128 * 128 / 2)]; d0[k] = dpp[n * 128]; d1[k] = dpp[n * 128 + 1]; }
#pragma unroll
            for (int k = 0; k < 16; ++k) { const int n = dir ? (NCH - 1 - (k0 + k)) : (k0 + k);
                up[(size_t)n * (128 * 128 / 2)] = pk2(s0, s1);
                s0 = d0[k] * s0 + bflo(u[k]); s1 = d1[k] * s1 + bfhi(u[k]); } }
    }
}
#endif
constexpr int HC_SPITCH = 272;
constexpr int HC_K = 128 * HG_PITCH, HC_S = 2 * 128 * HG_PITCH, HC_E = HC_S + 128 * HC_SPITCH;
static_assert(HC_E + 2 * 8 * 128 * 4 <= RING_BYTES, "hc LDS");
#ifndef HC_TERMS
#define HC_TERMS 7
#endif
__device__ __forceinline__ void hc_unit(Frame& F, int unit, int next_unit, v4u (&vst)[4], const float* hng) {
    const int h = unit & 3, n = (unit >> 2) & 127, b = unit >> 9, bh = b * 4 + h, t0 = n * CH;
    const bf16* PA = (const bf16*)(F.ws + WS_PA); const bf16* US = (const bf16*)(F.ws + WS_US); bf16* YH = (bf16*)(F.ws + WS_YH); float* ssq = (float*)(F.ws + WS_SSQ);
    LAS unsigned char* lds = F.lds + RING_OFF; LAS float* ebl = (LAS float*)(lds + HC_E);
    const int lane = F.lane, i = F.wave, fr = lane & 15, g = lane >> 4;
    const size_t trow = (size_t)(b * SEQ + t0 + 16 * i + fr);
    hg_v_write(F, vst);
    if (next_unit >= 0) hg_v_load(F, next_unit >> 9, next_unit & 3, ((next_unit >> 2) & 127) * CH, vst);
    const bf16* sbase0 = US + ((size_t)(bh * 2) * NCH + n) * 128 * 128;
    v4u sreg[4];
#pragma unroll
    for (int k = 0; k < 4; ++k) { const int c = F.tid + 512 * k; sreg[k] = *(const GAS v4u*)(sbase0 + (size_t)(c >> 4) * 128 + (c & 15) * 8); }
    h16x8 lfv[2][4]; v4u qwv[4];
#pragma unroll
    for (int ks = 0; ks < 4; ++ks) { lfv[0][ks] = *(const GAS h16x8*)(PA + trow * NPA + C_LF + 128 * h + 32 * ks + 8 * g); qwv[ks] = *(const GAS v4u*)(PA + trow * NPA + C_QH + 128 * h + 32 * ks + 8 * g); }
#pragma unroll
    for (int ks = 0; ks < 4; ++ks) lfv[1][ks] = *(const GAS h16x8*)(PA + trow * NPA + C_LB + 128 * h + 32 * ks + 8 * g);
    __builtin_amdgcn_sched_barrier(0);
    f32x4 o[8];
#pragma unroll
    for (int et = 0; et < 8; ++et) o[et] = (f32x4){0.f, 0.f, 0.f, 0.f};
    const LAS unsigned char* vtr = lds + HG_V + (4 * g + (fr >> 2)) * HG_PITCH + (fr & 3) * 8;
#pragma unroll
    for (int dir = 0; dir < 2; ++dir) {
        if (dir == 1) __syncthreads();
#pragma unroll
        for (int k = 0; k < 4; ++k) { const int c = F.tid + 512 * k; *(LAS v4u*)(lds + HC_S + (c >> 4) * HC_SPITCH + (c & 15) * 16) = sreg[k]; }
        float ql[32]; bf16x8 kst[4]; bf16x8 qf[4];
#pragma unroll
        for (int ks = 0; ks < 4; ++ks) { float lf[8], P[8], T[8], ke[8], kd[8], t8[8], et_[8];
            { const h16x8 hv = lfv[dir][ks];
#pragma unroll
              for (int jj = 0; jj < 8; ++jj) { lf[jj] = (float)hv[jj]; P[jj] = scan16(lf[jj]); T[jj] = __shfl(P[jj], (lane & 48) | 15); } }
            const v4u qw = qwv[ks];
            const float qv[8] = {bflo(qw.x), bfhi(qw.x), bflo(qw.y), bfhi(qw.y), bflo(qw.z), bfhi(qw.z), bflo(qw.w), bfhi(qw.w)};
#pragma unroll
            for (int jj = 0; jj < 8; ++jj) { const float kk = 1.0f - __builtin_amdgcn_exp2f(lf[jj]);
                const float binc = dir ? (T[jj] - P[jj] + lf[jj]) : P[jj];
                const float ea = __builtin_amdgcn_exp2f(binc), ra = __builtin_amdgcn_rcpf(ea); et_[jj] = __builtin_amdgcn_exp2f(T[jj]);
                ql[8 * ks + jj] = qv[jj] * ea; t8[jj] = ql[8 * ks + jj]; ke[jj] = kk * et_[jj] * ra; kd[jj] = kk * ra;
#if defined(HC_DBG) && HC_DBG >= 3
                ql[8 * ks + jj] = qv[jj]; t8[jj] = qv[jj]; kd[jj] = kk;
                if (HC_DBG == 4) kd[jj] = (32 * ks + 8 * g + jj == 0) ? 1.0f : 0.f;
                if (HC_DBG == 5) kd[jj] = (32 * ks + 8 * g + jj == 0) ? kk : 0.f;
                if (HC_DBG >= 9) kd[jj] = 0.f;
                if (HC_DBG == 8) kd[jj] = (32 * ks + 8 * g + jj == 0) ? (float)fr : 0.f;
                if (HC_DBG == 6) kd[jj] = (32 * ks + 8 * g + jj == 0) ? lf[jj] : 0.f;
                if (HC_DBG == 7) kd[jj] = (32 * ks + 8 * g + jj == 0) ? (1.0f - __expf(lf[jj])) : 0.f;
#endif
                }
            *(LAS bf16x8*)(lds + HC_K + (16 * i + fr) * HG_PITCH + (32 * ks + 8 * g) * 2) = pack_frag(ke);
            kst[ks] = pack_frag(kd); qf[ks] = pack_frag(t8);
            if (fr == 0) {
#pragma unroll
                for (int jj = 0; jj < 8; ++jj) ebl[(dir * 8 + i) * 128 + 32 * ks + 8 * g + jj] = et_[jj]; }
            __builtin_amdgcn_sched_barrier(0); }
        __syncthreads();
        if (dir == 0) {
#pragma unroll
            for (int k = 0; k < 4; ++k) { const int c = F.tid + 512 * k; sreg[k] = *(const GAS v4u*)(sbase0 + (size_t)NCH * 128 * 128 + (size_t)(c >> 4) * 128 + (c & 15) * 8); } }
        f32x4 at = (f32x4){0.f, 0.f, 0.f, 0.f};
#pragma unroll
        for (int ks = 0; ks < 4; ++ks) at = mfma16(kst[ks], qf[ks], at);
#if defined(HC_DBG) && HC_DBG >= 9
        { const float q0 = __shfl(ql[0], fr);
          for (int r = 0; r < 4; ++r) at[r] = (HC_DBG == 9) ? (float)(4 * g + r) * q0 : ((HC_DBG == 10) ? (float)(4 * g + r) : (float)fr); }
#endif
        float pend[4]; int jpend = i;
#pragma unroll
        for (int r = 0; r < 4; ++r) { const int s = 4 * g + r; const bool keep = (HC_TERMS & 1) && (dir ? (s >= fr) : (s <= fr)); pend[r] = keep ? at[r] : 0.f;
#if defined(HC_DBG) && HC_DBG == 1
            pend[r] = (dir == 0 && s == fr) ? 1.0f : 0.f;
#endif
            }
        bool have = true;
        const int nj = dir ? (7 - i) : i;
        for (int k = 0; k < nj; ++k) { const int j = dir ? (i + 1 + k) : (i - 1 - k);
            f32x4 a2 = (f32x4){0.f, 0.f, 0.f, 0.f};
            const LAS unsigned char* kp = lds + HC_K + (16 * j + fr) * HG_PITCH + g * 16;
#pragma unroll
            for (int ks = 0; ks < 4; ++ks) a2 = mfma16(*(const LAS bf16x8*)(kp + ks * 64), qf[ks], a2);
#pragma unroll
            for (int ks = 0; ks < 4; ++ks) { const LAS float* ep = ebl + (dir * 8 + j) * 128 + 32 * ks + 8 * g; float t8[8];
#pragma unroll
                for (int jj = 0; jj < 8; ++jj) { ql[8 * ks + jj] *= ep[jj]; t8[jj] = ql[8 * ks + jj]; }
                qf[ks] = pack_frag(t8); }
            if (have) { float pv[8];
#pragma unroll
                for (int r = 0; r < 4; ++r) { pv[r] = pend[r]; pv[4 + r] = (HC_TERMS & 2) ? a2[r] : 0.f; }
                const bf16x8 pf = pack_frag(pv); const LAS unsigned char* v0 = vtr + 16 * jpend * HG_PITCH; const LAS unsigned char* v1 = vtr + 16 * j * HG_PITCH;
#pragma unroll
                for (int et = 0; et < 8; ++et) o[et] = mfma16(join8(tr_read(v0 + et * 32), tr_read(v1 + et * 32)), pf, o[et]);
                have = false;
            } else {
#pragma unroll
                for (int r = 0; r < 4; ++r) pend[r] = (HC_TERMS & 2) ? a2[r] : 0.f;
                jpend = j; have = true; }
        }
        if (have) { float pv[8];
#pragma unroll
            for (int r = 0; r < 4; ++r) { pv[r] = pend[r]; pv[4 + r] = 0.f; }
            const bf16x8 pf = pack_frag(pv); const LAS unsigned char* v0 = vtr + 16 * jpend * HG_PITCH;
#pragma unroll
            for (int et = 0; et < 8; ++et) o[et] = mfma16(join8(tr_read(v0 + et * 32), tr_read(v0 + et * 32)), pf, o[et]); }
        const LAS unsigned char* sp = lds + HC_S + fr * HC_SPITCH + g * 16;
#pragma unroll
        for (int et = 0; et < 8; ++et)
#pragma unroll
            for (int ks = 0; ks < 4; ++ks) if (HC_TERMS & 4) o[et] = mfma16(*(const LAS bf16x8*)(sp + 16 * et * HC_SPITCH + ks * 64), qf[ks], o[et]);
    }
    float sq = 0.f; bf16* yp = YH + trow * 512 + 128 * h + 4 * g; const bf16* sgp = PA + trow * NPA + C_SG + 128 * h + 4 * g; const float* gp = hng + 128 * h + 4 * g;
    v2u swv[8]; f32x4 gvv[8];
#pragma unroll
    for (int et = 0; et < 8; ++et) { swv[et] = *(const GAS v2u*)(sgp + 16 * et); gvv[et] = *(const GAS f32x4*)(gp + 16 * et); }
#pragma unroll
    for (int et = 0; et < 8; ++et) { const v2u sw = swv[et]; const f32x4 gv = gvv[et]; const f32x4 ov = o[et];
        sq += (ov[0] * ov[0] + ov[1] * ov[1]) + (ov[2] * ov[2] + ov[3] * ov[3]);
        v2u wv; wv.x = cvt_pk_bf16(ov[0] * gv[0] * bflo(sw.x), ov[1] * gv[1] * bfhi(sw.x)); wv.y = cvt_pk_bf16(ov[2] * gv[2] * bflo(sw.y), ov[3] * gv[3] * bfhi(sw.y));
        *(GAS v2u*)(yp + 16 * et) = wv; }
    sq += __shfl_xor(sq, 16); sq += __shfl_xor(sq, 32);
    if (g == 0) ssq[trow * 4 + h] = sq;
    __syncthreads();
}
__device__ __forceinline__ int attn_item_unit(int i) { return (i < 256) ? i : 256 + ((i + 64) & 255); }
__device__ __forceinline__ void phase_attn(Frame& F, const float* sink) { constexpr int NU = BATCH * NKVH * (SEQ / 128); v4u st[12];
    static_assert(NU == 512, "attn_item_unit");
    if (F.vcu < NU) attn_stage_load(F, attn_item_unit(F.vcu), st);
    for (int i = F.vcu; i < NU; i += F.G) attn_unit(F, attn_item_unit(i), (i + F.G < NU) ? attn_item_unit(i + F.G) : -1, st, sink); }
__device__ __forceinline__ void phase_ha(Frame& F) { constexpr int NU = BATCH * HH * NCH; v4u vst[4]; h16x8 hvv[8];
    if (F.vcu < NU) { const int bh = F.vcu >> 7; hg_v_load(F, bh >> 2, bh & 3, (F.vcu & 127) * CH, vst); ha_decay_load(F, F.vcu, hvv); }
    for (int u = F.vcu; u < NU; u += F.G) ha_unit(F, u, (u + F.G < NU) ? u + F.G : -1, vst, hvv); }
__device__ __forceinline__ void phase_hc(Frame& F, const float* hng) {
    constexpr int NU = BATCH * NCH * HH; v4u vst[4];
    if (F.vcu < NU) hg_v_load(F, F.vcu >> 9, F.vcu & 3, ((F.vcu >> 2) & 127) * CH, vst);
    for (int u = F.vcu; u < NU; u += F.G) hc_unit(F, u, (u + F.G < NU) ? u + F.G : -1, vst, hng);
}

#if ROUTE_MFMA
constexpr int RM_PITCH = 2064, RM_ROWS0 = 63, RM_OFF1 = 132352;
static_assert(RM_ROWS0 * RM_PITCH <= LDSCTL_OFF && RM_OFF1 >= BRE_OFF + 128 && RM_OFF1 + (72 - RM_ROWS0) * RM_PITCH <= LDS_BYTES, "router LDS");
static_assert(NORMFOLD == 1 && XBF16 == 1, "the MFMA router reads the bf16 residual stream and writes no normalised copy");
__device__ __forceinline__ int rm_row(int R) { return R < RM_ROWS0 ? R * RM_PITCH : RM_OFF1 + (R - RM_ROWS0) * RM_PITCH; }
template <int N> __device__ __forceinline__ int dpp_ror_i(int v) { return __builtin_amdgcn_update_dpp(0, v, 0x120 + N, 0xf, 0xf, false); }
__device__ __forceinline__ float rowmax16(float v) { v = fmaxf(v, dpp_ror_t<8>(v)); v = fmaxf(v, dpp_ror_t<4>(v)); v = fmaxf(v, dpp_ror_t<2>(v)); v = fmaxf(v, dpp_ror_t<1>(v)); return v; }
__device__ __forceinline__ int rowmin16i(int v) { v = min(v, dpp_ror_i<8>(v)); v = min(v, dpp_ror_i<4>(v)); v = min(v, dpp_ror_i<2>(v)); v = min(v, dpp_ror_i<1>(v)); return v; }
__device__ __forceinline__ void phase_route_mfma(Frame& F, const Args& A, int l, const void* xsrc) {
    const int lane = F.lane, j = lane & 15, kg = lane >> 4, gw = F.vcu * NWAVES + F.wave, NGW = F.G * NWAVES;
    LAS unsigned char* lds = F.lds;
    volatile LAS int* hist = (volatile LAS int*)(F.lds + HIST_OFF);
    const float* w_re = A.in[I_WRE] + (size_t)l * NGRP * D * EPG;
    const float* w_rg = A.in[I_WRG] + (size_t)l * D * NGRP;
    const float* b_rg = A.in[I_BRG] + l * NGRP;
    const float* b_re = A.in[I_BRE] + l * NGRP * EPG;
    const float* gf = A.in[I_FNG] + (size_t)l * D;
    {
        const int k0 = 2 * F.tid;
        f32x4 we[4][4];
#pragma unroll
        for (int g = 0; g < 4; ++g) { const GAS f32x4* p = (const GAS f32x4*)(w_re + ((size_t)g * D + k0) * 8);
#pragma unroll
            for (int q = 0; q < 4; ++q) we[g][q] = p[q]; }
        const f32x4 wg0 = *(const GAS f32x4*)(w_rg + (size_t)k0 * 4), wg1 = *(const GAS f32x4*)(w_rg + (size_t)(k0 + 1) * 4);
        const float g0 = gf[k0], g1 = gf[k0 + 1];
        __builtin_amdgcn_sched_barrier(0);
#pragma unroll
        for (int n = 0; n < 36; ++n) {
            const float a = (n < 32 ? we[n >> 3][(n & 7) >> 2][n & 3] : wg0[n & 3]) * g0, b = (n < 32 ? we[n >> 3][2 + ((n & 7) >> 2)][n & 3] : wg1[n & 3]) * g1;
            const unsigned hi = cvt_pk_bf16(a, b), lo = cvt_pk_bf16(a - bflo(hi), b - bfhi(hi));
            *(LAS unsigned*)(lds + rm_row(n) + k0 * 2) = hi; *(LAS unsigned*)(lds + rm_row(36 + n) + k0 * 2) = lo; }
    }
    if (F.tid < 32) hist[F.tid] = 0;
    { int* stok = (int*)(F.ws + WS_STOK); for (int i = F.vcu * (NWAVES * 64) + F.tid; i < SLOT_ROWS; i += F.G * NWAVES * 64) stok[i] = 0; }
    const float bias0 = b_re[j], bias1 = b_re[16 + j], bias2 = b_rg[j & 3];
    int ra[2][3];
#pragma unroll
    for (int sp = 0; sp < 2; ++sp)
#pragma unroll
        for (int nt = 0; nt < 3; ++nt) ra[sp][nt] = rm_row(sp * 36 + (nt < 2 ? 16 * nt + j : 32 + (j & 3))) + kg * 16;
    const bf16* X = (const bf16*)xsrc;
    int* tok_e = (int*)(F.ws + WS_TOKE); float* tok_w = (float*)(F.ws + WS_TOKW); int* tok_r = (int*)(F.ws + WS_TOKR); float* rsf = (float*)(F.ws + WS_RSF);
    bool first = true;
    for (int tt = gw; tt < T / 16; tt += NGW) {
        bf16x8 xa[32];
        { const bf16* xp = X + (size_t)(16 * tt + j) * D + 8 * kg;
#pragma unroll
          for (int ks = 0; ks < 32; ++ks) xa[ks] = *(const GAS bf16x8*)(xp + 32 * ks); }
        if (first) { __syncthreads(); first = false; }
        float ssq = 0.f; f32x4 acc[3];
#pragma unroll
        for (int nt = 0; nt < 3; ++nt) acc[nt] = (f32x4){0.f, 0.f, 0.f, 0.f};
#pragma unroll
        for (int ks = 0; ks < 32; ++ks) { const v4u xw = __builtin_bit_cast(v4u, xa[ks]);
            { const float e0 = bflo(xw.x), e1 = bfhi(xw.x), e2 = bflo(xw.y), e3 = bfhi(xw.y), e4 = bflo(xw.z), e5 = bfhi(xw.z), e6 = bflo(xw.w), e7 = bfhi(xw.w);
              ssq += ((e0 * e0 + e1 * e1) + (e2 * e2 + e3 * e3)) + ((e4 * e4 + e5 * e5) + (e6 * e6 + e7 * e7)); }
#pragma unroll
            for (int sp = 0; sp < 2; ++sp)
#pragma unroll
                for (int nt = 0; nt < 3; ++nt) acc[nt] = mfma16(xa[ks], *(const LAS bf16x8*)(lds + ra[sp][nt] + ks * 64), acc[nt]); }
        ssq += __shfl_xor(ssq, 16); ssq += __shfl_xor(ssq, 32);
        const float rstdA = 1.0f / sqrtf(ssq * (1.f / D) + NORM_EPS);
#pragma unroll
        for (int r = 0; r < 4; ++r) { const int m = 16 * tt + 4 * kg + r; const float rs = __shfl(rstdA, 4 * kg + r);
            const float glv = acc[2][r] * rs + bias2;
            const float gm = rowmax16(glv); const int gt = rowmin16i(glv == gm ? (j & 3) : 99);
            const float p_top = 4.0f / rowsum16(expf(glv - gm));
            const bool hiT = (gt >> 1) != 0, valid = ((j >> 3) == (gt & 1));
            const float ev = (hiT ? acc[1][r] : acc[0][r]) * rs + (hiT ? bias1 : bias0);
            const float ev1 = valid ? ev : -3.0e38f; const float m1 = rowmax16(ev1); const int i1 = rowmin16i(ev1 == m1 ? (j & 7) : 99);
            const float ev2 = (valid && (j & 7) != i1) ? ev : -3.0e38f; const float m2 = rowmax16(ev2); const int i2 = rowmin16i(ev2 == m2 ? (j & 7) : 99);
            const float q2 = expf(m2 - m1), wn1 = p_top / (1.0f + q2), wn2 = p_top * q2 / (1.0f + q2);
            if (j == 0) { const int e1 = gt * 8 + i1, e2 = gt * 8 + i2;
                const int r1 = __hip_atomic_fetch_add((LAS int*)hist + e1, 1, __ATOMIC_RELAXED, __HIP_MEMORY_SCOPE_WORKGROUP);
                const int r2 = __hip_atomic_fetch_add((LAS int*)hist + e2, 1, __ATOMIC_RELAXED, __HIP_MEMORY_SCOPE_WORKGROUP);
                tok_e[2 * m] = e1; tok_e[2 * m + 1] = e2; tok_w[2 * m] = wn1; tok_w[2 * m + 1] = wn2; tok_r[2 * m] = r1; tok_r[2 * m + 1] = r2; rsf[m] = rs; } }
    }
    if (first) __syncthreads();
    __syncthreads();
    if (F.tid < 32) ((int*)(F.ws + WS_WGCNT))[blockIdx.x * 32 + F.tid] = hist[F.tid];
}
#endif
#else
__device__ void phase_attn(Frame& F, const float* sink);
__device__ void phase_ha(Frame& F);
__device__ void phase_hb(Frame& F, int v, int g);
__device__ void phase_hc(Frame& F, const float* hng);
#if ROUTE_MFMA
__device__ void phase_route_mfma(Frame& F, const Args& A, int l, const void* xsrc);
#endif
#endif


#if defined(ORACLE)
__global__ void __launch_bounds__(256) simple_attn(const bf16* PA, const float* sink, bf16* YA) {
    const int lane = threadIdx.x & 63, task = blockIdx.x * 4 + (threadIdx.x >> 6);
    const int m = task >> 3, qh = task & 7, kvh = qh >> 2, b = m / SEQ, t = m % SEQ;
    float q[64];
    { const bf16* qp = PA + (size_t)m * NPA + C_QA + 64 * qh;
#pragma unroll
      for (int d = 0; d < 64; ++d) q[d] = bf2f(qp[d]); }
    float s[5]; float mx = sink[qh] * LOG2E;
#pragma unroll
    for (int r = 0; r < 5; ++r) { const int j = t - WINDOW + 64 * r + lane; const bool ok = (j >= 0) && (j < SEQ) && (j <= t + WINDOW);
        float a = -3.0e38f;
        if (ok) { const bf16* kp = PA + (size_t)(b * SEQ + j) * NPA + C_KA + 64 * kvh; a = 0.f;
#pragma unroll
            for (int d = 0; d < 64; ++d) a += q[d] * bf2f(kp[d]); }
        s[r] = a; mx = fmaxf(mx, a); }
#pragma unroll
    for (int o = 1; o < 64; o <<= 1) mx = fmaxf(mx, __shfl_xor(mx, o));
    float den = 0.f;
#pragma unroll
    for (int r = 0; r < 5; ++r) { s[r] = (s[r] > -1.0e38f) ? exp2f(s[r] - mx) : 0.f; den += s[r]; }
    den = wave_sum(den) + exp2f(sink[qh] * LOG2E - mx);
    float o = 0.f;
    for (int r = 0; r < 5; ++r) for (int jj = 0; jj < 64; ++jj) { const int j = t - WINDOW + 64 * r + jj; const float p = __shfl(s[r], jj);
        if (j >= 0 && j < SEQ && j <= t + WINDOW) o += p * bf2f(PA[(size_t)(b * SEQ + j) * NPA + C_VA + 64 * kvh + lane]); }
#if defined(ABL_NOATTN)
    YA[(size_t)m * 512 + 64 * qh + lane] = 0;
#else
    YA[(size_t)m * 512 + 64 * qh + lane] = (bf16)f2bf(o / den);
#endif
}
__global__ void __launch_bounds__(512) simple_hgrn(const bf16* PA, const float* hng, float* obuf, bf16* YH, float* ssq) {
    __shared__ float part[32][4][128];
    const int tid = threadIdx.x, e = tid & 127, dq = tid >> 7, b = blockIdx.x >> 2, h = blockIdx.x & 3;
    for (int dir = 0; dir < 2; ++dir) {
        float S[32];
#pragma unroll
        for (int d = 0; d < 32; ++d) S[d] = 0.f;
        for (int t0 = 0; t0 < SEQ; t0 += 32) {
            for (int tt = 0; tt < 32; ++tt) { const int t = dir ? (SEQ - 1 - (t0 + tt)) : (t0 + tt); const bf16* row = PA + (size_t)(b * SEQ + t) * NPA;
                const float v = bf2f(row[C_VH + 128 * h + e]); const _Float16* lf = (const _Float16*)(row + (dir ? C_LB : C_LF) + 128 * h + 32 * dq); const bf16* qp = row + C_QH + 128 * h + 32 * dq;
                float o = 0.f;
#pragma unroll
                for (int d = 0; d < 32; ++d) { const float l = (float)lf[d], f = expf(l), k = -expm1f(l); S[d] = f * S[d] + k * v; o += S[d] * bf2f(qp[d]); }
                part[tt][dq][e] = o; }
            __syncthreads();
            for (int idx = tid; idx < 32 * 128; idx += 512) { const int tt = idx >> 7, ee = idx & 127; const int t = dir ? (SEQ - 1 - (t0 + tt)) : (t0 + tt); const size_t m = (size_t)b * SEQ + t;
                float o = (part[tt][0][ee] + part[tt][1][ee]) + (part[tt][2][ee] + part[tt][3][ee]);
                if (dir == 0) obuf[m * 512 + 128 * h + ee] = o;
                else { o += obuf[m * 512 + 128 * h + ee];
                    const float sg = bf2f(PA[m * NPA + C_SG + 128 * h + ee]);
#if defined(ABL_NOHGRN)
                    YH[m * 512 + 128 * h + ee] = 0;
#else
                    YH[m * 512 + 128 * h + ee] = (bf16)f2bf(o * hng[128 * h + ee] * sg);
#endif

                    const float q = wave_sum(o * o);
                    if ((tid & 63) == 0) atomicAdd(&ssq[m * 4 + h], q); } }
            __syncthreads();
        }
    }
}
__global__ void zero_f32(float* p, int n) { const int i = blockIdx.x * blockDim.x + threadIdx.x; if (i < n) p[i] = 0.f; }
#endif

#if defined(CHECK)
#define CK_NS 48
__device__ __forceinline__ int ck_row(int s) { return (int)(((long)s * 10007 + 77) % T); }
__device__ __forceinline__ bool ck_cmp(float got, float ref, float rtol, float atol, unsigned* cnt) { const float d = fabsf(got - ref); if (!(d <= rtol * fabsf(ref) + atol)) { atomicAdd(cnt, 1u); return true; } return false; }
__global__ void ck_norm(const float* x, const float* g, const bf16* XN, unsigned* cnt) {
    const int m = ck_row(blockIdx.x); __shared__ float red[256];
    float s = 0.f; for (int c = threadIdx.x; c < D; c += 256) { const float v = x[(size_t)m * D + c]; s += v * v; }
    red[threadIdx.x] = s; __syncthreads(); for (int o = 128; o > 0; o >>= 1) { if (threadIdx.x < o) red[threadIdx.x] += red[threadIdx.x + o]; __syncthreads(); }
    const float rstd = 1.0f / sqrtf(red[0] / D + NORM_EPS);
    for (int c = threadIdx.x; c < D; c += 256) ck_cmp(bf2f(XN[(size_t)m * D + c]), x[(size_t)m * D + c] * rstd * g[c], 0.01f, 0.01f, cnt);
}
__global__ void ck_pa(const bf16* XN, const float* w_in, const float* lb_tab  , int l, const bf16* PA, unsigned* cnt) {
    const int m = ck_row(blockIdx.x), pos = m % SEQ; __shared__ float z[NPA]; __shared__ float xr[D];
    for (int c = threadIdx.x; c < D; c += 256) xr[c] = bf2f(XN[(size_t)m * D + c]);
    __syncthreads();
    for (int c = threadIdx.x; c < NPA; c += 256) { float a = 0.f; for (int k = 0; k < D; ++k) a += xr[k] * w_in[(size_t)k * INW + c]; z[c] = a; }
    __syncthreads();
    for (int c = threadIdx.x; c < NPA; c += 256) {
        const float got_b = bf2f(PA[(size_t)m * NPA + c]); const float got_h = (float)((const _Float16*)PA)[(size_t)m * NPA + c];
        if (c < C_VA) { const int d = c & 63, i = d & 31; const double inv = exp2(-(double)i * (13.287712379549449 / 32.0)); const float cs = (float)cos((double)pos * inv), sn = (float)sin((double)pos * inv);
            const float x1 = z[(c & ~63) + i], x2 = z[(c & ~63) + i + 32]; float r = (d < 32) ? (x1 * cs - x2 * sn) : (x2 * cs + x1 * sn); if (c < C_KA) r *= QSCALE;
            ck_cmp(got_b, r, 0.02f, 0.03f, cnt + 0);
        } else if (c < C_QH) ck_cmp(got_b, z[c], 0.02f, 0.02f, cnt + 1);
        else if (c < C_LF) ck_cmp(got_b, z[c] / (1.f + expf(-z[c])), 0.02f, 0.02f, cnt + 2);
        else if (c < C_VH) { const int dir = (c >= C_LB), col = c - (dir ? C_LB : C_LF);
            float t0 = lb_tab[(0 * 2 + dir) * 512 + col], t1 = lb_tab[(1 * 2 + dir) * 512 + col]; const float mx = fmaxf(t0, t1); t0 = expf(t0 - mx); t1 = expf(t1 - mx);
            const float lb = (l == 0) ? 0.f : t1 / (t0 + t1); const float sg = 1.f / (1.f + expf(-z[c])); const float r = fmaxf(logf(lb + (1.f - lb) * sg), LOGF_MIN);
            ck_cmp(got_h, r, 0.01f, 0.02f, cnt + 3);
        } else if (c < C_SG) ck_cmp(got_b, z[c], 0.02f, 0.02f, cnt + 4);
        else ck_cmp(got_b, z[c] / (1.f + expf(-z[c])), 0.02f, 0.02f, cnt + 5);
    }
}
__global__ void ck_mix(const bf16* XN, const float* w_in, const bf16* YA, const bf16* YH, const float* ssq, const float* wua, const float* wuh, const bf16* GT, const bf16* MG, int which, unsigned* cnt) {
#ifndef CK_SHIFT
#define CK_SHIFT 0
#endif
    const int m = ck_row((blockIdx.x + CK_SHIFT) % CK_NS); __shared__ float xr[D]; __shared__ float ya[512]; __shared__ float yh[512];
    for (int c = threadIdx.x; c < D; c += 256) xr[c] = bf2f(XN[(size_t)m * D + c]);
    for (int c = threadIdx.x; c < 512; c += 256) { ya[c] = bf2f(YA[(size_t)m * 512 + c]); yh[c] = bf2f(YH[(size_t)m * 512 + c]); }
    __syncthreads();
    const float rstd = 1.0f / sqrtf((ssq[m * 4] + ssq[m * 4 + 1] + ssq[m * 4 + 2] + ssq[m * 4 + 3]) / 512.f + NORM_EPS);
    for (int c = threadIdx.x; c < D; c += 256) { float a = 0.f, b = 0.f, p = 0.f, q = 0.f;
        for (int k = 0; k < D; ++k) { a += xr[k] * w_in[(size_t)k * INW + NPA + c]; b += xr[k] * w_in[(size_t)k * INW + NPA + 1024 + c]; }
        for (int k = 0; k < 512; ++k) { p += ya[k] * wua[(size_t)k * D + c]; q += yh[k] * wuh[(size_t)k * D + c]; }
        float ga = 1.f / (1.f + expf(-a)), gb = 1.f / (1.f + expf(-b));
        if (which != 0) { ga = bf2f(GT[(size_t)m * NGATE + c]); gb = bf2f(GT[(size_t)m * NGATE + 1024 + c]); }
        if (which == 0) { unsigned* dbg = cnt + 100; if (blockIdx.x == 27) { const float e0 = fabsf(bf2f(GT[(size_t)m * NGATE + c]) - ga), e1 = fabsf(bf2f(GT[(size_t)m * NGATE + 1024 + c]) - gb); atomicMax(dbg + 200, __float_as_uint(e0)); atomicMax(dbg + 200, __float_as_uint(e1)); atomicMax(dbg + 201, __float_as_uint(fabsf(a))); atomicMax(dbg + 201, __float_as_uint(fabsf(b))); if (GT[(size_t)m * NGATE + c] == 0xFFFFu) atomicAdd(dbg + 203, 1u); if (GT[(size_t)m * NGATE + 1024 + c] == 0xFFFFu) atomicAdd(dbg + 203, 1u); if (e0 > 0.2f) { atomicAdd(dbg + 202, 1u); atomicOr(dbg + 210 + (c >> 11), 0u); atomicAdd(dbg + 300 + (c >> 6), 1u); } if (e1 > 0.2f) { atomicAdd(dbg + 202, 1u); atomicAdd(dbg + 300 + 16 + (c >> 6), 1u); } } if (ck_cmp(bf2f(GT[(size_t)m * NGATE + c]), ga, 0.01f, 0.01f, cnt + 0)) { atomicAdd(dbg + blockIdx.x, 1u); atomicAdd(dbg + 64 + (c >> 5), 1u); } if (ck_cmp(bf2f(GT[(size_t)m * NGATE + 1024 + c]), gb, 0.01f, 0.01f, cnt + 0)) { atomicAdd(dbg + blockIdx.x, 1u); atomicAdd(dbg + 64 + 32 + (c >> 5), 1u); } }
        else if (which == 1) ck_cmp(bf2f(MG[(size_t)m * D + c]), ga * p, 0.03f, 0.01f, cnt + 1);
        else ck_cmp(bf2f(MG[(size_t)m * D + c]), ga * p + gb * rstd * q, 0.03f, 0.02f, cnt + 2); }
}
__global__ void ck_out(const float* xprev, const bf16* MG, const float* wout, const float* X, unsigned* cnt) {
    const int m = ck_row(blockIdx.x); __shared__ float mg[D];
    for (int c = threadIdx.x; c < D; c += 256) mg[c] = bf2f(MG[(size_t)m * D + c]);
    __syncthreads();
    for (int c = threadIdx.x; c < D; c += 256) { float a = 0.f; for (int k = 0; k < D; ++k) a += mg[k] * wout[(size_t)k * D + c]; ck_cmp(X[(size_t)m * D + c], xprev[(size_t)m * D + c] + a, 0.01f, 0.02f, cnt); }
}
__global__ void ck_moe(const float* X, const float* g, const float* wrg, const float* brg, const float* wre, const float* bre, const float* weg, const float* weu, const float* wed,
                       const bf16* XN, const int* tok_e, const float* tok_w, const int* tok_p, const int* meta, const bf16* XP, const bf16* ACT, const bf16* Y, int stage, unsigned* cnt) {
    const int m = ck_row(blockIdx.x); __shared__ float h[D]; __shared__ float red[256]; __shared__ float lg[36]; __shared__ float act[DEXP];
    float s = 0.f; for (int c = threadIdx.x; c < D; c += 256) { const float v = X[(size_t)m * D + c]; s += v * v; }
    red[threadIdx.x] = s; __syncthreads(); for (int o = 128; o > 0; o >>= 1) { if (threadIdx.x < o) red[threadIdx.x] += red[threadIdx.x + o]; __syncthreads(); }
    const float rstd = 1.0f / sqrtf(red[0] / D + NORM_EPS);
    for (int c = threadIdx.x; c < D; c += 256) h[c] = X[(size_t)m * D + c] * rstd * g[c];
    __syncthreads();
    if (threadIdx.x < 36) { const int t = threadIdx.x; float a = 0.f;
        if (t < 4) { for (int k = 0; k < D; ++k) a += h[k] * wrg[k * 4 + t]; a += brg[t]; } else { const int gg = (t - 4) >> 3, e = (t - 4) & 7; for (int k = 0; k < D; ++k) a += h[k] * wre[((size_t)gg * D + k) * 8 + e]; a += bre[gg * 8 + e]; }
        lg[t] = a; }
    __syncthreads();
    int gt = 0; for (int k = 1; k < 4; ++k) if (lg[k] > lg[gt]) gt = k;
    float gden = 0.f; for (int k = 0; k < 4; ++k) gden += expf(lg[k] - lg[gt]);
    const float* el = lg + 4 + gt * 8; int i1 = 0; for (int k = 1; k < 8; ++k) if (el[k] > el[i1]) i1 = k; int i2 = (i1 == 0) ? 1 : 0; for (int k = 0; k < 8; ++k) if (k != i1 && el[k] > el[i2]) i2 = k;
    const float q2 = expf(el[i2] - el[i1]); const float w1 = (1.f / gden) / (1.f + q2), w2 = (1.f / gden) * q2 / (1.f + q2);
    const int e1 = gt * 8 + i1, e2 = gt * 8 + i2;
    if (stage == 0) { if (threadIdx.x == 0) { if (tok_e[2 * m] != e1 || tok_e[2 * m + 1] != e2) atomicAdd(cnt + 0, 1u); ck_cmp(tok_w[2 * m], w1, 0.01f, 1e-3f, cnt + 1); ck_cmp(tok_w[2 * m + 1], w2, 0.01f, 1e-3f, cnt + 1); } return; }
    for (int kk = 0; kk < 2; ++kk) { const int e = tok_e[2 * m + kk], p = tok_p[2 * m + kk];
        if (stage == 1) { if (threadIdx.x == 0) { const int rt = p >> 8; if (rt >= meta[0] || meta[1 + rt] != e) atomicAdd(cnt + 2, 1u); }
            for (int c = threadIdx.x; c < D; c += 256) if (XP[(size_t)p * D + c] != XN[(size_t)m * D + c]) atomicAdd(cnt + 3, 1u); continue; }
        const float* wg = weg + (size_t)e * D * DEXP; const float* wu = weu + (size_t)e * D * DEXP; const float* wd = wed + (size_t)e * DEXP * D;
        __syncthreads();
        for (int j = threadIdx.x; j < DEXP; j += 256) { float a = 0.f, b = 0.f; for (int k = 0; k < D; ++k) { const float hv = bf2f(XN[(size_t)m * D + k]); a += hv * wg[(size_t)k * DEXP + j]; b += hv * wu[(size_t)k * DEXP + j]; }
            const float r = a / (1.f + expf(-a)) * b; act[j] = r; if (stage == 2) ck_cmp(bf2f(ACT[(size_t)p * DEXP + j]), r, 0.03f, 0.02f, cnt + 4); }
        __syncthreads();
        if (stage == 3) for (int c = threadIdx.x; c < D; c += 256) { float a = 0.f; for (int j = 0; j < DEXP; ++j) a += act[j] * wd[(size_t)j * D + c]; ck_cmp(bf2f(Y[(size_t)p * D + c]), a, 0.03f, 0.03f, cnt + 5); }
    }
}

__global__ void ck_attn(const bf16* PA, const float* sink, const bf16* YA, unsigned* cnt) {
    const int m = ck_row(blockIdx.x), b = m / SEQ, t = m % SEQ; __shared__ float sc[512]; __shared__ float red[256];
    for (int qh = 0; qh < NQH; ++qh) { const int kvh = qh / 4;
        const bf16* qp = PA + (size_t)m * NPA + C_QA + 64 * qh;
        for (int jj = threadIdx.x; jj < 2 * WINDOW + 1; jj += 256) { const int j = t - WINDOW + jj; float a = -1e30f;
            if (j >= 0 && j < SEQ) { a = 0.f; const bf16* kp = PA + (size_t)(b * SEQ + j) * NPA + C_KA + 64 * kvh; for (int d = 0; d < 64; ++d) a += bf2f(qp[d]) * bf2f(kp[d]); a *= 0.6931471805599453f; }
            sc[jj] = a; }
        __syncthreads();
        float mx = sink[qh]; for (int jj = 0; jj < 2 * WINDOW + 1; ++jj) mx = fmaxf(mx, sc[jj]);
        float den = expf(sink[qh] - mx); for (int jj = 0; jj < 2 * WINDOW + 1; ++jj) den += expf(sc[jj] - mx);
        if (threadIdx.x < 64) { const int d = threadIdx.x; float o = 0.f; for (int jj = 0; jj < 2 * WINDOW + 1; ++jj) { const int j = t - WINDOW + jj; if (j >= 0 && j < SEQ) o += expf(sc[jj] - mx) * bf2f(PA[(size_t)(b * SEQ + j) * NPA + C_VA + 64 * kvh + d]); }
            ck_cmp(bf2f(YA[(size_t)m * 512 + 64 * qh + d]), o / den, 0.03f, 0.005f, cnt); }
        __syncthreads(); }
}
__global__ void ck_hgrn(const bf16* PA, const float* hng, const bf16* YH, const float* ssq, unsigned* cnt) {
    const int m = ck_row(blockIdx.x), b = m / SEQ, t = m % SEQ, h = blockIdx.y; __shared__ float wgt[128]; __shared__ float osum[128]; __shared__ float cum[128];
    const int e = threadIdx.x;
    float o = 0.f;
    for (int dir = 0; dir < 2; ++dir) { cum[e] = 0.f; __syncthreads();
        for (int n = 0; n < 768; ++n) { const int s = dir ? t + n : t - n; if (s < 0 || s >= SEQ) break;
            const bf16* row = PA + (size_t)(b * SEQ + s) * NPA; const bf16* rowt = PA + (size_t)m * NPA;
            { const int d = e; const float lf = (float)((const _Float16*)(row + (dir ? C_LB : C_LF) + 128 * h))[d];
              wgt[d] = bf2f(rowt[C_QH + 128 * h + d]) * (-expm1f(lf)) * expf(cum[d]);
#if defined(HC_DBG) && HC_DBG >= 3
              wgt[d] = bf2f(rowt[C_QH + 128 * h + d]) * (-expm1f(lf));
              if (HC_DBG == 4) wgt[d] = (d == 0) ? bf2f(rowt[C_QH + 128 * h]) : 0.f;
              if (HC_DBG == 5 || HC_DBG == 7) wgt[d] = (d == 0) ? wgt[d] : 0.f;
              if (HC_DBG == 10) wgt[d] = (d == 0) ? (float)(s & 15) : 0.f;
              if (HC_DBG == 11) wgt[d] = (d == 0) ? (float)(t & 15) : 0.f;
              if (HC_DBG == 8 || HC_DBG == 9) wgt[d] = (d == 0) ? bf2f(rowt[C_QH + 128 * h]) * (float)(s & 15) : 0.f;
              if (HC_DBG == 6) wgt[d] = (d == 0) ? bf2f(rowt[C_QH + 128 * h]) * lf : 0.f;
#endif
            }
            __syncthreads();
            float w = 0.f; for (int d = 0; d < 128; ++d) w += wgt[d];
#if defined(HC_TERMS)
            { const int cls = ((s >> 4) == (t >> 4)) ? 1 : (((s >> 7) == (t >> 7)) ? 2 : 4); if (!(HC_TERMS & cls)) w = 0.f; }
#endif
            o += w * bf2f(row[C_VH + 128 * h + e]);
            __syncthreads();
            { const int d = e; cum[d] += (float)((const _Float16*)(row + (dir ? C_LB : C_LF) + 128 * h))[d]; }
            __syncthreads(); } }
#if defined(HC_DBG) && HC_DBG == 1
    o = bf2f(PA[(size_t)m * NPA + C_VH + 128 * h + e]);
#endif
    osum[e] = o * o; __syncthreads(); for (int k = 64; k > 0; k >>= 1) { if (e < k) osum[e] += osum[e + k]; __syncthreads(); }
    if (e == 0) ck_cmp(ssq[m * 4 + h], osum[0], 0.03f, 1e-3f, cnt + 1);
    const float sg = bf2f(PA[(size_t)m * NPA + C_SG + 128 * h + e]);
    ck_cmp(bf2f(YH[(size_t)m * 512 + 128 * h + e]), o * hng[128 * h + e] * sg, 0.03f, 0.01f, cnt + 0);
}
__global__ void ck_comb(const float* xold, const float* xnew, const int* tok_p, const float* tok_w, const bf16* Y, const float* gfin, int last, unsigned* cnt) {
    const int m = ck_row(blockIdx.x); __shared__ float red[256]; __shared__ float xv[D];
    if (m >= SEQ) return;
    const int p1 = tok_p[2 * m], p2 = tok_p[2 * m + 1]; const float w1 = tok_w[2 * m], w2 = tok_w[2 * m + 1]; float s = 0.f;
    for (int c = threadIdx.x; c < D; c += 256) { const float v = xold[(size_t)m * D + c] + w1 * bf2f(Y[(size_t)p1 * D + c]) + w2 * bf2f(Y[(size_t)p2 * D + c]); xv[c] = v; s += v * v; }
    red[threadIdx.x] = s; __syncthreads(); for (int o = 128; o > 0; o >>= 1) { if (threadIdx.x < o) red[threadIdx.x] += red[threadIdx.x + o]; __syncthreads(); }
    const float rstd = 1.0f / sqrtf(red[0] / D + NORM_EPS);
    for (int c = threadIdx.x; c < D; c += 256) ck_cmp(xnew[(size_t)m * D + c], last ? xv[c] * rstd * gfin[c] : xv[c], 0.005f, 0.005f, cnt);
}

__global__ void ck_gates_full(const bf16* XN, const float* w_in, const bf16* GT, unsigned* st) {
    const int m = blockIdx.x >> 3, pn = blockIdx.x & 7, c = pn * 256 + threadIdx.x; __shared__ float xr[D];
    for (int k = threadIdx.x; k < D; k += 256) xr[k] = bf2f(XN[(size_t)m * D + k]);
    __syncthreads();
    float a = 0.f; for (int k = 0; k < D; ++k) a += xr[k] * w_in[(size_t)k * INW + NPA + c];
#if defined(CK_PLAIN)
    const float ref = a, got = bf2f(GT[(size_t)m * NGATE + c]);
#else
    const float ref = 1.f / (1.f + expf(-a)), got = bf2f(GT[(size_t)m * NGATE + c]);
#endif
    if (m == 8122 && !(fabsf(got - ref) <= 0.05f)) atomicMin(st + 700, (unsigned)c);
    if (m == 8123 && !(fabsf(got - ref) <= 0.05f)) atomicMin(st + 701, (unsigned)c);
    if (m == 8122) { if (c == 130) st[702] = __float_as_uint(got), st[703] = __float_as_uint(ref), st[704] = __float_as_uint(a); if (c == 131) st[705] = __float_as_uint(got), st[706] = __float_as_uint(ref); }
    if (!(fabsf(got - ref) <= 0.05f)) { atomicAdd(st + (m >> 8), 1u); atomicAdd(st + 128 + (m & 255), 1u); atomicAdd(st + 384 + threadIdx.x, 1u); atomicAdd(st + 640 + pn, 1u); }
}
__global__ void ck_flush() { asm volatile("buffer_wbl2 sc0 sc1\n\ts_waitcnt vmcnt(0)\n\tbuffer_inv sc0 sc1\n\ts_waitcnt vmcnt(0)" ::: "memory"); }

__global__ void ck_ha(const bf16* PA, const bf16* US, const float* HD, unsigned* cnt) {
    const int sidx = blockIdx.x, bh = sidx % 8, dir = (sidx >> 3) & 1, n = (sidx * 37 + 5) % NCH, b = bh >> 2, h = bh & 3, d = threadIdx.x, t0 = n * CH;
    __shared__ float kts[CH][128]; float cum = 0.f;
    for (int k = CH - 1; k >= 0; --k) { const int tok = dir ? (t0 + CH - 1 - k) : (t0 + k);
        const float lf = (float)((const _Float16*)(PA + (size_t)(b * SEQ + tok) * NPA + (dir ? C_LB : C_LF) + 128 * h))[d];
        kts[k][d] = -expm1f(lf) * expf(cum); cum += lf; }
    ck_cmp(HD[((size_t)(bh * 2 + dir) * NCH + n) * 128 + d], expf(cum), 0.01f, 1e-6f, cnt + 1);
    for (int e = 0; e < 128; e += 5) { float u = 0.f;
        for (int k = 0; k < CH; ++k) { const int tok = dir ? (t0 + CH - 1 - k) : (t0 + k); u += kts[k][d] * bf2f(PA[(size_t)(b * SEQ + tok) * NPA + C_VH + 128 * h + e]); }
        ck_cmp(bf2f(US[(((size_t)(bh * 2 + dir) * NCH + n) * 128 + e) * 128 + d]), u, 0.03f, 0.01f, cnt + 0); }
}
__global__ void ck_hb(const bf16* PA, const bf16* US, unsigned* cnt) {
    const int sidx = blockIdx.x, bh = sidx % 8, dir = (sidx >> 3) & 1, n = (sidx * 37 + 5) % NCH, b = bh >> 2, h = bh & 3, d = threadIdx.x, e = (sidx * 11 + 3) % 128;
    float cum = 0.f, sacc = 0.f;
    for (int k = 0; k < 1024; ++k) { const int tok = dir ? ((n + 1) * CH + k) : (n * CH - 1 - k); if (tok < 0 || tok >= SEQ) break;
        const bf16* row = PA + (size_t)(b * SEQ + tok) * NPA; const float lf = (float)((const _Float16*)(row + (dir ? C_LB : C_LF) + 128 * h))[d];
        sacc += -expm1f(lf) * expf(cum) * bf2f(row[C_VH + 128 * h + e]); cum += lf; }
    ck_cmp(bf2f(US[(((size_t)(bh * 2 + dir) * NCH + n) * 128 + e) * 128 + d]), sacc, 0.03f, 0.01f, cnt);
}

__global__ void ck_mfma(unsigned* cnt) {
#if defined(__HIP_DEVICE_COMPILE__)
    const int lane = threadIdx.x, fr = lane & 15, g = lane >> 4;
    float av[8], bv[8];
    for (int j = 0; j < 8; ++j) { const int k = 8 * g + j; av[j] = (k == 0) ? (float)fr : ((k == 9) ? (float)(fr * fr) : 0.f); bv[j] = (k == 0) ? (float)(fr + 1) : ((k == 9) ? 0.5f : 0.f); }
    f32x4 d = (f32x4){0.f, 0.f, 0.f, 0.f};
    d = mfma16(pack_frag(av), pack_frag(bv), d);
    for (int r = 0; r < 4; ++r) { const int s = 4 * g + r, c = fr; const float ref = (float)s * (float)(c + 1) + (float)(s * s) * 0.5f; if (fabsf(d[r] - ref) > 0.01f * fabsf(ref) + 0.01f) atomicAdd(cnt, 1u); }
#endif
}
#ifndef CK_SKIP
#define CK_SKIP 0ull
#endif
__global__ void ck_report(const unsigned* cnt, int n, float* out) { if (threadIdx.x == 0 && blockIdx.x == 0) {
#if defined(CK_DBG7)
    const unsigned* dbg = cnt + 7 + 100; int nrows = 0, ngrp = 0; unsigned mx = 0, first = 99; for (int i = 0; i < CK_NS; ++i) if (dbg[i]) { ++nrows; mx = dbg[i] > mx ? dbg[i] : mx; } for (int i = 0; i < 64; ++i) if (dbg[64 + i]) { ++ngrp; if (first == 99) first = i; }
    if (CK_DBG7 == 4) { const float me = __uint_as_float(dbg[200]), ma = __uint_as_float(dbg[201]); out[0] = (1.0f + fminf(me, 0.89f) * 10.0f) * powf(10.0f, 5.0f + floorf(fminf(ma, 30.0f))); return; }
    if (CK_DBG7 == 5) { int nl = 0; unsigned mxl = 0; for (int i = 0; i < 32; ++i) if (dbg[300 + i]) { ++nl; mxl = dbg[300 + i] > mxl ? dbg[300 + i] : mxl; } out[0] = (1.0f + 0.1f * (float)nl) * powf(10.0f, 5.0f + (float)(mxl > 30 ? 30 : mxl)); return; }
    if (CK_DBG7 == 7) { out[0] = (1.0f + 0.01f * (float)(dbg[203] % 100)) * powf(10.0f, 5.0f + (float)(dbg[203] / 100)); return; }
    if (CK_DBG7 >= 10) { const unsigned* st = cnt + 512; int npan = 0, nrit = 0, ncol = 0, ntile = 0; unsigned tot = 0, mxp = 0; int firstp = -1, firstr = -1, firstc = -1;
        for (int i = 0; i < 128; ++i) if (st[i]) { ++npan; tot += st[i]; if (st[i] > mxp) mxp = st[i]; if (firstp < 0) firstp = i; }
        for (int i = 0; i < 256; ++i) { if (st[128 + i]) { ++nrit; if (firstr < 0) firstr = i; } if (st[384 + i]) { ++ncol; if (firstc < 0) firstc = i; } }
        for (int i = 0; i < 8; ++i) if (st[640 + i]) ++ntile;
        float a = 0.f, b = 0.f;
        if (CK_DBG7 == 10) { a = (float)npan; b = log10f((float)(tot ? tot : 1)) * 4.0f; }
        if (CK_DBG7 == 11) { a = (float)nrit; b = (float)ncol / 10.0f; }
        if (CK_DBG7 == 12) { a = (float)firstp; b = (float)firstr / 10.0f; }
        if (CK_DBG7 == 13) { a = (float)firstc; b = (float)ntile; }
        if (CK_DBG7 == 22) { out[0] = (1.0f + 8.0f * __uint_as_float(st[702])) * powf(10.0f, 5.0f + floorf(20.0f * __uint_as_float(st[703]) + 0.5f)); return; }
        if (CK_DBG7 == 23) { out[0] = (1.0f + 8.0f * __uint_as_float(st[705])) * powf(10.0f, 5.0f + floorf(20.0f * __uint_as_float(st[706]) + 0.5f)); return; }
        if (CK_DBG7 == 20) { a = (float)(st[700] % 100); b = (float)(st[700] / 100); }
        if (CK_DBG7 == 21) { a = (float)(st[701] > 5000 ? 99 : st[701] % 100); b = (float)(st[701] > 5000 ? 30 : st[701] / 100); }
        out[0] = (1.0f + 0.01f * a) * powf(10.0f, 5.0f + floorf(b)); return; }
    if (CK_DBG7 == 6) { out[0] = (1.0f + 0.01f * (float)(dbg[202] % 100)) * powf(10.0f, 5.0f + (float)(dbg[202] / 100)); return; }
    if (CK_DBG7 == 3) { int s1 = -1, s2 = -1; for (int i = 0; i < CK_NS; ++i) if (dbg[i] > 20) { if (s1 < 0) s1 = i; else if (s2 < 0) s2 = i; } out[0] = (1.0f + 0.1f * (float)(s1 < 0 ? 0 : s1 % 50)) * powf(10.0f, (float)(5 + (s2 < 0 ? 0 : (s2 % 25)))); return; }
    if (CK_DBG7 == 1) out[0] = (1.0f + 0.1f * (float)first) * powf(10.0f, (float)(5 + nrows / 2));
    else out[0] = (1.0f + 0.1f * (float)ngrp) * powf(10.0f, (float)(5 + (int)floorf(4.0f * log10f((float)(mx ? mx : 1)))));
    return;
#endif
    for (int i = 0; i < n; ++i) if (cnt[i] && !((CK_SKIP >> i) & 1ull)) {
    out[0] = (1.0f + 0.1f * (float)(i % 10)) * powf(10.0f, (float)(5 + i / 10)); return; } } }
#endif

#ifndef PG8_SP2
#define PG8_SP2 true
#endif
#ifndef PG8_ALIGN
#define PG8_ALIGN true
#endif
__global__ void __launch_bounds__(NWAVES * 64, 2) mega_fwd(Args args) {
    extern __shared__ __attribute__((aligned(16))) unsigned char lds[];
    Frame F;
    F.lds = (LAS unsigned char*)lds;
    F.MISC = (volatile LAS unsigned*)(F.lds + MISC_OFF);
    F.tid = threadIdx.x; F.lane = F.tid & 63; F.wave = __builtin_amdgcn_readfirstlane(F.tid >> 6);
    F.G = gridDim.x; { const int bx = blockIdx.x; F.vcu = (F.G % 8 == 0) ? (bx % 8) * (F.G / 8) + bx / 8 : bx; }
    F.ws = args.ws; F.ctl = (gu32*)(args.ws + WS_CTL); F.out = args.out;
    const Args& A = args;
    for (int u = F.tid; u < (LDS_BYTES - LDSCTL_OFF) / 4; u += NWAVES * 64) ((LAS unsigned*)(F.lds + LDSCTL_OFF))[u] = 0u;
    __syncthreads();
    XcdBarrier bar = xcd_barrier_post((unsigned*)(F.ctl + CW_BAR) + args.li * XCD_BAR_WORDS, F.MISC + 8);
    const int lo = args.ph_lo, hi = args.ph_hi;
#ifndef PHMASK
#define PHMASK 0xffff
#endif
#define IN(k) (((PHMASK >> ((k) & 15)) & 1) && lo <= (k) && (k) < hi)
#if defined(PROBE_MASK)
    unsigned long long pr_acc = 0ull, pr_t0 = 0ull;
#define PR_BEGIN(k) do { if ((PROBE_MASK >> ((k) & 15)) & 1) pr_t0 = wall_clock64(); } while (0)
#define PR_END(k) do { if ((PROBE_MASK >> ((k) & 15)) & 1) pr_acc += wall_clock64() - pr_t0; } while (0)
#else
#define PR_BEGIN(k)
#define PR_END(k)
#endif
#define SEAM(k) do { if ((k) + 1 < hi) xcd_barrier(bar); PR_END(k); } while (0)
#define WSP() GAS unsigned char* wsg_ = (GAS unsigned char*)args.ws; asm volatile("" : "+s"(wsg_)); unsigned char* ws = (unsigned char*)wsg_; F.ws = ws; { int t_ = threadIdx.x; asm volatile("" : "+v"(t_)); F.tid = t_; F.lane = t_ & 63; F.wave = __builtin_amdgcn_readfirstlane(t_ >> 6); int g_ = gridDim.x, b_ = blockIdx.x; asm volatile("" : "+s"(g_), "+s"(b_)); F.G = g_; F.vcu = (g_ % 8 == 0) ? (b_ % 8) * (g_ / 8) + b_ / 8 : b_; cid = b_; } \
    bf16* XN = (bf16*)(ws + WS_XN); bf16* PA = (bf16*)(ws + WS_PA); bf16* GT = (bf16*)(ws + WS_PA); bf16* MG = (bf16*)(ws + WS_US); \
    bf16* YA = (bf16*)(ws + WS_Y); bf16* YH = (bf16*)(ws + WS_YH); (void)XN; (void)PA; (void)GT; (void)MG; (void)YA; (void)YH;
    int cid = (int)blockIdx.x;

#if !defined(ORACLE) || defined(ORACLE_FAST)
#if XBF16
#define XB_CUR(l) ((l) == 0 ? (NORMFOLD ? (void*)XN : (void*)A.in[I_X]) : (void*)F.out)
#define XB_NEW(l) ((l) == DEPTH - 1 ? (bf16*)(ws + WS_Y) : (bf16*)F.out)
#define XIN0(l) ((const void*)XB_CUR(l))
#define EPIOUT_T(l) EpiOutB<(l) == 0 && !NORMFOLD>
#else
#define XB_CUR(l) ((void*)F.out)
#define XB_NEW(l) (F.out)
#define XIN0(l) ((l) == 0 ? A.in[I_X] : (const float*)F.out)
#define EPIOUT_T(l) EpiOut
#endif
#if NORMFOLD
#define G1_A(l) ((l) == 0 ? XN : (const bf16*)F.out)
#define M1_A(l) ((const bf16*)XB_NEW(l))
#else
#define G1_A(l) XN
#define M1_A(l) XN
#endif
#define XCOPY0 nullptr
#else
#define XCOPY0 F.out
#define XIN0(l) ((const float*)F.out)
#endif
    if (IN(0)) { WSP(); PR_BEGIN(0);
        make_tables(F, A); conv_weights(F, A, 0);
#if NORM4 && !NORMFOLD
        norm_rows4(F, A.in[I_X], A.in[I_ANG], XN);
#else
        norm_rows(F, A.in[I_X], XCOPY0, A.in[I_ANG], XN, NORMFOLD ? (float*)(ws + WS_RSA) : nullptr);
#endif
        SEAM(0);
    }
#if G1A_SPLIT
#define PHASE3(l) if (IN(pb + 3)) { WSP(); PR_BEGIN(pb + 3);   \
            const int gh = G1A_SPLIT ? F.G / 2 : 0; \
            if (cid < gh) { pg8::Gemm g{XN, (const bf16*)(ws + WS_WIN) + (size_t)G1A_N * D, T, NPA - G1A_N, D}; pg8::StaticOrder S; S.init(T, NPA - G1A_N, gh, cid); \
                EpiInA E{PA, (const float*)(ws + WS_COS), (const float*)(ws + WS_SIN), (const float*)(ws + WS_LBT) + l * 2048, G1A_N / 256, (const float*)(ws + WS_RSA)}; \
                pg8::gemm_phase<EpiInA, pg8::StaticOrder, PG8_ALIGN, PG8_SP2>(F.lds + RING_OFF, g, S, E); } \
            else phase_hb(F, cid - gh, F.G - gh); \
            SEAM(pb + 3); }
#else
#define PHASE3(l) if (IN(pb + 3)) { WSP(); PR_BEGIN(pb + 3); phase_hb(F, F.vcu, F.G); SEAM(pb + 3); }
#endif
#if !defined(ORACLE) || defined(ORACLE_FAST)
#define G1A_N (NPA - 256 * G1A_SPLIT)
#define FAST_PHASES(l)         if (IN(pb + 2)) { WSP(); PR_BEGIN(pb + 2); PR_BEGIN(14); phase_attn(F, A.in[I_SINK] + (l) * NQH); PR_END(14); PR_BEGIN(15); phase_ha(F); PR_END(15); SEAM(pb + 2); } \
        PHASE3(l) \
        if (IN(pb + 4)) { WSP(); PR_BEGIN(pb + 4); phase_hc(F, A.in[I_HNG] + (l) * 512); SEAM(pb + 4); }
#else
#define G1A_N NPA
#define FAST_PHASES(l)
#endif
#if MOE_HANDOFF
#define MOE_ORDER1 pg8::ProducerOrder
#define MOE_ORDER2 pg8::ConsumerOrder
#define MOE_CNT(l) S.cnt = (unsigned*)(F.ctl + CW_MOE + (l) * MOE_BANK + 64);
#define MOE_SEAM(k) PR_END(k)
#else
#define MOE_ORDER1 pg8::GroupedOrder
#define MOE_ORDER2 pg8::GroupedOrder
#define MOE_CNT(l)
#define MOE_SEAM(k) SEAM(k)
#endif
#if ROUTE_MFMA
#define ROUTE_FN phase_route_mfma
#elif ROUTE4
#define ROUTE_FN phase_norm_route4
#else
#define ROUTE_FN phase_norm_route
#endif
#if defined(PROBE_BARRIERS)
#define PROBE_BARRIERS_EXTRA for (int k_ = 0; k_ < PROBE_BARRIERS; ++k_) xcd_barrier(bar);
#else
#define PROBE_BARRIERS_EXTRA
#endif
#if defined(PROBE_KLOOP)
#define PROBE_KLOOP_EXTRA { EpiNull E2{GT}; pg8::gemm_phase<EpiNull, pg8::StaticOrder, PG8_ALIGN, PG8_SP2>(F.lds + RING_OFF, g, S, E2); }
#else
#define PROBE_KLOOP_EXTRA
#endif
#define LAYER_BODY(l) { const int pb = 16 * (l); \
        if (IN(pb + 1)) { WSP(); PR_BEGIN(pb + 1); \
            const int cw = conv_wgs(F.G, (T / 256) * (G1A_N / 256), CONV_WGS), gg = F.G - cw;     \
            if (cid < gg) { pg8::Gemm g{G1_A(l), (const bf16*)(ws + WS_WIN), T, G1A_N, D}; pg8::StaticOrder S; S.init(T, G1A_N, gg, cid); \
                EpiInA E{PA, (const float*)(ws + WS_COS), (const float*)(ws + WS_SIN), (const float*)(ws + WS_LBT) + l * 2048, 0, (const float*)(ws + WS_RSA)}; \
                pg8::gemm_phase<EpiInA, pg8::StaticOrder, PG8_ALIGN, PG8_SP2>(F.lds + RING_OFF, g, S, E); } \
            if (EXPERTS_BY_QUEUE) { const int n1 = NEXP * 16 * 32, h0 = __builtin_amdgcn_readfirstlane((int)VLD(F.ctl + CW_H12)), h1 = min(n1, h0 + cw * (h0 ? CONV_PER_WG1 - 64 : CONV_PER_WG1));     \
                if (cid >= gg) conv_experts_range(F, A, l, h0, h1, (cid - gg) * NWAVES + F.wave, cw * NWAVES); \
                if (cw == 0) conv_experts_range(F, A, l, h1, n1, F.vcu * NWAVES + F.wave, F.G * NWAVES); \
                else if (cid < gg) conv_experts_range(F, A, l, h1, n1, cid * NWAVES + F.wave, gg * NWAVES); }   \
            SEAM(pb + 1); \
        } \
FAST_PHASES(l) \
        if (IN(pb + 5)) { WSP(); PR_BEGIN(pb + 5); \
            pg8::Gemm g{G1_A(l), (const bf16*)(ws + WS_WIN) + (size_t)NPA * D, T, NGATE, D}; pg8::StaticOrder S; S.init(T, NGATE, F.G, cid); \
            EpiGate E{GT, (const float*)(ws + WS_RSA)}; \
            pg8::gemm_phase<EpiGate, pg8::StaticOrder, PG8_ALIGN, PG8_SP2>(F.lds + RING_OFF, g, S, E); \
            PROBE_KLOOP_EXTRA \
            SEAM(pb + 5); \
        } \
        if (IN(pb + 6)) { WSP(); PR_BEGIN(pb + 6); \
            pg8::Gemm g{YA, (const bf16*)(ws + WS_WUA), T, D, 512}; pg8::StaticOrder S; S.init(T, D, F.G, cid); \
            EpiUpA E{MG, GT}; \
            pg8::gemm_phase<EpiUpA, pg8::StaticOrder, PG8_ALIGN, PG8_SP2>(F.lds + RING_OFF, g, S, E); \
            PR_END(pb + 6);   \
        } \
        if (IN(pb + 7)) { WSP(); PR_BEGIN(pb + 7); \
            pg8::Gemm g{YH, (const bf16*)(ws + WS_WUH), T, D, 512}; pg8::StaticOrder S; S.init(T, D, F.G, cid); \
            EpiUpB E{MG, GT, (const float*)(ws + WS_SSQ)}; \
            pg8::gemm_phase<EpiUpB, pg8::StaticOrder, PG8_ALIGN, PG8_SP2>(F.lds + RING_OFF, g, S, E); \
            SEAM(pb + 7); \
        } \
        if (IN(pb + 8)) { WSP(); PR_BEGIN(pb + 8); \
            pg8::Gemm g{MG, (const bf16*)(ws + WS_WOUT), T, D, D}; pg8::StaticOrder S; S.init(T, D, F.G, cid); \
            EPIOUT_T(l) E{XB_NEW(l), XIN0(l)}; \
            pg8::gemm_phase<EPIOUT_T(l), pg8::StaticOrder, PG8_ALIGN, PG8_SP2>(F.lds + RING_OFF, g, S, E); \
            SEAM(pb + 8); \
        } \
        if (IN(pb + 9)) { WSP(); PR_BEGIN(pb + 9); ROUTE_FN(F, A, l, XB_NEW(l)); SEAM(pb + 9); } \
        if (IN(pb + 10)) { WSP(); PR_BEGIN(pb + 10); phase_dispatch(F); PROBE_BARRIERS_EXTRA SEAM(pb + 10); } \
        if (IN(pb + 11)) { WSP(); PR_BEGIN(pb + 11); \
            const int cw = MOE_HANDOFF ? 0 : conv_wgs(F.G, 4 * __builtin_amdgcn_readfirstlane((int)VLD((const int*)(ws + WS_META))), CONV_WGS_MOE), gg = F.G - cw;     \
            if (cid < gg) { pg8::Gemm g{M1_A(l), (const bf16*)(ws + WS_W1), SLOT_ROWS, D, D}; MOE_ORDER1 S; S.init((const int*)(ws + WS_META), D, gg, cid); MOE_CNT(l) \
                EpiAct E{(bf16*)(ws + WS_ACT), (const float*)(ws + WS_RSS)}; \
                pg8::gemm_phase<EpiAct, MOE_ORDER1, PG8_ALIGN, PG8_SP2, true>(F.lds + RING_OFF, g, S, E, (const int*)(ws + WS_STOK)); } \
            if (EXPERTS_BY_QUEUE) { const int n1 = NEXP * 16 * 32, n2 = NEXP * 8 * 32, h2 = min(n2, cw * CONV_PER_WG2); \
                if (cid >= gg) conv_experts_range(F, A, l, n1, n1 + h2, (cid - gg) * NWAVES + F.wave, cw * NWAVES); \
                conv_experts_range(F, A, l, n1 + h2, n1 + n2, F.vcu * NWAVES + F.wave, F.G * NWAVES); } \
            MOE_SEAM(pb + 11); \
        } \
        if (IN(pb + 12)) { WSP(); PR_BEGIN(pb + 12); \
            const int cw = (MOE_HANDOFF || !EXPERTS_BY_QUEUE || (l) == DEPTH - 1) ? 0 : conv_wgs(F.G, 4 * __builtin_amdgcn_readfirstlane((int)VLD((const int*)(ws + WS_META))), CONV_WGS_MOE), gg = F.G - cw;     \
            if (cid < gg) { pg8::Gemm g{(const bf16*)(ws + WS_ACT), (const bf16*)(ws + WS_W2), SLOT_ROWS, D, DEXP}; MOE_ORDER2 S; S.init((const int*)(ws + WS_META), D, gg, cid, MOE_HANDOFF != 0); MOE_CNT(l) \
                EpiY E{(bf16*)(ws + WS_XP)}; \
                pg8::gemm_phase<EpiY, MOE_ORDER2, PG8_ALIGN, PG8_SP2, false, MOE_HANDOFF ? 16 : 0>(F.lds + RING_OFF, g, S, E); } \
            else conv_experts_range(F, A, (l) + 1, 0, cw * CONV_PER_WG12, (cid - gg) * NWAVES + F.wave, cw * NWAVES); \
            if (cw > 0 && cid == 0 && F.tid == 0) __hip_atomic_store(F.ctl + CW_H12, (unsigned)(cw * CONV_PER_WG12), __ATOMIC_RELAXED, __HIP_MEMORY_SCOPE_AGENT);     \
            SEAM(pb + 12); \
        } \
        if (IN(pb + 13)) { WSP(); PR_BEGIN(pb + 13); \
            const bool last = (l == DEPTH - 1); \
            if (!last) conv_weights(F, A, l + 1); \
            phase_combine(F, last ? A.in[I_FING] : A.in[I_ANG] + (size_t)(l + 1) * D, last, XB_NEW(l), XB_CUR((l) + 1)); \
            if (!last) { if ((pb + 15) + 1 < hi) xcd_barrier(bar); } PR_END(pb + 13); \
        } \
    }
    LAYER_BODY(0)
    LAYER_BODY(1)
    static_assert(DEPTH == 2, "layer bodies are written out");
#if defined(PROBE_MASK)
    if (blockIdx.x == 0 && threadIdx.x == 0) { const unsigned long long t1 = wall_clock64(), want = (unsigned long long)PROBE_MULT * pr_acc; while (wall_clock64() - t1 < want) __builtin_amdgcn_s_sleep(8); }
#endif
#undef IN
#undef SEAM
}

extern "C" void kernel_launch(void* const* d_in, const int* in_sizes, int n_in, void* d_out, int out_size, void* d_ws, size_t ws_size, hipStream_t stream) {
    static int grid = 0;
    if (grid == 0) {
        if (n_in != 18 || in_sizes[0] != T * D || out_size != T * D || ws_size < WS_END) { fprintf(stderr, "kernel_launch: unexpected shapes (n_in %d, in0 %d, out %d, ws %zu); nothing launched\n", n_in, n_in > 0 ? in_sizes[0] : -1, out_size, ws_size); grid = -1; return; }
        int dev = 0, cus = 0, per_cu = 0;
        if (hipGetDevice(&dev) != hipSuccess || hipDeviceGetAttribute(&cus, hipDeviceAttributeMultiprocessorCount, dev) != hipSuccess) { grid = -1; return; }
        if (hipFuncSetAttribute((const void*)mega_fwd, hipFuncAttributeMaxDynamicSharedMemorySize, LDS_BYTES) != hipSuccess) { fprintf(stderr, "kernel_launch: hipFuncSetAttribute failed\n"); grid = -1; return; }
        if (hipOccupancyMaxActiveBlocksPerMultiprocessor(&per_cu, (const void*)mega_fwd, NWAVES * 64, LDS_BYTES) != hipSuccess || per_cu < 1)
            fprintf(stderr, "kernel_launch: note: occupancy query reports %d workgroups per CU\n", per_cu);
        (void)hipGetLastError();
        grid = cus;
    }
    if (grid < 0) return;
    if (hipMemsetAsync((char*)d_ws + WS_CTL, 0, CTL_ZERO_BYTES, stream) != hipSuccess) return;
    Args a{};
    for (int i = 0; i < 18; ++i) a.in[i] = (const float*)d_in[i];
    a.out = (float*)d_out; a.ws = (unsigned char*)d_ws; a.pad = 0;
    int li = 0;
    auto launch = [&](int lo, int hi) { a.ph_lo = lo; a.ph_hi = hi; a.li = li++; hipLaunchKernelGGL(mega_fwd, dim3(grid), dim3(NWAVES * 64), LDS_BYTES, stream, a);
        const hipError_t le = hipPeekAtLastError(); if (le != hipSuccess) fprintf(stderr, "kernel_launch: launch [%d,%d) failed: %s\n", lo, hi, hipGetErrorName(le)); };
#if defined(ORACLE)
    unsigned char* ws = (unsigned char*)d_ws;
#if defined(CHECK)
    unsigned* cnt = (unsigned*)(ws + 525 * MiB + 512 * 1024); hipMemsetAsync(cnt, 0, 4096, stream);
    hipLaunchKernelGGL(ck_mfma, dim3(1), dim3(64), 0, stream, cnt + 39); hipMemsetAsync(cnt + 512 + 700, 0xFF, 8, stream);
    const float* const* in = (const float* const*)d_in; float* xs = (float*)d_out;
    const bf16* XNc = (const bf16*)(ws + WS_XN); const bf16* PAc = (const bf16*)(ws + WS_PA); const bf16* MGc = (const bf16*)(ws + WS_US);
    const bf16* YAc = (const bf16*)(ws + WS_Y); const bf16* YHc = (const bf16*)(ws + WS_YH); const float* ssqc = (const float*)(ws + WS_SSQ);
#define CKL(k, ...) hipLaunchKernelGGL(k, dim3(CK_NS), dim3(256), 0, stream, __VA_ARGS__)
#endif
    for (int l = 0; l < DEPTH; ++l) {
#if defined(CHECK)
        const float* w_in_l = in[I_WIN] + (size_t)l * D * INW; unsigned* c0 = cnt + 20 * l;
        if (l == 0) { launch(0, 1); CKL(ck_norm, in[I_X], in[I_ANG], XNc, c0 + 0); launch(1, 2); }
        else { CKL(ck_norm, (const float*)xs, in[I_ANG] + (size_t)l * D, XNc, c0 + 0); launch(16 * l + 1, 16 * l + 2); }
        CKL(ck_pa, XNc, w_in_l, in[I_LBT], l, PAc, c0 + 1);
#else
        if (l == 0) launch(0, 2); else launch(16 * l + 1, 16 * l + 2);
#endif
#if defined(ORACLE_FAST)
        launch(16 * l + 2, 16 * l + 3);
#if defined(CHECK)
        hipLaunchKernelGGL(ck_ha, dim3(CK_NS), dim3(128), 0, stream, (const bf16*)(ws + WS_PA), (const bf16*)(ws + WS_US), (const float*)(ws + WS_HD), cnt + 20 * l + 40 + 0);
#endif
        launch(16 * l + 3, 16 * l + 4);
#if defined(CHECK)
        hipLaunchKernelGGL(ck_hb, dim3(CK_NS), dim3(128), 0, stream, (const bf16*)(ws + WS_PA), (const bf16*)(ws + WS_US), cnt + 20 * l + 40 + 2);
#endif
        launch(16 * l + 4, 16 * l + 5);
#else
        hipLaunchKernelGGL(zero_f32, dim3(T * 4 / 256), dim3(256), 0, stream, (float*)(ws + WS_SSQ), T * 4);
        hipLaunchKernelGGL(simple_attn, dim3(T * 8 / 4), dim3(256), 0, stream, (const bf16*)(ws + WS_PA), (const float*)d_in[I_SINK] + l * NQH, (bf16*)(ws + WS_Y));
        hipLaunchKernelGGL(simple_hgrn, dim3(8), dim3(512), 0, stream, (const bf16*)(ws + WS_PA), (const float*)d_in[I_HNG] + l * 512, (float*)(ws + WS_US), (bf16*)(ws + WS_YH), (float*)(ws + WS_SSQ));
#endif
#if defined(CHECK)
        CKL(ck_attn, PAc, in[I_SINK] + l * NQH, YAc, c0 + 3 + 40); hipLaunchKernelGGL(ck_hgrn, dim3(CK_NS, 4), dim3(128), 0, stream, PAc, in[I_HNG] + l * 512, YHc, ssqc, c0 + 4 + 40);
        const float* wua = in[I_WUA] + (size_t)l * 512 * D; const float* wuh = in[I_WUH] + (size_t)l * 512 * D; const int pb = 16 * l;
#if defined(CK_SENTINEL)
        hipMemsetAsync(ws + WS_PA, 0xFF, (size_t)T * NGATE * 2, stream);
#endif
#if defined(CK_FLUSH)
        hipLaunchKernelGGL(ck_flush, dim3(4096), dim3(64), 0, stream);
#endif
        launch(pb + 5, pb + 6);
#if defined(CK_FLUSH)
        hipLaunchKernelGGL(ck_flush, dim3(4096), dim3(64), 0, stream);
#endif
        if (l == 0) hipLaunchKernelGGL(ck_gates_full, dim3(T * 8), dim3(256), 0, stream, XNc, w_in_l, PAc, cnt + 512); CKL(ck_mix, XNc, w_in_l, YAc, YHc, ssqc, wua, wuh, PAc, MGc, 0, c0 + 7);
        launch(pb + 6, pb + 7); CKL(ck_mix, XNc, w_in_l, YAc, YHc, ssqc, wua, wuh, PAc, MGc, 1, c0 + 7);
        launch(pb + 7, pb + 8); CKL(ck_mix, XNc, w_in_l, YAc, YHc, ssqc, wua, wuh, PAc, MGc, 2, c0 + 7);
        launch(pb + 8, pb + 9); if (l == 0) CKL(ck_out, in[I_X], MGc, in[I_WOUT], (const float*)xs, c0 + 10);
        const float* gff = in[I_FNG] + (size_t)l * D; const float* wrg = in[I_WRG] + (size_t)l * D * NGRP; const float* brg = in[I_BRG] + l * NGRP; const float* wre = in[I_WRE] + (size_t)l * NGRP * D * EPG; const float* bre = in[I_BRE] + l * NGRP * EPG;
        const float* weg = in[I_WEG] + (size_t)l * NEXP * D * DEXP; const float* weu = in[I_WEU] + (size_t)l * NEXP * D * DEXP; const float* wed = in[I_WED] + (size_t)l * NEXP * DEXP * D;
        const int* toke = (const int*)(ws + WS_TOKE); const float* tokw = (const float*)(ws + WS_TOKW); const int* tokp = (const int*)(ws + WS_TOKP); const int* metac = (const int*)(ws + WS_META);
        const bf16* XPc = (const bf16*)(ws + WS_XP); const bf16* ACTc = (const bf16*)(ws + WS_ACT);
#define CKM(st) CKL(ck_moe, (const float*)xs, gff, wrg, brg, wre, bre, weg, weu, wed, XNc, toke, tokw, tokp, metac, XPc, ACTc, XPc, st, c0 + 12)
        launch(pb + 9, pb + 10); CKL(ck_norm, (const float*)xs, gff, XNc, c0 + 11); CKM(0);
        launch(pb + 10, pb + 11); CKM(1);
        launch(pb + 11, pb + 12); CKM(2);
        launch(pb + 12, pb + 13); CKM(3);
        hipMemcpyAsync(ws + WS_US, xs, (size_t)T * D * 4 / 2, hipMemcpyDeviceToDevice, stream);
        launch(pb + 13, pb + 14);
        CKL(ck_comb, (const float*)(ws + WS_US), (const float*)xs, tokp, tokw, XPc, in[I_FING], (int)(l == DEPTH - 1), c0 + 6 + 40);
#else
#if defined(STOP_AFTER)
        launch(16 * l + 5, STOP_AFTER + 1); break;
#else
        launch(16 * l + 5, 16 * l + 14);
#endif
#endif
    }
#if defined(CHECK)
    hipLaunchKernelGGL(ck_report, dim3(1), dim3(64), 0, stream, (const unsigned*)cnt, 80, xs);
#endif
#else
    launch(0, 16 * (DEPTH - 1) + 14);
#endif
}
```

```cpp
#include <hip/hip_runtime.h>
#include <cstdio>
#include <cstdint>
namespace pg8 {
#define PG8_LAS __attribute__((address_space(3)))
typedef unsigned short bf16_t;
typedef short bf16x8 __attribute__((ext_vector_type(8)));
typedef float f32x4 __attribute__((ext_vector_type(4)));
typedef unsigned u32x4 __attribute__((ext_vector_type(4)));
typedef unsigned u32x2 __attribute__((ext_vector_type(2)));
constexpr int BM = 256, BK = 64, HALF = 128, HTB = HALF * BK * 2  , STAGE_BYTES = 8 * HTB, NXCD = 8, WGM = 8;

__host__ __device__ __forceinline__ int lds_byte(int r, int c) { const int st = (r >> 4) * 2 + (c >> 5), rr = r & 15, cc = c & 31, ob = rr * 64 + cc * 2; return st * 1024 + (ob ^ (((ob >> 9) & 1) << 5)); }
__host__ __device__ __forceinline__ void stage_rc(int b, int& R, int& C) { const int st = b / 1024, sb = b % 1024, swz = sb ^ (((sb >> 9) & 1) << 5); R = (st >> 1) * 16 + swz / 64; C = (st & 1) * 32 + (swz % 64) / 2; }
__host__ __device__ __forceinline__ int perm32(int rho) { const int n = rho >> 4, i = rho & 15; return 8 * (i >> 2) + 4 * n + (i & 3); }

struct Unit { int pm, pn, pb; };
struct Gemm { const bf16_t* A; const bf16_t* Bt; int M, N, K; };

struct StaticOrder {
    int nM, nN, nwg, G, c;
    __host__ __device__ void init(int M, int N, int G_, int c_) { nM = M / BM; nN = N / BM; nwg = nM * nN; G = G_; c = c_; }
    __host__ __device__ bool next(int i, Unit& u) const {
        const long L = (long)i * G + c; if (L >= nwg) return false;
        int wgid = (int)L; { const int q = nwg / NXCD, r = nwg % NXCD, xcd = wgid % NXCD, off = wgid / NXCD; wgid = (xcd < r ? xcd * (q + 1) : r * (q + 1) + (xcd - r) * q) + off; }
        const int nig = WGM * nN, gid = wgid / nig, fm = gid * WGM, gsz = (nM - fm) < WGM ? (nM - fm) : WGM;
        u.pm = fm + ((wgid % nig) % gsz); u.pn = (wgid % nig) / gsz; u.pb = u.pn; return true;
    }
    __device__ __forceinline__ void a_ready(const Unit&) const {}
    __device__ __forceinline__ void done(const Unit&) const {}
};
struct GroupedOrder {
    const int* meta; int nM, nN, nwg, G, base;
    __device__ __forceinline__ void init(const int* meta_, int N, int G_, int c_, bool second = false) { meta = meta_; nM = __builtin_amdgcn_readfirstlane(__hip_atomic_load(meta_, __ATOMIC_RELAXED, __HIP_MEMORY_SCOPE_AGENT)); nN = N / BM; nwg = nM * nN; G = G_;
        base = second ? (((c_ < nwg) ? (nwg - c_ + G_ - 1) / G_ : 0) * G_ + c_ - nwg) : c_; }
    __device__ __forceinline__ bool next(int i, Unit& u) const {
        int wgid = i * G + base; if (wgid >= nwg) return false;
        { const int q = nwg / NXCD, r = nwg % NXCD, xcd = wgid % NXCD, off = wgid / NXCD; wgid = (xcd < r ? xcd * (q + 1) : r * (q + 1) + (xcd - r) * q) + off; }
        const int nig = WGM * nN, gid = wgid / nig, fm = gid * WGM, gsz = (nM - fm) < WGM ? (nM - fm) : WGM;
        u.pm = fm + ((wgid % nig) % gsz); u.pn = (wgid % nig) / gsz;
        u.pb = __builtin_amdgcn_readfirstlane(__hip_atomic_load(meta + 1 + u.pm, __ATOMIC_RELAXED, __HIP_MEMORY_SCOPE_AGENT)) * nN + u.pn; return true;
    }
    __device__ __forceinline__ void a_ready(const Unit&) const {}
    __device__ __forceinline__ void done(const Unit&) const {}
};
struct ProducerOrder : GroupedOrder {
    unsigned* cnt;
    __device__ __forceinline__ void done(const Unit& u) const {
        asm volatile("s_waitcnt vmcnt(0)" ::: "memory");
        if ((threadIdx.x & 63) == 0) __hip_atomic_fetch_add(cnt + 64 * u.pm, 1u, __ATOMIC_RELAXED, __HIP_MEMORY_SCOPE_AGENT);
    }
};
struct ConsumerOrder : GroupedOrder {
    unsigned* cnt; static constexpr unsigned NEED = 32u;
    __device__ __forceinline__ void a_ready(const Unit& u) const {
        if (threadIdx.x < 64) {
            unsigned* tmo = cnt - 64;
            const unsigned long long t0 = __builtin_amdgcn_s_memrealtime(); unsigned polls = 0;
            while ((unsigned)__builtin_amdgcn_readfirstlane(__hip_atomic_load(cnt + 64 * u.pm, __ATOMIC_RELAXED, __HIP_MEMORY_SCOPE_AGENT)) < NEED) {
                if ((++polls & 255u) == 0u && __builtin_amdgcn_readfirstlane(__hip_atomic_load(tmo, __ATOMIC_RELAXED, __HIP_MEMORY_SCOPE_AGENT)) != 0u) break;
                if (__builtin_amdgcn_s_memrealtime() - t0 > 2000000ull) {
                    if (threadIdx.x == 0) { unsigned expect = 0u; __hip_atomic_compare_exchange_strong(tmo + 1, &expect, 0x600u | (unsigned)(u.pm & 0xff), __ATOMIC_RELAXED, __ATOMIC_RELAXED, __HIP_MEMORY_SCOPE_AGENT); __hip_atomic_store(tmo, 1u, __ATOMIC_RELAXED, __HIP_MEMORY_SCOPE_AGENT); }
                    break; }
                __builtin_amdgcn_s_sleep(2); }
            asm volatile("s_waitcnt vmcnt(0)" ::: "memory");
        }
        asm volatile("" ::: "memory"); __builtin_amdgcn_s_barrier(); asm volatile("" ::: "memory");
    }
};
typedef float f32x2_t __attribute__((ext_vector_type(2))); typedef __bf16 bf16x2_t __attribute__((ext_vector_type(2)));
__device__ __forceinline__ unsigned cvt_pk_bf16(float lo, float hi) { f32x2_t v = {lo, hi}; bf16x2_t b = __builtin_convertvector(v, bf16x2_t); return __builtin_bit_cast(unsigned, b); }
template <class Epi, class Sched, bool ALIGN_EPI = false, bool SP2 = false, bool GATHER = false, int A_AUX = 0>
__device__ __forceinline__ void gemm_phase(PG8_LAS unsigned char* lds, const Gemm g, const Sched& S, const Epi& E, const int* rowtab = nullptr) {
    int tid_ = threadIdx.x; asm volatile("" : "+v"(tid_));
    const int tid = tid_, wid = __builtin_amdgcn_readfirstlane(tid >> 6), lane = tid & 63, wr = wid >> 2, wc = wid & 3, fr = lane & 15, fq = lane >> 4;
    const int K = g.K, nt = K / BK;
    unsigned voffA[2], voffB[2];
#pragma unroll
    for (int i = 0; i < 2; ++i) { int R, C; stage_rc(tid * 16 + i * 8192, R, C); const int Rb = Epi::PERM ? ((R & ~31) + perm32(R & 31)) : R;
        voffA[i] = (unsigned)(R * K + C) * 2u; voffB[i] = (unsigned)(Rb * K + C) * 2u; }
    const size_t kstep = (size_t)(BK * 2);
    const size_t hstep = (size_t)HALF * K * 2;
    const size_t tstep = 2 * hstep;
    const unsigned ldsw = (unsigned)wid * 1024u;
    const int aoff = lds_byte(wr * 64 + fr, fq * 8), boff = lds_byte(wc * 32 + fr, fq * 8);
#define PG8_SA(b, h) (((b) * 2 + (h)) * HTB)
#define PG8_SB(b, h) ((4 + (b) * 2 + (h)) * HTB)
#define PG8_STAGE(bufoff, gbase, voff) do { _Pragma("unroll") for (int _i = 0; _i < 2; ++_i) \
        __builtin_amdgcn_global_load_lds((const unsigned*)((const char*)(gbase) + (voff)[_i]), (PG8_LAS unsigned*)(lds + (bufoff) + ldsw + _i * 8192), 16, 0, 0); } while (0)
#define PG8_STAGE_A(bufoff, gbase, h, RO) do { _Pragma("unroll") for (int _i = 0; _i < 2; ++_i) \
        __builtin_amdgcn_global_load_lds((const unsigned*)((const char*)(gbase) + (GATHER ? (size_t)RO[h][_i] : (size_t)(((h) ? hstep : 0) + voffA[_i]))), (PG8_LAS unsigned*)(lds + (bufoff) + ldsw + _i * 8192), 16, 0, A_AUX); } while (0)
#define PG8_ROWOFS(RO, pm_) do { if constexpr (GATHER) { _Pragma("unroll") for (int _h = 0; _h < 2; ++_h) _Pragma("unroll") for (int _i = 0; _i < 2; ++_i) { int _R, _C; stage_rc(tid * 16 + _i * 8192, _R, _C); \
        const int _tok = __hip_atomic_load(rowtab + (pm_) * 256 + _h * 128 + _R, __ATOMIC_RELAXED, __HIP_MEMORY_SCOPE_AGENT); RO[_h][_i] = (unsigned)_tok * (unsigned)(K * 2) + (unsigned)(_C * 2); } } } while (0)
#define PG8_LDA(dst, b, h) do { _Pragma("unroll") for (int m = 0; m < 4; ++m) _Pragma("unroll") for (int k = 0; k < 2; ++k) dst[m][k] = *(const PG8_LAS bf16x8*)(lds + PG8_SA(b, h) + aoff + m * 2048 + k * 1024); } while (0)
#define PG8_LDB(dst, b, h) do { _Pragma("unroll") for (int n = 0; n < 2; ++n) _Pragma("unroll") for (int k = 0; k < 2; ++k) dst[n][k] = *(const PG8_LAS bf16x8*)(lds + PG8_SB(b, h) + boff + n * 2048 + k * 1024); } while (0)
#define PG8_MMA(ai, bj, At, Bt) do { __builtin_amdgcn_s_setprio(1); _Pragma("unroll") for (int m = 0; m < 4; ++m) _Pragma("unroll") for (int n = 0; n < 2; ++n) _Pragma("unroll") for (int k = 0; k < 2; ++k) \
        acc[ai][bj][m][n] = __builtin_amdgcn_mfma_f32_16x16x32_bf16(Bt[n][k], At[m][k], acc[ai][bj][m][n], 0, 0, 0); __builtin_amdgcn_s_setprio(0); } while (0)
#define PG8_WAIT_V(n) asm volatile("s_waitcnt vmcnt(" #n ")" ::: "memory")
#define PG8_WAIT_L(n) asm volatile("s_waitcnt lgkmcnt(" #n ")" ::: "memory")
#define PG8_BAR __builtin_amdgcn_s_barrier()
#define PG8_SCHED __builtin_amdgcn_sched_barrier(0)
    Unit cur, nxt; int ui = 0;
    if (!S.next(0, cur)) return;
    f32x4 acc[2][2][4][2];
#pragma unroll
    for (int a = 0; a < 2; ++a)
#pragma unroll
        for (int b = 0; b < 2; ++b)
#pragma unroll
            for (int m = 0; m < 4; ++m)
#pragma unroll
                for (int n = 0; n < 2; ++n) acc[a][b][m][n] = (f32x4){0.f, 0.f, 0.f, 0.f};
    bf16x8 At[4][2], B0[2][2], B1[2][2];
    const char* cA = (const char*)g.A + (GATHER ? (size_t)0 : (size_t)cur.pm * tstep); const char* cB = (const char*)g.Bt + (size_t)cur.pb * tstep;
    unsigned rofsC[2][2] = {{0u, 0u}, {0u, 0u}}, rofsN[2][2] = {{0u, 0u}, {0u, 0u}};
    PG8_ROWOFS(rofsC, cur.pm);
    S.a_ready(cur);
    if constexpr (SP2) {
        PG8_STAGE(PG8_SB(0, 0), cB, voffB); PG8_STAGE(PG8_SB(0, 1), cB + hstep, voffB); PG8_STAGE_A(PG8_SA(0, 0), cA, 0, rofsC); PG8_STAGE_A(PG8_SA(0, 1), cA, 1, rofsC);
        if (wr == 1) PG8_BAR;
        PG8_WAIT_V(2); PG8_BAR;
        PG8_STAGE(PG8_SB(1, 0), cB + kstep, voffB); PG8_STAGE_A(PG8_SA(1, 0), cA + kstep, 0, rofsC); PG8_STAGE(PG8_SB(1, 1), cB + hstep + kstep, voffB);
        PG8_WAIT_V(6); PG8_BAR;
    } else {
        PG8_STAGE(PG8_SB(0, 0), cB, voffB); PG8_STAGE_A(PG8_SA(0, 0), cA, 0, rofsC); PG8_STAGE(PG8_SB(0, 1), cB + hstep, voffB); PG8_STAGE_A(PG8_SA(0, 1), cA, 1, rofsC);
        if (wr == 1) PG8_BAR;
        PG8_WAIT_V(4); PG8_BAR;
        PG8_STAGE(PG8_SB(1, 0), cB + kstep, voffB); PG8_STAGE_A(PG8_SA(1, 0), cA + kstep, 0, rofsC); PG8_STAGE(PG8_SB(1, 1), cB + hstep + kstep, voffB);
        PG8_WAIT_V(6); PG8_BAR;
    }
    for (;;) {
        const bool has_next = S.next(ui + 1, nxt);
        const char* nA = (has_next && !GATHER) ? (const char*)g.A + (size_t)nxt.pm * tstep : cA; const char* nB = has_next ? (const char*)g.Bt + (size_t)nxt.pb * tstep : cB;
        for (int t = 0; t < nt; t += 2) {
            const bool last = (t == nt - 2);
            const char* a1 = cA + (size_t)(t + 1) * kstep;
            const char* a2 = last ? nA : cA + (size_t)(t + 2) * kstep; const char* b2 = last ? nB : cB + (size_t)(t + 2) * kstep;
            const char* a3 = a2 + kstep; const char* b3 = b2 + kstep;
            if (last && has_next) { S.a_ready(nxt); PG8_ROWOFS(rofsN, nxt.pm); }
            unsigned ro2[2][2];
#pragma unroll
            for (int _h = 0; _h < 2; ++_h)
#pragma unroll
                for (int _i = 0; _i < 2; ++_i) ro2[_h][_i] = (last && has_next) ? rofsN[_h][_i] : rofsC[_h][_i];
            if constexpr (SP2) {
            PG8_LDB(B0, 0, 0); PG8_LDB(B1, 0, 1); PG8_SCHED; PG8_LDA(At, 0, 0); PG8_STAGE_A(PG8_SA(1, 1), a1, 1, rofsC);
            PG8_WAIT_V(8); PG8_WAIT_L(0); PG8_BAR; PG8_MMA(0, 0, At, B0); PG8_MMA(0, 1, At, B1); PG8_BAR; PG8_SCHED;
            PG8_LDA(At, 0, 1); PG8_STAGE(PG8_SB(0, 0), b2, voffB); PG8_STAGE(PG8_SB(0, 1), b2 + hstep, voffB); PG8_STAGE_A(PG8_SA(0, 0), a2, 0, ro2);
            PG8_WAIT_V(8); PG8_WAIT_L(0); PG8_BAR; PG8_MMA(1, 0, At, B0); PG8_MMA(1, 1, At, B1); PG8_BAR; PG8_SCHED;
            PG8_LDB(B0, 1, 0); PG8_LDB(B1, 1, 1); PG8_SCHED; PG8_LDA(At, 1, 0); PG8_STAGE_A(PG8_SA(0, 1), a2, 1, ro2);
            PG8_WAIT_V(8); PG8_WAIT_L(0); PG8_BAR; PG8_MMA(0, 0, At, B0); PG8_MMA(0, 1, At, B1); PG8_BAR; PG8_SCHED;
            PG8_LDA(At, 1, 1); PG8_STAGE(PG8_SB(1, 0), b3, voffB); PG8_STAGE(PG8_SB(1, 1), b3 + hstep, voffB); PG8_STAGE_A(PG8_SA(1, 0), a3, 0, ro2);
            PG8_WAIT_V(8); PG8_WAIT_L(0); PG8_BAR; PG8_MMA(1, 0, At, B0); PG8_MMA(1, 1, At, B1); PG8_BAR; PG8_SCHED;
            } else {
            PG8_LDB(B0, 0, 0); PG8_SCHED; PG8_LDA(At, 0, 0); PG8_STAGE_A(PG8_SA(1, 1), a1, 1, rofsC);
            PG8_WAIT_L(8); PG8_BAR; PG8_WAIT_L(0); PG8_MMA(0, 0, At, B0); PG8_BAR; PG8_SCHED;
            PG8_LDB(B1, 0, 1); PG8_STAGE(PG8_SB(0, 0), b2, voffB);
            PG8_BAR; PG8_WAIT_L(0); PG8_MMA(0, 1, At, B1); PG8_BAR;
            PG8_LDA(At, 0, 1); PG8_STAGE_A(PG8_SA(0, 0), a2, 0, ro2);
            PG8_BAR; PG8_WAIT_L(0); PG8_MMA(1, 0, At, B0); PG8_BAR; PG8_SCHED;
            PG8_STAGE(PG8_SB(0, 1), b2 + hstep, voffB);
            PG8_WAIT_V(6); PG8_BAR; PG8_MMA(1, 1, At, B1); PG8_BAR;
            PG8_LDB(B0, 1, 0); PG8_SCHED; PG8_LDA(At, 1, 0); PG8_STAGE_A(PG8_SA(0, 1), a2, 1, ro2);
            PG8_WAIT_L(8); PG8_BAR; PG8_WAIT_L(0); PG8_MMA(0, 0, At, B0); PG8_BAR; PG8_SCHED;
            PG8_LDB(B1, 1, 1); PG8_STAGE(PG8_SB(1, 0), b3, voffB);
            PG8_BAR; PG8_WAIT_L(0); PG8_MMA(0, 1, At, B1); PG8_BAR;
            PG8_LDA(At, 1, 1); PG8_STAGE_A(PG8_SA(1, 0), a3, 0, ro2);
            PG8_BAR; PG8_WAIT_L(0); PG8_MMA(1, 0, At, B0); PG8_BAR; PG8_SCHED;
            PG8_STAGE(PG8_SB(1, 1), b3 + hstep, voffB);
            PG8_WAIT_V(6); PG8_BAR; PG8_MMA(1, 1, At, B1); PG8_BAR;
            }
        }
        if constexpr (ALIGN_EPI) { if (wr == 0) PG8_BAR; }
        if constexpr (!Epi::AFTER_DRAIN) { E(acc, cur, wr, wc, fr, fq); S.done(cur); }
        if (!has_next) break;
#pragma unroll
        for (int a = 0; a < 2; ++a)
#pragma unroll
            for (int b = 0; b < 2; ++b)
#pragma unroll
                for (int m = 0; m < 4; ++m)
#pragma unroll
                    for (int n = 0; n < 2; ++n) acc[a][b][m][n] = (f32x4){0.f, 0.f, 0.f, 0.f};
        cur = nxt; cA = nA; cB = nB; ++ui;
#pragma unroll
        for (int _h = 0; _h < 2; ++_h)
#pragma unroll
            for (int _i = 0; _i < 2; ++_i) rofsC[_h][_i] = rofsN[_h][_i];
        if constexpr (ALIGN_EPI) { if (wr == 1) PG8_BAR; }
    }
    PG8_WAIT_V(0);
    if constexpr (!ALIGN_EPI) { if (wr == 0) PG8_BAR; }
    PG8_BAR;
    if constexpr (Epi::AFTER_DRAIN) { E.fused(acc, cur, wr, wc, fr, fq, lds, wid, lane); S.done(cur); }
#undef PG8_SA
#undef PG8_SB
#undef PG8_STAGE
#undef PG8_STAGE_A
#undef PG8_ROWOFS
#undef PG8_LDA
#undef PG8_LDB
#undef PG8_MMA
#undef PG8_WAIT_V
#undef PG8_WAIT_L
#undef PG8_BAR
#undef PG8_SCHED
}
}


constexpr int NWAVES = 8;
constexpr int BATCH = 2, SEQ = 16384, D = 1024, T = BATCH * SEQ, DEPTH = 2;
constexpr int NQH = 8, NKVH = 2, HD = 64, WINDOW = 128;
constexpr int HH = 4, HDK = 128;
constexpr int NGRP = 4, EPG = 8, NEXP = 32, DEXP = 512;
constexpr int INW = 5376, NPA = 3328, NGATE = 2048;
constexpr int C_QA = 0, C_KA = 512, C_VA = 640, C_QH = 768, C_LF = 1280, C_LB = 1792, C_VH = 2304, C_SG = 2816;
constexpr float NORM_EPS = 1e-6f, LOGF_MIN = -4.0f;
constexpr float LOG2E = 1.4426950408889634f;
constexpr float QSCALE = 0.125f * LOG2E;
constexpr int CH = 128, NCH = SEQ / CH;
constexpr int SLOT_ROWS = 73728;

constexpr size_t MiB = 1u << 20;
constexpr size_t WS_CTL = 0, CTL_ZERO_BYTES = 1 * MiB;
constexpr size_t WS_COS = 1 * MiB, WS_SIN = 3 * MiB, WS_LBT = 5 * MiB;
constexpr size_t WS_WIN = 6 * MiB, WS_WUA = 17 * MiB, WS_WUH = 18 * MiB, WS_WOUT = 19 * MiB, WS_W1 = 22 * MiB, WS_W2 = 86 * MiB;
constexpr size_t WS_XN = 118 * MiB;
constexpr size_t WS_PA = 182 * MiB;
constexpr size_t WS_US = 390 * MiB;
constexpr size_t WS_Y = 454 * MiB;
constexpr size_t WS_YH = 486 * MiB;
constexpr size_t WS_HD = 518 * MiB;
constexpr size_t WS_SSQ = 519 * MiB;
constexpr size_t WS_TOKE = 520 * MiB, WS_TOKW = 521 * MiB, WS_TOKR = 522 * MiB, WS_TOKP = 523 * MiB;
constexpr size_t WS_WGCNT = 524 * MiB;
constexpr size_t WS_META = 524 * MiB + 512 * 1024;
constexpr size_t WS_STOK = 525 * MiB;
constexpr size_t WS_RSA = 526 * MiB;
constexpr size_t WS_RSF = 526 * MiB + 128 * 1024;
constexpr size_t WS_RSS = 526 * MiB + 256 * 1024;
constexpr size_t WS_END = 527 * MiB;
constexpr size_t WS_XP = WS_PA;
constexpr size_t WS_ACT = WS_PA + (size_t)SLOT_ROWS * D * 2;
static_assert(WS_ACT + (size_t)SLOT_ROWS * DEXP * 2 <= WS_Y, "MoE overlay");
static_assert(WS_PA + (size_t)T * NPA * 2 <= WS_US && WS_W2 + (size_t)NEXP * D * DEXP * 2 <= WS_XN && WS_WIN + (size_t)INW * D * 2 <= WS_WUA, "ws map");
constexpr int CW_TMO = 0, CW_CODE = 1;
constexpr int CW_BAR = 4096;
#ifndef G1A_SPLIT
#define G1A_SPLIT 0
#endif
#ifndef CONV_WGS
#define CONV_WGS 16
#endif
#ifndef CONV_WGS_MOE
#define CONV_WGS_MOE 32
#endif
#ifndef CONV_PER_WG0
#define CONV_PER_WG0 0
#endif
#ifndef CONV_PER_WG1
#define CONV_PER_WG1 512
#endif
#ifndef CONV_PER_WG2
#define CONV_PER_WG2 256
#endif
#ifndef CONV_PER_WG12
#define CONV_PER_WG12 192
#endif
#ifndef DENSE_EARLY
#define DENSE_EARLY 1
#endif
#ifndef ROUTE_MFMA
#define ROUTE_MFMA 1
#endif
#ifndef NORM4
#define NORM4 0
#endif
#ifndef NORMFOLD
#define NORMFOLD 1
#endif
#ifndef XBF16
#define XBF16 1
#endif
#ifndef CONV_ASM_LOADS
#define CONV_ASM_LOADS 0
#endif
#ifndef EXPERTS_BY_QUEUE
#define EXPERTS_BY_QUEUE 1
#endif
#ifndef MOE_HANDOFF
#define MOE_HANDOFF 0
#endif
constexpr int MAX_LAUNCH = 16;
constexpr int CW_H12 = 2048;
constexpr int CW_MOE = 131072, MOE_BANK = 320 * 64;

constexpr int RING_OFF = 0, RING_BYTES = 131072;
constexpr int LDSCTL_OFF = RING_BYTES, MISC_OFF = LDSCTL_OFF + 320;
#ifndef ROUTE4
#define ROUTE4 1
#endif
constexpr int LDS_BYTES = ROUTE4 ? 163840 : 147456;

#define GAS __attribute__((address_space(1)))
#define LAS __attribute__((address_space(3)))
typedef unsigned short bf16;
typedef unsigned v4u __attribute__((ext_vector_type(4)));
typedef unsigned v2u __attribute__((ext_vector_type(2)));
typedef float f32x4 __attribute__((ext_vector_type(4)));
typedef short bf16x8 __attribute__((ext_vector_type(8)));
typedef short s16x4 __attribute__((ext_vector_type(4)));
typedef _Float16 h16x4 __attribute__((ext_vector_type(4)));
typedef _Float16 h16x8 __attribute__((ext_vector_type(8)));
typedef GAS unsigned gu32;
typedef GAS unsigned long long gu64;
#define RLX_AGENT __ATOMIC_RELAXED, __HIP_MEMORY_SCOPE_AGENT
#define LDS_WAIT() asm volatile("s_waitcnt lgkmcnt(0)" ::: "memory")
#define VM_WAIT() asm volatile("s_waitcnt vmcnt(0)" ::: "memory")
__device__ __forceinline__ unsigned f2bf(float f) { unsigned u = __builtin_bit_cast(unsigned, f); return (u + 0x7fffu + ((u >> 16) & 1u)) >> 16; }
__device__ __forceinline__ unsigned pk2(float lo, float hi) { return f2bf(lo) | (f2bf(hi) << 16); }
__device__ __forceinline__ float bf2f(unsigned short b) { return __builtin_bit_cast(float, ((unsigned)b) << 16); }
__device__ __forceinline__ float bflo(unsigned w) { return __builtin_bit_cast(float, w << 16); }
__device__ __forceinline__ float bfhi(unsigned w) { return __builtin_bit_cast(float, w & 0xffff0000u); }
__device__ __forceinline__ float fast_rcp(float x) { return __builtin_amdgcn_rcpf(x); }
__device__ __forceinline__ float sigmoidf_(float x) { return fast_rcp(1.0f + __expf(-x)); }
__device__ __forceinline__ float siluf_(float x) { return x * fast_rcp(1.0f + __expf(-x)); }
#ifndef SIGMOID_PK
#define SIGMOID_PK 0
#endif
typedef float f32x2v __attribute__((ext_vector_type(2)));
__device__ __forceinline__ f32x2v rcp1p_pk(f32x2v e) {
    const f32x2v d = e + 1.0f; f32x2v r;
    { typedef int i32x2v __attribute__((ext_vector_type(2))); const i32x2v sd = (i32x2v){0x7EF311C7, 0x7EF311C7} - __builtin_bit_cast(i32x2v, d); r = __builtin_bit_cast(f32x2v, sd); }
    r = r * (2.0f - d * r); r = r * (2.0f - d * r); return r;
}
__device__ __forceinline__ f32x4 sigmoid4(const f32x4& x) {
#if SIGMOID_PK
    f32x2v t0 = {x[0], x[1]}, t1 = {x[2], x[3]};
    t0 = __builtin_elementwise_min(t0 * -1.4426950408889634f, (f32x2v){126.f, 126.f}); t1 = __builtin_elementwise_min(t1 * -1.4426950408889634f, (f32x2v){126.f, 126.f});
    f32x2v e0, e1; e0.x = __builtin_amdgcn_exp2f(t0.x); e0.y = __builtin_amdgcn_exp2f(t0.y); e1.x = __builtin_amdgcn_exp2f(t1.x); e1.y = __builtin_amdgcn_exp2f(t1.y);
    const f32x2v r0 = rcp1p_pk(e0), r1 = rcp1p_pk(e1);
    return (f32x4){r0.x, r0.y, r1.x, r1.y};
#else
    return (f32x4){sigmoidf_(x[0]), sigmoidf_(x[1]), sigmoidf_(x[2]), sigmoidf_(x[3])};
#endif
}

#define XB_TMO      128
#define XB_XCNT(j)  (256  + 64 * (j))
#define XB_XSUB(j)  (1280 + 64 * (j))
#define XB_XGEN(j)  (2304 + 64 * (j))
#define XB_TOP      3328
#define XB_TOPGEN   3392
#define XCD_BAR_WORDS 3456
#define XB_SPIN_CAP (1u << 18)

__device__ __forceinline__ unsigned xb_ld(unsigned* p)              { return __hip_atomic_load(p, __ATOMIC_RELAXED, __HIP_MEMORY_SCOPE_AGENT); }
__device__ __forceinline__ unsigned xb_add(unsigned* p, unsigned v) { return __hip_atomic_fetch_add(p, v, __ATOMIC_RELAXED, __HIP_MEMORY_SCOPE_AGENT); }
__device__ __forceinline__ unsigned xb_xcc_id() { return (unsigned)__builtin_amdgcn_s_getreg((3 << 11) | 20) & 0xFu; }
#define XB_SPIN(cond, bar) do { unsigned _sp = 0; while (cond) { __builtin_amdgcn_s_sleep(1); \
    if ((++_sp & 255u) == 0u) { if (xb_ld(&(bar)[XB_TMO])) break; if (_sp > XB_SPIN_CAP) { atomicAdd(&(bar)[XB_TMO], 1u); break; } } } } while (0)

struct XcdBarrier {
    unsigned* bar; unsigned x;
    volatile LAS unsigned* st;
};

__device__ __forceinline__ XcdBarrier xcd_barrier_post(unsigned* bar, volatile LAS unsigned* st) {
    XcdBarrier b; b.bar = bar; b.x = xb_xcc_id(); b.st = st;
    if (threadIdx.x == 0) (void)xb_add(&bar[XB_XCNT(b.x)], 1u);
    return b;
}
__device__ __forceinline__ void xcd_barrier_complete(unsigned* bar, unsigned x, unsigned& nloc, unsigned& nx) {
    const unsigned G = gridDim.x * gridDim.y * gridDim.z;
    unsigned sum, cnt, mine, sp = 0u;
    for (;;) {
        sum = 0u; cnt = 0u; mine = 0u;
#pragma unroll
        for (unsigned j = 0; j < 16; ++j) { const unsigned c = xb_ld(&bar[XB_XCNT(j)]); sum += c; cnt += (c > 0u) ? 1u : 0u; mine = (j == x) ? c : mine; }
        if (sum == G) break;
        __builtin_amdgcn_s_sleep(1);
        if ((++sp & 255u) == 0u) { if (xb_ld(&bar[XB_TMO])) break; if (sp > XB_SPIN_CAP) { atomicAdd(&bar[XB_TMO], 1u); break; } }
    }
    nloc = mine > 0u ? mine : 1u; nx = cnt > 0u ? cnt : 1u;
}

__device__ __forceinline__ void xcd_barrier(const XcdBarrier& b) {
    asm volatile("s_waitcnt vmcnt(0)" ::: "memory");
    __syncthreads();
    if (threadIdx.x == 0) {
        unsigned* bar = b.bar;
        __builtin_amdgcn_s_waitcnt(0);
        unsigned nloc = b.st[0], nx = b.st[1];
        if (nloc == 0u) { xcd_barrier_complete(bar, b.x, nloc, nx); b.st[0] = nloc; b.st[1] = nx; }
        const unsigned old = xb_add(&bar[XB_XSUB(b.x)], 1u);
        const unsigned gen = old / nloc;
        if (old + 1u == (gen + 1u) * nloc) {
            __builtin_amdgcn_fence(__ATOMIC_RELEASE, "agent");
            asm volatile("s_waitcnt vmcnt(0)" ::: "memory");
            const unsigned og = xb_add(&bar[XB_TOP], 1u);
            const unsigned tg = og / nx;
            if (og + 1u == (tg + 1u) * nx) xb_add(&bar[XB_TOPGEN], 1u);
            else XB_SPIN(xb_ld(&bar[XB_TOPGEN]) == tg, bar);
            __builtin_amdgcn_fence(__ATOMIC_ACQUIRE, "agent");
            xb_add(&bar[XB_XGEN(b.x)], 1u);
            asm volatile("s_waitcnt vmcnt(0)" ::: "memory");
        } else {
            XB_SPIN(xb_ld(&bar[XB_XGEN(b.x)]) == gen, bar);
            __builtin_amdgcn_fence(__ATOMIC_ACQUIRE, "agent");
            asm volatile("s_waitcnt vmcnt(0)" ::: "memory");
        }
    }
    __syncthreads();
}

struct Frame {
    LAS unsigned char* lds;
    volatile LAS unsigned* MISC;
    gu32* ctl;
    int tid, lane, wave, vcu, G;
    unsigned char* ws;
    float* out;
};
struct Args { const float* in[18]; float* out; unsigned char* ws; int ph_lo, ph_hi, li, pad; };
enum { I_X = 0, I_ANG, I_WIN, I_SINK, I_LBT, I_HNG, I_WUA, I_WUH, I_WOUT, I_FNG, I_WRG, I_BRG, I_WRE, I_BRE, I_WEG, I_WEU, I_WED, I_FING };

__device__ __forceinline__ float wave_sum(float v) {
#if defined(__HIP_DEVICE_COMPILE__)
#define WS_ROR(n) v += __builtin_bit_cast(float, __builtin_amdgcn_update_dpp(0, __builtin_bit_cast(int, v), 0x120 + (n), 0xf, 0xf, false))
    WS_ROR(8); WS_ROR(4); WS_ROR(2); WS_ROR(1);
#undef WS_ROR
    const int b = __builtin_bit_cast(int, v);
    const float r0 = __builtin_bit_cast(float, __builtin_amdgcn_readlane(b, 0)), r1 = __builtin_bit_cast(float, __builtin_amdgcn_readlane(b, 16));
    const float r2 = __builtin_bit_cast(float, __builtin_amdgcn_readlane(b, 32)), r3 = __builtin_bit_cast(float, __builtin_amdgcn_readlane(b, 48));
    return (r0 + r1) + (r2 + r3);
#else
    return v;
#endif
}

struct CmPerm { const float* W; int N; __device__ __forceinline__ const float* seg(int p0, int n, int c, int& ld) const { ld = N; return W + p0 + 8 * c + 4 * n; } };
struct CmIn { const float* W; __device__ __forceinline__ const float* seg(int p0, int n, int c, int& ld) const { ld = INW;
    return (p0 < C_VA) ? (W + (p0 & ~63) + 32 * n + 16 * ((p0 >> 5) & 1) + 4 * c) : (W + p0 + 8 * c + 4 * n); } };
struct CmGU { const float* Wg; const float* Wu; __device__ __forceinline__ const float* seg(int p0, int n, int c, int& ld) const { ld = DEXP; return (n ? Wu : Wg) + 16 * (p0 >> 5) + 4 * c; } };
template <class CM> __device__ __forceinline__ void transpose_load(const CM& cm, int kb, int nb, int lane, f32x4 (&v)[8]) {
    const int k0 = 64 * kb, n0 = 32 * nb;
    const int nc = lane & 7, kr = lane >> 3;
    int ld; const float* src; { const float* s0 = cm.seg(n0, 0, nc & 3, ld); const float* s1 = cm.seg(n0, 1, nc & 3, ld); src = (nc >> 2) ? s1 : s0; }
#pragma unroll
    for (int i = 0; i < 8; ++i) v[i] = *(const GAS f32x4*)(src + (size_t)(k0 + 8 * i + kr) * ld);
}
__device__ __forceinline__ void transpose_finish(int K, bf16* WT, LAS float* scr, int kb, int nb, int lane, const f32x4 (&v)[8], const LAS float* gk = nullptr) {
    constexpr int SP = 36;
    const int k0 = 64 * kb, n0 = 32 * nb;
    const int nc = lane & 7, kr = lane >> 3;
#pragma unroll
    for (int i = 0; i < 8; ++i) *(LAS f32x4*)(scr + (8 * i + kr) * SP + 4 * nc) = gk ? v[i] * gk[k0 + 8 * i + kr] : v[i];
    LDS_WAIT(); asm volatile("" ::: "memory");
    const int c = lane & 7;
#pragma unroll
    for (int j = 0; j < 4; ++j) { const int n = (lane >> 3) + 8 * j; const LAS float* s = scr + (8 * c) * SP + n;
        v4u o; o.x = pk2(s[0 * SP], s[1 * SP]); o.y = pk2(s[2 * SP], s[3 * SP]); o.z = pk2(s[4 * SP], s[5 * SP]); o.w = pk2(s[6 * SP], s[7 * SP]);
        *(GAS v4u*)(WT + (size_t)(n0 + n) * K + k0 + 8 * c) = o; }
    LDS_WAIT(); asm volatile("" ::: "memory");
}
template <class CM> __device__ __forceinline__ void transpose_item(const CM& cm, int K, bf16* WT, LAS float* scr, int kb, int nb, int lane, const LAS float* gk = nullptr) {
    f32x4 v[8]; transpose_load(cm, kb, nb, lane, v); transpose_finish(K, WT, scr, kb, nb, lane, v, gk);
}
__device__ __forceinline__ void conv_weights(Frame& F, const Args& A, int l, int wi = -1, int nw = 0) {
    LAS float* scr = (LAS float*)(F.lds + RING_OFF + F.wave * 16384);
    const int gw = wi >= 0 ? wi : F.vcu * NWAVES + F.wave, NGW = wi >= 0 ? nw : F.G * NWAVES;
    unsigned char* ws = F.ws;
    const float* w_in = A.in[I_WIN] + (size_t)l * D * INW;
    const float* w_ua = A.in[I_WUA] + (size_t)l * 512 * D;
    const float* w_uh = A.in[I_WUH] + (size_t)l * 512 * D;
    const float* w_out = A.in[I_WOUT] + (size_t)l * D * D;
    const float* w_eg = A.in[I_WEG] + (size_t)l * NEXP * D * DEXP;
    const float* w_eu = A.in[I_WEU] + (size_t)l * NEXP * D * DEXP;
    const float* w_ed = A.in[I_WED] + (size_t)l * NEXP * DEXP * D;
    constexpr int I_A = 16 * (INW / 32), I_B = 8 * 32, I_D = 16 * 32, I_E1 = 16 * 32, I_E = NEXP * I_E1, I_F1 = 8 * 32, I_F = NEXP * I_F1;
    constexpr int NITEMS = I_A + 2 * I_B + I_D + (EXPERTS_BY_QUEUE ? 0 : I_E + I_F);
    LAS float* gkl = scr + 2560;
    if (NORMFOLD) { const float* gsrc = A.in[I_ANG] + (size_t)l * D;
#pragma unroll
        for (int j = 0; j < 4; ++j) *(LAS f32x4*)(gkl + 4 * F.lane + 256 * j) = *(const f32x4*)(gsrc + 4 * F.lane + 256 * j);
        LDS_WAIT(); }
    for (int it = gw; it < NITEMS; it += NGW) {
        int r = it;
        if (r < I_A) { CmIn cm{w_in}; transpose_item(cm, D, (bf16*)(ws + WS_WIN), scr, r / (INW / 32), r % (INW / 32), F.lane, NORMFOLD ? gkl : nullptr); continue; } r -= I_A;
        if (r < I_B) { CmPerm cm{w_ua, D}; transpose_item(cm, 512, (bf16*)(ws + WS_WUA), scr, r / 32, r % 32, F.lane); continue; } r -= I_B;
        if (r < I_B) { CmPerm cm{w_uh, D}; transpose_item(cm, 512, (bf16*)(ws + WS_WUH), scr, r / 32, r % 32, F.lane); continue; } r -= I_B;
        if (r < I_D) { CmPerm cm{w_out, D}; transpose_item(cm, D, (bf16*)(ws + WS_WOUT), scr, r / 32, r % 32, F.lane); continue; } r -= I_D;
        if (r < I_E) { const int e = r / I_E1, q = r % I_E1; CmGU cm{w_eg + (size_t)e * D * DEXP, w_eu + (size_t)e * D * DEXP};
            transpose_item(cm, D, (bf16*)(ws + WS_W1) + (size_t)e * 1024 * D, scr, q / 32, q % 32, F.lane); continue; } r -= I_E;
        { const int e = r / I_F1, q = r % I_F1; CmPerm cm{w_ed + (size_t)e * DEXP * D, D};
            transpose_item(cm, DEXP, (bf16*)(ws + WS_W2) + (size_t)e * D * DEXP, scr, q / 32, q % 32, F.lane); }
    }
}
__device__ __forceinline__ int conv_wgs(int G, int units, int cmax) {
    if (!EXPERTS_BY_QUEUE || G < 64 || (G % 8) != 0) return 0;
    const int r = (units + G - 1) / G; int c = cmax;
    while (c > 0 && (units + (G - c) - 1) / (G - c) > r) c -= 8;
    return c;
}
__device__ __forceinline__ void conv_experts_range(Frame& F, const Args& A, int l, int first, int last, int wi, int nw) {
    LAS float* scr = (LAS float*)(F.lds + RING_OFF + F.wave * 16384);
    unsigned char* ws = F.ws;
    const float* w_eg = A.in[I_WEG] + (size_t)l * NEXP * D * DEXP;
    const float* w_eu = A.in[I_WEU] + (size_t)l * NEXP * D * DEXP;
    const float* w_ed = A.in[I_WED] + (size_t)l * NEXP * DEXP * D;
    LAS float* gkl = scr + 2560;
    if (NORMFOLD && first < last) { const float* gsrc = A.in[I_FNG] + (size_t)l * D;
#pragma unroll
        for (int j = 0; j < 4; ++j) *(LAS f32x4*)(gkl + 4 * F.lane + 256 * j) = *(const f32x4*)(gsrc + 4 * F.lane + 256 * j);
        LDS_WAIT(); }
    constexpr int I_E1 = 16 * 32, I_E = NEXP * I_E1, I_F1 = 8 * 32;
    static_assert(I_E % 2 == 0 && I_F1 % 2 == 0, "pairs do not straddle");
#define CQ_LOAD(q, va, vb) do { const bool w1_ = (q) < I_E; const int r0_ = w1_ ? (q) : (q) - I_E, e_ = w1_ ? (r0_ >> 9) : (r0_ >> 8), r_ = w1_ ? (r0_ & 511) : (r0_ & 255), kb_ = r_ >> 5, nb_ = r_ & 31; \
        const int nc_ = F.lane & 7, kr_ = F.lane >> 3, n_ = nc_ >> 2, c_ = nc_ & 3; const size_t eo_ = (size_t)e_ * D * DEXP; \
        const float* base_ = w1_ ? ((n_ ? w_eu : w_eg) + eo_ + 16 * nb_ + 4 * c_) : (w_ed + eo_ + 32 * nb_ + 8 * c_ + 4 * n_); const int ld_ = w1_ ? DEXP : D, st_ = w1_ ? 16 : 32; \
        _Pragma("unroll") for (int i_ = 0; i_ < 8; ++i_) { const GAS float* p_ = (const GAS float*)(base_ + (size_t)(64 * kb_ + 8 * i_ + kr_) * ld_); const GAS float* p2_ = p_ + st_; \
            CQ_LD(va[i_], p_); CQ_LD(vb[i_], p2_); } } while (0)
#if CONV_ASM_LOADS
#define CQ_LD(dst, p) asm volatile("global_load_dwordx4 %0, %1, off" : "=&v"(dst) : "v"(p) : "memory")
#define CQ_WAIT(n, va, vb) asm volatile("s_waitcnt vmcnt(" #n ")" : "+v"(va[0]), "+v"(va[1]), "+v"(va[2]), "+v"(va[3]), "+v"(va[4]), "+v"(va[5]), "+v"(va[6]), "+v"(va[7]), \
        "+v"(vb[0]), "+v"(vb[1]), "+v"(vb[2]), "+v"(vb[3]), "+v"(vb[4]), "+v"(vb[5]), "+v"(vb[6]), "+v"(vb[7]) :: "memory")
#else
#define CQ_LD(dst, p) dst = *(const GAS f32x4*)(p)
#define CQ_WAIT(n, va, vb) do { } while (0)
#endif
#define CQ_FINISH(q, va, vb) do { const bool w1_ = (q) < I_E; const int r0_ = w1_ ? (q) : (q) - I_E, e_ = w1_ ? (r0_ >> 9) : (r0_ >> 8), r_ = w1_ ? (r0_ & 511) : (r0_ & 255); \
        bf16* WT_ = (w1_ ? (bf16*)(ws + WS_W1) : (bf16*)(ws + WS_W2)) + (size_t)e_ * (w1_ ? 1024 * D : D * DEXP); const int K_ = w1_ ? D : DEXP; \
        const LAS float* gk_ = (NORMFOLD && w1_) ? gkl : nullptr; transpose_finish(K_, WT_, scr, r_ >> 5, r_ & 31, F.lane, va, gk_); transpose_finish(K_, WT_, scr, r_ >> 5, (r_ & 31) + 1, F.lane, vb, gk_); } while (0)
    static_assert(I_E1 == 512 && I_F1 == 256, "shifts above");
    f32x4 a0[8], a1[8], b0[8], b1[8];
    const int step = 2 * nw;
    int qa = first + 2 * wi, qb; if (qa >= last) return;
    CQ_LOAD(qa, a0, a1);
    for (;;) {
        qb = qa + step; const bool hb = qb < last; { const int ql = hb ? qb : qa; CQ_LOAD(ql, b0, b1); }
        CQ_WAIT(16, a0, a1); CQ_FINISH(qa, a0, a1);
        if (!hb) { CQ_WAIT(0, b0, b1); break; }
        qa = qb + step; const bool ha = qa < last; { const int ql = ha ? qa : qb; CQ_LOAD(ql, a0, a1); }
        CQ_WAIT(16, b0, b1); CQ_FINISH(qb, b0, b1);
        if (!ha) { CQ_WAIT(0, a0, a1); break; }
    }
#undef CQ_WAIT
#undef CQ_LD
#undef CQ_LOAD
#undef CQ_FINISH
}
__device__ __forceinline__ void make_tables(Frame& F, const Args& A, int ti = -1, int nt_ = 0) {
    const int gt = ti >= 0 ? ti : F.vcu * (NWAVES * 64) + F.tid, NT = ti >= 0 ? nt_ : F.G * NWAVES * 64;
    float* cosT = (float*)(F.ws + WS_COS); float* sinT = (float*)(F.ws + WS_SIN); float* lbt = (float*)(F.ws + WS_LBT);
    const bool inv_fixed = (NT & 31) == 0;
    const double inv0 = exp2(-(double)(gt & 31) * (13.287712379549449 / 32.0));
    for (int idx = gt; idx < SEQ * 32; idx += NT) { const int pos = idx >> 5, i = idx & 31;
        const double inv = inv_fixed ? inv0 : exp2(-(double)i * (13.287712379549449 / 32.0));
        const double ang = (double)pos * inv; const double r = ang - 6.283185307179586476925 * rint(ang * 0.15915494309189533577);
        float s, c; sincosf((float)r, &s, &c); cosT[idx] = c; sinT[idx] = s; }
    for (int idx = gt; idx < 2 * 512; idx += NT) { const int dir = idx >> 9, col = idx & 511;
        float tv[DEPTH]; float mx = -3.0e38f;
#pragma unroll
        for (int l = 0; l < DEPTH; ++l) { tv[l] = A.in[I_LBT][(size_t)(l * 2 + dir) * 512 + col]; mx = fmaxf(mx, tv[l]); }
        float den = 0.f;
#pragma unroll
        for (int l = 0; l < DEPTH; ++l) { tv[l] = expf(tv[l] - mx); den += tv[l]; }
        float cum = 0.f;
#pragma unroll
        for (int l = 0; l < DEPTH; ++l) { if (l > 0) cum += tv[l] / den; const float lb = cum;
            lbt[((l * 2 + dir) * 2 + 0) * 512 + col] = lb; lbt[((l * 2 + dir) * 2 + 1) * 512 + col] = 0.f; } }
}
__device__ __forceinline__ void norm_rows(Frame& F, const float* xin, float* xcopy, const float* g, bf16* xn, float* rs_out = nullptr, int wi = -1, int nw = 0) {
    const int gw = wi >= 0 ? wi : F.vcu * NWAVES + F.wave, NGW = wi >= 0 ? nw : F.G * NWAVES;
    f32x4 gv[4];
#pragma unroll
    for (int j = 0; j < 4; ++j) gv[j] = *(const f32x4*)(g + 4 * F.lane + 256 * j);
    f32x4 vn[4];
    { const GAS f32x4* xr = (const GAS f32x4*)(xin + (size_t)gw * D) + F.lane;
#pragma unroll
      for (int j = 0; j < 4; ++j) vn[j] = xr[64 * j]; }
    for (int m = gw; m < T; m += NGW) {
        f32x4 v[4]; float s = 0.f;
#pragma unroll
        for (int j = 0; j < 4; ++j) { v[j] = vn[j]; s += (v[j].x * v[j].x + v[j].y * v[j].y) + (v[j].z * v[j].z + v[j].w * v[j].w); }
        if (m + NGW < T) { const GAS f32x4* xr = (const GAS f32x4*)(xin + (size_t)(m + NGW) * D) + F.lane;
#pragma unroll
            for (int j = 0; j < 4; ++j) vn[j] = xr[64 * j]; }
        const float rstd = 1.0f / sqrtf(wave_sum(s) * (1.f / D) + NORM_EPS);
        if (xcopy) { GAS f32x4* xo = (GAS f32x4*)(xcopy + (size_t)m * D) + F.lane;
#pragma unroll
            for (int j = 0; j < 4; ++j) xo[64 * j] = v[j]; }
        GAS v2u* o8 = (GAS v2u*)(xn + (size_t)m * D) + F.lane;
#pragma unroll
        for (int j = 0; j < 4; ++j) { const f32x4 y = rs_out ? v[j] : v[j] * rstd * gv[j]; v2u w; w.x = pk2(y.x, y.y); w.y = pk2(y.z, y.w); o8[64 * j] = w; }
        if (rs_out && F.lane == 0) rs_out[m] = rstd;
    }
}

__device__ __forceinline__ float row_sum16n(float v) {
#if defined(__HIP_DEVICE_COMPILE__)
#define RS_ROR(n) v += __builtin_bit_cast(float, __builtin_amdgcn_update_dpp(0, __builtin_bit_cast(int, v), 0x120 + (n), 0xf, 0xf, false))
    RS_ROR(8); RS_ROR(4); RS_ROR(2); RS_ROR(1);
#undef RS_ROR
#endif
    return v;
}
__device__ __forceinline__ void norm_rows4(Frame& F, const float* xin, const float* g, bf16* xn) {
    const int gw = F.vcu * NWAVES + F.wave, NGW = F.G * NWAVES, r = F.lane >> 4, c = F.lane & 15;
    constexpr int NTG = T / 4;
    f32x4 vq[16], gq[16];
#pragma unroll
    for (int k = 0; k < 16; ++k) gq[k] = *(const f32x4*)(g + 64 * k + 4 * c);
    if (gw < NTG) { const GAS f32x4* xr = (const GAS f32x4*)(xin + (size_t)(4 * gw + r) * D) + c;
#pragma unroll
        for (int k = 0; k < 16; ++k) vq[k] = xr[16 * k]; }
    for (int tg = gw; tg < NTG; tg += NGW) { const int m = 4 * tg + r;
        f32x4 v[16]; float s = 0.f;
#pragma unroll
        for (int k = 0; k < 16; ++k) { v[k] = vq[k]; s += (v[k].x * v[k].x + v[k].y * v[k].y) + (v[k].z * v[k].z + v[k].w * v[k].w); }
        if (tg + NGW < NTG) { const GAS f32x4* xr = (const GAS f32x4*)(xin + (size_t)(4 * (tg + NGW) + r) * D) + c;
#pragma unroll
            for (int k = 0; k < 16; ++k) vq[k] = xr[16 * k]; }
        const float rstd = 1.0f / sqrtf(row_sum16n(s) * (1.f / D) + NORM_EPS);
        GAS v2u* o8 = (GAS v2u*)(xn + (size_t)m * D) + c;
#pragma unroll
        for (int k = 0; k < 16; ++k) { const f32x4 y = v[k] * rstd * gq[k]; v2u w; w.x = pk2(y.x, y.y); w.y = pk2(y.z, y.w); o8[16 * k] = w; }
    }
}

using pg8::Unit; using pg8::cvt_pk_bf16;
__device__ __forceinline__ v4u pack8(const f32x4& a, const f32x4& b) { v4u w; w.x = cvt_pk_bf16(a[0], a[1]); w.y = cvt_pk_bf16(a[2], a[3]); w.z = cvt_pk_bf16(b[0], b[1]); w.w = cvt_pk_bf16(b[2], b[3]); return w; }
__device__ __forceinline__ void unpack8(const v4u& w, f32x4& a, f32x4& b) { a = (f32x4){bflo(w.x), bfhi(w.x), bflo(w.y), bfhi(w.y)}; b = (f32x4){bflo(w.z), bfhi(w.z), bflo(w.w), bfhi(w.w)}; }
__device__ __forceinline__ float logf_gate(float z, float lb, float nrl) {
    const float t = __builtin_amdgcn_exp2f(fabsf(z) * nrl), num = (z >= 0.f) ? __builtin_fmaf(lb, t, 1.0f) : (lb + t);
    const float r2 = __builtin_amdgcn_logf(num) - __builtin_amdgcn_logf(1.0f + t);
    return fmaxf(r2, LOGF_MIN * 1.4426950408889634f);
}
struct EpiInA {
    static constexpr bool PERM = false, AFTER_DRAIN = false;
    bf16* PA; const float* cosT; const float* sinT; const float* lbt;
    int pofs;
    const float* rs;
    __device__ __forceinline__ void operator()(const f32x4 (&acc)[2][2][4][2], const Unit& u, int wr, int wc, int fr, int fq) const {
        const int pn = u.pn + pofs, row0 = u.pm * 256 + wr * 64 + fr;
        float rsv[2][4];
#pragma unroll
        for (int ai = 0; ai < 2; ++ai)
#pragma unroll
            for (int m = 0; m < 4; ++m) rsv[ai][m] = NORMFOLD ? rs[row0 + 128 * ai + 16 * m] : 1.0f;
#pragma unroll
        for (int bj = 0; bj < 2; ++bj) {
            int mode = 0; float sc = 1.f; int lbo = 0;
            if (pn < 2) { mode = 1; sc = QSCALE; } else if (pn == 2) { mode = (bj == 0) ? 1 : 0; } else if (pn < 5) mode = 2;
            else if (pn < 7) { mode = 3; lbo = (pn - 5) * 256; } else if (pn < 9) { mode = 3; lbo = 1024 + (pn - 7) * 256; } else if (pn < 11) mode = 0; else mode = 2;
            if (mode == 1) {
                const int hb = 256 * pn + 128 * bj + 64 * (wc >> 1), d0 = 16 * (wc & 1) + 4 * fq;
#pragma unroll
                for (int ai = 0; ai < 2; ++ai) { f32x4 csv[4], snv[4];
#pragma unroll
                    for (int m = 0; m < 4; ++m) { const int pos = (row0 + 128 * ai + 16 * m) & (SEQ - 1); csv[m] = *(const f32x4*)(cosT + pos * 32 + d0); snv[m] = *(const f32x4*)(sinT + pos * 32 + d0); }
#pragma unroll
                    for (int m = 0; m < 4; ++m) { const int r = row0 + 128 * ai + 16 * m;
                        const f32x4 cs = csv[m], sn = snv[m];
                        const f32x4 x1 = acc[ai][bj][m][0], x2 = acc[ai][bj][m][1];
                        const float scr_ = sc * rsv[ai][m];
                        const f32x4 o1 = (x1 * cs - x2 * sn) * scr_, o2 = (x2 * cs + x1 * sn) * scr_;
                        bf16* rp = PA + (size_t)r * NPA + hb + d0;
                        v2u w1; w1.x = cvt_pk_bf16(o1[0], o1[1]); w1.y = cvt_pk_bf16(o1[2], o1[3]); *(v2u*)rp = w1;
                        v2u w2; w2.x = cvt_pk_bf16(o2[0], o2[1]); w2.y = cvt_pk_bf16(o2[2], o2[3]); *(v2u*)(rp + 32) = w2; }
                    asm volatile("" ::: "memory"); }
            } else {
                const int c0 = 256 * pn + 128 * bj + 32 * wc + 8 * fq;
                if (mode == 3) {
                    const float* lp = lbt + lbo + 128 * bj + 32 * wc + 8 * fq;
#pragma unroll
                    for (int n = 0; n < 2; ++n) { const f32x4 la = *(const f32x4*)(lp + 4 * n);
#pragma unroll
                        for (int ai = 0; ai < 2; ++ai)
#pragma unroll
                            for (int m = 0; m < 4; ++m) { const int r = row0 + 128 * ai + 16 * m; bf16* rp = PA + (size_t)r * NPA + c0 + 4 * n;
                                const f32x4 v = acc[ai][bj][m][n]; const float nrl = rsv[ai][m] * -1.4426950408889634f; h16x4 hv;
#pragma unroll
                                for (int j = 0; j < 4; ++j) hv[j] = (_Float16)logf_gate(v[j], la[j], nrl);
                                *(h16x4*)rp = hv; asm volatile("" ::: "memory"); } }
                } else {
#pragma unroll
                    for (int ai = 0; ai < 2; ++ai)
#pragma unroll
                        for (int m = 0; m < 4; ++m) { const int r = row0 + 128 * ai + 16 * m; bf16* rp = PA + (size_t)r * NPA + c0;
                            f32x4 v0 = acc[ai][bj][m][0], v1 = acc[ai][bj][m][1];
                            if (NORMFOLD) { const float rr = rsv[ai][m]; v0 = v0 * rr; v1 = v1 * rr; }
                            if (mode == 2) {
#pragma unroll
                                for (int j = 0; j < 4; ++j) { v0[j] = siluf_(v0[j]); v1[j] = siluf_(v1[j]); } }
                            *(v4u*)rp = pack8(v0, v1); asm volatile("" ::: "memory"); }
                }
            }
        }
    }
};
#ifndef EPI_NT
#define EPI_NT 0
#endif
#if EPI_NT
#define EPI_STORE16(p_, v_) __builtin_nontemporal_store((v_), (v4u*)(p_))
#else
#define EPI_STORE16(p_, v_) (*(v4u*)(p_) = (v_))
#endif
struct EpiGate {
    static constexpr bool PERM = false, AFTER_DRAIN = false;
    bf16* O; const float* rs;
    __device__ __forceinline__ void operator()(const f32x4 (&acc)[2][2][4][2], const Unit& u, int wr, int wc, int fr, int fq) const {
        const int row0 = u.pm * 256 + wr * 64 + fr, c0 = 256 * u.pn + 32 * wc + 8 * fq;
        float rsv[2][4];
#pragma unroll
        for (int ai = 0; ai < 2; ++ai)
#pragma unroll
            for (int m = 0; m < 4; ++m) rsv[ai][m] = NORMFOLD ? rs[row0 + 128 * ai + 16 * m] : 1.0f;
#pragma unroll
        for (int ai = 0; ai < 2; ++ai)
#pragma unroll
            for (int m = 0; m < 4; ++m) { bf16* rp = O + (size_t)(row0 + 128 * ai + 16 * m) * NGATE + c0; const float rc = rsv[ai][m] * -1.4426950408889634f;
#pragma unroll
                for (int bj = 0; bj < 2; ++bj) { f32x4 v0 = acc[ai][bj][m][0] * rc, v1 = acc[ai][bj][m][1] * rc;
#pragma unroll
                    for (int j = 0; j < 4; ++j) { v0[j] = fast_rcp(1.0f + __builtin_amdgcn_exp2f(v0[j])); v1[j] = fast_rcp(1.0f + __builtin_amdgcn_exp2f(v1[j])); }
                    EPI_STORE16(rp + 128 * bj, pack8(v0, v1)); } }
    }
};
#if defined(PROBE_KLOOP)
struct EpiNull {
    static constexpr bool PERM = false, AFTER_DRAIN = false;
    bf16* O;
    __device__ __forceinline__ void operator()(const f32x4 (&acc)[2][2][4][2], const Unit& u, int wr, int wc, int fr, int fq) const {
        float s = 0.f;
#pragma unroll
        for (int ai = 0; ai < 2; ++ai)
#pragma unroll
            for (int bj = 0; bj < 2; ++bj)
#pragma unroll
                for (int m = 0; m < 4; ++m)
#pragma unroll
                    for (int n = 0; n < 2; ++n) s += acc[ai][bj][m][n][0] + acc[ai][bj][m][n][1] + acc[ai][bj][m][n][2] + acc[ai][bj][m][n][3];
        if (s == 12345.678f) O[u.pm + wr + wc + fr + fq] = (bf16)1;
    }
};
#endif
struct EpiUpA {
    static constexpr bool PERM = false, AFTER_DRAIN = false;
    bf16* MG; const bf16* GT;
    __device__ __forceinline__ void operator()(const f32x4 (&acc)[2][2][4][2], const Unit& u, int wr, int wc, int fr, int fq) const {
        const int row0 = u.pm * 256 + wr * 64 + fr, c0 = 256 * u.pn + 32 * wc + 8 * fq;
        v4u gw[2][2][2];
#define UA_LOAD(q_, buf_) do { _Pragma("unroll") for (int mm = 0; mm < 2; ++mm) _Pragma("unroll") for (int bj = 0; bj < 2; ++bj) \
            gw[buf_][mm][bj] = *(const v4u*)(GT + (size_t)(row0 + 128 * ((q_) >> 1) + 16 * (2 * ((q_) & 1) + mm)) * NGATE + c0 + 128 * bj); } while (0)
        UA_LOAD(0, 0);
#pragma unroll
        for (int q = 0; q < 4; ++q) { const int ai = q >> 1, mh = q & 1;
            if (q < 3) UA_LOAD(q + 1, (q + 1) & 1);
            __builtin_amdgcn_sched_barrier(0);
#pragma unroll
            for (int mm = 0; mm < 2; ++mm) { const int m = 2 * mh + mm; bf16* rp = MG + (size_t)(row0 + 128 * ai + 16 * m) * D + c0;
#pragma unroll
                for (int bj = 0; bj < 2; ++bj) { f32x4 g0, g1; unpack8(gw[q & 1][mm][bj], g0, g1);
                    *(v4u*)(rp + 128 * bj) = pack8(acc[ai][bj][m][0] * g0, acc[ai][bj][m][1] * g1); } }
            __builtin_amdgcn_sched_barrier(0); }
#undef UA_LOAD
    }
};
struct EpiUpB {
    static constexpr bool PERM = false, AFTER_DRAIN = false;
    bf16* MG; const bf16* GT; const float* ssq;
    __device__ __forceinline__ void operator()(const f32x4 (&acc)[2][2][4][2], const Unit& u, int wr, int wc, int fr, int fq) const {
        const int row0 = u.pm * 256 + wr * 64 + fr, c0 = 256 * u.pn + 32 * wc + 8 * fq;
        v4u gw[2][2][2], pw[2][2][2]; f32x4 sq[2][2];
#define UB_LOAD(q_, buf_) do { _Pragma("unroll") for (int mm = 0; mm < 2; ++mm) { const int r_ = row0 + 128 * ((q_) >> 1) + 16 * (2 * ((q_) & 1) + mm); sq[buf_][mm] = *(const f32x4*)(ssq + (size_t)r_ * 4); \
            _Pragma("unroll") for (int bj = 0; bj < 2; ++bj) { gw[buf_][mm][bj] = *(const v4u*)(GT + (size_t)r_ * NGATE + 1024 + c0 + 128 * bj); pw[buf_][mm][bj] = *(const v4u*)(MG + (size_t)r_ * D + c0 + 128 * bj); } } } while (0)
        UB_LOAD(0, 0);
#pragma unroll
        for (int q = 0; q < 4; ++q) { const int ai = q >> 1, mh = q & 1;
            if (q < 3) UB_LOAD(q + 1, (q + 1) & 1);
            __builtin_amdgcn_sched_barrier(0);
#pragma unroll
            for (int mm = 0; mm < 2; ++mm) { const int m = 2 * mh + mm; bf16* rp = MG + (size_t)(row0 + 128 * ai + 16 * m) * D + c0; const f32x4 sv = sq[q & 1][mm];
                const float rstd = 1.0f / sqrtf(((sv[0] + sv[1]) + (sv[2] + sv[3])) * (1.f / 512.f) + NORM_EPS);
#pragma unroll
                for (int bj = 0; bj < 2; ++bj) { f32x4 g0, g1, p0, p1; unpack8(gw[q & 1][mm][bj], g0, g1); unpack8(pw[q & 1][mm][bj], p0, p1);
                    *(v4u*)(rp + 128 * bj) = pack8(p0 + acc[ai][bj][m][0] * g0 * rstd, p1 + acc[ai][bj][m][1] * g1 * rstd); } }
            __builtin_amdgcn_sched_barrier(0); }
#undef UB_LOAD
    }
};
struct EpiOut {
    static constexpr bool PERM = false, AFTER_DRAIN = false;
    float* X; const float* XI;
    __device__ __forceinline__ void operator()(const f32x4 (&acc)[2][2][4][2], const Unit& u, int wr, int wc, int fr, int fq) const {
        const int row0 = u.pm * 256 + wr * 64 + fr, c0 = 256 * u.pn + 32 * wc + 8 * fq;
#pragma unroll
        for (int ai = 0; ai < 2; ++ai) { f32x4 xv[4][2][2];
#pragma unroll
            for (int m = 0; m < 4; ++m)
#pragma unroll
                for (int bj = 0; bj < 2; ++bj) { const f32x4* p = (const f32x4*)(XI + (size_t)(row0 + 128 * ai + 16 * m) * D + c0 + 128 * bj); xv[m][bj][0] = p[0]; xv[m][bj][1] = p[1]; }
#pragma unroll
            for (int m = 0; m < 4; ++m)
#pragma unroll
                for (int bj = 0; bj < 2; ++bj) { f32x4* p = (f32x4*)(X + (size_t)(row0 + 128 * ai + 16 * m) * D + c0 + 128 * bj); p[0] = xv[m][bj][0] + acc[ai][bj][m][0]; p[1] = xv[m][bj][1] + acc[ai][bj][m][1]; }
            asm volatile("" ::: "memory"); }
    }
};
template <bool IN_F32> struct EpiOutB {
    static constexpr bool PERM = false, AFTER_DRAIN = false;
    bf16* XO; const void* XI;
    __device__ __forceinline__ void operator()(const f32x4 (&acc)[2][2][4][2], const Unit& u, int wr, int wc, int fr, int fq) const {
        const int row0 = u.pm * 256 + wr * 64 + fr, c0 = 256 * u.pn + 32 * wc + 8 * fq;
#pragma unroll
        for (int ai = 0; ai < 2; ++ai) { f32x4 xv[4][2][2];
#pragma unroll
            for (int m = 0; m < 4; ++m)
#pragma unroll
                for (int bj = 0; bj < 2; ++bj) { const size_t o = (size_t)(row0 + 128 * ai + 16 * m) * D + c0 + 128 * bj;
                    if constexpr (IN_F32) { const f32x4* p = (const f32x4*)((const float*)XI + o); xv[m][bj][0] = p[0]; xv[m][bj][1] = p[1]; }
                    else { const v4u w = *(const v4u*)((const bf16*)XI + o); unpack8(w, xv[m][bj][0], xv[m][bj][1]); } }
#pragma unroll
            for (int m = 0; m < 4; ++m)
#pragma unroll
                for (int bj = 0; bj < 2; ++bj) { const size_t o = (size_t)(row0 + 128 * ai + 16 * m) * D + c0 + 128 * bj;
                    *(v4u*)(XO + o) = pack8(xv[m][bj][0] + acc[ai][bj][m][0], xv[m][bj][1] + acc[ai][bj][m][1]); }
            asm volatile("" ::: "memory"); }
    }
};
struct EpiAct {
    static constexpr bool PERM = false, AFTER_DRAIN = false;
    bf16* ACT; const float* rs;
    __device__ __forceinline__ void operator()(const f32x4 (&acc)[2][2][4][2], const Unit& u, int wr, int wc, int fr, int fq) const {
        const int row0 = u.pm * 256 + wr * 64 + fr, c0 = 128 * u.pn + 16 * wc + 4 * fq;
        float rsv[2][4];
#pragma unroll
        for (int ai = 0; ai < 2; ++ai)
#pragma unroll
            for (int m = 0; m < 4; ++m) rsv[ai][m] = NORMFOLD ? rs[row0 + 128 * ai + 16 * m] : 1.0f;
#pragma unroll
        for (int ai = 0; ai < 2; ++ai)
#pragma unroll
            for (int m = 0; m < 4; ++m) { bf16* rp = ACT + (size_t)(row0 + 128 * ai + 16 * m) * DEXP + c0; const float rr = rsv[ai][m];
#pragma unroll
                for (int bj = 0; bj < 2; ++bj) { const f32x4 ag = acc[ai][bj][m][0], au = acc[ai][bj][m][1]; const f32x4 t = ag * (rr * -1.4426950408889634f), pq = ag * au; f32x4 a;
#pragma unroll
                    for (int j = 0; j < 4; ++j) a[j] = pq[j] * ((rr * rr) * fast_rcp(1.0f + __builtin_amdgcn_exp2f(t[j])));
                    const unsigned long long w64 = (unsigned long long)cvt_pk_bf16(a[0], a[1]) | ((unsigned long long)cvt_pk_bf16(a[2], a[3]) << 32);
#if MOE_HANDOFF
                    __hip_atomic_store((gu64*)(rp + 64 * bj), w64, RLX_AGENT); } }
#else
                    *(unsigned long long*)(rp + 64 * bj) = w64; } }
#endif
    }
};
struct EpiY {
    static constexpr bool PERM = false, AFTER_DRAIN = false;
    bf16* Y;
    __device__ __forceinline__ void operator()(const f32x4 (&acc)[2][2][4][2], const Unit& u, int wr, int wc, int fr, int fq) const {
        const int row0 = u.pm * 256 + wr * 64 + fr, c0 = 256 * u.pn + 32 * wc + 8 * fq;
#pragma unroll
        for (int ai = 0; ai < 2; ++ai)
#pragma unroll
            for (int m = 0; m < 4; ++m) { bf16* rp = Y + (size_t)(row0 + 128 * ai + 16 * m) * D + c0;
#pragma unroll
                for (int bj = 0; bj < 2; ++bj) *(v4u*)(rp + 128 * bj) = pack8(acc[ai][bj][m][0], acc[ai][bj][m][1]); }
    }
};

#define VLD(p) __hip_atomic_load((p), __ATOMIC_RELAXED, __HIP_MEMORY_SCOPE_AGENT)
constexpr int HIST_OFF = MISC_OFF + 256;
constexpr int SBASE_OFF = HIST_OFF + 128;
constexpr int STOT_OFF = SBASE_OFF + 128;
constexpr int BRE_OFF = STOT_OFF + 128;
static_assert(BRE_OFF + 128 <= LDS_BYTES, "LDS misc");

__device__ __forceinline__ void phase_norm_route(Frame& F, const Args& A, int l, const void* xsrc) {
    const int gw = F.vcu * NWAVES + F.wave, NGW = F.G * NWAVES, lane = F.lane;
    LAS f32x4* Wre = (LAS f32x4*)(F.lds + RING_OFF);
    volatile LAS int* hist = (volatile LAS int*)(F.lds + HIST_OFF);
    const float* w_re = A.in[I_WRE] + (size_t)l * NGRP * D * EPG;
    const float* w_rg = A.in[I_WRG] + (size_t)l * D * NGRP;
    const float* b_rg = A.in[I_BRG] + l * NGRP;
    const float* b_re = A.in[I_BRE] + l * NGRP * EPG;
    const float* gf = A.in[I_FNG] + (size_t)l * D;
    for (int idx = F.tid; idx < NGRP * D; idx += NWAVES * 64) { const int g = idx >> 10, i = idx & 1023, li = (i & 255) >> 2, jj = 4 * (i >> 8) + (i & 3);
        const f32x4 a = *(const f32x4*)(w_re + (size_t)idx * 8), b = *(const f32x4*)(w_re + (size_t)idx * 8 + 4);
        Wre[((g * 2 + 0) * 16 + jj) * 64 + li] = a; Wre[((g * 2 + 1) * 16 + jj) * 64 + li] = b; }
    if (F.tid < 32) { hist[F.tid] = 0; ((LAS float*)(F.lds + BRE_OFF))[F.tid] = b_re[F.tid]; }
    { int* stok = (int*)(F.ws + WS_STOK); for (int i = F.vcu * (NWAVES * 64) + F.tid; i < SLOT_ROWS; i += F.G * NWAVES * 64) stok[i] = 0; }
    f32x4 wgr[16], gv[4];
#pragma unroll
    for (int j = 0; j < 4; ++j) { gv[j] = *(const f32x4*)(gf + 4 * lane + 256 * j);
#pragma unroll
        for (int c = 0; c < 4; ++c) wgr[4 * j + c] = *(const f32x4*)(w_rg + (size_t)(4 * lane + 256 * j + c) * 4); }
    f32x4 brg = *(const f32x4*)b_rg;
    __syncthreads();
    bf16* XN = (bf16*)(F.ws + WS_XN);
#if XBF16
    const bf16* X = (const bf16*)xsrc;
    typedef v2u xraw_t;
#define NR_LOAD(dst, row) do { const GAS v2u* xr_ = (const GAS v2u*)(X + (size_t)(row) * D) + lane; _Pragma("unroll") for (int j = 0; j < 4; ++j) dst[j] = xr_[64 * j]; } while (0)
#define NR_CVT(w_) ((f32x4){bflo((w_).x), bfhi((w_).x), bflo((w_).y), bfhi((w_).y)})
#else
    const float* X = (const float*)xsrc;
    typedef f32x4 xraw_t;
#define NR_LOAD(dst, row) do { const GAS f32x4* xr_ = (const GAS f32x4*)(X + (size_t)(row) * D) + lane; _Pragma("unroll") for (int j = 0; j < 4; ++j) dst[j] = xr_[64 * j]; } while (0)
#define NR_CVT(w_) (w_)
#endif
    int* tok_e = (int*)(F.ws + WS_TOKE); float* tok_w = (float*)(F.ws + WS_TOKW); int* tok_r = (int*)(F.ws + WS_TOKR);
    xraw_t vn[4], vn2[4];
    NR_LOAD(vn, gw); if (gw + NGW < T) NR_LOAD(vn2, gw + NGW);
    int pe1 = 0, pe2 = 0, pr1 = 0, pr2 = 0, pm = -1; float pw1 = 0.f, pw2 = 0.f;
    for (int m = gw; m < T; m += NGW) {
        f32x4 v[4]; float s = 0.f;
#pragma unroll
        for (int j = 0; j < 4; ++j) { v[j] = NR_CVT(vn[j]); vn[j] = vn2[j]; s += (v[j].x * v[j].x + v[j].y * v[j].y) + (v[j].z * v[j].z + v[j].w * v[j].w); }
        if (m + 2 * NGW < T) NR_LOAD(vn2, m + 2 * NGW);
        if (lane == 0 && pm >= 0) { tok_e[2 * pm] = pe1; tok_e[2 * pm + 1] = pe2; tok_w[2 * pm] = pw1; tok_w[2 * pm + 1] = pw2; tok_r[2 * pm] = pr1; tok_r[2 * pm + 1] = pr2; }
        const float rstd = 1.0f / sqrtf(wave_sum(s) * (1.f / D) + NORM_EPS);
        GAS v2u* o8 = (GAS v2u*)(XN + (size_t)m * D) + lane;
        f32x4 ga = (f32x4){0.f, 0.f, 0.f, 0.f};
#pragma unroll
        for (int j = 0; j < 4; ++j) { v[j] = v[j] * rstd * gv[j]; v2u w; w.x = pk2(v[j].x, v[j].y); w.y = pk2(v[j].z, v[j].w); o8[64 * j] = w;
            ga += wgr[4 * j + 0] * v[j].x; ga += wgr[4 * j + 1] * v[j].y; ga += wgr[4 * j + 2] * v[j].z; ga += wgr[4 * j + 3] * v[j].w; }
        float gl[4];
#pragma unroll
        for (int k = 0; k < 4; ++k) gl[k] = wave_sum(ga[k]) + brg[k];
        int gt = 0; float gm = gl[0];
#pragma unroll
        for (int k = 1; k < 4; ++k) if (gl[k] > gm) { gm = gl[k]; gt = k; }
        float gden = 0.f;
#pragma unroll
        for (int k = 0; k < 4; ++k) gden += expf(gl[k] - gm);
        const float p_top = 1.0f / gden;
        gt = __builtin_amdgcn_readfirstlane(gt);
        f32x4 a0 = (f32x4){0.f, 0.f, 0.f, 0.f}, a1 = a0;
        const LAS f32x4* w0 = Wre + ((gt * 2 + 0) * 16) * 64 + lane; const LAS f32x4* w1 = Wre + ((gt * 2 + 1) * 16) * 64 + lane;
        f32x4 wa[2][4], wb[2][4];
#pragma unroll
        for (int c = 0; c < 4; ++c) { wa[0][c] = w0[c * 64]; wb[0][c] = w1[c * 64]; }
#pragma unroll
        for (int j = 0; j < 4; ++j) {
            if (j < 3) {
#pragma unroll
                for (int c = 0; c < 4; ++c) { wa[(j + 1) & 1][c] = w0[(4 * (j + 1) + c) * 64]; wb[(j + 1) & 1][c] = w1[(4 * (j + 1) + c) * 64]; } }
            __builtin_amdgcn_sched_barrier(0);
            a0 += wa[j & 1][0] * v[j].x; a1 += wb[j & 1][0] * v[j].x;
            a0 += wa[j & 1][1] * v[j].y; a1 += wb[j & 1][1] * v[j].y;
            a0 += wa[j & 1][2] * v[j].z; a1 += wb[j & 1][2] * v[j].z;
            a0 += wa[j & 1][3] * v[j].w; a1 += wb[j & 1][3] * v[j].w;
            __builtin_amdgcn_sched_barrier(0); }
        const f32x4 bl0 = *(const LAS f32x4*)(F.lds + BRE_OFF + gt * 32), bl1 = *(const LAS f32x4*)(F.lds + BRE_OFF + gt * 32 + 16);
        float el[8];
#pragma unroll
        for (int k = 0; k < 4; ++k) { el[k] = wave_sum(a0[k]) + bl0[k]; el[4 + k] = wave_sum(a1[k]) + bl1[k]; }
        int i1 = 0; float m1 = el[0];
#pragma unroll
        for (int k = 1; k < 8; ++k) if (el[k] > m1) { m1 = el[k]; i1 = k; }
        int i2 = -1; float m2 = -3.0e38f;
#pragma unroll
        for (int k = 0; k < 8; ++k) if (k != i1 && el[k] > m2) { m2 = el[k]; i2 = k; }
        const float q1 = 1.0f, q2 = expf(m2 - m1);
        const float wn1 = p_top * q1 / (q1 + q2), wn2 = p_top * q2 / (q1 + q2);
        if (lane == 0) {
            pe1 = gt * 8 + i1; pe2 = gt * 8 + i2; pw1 = wn1; pw2 = wn2; pm = m;
            pr1 = __hip_atomic_fetch_add((LAS int*)hist + pe1, 1, __ATOMIC_RELAXED, __HIP_MEMORY_SCOPE_WORKGROUP);
            pr2 = __hip_atomic_fetch_add((LAS int*)hist + pe2, 1, __ATOMIC_RELAXED, __HIP_MEMORY_SCOPE_WORKGROUP);
        }
    }
    if (lane == 0 && pm >= 0) { tok_e[2 * pm] = pe1; tok_e[2 * pm + 1] = pe2; tok_w[2 * pm] = pw1; tok_w[2 * pm + 1] = pw2; tok_r[2 * pm] = pr1; tok_r[2 * pm + 1] = pr2; }
    __syncthreads();
    if (F.tid < 32) ((int*)(F.ws + WS_WGCNT))[blockIdx.x * 32 + F.tid] = hist[F.tid];
#undef NR_LOAD
#undef NR_CVT
}
#if ROUTE4
constexpr int WGR_OFF = (BRE_OFF + 128 + 255) & ~255, GNW_OFF = WGR_OFF + 16384;
static_assert(GNW_OFF + 4096 <= LDS_BYTES, "LDS route4");
__device__ __forceinline__ float row_sum16(float v) {
#if defined(__HIP_DEVICE_COMPILE__)
#define RS_ROR(n) v += __builtin_bit_cast(float, __builtin_amdgcn_update_dpp(0, __builtin_bit_cast(int, v), 0x120 + (n), 0xf, 0xf, false))
    RS_ROR(8); RS_ROR(4); RS_ROR(2); RS_ROR(1);
#undef RS_ROR
#endif
    return v;
}
__device__ __forceinline__ void phase_norm_route4(Frame& F, const Args& A, int l, const void* xsrc) {
    const int gw = F.vcu * NWAVES + F.wave, NGW = F.G * NWAVES, lane = F.lane, r = lane >> 4, c = lane & 15;
    LAS f32x4* WE = (LAS f32x4*)(F.lds + RING_OFF); LAS f32x4* WG = (LAS f32x4*)(F.lds + WGR_OFF); LAS f32x4* GL = (LAS f32x4*)(F.lds + GNW_OFF);
    volatile LAS int* hist = (volatile LAS int*)(F.lds + HIST_OFF);
    const float* w_re = A.in[I_WRE] + (size_t)l * NGRP * D * EPG;
    const float* w_rg = A.in[I_WRG] + (size_t)l * D * NGRP;
    const float* b_rg = A.in[I_BRG] + l * NGRP;
    const float* b_re = A.in[I_BRE] + l * NGRP * EPG;
    const float* gf = A.in[I_FNG] + (size_t)l * D;
    static_assert(XBF16 == 1, "route4 reads the bf16 residual stream");
    const bf16* X = (const bf16*)xsrc;
    constexpr int NTG = T / 4;
    v2u xn[16];
    if (gw < NTG) { const GAS v2u* xr = (const GAS v2u*)(X + (size_t)(4 * gw + r) * D) + c;
#pragma unroll
        for (int k = 0; k < 16; ++k) xn[k] = xr[16 * k]; }
    {
        f32x4 ta[8], tb[8], tg2[2], tgl = (f32x4){0.f, 0.f, 0.f, 0.f};
#pragma unroll
        for (int u = 0; u < 8; ++u) { const int idx = F.tid + u * (NWAVES * 64); ta[u] = *(const GAS f32x4*)(w_re + (size_t)idx * 8); tb[u] = *(const GAS f32x4*)(w_re + (size_t)idx * 8 + 4); }
#pragma unroll
        for (int u = 0; u < 2; ++u) tg2[u] = *(const GAS f32x4*)(w_rg + (size_t)(F.tid + u * (NWAVES * 64)) * 4);
        if (F.tid < 256) tgl = *(const GAS f32x4*)(gf + 64 * (F.tid >> 4) + 4 * (F.tid & 15));
        float gs[2] = {1.0f, 1.0f};
        if (NORMFOLD) { gs[0] = gf[F.tid]; gs[1] = gf[F.tid + NWAVES * 64]; }
        __builtin_amdgcn_sched_barrier(0);
#pragma unroll
        for (int u = 0; u < 8; ++u) { const int idx = F.tid + u * (NWAVES * 64), g = idx >> 10, e = idx & 1023, k = e >> 6, cc = (e >> 2) & 15, i = e & 3; const float gg_ = gs[u & 1];
            WE[((g * 16 + k) * 8 + 2 * i) * 16 + cc] = ta[u] * gg_; WE[((g * 16 + k) * 8 + 2 * i + 1) * 16 + cc] = tb[u] * gg_; }
#pragma unroll
        for (int u = 0; u < 2; ++u) { const int e = F.tid + u * (NWAVES * 64), k = e >> 6, cc = (e >> 2) & 15, i = e & 3; WG[(k * 4 + i) * 16 + cc] = tg2[u] * gs[u]; }
        if (F.tid < 256) GL[F.tid] = tgl;
    }
    static_assert(NGRP * D == 8 * NWAVES * 64 && D == 2 * NWAVES * 64, "staging loops above");
    if (F.tid < 32) { hist[F.tid] = 0; ((LAS float*)(F.lds + BRE_OFF))[F.tid] = b_re[F.tid]; }
    { int* stok = (int*)(F.ws + WS_STOK); for (int i = F.vcu * (NWAVES * 64) + F.tid; i < SLOT_ROWS; i += F.G * NWAVES * 64) stok[i] = 0; }
    const f32x4 brg = *(const f32x4*)b_rg;
    __syncthreads();
    bf16* XN = (bf16*)(F.ws + WS_XN);
    int* tok_e = (int*)(F.ws + WS_TOKE); float* tok_w = (float*)(F.ws + WS_TOKW); int* tok_r = (int*)(F.ws + WS_TOKR);
    int pe1 = 0, pe2 = 0, pr1 = 0, pr2 = 0, pm = -1; float pw1 = 0.f, pw2 = 0.f, prs = 0.f; float* rsf = (float*)(F.ws + WS_RSF);
    for (int tg = gw; tg < NTG; tg += NGW) {
        const int m = 4 * tg + r;
        f32x4 v[16]; float s = 0.f;
#pragma unroll
        for (int k = 0; k < 16; ++k) { const v2u w = xn[k]; v[k] = (f32x4){bflo(w.x), bfhi(w.x), bflo(w.y), bfhi(w.y)}; s += (v[k].x * v[k].x + v[k].y * v[k].y) + (v[k].z * v[k].z + v[k].w * v[k].w); }
        if (tg + NGW < NTG) { const GAS v2u* xr = (const GAS v2u*)(X + (size_t)(4 * (tg + NGW) + r) * D) + c;
#pragma unroll
            for (int k = 0; k < 16; ++k) xn[k] = xr[16 * k]; }
        if (c == 0 && pm >= 0) { tok_e[2 * pm] = pe1; tok_e[2 * pm + 1] = pe2; tok_w[2 * pm] = pw1; tok_w[2 * pm + 1] = pw2; tok_r[2 * pm] = pr1; tok_r[2 * pm + 1] = pr2; if (NORMFOLD) rsf[pm] = prs; }
        const float rstd = 1.0f / sqrtf(row_sum16(s) * (1.f / D) + NORM_EPS);
        GAS v2u* o8 = (GAS v2u*)(XN + (size_t)m * D) + c;
        f32x4 ga = (f32x4){0.f, 0.f, 0.f, 0.f};
#pragma unroll
        for (int k = 0; k < 16; ++k) { const f32x4 w0 = WG[(k * 4 + 0) * 16 + c], w1 = WG[(k * 4 + 1) * 16 + c], w2 = WG[(k * 4 + 2) * 16 + c], w3 = WG[(k * 4 + 3) * 16 + c];
            if (NORMFOLD) v[k] = v[k] * rstd; else { const f32x4 gk = GL[k * 16 + c]; v[k] = v[k] * rstd * gk; } if (!NORMFOLD) { v2u w; w.x = pk2(v[k].x, v[k].y); w.y = pk2(v[k].z, v[k].w); o8[16 * k] = w; }
            ga += w0 * v[k].x; ga += w1 * v[k].y; ga += w2 * v[k].z; ga += w3 * v[k].w; }
        float gl[4];
#pragma unroll
        for (int q = 0; q < 4; ++q) gl[q] = row_sum16(ga[q]) + brg[q];
        int gt = 0; float gm = gl[0];
#pragma unroll
        for (int q = 1; q < 4; ++q) if (gl[q] > gm) { gm = gl[q]; gt = q; }
        float gden = 0.f;
#pragma unroll
        for (int q = 0; q < 4; ++q) gden += expf(gl[q] - gm);
        const float p_top = 1.0f / gden;
        f32x4 a0 = (f32x4){0.f, 0.f, 0.f, 0.f}, a1 = a0;
        const LAS f32x4* we = WE + (gt * 16) * 8 * 16 + c;
        f32x4 wb[2][8];
#pragma unroll
        for (int q = 0; q < 8; ++q) wb[0][q] = we[q * 16];
#pragma unroll
        for (int k = 0; k < 16; ++k) {
            if (k < 15) {
#pragma unroll
                for (int q = 0; q < 8; ++q) wb[(k + 1) & 1][q] = we[((k + 1) * 8 + q) * 16]; }
            __builtin_amdgcn_sched_barrier(0);
            a0 += wb[k & 1][0] * v[k].x; a1 += wb[k & 1][1] * v[k].x;
            a0 += wb[k & 1][2] * v[k].y; a1 += wb[k & 1][3] * v[k].y;
            a0 += wb[k & 1][4] * v[k].z; a1 += wb[k & 1][5] * v[k].z;
            a0 += wb[k & 1][6] * v[k].w; a1 += wb[k & 1][7] * v[k].w;
            __builtin_amdgcn_sched_barrier(0); }
        const f32x4 bl0 = *(const LAS f32x4*)(F.lds + BRE_OFF + gt * 32), bl1 = *(const LAS f32x4*)(F.lds + BRE_OFF + gt * 32 + 16);
        float el[8];
#pragma unroll
        for (int q = 0; q < 4; ++q) { el[q] = row_sum16(a0[q]) + bl0[q]; el[4 + q] = row_sum16(a1[q]) + bl1[q]; }
        int i1 = 0; float m1 = el[0];
#pragma unroll
        for (int q = 1; q < 8; ++q) if (el[q] > m1) { m1 = el[q]; i1 = q; }
        int i2 = -1; float m2 = -3.0e38f;
#pragma unroll
        for (int q = 0; q < 8; ++q) if (q != i1 && el[q] > m2) { m2 = el[q]; i2 = q; }
        const float q1 = 1.0f, q2 = expf(m2 - m1);
        const float wn1 = p_top * q1 / (q1 + q2), wn2 = p_top * q2 / (q1 + q2);
        if (c == 0) {
            pe1 = gt * 8 + i1; pe2 = gt * 8 + i2; pw1 = wn1; pw2 = wn2; pm = m; prs = rstd;
            pr1 = __hip_atomic_fetch_add((LAS int*)hist + pe1, 1, __ATOMIC_RELAXED, __HIP_MEMORY_SCOPE_WORKGROUP);
            pr2 = __hip_atomic_fetch_add((LAS int*)hist + pe2, 1, __ATOMIC_RELAXED, __HIP_MEMORY_SCOPE_WORKGROUP);
        }
    }
    if (c == 0 && pm >= 0) { tok_e[2 * pm] = pe1; tok_e[2 * pm + 1] = pe2; tok_w[2 * pm] = pw1; tok_w[2 * pm + 1] = pw2; tok_r[2 * pm] = pr1; tok_r[2 * pm + 1] = pr2; if (NORMFOLD) rsf[pm] = prs; }
    __syncthreads();
    if (F.tid < 32) ((int*)(F.ws + WS_WGCNT))[blockIdx.x * 32 + F.tid] = hist[F.tid];
}
#endif
__device__ __forceinline__ void phase_dispatch(Frame& F) {
    const int gw = F.vcu * NWAVES + F.wave, NGW = F.G * NWAVES, lane = F.lane;
    volatile LAS int* sbase = (volatile LAS int*)(F.lds + SBASE_OFF); volatile LAS int* stot = (volatile LAS int*)(F.lds + STOT_OFF);
    const int* wgcnt = (const int*)(F.ws + WS_WGCNT); int* meta = (int*)(F.ws + WS_META);
#if ROUTE_MFMA
    const int mtok = 16 * ((F.tid >> 7) * NGW + F.vcu * NWAVES + ((F.tid >> 4) & 7)) + (F.tid & 15);
#elif ROUTE4
    const int mtok = 4 * ((F.tid >> 5) * NGW + F.vcu * NWAVES + ((F.tid >> 2) & 7)) + (F.tid & 3);
#else
    const int mtok = (F.tid >> 3) * NGW + F.vcu * NWAVES + (F.tid & 7);
#endif
    int pe1 = 0, pe2 = 0, pr1 = 0, pr2 = 0; float prr = 0.f;
    if (F.tid < T / F.G) { pe1 = VLD((const int*)(F.ws + WS_TOKE) + 2 * mtok); pe2 = VLD((const int*)(F.ws + WS_TOKE) + 2 * mtok + 1); pr1 = VLD((const int*)(F.ws + WS_TOKR) + 2 * mtok); pr2 = VLD((const int*)(F.ws + WS_TOKR) + 2 * mtok + 1);
        if (NORMFOLD) prr = VLD((const float*)(F.ws + WS_RSF) + mtok); }
    {
        volatile LAS int* part = (volatile LAS int*)(F.lds + RING_OFF);
        const int e = F.tid & 31, sl = F.tid >> 5; int tot = 0, base = 0;
        for (int w = sl; w < F.G; w += 16) { const int c = wgcnt[w * 32 + e]; tot += c; if (w < (int)blockIdx.x) base += c; }
        part[sl * 32 + e] = tot; part[512 + sl * 32 + e] = base;
        __syncthreads();
        if (F.tid < 32) { int t2 = 0, b2 = 0;
#pragma unroll
            for (int k = 0; k < 16; ++k) { t2 += part[k * 32 + F.tid]; b2 += part[512 + k * 32 + F.tid]; }
            stot[F.tid] = t2; sbase[F.tid] = b2; } }
    __syncthreads();
    if (F.tid < 64) {
        const int e = F.tid & 31; const int nt = (F.tid < NEXP) ? ((stot[e] + 255) >> 8) : 0; int inc = nt;
#pragma unroll
        for (int o = 1; o < 32; o <<= 1) { const int up = __shfl_up(inc, o); if ((F.tid & 63) >= o) inc += up; }
        const int exc = inc - nt;
        if (F.tid < NEXP) { sbase[e] = sbase[e] + 256 * exc;
            if (blockIdx.x == 0) { for (int k = 0; k < nt; ++k) meta[1 + exc + k] = e; if (e == NEXP - 1) meta[0] = inc; } } }
    __syncthreads();
    int* tok_p = (int*)(F.ws + WS_TOKP); int* stok = (int*)(F.ws + WS_STOK);
    if (F.tid < T / F.G) { const int m = mtok;
        const int p1 = sbase[pe1] + pr1, p2 = sbase[pe2] + pr2;
        tok_p[2 * m] = p1; tok_p[2 * m + 1] = p2; stok[p1] = m; stok[p2] = m;
        if (NORMFOLD) { float* rss = (float*)(F.ws + WS_RSS); rss[p1] = prr; rss[p2] = prr; } }
    (void)gw; (void)lane;
}
__device__ __forceinline__ void phase_combine(Frame& F, const float* g, bool last, const void* xsrc, void* xdst) {
    const int gw = F.vcu * NWAVES + F.wave, NGW = F.G * NWAVES, lane = F.lane;
    const int* tok_p = (const int*)(F.ws + WS_TOKP); const float* tok_w = (const float*)(F.ws + WS_TOKW);
    const bf16* Y = (const bf16*)(F.ws + WS_XP); bf16* XN = (bf16*)(F.ws + WS_XN);
#if XBF16
    typedef v2u xraw_t; const bf16* X = (const bf16*)xsrc;
#define PC_CVT(w_) ((f32x4){bflo((w_).x), bfhi((w_).x), bflo((w_).y), bfhi((w_).y)})
#else
    typedef f32x4 xraw_t; const float* X = (const float*)xsrc;
#define PC_CVT(w_) (w_)
#endif
    f32x4 gv[4];
#pragma unroll
    for (int j = 0; j < 4; ++j) gv[j] = *(const f32x4*)(g + 4 * lane + 256 * j);
    float cw1, cw2, dw1 = 0.f, dw2 = 0.f; xraw_t xn_[4], xm_[4]; v2u ya_[4], yb_[4], yc_[4], yd_[4];
    { const int p1 = VLD(tok_p + 2 * gw), p2 = VLD(tok_p + 2 * gw + 1); cw1 = VLD(tok_w + 2 * gw); cw2 = VLD(tok_w + 2 * gw + 1);
      const GAS xraw_t* xr = (const GAS xraw_t*)(X + (size_t)gw * D) + lane; const GAS v2u* y1 = (const GAS v2u*)(Y + (size_t)p1 * D) + lane; const GAS v2u* y2 = (const GAS v2u*)(Y + (size_t)p2 * D) + lane;
#pragma unroll
      for (int j = 0; j < 4; ++j) { xn_[j] = xr[64 * j]; ya_[j] = y1[64 * j]; yb_[j] = y2[64 * j]; } }
    if (gw + NGW < T) { const int mn = gw + NGW; const int p1 = VLD(tok_p + 2 * mn), p2 = VLD(tok_p + 2 * mn + 1); dw1 = VLD(tok_w + 2 * mn); dw2 = VLD(tok_w + 2 * mn + 1);
      const GAS xraw_t* xr = (const GAS xraw_t*)(X + (size_t)mn * D) + lane; const GAS v2u* y1 = (const GAS v2u*)(Y + (size_t)p1 * D) + lane; const GAS v2u* y2 = (const GAS v2u*)(Y + (size_t)p2 * D) + lane;
#pragma unroll
      for (int j = 0; j < 4; ++j) { xm_[j] = xr[64 * j]; yc_[j] = y1[64 * j]; yd_[j] = y2[64 * j]; } }
    int tp1 = 0, tp2 = 0; float tw1 = 0.f, tw2 = 0.f;
    if (gw + 2 * NGW < T) { const int mn = gw + 2 * NGW; tp1 = VLD(tok_p + 2 * mn); tp2 = VLD(tok_p + 2 * mn + 1); tw1 = VLD(tok_w + 2 * mn); tw2 = VLD(tok_w + 2 * mn + 1); }
    float prsd = 0.f; f32x4 po[4]; v2u pox[4], pon[4]; int pm = -1;
#pragma unroll
    for (int j = 0; j < 4; ++j) { po[j] = (f32x4){0.f, 0.f, 0.f, 0.f}; pox[j] = (v2u){0u, 0u}; pon[j] = (v2u){0u, 0u}; }
#if XBF16
#define PC_FLUSH() do { if (pm >= 0) { if (last) { GAS f32x4* xr_ = (GAS f32x4*)(F.out + (size_t)pm * D) + lane; _Pragma("unroll") for (int j = 0; j < 4; ++j) xr_[64 * j] = po[j]; } \
        else { GAS v2u* o8_ = (GAS v2u*)(XN + (size_t)pm * D) + lane; GAS v2u* xo_ = (GAS v2u*)((bf16*)xdst + (size_t)pm * D) + lane; _Pragma("unroll") for (int j = 0; j < 4; ++j) { xo_[64 * j] = pox[j]; if (!NORMFOLD) o8_[64 * j] = pon[j]; } \
            if (NORMFOLD && lane == 0) ((float*)(F.ws + WS_RSA))[pm] = prsd; } } } while (0)
#else
#define PC_FLUSH() do { if (pm >= 0) { if (last) { GAS f32x4* xr_ = (GAS f32x4*)(F.out + (size_t)pm * D) + lane; _Pragma("unroll") for (int j = 0; j < 4; ++j) xr_[64 * j] = po[j]; } \
        else { GAS v2u* o8_ = (GAS v2u*)(XN + (size_t)pm * D) + lane; GAS f32x4* xo_ = (GAS f32x4*)((float*)xdst + (size_t)pm * D) + lane; _Pragma("unroll") for (int j = 0; j < 4; ++j) { xo_[64 * j] = po[j]; o8_[64 * j] = pon[j]; } } } } while (0)
#endif
    for (int m = gw; m < T; m += NGW) {
        const float w1 = cw1, w2 = cw2;
        f32x4 v[4]; float s = 0.f;
#pragma unroll
        for (int j = 0; j < 4; ++j) { const v2u a = ya_[j], b = yb_[j];
            const f32x4 ya = (f32x4){bflo(a.x), bfhi(a.x), bflo(a.y), bfhi(a.y)}, yb = (f32x4){bflo(b.x), bfhi(b.x), bflo(b.y), bfhi(b.y)};
            v[j] = PC_CVT(xn_[j]) + (ya * w1 + yb * w2);
            s += (v[j].x * v[j].x + v[j].y * v[j].y) + (v[j].z * v[j].z + v[j].w * v[j].w);
            xn_[j] = xm_[j]; ya_[j] = yc_[j]; yb_[j] = yd_[j]; }
        cw1 = dw1; cw2 = dw2; dw1 = tw1; dw2 = tw2;
        if (m + 2 * NGW < T) { const int mn = m + 2 * NGW;
            const GAS xraw_t* xq = (const GAS xraw_t*)(X + (size_t)mn * D) + lane; const GAS v2u* y1 = (const GAS v2u*)(Y + (size_t)tp1 * D) + lane; const GAS v2u* y2 = (const GAS v2u*)(Y + (size_t)tp2 * D) + lane;
#pragma unroll
            for (int j = 0; j < 4; ++j) { xm_[j] = xq[64 * j]; yc_[j] = y1[64 * j]; yd_[j] = y2[64 * j]; } }
        if (m + 3 * NGW < T) { const int mn = m + 3 * NGW; tp1 = VLD(tok_p + 2 * mn); tp2 = VLD(tok_p + 2 * mn + 1); tw1 = VLD(tok_w + 2 * mn); tw2 = VLD(tok_w + 2 * mn + 1); }
        PC_FLUSH();
        const float rstd = 1.0f / sqrtf(wave_sum(s) * (1.f / D) + NORM_EPS);
        pm = m;
        if (last) {
#pragma unroll
            for (int j = 0; j < 4; ++j) po[j] = v[j] * rstd * gv[j];
        } else {
            if (NORMFOLD) prsd = rstd;
#pragma unroll
            for (int j = 0; j < 4; ++j) { const f32x4 y = v[j] * rstd * gv[j]; pon[j].x = pk2(y.x, y.y); pon[j].y = pk2(y.z, y.w);
#if XBF16
                pox[j].x = pk2(v[j].x, v[j].y); pox[j].y = pk2(v[j].z, v[j].w);
#else
                po[j] = v[j];
#endif
            }
        }
    }
    PC_FLUSH();
#undef PC_FLUSH
#undef PC_CVT
}

#if defined(__HIP_DEVICE_COMPILE__)
typedef float f32x4v __attribute__((ext_vector_type(4)));
typedef short v4i16_t __attribute__((ext_vector_type(4)));
__device__ __forceinline__ f32x4 mfma16(const bf16x8& a, const bf16x8& b, const f32x4& c) { return __builtin_amdgcn_mfma_f32_16x16x32_bf16(a, b, c, 0, 0, 0); }
__device__ __forceinline__ s16x4 tr_read(const LAS unsigned char* p) { return __builtin_bit_cast(s16x4, __builtin_amdgcn_ds_read_tr16_b64_v4i16((LAS v4i16_t*)p)); }
__device__ __forceinline__ bf16x8 join8(const s16x4& a, const s16x4& b) { bf16x8 r; r[0] = a[0]; r[1] = a[1]; r[2] = a[2]; r[3] = a[3]; r[4] = b[0]; r[5] = b[1]; r[6] = b[2]; r[7] = b[3]; return r; }
__device__ __forceinline__ bf16x8 pack_frag(const float (&v)[8]) { v4u w; w.x = cvt_pk_bf16(v[0], v[1]); w.y = cvt_pk_bf16(v[2], v[3]); w.z = cvt_pk_bf16(v[4], v[5]); w.w = cvt_pk_bf16(v[6], v[7]); return __builtin_bit_cast(bf16x8, w); }
template <int N> __device__ __forceinline__ float dpp_shr_t(float v) { return __builtin_bit_cast(float, __builtin_amdgcn_update_dpp(0, __builtin_bit_cast(int, v), 0x110 + N, 0xf, 0xf, true)); }
template <int N> __device__ __forceinline__ float dpp_ror_t(float v) { return __builtin_bit_cast(float, __builtin_amdgcn_update_dpp(0, __builtin_bit_cast(int, v), 0x120 + N, 0xf, 0xf, false)); }
__device__ __forceinline__ float rowsum16(float v) { v += dpp_ror_t<8>(v); v += dpp_ror_t<4>(v); v += dpp_ror_t<2>(v); v += dpp_ror_t<1>(v); return v; }
__device__ __forceinline__ float scan16(float v) { v += dpp_shr_t<1>(v); v += dpp_shr_t<2>(v); v += dpp_shr_t<4>(v); v += dpp_shr_t<8>(v); return v; }

constexpr int AT_PITCH = 160;
constexpr int AT_KOFF = 0, AT_VOFF = 384 * AT_PITCH;
__device__ __forceinline__ void attn_stage_load(Frame& F, int unit, v4u (&st)[12]) {
    const int b = unit >> 8, kvh = (unit >> 7) & 1, Q0 = (unit & 127) * 128; const bf16* PA = (const bf16*)(F.ws + WS_PA);
#pragma unroll
    for (int k = 0; k < 12; ++k) { const int idx = F.tid + 512 * k, kv = idx / (384 * 8), r = (idx >> 3) % 384, ch = idx & 7, key = Q0 - 128 + r;
        st[k] = (v4u){0u, 0u, 0u, 0u};
        if (key >= 0 && key < SEQ) st[k] = *(const GAS v4u*)(PA + (size_t)(b * SEQ + key) * NPA + (kv ? C_VA : C_KA) + 64 * kvh + 8 * ch); }
}
__device__ __forceinline__ void attn_stage_write(Frame& F, const v4u (&st)[12]) {
    LAS unsigned char* lds = F.lds + RING_OFF;
#pragma unroll
    for (int k = 0; k < 12; ++k) { const int idx = F.tid + 512 * k, kv = idx / (384 * 8), r = (idx >> 3) % 384, ch = idx & 7;
        *(LAS v4u*)(lds + (kv ? AT_VOFF : AT_KOFF) + r * AT_PITCH + ch * 16) = st[k]; }
}
__device__ __forceinline__ void attn_unit(Frame& F, int unit, int next_unit, v4u (&st)[12], const float* sink) {
    const int b = unit >> 8, kvh = (unit >> 7) & 1, qb = unit & 127, Q0 = qb * 128;
    const bf16* PA = (const bf16*)(F.ws + WS_PA); bf16* YA = (bf16*)(F.ws + WS_Y);
    LAS unsigned char* lds = F.lds + RING_OFF;
    attn_stage_write(F, st);
    __syncthreads();
    const int lane = F.lane, w = F.wave, fr = lane & 15, g = lane >> 4, qh = 4 * kvh + (w >> 1);
    const float sk = sink[qh] * LOG2E;
    const bool edge = (qb == 0) || (qb == SEQ / 128 - 1);
    static_assert(WINDOW == 128, "interior-tile test below");
    bf16x8 qn0, qn1;
    { const bf16* qp = PA + (size_t)(b * SEQ + Q0 + 64 * (w & 1) + fr) * NPA + C_QA + 64 * qh + 8 * g; qn0 = *(const GAS bf16x8*)qp; qn1 = *(const GAS bf16x8*)(qp + 32); }
    if (next_unit >= 0) attn_stage_load(F, next_unit, st);
    v2u py[4]; bf16* pyp = YA;
#pragma unroll
    for (int dt = 0; dt < 4; ++dt) py[dt] = (v2u){0u, 0u};
    for (int qbk = 0; qbk < 4; ++qbk) {
        const int qrel = 64 * (w & 1) + 16 * qbk, q = Q0 + qrel + fr;
        const bf16x8 qf0 = qn0, qf1 = qn1;
        f32x4 s[17]; float mx = sk;
#pragma unroll
        for (int t = 0; t < 17; ++t) { const int krel = qrel + 16 * t;
            const LAS unsigned char* kp = lds + AT_KOFF + (krel + fr) * AT_PITCH + g * 16;
            f32x4 a = (f32x4){0.f, 0.f, 0.f, 0.f};
            a = mfma16(*(const LAS bf16x8*)kp, qf0, a); a = mfma16(*(const LAS bf16x8*)(kp + 64), qf1, a);
            s[t] = a; }
#define AT_MASK(t) do { _Pragma("unroll") for (int r = 0; r < 4; ++r) { const int key = Q0 - 128 + qrel + 16 * (t) + 4 * g + r; const int dlt = key - q; \
            const bool ok = (dlt >= -WINDOW) && (dlt <= WINDOW) && (key >= 0) && (key < SEQ); s[t][r] = ok ? s[t][r] : -3.0e38f; } } while (0)
        if (edge) {
#pragma unroll
            for (int t = 0; t < 17; ++t) AT_MASK(t);
        } else { AT_MASK(0); AT_MASK(16); }
#undef AT_MASK
#pragma unroll
        for (int t = 0; t < 17; ++t) mx = fmaxf(fmaxf(mx, fmaxf(s[t][0], s[t][1])), fmaxf(s[t][2], s[t][3]));
        __builtin_amdgcn_sched_barrier(0);
        if (qbk < 3) { const bf16* qp = PA + (size_t)(b * SEQ + q + 16) * NPA + C_QA + 64 * qh + 8 * g; qn0 = *(const GAS bf16x8*)qp; qn1 = *(const GAS bf16x8*)(qp + 32); }
        if (qbk > 0) {
#pragma unroll
            for (int dt = 0; dt < 4; ++dt) *(GAS v2u*)(pyp + 16 * dt) = py[dt]; }
        __builtin_amdgcn_sched_barrier(0);
        mx = fmaxf(mx, __shfl_xor(mx, 16)); mx = fmaxf(mx, __shfl_xor(mx, 32));
        float den = 0.f;
#pragma unroll
        for (int t = 0; t < 17; ++t)
#pragma unroll
            for (int r = 0; r < 4; ++r) { const float p = __builtin_amdgcn_exp2f(s[t][r] - mx); s[t][r] = p; den += p; }
        den += __shfl_xor(den, 16); den += __shfl_xor(den, 32); den += __builtin_amdgcn_exp2f(sk - mx);
        const float inv = 1.0f / den;
        f32x4 o[4];
#pragma unroll
        for (int dt = 0; dt < 4; ++dt) o[dt] = (f32x4){0.f, 0.f, 0.f, 0.f};
#pragma unroll
        for (int tp = 0; tp < 9; ++tp) { const int t0 = 2 * tp, t1 = (2 * tp + 1 < 17) ? 2 * tp + 1 : 2 * tp;
            float pv[8];
#pragma unroll
            for (int r = 0; r < 4; ++r) { pv[r] = s[t0][r]; pv[4 + r] = (2 * tp + 1 < 17) ? s[t1][r] : 0.f; }
            const bf16x8 pf = pack_frag(pv);
            const LAS unsigned char* v0 = lds + AT_VOFF + (qrel + 16 * t0 + 4 * g + (fr >> 2)) * AT_PITCH + (fr & 3) * 8;
            const LAS unsigned char* v1 = lds + AT_VOFF + (qrel + 16 * t1 + 4 * g + (fr >> 2)) * AT_PITCH + (fr & 3) * 8;
#pragma unroll
            for (int dt = 0; dt < 4; ++dt) o[dt] = mfma16(join8(tr_read(v0 + dt * 32), tr_read(v1 + dt * 32)), pf, o[dt]); }
        pyp = YA + (size_t)(b * SEQ + q) * 512 + 64 * qh + 4 * g;
#pragma unroll
        for (int dt = 0; dt < 4; ++dt) { py[dt].x = cvt_pk_bf16(o[dt][0] * inv, o[dt][1] * inv); py[dt].y = cvt_pk_bf16(o[dt][2] * inv, o[dt][3] * inv); }
    }
#pragma unroll
    for (int dt = 0; dt < 4; ++dt) *(GAS v2u*)(pyp + 16 * dt) = py[dt];
    __syncthreads();
}
constexpr int HG_PITCH = 288;
constexpr int HG_V = 0, HG_KF = 128 * HG_PITCH, HG_KB = 2 * 128 * HG_PITCH, HG_TOT = 3 * 128 * HG_PITCH;
static_assert(HG_TOT + (4 * 8 * 128 + 256) * 4 <= RING_BYTES, "hgrn LDS");
__device__ __forceinline__ void hg_load_scan8(const bf16* p8  , float (&lf)[8], float (&P)[8], float (&T)[8], int lane) {
    const h16x8 hv = *(const GAS h16x8*)p8;
#pragma unroll
    for (int jj = 0; jj < 8; ++jj) { lf[jj] = (float)hv[jj]; P[jj] = scan16(lf[jj]); T[jj] = __shfl(P[jj], (lane & 48) | 15); }
}
__device__ __forceinline__ void hg_v_load(Frame& F, int b, int h, int t0, v4u (&vst)[4]) { const bf16* PA = (const bf16*)(F.ws + WS_PA);
#pragma unroll
    for (int k = 0; k < 4; ++k) { const int idx = F.tid + 512 * k, r = idx >> 4, ch = idx & 15; vst[k] = *(const GAS v4u*)(PA + (size_t)(b * SEQ + t0 + r) * NPA + C_VH + 128 * h + 8 * ch); } }
__device__ __forceinline__ void hg_v_write(Frame& F, const v4u (&vst)[4]) { LAS unsigned char* lds = F.lds + RING_OFF;
#pragma unroll
    for (int k = 0; k < 4; ++k) { const int idx = F.tid + 512 * k, r = idx >> 4, ch = idx & 15; *(LAS v4u*)(lds + HG_V + r * HG_PITCH + ch * 16) = vst[k]; } }
__device__ __forceinline__ void ha_decay_load(Frame& F, int unit, h16x8 (&hvv)[8]) {
    const int bh = unit >> 7, n = unit & 127, b = bh >> 2, h = bh & 3, t0 = n * CH, lane = F.lane, w = F.wave, fr = lane & 15, g = lane >> 4, dir = w >> 2, dq = w & 3;
    const bf16* lp = (const bf16*)(F.ws + WS_PA) + (size_t)(b * SEQ + t0 + fr) * NPA + (dir ? C_LB : C_LF) + 128 * h + 32 * dq + 8 * g;
#pragma unroll
    for (int k = 0; k < 8; ++k) { const int j = dir ? k : (7 - k); hvv[k] = *(const GAS h16x8*)(lp + (size_t)(16 * j) * NPA); }
}
__device__ __forceinline__ void ha_unit(Frame& F, int unit, int next_unit, v4u (&vst)[4], h16x8 (&hvv)[8]) {
    const int bh = unit >> 7, n = unit & 127, b = bh >> 2, h = bh & 3, t0 = n * CH;
    const bf16* PA = (const bf16*)(F.ws + WS_PA); bf16* US = (bf16*)(F.ws + WS_US); float* HD = (float*)(F.ws + WS_HD);
    LAS unsigned char* lds = F.lds + RING_OFF;
    const int lane = F.lane, w = F.wave, fr = lane & 15, g = lane >> 4, dir = w >> 2, dq = w & 3;
    hg_v_write(F, vst);
    if (next_unit >= 0) { const int bh2 = next_unit >> 7; hg_v_load(F, bh2 >> 2, bh2 & 3, (next_unit & 127) * CH, vst); }
    float run[8];
#pragma unroll
    for (int jj = 0; jj < 8; ++jj) run[jj] = 0.f;
    __builtin_amdgcn_sched_barrier(0);
#pragma unroll
    for (int k = 0; k < 8; ++k) { const int j = dir ? k : (7 - k);
        float kv[8];
#pragma unroll
        for (int jj = 0; jj < 8; ++jj) { const float lf = (float)hvv[k][jj], P = scan16(lf), Tt = __shfl(P, (lane & 48) | 15);
            const float wi = dir ? (P - lf) : (Tt - P); kv[jj] = (1.0f - __builtin_amdgcn_exp2f(lf)) * __builtin_amdgcn_exp2f(wi + run[jj]); run[jj] += Tt; }
        *(LAS bf16x8*)(lds + (dir ? HG_KB : HG_KF) + (16 * j + fr) * HG_PITCH + (32 * dq + 8 * g) * 2) = pack_frag(kv); }
    __builtin_amdgcn_sched_barrier(0);
    if (next_unit >= 0) ha_decay_load(F, next_unit, hvv);
    __builtin_amdgcn_sched_barrier(0);
    if (fr == 0) {
#pragma unroll
        for (int jj = 0; jj < 8; ++jj) HD[((size_t)(bh * 2 + dir) * NCH + n) * 128 + 32 * dq + 8 * g + jj] = __builtin_amdgcn_exp2f(run[jj]); }
    __syncthreads();
    f32x4 acc[2][8];
#pragma unroll
    for (int mt = 0; mt < 2; ++mt)
#pragma unroll
        for (int nt = 0; nt < 8; ++nt) acc[mt][nt] = (f32x4){0.f, 0.f, 0.f, 0.f};
    const LAS unsigned char* kb = lds + (dir ? HG_KB : HG_KF) + (4 * g + (fr >> 2)) * HG_PITCH + (fr & 3) * 8;
    const LAS unsigned char* vb = lds + HG_V + (4 * g + (fr >> 2)) * HG_PITCH + (fr & 3) * 8;
#pragma unroll
    for (int ks = 0; ks < 4; ++ks) { bf16x8 af[2];
#pragma unroll
        for (int mt = 0; mt < 2; ++mt) { const LAS unsigned char* p = kb + (32 * ks) * HG_PITCH + (16 * (2 * dq + mt)) * 2; af[mt] = join8(tr_read(p), tr_read(p + 16 * HG_PITCH)); }
#pragma unroll
        for (int nt = 0; nt < 8; ++nt) { const LAS unsigned char* p = vb + (32 * ks) * HG_PITCH + (16 * nt) * 2; const bf16x8 bfr = join8(tr_read(p), tr_read(p + 16 * HG_PITCH));
#pragma unroll
            for (int mt = 0; mt < 2; ++mt) acc[mt][nt] = mfma16(af[mt], bfr, acc[mt][nt]); } }
    bf16* up = US + ((size_t)(bh * 2 + dir) * NCH + n) * 128 * 128;
#pragma unroll
    for (int mt = 0; mt < 2; ++mt)
#pragma unroll
        for (int nt = 0; nt < 8; ++nt) { v2u wv; wv.x = cvt_pk_bf16(acc[mt][nt][0], acc[mt][nt][1]); wv.y = cvt_pk_bf16(acc[mt][nt][2], acc[mt][nt][3]);
            *(GAS v2u*)(up + (size_t)(16 * nt + fr) * 128 + 16 * (2 * dq + mt) + 4 * g) = wv; }
    __syncthreads();
}
#if G1A_SPLIT
__device__ __forceinline__ void phase_hb(Frame& F, int v, int g) {
    bf16* US = (bf16*)(F.ws + WS_US); const float* HD = (const float*)(F.ws + WS_HD);
    const int stride = g * NWAVES * 64, TOT = 16 * 128 * 64;
    for (int ea = v * (NWAVES * 64) + F.tid; ea < TOT; ea += 2 * stride) {
        const bool two = G1A_SPLIT && (ea + stride < TOT); const int eb = two ? ea + stride : ea;
        const int dpa = ea & 63, ca = ea >> 13, dira = ca & 1, dpb = eb & 63, cb = eb >> 13, dirb = cb & 1;
        float a0 = 0.f, a1 = 0.f, b0 = 0.f, b1 = 0.f;
        GAS unsigned* upa = (GAS unsigned*)(US + (size_t)ca * NCH * 128 * 128 + (size_t)((ea >> 6) & 127) * 128) + dpa; const GAS pg8::f32x2_t* dda = (const GAS pg8::f32x2_t*)((const GAS float*)HD + (size_t)ca * NCH * 128) + dpa;
        GAS unsigned* upb = (GAS unsigned*)(US + (size_t)cb * NCH * 128 * 128 + (size_t)((eb >> 6) & 127) * 128) + dpb; const GAS pg8::f32x2_t* ddb = (const GAS pg8::f32x2_t*)((const GAS float*)HD + (size_t)cb * NCH * 128) + dpb;
        for (int k0 = 0; k0 < NCH; k0 += 16) {
            unsigned ua[16], ub[16]; pg8::f32x2_t da[16], db[16];
#pragma unroll
            for (int k = 0; k < 16; ++k) { const int na = dira ? (NCH - 1 - (k0 + k)) : (k0 + k), nb = dirb ? (NCH - 1 - (k0 + k)) : (k0 + k);
                ua[k] = upa[(size_t)na * (128 * 128 / 2)]; da[k] = dda[na * 64]; ub[k] = upb[(size_t)nb * (128 * 128 / 2)]; db[k] = ddb[nb * 64]; }
#pragma unroll
            for (int k = 0; k < 16; ++k) { const int na = dira ? (NCH - 1 - (k0 + k)) : (k0 + k), nb = dirb ? (NCH - 1 - (k0 + k)) : (k0 + k);
                upa[(size_t)na * (128 * 128 / 2)] = pk2(a0, a1);
                a0 = da[k].x * a0 + bflo(ua[k]); a1 = da[k].y * a1 + bfhi(ua[k]);
                if (two) upb[(size_t)nb * (128 * 128 / 2)] = pk2(b0, b1);
                b0 = db[k].x * b0 + bflo(ub[k]); b1 = db[k].y * b1 + bfhi(ub[k]); } }
    }
}
#else
__device__ __forceinline__ void phase_hb(Frame& F, int v, int g) {
    bf16* US = (bf16*)(F.ws + WS_US); const float* HD = (const float*)(F.ws + WS_HD);
    const int idx = v * (NWAVES * 64) + F.tid;
    for (int e0 = idx; e0 < 16 * 128 * 64; e0 += g * NWAVES * 64) { const int dp = e0 & 63, e = (e0 >> 6) & 127, combo = e0 >> 13, dir = combo & 1;
        float s0 = 0.f, s1 = 0.f;
        GAS unsigned* up = (GAS unsigned*)(US + (size_t)combo * NCH * 128 * 128 + (size_t)e * 128) + dp; const GAS float* dpp = (const GAS float*)HD + (size_t)combo * NCH * 128 + 2 * dp;
        for (int k0 = 0; k0 < NCH; k0 += 16) {
            unsigned u[16]; float d0[16], d1[16];
#pragma unroll
            for (int k = 0; k < 16; ++k) { const int n = dir ? (NCH - 1 - (k0 + k)) : (k0 + k); u[k] = up[(size_t)n * (128 * 128 / 2)]; d0[k] = dpp[n * 128]; d1[k] = dpp[n * 128 + 1]; }
#pragma unroll
            for (int k = 0; k < 16; ++k) { const int n = dir ? (NCH - 1 - (k0 + k)) : (k0 + k);
                up[(size_t)n * (128 * 128 / 2)] = pk2(s0, s1);
                s0 = d0[k] * s0 + bflo(u[k]); s1 = d1[k] * s1 + bfhi(u[k]); } }
    }
}
#endif
constexpr int HC_SPITCH = 272;
constexpr int HC_K = 128 * HG_PITCH, HC_S = 2 * 128 * HG_PITCH, HC_E = HC_S + 128 * HC_SPITCH;
static_assert(HC_E + 2 * 8 * 128 * 4 <= RING_BYTES, "hc LDS");
#ifndef HC_TERMS
#define HC_TERMS 7
#endif
__device__ __forceinline__ void hc_unit(Frame& F, int unit, int next_unit, v4u (&vst)[4], const float* hng) {
    const int h = unit & 3, n = (unit >> 2) & 127, b = unit >> 9, bh = b * 4 + h, t0 = n * CH;
    const bf16* PA = (const bf16*)(F.ws + WS_PA); const bf16* US = (const bf16*)(F.ws + WS_US); bf16* YH = (bf16*)(F.ws + WS_YH); float* ssq = (float*)(F.ws + WS_SSQ);
    LAS unsigned char* lds = F.lds + RING_OFF; LAS float* ebl = (LAS float*)(lds + HC_E);
    const int lane = F.lane, i = F.wave, fr = lane & 15, g = lane >> 4;
    const size_t trow = (size_t)(b * SEQ + t0 + 16 * i + fr);
    hg_v_write(F, vst);
    if (next_unit >= 0) hg_v_load(F, next_unit >> 9, next_unit & 3, ((next_unit >> 2) & 127) * CH, vst);
    const bf16* sbase0 = US + ((size_t)(bh * 2) * NCH + n) * 128 * 128;
    v4u sreg[4];
#pragma unroll
    for (int k = 0; k < 4; ++k) { const int c = F.tid + 512 * k; sreg[k] = *(const GAS v4u*)(sbase0 + (size_t)(c >> 4) * 128 + (c & 15) * 8); }
    h16x8 lfv[2][4]; v4u qwv[4];
#pragma unroll
    for (int ks = 0; ks < 4; ++ks) { lfv[0][ks] = *(const GAS h16x8*)(PA + trow * NPA + C_LF + 128 * h + 32 * ks + 8 * g); qwv[ks] = *(const GAS v4u*)(PA + trow * NPA + C_QH + 128 * h + 32 * ks + 8 * g); }
#pragma unroll
    for (int ks = 0; ks < 4; ++ks) lfv[1][ks] = *(const GAS h16x8*)(PA + trow * NPA + C_LB + 128 * h + 32 * ks + 8 * g);
    __builtin_amdgcn_sched_barrier(0);
    f32x4 o[8];
#pragma unroll
    for (int et = 0; et < 8; ++et) o[et] = (f32x4){0.f, 0.f, 0.f, 0.f};
    const LAS unsigned char* vtr = lds + HG_V + (4 * g + (fr >> 2)) * HG_PITCH + (fr & 3) * 8;
#pragma unroll
    for (int dir = 0; dir < 2; ++dir) {
        if (dir == 1) __syncthreads();
#pragma unroll
        for (int k = 0; k < 4; ++k) { const int c = F.tid + 512 * k; *(LAS v4u*)(lds + HC_S + (c >> 4) * HC_SPITCH + (c & 15) * 16) = sreg[k]; }
        float ql[32]; bf16x8 kst[4]; bf16x8 qf[4];
#pragma unroll
        for (int ks = 0; ks < 4; ++ks) { float lf[8], P[8], T[8], ke[8], kd[8], t8[8], et_[8];
            { const h16x8 hv = lfv[dir][ks];
#pragma unroll
              for (int jj = 0; jj < 8; ++jj) { lf[jj] = (float)hv[jj]; P[jj] = scan16(lf[jj]); T[jj] = __shfl(P[jj], (lane & 48) | 15); } }
            const v4u qw = qwv[ks];
            const float qv[8] = {bflo(qw.x), bfhi(qw.x), bflo(qw.y), bfhi(qw.y), bflo(qw.z), bfhi(qw.z), bflo(qw.w), bfhi(qw.w)};
#pragma unroll
            for (int jj = 0; jj < 8; ++jj) { const float kk = 1.0f - __builtin_amdgcn_exp2f(lf[jj]);
                const float binc = dir ? (T[jj] - P[jj] + lf[jj]) : P[jj];
                const float ea = __builtin_amdgcn_exp2f(binc), ra = __builtin_amdgcn_rcpf(ea); et_[jj] = __builtin_amdgcn_exp2f(T[jj]);
                ql[8 * ks + jj] = qv[jj] * ea; t8[jj] = ql[8 * ks + jj]; ke[jj] = kk * et_[jj] * ra; kd[jj] = kk * ra;
#if defined(HC_DBG) && HC_DBG >= 3
                ql[8 * ks + jj] = qv[jj]; t8[jj] = qv[jj]; kd[jj] = kk;
                if (HC_DBG == 4) kd[jj] = (32 * ks + 8 * g + jj == 0) ? 1.0f : 0.f;
                if (HC_DBG == 5) kd[jj] = (32 * ks + 8 * g + jj == 0) ? kk : 0.f;
                if (HC_DBG >= 9) kd[jj] = 0.f;
                if (HC_DBG == 8) kd[jj] = (32 * ks + 8 * g + jj == 0) ? (float)fr : 0.f;
                if (HC_DBG == 6) kd[jj] = (32 * ks + 8 * g + jj == 0) ? lf[jj] : 0.f;
                if (HC_DBG == 7) kd[jj] = (32 * ks + 8 * g + jj == 0) ? (1.0f - __expf(lf[jj])) : 0.f;
#endif
                }
            *(LAS bf16x8*)(lds + HC_K + (16 * i + fr) * HG_PITCH + (32 * ks + 8 * g) * 2) = pack_frag(ke);
            kst[ks] = pack_frag(kd); qf[ks] = pack_frag(t8);
            if (fr == 0) {
#pragma unroll
                for (int jj = 0; jj < 8; ++jj) ebl[(dir * 8 + i) * 128 + 32 * ks + 8 * g + jj] = et_[jj]; }
            __builtin_amdgcn_sched_barrier(0); }
        __syncthreads();
        if (dir == 0) {
#pragma unroll
            for (int k = 0; k < 4; ++k) { const int c = F.tid + 512 * k; sreg[k] = *(const GAS v4u*)(sbase0 + (size_t)NCH * 128 * 128 + (size_t)(c >> 4) * 128 + (c & 15) * 8); } }
        f32x4 at = (f32x4){0.f, 0.f, 0.f, 0.f};
#pragma unroll
        for (int ks = 0; ks < 4; ++ks) at = mfma16(kst[ks], qf[ks], at);
#if defined(HC_DBG) && HC_DBG >= 9
        { const float q0 = __shfl(ql[0], fr);
          for (int r = 0; r < 4; ++r) at[r] = (HC_DBG == 9) ? (float)(4 * g + r) * q0 : ((HC_DBG == 10) ? (float)(4 * g + r) : (float)fr); }
#endif
        float pend[4]; int jpend = i;
#pragma unroll
        for (int r = 0; r < 4; ++r) { const int s = 4 * g + r; const bool keep = (HC_TERMS & 1) && (dir ? (s >= fr) : (s <= fr)); pend[r] = keep ? at[r] : 0.f;
#if defined(HC_DBG) && HC_DBG == 1
            pend[r] = (dir == 0 && s == fr) ? 1.0f : 0.f;
#endif
            }
        bool have = true;
        const int nj = dir ? (7 - i) : i;
        for (int k = 0; k < nj; ++k) { const int j = dir ? (i + 1 + k) : (i - 1 - k);
            f32x4 a2 = (f32x4){0.f, 0.f, 0.f, 0.f};
            const LAS unsigned char* kp = lds + HC_K + (16 * j + fr) * HG_PITCH + g * 16;
#pragma unroll
            for (int ks = 0; ks < 4; ++ks) a2 = mfma16(*(const LAS bf16x8*)(kp + ks * 64), qf[ks], a2);
#pragma unroll
            for (int ks = 0; ks < 4; ++ks) { const LAS float* ep = ebl + (dir * 8 + j) * 128 + 32 * ks + 8 * g; float t8[8];
#pragma unroll
                for (int jj = 0; jj < 8; ++jj) { ql[8 * ks + jj] *= ep[jj]; t8[jj] = ql[8 * ks + jj]; }
                qf[ks] = pack_frag(t8); }
            if (have) { float pv[8];
#pragma unroll
                for (int r = 0; r < 4; ++r) { pv[r] = pend[r]; pv[4 + r] = (HC_TERMS & 2) ? a2[r] : 0.f; }
                const bf16x8 pf = pack_frag(pv); const LAS unsigned char* v0 = vtr + 16 * jpend * HG_PITCH; const LAS unsigned char* v1 = vtr + 16 * j * HG_PITCH;
#pragma unroll
                for (int et = 0; et < 8; ++et) o[et] = mfma16(join8(tr_read(v0 + et * 32), tr_read(v1 + et * 32)), pf, o[et]);
                have = false;
            } else {
#pragma unroll
                for (int r = 0; r < 4; ++r) pend[r] = (HC_TERMS & 2) ? a2[r] : 0.f;
                jpend = j; have = true; }
        }
        if (have) { float pv[8];
#pragma unroll
            for (int r = 0; r < 4; ++r) { pv[r] = pend[r]; pv[4 + r] = 0.f; }
            const bf16x8 pf = pack_frag(pv); const LAS unsigned char* v0 = vtr + 16 * jpend * HG_PITCH;
#pragma unroll
            for (int et = 0; et < 8; ++et) o[et] = mfma16(join8(tr_read(v0 + et * 32), tr_read(v0 + et * 32)), pf, o[et]); }
        const LAS unsigned char* sp = lds + HC_S + fr * HC_SPITCH + g * 16;
#pragma unroll
        for (int et = 0; et < 8; ++et)
#pragma unroll
            for (int ks = 0; ks < 4; ++ks) if (HC_TERMS & 4) o[et] = mfma16(*(const LAS bf16x8*)(sp + 16 * et * HC_SPITCH + ks * 64), qf[ks], o[et]);
    }
    float sq = 0.f; bf16* yp = YH + trow * 512 + 128 * h + 4 * g; const bf16* sgp = PA + trow * NPA + C_SG + 128 * h + 4 * g; const float* gp = hng + 128 * h + 4 * g;
    v2u swv[8]; f32x4 gvv[8];
#pragma unroll
    for (int et = 0; et < 8; ++et) { swv[et] = *(const GAS v2u*)(sgp + 16 * et); gvv[et] = *(const GAS f32x4*)(gp + 16 * et); }
#pragma unroll
    for (int et = 0; et < 8; ++et) { const v2u sw = swv[et]; const f32x4 gv = gvv[et]; const f32x4 ov = o[et];
        sq += (ov[0] * ov[0] + ov[1] * ov[1]) + (ov[2] * ov[2] + ov[3] * ov[3]);
        v2u wv; wv.x = cvt_pk_bf16(ov[0] * gv[0] * bflo(sw.x), ov[1] * gv[1] * bfhi(sw.x)); wv.y = cvt_pk_bf16(ov[2] * gv[2] * bflo(sw.y), ov[3] * gv[3] * bfhi(sw.y));
        *(GAS v2u*)(yp + 16 * et) = wv; }
    sq += __shfl_xor(sq, 16); sq += __shfl_xor(sq, 32);
    if (g == 0) ssq[trow * 4 + h] = sq;
    __syncthreads();
}
__device__ __forceinline__ int attn_item_unit(int i) { return (i < 256) ? i : 256 + ((i + 64) & 255); }
__device__ __forceinline__ void phase_attn(Frame& F, const float* sink) { constexpr int NU = BATCH * NKVH * (SEQ / 128); v4u st[12];
    static_assert(NU == 512, "attn_item_unit");
    if (F.vcu < NU) attn_stage_load(F, attn_item_unit(F.vcu), st);
    for (int i = F.vcu; i < NU; i += F.G) attn_unit(F, attn_item_unit(i), (i + F.G < NU) ? attn_item_unit(i + F.G) : -1, st, sink); }
__device__ __forceinline__ void phase_ha(Frame& F) { constexpr int NU = BATCH * HH * NCH; v4u vst[4]; h16x8 hvv[8];
    if (F.vcu < NU) { const int bh = F.vcu >> 7; hg_v_load(F, bh >> 2, bh & 3, (F.vcu & 127) * CH, vst); ha_decay_load(F, F.vcu, hvv); }
    for (int u = F.vcu; u < NU; u += F.G) ha_unit(F, u, (u + F.G < NU) ? u + F.G : -1, vst, hvv); }
__device__ __forceinline__ void phase_hc(Frame& F, const float* hng) {
    constexpr int NU = BATCH * NCH * HH; v4u vst[4];
    if (F.vcu < NU) hg_v_load(F, F.vcu >> 9, F.vcu & 3, ((F.vcu >> 2) & 127) * CH, vst);
    for (int u = F.vcu; u < NU; u += F.G) hc_unit(F, u, (u + F.G < NU) ? u + F.G : -1, vst, hng);
}

#if ROUTE_MFMA
constexpr int RM_PITCH = 2064, RM_ROWS0 = 63, RM_OFF1 = 132352;
static_assert(RM_ROWS0 * RM_PITCH <= LDSCTL_OFF && RM_OFF1 >= BRE_OFF + 128 && RM_OFF1 + (72 - RM_ROWS0) * RM_PITCH <= LDS_BYTES, "router LDS");
static_assert(NORMFOLD == 1 && XBF16 == 1, "the MFMA router reads the bf16 residual stream and writes no normalised copy");
__device__ __forceinline__ int rm_row(int R) { return R < RM_ROWS0 ? R * RM_PITCH : RM_OFF1 + (R - RM_ROWS0) * RM_PITCH; }
template <int N> __device__ __forceinline__ int dpp_ror_i(int v) { return __builtin_amdgcn_update_dpp(0, v, 0x120 + N, 0xf, 0xf, false); }
__device__ __forceinline__ float rowmax16(float v) { v = fmaxf(v, dpp_ror_t<8>(v)); v = fmaxf(v, dpp_ror_t<4>(v)); v = fmaxf(v, dpp_ror_t<2>(v)); v = fmaxf(v, dpp_ror_t<1>(v)); return v; }
__device__ __forceinline__ int rowmin16i(int v) { v = min(v, dpp_ror_i<8>(v)); v = min(v, dpp_ror_i<4>(v)); v = min(v, dpp_ror_i<2>(v)); v = min(v, dpp_ror_i<1>(v)); return v; }
__device__ __forceinline__ void phase_route_mfma(Frame& F, const Args& A, int l, const void* xsrc) {
    const int lane = F.lane, j = lane & 15, kg = lane >> 4, gw = F.vcu * NWAVES + F.wave, NGW = F.G * NWAVES;
    LAS unsigned char* lds = F.lds;
    volatile LAS int* hist = (volatile LAS int*)(F.lds + HIST_OFF);
    const float* w_re = A.in[I_WRE] + (size_t)l * NGRP * D * EPG;
    const float* w_rg = A.in[I_WRG] + (size_t)l * D * NGRP;
    const float* b_rg = A.in[I_BRG] + l * NGRP;
    const float* b_re = A.in[I_BRE] + l * NGRP * EPG;
    const float* gf = A.in[I_FNG] + (size_t)l * D;
    {
        const int k0 = 2 * F.tid;
        f32x4 we[4][4];
#pragma unroll
        for (int g = 0; g < 4; ++g) { const GAS f32x4* p = (const GAS f32x4*)(w_re + ((size_t)g * D + k0) * 8);
#pragma unroll
            for (int q = 0; q < 4; ++q) we[g][q] = p[q]; }
        const f32x4 wg0 = *(const GAS f32x4*)(w_rg + (size_t)k0 * 4), wg1 = *(const GAS f32x4*)(w_rg + (size_t)(k0 + 1) * 4);
        const float g0 = gf[k0], g1 = gf[k0 + 1];
        __builtin_amdgcn_sched_barrier(0);
#pragma unroll
        for (int n = 0; n < 36; ++n) {
            const float a = (n < 32 ? we[n >> 3][(n & 7) >> 2][n & 3] : wg0[n & 3]) * g0, b = (n < 32 ? we[n >> 3][2 + ((n & 7) >> 2)][n & 3] : wg1[n & 3]) * g1;
            const unsigned hi = cvt_pk_bf16(a, b), lo = cvt_pk_bf16(a - bflo(hi), b - bfhi(hi));
            *(LAS unsigned*)(lds + rm_row(n) + k0 * 2) = hi; *(LAS unsigned*)(lds + rm_row(36 + n) + k0 * 2) = lo; }
    }
    if (F.tid < 32) hist[F.tid] = 0;
    { int* stok = (int*)(F.ws + WS_STOK); for (int i = F.vcu * (NWAVES * 64) + F.tid; i < SLOT_ROWS; i += F.G * NWAVES * 64) stok[i] = 0; }
    const float bias0 = b_re[j], bias1 = b_re[16 + j], bias2 = b_rg[j & 3];
    int ra[2][3];
#pragma unroll
    for (int sp = 0; sp < 2; ++sp)
#pragma unroll
        for (int nt = 0; nt < 3; ++nt) ra[sp][nt] = rm_row(sp * 36 + (nt < 2 ? 16 * nt + j : 32 + (j & 3))) + kg * 16;
    const bf16* X = (const bf16*)xsrc;
    int* tok_e = (int*)(F.ws + WS_TOKE); float* tok_w = (float*)(F.ws + WS_TOKW); int* tok_r = (int*)(F.ws + WS_TOKR); float* rsf = (float*)(F.ws + WS_RSF);
    bool first = true;
    for (int tt = gw; tt < T / 16; tt += NGW) {
        bf16x8 xa[32];
        { const bf16* xp = X + (size_t)(16 * tt + j) * D + 8 * kg;
#pragma unroll
          for (int ks = 0; ks < 32; ++ks) xa[ks] = *(const GAS bf16x8*)(xp + 32 * ks); }
        if (first) { __syncthreads(); first = false; }
        float ssq = 0.f; f32x4 acc[3];
#pragma unroll
        for (int nt = 0; nt < 3; ++nt) acc[nt] = (f32x4){0.f, 0.f, 0.f, 0.f};
#pragma unroll
        for (int ks = 0; ks < 32; ++ks) { const v4u xw = __builtin_bit_cast(v4u, xa[ks]);
            { const float e0 = bflo(xw.x), e1 = bfhi(xw.x), e2 = bflo(xw.y), e3 = bfhi(xw.y), e4 = bflo(xw.z), e5 = bfhi(xw.z), e6 = bflo(xw.w), e7 = bfhi(xw.w);
              ssq += ((e0 * e0 + e1 * e1) + (e2 * e2 + e3 * e3)) + ((e4 * e4 + e5 * e5) + (e6 * e6 + e7 * e7)); }
#pragma unroll
            for (int sp = 0; sp < 2; ++sp)
#pragma unroll
                for (int nt = 0; nt < 3; ++nt) acc[nt] = mfma16(xa[ks], *(const LAS bf16x8*)(lds + ra[sp][nt] + ks * 64), acc[nt]); }
        ssq += __shfl_xor(ssq, 16); ssq += __shfl_xor(ssq, 32);
        const float rstdA = 1.0f / sqrtf(ssq * (1.f / D) + NORM_EPS);
#pragma unroll
        for (int r = 0; r < 4; ++r) { const int m = 16 * tt + 4 * kg + r; const float rs = __shfl(rstdA, 4 * kg + r);
            const float glv = acc[2][r] * rs + bias2;
            const float gm = rowmax16(glv); const int gt = rowmin16i(glv == gm ? (j & 3) : 99);
            const float p_top = 4.0f / rowsum16(expf(glv - gm));
            const bool hiT = (gt >> 1) != 0, valid = ((j >> 3) == (gt & 1));
            const float ev = (hiT ? acc[1][r] : acc[0][r]) * rs + (hiT ? bias1 : bias0);
            const float ev1 = valid ? ev : -3.0e38f; const float m1 = rowmax16(ev1); const int i1 = rowmin16i(ev1 == m1 ? (j & 7) : 99);
            const float ev2 = (valid && (j & 7) != i1) ? ev : -3.0e38f; const float m2 = rowmax16(ev2); const int i2 = rowmin16i(ev2 == m2 ? (j & 7) : 99);
            const float q2 = expf(m2 - m1), wn1 = p_top / (1.0f + q2), wn2 = p_top * q2 / (1.0f + q2);
            if (j == 0) { const int e1 = gt * 8 + i1, e2 = gt * 8 + i2;
                const int r1 = __hip_atomic_fetch_add((LAS int*)hist + e1, 1, __ATOMIC_RELAXED, __HIP_MEMORY_SCOPE_WORKGROUP);
                const int r2 = __hip_atomic_fetch_add((LAS int*)hist + e2, 1, __ATOMIC_RELAXED, __HIP_MEMORY_SCOPE_WORKGROUP);
                tok_e[2 * m] = e1; tok_e[2 * m + 1] = e2; tok_w[2 * m] = wn1; tok_w[2 * m + 1] = wn2; tok_r[2 * m] = r1; tok_r[2 * m + 1] = r2; rsf[m] = rs; } }
    }
    if (first) __syncthreads();
    __syncthreads();
    if (F.tid < 32) ((int*)(F.ws + WS_WGCNT))[blockIdx.x * 32 + F.tid] = hist[F.tid];
}
#endif
#else
__device__ void phase_attn(Frame& F, const float* sink);
__device__ void phase_ha(Frame& F);
__device__ void phase_hb(Frame& F, int v, int g);
__device__ void phase_hc(Frame& F, const float* hng);
#if ROUTE_MFMA
__device__ void phase_route_mfma(Frame& F, const Args& A, int l, const void* xsrc);
#endif
#endif


#if defined(ORACLE)
__global__ void __launch_bounds__(256) simple_attn(const bf16* PA, const float* sink, bf16* YA) {
    const int lane = threadIdx.x & 63, task = blockIdx.x * 4 + (threadIdx.x >> 6);
    const int m = task >> 3, qh = task & 7, kvh = qh >> 2, b = m / SEQ, t = m % SEQ;
    float q[64];
    { const bf16* qp = PA + (size_t)m * NPA + C_QA + 64 * qh;
#pragma unroll
      for (int d = 0; d < 64; ++d) q[d] = bf2f(qp[d]); }
    float s[5]; float mx = sink[qh] * LOG2E;
#pragma unroll
    for (int r = 0; r < 5; ++r) { const int j = t - WINDOW + 64 * r + lane; const bool ok = (j >= 0) && (j < SEQ) && (j <= t + WINDOW);
        float a = -3.0e38f;
        if (ok) { const bf16* kp = PA + (size_t)(b * SEQ + j) * NPA + C_KA + 64 * kvh; a = 0.f;
#pragma unroll
            for (int d = 0; d < 64; ++d) a += q[d] * bf2f(kp[d]); }
        s[r] = a; mx = fmaxf(mx, a); }
#pragma unroll
    for (int o = 1; o < 64; o <<= 1) mx = fmaxf(mx, __shfl_xor(mx, o));
    float den = 0.f;
#pragma unroll
    for (int r = 0; r < 5; ++r) { s[r] = (s[r] > -1.0e38f) ? exp2f(s[r] - mx) : 0.f; den += s[r]; }
    den = wave_sum(den) + exp2f(sink[qh] * LOG2E - mx);
    float o = 0.f;
    for (int r = 0; r < 5; ++r) for (int jj = 0; jj < 64; ++jj) { const int j = t - WINDOW + 64 * r + jj; const float p = __shfl(s[r], jj);
        if (j >= 0 && j < SEQ && j <= t + WINDOW) o += p * bf2f(PA[(size_t)(b * SEQ + j) * NPA + C_VA + 64 * kvh + lane]); }
#if defined(ABL_NOATTN)
    YA[(size_t)m * 512 + 64 * qh + lane] = 0;
#else
    YA[(size_t)m * 512 + 64 * qh + lane] = (bf16)f2bf(o / den);
#endif
}
__global__ void __launch_bounds__(512) simple_hgrn(const bf16* PA, const float* hng, float* obuf, bf16* YH, float* ssq) {
    __shared__ float part[32][4][128];
    const int tid = threadIdx.x, e = tid & 127, dq = tid >> 7, b = blockIdx.x >> 2, h = blockIdx.x & 3;
    for (int dir = 0; dir < 2; ++dir) {
        float S[32];
#pragma unroll
        for (int d = 0; d < 32; ++d) S[d] = 0.f;
        for (int t0 = 0; t0 < SEQ; t0 += 32) {
            for (int tt = 0; tt < 32; ++tt) { const int t = dir ? (SEQ - 1 - (t0 + tt)) : (t0 + tt); const bf16* row = PA + (size_t)(b * SEQ + t) * NPA;
                const float v = bf2f(row[C_VH + 128 * h + e]); const _Float16* lf = (const _Float16*)(row + (dir ? C_LB : C_LF) + 128 * h + 32 * dq); const bf16* qp = row + C_QH + 128 * h + 32 * dq;
                float o = 0.f;
#pragma unroll
                for (int d = 0; d < 32; ++d) { const float l = (float)lf[d], f = expf(l), k = -expm1f(l); S[d] = f * S[d] + k * v; o += S[d] * bf2f(qp[d]); }
                part[tt][dq][e] = o; }
            __syncthreads();
            for (int idx = tid; idx < 32 * 128; idx += 512) { const int tt = idx >> 7, ee = idx & 127; const int t = dir ? (SEQ - 1 - (t0 + tt)) : (t0 + tt); const size_t m = (size_t)b * SEQ + t;
                float o = (part[tt][0][ee] + part[tt][1][ee]) + (part[tt][2][ee] + part[tt][3][ee]);
                if (dir == 0) obuf[m * 512 + 128 * h + ee] = o;
                else { o += obuf[m * 512 + 128 * h + ee];
                    const float sg = bf2f(PA[m * NPA + C_SG + 128 * h + ee]);
#if defined(ABL_NOHGRN)
                    YH[m * 512 + 128 * h + ee] = 0;
#else
                    YH[m * 512 + 128 * h + ee] = (bf16)f2bf(o * hng[128 * h + ee] * sg);
#endif

                    const float q = wave_sum(o * o);
                    if ((tid & 63) == 0) atomicAdd(&ssq[m * 4 + h], q); } }
            __syncthreads();
        }
    }
}
__global__ void zero_f32(float* p, int n) { const int i = blockIdx.x * blockDim.x + threadIdx.x; if (i < n) p[i] = 0.f; }
#endif

#if defined(CHECK)
#define CK_NS 48
__device__ __forceinline__ int ck_row(int s) { return (int)(((long)s * 10007 + 77) % T); }
__device__ __forceinline__ bool ck_cmp(float got, float ref, float rtol, float atol, unsigned* cnt) { const float d = fabsf(got - ref); if (!(d <= rtol * fabsf(ref) + atol)) { atomicAdd(cnt, 1u); return true; } return false; }
__global__ void ck_norm(const float* x, const float* g, const bf16* XN, unsigned* cnt) {
    const int m = ck_row(blockIdx.x); __shared__ float red[256];
    float s = 0.f; for (int c = threadIdx.x; c < D; c += 256) { const float v = x[(size_t)m * D + c]; s += v * v; }
    red[threadIdx.x] = s; __syncthreads(); for (int o = 128; o > 0; o >>= 1) { if (threadIdx.x < o) red[threadIdx.x] += red[threadIdx.x + o]; __syncthreads(); }
    const float rstd = 1.0f / sqrtf(red[0] / D + NORM_EPS);
    for (int c = threadIdx.x; c < D; c += 256) ck_cmp(bf2f(XN[(size_t)m * D + c]), x[(size_t)m * D + c] * rstd * g[c], 0.01f, 0.01f, cnt);
}
__global__ void ck_pa(const bf16* XN, const float* w_in, const float* lb_tab  , int l, const bf16* PA, unsigned* cnt) {
    const int m = ck_row(blockIdx.x), pos = m % SEQ; __shared__ float z[NPA]; __shared__ float xr[D];
    for (int c = threadIdx.x; c < D; c += 256) xr[c] = bf2f(XN[(size_t)m * D + c]);
    __syncthreads();
    for (int c = threadIdx.x; c < NPA; c += 256) { float a = 0.f; for (int k = 0; k < D; ++k) a += xr[k] * w_in[(size_t)k * INW + c]; z[c] = a; }
    __syncthreads();
    for (int c = threadIdx.x; c < NPA; c += 256) {
        const float got_b = bf2f(PA[(size_t)m * NPA + c]); const float got_h = (float)((const _Float16*)PA)[(size_t)m * NPA + c];
        if (c < C_VA) { const int d = c & 63, i = d & 31; const double inv = exp2(-(double)i * (13.287712379549449 / 32.0)); const float cs = (float)cos((double)pos * inv), sn = (float)sin((double)pos * inv);
            const float x1 = z[(c & ~63) + i], x2 = z[(c & ~63) + i + 32]; float r = (d < 32) ? (x1 * cs - x2 * sn) : (x2 * cs + x1 * sn); if (c < C_KA) r *= QSCALE;
            ck_cmp(got_b, r, 0.02f, 0.03f, cnt + 0);
        } else if (c < C_QH) ck_cmp(got_b, z[c], 0.02f, 0.02f, cnt + 1);
        else if (c < C_LF) ck_cmp(got_b, z[c] / (1.f + expf(-z[c])), 0.02f, 0.02f, cnt + 2);
        else if (c < C_VH) { const int dir = (c >= C_LB), col = c - (dir ? C_LB : C_LF);
            float t0 = lb_tab[(0 * 2 + dir) * 512 + col], t1 = lb_tab[(1 * 2 + dir) * 512 + col]; const float mx = fmaxf(t0, t1); t0 = expf(t0 - mx); t1 = expf(t1 - mx);
            const float lb = (l == 0) ? 0.f : t1 / (t0 + t1); const float sg = 1.f / (1.f + expf(-z[c])); const float r = fmaxf(logf(lb + (1.f - lb) * sg), LOGF_MIN);
            ck_cmp(got_h, r, 0.01f, 0.02f, cnt + 3);
        } else if (c < C_SG) ck_cmp(got_b, z[c], 0.02f, 0.02f, cnt + 4);
        else ck_cmp(got_b, z[c] / (1.f + expf(-z[c])), 0.02f, 0.02f, cnt + 5);
    }
}
__global__ void ck_mix(const bf16* XN, const float* w_in, const bf16* YA, const bf16* YH, const float* ssq, const float* wua, const float* wuh, const bf16* GT, const bf16* MG, int which, unsigned* cnt) {
#ifndef CK_SHIFT
#define CK_SHIFT 0
#endif
    const int m = ck_row((blockIdx.x + CK_SHIFT) % CK_NS); __shared__ float xr[D]; __shared__ float ya[512]; __shared__ float yh[512];
    for (int c = threadIdx.x; c < D; c += 256) xr[c] = bf2f(XN[(size_t)m * D + c]);
    for (int c = threadIdx.x; c < 512; c += 256) { ya[c] = bf2f(YA[(size_t)m * 512 + c]); yh[c] = bf2f(YH[(size_t)m * 512 + c]); }
    __syncthreads();
    const float rstd = 1.0f / sqrtf((ssq[m * 4] + ssq[m * 4 + 1] + ssq[m * 4 + 2] + ssq[m * 4 + 3]) / 512.f + NORM_EPS);
    for (int c = threadIdx.x; c < D; c += 256) { float a = 0.f, b = 0.f, p = 0.f, q = 0.f;
        for (int k = 0; k < D; ++k) { a += xr[k] * w_in[(size_t)k * INW + NPA + c]; b += xr[k] * w_in[(size_t)k * INW + NPA + 1024 + c]; }
        for (int k = 0; k < 512; ++k) { p += ya[k] * wua[(size_t)k * D + c]; q += yh[k] * wuh[(size_t)k * D + c]; }
        float ga = 1.f / (1.f + expf(-a)), gb = 1.f / (1.f + expf(-b));
        if (which != 0) { ga = bf2f(GT[(size_t)m * NGATE + c]); gb = bf2f(GT[(size_t)m * NGATE + 1024 + c]); }
        if (which == 0) { unsigned* dbg = cnt + 100; if (blockIdx.x == 27) { const float e0 = fabsf(bf2f(GT[(size_t)m * NGATE + c]) - ga), e1 = fabsf(bf2f(GT[(size_t)m * NGATE + 1024 + c]) - gb); atomicMax(dbg + 200, __float_as_uint(e0)); atomicMax(dbg + 200, __float_as_uint(e1)); atomicMax(dbg + 201, __float_as_uint(fabsf(a))); atomicMax(dbg + 201, __float_as_uint(fabsf(b))); if (GT[(size_t)m * NGATE + c] == 0xFFFFu) atomicAdd(dbg + 203, 1u); if (GT[(size_t)m * NGATE + 1024 + c] == 0xFFFFu) atomicAdd(dbg + 203, 1u); if (e0 > 0.2f) { atomicAdd(dbg + 202, 1u); atomicOr(dbg + 210 + (c >> 11), 0u); atomicAdd(dbg + 300 + (c >> 6), 1u); } if (e1 > 0.2f) { atomicAdd(dbg + 202, 1u); atomicAdd(dbg + 300 + 16 + (c >> 6), 1u); } } if (ck_cmp(bf2f(GT[(size_t)m * NGATE + c]), ga, 0.01f, 0.01f, cnt + 0)) { atomicAdd(dbg + blockIdx.x, 1u); atomicAdd(dbg + 64 + (c >> 5), 1u); } if (ck_cmp(bf2f(GT[(size_t)m * NGATE + 1024 + c]), gb, 0.01f, 0.01f, cnt + 0)) { atomicAdd(dbg + blockIdx.x, 1u); atomicAdd(dbg + 64 + 32 + (c >> 5), 1u); } }
        else if (which == 1) ck_cmp(bf2f(MG[(size_t)m * D + c]), ga * p, 0.03f, 0.01f, cnt + 1);
        else ck_cmp(bf2f(MG[(size_t)m * D + c]), ga * p + gb * rstd * q, 0.03f, 0.02f, cnt + 2); }
}
__global__ void ck_out(const float* xprev, const bf16* MG, const float* wout, const float* X, unsigned* cnt) {
    const int m = ck_row(blockIdx.x); __shared__ float mg[D];
    for (int c = threadIdx.x; c < D; c += 256) mg[c] = bf2f(MG[(size_t)m * D + c]);
    __syncthreads();
    for (int c = threadIdx.x; c < D; c += 256) { float a = 0.f; for (int k = 0; k < D; ++k) a += mg[k] * wout[(size_t)k * D + c]; ck_cmp(X[(size_t)m * D + c], xprev[(size_t)m * D + c] + a, 0.01f, 0.02f, cnt); }
}
__global__ void ck_moe(const float* X, const float* g, const float* wrg, const float* brg, const float* wre, const float* bre, const float* weg, const float* weu, const float* wed,
                       const bf16* XN, const int* tok_e, const float* tok_w, const int* tok_p, const int* meta, const bf16* XP, const bf16* ACT, const bf16* Y, int stage, unsigned* cnt) {
    const int m = ck_row(blockIdx.x); __shared__ float h[D]; __shared__ float red[256]; __shared__ float lg[36]; __shared__ float act[DEXP];
    float s = 0.f; for (int c = threadIdx.x; c < D; c += 256) { const float v = X[(size_t)m * D + c]; s += v * v; }
    red[threadIdx.x] = s; __syncthreads(); for (int o = 128; o > 0; o >>= 1) { if (threadIdx.x < o) red[threadIdx.x] += red[threadIdx.x + o]; __syncthreads(); }
    const float rstd = 1.0f / sqrtf(red[0] / D + NORM_EPS);
    for (int c = threadIdx.x; c < D; c += 256) h[c] = X[(size_t)m * D + c] * rstd * g[c];
    __syncthreads();
    if (threadIdx.x < 36) { const int t = threadIdx.x; float a = 0.f;
        if (t < 4) { for (int k = 0; k < D; ++k) a += h[k] * wrg[k * 4 + t]; a += brg[t]; } else { const int gg = (t - 4) >> 3, e = (t - 4) & 7; for (int k = 0; k < D; ++k) a += h[k] * wre[((size_t)gg * D + k) * 8 + e]; a += bre[gg * 8 + e]; }
        lg[t] = a; }
    __syncthreads();
    int gt = 0; for (int k = 1; k < 4; ++k) if (lg[k] > lg[gt]) gt = k;
    float gden = 0.f; for (int k = 0; k < 4; ++k) gden += expf(lg[k] - lg[gt]);
    const float* el = lg + 4 + gt * 8; int i1 = 0; for (int k = 1; k < 8; ++k) if (el[k] > el[i1]) i1 = k; int i2 = (i1 == 0) ? 1 : 0; for (int k = 0; k < 8; ++k) if (k != i1 && el[k] > el[i2]) i2 = k;
    const float q2 = expf(el[i2] - el[i1]); const float w1 = (1.f / gden) / (1.f + q2), w2 = (1.f / gden) * q2 / (1.f + q2);
    const int e1 = gt * 8 + i1, e2 = gt * 8 + i2;
    if (stage == 0) { if (threadIdx.x == 0) { if (tok_e[2 * m] != e1 || tok_e[2 * m + 1] != e2) atomicAdd(cnt + 0, 1u); ck_cmp(tok_w[2 * m], w1, 0.01f, 1e-3f, cnt + 1); ck_cmp(tok_w[2 * m + 1], w2, 0.01f, 1e-3f, cnt + 1); } return; }
    for (int kk = 0; kk < 2; ++kk) { const int e = tok_e[2 * m + kk], p = tok_p[2 * m + kk];
        if (stage == 1) { if (threadIdx.x == 0) { const int rt = p >> 8; if (rt >= meta[0] || meta[1 + rt] != e) atomicAdd(cnt + 2, 1u); }
            for (int c = threadIdx.x; c < D; c += 256) if (XP[(size_t)p * D + c] != XN[(size_t)m * D + c]) atomicAdd(cnt + 3, 1u); continue; }
        const float* wg = weg + (size_t)e * D * DEXP; const float* wu = weu + (size_t)e * D * DEXP; const float* wd = wed + (size_t)e * DEXP * D;
        __syncthreads();
        for (int j = threadIdx.x; j < DEXP; j += 256) { float a = 0.f, b = 0.f; for (int k = 0; k < D; ++k) { const float hv = bf2f(XN[(size_t)m * D + k]); a += hv * wg[(size_t)k * DEXP + j]; b += hv * wu[(size_t)k * DEXP + j]; }
            const float r = a / (1.f + expf(-a)) * b; act[j] = r; if (stage == 2) ck_cmp(bf2f(ACT[(size_t)p * DEXP + j]), r, 0.03f, 0.02f, cnt + 4); }
        __syncthreads();
        if (stage == 3) for (int c = threadIdx.x; c < D; c += 256) { float a = 0.f; for (int j = 0; j < DEXP; ++j) a += act[j] * wd[(size_t)j * D + c]; ck_cmp(bf2f(Y[(size_t)p * D + c]), a, 0.03f, 0.03f, cnt + 5); }
    }
}

__global__ void ck_attn(const bf16* PA, const float* sink, const bf16* YA, unsigned* cnt) {
    const int m = ck_row(blockIdx.x), b = m / SEQ, t = m % SEQ; __shared__ float sc[512]; __shared__ float red[256];
    for (int qh = 0; qh < NQH; ++qh) { const int kvh = qh / 4;
        const bf16* qp = PA + (size_t)m * NPA + C_QA + 64 * qh;
        for (int jj = threadIdx.x; jj < 2 * WINDOW + 1; jj += 256) { const int j = t - WINDOW + jj; float a = -1e30f;
            if (j >= 0 && j < SEQ) { a = 0.f; const bf16* kp = PA + (size_t)(b * SEQ + j) * NPA + C_KA + 64 * kvh; for (int d = 0; d < 64; ++d) a += bf2f(qp[d]) * bf2f(kp[d]); a *= 0.6931471805599453f; }
            sc[jj] = a; }
        __syncthreads();
        float mx = sink[qh]; for (int jj = 0; jj < 2 * WINDOW + 1; ++jj) mx = fmaxf(mx, sc[jj]);
        float den = expf(sink[qh] - mx); for (int jj = 0; jj < 2 * WINDOW + 1; ++jj) den += expf(sc[jj] - mx);
        if (threadIdx.x < 64) { const int d = threadIdx.x; float o = 0.f; for (int jj = 0; jj < 2 * WINDOW + 1; ++jj) { const int j = t - WINDOW + jj; if (j >= 0 && j < SEQ) o += expf(sc[jj] - mx) * bf2f(PA[(size_t)(b * SEQ + j) * NPA + C_VA + 64 * kvh + d]); }
            ck_cmp(bf2f(YA[(size_t)m * 512 + 64 * qh + d]), o / den, 0.03f, 0.005f, cnt); }
        __syncthreads(); }
}
__global__ void ck_hgrn(const bf16* PA, const float* hng, const bf16* YH, const float* ssq, unsigned* cnt) {
    const int m = ck_row(blockIdx.x), b = m / SEQ, t = m % SEQ, h = blockIdx.y; __shared__ float wgt[128]; __shared__ float osum[128]; __shared__ float cum[128];
    const int e = threadIdx.x;
    float o = 0.f;
    for (int dir = 0; dir < 2; ++dir) { cum[e] = 0.f; __syncthreads();
        for (int n = 0; n < 768; ++n) { const int s = dir ? t + n : t - n; if (s < 0 || s >= SEQ) break;
            const bf16* row = PA + (size_t)(b * SEQ + s) * NPA; const bf16* rowt = PA + (size_t)m * NPA;
            { const int d = e; const float lf = (float)((const _Float16*)(row + (dir ? C_LB : C_LF) + 128 * h))[d];
              wgt[d] = bf2f(rowt[C_QH + 128 * h + d]) * (-expm1f(lf)) * expf(cum[d]);
#if defined(HC_DBG) && HC_DBG >= 3
              wgt[d] = bf2f(rowt[C_QH + 128 * h + d]) * (-expm1f(lf));
              if (HC_DBG == 4) wgt[d] = (d == 0) ? bf2f(rowt[C_QH + 128 * h]) : 0.f;
              if (HC_DBG == 5 || HC_DBG == 7) wgt[d] = (d == 0) ? wgt[d] : 0.f;
              if (HC_DBG == 10) wgt[d] = (d == 0) ? (float)(s & 15) : 0.f;
              if (HC_DBG == 11) wgt[d] = (d == 0) ? (float)(t & 15) : 0.f;
              if (HC_DBG == 8 || HC_DBG == 9) wgt[d] = (d == 0) ? bf2f(rowt[C_QH + 128 * h]) * (float)(s & 15) : 0.f;
              if (HC_DBG == 6) wgt[d] = (d == 0) ? bf2f(rowt[C_QH + 128 * h]) * lf : 0.f;
#endif
            }
            __syncthreads();
            float w = 0.f; for (int d = 0; d < 128; ++d) w += wgt[d];
#if defined(HC_TERMS)
            { const int cls = ((s >> 4) == (t >> 4)) ? 1 : (((s >> 7) == (t >> 7)) ? 2 : 4); if (!(HC_TERMS & cls)) w = 0.f; }
#endif
            o += w * bf2f(row[C_VH + 128 * h + e]);
            __syncthreads();
            { const int d = e; cum[d] += (float)((const _Float16*)(row + (dir ? C_LB : C_LF) + 128 * h))[d]; }
            __syncthreads(); } }
#if defined(HC_DBG) && HC_DBG == 1
    o = bf2f(PA[(size_t)m * NPA + C_VH + 128 * h + e]);
#endif
    osum[e] = o * o; __syncthreads(); for (int k = 64; k > 0; k >>= 1) { if (e < k) osum[e] += osum[e + k]; __syncthreads(); }
    if (e == 0) ck_cmp(ssq[m * 4 + h], osum[0], 0.03f, 1e-3f, cnt + 1);
    const float sg = bf2f(PA[(size_t)m * NPA + C_SG + 128 * h + e]);
    ck_cmp(bf2f(YH[(size_t)m * 512 + 128 * h + e]), o * hng[128 * h + e] * sg, 0.03f, 0.01f, cnt + 0);
}
__global__ void ck_comb(const float* xold, const float* xnew, const int* tok_p, const float* tok_w, const bf16* Y, const float* gfin, int last, unsigned* cnt) {
    const int m = ck_row(blockIdx.x); __shared__ float red[256]; __shared__ float xv[D];
    if (m >= SEQ) return;
    const int p1 = tok_p[2 * m], p2 = tok_p[2 * m + 1]; const float w1 = tok_w[2 * m], w2 = tok_w[2 * m + 1]; float s = 0.f;
    for (int c = threadIdx.x; c < D; c += 256) { const float v = xold[(size_t)m * D + c] + w1 * bf2f(Y[(size_t)p1 * D + c]) + w2 * bf2f(Y[(size_t)p2 * D + c]); xv[c] = v; s += v * v; }
    red[threadIdx.x] = s; __syncthreads(); for (int o = 128; o > 0; o >>= 1) { if (threadIdx.x < o) red[threadIdx.x] += red[threadIdx.x + o]; __syncthreads(); }
    const float rstd = 1.0f / sqrtf(red[0] / D + NORM_EPS);
    for (int c = threadIdx.x; c < D; c += 256) ck_cmp(xnew[(size_t)m * D + c], last ? xv[c] * rstd * gfin[c] : xv[c], 0.005f, 0.005f, cnt);
}

__global__ void ck_gates_full(const bf16* XN, const float* w_in, const bf16* GT, unsigned* st) {
    const int m = blockIdx.x >> 3, pn = blockIdx.x & 7, c = pn * 256 + threadIdx.x; __shared__ float xr[D];
    for (int k = threadIdx.x; k < D; k += 256) xr[k] = bf2f(XN[(size_t)m * D + k]);
    __syncthreads();
    float a = 0.f; for (int k = 0; k < D; ++k) a += xr[k] * w_in[(size_t)k * INW + NPA + c];
#if defined(CK_PLAIN)
    const float ref = a, got = bf2f(GT[(size_t)m * NGATE + c]);
#else
    const float ref = 1.f / (1.f + expf(-a)), got = bf2f(GT[(size_t)m * NGATE + c]);
#endif
    if (m == 8122 && !(fabsf(got - ref) <= 0.05f)) atomicMin(st + 700, (unsigned)c);
    if (m == 8123 && !(fabsf(got - ref) <= 0.05f)) atomicMin(st + 701, (unsigned)c);
    if (m == 8122) { if (c == 130) st[702] = __float_as_uint(got), st[703] = __float_as_uint(ref), st[704] = __float_as_uint(a); if (c == 131) st[705] = __float_as_uint(got), st[706] = __float_as_uint(ref); }
    if (!(fabsf(got - ref) <= 0.05f)) { atomicAdd(st + (m >> 8), 1u); atomicAdd(st + 128 + (m & 255), 1u); atomicAdd(st + 384 + threadIdx.x, 1u); atomicAdd(st + 640 + pn, 1u); }
}
__global__ void ck_flush() { asm volatile("buffer_wbl2 sc0 sc1\n\ts_waitcnt vmcnt(0)\n\tbuffer_inv sc0 sc1\n\ts_waitcnt vmcnt(0)" ::: "memory"); }

__global__ void ck_ha(const bf16* PA, const bf16* US, const float* HD, unsigned* cnt) {
    const int sidx = blockIdx.x, bh = sidx % 8, dir = (sidx >> 3) & 1, n = (sidx * 37 + 5) % NCH, b = bh >> 2, h = bh & 3, d = threadIdx.x, t0 = n * CH;
    __shared__ float kts[CH][128]; float cum = 0.f;
    for (int k = CH - 1; k >= 0; --k) { const int tok = dir ? (t0 + CH - 1 - k) : (t0 + k);
        const float lf = (float)((const _Float16*)(PA + (size_t)(b * SEQ + tok) * NPA + (dir ? C_LB : C_LF) + 128 * h))[d];
        kts[k][d] = -expm1f(lf) * expf(cum); cum += lf; }
    ck_cmp(HD[((size_t)(bh * 2 + dir) * NCH + n) * 128 + d], expf(cum), 0.01f, 1e-6f, cnt + 1);
    for (int e = 0; e < 128; e += 5) { float u = 0.f;
        for (int k = 0; k < CH; ++k) { const int tok = dir ? (t0 + CH - 1 - k) : (t0 + k); u += kts[k][d] * bf2f(PA[(size_t)(b * SEQ + tok) * NPA + C_VH + 128 * h + e]); }
        ck_cmp(bf2f(US[(((size_t)(bh * 2 + dir) * NCH + n) * 128 + e) * 128 + d]), u, 0.03f, 0.01f, cnt + 0); }
}
__global__ void ck_hb(const bf16* PA, const bf16* US, unsigned* cnt) {
    const int sidx = blockIdx.x, bh = sidx % 8, dir = (sidx >> 3) & 1, n = (sidx * 37 + 5) % NCH, b = bh >> 2, h = bh & 3, d = threadIdx.x, e = (sidx * 11 + 3) % 128;
    float cum = 0.f, sacc = 0.f;
    for (int k = 0; k < 1024; ++k) { const int tok = dir ? ((n + 1) * CH + k) : (n * CH - 1 - k); if (tok < 0 || tok >= SEQ) break;
        const bf16* row = PA + (size_t)(b * SEQ + tok) * NPA; const float lf = (float)((const _Float16*)(row + (dir ? C_LB : C_LF) + 128 * h))[d];
        sacc += -expm1f(lf) * expf(cum) * bf2f(row[C_VH + 128 * h + e]); cum += lf; }
    ck_cmp(bf2f(US[(((size_t)(bh * 2 + dir) * NCH + n) * 128 + e) * 128 + d]), sacc, 0.03f, 0.01f, cnt);
}

__global__ void ck_mfma(unsigned* cnt) {
#if defined(__HIP_DEVICE_COMPILE__)
    const int lane = threadIdx.x, fr = lane & 15, g = lane >> 4;
    float av[8], bv[8];
    for (int j = 0; j < 8; ++j) { const int k = 8 * g + j; av[j] = (k == 0) ? (float)fr : ((k == 9) ? (float)(fr * fr) : 0.f); bv[j] = (k == 0) ? (float)(fr + 1) : ((k == 9) ? 0.5f : 0.f); }
    f32x4 d = (f32x4){0.f, 0.f, 0.f, 0.f};
    d = mfma16(pack_frag(av), pack_frag(bv), d);
    for (int r = 0; r < 4; ++r) { const int s = 4 * g + r, c = fr; const float ref = (float)s * (float)(c + 1) + (float)(s * s) * 0.5f; if (fabsf(d[r] - ref) > 0.01f * fabsf(ref) + 0.01f) atomicAdd(cnt, 1u); }
#endif
}
#ifndef CK_SKIP
#define CK_SKIP 0ull
#endif
__global__ void ck_report(const unsigned* cnt, int n, float* out) { if (threadIdx.x == 0 && blockIdx.x == 0) {
#if defined(CK_DBG7)
    const unsigned* dbg = cnt + 7 + 100; int nrows = 0, ngrp = 0; unsigned mx = 0, first = 99; for (int i = 0; i < CK_NS; ++i) if (dbg[i]) { ++nrows; mx = dbg[i] > mx ? dbg[i] : mx; } for (int i = 0; i < 64; ++i) if (dbg[64 + i]) { ++ngrp; if (first == 99) first = i; }
    if (CK_DBG7 == 4) { const float me = __uint_as_float(dbg[200]), ma = __uint_as_float(dbg[201]); out[0] = (1.0f + fminf(me, 0.89f) * 10.0f) * powf(10.0f, 5.0f + floorf(fminf(ma, 30.0f))); return; }
    if (CK_DBG7 == 5) { int nl = 0; unsigned mxl = 0; for (int i = 0; i < 32; ++i) if (dbg[300 + i]) { ++nl; mxl = dbg[300 + i] > mxl ? dbg[300 + i] : mxl; } out[0] = (1.0f + 0.1f * (float)nl) * powf(10.0f, 5.0f + (float)(mxl > 30 ? 30 : mxl)); return; }
    if (CK_DBG7 == 7) { out[0] = (1.0f + 0.01f * (float)(dbg[203] % 100)) * powf(10.0f, 5.0f + (float)(dbg[203] / 100)); return; }
    if (CK_DBG7 >= 10) { const unsigned* st = cnt + 512; int npan = 0, nrit = 0, ncol = 0, ntile = 0; unsigned tot = 0, mxp = 0; int firstp = -1, firstr = -1, firstc = -1;
        for (int i = 0; i < 128; ++i) if (st[i]) { ++npan; tot += st[i]; if (st[i] > mxp) mxp = st[i]; if (firstp < 0) firstp = i; }
        for (int i = 0; i < 256; ++i) { if (st[128 + i]) { ++nrit; if (firstr < 0) firstr = i; } if (st[384 + i]) { ++ncol; if (firstc < 0) firstc = i; } }
        for (int i = 0; i < 8; ++i) if (st[640 + i]) ++ntile;
        float a = 0.f, b = 0.f;
        if (CK_DBG7 == 10) { a = (float)npan; b = log10f((float)(tot ? tot : 1)) * 4.0f; }
        if (CK_DBG7 == 11) { a = (float)nrit; b = (float)ncol / 10.0f; }
        if (CK_DBG7 == 12) { a = (float)firstp; b = (float)firstr / 10.0f; }
        if (CK_DBG7 == 13) { a = (float)firstc; b = (float)ntile; }
        if (CK_DBG7 == 22) { out[0] = (1.0f + 8.0f * __uint_as_float(st[702])) * powf(10.0f, 5.0f + floorf(20.0f * __uint_as_float(st[703]) + 0.5f)); return; }
        if (CK_DBG7 == 23) { out[0] = (1.0f + 8.0f * __uint_as_float(st[705])) * powf(10.0f, 5.0f + floorf(20.0f * __uint_as_float(st[706]) + 0.5f)); return; }
        if (CK_DBG7 == 20) { a = (float)(st[700] % 100); b = (float)(st[700] / 100); }
        if (CK_DBG7 == 21) { a = (float)(st[701] > 5000 ? 99 : st[701] % 100); b = (float)(st[701] > 5000 ? 30 : st[701] / 100); }
        out[0] = (1.0f + 0.01f * a) * powf(10.0f, 5.0f + floorf(b)); return; }
    if (CK_DBG7 == 6) { out[0] = (1.0f + 0.01f * (float)(dbg[202] % 100)) * powf(10.0f, 5.0f + (float)(dbg[202] / 100)); return; }
    if (CK_DBG7 == 3) { int s1 = -1, s2 = -1; for (int i = 0; i < CK_NS; ++i) if (dbg[i] > 20) { if (s1 < 0) s1 = i; else if (s2 < 0) s2 = i; } out[0] = (1.0f + 0.1f * (float)(s1 < 0 ? 0 : s1 % 50)) * powf(10.0f, (float)(5 + (s2 < 0 ? 0 : (s2 % 25)))); return; }
    if (CK_DBG7 == 1) out[0] = (1.0f + 0.1f * (float)first) * powf(10.0f, (float)(5 + nrows / 2));
    else out[0] = (1.0f + 0.1f * (float)ngrp) * powf(10.0f, (float)(5 + (int)floorf(4.0f * log10f((float)(mx ? mx : 1)))));
    return;
#endif
    for (int i = 0; i < n; ++i) if (cnt[i] && !((CK_SKIP >> i) & 1ull)) {
    out[0] = (1.0f + 0.1f * (float)(i % 10)) * powf(10.0f, (float)(5 + i / 10)); return; } } }
#endif

#ifndef PG8_SP2
#define PG8_SP2 true
#endif
#ifndef PG8_ALIGN
#define PG8_ALIGN true
#endif
__global__ void __launch_bounds__(NWAVES * 64, 2) mega_fwd(Args args) {
    extern __shared__ __attribute__((aligned(16))) unsigned char lds[];
    Frame F;
    F.lds = (LAS unsigned char*)lds;
    F.MISC = (volatile LAS unsigned*)(F.lds + MISC_OFF);
    F.tid = threadIdx.x; F.lane = F.tid & 63; F.wave = __builtin_amdgcn_readfirstlane(F.tid >> 6);
    F.G = gridDim.x; { const int bx = blockIdx.x; F.vcu = (F.G % 8 == 0) ? (bx % 8) * (F.G / 8) + bx / 8 : bx; }
    F.ws = args.ws; F.ctl = (gu32*)(args.ws + WS_CTL); F.out = args.out;
    const Args& A = args;
    for (int u = F.tid; u < (LDS_BYTES - LDSCTL_OFF) / 4; u += NWAVES * 64) ((LAS unsigned*)(F.lds + LDSCTL_OFF))[u] = 0u;
    __syncthreads();
    XcdBarrier bar = xcd_barrier_post((unsigned*)(F.ctl + CW_BAR) + args.li * XCD_BAR_WORDS, F.MISC + 8);
    const int lo = args.ph_lo, hi = args.ph_hi;
#ifndef PHMASK
#define PHMASK 0xffff
#endif
#define IN(k) (((PHMASK >> ((k) & 15)) & 1) && lo <= (k) && (k) < hi)
#if defined(PROBE_MASK)
    unsigned long long pr_acc = 0ull, pr_t0 = 0ull;
#define PR_BEGIN(k) do { if ((PROBE_MASK >> ((k) & 15)) & 1) pr_t0 = wall_clock64(); } while (0)
#define PR_END(k) do { if ((PROBE_MASK >> ((k) & 15)) & 1) pr_acc += wall_clock64() - pr_t0; } while (0)
#else
#define PR_BEGIN(k)
#define PR_END(k)
#endif
#define SEAM(k) do { if ((k) + 1 < hi) xcd_barrier(bar); PR_END(k); } while (0)
#define WSP() GAS unsigned char* wsg_ = (GAS unsigned char*)args.ws; asm volatile("" : "+s"(wsg_)); unsigned char* ws = (unsigned char*)wsg_; F.ws = ws; { int t_ = threadIdx.x; asm volatile("" : "+v"(t_)); F.tid = t_; F.lane = t_ & 63; F.wave = __builtin_amdgcn_readfirstlane(t_ >> 6); int g_ = gridDim.x, b_ = blockIdx.x; asm volatile("" : "+s"(g_), "+s"(b_)); F.G = g_; F.vcu = (g_ % 8 == 0) ? (b_ % 8) * (g_ / 8) + b_ / 8 : b_; cid = b_; } \
    bf16* XN = (bf16*)(ws + WS_XN); bf16* PA = (bf16*)(ws + WS_PA); bf16* GT = (bf16*)(ws + WS_PA); bf16* MG = (bf16*)(ws + WS_US); \
    bf16* YA = (bf16*)(ws + WS_Y); bf16* YH = (bf16*)(ws + WS_YH); (void)XN; (void)PA; (void)GT; (void)MG; (void)YA; (void)YH;
    int cid = (int)blockIdx.x;

#if !defined(ORACLE) || defined(ORACLE_FAST)
#if XBF16
#define XB_CUR(l) ((l) == 0 ? (NORMFOLD ? (void*)XN : (void*)A.in[I_X]) : (void*)F.out)
#define XB_NEW(l) ((l) == DEPTH - 1 ? (bf16*)(ws + WS_Y) : (bf16*)F.out)
#define XIN0(l) ((const void*)XB_CUR(l))
#define EPIOUT_T(l) EpiOutB<(l) == 0 && !NORMFOLD>
#else
#define XB_CUR(l) ((void*)F.out)
#define XB_NEW(l) (F.out)
#define XIN0(l) ((l) == 0 ? A.in[I_X] : (const float*)F.out)
#define EPIOUT_T(l) EpiOut
#endif
#if NORMFOLD
#define G1_A(l) ((l) == 0 ? XN : (const bf16*)F.out)
#define M1_A(l) ((const bf16*)XB_NEW(l))
#else
#define G1_A(l) XN
#define M1_A(l) XN
#endif
#define XCOPY0 nullptr
#else
#define XCOPY0 F.out
#define XIN0(l) ((const float*)F.out)
#endif
    if (IN(0)) { WSP(); PR_BEGIN(0);
#if CONV_PER_WG0 > 0 && EXPERTS_BY_QUEUE && !(NORM4 && !NORMFOLD)
        {
            const int cw0 = conv_wgs(F.G, (T / 256) * ((NPA - 256 * G1A_SPLIT) / 256), CONV_WGS), gg0 = F.G - cw0;
            if (cid < gg0) { const int wi0 = cw0 ? cid * NWAVES + F.wave : -1, nw0 = gg0 * NWAVES;
                make_tables(F, A, cw0 ? cid * (NWAVES * 64) + F.tid : -1, gg0 * NWAVES * 64); conv_weights(F, A, 0, wi0, nw0);
                norm_rows(F, A.in[I_X], XCOPY0, A.in[I_ANG], XN, NORMFOLD ? (float*)(ws + WS_RSA) : nullptr, wi0, nw0); }
            else { conv_experts_range(F, A, 0, 0, cw0 * CONV_PER_WG0, (cid - gg0) * NWAVES + F.wave, cw0 * NWAVES);
                if (cid == gg0 && F.tid == 0) __hip_atomic_store(F.ctl + CW_H12, (unsigned)(cw0 * CONV_PER_WG0), __ATOMIC_RELAXED, __HIP_MEMORY_SCOPE_AGENT); } }
#else
        make_tables(F, A); conv_weights(F, A, 0);
#if NORM4 && !NORMFOLD
        norm_rows4(F, A.in[I_X], A.in[I_ANG], XN);
#else
        norm_rows(F, A.in[I_X], XCOPY0, A.in[I_ANG], XN, NORMFOLD ? (float*)(ws + WS_RSA) : nullptr);
#endif
#endif
        SEAM(0);
    }
#if G1A_SPLIT
#define PHASE3(l) if (IN(pb + 3)) { WSP(); PR_BEGIN(pb + 3);   \
            const int gh = G1A_SPLIT ? F.G / 2 : 0; \
            if (cid < gh) { pg8::Gemm g{XN, (const bf16*)(ws + WS_WIN) + (size_t)G1A_N * D, T, NPA - G1A_N, D}; pg8::StaticOrder S; S.init(T, NPA - G1A_N, gh, cid); \
                EpiInA E{PA, (const float*)(ws + WS_COS), (const float*)(ws + WS_SIN), (const float*)(ws + WS_LBT) + l * 2048, G1A_N / 256, (const float*)(ws + WS_RSA)}; \
                pg8::gemm_phase<EpiInA, pg8::StaticOrder, PG8_ALIGN, PG8_SP2>(F.lds + RING_OFF, g, S, E); } \
            else phase_hb(F, cid - gh, F.G - gh); \
            SEAM(pb + 3); }
#else
#define PHASE3(l) if (IN(pb + 3)) { WSP(); PR_BEGIN(pb + 3); phase_hb(F, F.vcu, F.G); SEAM(pb + 3); }
#endif
#if !defined(ORACLE) || defined(ORACLE_FAST)
#define G1A_N (NPA - 256 * G1A_SPLIT)
#define FAST_PHASES(l)         if (IN(pb + 2)) { WSP(); PR_BEGIN(pb + 2); PR_BEGIN(14); phase_attn(F, A.in[I_SINK] + (l) * NQH); PR_END(14); PR_BEGIN(15); phase_ha(F); PR_END(15); SEAM(pb + 2); } \
        PHASE3(l) \
        if (IN(pb + 4)) { WSP(); PR_BEGIN(pb + 4); phase_hc(F, A.in[I_HNG] + (l) * 512); SEAM(pb + 4); }
#else
#define G1A_N NPA
#define FAST_PHASES(l)
#endif
#if MOE_HANDOFF
#define MOE_ORDER1 pg8::ProducerOrder
#define MOE_ORDER2 pg8::ConsumerOrder
#define MOE_CNT(l) S.cnt = (unsigned*)(F.ctl + CW_MOE + (l) * MOE_BANK + 64);
#define MOE_SEAM(k) PR_END(k)
#else
#define MOE_ORDER1 pg8::GroupedOrder
#define MOE_ORDER2 pg8::GroupedOrder
#define MOE_CNT(l)
#define MOE_SEAM(k) SEAM(k)
#endif
#if ROUTE_MFMA
#define ROUTE_FN phase_route_mfma
#elif ROUTE4
#define ROUTE_FN phase_norm_route4
#else
#define ROUTE_FN phase_norm_route
#endif
#if defined(PROBE_BARRIERS)
#define PROBE_BARRIERS_EXTRA for (int k_ = 0; k_ < PROBE_BARRIERS; ++k_) xcd_barrier(bar);
#else
#define PROBE_BARRIERS_EXTRA
#endif
#if defined(PROBE_KLOOP)
#define PROBE_KLOOP_EXTRA { EpiNull E2{GT}; pg8::gemm_phase<EpiNull, pg8::StaticOrder, PG8_ALIGN, PG8_SP2>(F.lds + RING_OFF, g, S, E2); }
#else
#define PROBE_KLOOP_EXTRA
#endif
#define LAYER_BODY(l) { const int pb = 16 * (l); \
        if (IN(pb + 1)) { WSP(); PR_BEGIN(pb + 1); \
            const int cw = conv_wgs(F.G, (T / 256) * (G1A_N / 256), CONV_WGS), gg = F.G - cw;     \
            if (cid < gg) { pg8::Gemm g{G1_A(l), (const bf16*)(ws + WS_WIN), T, G1A_N, D}; pg8::StaticOrder S; S.init(T, G1A_N, gg, cid); \
                EpiInA E{PA, (const float*)(ws + WS_COS), (const float*)(ws + WS_SIN), (const float*)(ws + WS_LBT) + l * 2048, 0, (const float*)(ws + WS_RSA)}; \
                pg8::gemm_phase<EpiInA, pg8::StaticOrder, PG8_ALIGN, PG8_SP2>(F.lds + RING_OFF, g, S, E); } \
            if (EXPERTS_BY_QUEUE) { const int n1 = NEXP * 16 * 32, h0 = __builtin_amdgcn_readfirstlane((int)VLD(F.ctl + CW_H12)), h1 = min(n1, h0 + cw * ((l) ? CONV_PER_WG1 - 64 : CONV_PER_WG1));     \
                if (cid >= gg) conv_experts_range(F, A, l, h0, h1, (cid - gg) * NWAVES + F.wave, cw * NWAVES); \
                if (cw == 0) conv_experts_range(F, A, l, h1, n1, F.vcu * NWAVES + F.wave, F.G * NWAVES); \
                else if (cid < gg) conv_experts_range(F, A, l, h1, n1, cid * NWAVES + F.wave, gg * NWAVES); }   \
            SEAM(pb + 1); \
        } \
FAST_PHASES(l) \
        if (IN(pb + 5)) { WSP(); PR_BEGIN(pb + 5); \
            pg8::Gemm g{G1_A(l), (const bf16*)(ws + WS_WIN) + (size_t)NPA * D, T, NGATE, D}; pg8::StaticOrder S; S.init(T, NGATE, F.G, cid); \
            EpiGate E{GT, (const float*)(ws + WS_RSA)}; \
            pg8::gemm_phase<EpiGate, pg8::StaticOrder, PG8_ALIGN, PG8_SP2>(F.lds + RING_OFF, g, S, E); \
            PROBE_KLOOP_EXTRA \
            SEAM(pb + 5); \
        } \
        if (IN(pb + 6)) { WSP(); PR_BEGIN(pb + 6); \
            pg8::Gemm g{YA, (const bf16*)(ws + WS_WUA), T, D, 512}; pg8::StaticOrder S; S.init(T, D, F.G, cid); \
            EpiUpA E{MG, GT}; \
            pg8::gemm_phase<EpiUpA, pg8::StaticOrder, PG8_ALIGN, PG8_SP2>(F.lds + RING_OFF, g, S, E); \
            PR_END(pb + 6);   \
        } \
        if (IN(pb + 7)) { WSP(); PR_BEGIN(pb + 7); \
            pg8::Gemm g{YH, (const bf16*)(ws + WS_WUH), T, D, 512}; pg8::StaticOrder S; S.init(T, D, F.G, cid); \
            EpiUpB E{MG, GT, (const float*)(ws + WS_SSQ)}; \
            pg8::gemm_phase<EpiUpB, pg8::StaticOrder, PG8_ALIGN, PG8_SP2>(F.lds + RING_OFF, g, S, E); \
            SEAM(pb + 7); \
        } \
        if (IN(pb + 8)) { WSP(); PR_BEGIN(pb + 8); \
            pg8::Gemm g{MG, (const bf16*)(ws + WS_WOUT), T, D, D}; pg8::StaticOrder S; S.init(T, D, F.G, cid); \
            EPIOUT_T(l) E{XB_NEW(l), XIN0(l)}; \
            pg8::gemm_phase<EPIOUT_T(l), pg8::StaticOrder, PG8_ALIGN, PG8_SP2>(F.lds + RING_OFF, g, S, E); \
            SEAM(pb + 8); \
        } \
        if (IN(pb + 9)) { WSP(); PR_BEGIN(pb + 9); ROUTE_FN(F, A, l, XB_NEW(l)); SEAM(pb + 9); } \
        if (IN(pb + 10)) { WSP(); PR_BEGIN(pb + 10); phase_dispatch(F); PROBE_BARRIERS_EXTRA SEAM(pb + 10); } \
        if (IN(pb + 11)) { WSP(); PR_BEGIN(pb + 11); \
            const int cw = MOE_HANDOFF ? 0 : conv_wgs(F.G, 4 * __builtin_amdgcn_readfirstlane((int)VLD((const int*)(ws + WS_META))), CONV_WGS_MOE), gg = F.G - cw;     \
            if (cid < gg) { pg8::Gemm g{M1_A(l), (const bf16*)(ws + WS_W1), SLOT_ROWS, D, D}; MOE_ORDER1 S; S.init((const int*)(ws + WS_META), D, gg, cid); MOE_CNT(l) \
                EpiAct E{(bf16*)(ws + WS_ACT), (const float*)(ws + WS_RSS)}; \
                pg8::gemm_phase<EpiAct, MOE_ORDER1, PG8_ALIGN, PG8_SP2, true>(F.lds + RING_OFF, g, S, E, (const int*)(ws + WS_STOK)); } \
            if (EXPERTS_BY_QUEUE) { const int n1 = NEXP * 16 * 32, n2 = NEXP * 8 * 32, h2 = min(n2, cw * CONV_PER_WG2); \
                if (cid >= gg) { conv_experts_range(F, A, l, n1, n1 + h2, (cid - gg) * NWAVES + F.wave, cw * NWAVES); \
                    if (DENSE_EARLY && (l) + 1 < DEPTH) conv_weights(F, A, (l) + 1, (cid - gg) * NWAVES + F.wave, cw * NWAVES); }     \
                conv_experts_range(F, A, l, n1 + h2, n1 + n2, F.vcu * NWAVES + F.wave, F.G * NWAVES); } \
            MOE_SEAM(pb + 11); \
        } \
        if (IN(pb + 12)) { WSP(); PR_BEGIN(pb + 12); \
            const int cw = (MOE_HANDOFF || !EXPERTS_BY_QUEUE || (l) == DEPTH - 1) ? 0 : conv_wgs(F.G, 4 * __builtin_amdgcn_readfirstlane((int)VLD((const int*)(ws + WS_META))), CONV_WGS_MOE), gg = F.G - cw;     \
            if (cid < gg) { pg8::Gemm g{(const bf16*)(ws + WS_ACT), (const bf16*)(ws + WS_W2), SLOT_ROWS, D, DEXP}; MOE_ORDER2 S; S.init((const int*)(ws + WS_META), D, gg, cid, MOE_HANDOFF != 0); MOE_CNT(l) \
                EpiY E{(bf16*)(ws + WS_XP)}; \
                pg8::gemm_phase<EpiY, MOE_ORDER2, PG8_ALIGN, PG8_SP2, false, MOE_HANDOFF ? 16 : 0>(F.lds + RING_OFF, g, S, E); } \
            else conv_experts_range(F, A, (l) + 1, 0, cw * CONV_PER_WG12, (cid - gg) * NWAVES + F.wave, cw * NWAVES); \
            if (cw > 0 && cid == 0 && F.tid == 0) __hip_atomic_store(F.ctl + CW_H12, (unsigned)(cw * CONV_PER_WG12), __ATOMIC_RELAXED, __HIP_MEMORY_SCOPE_AGENT);     \
            SEAM(pb + 12); \
        } \
        if (IN(pb + 13)) { WSP(); PR_BEGIN(pb + 13); \
            const bool last = (l == DEPTH - 1); \
            if (!last && !(DENSE_EARLY && conv_wgs(F.G, 4 * __builtin_amdgcn_readfirstlane((int)VLD((const int*)(ws + WS_META))), CONV_WGS_MOE) > 0 && !MOE_HANDOFF)) conv_weights(F, A, l + 1); \
            phase_combine(F, last ? A.in[I_FING] : A.in[I_ANG] + (size_t)(l + 1) * D, last, XB_NEW(l), XB_CUR((l) + 1)); \
            if (!last) { if ((pb + 15) + 1 < hi) xcd_barrier(bar); } PR_END(pb + 13); \
        } \
    }
    LAYER_BODY(0)
    LAYER_BODY(1)
    static_assert(DEPTH == 2, "layer bodies are written out");
#if defined(PROBE_MASK)
    if (blockIdx.x == 0 && threadIdx.x == 0) { const unsigned long long t1 = wall_clock64(), want = (unsigned long long)PROBE_MULT * pr_acc; while (wall_clock64() - t1 < want) __builtin_amdgcn_s_sleep(8); }
#endif
#undef IN
#undef SEAM
}

extern "C" void kernel_launch(void* const* d_in, const int* in_sizes, int n_in, void* d_out, int out_size, void* d_ws, size_t ws_size, hipStream_t stream) {
    static int grid = 0;
    if (grid == 0) {
        if (n_in != 18 || in_sizes[0] != T * D || out_size != T * D || ws_size < WS_END) { fprintf(stderr, "kernel_launch: unexpected shapes (n_in %d, in0 %d, out %d, ws %zu); nothing launched\n", n_in, n_in > 0 ? in_sizes[0] : -1, out_size, ws_size); grid = -1; return; }
        int dev = 0, cus = 0, per_cu = 0;
        if (hipGetDevice(&dev) != hipSuccess || hipDeviceGetAttribute(&cus, hipDeviceAttributeMultiprocessorCount, dev) != hipSuccess) { grid = -1; return; }
        if (hipFuncSetAttribute((const void*)mega_fwd, hipFuncAttributeMaxDynamicSharedMemorySize, LDS_BYTES) != hipSuccess) { fprintf(stderr, "kernel_launch: hipFuncSetAttribute failed\n"); grid = -1; return; }
        if (hipOccupancyMaxActiveBlocksPerMultiprocessor(&per_cu, (const void*)mega_fwd, NWAVES * 64, LDS_BYTES) != hipSuccess || per_cu < 1)
            fprintf(stderr, "kernel_launch: note: occupancy query reports %d workgroups per CU\n", per_cu);
        (void)hipGetLastError();
        grid = cus;
    }
    if (grid < 0) return;
    if (hipMemsetAsync((char*)d_ws + WS_CTL, 0, CTL_ZERO_BYTES, stream) != hipSuccess) return;
    Args a{};
    for (int i = 0; i < 18; ++i) a.in[i] = (const float*)d_in[i];
    a.out = (float*)d_out; a.ws = (unsigned char*)d_ws; a.pad = 0;
    int li = 0;
    auto launch = [&](int lo, int hi) { a.ph_lo = lo; a.ph_hi = hi; a.li = li++; hipLaunchKernelGGL(mega_fwd, dim3(grid), dim3(NWAVES * 64), LDS_BYTES, stream, a);
        const hipError_t le = hipPeekAtLastError(); if (le != hipSuccess) fprintf(stderr, "kernel_launch: launch [%d,%d) failed: %s\n", lo, hi, hipGetErrorName(le)); };
#if defined(ORACLE)
    unsigned char* ws = (unsigned char*)d_ws;
#if defined(CHECK)
    unsigned* cnt = (unsigned*)(ws + 525 * MiB + 512 * 1024); hipMemsetAsync(cnt, 0, 4096, stream);
    hipLaunchKernelGGL(ck_mfma, dim3(1), dim3(64), 0, stream, cnt + 39); hipMemsetAsync(cnt + 512 + 700, 0xFF, 8, stream);
    const float* const* in = (const float* const*)d_in; float* xs = (float*)d_out;
    const bf16* XNc = (const bf16*)(ws + WS_XN); const bf16* PAc = (const bf16*)(ws + WS_PA); const bf16* MGc = (const bf16*)(ws + WS_US);
    const bf16* YAc = (const bf16*)(ws + WS_Y); const bf16* YHc = (const bf16*)(ws + WS_YH); const float* ssqc = (const float*)(ws + WS_SSQ);
#define CKL(k, ...) hipLaunchKernelGGL(k, dim3(CK_NS), dim3(256), 0, stream, __VA_ARGS__)
#endif
    for (int l = 0; l < DEPTH; ++l) {
#if defined(CHECK)
        const float* w_in_l = in[I_WIN] + (size_t)l * D * INW; unsigned* c0 = cnt + 20 * l;
        if (l == 0) { launch(0, 1); CKL(ck_norm, in[I_X], in[I_ANG], XNc, c0 + 0); launch(1, 2); }
        else { CKL(ck_norm, (const float*)xs, in[I_ANG] + (size_t)l * D, XNc, c0 + 0); launch(16 * l + 1, 16 * l + 2); }
        CKL(ck_pa, XNc, w_in_l, in[I_LBT], l, PAc, c0 + 1);
#else
        if (l == 0) launch(0, 2); else launch(16 * l + 1, 16 * l + 2);
#endif
#if defined(ORACLE_FAST)
        launch(16 * l + 2, 16 * l + 3);
#if defined(CHECK)
        hipLaunchKernelGGL(ck_ha, dim3(CK_NS), dim3(128), 0, stream, (const bf16*)(ws + WS_PA), (const bf16*)(ws + WS_US), (const float*)(ws + WS_HD), cnt + 20 * l + 40 + 0);
#endif
        launch(16 * l + 3, 16 * l + 4);
#if defined(CHECK)
        hipLaunchKernelGGL(ck_hb, dim3(CK_NS), dim3(128), 0, stream, (const bf16*)(ws + WS_PA), (const bf16*)(ws + WS_US), cnt + 20 * l + 40 + 2);
#endif
        launch(16 * l + 4, 16 * l + 5);
#else
        hipLaunchKernelGGL(zero_f32, dim3(T * 4 / 256), dim3(256), 0, stream, (float*)(ws + WS_SSQ), T * 4);
        hipLaunchKernelGGL(simple_attn, dim3(T * 8 / 4), dim3(256), 0, stream, (const bf16*)(ws + WS_PA), (const float*)d_in[I_SINK] + l * NQH, (bf16*)(ws + WS_Y));
        hipLaunchKernelGGL(simple_hgrn, dim3(8), dim3(512), 0, stream, (const bf16*)(ws + WS_PA), (const float*)d_in[I_HNG] + l * 512, (float*)(ws + WS_US), (bf16*)(ws + WS_YH), (float*)(ws + WS_SSQ));
#endif
#if defined(CHECK)
        CKL(ck_attn, PAc, in[I_SINK] + l * NQH, YAc, c0 + 3 + 40); hipLaunchKernelGGL(ck_hgrn, dim3(CK_NS, 4), dim3(128), 0, stream, PAc, in[I_HNG] + l * 512, YHc, ssqc, c0 + 4 + 40);
        const float* wua = in[I_WUA] + (size_t)l * 512 * D; const float* wuh = in[I_WUH] + (size_t)l * 512 * D; const int pb = 16 * l;
#if defined(CK_SENTINEL)
        hipMemsetAsync(ws + WS_PA, 0xFF, (size_t)T * NGATE * 2, stream);
#endif
#if defined(CK_FLUSH)
        hipLaunchKernelGGL(ck_flush, dim3(4096), dim3(64), 0, stream);
#endif
        launch(pb + 5, pb + 6);
#if defined(CK_FLUSH)
        hipLaunchKernelGGL(ck_flush, dim3(4096), dim3(64), 0, stream);
#endif
        if (l == 0) hipLaunchKernelGGL(ck_gates_full, dim3(T * 8), dim3(256), 0, stream, XNc, w_in_l, PAc, cnt + 512); CKL(ck_mix, XNc, w_in_l, YAc, YHc, ssqc, wua, wuh, PAc, MGc, 0, c0 + 7);
        launch(pb + 6, pb + 7); CKL(ck_mix, XNc, w_in_l, YAc, YHc, ssqc, wua, wuh, PAc, MGc, 1, c0 + 7);
        launch(pb + 7, pb + 8); CKL(ck_mix, XNc, w_in_l, YAc, YHc, ssqc, wua, wuh, PAc, MGc, 2, c0 + 7);
        launch(pb + 8, pb + 9); if (l == 0) CKL(ck_out, in[I_X], MGc, in[I_WOUT], (const float*)xs, c0 + 10);
        const float* gff = in[I_FNG] + (size_t)l * D; const float* wrg = in[I_WRG] + (size_t)l * D * NGRP; const float* brg = in[I_BRG] + l * NGRP; const float* wre = in[I_WRE] + (size_t)l * NGRP * D * EPG; const float* bre = in[I_BRE] + l * NGRP * EPG;
        const float* weg = in[I_WEG] + (size_t)l * NEXP * D * DEXP; const float* weu = in[I_WEU] + (size_t)l * NEXP * D * DEXP; const float* wed = in[I_WED] + (size_t)l * NEXP * DEXP * D;
        const int* toke = (const int*)(ws + WS_TOKE); const float* tokw = (const float*)(ws + WS_TOKW); const int* tokp = (const int*)(ws + WS_TOKP); const int* metac = (const int*)(ws + WS_META);
        const bf16* XPc = (const bf16*)(ws + WS_XP); const bf16* ACTc = (const bf16*)(ws + WS_ACT);
#define CKM(st) CKL(ck_moe, (const float*)xs, gff, wrg, brg, wre, bre, weg, weu, wed, XNc, toke, tokw, tokp, metac, XPc, ACTc, XPc, st, c0 + 12)
        launch(pb + 9, pb + 10); CKL(ck_norm, (const float*)xs, gff, XNc, c0 + 11); CKM(0);
        launch(pb + 10, pb + 11); CKM(1);
        launch(pb + 11, pb + 12); CKM(2);
        launch(pb + 12, pb + 13); CKM(3);
        hipMemcpyAsync(ws + WS_US, xs, (size_t)T * D * 4 / 2, hipMemcpyDeviceToDevice, stream);
        launch(pb + 13, pb + 14);
        CKL(ck_comb, (const float*)(ws + WS_US), (const float*)xs, tokp, tokw, XPc, in[I_FING], (int)(l == DEPTH - 1), c0 + 6 + 40);
#else
#if defined(STOP_AFTER)
        launch(16 * l + 5, STOP_AFTER + 1); break;
#else
        launch(16 * l + 5, 16 * l + 14);
#endif
#endif
    }
#if defined(CHECK)
    hipLaunchKernelGGL(ck_report, dim3(1), dim3(64), 0, stream, (const unsigned*)cnt, 80, xs);
#endif
#else
    launch(0, 16 * (DEPTH - 1) + 14);
#endif
}
```
